# Optimizing an MI355X kernel written in HIP

```python
import math
import jax
import jax.numpy as jnp
from jax import lax
import numpy as np

D_MODEL = 2048
BATCH = 4
SEQ = 2048
DEPTH = 1

GRID_W = 64
CTX_LEN = 256
HEAD_DIM = 64
D_HY = 1024
D_NA = D_MODEL - D_HY
NA_HEADS = D_NA // HEAD_DIM
OFF_Q = 3 * D_HY
OFF_K = OFF_Q + D_NA
OFF_V = OFF_K + D_NA
D_PROJ = OFF_V + D_NA
SHORT_CONV = 3
HY_ORDER = 2
FILTER_EMB = 33
FILTER_ORDER = 64
DECAY_TARGET = 1e-2
FAST_DECAY_PCT = 0.3
SLOW_DECAY_PCT = 1.5
NA_KH = 8
NA_KW = 16
NA_QB = 16
NA_KB = 2 * NA_KW
PEER_HEADS = 8
PEER_NKEYS = 128
PEER_EXPERTS = PEER_NKEYS * PEER_NKEYS
PEER_DKEY = 256
PEER_TOPK = 16
PEER_CHUNK = 128
LN_EPS = 1e-5
ALPHA = (2.0 * DEPTH) ** 0.25
BETA = (8.0 * DEPTH) ** -0.25
NEG_INF = -1e30

kernel_name = 'hymba_hyena_natten_peer_dit_block'


def layer_norm(x, g, b):
    xf = x.astype(jnp.float32)
    xc = xf - jnp.mean(xf, -1, keepdims=True)
    var = jnp.mean(xc * xc, -1, keepdims=True)
    return (xc * lax.rsqrt(var + LN_EPS) * g + b).astype(x.dtype)


def rms_norm(x, g):
    xf = x.astype(jnp.float32)
    return (xf * lax.rsqrt(jnp.mean(xf * xf, -1, keepdims=True) + LN_EPS) * g).astype(x.dtype)


def ada_params(cond, w_ada, b_ada):
    m = jax.nn.silu(cond) @ w_ada + b_ada
    return m.reshape(cond.shape[0], 6, 1, D_MODEL)


def modulate(x, shift, scale):
    return x * (1.0 + scale) + shift


def short_conv(z, w, b):
    L = z.shape[1]
    zp = jnp.pad(z, ((0, 0), (1, 1), (0, 0)))
    return zp[:, :L] * w[0] + zp[:, 1:L + 1] * w[1] + zp[:, 2:L + 2] * w[2] + b


def hyena_filters(L, w1, b1, w2, b2, w3, b3, w4, freq):
    t = jnp.linspace(0.0, 1.0, L, dtype=jnp.float32)[:, None]
    bands = (FILTER_EMB - 1) // 2
    w = 2.0 * math.pi * jnp.arange(L, dtype=jnp.float32)[:, None] / L
    f = jnp.linspace(1e-4, bands - 1, bands, dtype=jnp.float32)[None, :]
    z = jnp.concatenate([t, jnp.cos(f * w), -jnp.sin(f * w)], axis=-1)
    h = jnp.sin(freq[0] * (z @ w1 + b1))
    h = jnp.sin(freq[1] * (h @ w2 + b2))
    h = jnp.sin(freq[2] * (h @ w3 + b3))
    h = (h @ w4).astype(jnp.float32).reshape(L, HY_ORDER, 2, D_HY)
    deltas = jnp.abs(jnp.linspace(math.log(DECAY_TARGET) / SLOW_DECAY_PCT,
                                  math.log(DECAY_TARGET) / FAST_DECAY_PCT, D_HY, dtype=jnp.float32))
    h = h * jnp.exp(-t * deltas)[:, None, None, :]
    h = h / jnp.sum(jnp.abs(h), axis=(0, 2), keepdims=True)
    fwd, bwd = h[:, :, 0], h[:, :, 1]
    k_circ = jnp.concatenate([fwd, jnp.zeros_like(fwd[:1]), bwd[:0:-1]], axis=0)
    return jnp.fft.rfft(k_circ, axis=0)


def hyena(z, kf, skip, conv_w, conv_b):
    L = z.shape[1]
    z = short_conv(z, conv_w, conv_b)
    v, x1, x2 = jnp.split(z, 3, axis=-1)

    def long_conv(u, o):
        uf = jnp.fft.rfft(u.astype(jnp.float32), n=2 * L, axis=1)
        y = jnp.fft.irfft(uf * kf[:, o], n=2 * L, axis=1)[:, :L]
        return y.astype(u.dtype) + u * skip[o]

    y = x1 * long_conv(v, 0)
    return x2 * long_conv(y, 1)


def neighbourhood_attention(q, k, v, k_ctx, v_ctx, rpb):
    B, L, H, DH = q.shape
    rows = L // GRID_W
    kh = min(NA_KH, rows)
    ncb = GRID_W // NA_QB
    nk = kh * NA_KB
    r = jnp.arange(rows)
    row_start = jnp.clip(r - kh // 2, 0, rows - kh)
    key_rows = row_start[:, None] + jnp.arange(kh)
    j = jnp.arange(ncb)
    col_start = jnp.clip(j * NA_QB - NA_KW // 2, 0, GRID_W - NA_KB)
    key_cols = col_start[:, None] + jnp.arange(NA_KB)
    tok = (key_rows[:, None, :, None] * GRID_W + key_cols[None, :, None, :]).reshape(rows, ncb, nk)
    k_blk = k[:, tok]
    v_blk = v[:, tok]
    q_blk = q.reshape(B, rows, ncb, NA_QB, H, DH)
    q_col = j[:, None] * NA_QB + jnp.arange(NA_QB)
    win_start = jnp.clip(q_col - NA_KW // 2, 0, GRID_W - NA_KW)
    rel = key_cols[:, None, :] - win_start[:, :, None]
    col_ok = (rel >= 0) & (rel < NA_KW)
    mask = jnp.broadcast_to(col_ok[:, :, None, :], (ncb, NA_QB, kh, NA_KB)).reshape(ncb, NA_QB, nk)
    d_row = key_rows - r[:, None]
    d_col = jnp.clip(key_cols[:, None, :] - q_col[:, :, None] + NA_KW - 1, 0, 2 * NA_KW - 2)
    bias = rpb[:, d_row + NA_KH - 1][..., d_col]
    bias = bias.transpose(0, 1, 3, 4, 2, 5).reshape(H, rows, ncb, NA_QB, nk)
    scale = HEAD_DIM ** -0.5
    s_lat = jnp.einsum('brjqhd,brjkhd->bhrjqk', q_blk, k_blk).astype(jnp.float32) * scale + bias
    s_lat = jnp.where(mask, s_lat, NEG_INF)
    s_ctx = jnp.einsum('brjqhd,bchd->bhrjqc', q_blk, k_ctx).astype(jnp.float32) * scale
    p = jax.nn.softmax(jnp.concatenate([s_lat, s_ctx], axis=-1), axis=-1).astype(v.dtype)
    o = (jnp.einsum('bhrjqk,brjkhd->brjqhd', p[..., :nk], v_blk)
         + jnp.einsum('bhrjqc,bchd->brjqhd', p[..., nk:], v_ctx))
    return o.reshape(B, L, H * DH)


def context_attention(q, k, v):
    B, C, H, DH = q.shape
    s = jnp.einsum('bqhd,bkhd->bhqk', q, k).astype(jnp.float32) * HEAD_DIM ** -0.5
    p = jax.nn.softmax(s, axis=-1).astype(v.dtype)
    return jnp.einsum('bhqk,bkhd->bqhd', p, v).reshape(B, C, H * DH)


def merge_groups(hy_out, na_out, g_hy, g_na, w_out):
    return jnp.concatenate([rms_norm(hy_out, g_hy), rms_norm(na_out, g_na)], axis=-1) @ w_out


def peer(u, w_q, sub_keys, expert_u, expert_v):
    B, L, D = u.shape
    q = (u @ w_q).reshape(B, L, PEER_HEADS, 2, PEER_DKEY // 2)
    s = jnp.einsum('blhpd,hpnd->blhpn', q, sub_keys).astype(jnp.float32)
    s_a, i_a = lax.top_k(s[..., 0, :], PEER_TOPK)
    s_b, i_b = lax.top_k(s[..., 1, :], PEER_TOPK)
    n_cand = PEER_TOPK * PEER_TOPK
    cand_s = (s_a[..., :, None] + s_b[..., None, :]).reshape(B, L, PEER_HEADS, n_cand)
    cand_i = (i_a[..., :, None] * PEER_NKEYS + i_b[..., None, :]).reshape(B, L, PEER_HEADS, n_cand)
    top_s, pos = lax.top_k(cand_s, PEER_TOPK)
    idx = jnp.take_along_axis(cand_i, pos, axis=-1)
    g = jax.nn.softmax(top_s, axis=-1).astype(u.dtype)
    n_chunks = (B * L) // PEER_CHUNK
    sel = PEER_HEADS * PEER_TOPK
    u_c = u.reshape(n_chunks, PEER_CHUNK, D)
    idx_c = idx.reshape(n_chunks, PEER_CHUNK, sel)
    g_c = g.reshape(n_chunks, PEER_CHUNK, sel)

    def chunk(args):
        ut, it, gt = args
        act = jax.nn.gelu(jnp.einsum('td,tkd->tk', ut, expert_u[it]), approximate=False)
        return jnp.einsum('tk,tkd->td', gt * act, expert_v[it])

    return lax.map(chunk, (u_c, idx_c, g_c)).reshape(B, L, D)


def setup_inputs(seed: int = 0) -> dict:
    key = jax.random.key(seed)
    ks = jax.random.split(key, 32)

    def nrm(k, shape, s):
        return jax.random.normal(k, shape, jnp.float32) * s

    col_scale = jnp.concatenate([jnp.full((D_HY,), BETA, jnp.float32),
                                 jnp.ones((OFF_V - D_HY,), jnp.float32),
                                 jnp.full((D_NA,), BETA, jnp.float32)])
    return {
        'x': nrm(ks[0], (BATCH, SEQ, D_MODEL), 1.0),
        'c': nrm(ks[1], (BATCH, D_MODEL), 1.0),
        'ctx': nrm(ks[2], (BATCH, CTX_LEN, D_MODEL), 1.0),
        'c_ctx': nrm(ks[3], (D_MODEL,), 1.0),
        'w_ada': nrm(ks[4], (DEPTH, D_MODEL, 6 * D_MODEL), D_MODEL ** -0.5),
        'b_ada': nrm(ks[5], (DEPTH, 6 * D_MODEL), 0.01),
        'w_in': nrm(ks[6], (DEPTH, D_MODEL, D_PROJ), D_MODEL ** -0.5) * col_scale,
        'conv_w': nrm(ks[7], (DEPTH, SHORT_CONV, 3 * D_HY), SHORT_CONV ** -0.5),
        'conv_b': nrm(ks[8], (DEPTH, 3 * D_HY), 0.01),
        'filt_w1': nrm(ks[9], (DEPTH, FILTER_EMB, FILTER_ORDER), FILTER_EMB ** -0.5),
        'filt_b1': nrm(ks[10], (DEPTH, FILTER_ORDER), 0.1),
        'filt_w2': nrm(ks[11], (DEPTH, FILTER_ORDER, FILTER_ORDER), FILTER_ORDER ** -0.5),
        'filt_b2': nrm(ks[12], (DEPTH, FILTER_ORDER), 0.1),
        'filt_w3': nrm(ks[13], (DEPTH, FILTER_ORDER, FILTER_ORDER), FILTER_ORDER ** -0.5),
        'filt_b3': nrm(ks[14], (DEPTH, FILTER_ORDER), 0.1),
        'filt_w4': nrm(ks[15], (DEPTH, FILTER_ORDER, HY_ORDER * 2 * D_HY), FILTER_ORDER ** -0.5),
        'filt_freq': 1.0 + nrm(ks[16], (DEPTH, 3, FILTER_ORDER), 0.01),
        'hy_skip': nrm(ks[17], (DEPTH, HY_ORDER, D_HY), 0.5),
        'na_rpb': nrm(ks[18], (DEPTH, NA_HEADS, 2 * NA_KH - 1, 2 * NA_KW - 1), 0.02),
        'hy_norm_g': 1.0 + nrm(ks[19], (DEPTH, D_HY), 0.01),
        'na_norm_g': 1.0 + nrm(ks[20], (DEPTH, D_NA), 0.01),
        'w_out': nrm(ks[21], (DEPTH, D_MODEL, D_MODEL), D_MODEL ** -0.5 * BETA),
        'ln1_g': 1.0 + nrm(ks[22], (DEPTH, D_MODEL), 0.01),
        'ln1_b': nrm(ks[23], (DEPTH, D_MODEL), 0.01),
        'peer_wq': nrm(ks[24], (DEPTH, D_MODEL, PEER_HEADS * PEER_DKEY), D_MODEL ** -0.5),
        'peer_keys': nrm(ks[25], (DEPTH, PEER_HEADS, 2, PEER_NKEYS, PEER_DKEY // 2), (PEER_DKEY // 2) ** -0.5),
        'peer_u': nrm(ks[26], (DEPTH, PEER_EXPERTS, D_MODEL), D_MODEL ** -0.5 * BETA),
        'peer_v': nrm(ks[27], (DEPTH, PEER_EXPERTS, D_MODEL), BETA),
        'ln2_g': 1.0 + nrm(ks[28], (DEPTH, D_MODEL), 0.01),
        'ln2_b': nrm(ks[29], (DEPTH, D_MODEL), 0.01),
    }


def reference(x, c, ctx, c_ctx, w_ada, b_ada, w_in, conv_w, conv_b, filt_w1, filt_b1, filt_w2, filt_b2,
              filt_w3, filt_b3, filt_w4, filt_freq, hy_skip, na_rpb, hy_norm_g, na_norm_g, w_out,
              ln1_g, ln1_b, peer_wq, peer_keys, peer_u, peer_v, ln2_g, ln2_b):
    B, L, _ = x.shape
    C = ctx.shape[1]
    for l in range(DEPTH):
        m = ada_params(c, w_ada[l], b_ada[l])
        mc = ada_params(c_ctx[None], w_ada[l], b_ada[l])
        filt = (filt_w1[l], filt_b1[l], filt_w2[l], filt_b2[l], filt_w3[l], filt_b3[l], filt_w4[l], filt_freq[l])

        u = modulate(x, m[:, 0], m[:, 1])
        uc = modulate(ctx, mc[:, 0], mc[:, 1])
        proj = u @ w_in[l]
        kv_c = uc @ w_in[l][:, OFF_K:]
        k_c = kv_c[..., :D_NA].reshape(B, C, NA_HEADS, HEAD_DIM)
        v_c = kv_c[..., D_NA:].reshape(B, C, NA_HEADS, HEAD_DIM)
        hy_out = hyena(proj[..., :OFF_Q], hyena_filters(L, *filt), hy_skip[l], conv_w[l], conv_b[l])
        q = proj[..., OFF_Q:OFF_K].reshape(B, L, NA_HEADS, HEAD_DIM)
        k = proj[..., OFF_K:OFF_V].reshape(B, L, NA_HEADS, HEAD_DIM)
        v = proj[..., OFF_V:].reshape(B, L, NA_HEADS, HEAD_DIM)
        na_out = neighbourhood_attention(q, k, v, k_c, v_c, na_rpb[l])
        y = merge_groups(hy_out, na_out, hy_norm_g[l], na_norm_g[l], w_out[l])
        x_new = layer_norm(ALPHA * x + m[:, 2] * y, ln1_g[l], ln1_b[l])

        f = peer(modulate(x_new, m[:, 3], m[:, 4]), peer_wq[l], peer_keys[l], peer_u[l], peer_v[l])
        x_new = layer_norm(ALPHA * x_new + m[:, 5] * f, ln2_g[l], ln2_b[l])

        if l < DEPTH - 1:
            proj_c = uc @ w_in[l][:, :OFF_K]
            hy_c = hyena(proj_c[..., :OFF_Q], hyena_filters(C, *filt), hy_skip[l], conv_w[l], conv_b[l])
            q_c = proj_c[..., OFF_Q:].reshape(B, C, NA_HEADS, HEAD_DIM)
            att_c = context_attention(q_c, k_c, v_c)
            y_c = merge_groups(hy_c, att_c, hy_norm_g[l], na_norm_g[l], w_out[l])
            ctx = layer_norm(ALPHA * ctx + mc[:, 2] * y_c, ln1_g[l], ln1_b[l])
            f_c = peer(modulate(ctx, mc[:, 3], mc[:, 4]), peer_wq[l], peer_keys[l], peer_u[l], peer_v[l])
            ctx = layer_norm(ALPHA * ctx + mc[:, 5] * f_c, ln2_g[l], ln2_b[l])
        x = x_new
    return x
```

```cpp
#include <hip/hip_runtime.h>
#include <hip/hip_cooperative_groups.h>
#include <cstdio>
namespace cg = cooperative_groups;

constexpr int D = 2048, NB = 4, SL = 2048, NT = NB * SL, CL = 256, NTC = NB * CL;
constexpr int DHY = 1024, DNA = 1024, DPROJ = 6144, OFFQ = 3072, OFFK = 4096, OFFV = 5120;
constexpr int NTHREADS = 512, NWAVES = 8;
constexpr float LN_EPS = 1e-5f;
constexpr float ALPHA = 1.189207115002721f;

enum { I_X = 0, I_C, I_CTX, I_CCTX, I_WADA, I_BADA, I_WIN, I_CONVW, I_CONVB, I_FW1, I_FB1, I_FW2, I_FB2, I_FW3, I_FB3, I_FW4,
       I_FREQ, I_SKIP, I_RPB, I_GHY, I_GNA, I_WOUT, I_LN1G, I_LN1B, I_WQ, I_KEYS, I_PU, I_PV, I_LN2G, I_LN2B, N_IN };

constexpr size_t W_ADAP = 0;
constexpr size_t W_ADA  = W_ADAP + 16 * 5 * 12288;
constexpr size_t W_FS   = W_ADA + 5 * 12288;
constexpr size_t W_IDX  = W_FS + 2048;
constexpr size_t W_G    = W_IDX + (size_t)NT * 128;
constexpr size_t W_BIG  = 4194304;
constexpr size_t W_U    = W_BIG;
constexpr size_t W_UC   = W_U + (size_t)NT * D;
constexpr size_t W_KVC  = W_UC + (size_t)NTC * D;
constexpr size_t W_PROJ = W_KVC + (size_t)NTC * D;
constexpr size_t W_KF   = W_PROJ + (size_t)NT * DPROJ;
constexpr size_t W_CAT  = W_KF + (size_t)2 * 1024 * 4096;
constexpr size_t W_X1   = W_CAT + (size_t)NT * D;
constexpr size_t W_END  = W_X1 + (size_t)NT * D;
static_assert(W_G + (size_t)NT * 128 <= W_BIG, "small region overflow");

constexpr int LDS_BYTES = 132 * 1024;
constexpr int RED_OFF = 131072;

struct Params { const float* in[N_IN]; float* out; float* ws; };

__device__ __forceinline__ float wave_sum(float v) {
#pragma unroll
    for (int o = 32; o; o >>= 1) v += __shfl_xor(v, o);
    return v;
}
__device__ __forceinline__ float block_sum(float v, float* red) {
    v = wave_sum(v);
    __syncthreads();
    if ((threadIdx.x & 63) == 0) red[threadIdx.x >> 6] = v;
    __syncthreads();
    float s = 0.f;
#pragma unroll
    for (int i = 0; i < NWAVES; ++i) s += red[i];
    return s;
}
__device__ __forceinline__ int opaque_tid() { int t = threadIdx.x; asm volatile("" : "+v"(t)); return t; }
__device__ __forceinline__ float silu(float x) { return x / (1.0f + expf(-x)); }

__device__ __forceinline__ void naive_gemm(const float* __restrict__ A, int lda, const float* __restrict__ Bm, int ldb,
                                           float* __restrict__ C, int ldc, int M, int N, int K, float* lds) {
    float* As = lds;
    float* Bs = lds + 16 * 132;
    const int tid = opaque_tid(), tx = tid & 31, ty = tid >> 5;
    const int tilesN = N / 128, ntiles = (M / 128) * tilesN;
    for (int tile = blockIdx.x; tile < ntiles; tile += gridDim.x) {
        const int m0 = (tile / tilesN) * 128, n0 = (tile % tilesN) * 128;
        float acc[8][4];
#pragma unroll
        for (int i = 0; i < 8; ++i)
#pragma unroll
            for (int j = 0; j < 4; ++j) acc[i][j] = 0.f;
        for (int k0 = 0; k0 < K; k0 += 16) {
            {
                const int row = tid >> 2, kq = (tid & 3) * 4;
                const float4 a = *(const float4*)(A + (size_t)(m0 + row) * lda + k0 + kq);
                As[(kq + 0) * 132 + row] = a.x; As[(kq + 1) * 132 + row] = a.y; As[(kq + 2) * 132 + row] = a.z; As[(kq + 3) * 132 + row] = a.w;
                const int kk = tid >> 5, n4 = (tid & 31) * 4;
                *(float4*)(Bs + kk * 128 + n4) = *(const float4*)(Bm + (size_t)(k0 + kk) * ldb + n0 + n4);
            }
            __syncthreads();
#pragma unroll 4
            for (int k = 0; k < 16; ++k) {
                const float4 a0 = *(const float4*)(As + k * 132 + ty * 8), a1 = *(const float4*)(As + k * 132 + ty * 8 + 4);
                const float4 b = *(const float4*)(Bs + k * 128 + tx * 4);
                const float av[8] = {a0.x, a0.y, a0.z, a0.w, a1.x, a1.y, a1.z, a1.w};
                const float bv[4] = {b.x, b.y, b.z, b.w};
#pragma unroll
                for (int i = 0; i < 8; ++i)
#pragma unroll
                    for (int j = 0; j < 4; ++j) acc[i][j] += av[i] * bv[j];
            }
            __syncthreads();
        }
#pragma unroll
        for (int i = 0; i < 8; ++i)
            *(float4*)(C + (size_t)(m0 + ty * 8 + i) * ldc + n0 + tx * 4) = make_float4(acc[i][0], acc[i][1], acc[i][2], acc[i][3]);
    }
}

__device__ __forceinline__ void phase_a(const Params& p, float* lds) {
    const int tid = opaque_tid();
    const float* c = p.in[I_C]; const float* cctx = p.in[I_CCTX]; const float* wada = p.in[I_WADA];
    float* part = p.ws + W_ADAP;
    for (int item = blockIdx.x; item < 16 * 24; item += gridDim.x) {
        const int ks = item / 24, j = (item % 24) * 512 + tid;
        __syncthreads();
        for (int e = tid; e < 5 * 128; e += NTHREADS) { const int n = e >> 7, k = ks * 128 + (e & 127); lds[e] = silu(n < 4 ? c[n * 2048 + k] : cctx[k]); }
        __syncthreads();
        float a0 = 0.f, a1 = 0.f, a2 = 0.f, a3 = 0.f, a4 = 0.f;
#pragma unroll 8
        for (int kk = 0; kk < 128; ++kk) {
            const float w = wada[(size_t)(ks * 128 + kk) * 12288 + j];
            a0 += lds[kk] * w; a1 += lds[128 + kk] * w; a2 += lds[256 + kk] * w; a3 += lds[384 + kk] * w; a4 += lds[512 + kk] * w;
        }
        part[(size_t)(ks * 5 + 0) * 12288 + j] = a0; part[(size_t)(ks * 5 + 1) * 12288 + j] = a1; part[(size_t)(ks * 5 + 2) * 12288 + j] = a2;
        part[(size_t)(ks * 5 + 3) * 12288 + j] = a3; part[(size_t)(ks * 5 + 4) * 12288 + j] = a4;
    }
    const float* w1 = p.in[I_FW1]; const float* b1 = p.in[I_FB1]; const float* w2 = p.in[I_FW2]; const float* b2 = p.in[I_FB2];
    const float* w3 = p.in[I_FW3]; const float* b3 = p.in[I_FB3]; const float* w4 = p.in[I_FW4]; const float* freq = p.in[I_FREQ];
    float* hraw = p.ws + W_X1;
    float* z = lds; float* h1 = lds + 64; float* h2 = lds + 128; float* h3 = lds + 192;
    for (int i = blockIdx.x; i < SL; i += gridDim.x) {
        const float t = (float)i / 2047.0f, w = 6.283185307179586f * (float)i / 2048.0f;
        __syncthreads();
        if (tid < 33) {
            float v;
            if (tid == 0) v = t;
            else if (tid <= 16) { const float f = 1e-4f + (float)(tid - 1) * ((15.0f - 1e-4f) / 15.0f); v = cosf(f * w); }
            else { const float f = 1e-4f + (float)(tid - 17) * ((15.0f - 1e-4f) / 15.0f); v = -sinf(f * w); }
            z[tid] = v;
        }
        __syncthreads();
        if (tid < 64) { float a = b1[tid];
#pragma unroll 4
            for (int m = 0; m < 33; ++m) a += z[m] * w1[m * 64 + tid]; h1[tid] = sinf(freq[tid] * a); }
        __syncthreads();
        if (tid < 64) { float a = b2[tid];
#pragma unroll 4
            for (int m = 0; m < 64; ++m) a += h1[m] * w2[m * 64 + tid]; h2[tid] = sinf(freq[64 + tid] * a); }
        __syncthreads();
        if (tid < 64) { float a = b3[tid];
#pragma unroll 4
            for (int m = 0; m < 64; ++m) a += h2[m] * w3[m * 64 + tid]; h3[tid] = sinf(freq[128 + tid] * a); }
        __syncthreads();
#pragma unroll 1
        for (int jj = 0; jj < 8; ++jj) {
            const int j = jj * 512 + tid;
            float a = 0.f;
#pragma unroll 8
            for (int m = 0; m < 64; ++m) a += h3[m] * w4[m * 4096 + j];
            const int ch = j & 1023;
            const float delta = 3.070113457f + (float)ch * ((15.35056729f - 3.070113457f) / 1023.0f);
            hraw[(size_t)i * 4096 + j] = a * expf(-t * delta);
        }
    }
}

__device__ __forceinline__ void phase_b(const Params& p, float* lds) {
    const int tid = opaque_tid();
    const float* part = p.ws + W_ADAP; float* ada = p.ws + W_ADA; const float* bada = p.in[I_BADA];
    for (int e = blockIdx.x * NTHREADS + tid; e < 5 * 12288; e += gridDim.x * NTHREADS) {
        const int j = e % 12288;
        float s = bada[j];
        for (int ks = 0; ks < 16; ++ks) s += part[(size_t)ks * 5 * 12288 + e];
        ada[e] = s;
    }
    const float* hraw = p.ws + W_X1; float* fs = p.ws + W_FS;
    for (int item = blockIdx.x; item < 32; item += gridDim.x) {
        const int o = item / 16, cgp = item % 16, cl = tid & 63, sl = tid >> 6;
        const int c = cgp * 64 + cl;
        float s = 0.f;
        for (int i = sl; i < SL; i += 8) s += fabsf(hraw[(size_t)i * 4096 + o * 2048 + c]) + fabsf(hraw[(size_t)i * 4096 + o * 2048 + 1024 + c]);
        __syncthreads();
        lds[sl * 64 + cl] = s;
        __syncthreads();
        if (tid < 64) { float tot = 0.f; for (int q = 0; q < 8; ++q) tot += lds[q * 64 + tid]; fs[o * 1024 + c] = tot; }
    }
}

__device__ __forceinline__ void phase_c(const Params& p) {
    const int tid = opaque_tid();
    const float* ada = p.ws + W_ADA;
    const float* x = p.in[I_X]; float* u = p.ws + W_U;
    for (size_t e = (size_t)blockIdx.x * NTHREADS + tid; e < (size_t)NT * D / 4; e += (size_t)gridDim.x * NTHREADS) {
        const size_t row = e / (D / 4); const int col = (int)(e % (D / 4)) * 4; const int b = (int)(row / SL);
        const float4 xv = *(const float4*)(x + row * D + col);
        const float4 sh = *(const float4*)(ada + b * 12288 + col), sc = *(const float4*)(ada + b * 12288 + 2048 + col);
        *(float4*)(u + row * D + col) = make_float4(xv.x * (1.f + sc.x) + sh.x, xv.y * (1.f + sc.y) + sh.y, xv.z * (1.f + sc.z) + sh.z, xv.w * (1.f + sc.w) + sh.w);
    }
    const float* ctx = p.in[I_CTX]; float* uc = p.ws + W_UC;
    for (size_t e = (size_t)blockIdx.x * NTHREADS + tid; e < (size_t)NTC * D / 4; e += (size_t)gridDim.x * NTHREADS) {
        const size_t row = e / (D / 4); const int col = (int)(e % (D / 4)) * 4;
        const float4 xv = *(const float4*)(ctx + row * D + col);
        const float4 sh = *(const float4*)(ada + 4 * 12288 + col), sc = *(const float4*)(ada + 4 * 12288 + 2048 + col);
        *(float4*)(uc + row * D + col) = make_float4(xv.x * (1.f + sc.x) + sh.x, xv.y * (1.f + sc.y) + sh.y, xv.z * (1.f + sc.z) + sh.z, xv.w * (1.f + sc.w) + sh.w);
    }
    const float* hraw = p.ws + W_X1; const float* fs = p.ws + W_FS; float* kf = p.ws + W_KF;
    for (size_t e = (size_t)blockIdx.x * NTHREADS + tid; e < (size_t)2 * 1024 * 4096; e += (size_t)gridDim.x * NTHREADS) {
        const int idx = (int)(e & 4095); const int oc = (int)(e >> 12); const int o = oc >> 10, c = oc & 1023;
        float v = 0.f;
        if (idx < 4095) {
            const int d = idx - 2047;
            const float inv = 1.0f / fs[oc];
            v = (d >= 0 ? hraw[(size_t)d * 4096 + o * 2048 + c] : hraw[(size_t)(-d) * 4096 + o * 2048 + 1024 + c]) * inv;
        }
        kf[e] = v;
    }
}

__device__ __forceinline__ void phase_hyena(const Params& p, float* lds) {
    const int tid = opaque_tid();
    const float* proj = p.ws + W_PROJ; const float* kf = p.ws + W_KF; float* cat = p.ws + W_CAT;
    const float* cw = p.in[I_CONVW]; const float* cb = p.in[I_CONVB]; const float* skip = p.in[I_SKIP];
    float* K0 = lds; float* K1 = lds + 4096; float* vs = lds + 8192; float* x1s = lds + 10240; float* x2s = lds + 12288; float* ys = lds + 14336;
    for (int item = blockIdx.x; item < NB * DHY; item += gridDim.x) {
        const int b = item / DHY, c = item % DHY;
        __syncthreads();
        for (int i = tid; i < 4096; i += NTHREADS) { K0[i] = kf[(size_t)c * 4096 + i]; K1[i] = kf[(size_t)(1024 + c) * 4096 + i]; }
        for (int e = tid; e < 3 * SL; e += NTHREADS) {
            const int g = e / SL, t = e % SL, ch = g * 1024 + c;
            const float* zp = proj + (size_t)(b * SL + t) * DPROJ + ch;
            const float zm = t > 0 ? zp[-DPROJ] : 0.f, z0 = zp[0], zq = t < SL - 1 ? zp[DPROJ] : 0.f;
            const float v = zm * cw[ch] + z0 * cw[3072 + ch] + zq * cw[6144 + ch] + cb[ch];
            (g == 0 ? vs : (g == 1 ? x1s : x2s))[t] = v;
        }
        __syncthreads();
        const int t0 = tid * 4;
#pragma unroll 1
        for (int ord = 0; ord < 2; ++ord) {
            const float* Kp = ord == 0 ? K0 : K1; const float* src = ord == 0 ? vs : ys;
            float a0 = 0.f, a1 = 0.f, a2 = 0.f, a3 = 0.f;
            for (int s0 = 0; s0 < SL; s0 += 4) {
                const int base = t0 - s0 + 2047;
                const float4 ka = *(const float4*)(Kp + base - 3), kb = *(const float4*)(Kp + base + 1);
                const float4 sv = *(const float4*)(src + s0);
                const float kk[8] = {ka.x, ka.y, ka.z, ka.w, kb.x, kb.y, kb.z, kb.w};
                const float sa[4] = {sv.x, sv.y, sv.z, sv.w};
#pragma unroll
                for (int ds = 0; ds < 4; ++ds) { a0 += kk[3 - ds] * sa[ds]; a1 += kk[4 - ds] * sa[ds]; a2 += kk[5 - ds] * sa[ds]; a3 += kk[6 - ds] * sa[ds]; }
            }
            const float sk = skip[ord * 1024 + c];
            const float4 sv = *(const float4*)(src + t0);
            const float4 gt = *(const float4*)((ord == 0 ? x1s : x2s) + t0);
            const float r0 = gt.x * (a0 + sv.x * sk), r1 = gt.y * (a1 + sv.y * sk), r2 = gt.z * (a2 + sv.z * sk), r3 = gt.w * (a3 + sv.w * sk);
            if (ord == 0) { *(float4*)(ys + t0) = make_float4(r0, r1, r2, r3); __syncthreads(); }
            else {
                float* op = cat + (size_t)(b * SL + t0) * D + c;
                op[0] = r0; op[D] = r1; op[2 * D] = r2; op[3 * D] = r3;
            }
        }
    }
}

__device__ __forceinline__ void phase_na(const Params& p) {
    const int tid = opaque_tid(), xq = tid >> 3, sub = tid & 7;
    const float* proj = p.ws + W_PROJ; const float* kvc = p.ws + W_KVC; const float* rpb = p.in[I_RPB]; float* cat = p.ws + W_CAT;
    for (int item = blockIdx.x; item < NB * 16 * 32; item += gridDim.x) {
        const int b = item / 512, h = (item / 32) % 16, r = item % 32;
        const int rs = min(max(r - 4, 0), 24), wsx = min(max(xq - 8, 0), 48);
        float q8[8], o8[8];
        {
            const float* qp = proj + (size_t)(b * SL + r * 64 + xq) * DPROJ + OFFQ + h * 64 + sub * 8;
            const float4 v0 = *(const float4*)qp, v1 = *(const float4*)(qp + 4);
            q8[0] = v0.x * 0.125f; q8[1] = v0.y * 0.125f; q8[2] = v0.z * 0.125f; q8[3] = v0.w * 0.125f;
            q8[4] = v1.x * 0.125f; q8[5] = v1.y * 0.125f; q8[6] = v1.z * 0.125f; q8[7] = v1.w * 0.125f;
        }
#pragma unroll
        for (int i = 0; i < 8; ++i) o8[i] = 0.f;
        float m = -1e30f, l = 0.f;
#pragma unroll 2
        for (int j = 0; j < 384; ++j) {
            const float* kp; float bias = 0.f;
            if (j < 128) {
                const int kr = rs + (j >> 4), kc = wsx + (j & 15);
                kp = proj + (size_t)(b * SL + kr * 64 + kc) * DPROJ + OFFK + h * 64 + sub * 8;
                bias = rpb[h * 465 + (kr - r + 7) * 31 + (kc - xq + 15)];
            } else {
                kp = kvc + (size_t)(b * CL + (j - 128)) * D + h * 64 + sub * 8;
            }
            const float4 k0 = *(const float4*)kp, k1 = *(const float4*)(kp + 4);
            const float4 v0 = *(const float4*)(kp + 1024), v1 = *(const float4*)(kp + 1028);
            float s = q8[0] * k0.x + q8[1] * k0.y + q8[2] * k0.z + q8[3] * k0.w + q8[4] * k1.x + q8[5] * k1.y + q8[6] * k1.z + q8[7] * k1.w;
            s += __shfl_xor(s, 1); s += __shfl_xor(s, 2); s += __shfl_xor(s, 4);
            s += bias;
            const float mn = fmaxf(m, s), corr = expf(m - mn), pe = expf(s - mn);
            l = l * corr + pe; m = mn;
            o8[0] = o8[0] * corr + pe * v0.x; o8[1] = o8[1] * corr + pe * v0.y; o8[2] = o8[2] * corr + pe * v0.z; o8[3] = o8[3] * corr + pe * v0.w;
            o8[4] = o8[4] * corr + pe * v1.x; o8[5] = o8[5] * corr + pe * v1.y; o8[6] = o8[6] * corr + pe * v1.z; o8[7] = o8[7] * corr + pe * v1.w;
        }
        const float inv = 1.0f / l;
        float* op = cat + (size_t)(b * SL + r * 64 + xq) * D + DHY + h * 64 + sub * 8;
        *(float4*)op = make_float4(o8[0] * inv, o8[1] * inv, o8[2] * inv, o8[3] * inv);
        *(float4*)(op + 4) = make_float4(o8[4] * inv, o8[5] * inv, o8[6] * inv, o8[7] * inv);
    }
}

__device__ __forceinline__ void phase_f(const Params& p, float* red) {
    const int tid = opaque_tid();
    float* cat = p.ws + W_CAT; const float* ghy = p.in[I_GHY]; const float* gna = p.in[I_GNA];
    for (int t = blockIdx.x; t < NT; t += gridDim.x) {
        float* row = cat + (size_t)t * D;
        const float2 hv = *(const float2*)(row + tid * 2), nv = *(const float2*)(row + DHY + tid * 2);
        const float sh = block_sum(hv.x * hv.x + hv.y * hv.y, red);
        const float sn = block_sum(nv.x * nv.x + nv.y * nv.y, red);
        const float rh = rsqrtf(sh * (1.0f / 1024.0f) + LN_EPS), rn = rsqrtf(sn * (1.0f / 1024.0f) + LN_EPS);
        *(float2*)(row + tid * 2) = make_float2(hv.x * rh * ghy[tid * 2], hv.y * rh * ghy[tid * 2 + 1]);
        *(float2*)(row + DHY + tid * 2) = make_float2(nv.x * rn * gna[tid * 2], nv.y * rn * gna[tid * 2 + 1]);
    }
}

__device__ __forceinline__ void phase_h(const Params& p, float* red) {
    const int tid = opaque_tid();
    const float* x = p.in[I_X]; const float* y = p.ws + W_PROJ; const float* ada = p.ws + W_ADA;
    const float* g = p.in[I_LN1G]; const float* be = p.in[I_LN1B];
    float* x1 = p.ws + W_X1; float* u2 = p.ws + W_U;
    for (int t = blockIdx.x; t < NT; t += gridDim.x) {
        const int b = t / SL, col = tid * 4;
        const float4 xv = *(const float4*)(x + (size_t)t * D + col), yv = *(const float4*)(y + (size_t)t * D + col);
        const float4 gt = *(const float4*)(ada + b * 12288 + 2 * 2048 + col);
        float v[4] = {ALPHA * xv.x + gt.x * yv.x, ALPHA * xv.y + gt.y * yv.y, ALPHA * xv.z + gt.z * yv.z, ALPHA * xv.w + gt.w * yv.w};
        const float mean = block_sum(v[0] + v[1] + v[2] + v[3], red) * (1.0f / 2048.0f);
        float d[4] = {v[0] - mean, v[1] - mean, v[2] - mean, v[3] - mean};
        const float var = block_sum(d[0] * d[0] + d[1] * d[1] + d[2] * d[2] + d[3] * d[3], red) * (1.0f / 2048.0f);
        const float rstd = rsqrtf(var + LN_EPS);
        const float4 gv = *(const float4*)(g + col), bv = *(const float4*)(be + col);
        const float4 o = make_float4(d[0] * rstd * gv.x + bv.x, d[1] * rstd * gv.y + bv.y, d[2] * rstd * gv.z + bv.z, d[3] * rstd * gv.w + bv.w);
        *(float4*)(x1 + (size_t)t * D + col) = o;
        const float4 sh = *(const float4*)(ada + b * 12288 + 3 * 2048 + col), sc = *(const float4*)(ada + b * 12288 + 4 * 2048 + col);
        *(float4*)(u2 + (size_t)t * D + col) = make_float4(o.x * (1.f + sc.x) + sh.x, o.y * (1.f + sc.y) + sh.y, o.z * (1.f + sc.z) + sh.z, o.w * (1.f + sc.w) + sh.w);
    }
}

__device__ __forceinline__ void wave_argmax(float& v, int& i) {
#pragma unroll
    for (int o = 32; o; o >>= 1) {
        const float ov = __shfl_xor(v, o); const int oi = __shfl_xor(i, o);
        if (ov > v || (ov == v && oi < i)) { v = ov; i = oi; }
    }
}
__device__ __forceinline__ void phase_j(const Params& p, float* lds) {
    const int tid = opaque_tid(), lane = tid & 63, wv = tid >> 6;
    const float* qg = p.ws + W_PROJ; const float* keys = p.in[I_KEYS];
    int* idxo = (int*)(p.ws + W_IDX); float* go = p.ws + W_G;
    float* qs = lds; float* sc = lds + 8 * 2048;
    for (int item = blockIdx.x; item < NT / 8; item += gridDim.x) {
        const int tk0 = item * 8;
        __syncthreads();
        for (int e = tid; e < 8 * 2048 / 4; e += NTHREADS) *(float4*)(qs + e * 4) = *(const float4*)(qg + (size_t)tk0 * D + e * 4);
        __syncthreads();
#pragma unroll 1
        for (int ci = 0; ci < 4; ++ci) {
            const int combo = ci * 512 + tid, qoff = (combo >> 7) * 128;
            const float* kp = keys + (size_t)combo * 128;
            float a[8];
#pragma unroll
            for (int t = 0; t < 8; ++t) a[t] = 0.f;
            for (int d4 = 0; d4 < 32; ++d4) {
                const float4 kv = *(const float4*)(kp + d4 * 4);
#pragma unroll
                for (int t = 0; t < 8; ++t) { const float4 qv = *(const float4*)(qs + t * 2048 + qoff + d4 * 4); a[t] += kv.x * qv.x + kv.y * qv.y + kv.z * qv.z + kv.w * qv.w; }
            }
#pragma unroll
            for (int t = 0; t < 8; ++t) sc[t * 2048 + combo] = a[t];
        }
        __syncthreads();
        const float* st = sc + wv * 2048;
#pragma unroll 1
        for (int h = 0; h < 8; ++h) {
            float sa_l = 0.f, sb_l = 0.f; int ia_l = 0, ib_l = 0;
#pragma unroll 1
            for (int pp = 0; pp < 2; ++pp) {
                float a0 = st[(h * 2 + pp) * 128 + lane], a1 = st[(h * 2 + pp) * 128 + 64 + lane];
#pragma unroll 1
                for (int r = 0; r < 16; ++r) {
                    float v; int i;
                    if (a0 >= a1) { v = a0; i = lane; } else { v = a1; i = lane + 64; }
                    wave_argmax(v, i);
                    if (lane == r) { if (pp == 0) { sa_l = v; ia_l = i; } else { sb_l = v; ib_l = i; } }
                    if (i == lane) a0 = -3.0e38f;
                    if (i == lane + 64) a1 = -3.0e38f;
                }
            }
            float cs[4];
#pragma unroll
            for (int j = 0; j < 4; ++j) { const int ci = lane + 64 * j; cs[j] = __shfl(sa_l, ci >> 4) + __shfl(sb_l, ci & 15); }
            float top_l = 0.f; int e_l = 0;
#pragma unroll 1
            for (int r = 0; r < 16; ++r) {
                float v = cs[0]; int i = lane;
#pragma unroll
                for (int j = 1; j < 4; ++j) if (cs[j] > v) { v = cs[j]; i = lane + 64 * j; }
                wave_argmax(v, i);
                const int ea = __shfl(ia_l, i >> 4), eb = __shfl(ib_l, i & 15);
                if (lane == r) { top_l = v; e_l = ea * 128 + eb; }
#pragma unroll
                for (int j = 0; j < 4; ++j) if (i == lane + 64 * j) cs[j] = -3.0e38f;
            }
            const float mx = __shfl(top_l, 0);
            const float ex = lane < 16 ? expf(top_l - mx) : 0.f;
            const float sum = wave_sum(ex);
            if (lane < 16) { idxo[(size_t)(tk0 + wv) * 128 + h * 16 + lane] = e_l; go[(size_t)(tk0 + wv) * 128 + h * 16 + lane] = ex / sum; }
        }
    }
}

__device__ __forceinline__ void phase_k(const Params& p, float* lds, float* red) {
    const int tid = opaque_tid(), lane = tid & 63, wv = tid >> 6;
    const float* u2 = p.ws + W_U; const float* x1 = p.ws + W_X1; const float* ada = p.ws + W_ADA;
    const int* idx = (const int*)(p.ws + W_IDX); const float* gg = p.ws + W_G;
    const float* pu = p.in[I_PU]; const float* pv = p.in[I_PV]; const float* g2 = p.in[I_LN2G]; const float* b2 = p.in[I_LN2B];
    for (int t = blockIdx.x; t < NT; t += gridDim.x) {
        const int b = t / SL;
        float4 uu[8], fa[8];
#pragma unroll
        for (int j = 0; j < 8; ++j) { uu[j] = *(const float4*)(u2 + (size_t)t * D + j * 256 + lane * 4); fa[j] = make_float4(0.f, 0.f, 0.f, 0.f); }
#pragma unroll 1
        for (int k = 0; k < 16; ++k) {
            const int e = idx[(size_t)t * 128 + wv * 16 + k]; const float gk = gg[(size_t)t * 128 + wv * 16 + k];
            const float* ur = pu + (size_t)e * D; const float* vr = pv + (size_t)e * D;
            float dt = 0.f;
#pragma unroll
            for (int j = 0; j < 8; ++j) { const float4 w = *(const float4*)(ur + j * 256 + lane * 4); dt += uu[j].x * w.x + uu[j].y * w.y + uu[j].z * w.z + uu[j].w * w.w; }
            dt = wave_sum(dt);
            const float act = 0.5f * dt * (1.0f + erff(dt * 0.7071067811865476f));
            const float wg = gk * act;
#pragma unroll
            for (int j = 0; j < 8; ++j) { const float4 w = *(const float4*)(vr + j * 256 + lane * 4); fa[j].x += wg * w.x; fa[j].y += wg * w.y; fa[j].z += wg * w.z; fa[j].w += wg * w.w; }
        }
        __syncthreads();
#pragma unroll
        for (int j = 0; j < 8; ++j) *(float4*)(lds + wv * 2048 + j * 256 + lane * 4) = fa[j];
        __syncthreads();
        const int col = tid * 4;
        float4 f = make_float4(0.f, 0.f, 0.f, 0.f);
#pragma unroll
        for (int w = 0; w < 8; ++w) { const float4 q = *(const float4*)(lds + w * 2048 + col); f.x += q.x; f.y += q.y; f.z += q.z; f.w += q.w; }
        const float4 xv = *(const float4*)(x1 + (size_t)t * D + col);
        const float4 gt = *(const float4*)(ada + b * 12288 + 5 * 2048 + col);
        float v[4] = {ALPHA * xv.x + gt.x * f.x, ALPHA * xv.y + gt.y * f.y, ALPHA * xv.z + gt.z * f.z, ALPHA * xv.w + gt.w * f.w};
        const float mean = block_sum(v[0] + v[1] + v[2] + v[3], red) * (1.0f / 2048.0f);
        float d[4] = {v[0] - mean, v[1] - mean, v[2] - mean, v[3] - mean};
        const float var = block_sum(d[0] * d[0] + d[1] * d[1] + d[2] * d[2] + d[3] * d[3], red) * (1.0f / 2048.0f);
        const float rstd = rsqrtf(var + LN_EPS);
        const float4 gv = *(const float4*)(g2 + col), bv = *(const float4*)(b2 + col);
        *(float4*)(p.out + (size_t)t * D + col) = make_float4(d[0] * rstd * gv.x + bv.x, d[1] * rstd * gv.y + bv.y, d[2] * rstd * gv.z + bv.z, d[3] * rstd * gv.w + bv.w);
    }
}

__global__ void __launch_bounds__(NTHREADS) fwd_megakernel(Params p) {
    extern __shared__ __attribute__((aligned(16))) unsigned char smem[];
    float* lds = (float*)smem; float* red = (float*)(smem + RED_OFF);
    cg::grid_group grid = cg::this_grid();
    phase_a(p, lds);
    grid.sync();
    phase_b(p, lds);
    grid.sync();
    phase_c(p);
    grid.sync();
    naive_gemm(p.ws + W_U, D, p.in[I_WIN], DPROJ, p.ws + W_PROJ, DPROJ, NT, DPROJ, D, lds);
    naive_gemm(p.ws + W_UC, D, p.in[I_WIN] + OFFK, DPROJ, p.ws + W_KVC, D, NTC, 2 * DNA, D, lds);
    grid.sync();
    phase_hyena(p, lds);
    phase_na(p);
    grid.sync();
    phase_f(p, red);
    grid.sync();
    naive_gemm(p.ws + W_CAT, D, p.in[I_WOUT], D, p.ws + W_PROJ, D, NT, D, D, lds);
    grid.sync();
    phase_h(p, red);
    grid.sync();
    naive_gemm(p.ws + W_U, D, p.in[I_WQ], D, p.ws + W_PROJ, D, NT, D, D, lds);
    grid.sync();
    phase_j(p, lds);
    grid.sync();
    phase_k(p, lds, red);
}

extern "C" void kernel_launch(void* const* d_in, const int* in_sizes, int n_in, void* d_out, int out_size, void* d_ws, size_t ws_size, hipStream_t stream) {
    static int grid_blocks = 0;
    if (grid_blocks == 0) {
        if (n_in != N_IN || out_size != NT * D || ws_size < W_END * sizeof(float)) {
            fprintf(stderr, "kernel_launch: unexpected shapes: n_in %d out %d ws %zu (need %zu)\n", n_in, out_size, ws_size, (size_t)W_END * 4); grid_blocks = -1; return; }
        int dev = 0, cus = 0, per_cu = 0;
        hipGetDevice(&dev);
        hipDeviceGetAttribute(&cus, hipDeviceAttributeMultiprocessorCount, dev);
        if (hipFuncSetAttribute((const void*)fwd_megakernel, hipFuncAttributeMaxDynamicSharedMemorySize, LDS_BYTES) != hipSuccess) { fprintf(stderr, "kernel_launch: hipFuncSetAttribute failed\n"); grid_blocks = -1; return; }
        if (hipOccupancyMaxActiveBlocksPerMultiprocessor(&per_cu, (const void*)fwd_megakernel, NTHREADS, LDS_BYTES) != hipSuccess || per_cu < 1) { fprintf(stderr, "kernel_launch: occupancy query failed (%d)\n", per_cu); (void)hipGetLastError(); grid_blocks = -1; return; }
        grid_blocks = cus * (per_cu > 1 ? 1 : per_cu);
        fprintf(stderr, "kernel_launch: cus %d per_cu %d grid %d\n", cus, per_cu, grid_blocks);
    }
    if (grid_blocks < 0) return;
    Params p{};
    for (int i = 0; i < N_IN; ++i) p.in[i] = (const float*)d_in[i];
    p.out = (float*)d_out; p.ws = (float*)d_ws;
    void* args[] = {&p};
    hipError_t e = hipLaunchCooperativeKernel((const void*)fwd_megakernel, dim3(grid_blocks), dim3(NTHREADS), args, LDS_BYTES, stream);
    if (e != hipSuccess) fprintf(stderr, "cooperative launch failed: %s (grid %d)\n", hipGetErrorString(e), grid_blocks);
}
```

```cpp
#include <hip/hip_runtime.h>
#include <hip/hip_cooperative_groups.h>
#include <cstdio>
namespace cg = cooperative_groups;

constexpr int D = 2048, NB = 4, SL = 2048, NT = NB * SL, CL = 256, NTC = NB * CL;
constexpr int DHY = 1024, DNA = 1024, DPROJ = 6144, OFFQ = 3072, OFFK = 4096, OFFV = 5120;
constexpr int NTHREADS = 512, NWAVES = 8;
constexpr float LN_EPS = 1e-5f;
constexpr float ALPHA = 1.189207115002721f;

enum { I_X = 0, I_C, I_CTX, I_CCTX, I_WADA, I_BADA, I_WIN, I_CONVW, I_CONVB, I_FW1, I_FB1, I_FW2, I_FB2, I_FW3, I_FB3, I_FW4,
       I_FREQ, I_SKIP, I_RPB, I_GHY, I_GNA, I_WOUT, I_LN1G, I_LN1B, I_WQ, I_KEYS, I_PU, I_PV, I_LN2G, I_LN2B, N_IN };

constexpr size_t W_ADAP = 0;
constexpr size_t W_ADA  = W_ADAP + 32 * 5 * 12288;
constexpr size_t W_FS   = W_ADA + 5 * 12288;
constexpr size_t W_SP   = W_FS + 4096;
constexpr size_t W_SU   = W_SP + 32 * 4096;
constexpr size_t W_SV   = W_SU + 16384;
constexpr size_t W_SU2  = W_SV + 16384;
static_assert((W_SU2 + 8192) * 4 <= 14 * 1048576, "small region overflow");
constexpr size_t MiB = 1048576;
constexpr size_t B_WINT  = 16 * MiB;
constexpr size_t B_WOUTT = B_WINT + 24 * MiB;
constexpr size_t B_WQT   = B_WOUTT + 8 * MiB;
constexpr size_t B_UB    = B_WQT + 8 * MiB;
constexpr size_t B_ZT    = B_UB + 36 * MiB;
constexpr size_t B_VT    = B_ZT + 48 * MiB;
constexpr size_t B_QH    = B_VT + 16 * MiB;
constexpr size_t B_KH    = B_QH + 16 * MiB;
constexpr size_t B_KCH   = B_KH + 16 * MiB;
constexpr size_t B_VCT   = B_KCH + 2 * MiB;
constexpr size_t B_KF    = B_VCT + 2 * MiB;
constexpr size_t B_HRAW  = B_KF + 32 * MiB;
constexpr size_t B_HYT   = B_HRAW;
constexpr size_t B_NA    = B_HRAW + 16 * MiB;
constexpr size_t B_Y     = B_HRAW + 32 * MiB;
constexpr size_t B_X1    = B_Y + 64 * MiB;
constexpr size_t B_U2Q   = B_X1 + 64 * MiB;
constexpr size_t B_TQ    = B_U2Q + 16 * MiB;
constexpr size_t B_END   = B_TQ + 64 * MiB;
constexpr size_t W_KF = B_KF / 4, W_X1 = B_X1 / 4, W_HRAW = B_HRAW / 4, W_Y = B_Y / 4, W_END = B_END / 4;
static_assert(B_END <= 512 * MiB, "workspace");

constexpr int LDS_BYTES = 156 * 1024;
constexpr int RED_OFF = 155 * 1024;

struct Params { const float* in[N_IN]; float* out; float* ws; };

namespace pg8 {
#define PG8_LAS __attribute__((address_space(3)))
typedef unsigned short bf16_t;
typedef short bf16x8 __attribute__((ext_vector_type(8)));
typedef float f32x4 __attribute__((ext_vector_type(4)));
typedef unsigned u32x4 __attribute__((ext_vector_type(4)));
constexpr int BM = 256, BK = 64, HALF = 128, HTB = HALF * BK * 2  , STAGE_BYTES = 8 * HTB, NXCD = 8, WGM = 8;

__host__ __device__ __forceinline__ int lds_byte(int r, int c) { const int st = (r >> 4) * 2 + (c >> 5), rr = r & 15, cc = c & 31, ob = rr * 64 + cc * 2; return st * 1024 + (ob ^ (((ob >> 9) & 1) << 5)); }
__host__ __device__ __forceinline__ void stage_rc(int b, int& R, int& C) { const int st = b / 1024, sb = b % 1024, swz = sb ^ (((sb >> 9) & 1) << 5); R = (st >> 1) * 16 + swz / 64; C = (st & 1) * 32 + (swz % 64) / 2; }
__host__ __device__ __forceinline__ int perm32(int rho) { const int n = rho >> 4, i = rho & 15; return 8 * (i >> 2) + 4 * n + (i & 3); }

struct Unit { int pm, pn, kind; };
struct Gemm { const bf16_t* A; const bf16_t* Bt; int M, N, K; };

struct StaticOrder {
    int nM, nN, nwg, G, c;
    __host__ __device__ void init(int M, int N, int G_, int c_) { nM = M / BM; nN = N / BM; nwg = nM * nN; G = G_; c = c_; }
    __host__ __device__ bool next(int i, Unit& u) const {
        const long L = (long)i * G + c; if (L >= nwg) return false;
        int wgid = (int)L; { const int q = nwg / NXCD, r = nwg % NXCD, xcd = wgid % NXCD, off = wgid / NXCD; wgid = (xcd < r ? xcd * (q + 1) : r * (q + 1) + (xcd - r) * q) + off; }
        const int nig = WGM * nN, gid = wgid / nig, fm = gid * WGM, gsz = (nM - fm) < WGM ? (nM - fm) : WGM;
        u.pm = fm + ((wgid % nig) % gsz); u.pn = (wgid % nig) / gsz; return true;
    }
    __device__ __forceinline__ void a_ready(const Unit&) const {}
    __device__ __forceinline__ void done(const Unit&) const {}
    template <class G_> __device__ __forceinline__ const char* pa(const G_& g, const Unit& u) const { return (const char*)g.A + (size_t)u.pm * (size_t)(BM * 2) * g.K; }
    template <class G_> __device__ __forceinline__ const char* pb(const G_& g, const Unit& u) const { return (const char*)g.Bt + (size_t)u.pn * (size_t)(BM * 2) * g.K; }
};
__device__ __forceinline__ unsigned cvt_pk_bf16(float lo, float hi) { unsigned r; asm volatile("v_cvt_pk_bf16_f32 %0, %1, %2" : "=v"(r) : "v"(lo), "v"(hi)); return r; }
typedef float f32x2 __attribute__((ext_vector_type(2)));
__device__ __forceinline__ f32x2 gelu_pk(f32x2 v) {
    const f32x2 av = __builtin_elementwise_abs(v), d = av * 0.2316418882f + 1.0f;
    f32x2 t; t.x = __builtin_amdgcn_rcpf(d.x); t.y = __builtin_amdgcn_rcpf(d.y);
    f32x2 q = t * 0.5307027145f + (-0.7265760135f); q = q * t + 0.7107068705f; q = q * t + (-0.142248368f); q = q * t + 0.127414796f; q = q * t;
    const f32x2 s = (v * v) * (-0.72134752044f);
    f32x2 e; e.x = __builtin_amdgcn_exp2f(s.x); e.y = __builtin_amdgcn_exp2f(s.y);
    const f32x2 m = v * (q * e), r = v - m;
    f32x2 o; o.x = v.x < 0.f ? m.x : r.x; o.y = v.y < 0.f ? m.y : r.y; return o;
}

struct EpiF32 {
    static constexpr bool PERM = false, AFTER_DRAIN = false;
    float* C; int ldc; const float* bias;
    __device__ __forceinline__ void operator()(const f32x4 (&acc)[2][2][4][2], const Unit& u, int wr, int wc, int fr, int fq) const {
        const int row0 = u.pm * BM + wr * 64 + fr, col0 = u.pn * BM + wc * 32 + 4 * fq;
        f32x4 bv[2][2];
#pragma unroll
        for (int bj = 0; bj < 2; ++bj)
#pragma unroll
            for (int n = 0; n < 2; ++n) bv[bj][n] = bias ? *(const f32x4*)(bias + col0 + bj * HALF + n * 16) : (f32x4){0.f, 0.f, 0.f, 0.f};
#pragma unroll
        for (int ai = 0; ai < 2; ++ai)
#pragma unroll
            for (int m = 0; m < 4; ++m) { float* rowp = C + (size_t)(row0 + ai * HALF + m * 16) * ldc + col0;
#pragma unroll
                for (int bj = 0; bj < 2; ++bj)
#pragma unroll
                    for (int n = 0; n < 2; ++n) *(f32x4*)(rowp + bj * HALF + n * 16) = acc[ai][bj][m][n] + bv[bj][n]; }
    }
};
template <int ACT  > struct EpiBf16 {
    static constexpr bool PERM = true, AFTER_DRAIN = false;
    bf16_t* O; int ldc; const float* bias; int split_cols; size_t split_stride;
    __device__ __forceinline__ void operator()(const f32x4 (&acc)[2][2][4][2], const Unit& u, int wr, int wc, int fr, int fq) const {
        const int row0 = u.pm * BM + wr * 64 + fr; int colt = u.pn * BM; bf16_t* base = O;
        if (split_cols) { const int t = colt / split_cols; base += (size_t)t * split_stride; colt -= t * split_cols; }
        const int col0 = colt + wc * 32 + 8 * fq, bcol0 = u.pn * BM + wc * 32 + 8 * fq;
        f32x4 bv[2][2];
#pragma unroll
        for (int bj = 0; bj < 2; ++bj)
#pragma unroll
            for (int n = 0; n < 2; ++n) bv[bj][n] = bias ? *(const f32x4*)(bias + bcol0 + bj * HALF + 4 * n) : (f32x4){0.f, 0.f, 0.f, 0.f};
#pragma unroll
        for (int ai = 0; ai < 2; ++ai)
#pragma unroll
            for (int m = 0; m < 4; ++m) { bf16_t* rowp = base + (size_t)(row0 + ai * HALF + m * 16) * ldc + col0;
#pragma unroll
                for (int bj = 0; bj < 2; ++bj) { f32x4 v0 = acc[ai][bj][m][0] + bv[bj][0], v1 = acc[ai][bj][m][1] + bv[bj][1];
                    if (ACT == 1) { f32x2 a = gelu_pk((f32x2){v0[0], v0[1]}), b = gelu_pk((f32x2){v0[2], v0[3]}), c = gelu_pk((f32x2){v1[0], v1[1]}), d = gelu_pk((f32x2){v1[2], v1[3]});
                        v0 = (f32x4){a.x, a.y, b.x, b.y}; v1 = (f32x4){c.x, c.y, d.x, d.y}; }
                    if (ACT == 2) {
#pragma unroll
                        for (int j = 0; j < 4; ++j) { v0[j] = 0.5f * v0[j] * (1.0f + erff(v0[j] * 0.70710678f)); v1[j] = 0.5f * v1[j] * (1.0f + erff(v1[j] * 0.70710678f)); } }
                    u32x4 w; w.x = cvt_pk_bf16(v0[0], v0[1]); w.y = cvt_pk_bf16(v0[2], v0[3]); w.z = cvt_pk_bf16(v1[0], v1[1]); w.w = cvt_pk_bf16(v1[2], v1[3]);
                    *(u32x4*)(rowp + bj * HALF) = w; } }
    }
};
template <class Epi, class Sched, bool STAMP = false>
__device__ __forceinline__ void gemm_phase(PG8_LAS unsigned char* lds, const Gemm g, const Sched& S, const Epi& E, unsigned long long* stamps) {
    const int tid = threadIdx.x, wid = __builtin_amdgcn_readfirstlane(tid >> 6), lane = tid & 63, wr = wid >> 2, wc = wid & 3, fr = lane & 15, fq = lane >> 4;
    const int K = g.K, nt = K / BK;
    int ts_lo = 0, ts_hi = 0, nts = 0; const unsigned long long rt_entry = STAMP ? (unsigned long long)wall_clock64() : 0ull;
#define PG8_STAMP() do { if (STAMP && wid == 0 && nts < 64) { const unsigned long long _c = (unsigned long long)clock64(); \
        ts_lo = (lane == nts) ? (int)(unsigned)_c : ts_lo; ts_hi = (lane == nts) ? (int)(unsigned)(_c >> 32) : ts_hi; ++nts; } } while (0)
    PG8_STAMP();
    unsigned voffA[2], voffB[2];
#pragma unroll
    for (int i = 0; i < 2; ++i) { int R, C; stage_rc(tid * 16 + i * 8192, R, C); const int Rb = Epi::PERM ? ((R & ~31) + perm32(R & 31)) : R;
        voffA[i] = (unsigned)(R * K + C) * 2u; voffB[i] = (unsigned)(Rb * K + C) * 2u; }
    const size_t kstep = (size_t)(BK * 2);
    const size_t hstep = (size_t)HALF * K * 2;
    const size_t tstep = 2 * hstep;
    const unsigned ldsw = (unsigned)wid * 1024u;
    const int aoff = lds_byte(wr * 64 + fr, fq * 8), boff = lds_byte(wc * 32 + fr, fq * 8);
#define PG8_SA(b, h) (((b) * 2 + (h)) * HTB)
#define PG8_SB(b, h) ((4 + (b) * 2 + (h)) * HTB)
#define PG8_STAGE(bufoff, gbase, voff) do { _Pragma("unroll") for (int _i = 0; _i < 2; ++_i) \
        __builtin_amdgcn_global_load_lds((const unsigned*)((const char*)(gbase) + (voff)[_i]), (PG8_LAS unsigned*)(lds + (bufoff) + ldsw + _i * 8192), 16, 0, 0); } while (0)
#define PG8_LDA(dst, b, h) do { _Pragma("unroll") for (int m = 0; m < 4; ++m) _Pragma("unroll") for (int k = 0; k < 2; ++k) dst[m][k] = *(const PG8_LAS bf16x8*)(lds + PG8_SA(b, h) + aoff + m * 2048 + k * 1024); } while (0)
#define PG8_LDB(dst, b, h) do { _Pragma("unroll") for (int n = 0; n < 2; ++n) _Pragma("unroll") for (int k = 0; k < 2; ++k) dst[n][k] = *(const PG8_LAS bf16x8*)(lds + PG8_SB(b, h) + boff + n * 2048 + k * 1024); } while (0)
#define PG8_MMA(ai, bj, At, Bt) do { __builtin_amdgcn_s_setprio(1); _Pragma("unroll") for (int m = 0; m < 4; ++m) _Pragma("unroll") for (int n = 0; n < 2; ++n) _Pragma("unroll") for (int k = 0; k < 2; ++k) \
        acc[ai][bj][m][n] = __builtin_amdgcn_mfma_f32_16x16x32_bf16(Bt[n][k], At[m][k], acc[ai][bj][m][n], 0, 0, 0); __builtin_amdgcn_s_setprio(0); } while (0)
#define PG8_WAIT_V(n) asm volatile("s_waitcnt vmcnt(" #n ")" ::: "memory")
#define PG8_WAIT_L(n) asm volatile("s_waitcnt lgkmcnt(" #n ")" ::: "memory")
#define PG8_BAR __builtin_amdgcn_s_barrier()
#define PG8_SCHED __builtin_amdgcn_sched_barrier(0)
    Unit cur, nxt; int ui = 0;
    if (!S.next(0, cur)) return;
    f32x4 acc[2][2][4][2];
#pragma unroll
    for (int a = 0; a < 2; ++a)
#pragma unroll
        for (int b = 0; b < 2; ++b)
#pragma unroll
            for (int m = 0; m < 4; ++m)
#pragma unroll
                for (int n = 0; n < 2; ++n) acc[a][b][m][n] = (f32x4){0.f, 0.f, 0.f, 0.f};
    bf16x8 At[4][2], B0[2][2], B1[2][2];
    const char* cA = S.pa(g, cur); const char* cB = S.pb(g, cur);
    S.a_ready(cur);
    PG8_STAGE(PG8_SB(0, 0), cB, voffB); PG8_STAGE(PG8_SA(0, 0), cA, voffA); PG8_STAGE(PG8_SB(0, 1), cB + hstep, voffB); PG8_STAGE(PG8_SA(0, 1), cA + hstep, voffA);
    if (wr == 1) PG8_BAR;
    PG8_WAIT_V(4); PG8_BAR;
    PG8_STAGE(PG8_SB(1, 0), cB + kstep, voffB); PG8_STAGE(PG8_SA(1, 0), cA + kstep, voffA); PG8_STAGE(PG8_SB(1, 1), cB + hstep + kstep, voffB);
    PG8_WAIT_V(6); PG8_BAR;
    PG8_STAMP();
    for (;;) {
        const bool has_next = S.next(ui + 1, nxt);
        const char* nA = has_next ? S.pa(g, nxt) : cA; const char* nB = has_next ? S.pb(g, nxt) : cB;
        for (int t = 0; t < nt; t += 2) {
            const bool last = (t == nt - 2);
            const char* a1 = cA + (size_t)(t + 1) * kstep;
            const char* a2 = last ? nA : cA + (size_t)(t + 2) * kstep; const char* b2 = last ? nB : cB + (size_t)(t + 2) * kstep;
            const char* a3 = a2 + kstep; const char* b3 = b2 + kstep;
            if (last && has_next) S.a_ready(nxt);
            PG8_LDB(B0, 0, 0); PG8_SCHED; PG8_LDA(At, 0, 0); PG8_STAGE(PG8_SA(1, 1), a1 + hstep, voffA);
            PG8_WAIT_L(8); PG8_BAR; PG8_WAIT_L(0); PG8_MMA(0, 0, At, B0); PG8_BAR; PG8_SCHED;
            PG8_LDB(B1, 0, 1); PG8_STAGE(PG8_SB(0, 0), b2, voffB);
            PG8_BAR; PG8_WAIT_L(0); PG8_MMA(0, 1, At, B1); PG8_BAR;
            PG8_LDA(At, 0, 1); PG8_STAGE(PG8_SA(0, 0), a2, voffA);
            PG8_BAR; PG8_WAIT_L(0); PG8_MMA(1, 0, At, B0); PG8_BAR; PG8_SCHED;
            PG8_STAGE(PG8_SB(0, 1), b2 + hstep, voffB);
            PG8_WAIT_V(6); PG8_BAR; PG8_MMA(1, 1, At, B1); PG8_BAR;
            PG8_LDB(B0, 1, 0); PG8_SCHED; PG8_LDA(At, 1, 0); PG8_STAGE(PG8_SA(0, 1), a2 + hstep, voffA);
            PG8_WAIT_L(8); PG8_BAR; PG8_WAIT_L(0); PG8_MMA(0, 0, At, B0); PG8_BAR; PG8_SCHED;
            PG8_LDB(B1, 1, 1); PG8_STAGE(PG8_SB(1, 0), b3, voffB);
            PG8_BAR; PG8_WAIT_L(0); PG8_MMA(0, 1, At, B1); PG8_BAR;
            PG8_LDA(At, 1, 1); PG8_STAGE(PG8_SA(1, 0), a3, voffA);
            PG8_BAR; PG8_WAIT_L(0); PG8_MMA(1, 0, At, B0); PG8_BAR; PG8_SCHED;
            PG8_STAGE(PG8_SB(1, 1), b3 + hstep, voffB);
            PG8_WAIT_V(6); PG8_BAR; PG8_MMA(1, 1, At, B1); PG8_BAR;
        }
        PG8_STAMP();
        if constexpr (!Epi::AFTER_DRAIN) { E(acc, cur, wr, wc, fr, fq); S.done(cur); }
        PG8_STAMP();
        if (!has_next) break;
#pragma unroll
        for (int a = 0; a < 2; ++a)
#pragma unroll
            for (int b = 0; b < 2; ++b)
#pragma unroll
                for (int m = 0; m < 4; ++m)
#pragma unroll
                    for (int n = 0; n < 2; ++n) acc[a][b][m][n] = (f32x4){0.f, 0.f, 0.f, 0.f};
        cur = nxt; cA = nA; cB = nB; ++ui;
    }
    PG8_WAIT_V(0);
    if (wr == 0) PG8_BAR;
    PG8_BAR;
    if constexpr (Epi::AFTER_DRAIN) { E.fused(acc, cur, wr, wc, fr, fq, lds, wid, lane); S.done(cur); }
    PG8_STAMP();
    if (STAMP && wid == 0) { stamps[lane] = lane < nts ? (((unsigned long long)(unsigned)ts_hi << 32) | (unsigned)ts_lo) : 0ull;
        if (lane == 62) stamps[62] = rt_entry; if (lane == 63) stamps[63] = (unsigned long long)wall_clock64(); }
#undef PG8_STAMP
#undef PG8_SA
#undef PG8_SB
#undef PG8_STAGE
#undef PG8_LDA
#undef PG8_LDB
#undef PG8_MMA
#undef PG8_WAIT_V
#undef PG8_WAIT_L
#undef PG8_BAR
#undef PG8_SCHED
}
}

typedef unsigned short bf16_t;
__device__ __forceinline__ float wave_sum(float v) {
#pragma unroll
    for (int o = 32; o; o >>= 1) v += __shfl_xor(v, o);
    return v;
}
__device__ __forceinline__ float block_sum(float v, float* red) {
    v = wave_sum(v);
    __syncthreads();
    if ((threadIdx.x & 63) == 0) red[threadIdx.x >> 6] = v;
    __syncthreads();
    float s = 0.f;
#pragma unroll
    for (int i = 0; i < NWAVES; ++i) s += red[i];
    return s;
}
__device__ __forceinline__ int opaque_tid() { int t = threadIdx.x; asm volatile("" : "+v"(t)); return t; }
typedef float nt_f32x4 __attribute__((ext_vector_type(4)));
__device__ __forceinline__ float4 nt_load4(const float* p) { const nt_f32x4 v = __builtin_nontemporal_load((const nt_f32x4*)p); return make_float4(v[0], v[1], v[2], v[3]); }
typedef unsigned nt_u32x4 __attribute__((ext_vector_type(4)));
typedef unsigned nt_u32x2 __attribute__((ext_vector_type(2)));
__device__ __forceinline__ uint4 nt_load4u(const void* p) { const nt_u32x4 v = __builtin_nontemporal_load((const nt_u32x4*)p); return make_uint4(v[0], v[1], v[2], v[3]); }
__device__ __forceinline__ uint2 nt_load2u(const void* p) { const nt_u32x2 v = __builtin_nontemporal_load((const nt_u32x2*)p); return make_uint2(v[0], v[1]); }
__device__ __forceinline__ void nt_store4(float* p, float a, float b, float c, float d) { nt_f32x4 v = {a, b, c, d}; __builtin_nontemporal_store(v, (nt_f32x4*)p); }
__device__ __forceinline__ void nt_store4u(void* p, uint4 v) { nt_u32x4 w = {v.x, v.y, v.z, v.w}; __builtin_nontemporal_store(w, (nt_u32x4*)p); }
__device__ __forceinline__ void nt_store2u(void* p, uint2 v) { nt_u32x2 w = {v.x, v.y}; __builtin_nontemporal_store(w, (nt_u32x2*)p); }
__device__ __forceinline__ float silu(float x) { return x / (1.0f + expf(-x)); }


__device__ __forceinline__ unsigned pk_bf16(float lo, float hi) { unsigned r; asm volatile("v_cvt_pk_bf16_f32 %0, %1, %2" : "=v"(r) : "v"(lo), "v"(hi)); return r; }
__device__ __forceinline__ void transpose_convert(const float* __restrict__ W, bf16_t* __restrict__ Wt, int K, int N, float* lds, int wb0, int nwb) {
    const int tid = opaque_tid();
    const int tk = K / 64, tn = N / 256;
    for (int tile = (int)blockIdx.x - wb0; tile < tk * tn; tile += nwb) {
        const int k0 = (tile / tn) * 64, n0 = (tile % tn) * 256;
        __syncthreads();
        float4 v[8];
#pragma unroll
        for (int i = 0; i < 8; ++i) v[i] = nt_load4(W + (size_t)(k0 + (tid >> 6) + 8 * i) * N + n0 + (tid & 63) * 4);
#pragma unroll
        for (int i = 0; i < 8; ++i) { float* d = lds + ((tid >> 6) + 8 * i) * 257 + (tid & 63) * 4; d[0] = v[i].x; d[1] = v[i].y; d[2] = v[i].z; d[3] = v[i].w; }
        __syncthreads();
#pragma unroll
        for (int q = 0; q < 4; ++q) {
            const int c = q * NTHREADS + tid, n = c >> 3, k8 = (c & 7) * 8;
            uint4 o;
            o.x = pk_bf16(lds[(k8 + 0) * 257 + n], lds[(k8 + 1) * 257 + n]); o.y = pk_bf16(lds[(k8 + 2) * 257 + n], lds[(k8 + 3) * 257 + n]);
            o.z = pk_bf16(lds[(k8 + 4) * 257 + n], lds[(k8 + 5) * 257 + n]); o.w = pk_bf16(lds[(k8 + 6) * 257 + n], lds[(k8 + 7) * 257 + n]);
            *(uint4*)(Wt + (size_t)(n0 + n) * K + k0 + k8) = o;
        }
    }
}
__device__ __forceinline__ float wave_max(float v) {
#pragma unroll
    for (int o = 32; o; o >>= 1) v = fmaxf(v, __shfl_xor(v, o));
    return v;
}
__device__ __forceinline__ float block_max(float v, float* red) {
    v = wave_max(v);
    __syncthreads();
    if ((threadIdx.x & 63) == 0) red[threadIdx.x >> 6] = v;
    __syncthreads();
    float s = red[0];
#pragma unroll
    for (int i = 1; i < NWAVES; ++i) s = fmaxf(s, red[i]);
    return s;
}
__device__ __forceinline__ unsigned q4(float a, float b, float c, float d, float inv, int off) {
    const int x = __float2int_rn(a * inv) + off, y = __float2int_rn(b * inv) + off, z = __float2int_rn(c * inv) + off, w = __float2int_rn(d * inv) + off;
    return (unsigned)(x & 255) | ((unsigned)(y & 255) << 8) | ((unsigned)(z & 255) << 16) | ((unsigned)(w & 255) << 24);
}
constexpr int VROW = 1152;
template <int O> __device__ __forceinline__ unsigned nib8(const float (&x)[16], float inv) {
    unsigned r = 0;
#pragma unroll
    for (int i = 0; i < 8; ++i) r |= (unsigned)(min(max(__float2int_rn(x[O + i] * inv), -7), 7) + 8) << (4 * i);
    return r;
}
__device__ __forceinline__ void quant_tables(const Params& p, int wb0, int nwb) {
    const int tid = opaque_tid(), lane = tid & 63, wv = tid >> 6;
    unsigned char* tq = (unsigned char*)p.ws + B_TQ; float* rsc = p.ws + W_SU;
    const int nw = nwb * NWAVES;
    for (int row0 = ((int)blockIdx.x - wb0) * NWAVES + wv; row0 < 2 * 16384; row0 += 2 * nw) {
        float x[2][2][16]; float mx[2][2];
#pragma unroll
        for (int u = 0; u < 2; ++u) {
            const int row = min(row0 + u * nw, 2 * 16384 - 1);
            const float* src = (row < 16384 ? p.in[I_PU] : p.in[I_PV]) + (size_t)(row & 16383) * D + lane * 4;
#pragma unroll
            for (int h = 0; h < 2; ++h) {
                mx[u][h] = 0.f;
#pragma unroll
                for (int q = 0; q < 4; ++q) { const float4 v = nt_load4(src + (h * 4 + q) * 256); x[u][h][q * 4] = v.x; x[u][h][q * 4 + 1] = v.y; x[u][h][q * 4 + 2] = v.z; x[u][h][q * 4 + 3] = v.w;
                    mx[u][h] = fmaxf(mx[u][h], fmaxf(fmaxf(fabsf(v.x), fabsf(v.y)), fmaxf(fabsf(v.z), fabsf(v.w)))); }
            }
        }
#pragma unroll
        for (int u = 0; u < 2; ++u) {
            const int row = row0 + u * nw;
            if (row < 2 * 16384) {
                unsigned char* dst = tq + (size_t)row * VROW;
                const float rmx = wave_max(fmaxf(mx[u][0], mx[u][1]));
                const float R = rmx > 0.f ? rmx * (1.0f / (7.0f * 240.0f)) : 1.0f, invR = 1.0f / R;
                const int pk = __builtin_amdgcn_cvt_pk_fp8_f32(mx[u][0] * (1.03f / 7.0f) * invR, mx[u][1] * (1.03f / 7.0f) * invR, 0, false);
                const float s0 = __builtin_amdgcn_cvt_f32_fp8(pk, 0) * R, s1 = __builtin_amdgcn_cvt_f32_fp8(pk, 1) * R;
                const float i0 = s0 > 0.f ? 1.0f / s0 : 0.f, i1 = s1 > 0.f ? 1.0f / s1 : 0.f;
                nt_store4u(dst + lane * 16, make_uint4(nib8<0>(x[u][0], i0), nib8<8>(x[u][0], i0), nib8<0>(x[u][1], i1), nib8<8>(x[u][1], i1)));
                *(unsigned short*)(dst + 1024 + lane * 2) = (unsigned short)(pk & 0xffff);
                if (lane == 0) rsc[row] = R;
            }
        }
    }
}

__device__ __forceinline__ void naive_gemm(const float* __restrict__ A, int lda, const float* __restrict__ Bm, int ldb,
                                           float* __restrict__ C, int ldc, int M, int N, int K, float* lds) {
    float* As = lds;
    float* Bs = lds + 16 * 132;
    const int tid = opaque_tid(), tx = tid & 31, ty = tid >> 5;
    const int tilesN = N / 128, ntiles = (M / 128) * tilesN;
    for (int tile = blockIdx.x; tile < ntiles; tile += gridDim.x) {
        const int m0 = (tile / tilesN) * 128, n0 = (tile % tilesN) * 128;
        float acc[8][4];
#pragma unroll
        for (int i = 0; i < 8; ++i)
#pragma unroll
            for (int j = 0; j < 4; ++j) acc[i][j] = 0.f;
        for (int k0 = 0; k0 < K; k0 += 16) {
            {
                const int row = tid >> 2, kq = (tid & 3) * 4;
                const float4 a = *(const float4*)(A + (size_t)(m0 + row) * lda + k0 + kq);
                As[(kq + 0) * 132 + row] = a.x; As[(kq + 1) * 132 + row] = a.y; As[(kq + 2) * 132 + row] = a.z; As[(kq + 3) * 132 + row] = a.w;
                const int kk = tid >> 5, n4 = (tid & 31) * 4;
                *(float4*)(Bs + kk * 128 + n4) = *(const float4*)(Bm + (size_t)(k0 + kk) * ldb + n0 + n4);
            }
            __syncthreads();
#pragma unroll 4
            for (int k = 0; k < 16; ++k) {
                const float4 a0 = *(const float4*)(As + k * 132 + ty * 8), a1 = *(const float4*)(As + k * 132 + ty * 8 + 4);
                const float4 b = *(const float4*)(Bs + k * 128 + tx * 4);
                const float av[8] = {a0.x, a0.y, a0.z, a0.w, a1.x, a1.y, a1.z, a1.w};
                const float bv[4] = {b.x, b.y, b.z, b.w};
#pragma unroll
                for (int i = 0; i < 8; ++i)
#pragma unroll
                    for (int j = 0; j < 4; ++j) acc[i][j] += av[i] * bv[j];
            }
            __syncthreads();
        }
#pragma unroll
        for (int i = 0; i < 8; ++i)
            *(float4*)(C + (size_t)(m0 + ty * 8 + i) * ldc + n0 + tx * 4) = make_float4(acc[i][0], acc[i][1], acc[i][2], acc[i][3]);
    }
}

__device__ __forceinline__ void phase_a(const Params& p, float* lds) {
    const int tid = opaque_tid();
    const float* c = p.in[I_C]; const float* cctx = p.in[I_CCTX]; const float* wada = p.in[I_WADA];
    float* part = p.ws + W_ADAP;
    for (int item = blockIdx.x; item < 32 * 24; item += gridDim.x) {
        const int ks = item / 24, j = (item % 24) * 512 + tid;
        __syncthreads();
        if (tid < 5 * 64) { const int n = tid >> 6, k = ks * 64 + (tid & 63); lds[tid] = silu(n < 4 ? c[n * 2048 + k] : cctx[k]); }
        __syncthreads();
        float a0 = 0.f, a1 = 0.f, a2 = 0.f, a3 = 0.f, a4 = 0.f;
#pragma unroll 32
        for (int kk = 0; kk < 64; ++kk) {
            const float w = __builtin_nontemporal_load(wada + (size_t)(ks * 64 + kk) * 12288 + j);
            a0 += lds[kk] * w; a1 += lds[64 + kk] * w; a2 += lds[128 + kk] * w; a3 += lds[192 + kk] * w; a4 += lds[256 + kk] * w;
        }
        part[(size_t)(ks * 5 + 0) * 12288 + j] = a0; part[(size_t)(ks * 5 + 1) * 12288 + j] = a1; part[(size_t)(ks * 5 + 2) * 12288 + j] = a2;
        part[(size_t)(ks * 5 + 3) * 12288 + j] = a3; part[(size_t)(ks * 5 + 4) * 12288 + j] = a4;
    }
}
typedef short bf16x8v __attribute__((ext_vector_type(8)));
typedef float f32x4v __attribute__((ext_vector_type(4)));
typedef float f32x16v __attribute__((ext_vector_type(16)));
__device__ __forceinline__ void phase_filters(const Params& p, float* lds) {
    const int tid = opaque_tid();
    const float* w1 = p.in[I_FW1]; const float* b1 = p.in[I_FB1]; const float* w2 = p.in[I_FW2]; const float* b2 = p.in[I_FB2];
    const float* w3 = p.in[I_FW3]; const float* b3 = p.in[I_FB3]; const float* w4 = p.in[I_FW4]; const float* freq = p.in[I_FREQ];
    float* hT = (float*)((char*)p.ws + B_KF); float* sp = p.ws + W_SP;
    float* zf = lds; float* ha = lds + 64 * 36; float* hb = ha + 64 * 68; float* red2 = hb + 64 * 68;
    float* W1 = red2 + 256; float* W2 = W1 + 33 * 64; float* W3 = W2 + 64 * 64;
    __syncthreads();
    for (int e = tid; e < 33 * 64; e += NTHREADS) W1[e] = w1[e];
    for (int e = tid; e < 64 * 64; e += NTHREADS) { W2[e] = w2[e]; W3[e] = w3[e]; }
    for (int item = blockIdx.x; item < 256; item += gridDim.x) {
        const int pt = item >> 3;
        __syncthreads();
        for (int e = tid; e < 64 * 33; e += NTHREADS) {
            const int pos = e / 33, m = e % 33, i = pt * 64 + pos;
            const float t = (float)i / 2047.0f, w = 6.283185307179586f * (float)i / 2048.0f;
            float v;
            if (m == 0) v = t;
            else if (m <= 16) { const float f = 1e-4f + (float)(m - 1) * ((15.0f - 1e-4f) / 15.0f); v = __cosf(f * w); }
            else { const float f = 1e-4f + (float)(m - 17) * ((15.0f - 1e-4f) / 15.0f); v = -__sinf(f * w); }
            zf[pos * 36 + m] = v;
        }
        __syncthreads();
        const int pos = tid >> 3, u0 = (tid & 7) * 8;
        {
            float a[8];
#pragma unroll
            for (int u = 0; u < 8; ++u) a[u] = b1[u0 + u];
#pragma unroll 11
            for (int m = 0; m < 33; ++m) { const float zv = zf[pos * 36 + m]; const float4 wa = *(const float4*)(W1 + m * 64 + u0), wb = *(const float4*)(W1 + m * 64 + u0 + 4);
                a[0] += zv * wa.x; a[1] += zv * wa.y; a[2] += zv * wa.z; a[3] += zv * wa.w; a[4] += zv * wb.x; a[5] += zv * wb.y; a[6] += zv * wb.z; a[7] += zv * wb.w; }
#pragma unroll
            for (int u = 0; u < 8; ++u) ha[pos * 68 + u0 + u] = __sinf(freq[u0 + u] * a[u]);
        }
        __syncthreads();
        {
            float a[8];
#pragma unroll
            for (int u = 0; u < 8; ++u) a[u] = b2[u0 + u];
#pragma unroll 16
            for (int m = 0; m < 64; ++m) { const float zv = ha[pos * 68 + m]; const float4 wa = *(const float4*)(W2 + m * 64 + u0), wb = *(const float4*)(W2 + m * 64 + u0 + 4);
                a[0] += zv * wa.x; a[1] += zv * wa.y; a[2] += zv * wa.z; a[3] += zv * wa.w; a[4] += zv * wb.x; a[5] += zv * wb.y; a[6] += zv * wb.z; a[7] += zv * wb.w; }
#pragma unroll
            for (int u = 0; u < 8; ++u) hb[pos * 68 + u0 + u] = __sinf(freq[64 + u0 + u] * a[u]);
        }
        __syncthreads();
        {
            float a[8];
#pragma unroll
            for (int u = 0; u < 8; ++u) a[u] = b3[u0 + u];
#pragma unroll 16
            for (int m = 0; m < 64; ++m) { const float zv = hb[pos * 68 + m]; const float4 wa = *(const float4*)(W3 + m * 64 + u0), wb = *(const float4*)(W3 + m * 64 + u0 + 4);
                a[0] += zv * wa.x; a[1] += zv * wa.y; a[2] += zv * wa.z; a[3] += zv * wa.w; a[4] += zv * wb.x; a[5] += zv * wb.y; a[6] += zv * wb.z; a[7] += zv * wb.w; }
#pragma unroll
            for (int u = 0; u < 8; ++u) ha[pos * 68 + u0 + u] = __sinf(freq[128 + u0 + u] * a[u]);
        }
        __syncthreads();
#pragma unroll 1
        for (int jt = (item & 7) * 2; jt < (item & 7) * 2 + 2; ++jt) {
            const int lane = tid & 63, wv = tid >> 6, cl = lane & 15, g = lane >> 4;
            union frag { unsigned u[4]; bf16x8v v; };
            frag af[2][2];
#pragma unroll
            for (int mt = 0; mt < 2; ++mt)
#pragma unroll
                for (int ks = 0; ks < 2; ++ks) {
                    const float* wp = w4 + (size_t)(ks * 32 + 8 * g) * 4096 + jt * 256 + wv * 32 + mt * 16 + cl;
                    float x[8];
#pragma unroll
                    for (int i = 0; i < 8; ++i) x[i] = wp[(size_t)i * 4096];
                    af[mt][ks].u[0] = pk_bf16(x[0], x[1]); af[mt][ks].u[1] = pk_bf16(x[2], x[3]); af[mt][ks].u[2] = pk_bf16(x[4], x[5]); af[mt][ks].u[3] = pk_bf16(x[6], x[7]);
                }
            f32x4v acc[2][4];
#pragma unroll
            for (int mt = 0; mt < 2; ++mt)
#pragma unroll
                for (int nt = 0; nt < 4; ++nt) acc[mt][nt] = (f32x4v){0.f, 0.f, 0.f, 0.f};
#pragma unroll
            for (int nt = 0; nt < 4; ++nt)
#pragma unroll
                for (int ks = 0; ks < 2; ++ks) {
                    const float4 h0 = *(const float4*)(ha + (nt * 16 + cl) * 68 + ks * 32 + 8 * g), h1 = *(const float4*)(ha + (nt * 16 + cl) * 68 + ks * 32 + 8 * g + 4);
                    frag bf; bf.u[0] = pk_bf16(h0.x, h0.y); bf.u[1] = pk_bf16(h0.z, h0.w); bf.u[2] = pk_bf16(h1.x, h1.y); bf.u[3] = pk_bf16(h1.z, h1.w);
#pragma unroll
                    for (int mt = 0; mt < 2; ++mt) acc[mt][nt] = __builtin_amdgcn_mfma_f32_16x16x32_bf16(af[mt][ks].v, bf.v, acc[mt][nt], 0, 0, 0);
                }
#pragma unroll
            for (int mt = 0; mt < 2; ++mt)
#pragma unroll
                for (int r = 0; r < 4; ++r) {
                    const int j = jt * 256 + wv * 32 + mt * 16 + 4 * g + r;
                    const float delta = 3.070113457f + (float)(j & 1023) * ((15.35056729f - 3.070113457f) / 1023.0f);
                    float asum = 0.f;
#pragma unroll
                    for (int nt = 0; nt < 4; ++nt) {
                        const int ps = pt * 64 + nt * 16 + cl;
                        const float val = acc[mt][nt][r] * __expf(-((float)ps / 2047.0f) * delta);
                        asum += fabsf(val);
                        __builtin_nontemporal_store(val, hT + (size_t)j * SL + ps);
                    }
                    asum += __shfl_xor(asum, 1); asum += __shfl_xor(asum, 2); asum += __shfl_xor(asum, 4); asum += __shfl_xor(asum, 8);
                    if (cl == 0) sp[(size_t)pt * 4096 + j] = asum;
                }
        }
    }
}

__device__ __forceinline__ void phase_b(const Params& p) {
    const int tid = opaque_tid();
    const float* part = p.ws + W_ADAP; float* ada = p.ws + W_ADA; const float* bada = p.in[I_BADA];
    for (int e = blockIdx.x * NTHREADS + tid; e < 5 * 12288; e += gridDim.x * NTHREADS) {
        float s = bada[e % 12288];
#pragma unroll 8
        for (int ks = 0; ks < 32; ++ks) s += part[(size_t)ks * 5 * 12288 + e];
        ada[e] = s;
    }
    const float* sp = p.ws + W_SP; float* fs = p.ws + W_FS;
    for (int j = blockIdx.x * NTHREADS + tid; j < 4096; j += gridDim.x * NTHREADS) {
        float s = 0.f;
#pragma unroll 8
        for (int pt = 0; pt < 32; ++pt) s += sp[(size_t)pt * 4096 + j];
        fs[j] = s;
    }
}

__device__ __forceinline__ void phase_c(const Params& p) {
    const int tid = opaque_tid();
    const float* ada = p.ws + W_ADA;
    const float* x = p.in[I_X]; bf16_t* ub = (bf16_t*)((char*)p.ws + B_UB);
    for (size_t e = (size_t)blockIdx.x * NTHREADS + tid; e < (size_t)NT * D / 4; e += (size_t)gridDim.x * NTHREADS) {
        const size_t row = e / (D / 4); const int col = (int)(e % (D / 4)) * 4; const int b = (int)(row / SL);
        const float4 xv = nt_load4(x + row * D + col);
        const float4 sh = *(const float4*)(ada + b * 12288 + col), sc = *(const float4*)(ada + b * 12288 + 2048 + col);
        uint2 o; o.x = pk_bf16(xv.x * (1.f + sc.x) + sh.x, xv.y * (1.f + sc.y) + sh.y); o.y = pk_bf16(xv.z * (1.f + sc.z) + sh.z, xv.w * (1.f + sc.w) + sh.w);
        *(uint2*)(ub + row * D + col) = o;
    }
    const float* ctx = p.in[I_CTX]; bf16_t* ucb = ub + (size_t)NT * D;
    for (size_t e = (size_t)blockIdx.x * NTHREADS + tid; e < (size_t)NTC * D / 4; e += (size_t)gridDim.x * NTHREADS) {
        const size_t row = e / (D / 4); const int col = (int)(e % (D / 4)) * 4;
        const float4 xv = nt_load4(ctx + row * D + col);
        const float4 sh = *(const float4*)(ada + 4 * 12288 + col), sc = *(const float4*)(ada + 4 * 12288 + 2048 + col);
        uint2 o; o.x = pk_bf16(xv.x * (1.f + sc.x) + sh.x, xv.y * (1.f + sc.y) + sh.y); o.y = pk_bf16(xv.z * (1.f + sc.z) + sh.z, xv.w * (1.f + sc.w) + sh.w);
        *(uint2*)(ucb + row * D + col) = o;
    }
}

__device__ __forceinline__ float bf2f(bf16_t v) { return __uint_as_float(((unsigned)v) << 16); }
constexpr int HY_PB = 4416, HY_PJ = 272, HY_R0 = 4 * HY_PB, HY_R1 = HY_R0 + 8192 + 64, HY_SLOT = HY_R1 + 8192 + 64;
static_assert(HY_SLOT % 16 == 0 && 4 * HY_SLOT <= 160 * 1024, "hyena LDS");
__device__ __forceinline__ bf16x8v hy_lda(const unsigned char* base, int off) {
    const unsigned* q = (const unsigned*)(base + off);
    union { unsigned u[4]; bf16x8v v; } r; r.u[0] = q[0]; r.u[1] = q[1]; r.u[2] = q[2]; r.u[3] = q[3];
    return r.v;
}
__device__ __forceinline__ void hy_stage_rows(const bf16_t* zT, const float* cw, const float* cb, int ch, int half, int lane, unsigned char* sl) {
    const float w0 = cw[ch], w1 = cw[3072 + ch], w2 = cw[6144 + ch], bs = cb[ch];
#pragma unroll 4
    for (int q = 0; q < 8; ++q) {
        const int bsel = 2 * half + (q >> 2), t0 = ((q & 3) * 64 + lane) * 8;
        const bf16_t* zrow = zT + (size_t)ch * NT + bsel * SL;
        const uint4 raw = nt_load4u(zrow + t0);
        float z[10];
        z[0] = t0 > 0 ? bf2f(zrow[t0 - 1]) : 0.f; z[9] = t0 + 8 < SL ? bf2f(zrow[t0 + 8]) : 0.f;
        z[1] = __uint_as_float(raw.x << 16); z[2] = __uint_as_float(raw.x & 0xffff0000u); z[3] = __uint_as_float(raw.y << 16); z[4] = __uint_as_float(raw.y & 0xffff0000u);
        z[5] = __uint_as_float(raw.z << 16); z[6] = __uint_as_float(raw.z & 0xffff0000u); z[7] = __uint_as_float(raw.w << 16); z[8] = __uint_as_float(raw.w & 0xffff0000u);
        float sv[8];
#pragma unroll
        for (int i = 0; i < 8; ++i) sv[i] = w0 * z[i] + w1 * z[i + 1] + w2 * z[i + 2] + bs;
        uint4 o; o.x = pk_bf16(sv[0], sv[1]); o.y = pk_bf16(sv[2], sv[3]); o.z = pk_bf16(sv[4], sv[5]); o.w = pk_bf16(sv[6], sv[7]);
        *(uint4*)(sl + bsel * HY_PB + (t0 >> 7) * HY_PJ + (t0 & 127) * 2) = o;
    }
}
__device__ __forceinline__ void phase_hyena(const Params& p, unsigned char* smem) {
    const int tid = opaque_tid(), lane = tid & 63, wv = tid >> 6, slot = wv >> 1, half = wv & 1, pt = tid & 127;
    const bf16_t* zT = (const bf16_t*)((const char*)p.ws + B_ZT); const float* hT = (const float*)((const char*)p.ws + B_KF); const float* fs = p.ws + W_FS; bf16_t* hyT = (bf16_t*)((char*)p.ws + B_HYT);
    const float* cw = p.in[I_CONVW]; const float* cb = p.in[I_CONVB]; const float* skip = p.in[I_SKIP];
    unsigned char* sl = smem + slot * HY_SLOT;
    const int a_ = lane & 31, hh = lane >> 5, i_local = a_ >> 2, batch = a_ & 3, I0 = 8 * half;
    const int laneA = ((a_ & 1) ? HY_R0 : HY_R1) + 2 * (2047 - a_ - (1 - (a_ & 1)) + 8 * hh);
    for (int item = blockIdx.x; item < DHY / 4; item += gridDim.x) {
        const int c = item * 4 + slot;
        __syncthreads();
        hy_stage_rows(zT, cw, cb, c, half, lane, sl);
#pragma unroll 1
        for (int ord = 0; ord < 2; ++ord) {
            {
                const float* hf = hT + (size_t)((ord * 2 + 0) * 1024 + c) * SL; const float* hbk = hT + (size_t)((ord * 2 + 1) * 1024 + c) * SL;
                const float sk = skip[ord * 1024 + c]; const float invs = 1.0f / (fs[(ord * 2 + 0) * 1024 + c] + fs[(ord * 2 + 1) * 1024 + c]);
#pragma unroll
                for (int q = 0; q < 4; ++q) {
                    const int X0 = (q * 128 + pt) * 8;
                    float rv[9];
#pragma unroll
                    for (int i = 0; i < 9; ++i) { const int dp = 2047 - X0 - i; rv[i] = (dp >= 0 ? __builtin_nontemporal_load(hf + dp) : (dp >= -2047 ? __builtin_nontemporal_load(hbk - dp) : 0.f)) * invs; if (dp == 0) rv[i] += sk; }
                    uint4 o0, o1;
                    o0.x = pk_bf16(rv[0], rv[1]); o0.y = pk_bf16(rv[2], rv[3]); o0.z = pk_bf16(rv[4], rv[5]); o0.w = pk_bf16(rv[6], rv[7]);
                    o1.x = pk_bf16(rv[1], rv[2]); o1.y = pk_bf16(rv[3], rv[4]); o1.z = pk_bf16(rv[5], rv[6]); o1.w = pk_bf16(rv[7], rv[8]);
                    *(uint4*)(sl + HY_R0 + X0 * 2) = o0; *(uint4*)(sl + HY_R1 + X0 * 2) = o1;
                }
            }
            __syncthreads();
            f32x16v acc[4];
#pragma unroll
            for (int mb = 0; mb < 4; ++mb)
#pragma unroll
                for (int e = 0; e < 16; ++e) acc[mb][e] = 0.f;
            {
                const int dlo = I0 - 15, dhi = I0 + 7;
                bf16x8v As[7][2];
#pragma unroll
                for (int s2 = 0; s2 < 3; ++s2)
#pragma unroll
                    for (int k2 = 0; k2 < 2; ++k2) As[4 + s2][k2] = hy_lda(sl, laneA - 64 * (4 * dlo - 3 + s2) + 32 * k2);
#pragma unroll 1
                for (int d = dlo; d <= dhi; ++d) {
#pragma unroll
                    for (int k2 = 0; k2 < 2; ++k2) { As[0][k2] = As[4][k2]; As[1][k2] = As[5][k2]; As[2][k2] = As[6][k2]; }
#pragma unroll
                    for (int s2 = 3; s2 < 7; ++s2)
#pragma unroll
                        for (int k2 = 0; k2 < 2; ++k2) As[s2][k2] = hy_lda(sl, laneA - 64 * (4 * d - 3 + s2) + 32 * k2);
                    const int jl = I0 + i_local - d; const bool valid = (unsigned)jl < 16u;
                    const unsigned char* bp = sl + batch * HY_PB + (valid ? jl : 0) * HY_PJ + hh * 16;
                    bf16x8v Bq[8];
#pragma unroll
                    for (int q = 0; q < 8; ++q) { const bf16x8v v = *(const bf16x8v*)(bp + q * 32); const bf16x8v zero = {0, 0, 0, 0, 0, 0, 0, 0}; Bq[q] = valid ? v : zero; }
#pragma unroll
                    for (int kb = 0; kb < 4; ++kb)
#pragma unroll
                        for (int k2 = 0; k2 < 2; ++k2)
#pragma unroll
                            for (int mb = 0; mb < 4; ++mb) acc[mb] = __builtin_amdgcn_mfma_f32_32x32x16_bf16(As[mb - kb + 3][k2], Bq[2 * kb + k2], acc[mb], 0, 0, 0);
                }
            }
            __syncthreads();
            hy_stage_rows(zT, cw, cb, (ord == 0 ? 1024 : 2048) + c, half, lane, sl);
            __syncthreads();
            {
#pragma unroll
                for (int mb = 0; mb < 4; ++mb)
#pragma unroll
                    for (int q4 = 0; q4 < 4; ++q4) {
                        const int t4 = 128 * (I0 + i_local) + 32 * mb + 8 * q4 + 4 * hh;
                        uint2* gp = (uint2*)(sl + batch * HY_PB + (t4 >> 7) * HY_PJ + (t4 & 127) * 2);
                        const uint2 gv = *gp;
                        uint2 o; o.x = pk_bf16(__uint_as_float(gv.x << 16) * acc[mb][q4 * 4 + 0], __uint_as_float(gv.x & 0xffff0000u) * acc[mb][q4 * 4 + 1]);
                        o.y = pk_bf16(__uint_as_float(gv.y << 16) * acc[mb][q4 * 4 + 2], __uint_as_float(gv.y & 0xffff0000u) * acc[mb][q4 * 4 + 3]);
                        *gp = o;
                    }
            }
            if (ord == 1) {
                __syncthreads();
#pragma unroll
                for (int q = 0; q < 8; ++q) {
                    const int bsel = 2 * half + (q >> 2), t0 = ((q & 3) * 64 + lane) * 8;
                    nt_store4u(hyT + (size_t)c * NT + bsel * SL + t0, *(const uint4*)(sl + bsel * HY_PB + (t0 >> 7) * HY_PJ + (t0 & 127) * 2));
                }
            }
        }
    }
}

__device__ __forceinline__ bf16x8v pack_p(const f32x4v& lo, const f32x4v& hi) {
    union { unsigned u[4]; bf16x8v v; } r;
    r.u[0] = pk_bf16(lo[0], lo[1]); r.u[1] = pk_bf16(lo[2], lo[3]); r.u[2] = pk_bf16(hi[0], hi[1]); r.u[3] = pk_bf16(hi[2], hi[3]);
    return r.v;
}
__device__ __forceinline__ bf16x8v ld_pair8(const bf16_t* lo, const bf16_t* hi) {
    union { uint2 d[2]; bf16x8v v; } r;
    r.d[0] = *(const uint2*)lo; r.d[1] = *(const uint2*)hi;
    return r.v;
}
typedef __attribute__((address_space(3))) const bf16_t* lds_bf16p;
#define LDS_FRAG(pe) (*(const __attribute__((address_space(3))) bf16x8v*)(pe))
constexpr int NA_KC = 0, NA_VC = 32768, NA_KL = 65536, NA_RPB = 155648;
__device__ __forceinline__ void phase_na(const Params& p, unsigned char* smem) {
    const int tid = opaque_tid(), lane = tid & 63, wv = tid >> 6, ql = lane & 15, g = lane >> 4;
    const bf16_t* qh = (const bf16_t*)((const char*)p.ws + B_QH); const bf16_t* kh = (const bf16_t*)((const char*)p.ws + B_KH);
    const bf16_t* kch = (const bf16_t*)((const char*)p.ws + B_KCH); const bf16_t* vT = (const bf16_t*)((const char*)p.ws + B_VT);
    const bf16_t* vcT = (const bf16_t*)((const char*)p.ws + B_VCT); bf16_t* na = (bf16_t*)((char*)p.ws + B_NA);
    const float* rpb = p.in[I_RPB];
    const lds_bf16p kcl = (lds_bf16p)((__attribute__((address_space(3))) unsigned char*)smem + NA_KC);
    const lds_bf16p vcl = (lds_bf16p)((__attribute__((address_space(3))) unsigned char*)smem + NA_VC);
    const lds_bf16p kll = (lds_bf16p)((__attribute__((address_space(3))) unsigned char*)smem + NA_KL);
    for (int sitem = blockIdx.x; sitem < 256; sitem += gridDim.x) {
      const int b = sitem >> 6, h = (sitem >> 2) & 15, rqp = sitem & 3;
      __syncthreads();
      {
          const uint4* s0 = (const uint4*)(kch + (size_t)((b * 16 + h) * 32) * 512); const uint4* s1 = (const uint4*)(vcT + (size_t)((b * 16 + h) * 32) * 512);
          uint4* d0 = (uint4*)(smem + NA_KC); uint4* d1 = (uint4*)(smem + NA_VC);
#pragma unroll
          for (int i = 0; i < 4; ++i) { d0[tid + i * NTHREADS] = s0[tid + i * NTHREADS]; d1[tid + i * NTHREADS] = s1[tid + i * NTHREADS]; }
          if (tid < 465) ((float*)(smem + NA_RPB))[tid] = rpb[h * 465 + tid];
      }
#pragma unroll 1
      for (int half = 0; half < 2; ++half) {
        const int r0 = rqp * 8 + half * 4;
        const int rs_min = min(max(r0 - 4, 0), 24), rs_max = min(max(r0 - 1, 0), 24), nrows = rs_max - rs_min + 8;
        if (half) __syncthreads();
        {
            const uint4* s0 = (const uint4*)(kh + (size_t)((b * 16 + h) * 256 + rs_min * 8) * 512); uint4* d0 = (uint4*)(smem + NA_KL);
            for (int e = tid; e < nrows * 512; e += NTHREADS) d0[e] = s0[e];
        }
        __syncthreads();
#pragma unroll 1
        for (int ti = 0; ti < 2; ++ti) {
        const int r = r0 + (wv >> 2) + 2 * ti, j = wv & 3;
        const int rs = min(max(r - 4, 0), 24), cs = min(max(16 * j - 8, 0), 32);
        const int x = 16 * j + ql, wsx = min(max(x - 8, 0), 48);
        const bf16_t* qrow = qh + ((size_t)((b * 16 + h) * SL + r * 64 + x)) * 64;
        const bf16x8v qf0 = __builtin_nontemporal_load((const bf16x8v*)(qrow + 8 * g)), qf1 = __builtin_nontemporal_load((const bf16x8v*)(qrow + 32 + 8 * g));
        const __attribute__((address_space(3))) float* rp_h = (const __attribute__((address_space(3))) float*)((__attribute__((address_space(3))) unsigned char*)smem + NA_RPB);
        f32x4v o1[4], o2[4]; float m1 = -1e30f, l1 = 0.f, m2 = -1e30f, l2 = 0.f;
#pragma unroll
        for (int d = 0; d < 4; ++d) { o1[d] = (f32x4v){0.f, 0.f, 0.f, 0.f}; o2[d] = (f32x4v){0.f, 0.f, 0.f, 0.f}; }
        const int koff = (ql >> 2) * 512 + g * 32 + (ql & 3) * 8;
        const bf16_t* vb = vT + (size_t)((b * 16 + h) * 256 + g) * 512 + ql * 8;
        {
            f32x4v st[16];
#pragma unroll
            for (int kb = 0; kb < 16; ++kb) {
                const lds_bf16p kp = kcl + koff + (kb >> 1) * 2048 + (kb & 1) * 128;
                const bf16x8v a0 = LDS_FRAG(kp), a1 = LDS_FRAG(kp + 256);
                f32x4v acc = {0.f, 0.f, 0.f, 0.f};
                acc = __builtin_amdgcn_mfma_f32_16x16x32_bf16(a0, qf0, acc, 0, 0, 0);
                acc = __builtin_amdgcn_mfma_f32_16x16x32_bf16(a1, qf1, acc, 0, 0, 0);
#pragma unroll
                for (int rr = 0; rr < 4; ++rr) { acc[rr] *= 0.125f; m1 = fmaxf(m1, acc[rr]); }
                st[kb] = acc;
            }
            m1 = fmaxf(m1, __shfl_xor(m1, 16)); m1 = fmaxf(m1, __shfl_xor(m1, 32));
#pragma unroll
            for (int kb = 0; kb < 16; ++kb)
#pragma unroll
                for (int rr = 0; rr < 4; ++rr) { const float e = __expf(st[kb][rr] - m1); st[kb][rr] = e; l1 += e; }
            l1 += __shfl_xor(l1, 16); l1 += __shfl_xor(l1, 32);
#pragma unroll
            for (int kp = 0; kp < 8; ++kp) {
                const bf16x8v pb = pack_p(st[2 * kp], st[2 * kp + 1]);
#pragma unroll
                for (int d = 0; d < 4; ++d) o1[d] = __builtin_amdgcn_mfma_f32_16x16x32_bf16(LDS_FRAG(vcl + g * 512 + ql * 8 + kp * 2048 + d * 128), pb, o1[d], 0, 0, 0);
            }
        }
        {
            f32x4v st[16];
#pragma unroll
            for (int kb = 0; kb < 16; ++kb) {
                const lds_bf16p kp = kll + koff + ((((rs + (kb >> 1) - rs_min) * 64 + cs) >> 3) * 512) + (kb & 1) * 128;
                const bf16x8v a0 = LDS_FRAG(kp), a1 = LDS_FRAG(kp + 256);
                f32x4v acc = {0.f, 0.f, 0.f, 0.f};
                acc = __builtin_amdgcn_mfma_f32_16x16x32_bf16(a0, qf0, acc, 0, 0, 0);
                acc = __builtin_amdgcn_mfma_f32_16x16x32_bf16(a1, qf1, acc, 0, 0, 0);
                const int dr = rs + (kb >> 1) - r + 7;
#pragma unroll
                for (int rr = 0; rr < 4; ++rr) {
                    const int kc = cs + 8 * g + 4 * (kb & 1) + rr, rel = kc - wsx;
                    const bool ok = rel >= 0 && rel < 16;
                    const int dc = min(max(kc - x + 15, 0), 30);
                    const float sv = ok ? acc[rr] * 0.125f + rp_h[dr * 31 + dc] : -1e30f;
                    acc[rr] = sv; m2 = fmaxf(m2, sv);
                }
                st[kb] = acc;
                if ((kb & 7) == 7) asm volatile("" ::: "memory");
            }
            m2 = fmaxf(m2, __shfl_xor(m2, 16)); m2 = fmaxf(m2, __shfl_xor(m2, 32));
#pragma unroll
            for (int kb = 0; kb < 16; ++kb)
#pragma unroll
                for (int rr = 0; rr < 4; ++rr) { const float e = __expf(st[kb][rr] - m2); st[kb][rr] = e; l2 += e; }
            l2 += __shfl_xor(l2, 16); l2 += __shfl_xor(l2, 32);
#pragma unroll
            for (int kp = 0; kp < 8; ++kp) {
                const bf16x8v pb = pack_p(st[2 * kp], st[2 * kp + 1]);
                const bf16_t* vp = vb + (size_t)(((rs + kp) * 64 + cs) >> 3) * 512;
#pragma unroll
                for (int d = 0; d < 4; ++d) o2[d] = __builtin_amdgcn_mfma_f32_16x16x32_bf16(*(const bf16x8v*)(vp + d * 128), pb, o2[d], 0, 0, 0);
                if ((kp & 3) == 3) asm volatile("" ::: "memory");
            }
        }
        const float mm = fmaxf(m1, m2), c1 = __expf(m1 - mm), c2 = __expf(m2 - mm);
        const float inv = 1.0f / (c1 * l1 + c2 * l2);
        const float w1 = c1 * inv, w2 = c2 * inv;
        f32x4v o[4];
#pragma unroll
        for (int d = 0; d < 4; ++d) o[d] = o1[d] * w1 + o2[d] * w2;
        bf16_t* op = na + (size_t)(b * SL + r * 64 + x) * DNA + h * 64 + 4 * g;
#pragma unroll
        for (int d = 0; d < 4; ++d) { uint2 w; w.x = pk_bf16(o[d][0], o[d][1]); w.y = pk_bf16(o[d][2], o[d][3]); nt_store2u(op + 16 * d, w); }
        }
      }
    }
}

__device__ __forceinline__ void phase_f(const Params& p, float* ldsf) {
    const int tid = opaque_tid();
    const bf16_t* hyT = (const bf16_t*)((const char*)p.ws + B_HYT); const bf16_t* na = (const bf16_t*)((const char*)p.ws + B_NA);
    bf16_t* ob = (bf16_t*)((char*)p.ws + B_UB);
    const float* ghy = p.in[I_GHY]; const float* gna = p.in[I_GNA];
    bf16_t* tile = (bf16_t*)ldsf;
    for (int item = blockIdx.x; item < NT / 32; item += gridDim.x) {
        const int t0 = item * 32;
        __syncthreads();
        uint4 hvv[8];
#pragma unroll
        for (int q = 0; q < 8; ++q) { const int e = q * NTHREADS + tid; hvv[q] = nt_load4u(hyT + (size_t)(e >> 2) * NT + t0 + (e & 3) * 8); }
#pragma unroll
        for (int q = 0; q < 8; ++q) {
            const int e = q * NTHREADS + tid, ch = e >> 2, part = e & 3;
            const unsigned wd[4] = {hvv[q].x, hvv[q].y, hvv[q].z, hvv[q].w};
#pragma unroll
            for (int i = 0; i < 4; ++i) { tile[(part * 8 + 2 * i) * 1032 + ch] = (bf16_t)(wd[i] & 0xffffu); tile[(part * 8 + 2 * i + 1) * 1032 + ch] = (bf16_t)(wd[i] >> 16); }
        }
        __syncthreads();
        const int tk = tid >> 4, sub = tid & 15;
        float hv[64]; float sh = 0.f, sn = 0.f;
#pragma unroll
        for (int i = 0; i < 8; ++i) {
            const uint4 v = *(const uint4*)(tile + tk * 1032 + (i * 16 + sub) * 8);
            const unsigned wd[4] = {v.x, v.y, v.z, v.w};
#pragma unroll
            for (int k = 0; k < 4; ++k) { const float a = __uint_as_float(wd[k] << 16), c = __uint_as_float(wd[k] & 0xffff0000u); hv[i * 8 + 2 * k] = a; hv[i * 8 + 2 * k + 1] = c; sh += a * a + c * c; }
        }
        const bf16_t* nrow = na + (size_t)(t0 + tk) * DNA;
        uint4 nv[8];
#pragma unroll
        for (int i = 0; i < 8; ++i) { nv[i] = nt_load4u(nrow + (i * 16 + sub) * 8);
            const unsigned wd[4] = {nv[i].x, nv[i].y, nv[i].z, nv[i].w};
#pragma unroll
            for (int k = 0; k < 4; ++k) { const float a = __uint_as_float(wd[k] << 16), c = __uint_as_float(wd[k] & 0xffff0000u); sn += a * a + c * c; } }
        sh += __shfl_xor(sh, 1); sh += __shfl_xor(sh, 2); sh += __shfl_xor(sh, 4); sh += __shfl_xor(sh, 8);
        sn += __shfl_xor(sn, 1); sn += __shfl_xor(sn, 2); sn += __shfl_xor(sn, 4); sn += __shfl_xor(sn, 8);
        const float rh = rsqrtf(sh * (1.0f / 1024.0f) + LN_EPS), rn = rsqrtf(sn * (1.0f / 1024.0f) + LN_EPS);
        bf16_t* orow = ob + (size_t)(t0 + tk) * D;
#pragma unroll
        for (int i = 0; i < 8; ++i) {
            const float4 g0 = *(const float4*)(ghy + (i * 16 + sub) * 8), g1 = *(const float4*)(ghy + (i * 16 + sub) * 8 + 4);
            uint4 w; w.x = pk_bf16(hv[i * 8] * rh * g0.x, hv[i * 8 + 1] * rh * g0.y); w.y = pk_bf16(hv[i * 8 + 2] * rh * g0.z, hv[i * 8 + 3] * rh * g0.w);
            w.z = pk_bf16(hv[i * 8 + 4] * rh * g1.x, hv[i * 8 + 5] * rh * g1.y); w.w = pk_bf16(hv[i * 8 + 6] * rh * g1.z, hv[i * 8 + 7] * rh * g1.w);
            *(uint4*)(orow + (i * 16 + sub) * 8) = w;
        }
#pragma unroll
        for (int i = 0; i < 8; ++i) {
            const float4 g0 = *(const float4*)(gna + (i * 16 + sub) * 8), g1 = *(const float4*)(gna + (i * 16 + sub) * 8 + 4);
            const unsigned wd[4] = {nv[i].x, nv[i].y, nv[i].z, nv[i].w};
            float a[8];
#pragma unroll
            for (int k = 0; k < 4; ++k) { a[2 * k] = __uint_as_float(wd[k] << 16); a[2 * k + 1] = __uint_as_float(wd[k] & 0xffff0000u); }
            uint4 w; w.x = pk_bf16(a[0] * rn * g0.x, a[1] * rn * g0.y); w.y = pk_bf16(a[2] * rn * g0.z, a[3] * rn * g0.w);
            w.z = pk_bf16(a[4] * rn * g1.x, a[5] * rn * g1.y); w.w = pk_bf16(a[6] * rn * g1.z, a[7] * rn * g1.w);
            *(uint4*)(orow + DHY + (i * 16 + sub) * 8) = w;
        }
    }
}

__device__ __forceinline__ void phase_h(const Params& p) {
    const int tid = opaque_tid(), lane = tid & 63, wv = tid >> 6;
    const float* x = p.in[I_X]; const bf16_t* y = (const bf16_t*)((const char*)p.ws + B_Y); const float* ada = p.ws + W_ADA;
    const float* g = p.in[I_LN1G]; const float* be = p.in[I_LN1B];
    bf16_t* x1 = (bf16_t*)((char*)p.ws + B_X1); bf16_t* u2b = (bf16_t*)((char*)p.ws + B_UB); unsigned* u2q = (unsigned*)((char*)p.ws + B_U2Q); float* su2 = p.ws + W_SU2;
#pragma unroll 1
    for (int tp = blockIdx.x * NWAVES + wv; tp < NT / 2; tp += gridDim.x * NWAVES) {
        const int b = (2 * tp) / SL;
        float v[2][32]; float s[2] = {0.f, 0.f};
#pragma unroll
        for (int u = 0; u < 2; ++u)
#pragma unroll
            for (int j = 0; j < 8; ++j) {
                const int col = j * 256 + lane * 4; const size_t t = (size_t)(2 * tp + u);
                const float4 xv = nt_load4(x + t * D + col); const uint2 yb = nt_load2u(y + t * D + col);
                const float4 yv = make_float4(__uint_as_float(yb.x << 16), __uint_as_float(yb.x & 0xffff0000u), __uint_as_float(yb.y << 16), __uint_as_float(yb.y & 0xffff0000u));
                const float4 gt = *(const float4*)(ada + b * 12288 + 2 * 2048 + col);
                v[u][j * 4] = ALPHA * xv.x + gt.x * yv.x; v[u][j * 4 + 1] = ALPHA * xv.y + gt.y * yv.y; v[u][j * 4 + 2] = ALPHA * xv.z + gt.z * yv.z; v[u][j * 4 + 3] = ALPHA * xv.w + gt.w * yv.w;
                s[u] += (v[u][j * 4] + v[u][j * 4 + 1]) + (v[u][j * 4 + 2] + v[u][j * 4 + 3]);
            }
        float rstd[2];
#pragma unroll
        for (int u = 0; u < 2; ++u) {
            const float mean = wave_sum(s[u]) * (1.0f / 2048.0f);
            float q2 = 0.f;
#pragma unroll
            for (int i = 0; i < 32; ++i) { v[u][i] -= mean; q2 += v[u][i] * v[u][i]; }
            rstd[u] = rsqrtf(wave_sum(q2) * (1.0f / 2048.0f) + LN_EPS);
        }
        asm volatile("" ::: "memory");
        float umx[2] = {0.f, 0.f};
#pragma unroll
        for (int j = 0; j < 8; ++j) {
            const int col = j * 256 + lane * 4;
            const float4 gv = *(const float4*)(g + col), bv = *(const float4*)(be + col);
            const float4 sh = *(const float4*)(ada + b * 12288 + 3 * 2048 + col), sc = *(const float4*)(ada + b * 12288 + 4 * 2048 + col);
#pragma unroll
            for (int u = 0; u < 2; ++u) {
                const size_t t = (size_t)(2 * tp + u);
                const float4 o = make_float4(v[u][j * 4] * rstd[u] * gv.x + bv.x, v[u][j * 4 + 1] * rstd[u] * gv.y + bv.y, v[u][j * 4 + 2] * rstd[u] * gv.z + bv.z, v[u][j * 4 + 3] * rstd[u] * gv.w + bv.w);
                { uint2 xb; xb.x = pk_bf16(o.x, o.y); xb.y = pk_bf16(o.z, o.w); nt_store2u(x1 + t * D + col, xb); }
                const float4 uv = make_float4(o.x * (1.f + sc.x) + sh.x, o.y * (1.f + sc.y) + sh.y, o.z * (1.f + sc.z) + sh.z, o.w * (1.f + sc.w) + sh.w);
                v[u][j * 4] = uv.x; v[u][j * 4 + 1] = uv.y; v[u][j * 4 + 2] = uv.z; v[u][j * 4 + 3] = uv.w;
                uint2 ub2; ub2.x = pk_bf16(uv.x, uv.y); ub2.y = pk_bf16(uv.z, uv.w);
                *(uint2*)(u2b + t * D + col) = ub2;
                umx[u] = fmaxf(umx[u], fmaxf(fmaxf(fabsf(uv.x), fabsf(uv.y)), fmaxf(fabsf(uv.z), fabsf(uv.w))));
            }
        }
#pragma unroll
        for (int u = 0; u < 2; ++u) {
            const size_t t = (size_t)(2 * tp + u);
            const float um = wave_max(umx[u]);
            const float inv = um > 0.f ? 127.0f / um : 0.f;
            uint4 qa, qb;
            qa.x = q4(v[u][0], v[u][1], v[u][2], v[u][3], inv, 0); qa.y = q4(v[u][4], v[u][5], v[u][6], v[u][7], inv, 0); qa.z = q4(v[u][8], v[u][9], v[u][10], v[u][11], inv, 0); qa.w = q4(v[u][12], v[u][13], v[u][14], v[u][15], inv, 0);
            qb.x = q4(v[u][16], v[u][17], v[u][18], v[u][19], inv, 0); qb.y = q4(v[u][20], v[u][21], v[u][22], v[u][23], inv, 0); qb.z = q4(v[u][24], v[u][25], v[u][26], v[u][27], inv, 0); qb.w = q4(v[u][28], v[u][29], v[u][30], v[u][31], inv, 0);
            nt_store4u(u2q + t * 512 + lane * 8, qa); nt_store4u(u2q + t * 512 + lane * 8 + 4, qb);
            if (lane == 0) su2[t] = um * (1.0f / 127.0f);
        }
    }
}

template <int N> __device__ __forceinline__ void bitonic_desc(float (&v)[N]) {
#pragma unroll
    for (int k = 2; k <= N; k <<= 1)
#pragma unroll
        for (int j = k >> 1; j > 0; j >>= 1)
#pragma unroll
            for (int i = 0; i < N; ++i) { const int l = i ^ j; if (l > i) { const float x = v[i], y = v[l]; const float mx = fmaxf(x, y), mn = fminf(x, y); if ((i & k) == 0) { v[i] = mx; v[l] = mn; } else { v[i] = mn; v[l] = mx; } } }
}
__device__ __forceinline__ void bitonic_merge16_desc(float (&v)[16]) {
#pragma unroll
    for (int j = 8; j > 0; j >>= 1)
#pragma unroll
        for (int i = 0; i < 16; ++i) { const int l = i ^ j; if (l > i) { const float x = v[i], y = v[l]; v[i] = fmaxf(x, y); v[l] = fminf(x, y); } }
}
__device__ __forceinline__ void top16_of_128(float (&sc)[32], float (&top)[16]) {
    float lo[16], hi[16];
#pragma unroll
    for (int i = 0; i < 16; ++i) { lo[i] = sc[i]; hi[i] = sc[16 + i]; }
    bitonic_desc<16>(lo); bitonic_desc<16>(hi);
#pragma unroll
    for (int i = 0; i < 16; ++i) top[i] = fmaxf(lo[i], hi[15 - i]);
    bitonic_merge16_desc(top);
#pragma unroll
    for (int off = 16; off <= 32; off <<= 1) {
        float o[16];
#pragma unroll
        for (int i = 0; i < 16; ++i) o[i] = __shfl_xor(top[15 - i], off);
#pragma unroll
        for (int i = 0; i < 16; ++i) top[i] = fmaxf(top[i], o[i]);
        bitonic_merge16_desc(top);
    }
}
__device__ __forceinline__ void ce_carry(float& va, int& xa, float& vb, int& xb, bool desc) {
    const bool sw = desc ? (vb > va) : (vb < va);
    const float tv = sw ? vb : va, uv = sw ? va : vb; const int tx = sw ? xb : xa, ux = sw ? xa : xb;
    va = tv; vb = uv; xa = tx; xb = ux;
}
__device__ __forceinline__ void bitonic_merge16_desc_carry(float (&v)[16], int (&x)[16]) {
#pragma unroll
    for (int j = 8; j > 0; j >>= 1)
#pragma unroll
        for (int i = 0; i < 16; ++i) { const int l = i ^ j; if (l > i) ce_carry(v[i], x[i], v[l], x[l], true); }
}
constexpr int CAND_I[52] = {0,0,0,0,0,0,0,0,0,0,0,0,0,0,0,0,1,1,1,1,1,1,1,1,2,2,2,2,2,3,3,3,3,4,4,4,5,5,6,6,7,7,8,9,10,11,12,13,14,15,-1,-1};
constexpr int CAND_J[52] = {0,1,2,3,4,5,6,7,8,9,10,11,12,13,14,15,0,1,2,3,4,5,6,7,0,1,2,3,4,0,1,2,3,0,1,2,0,1,0,1,0,1,0,0,0,0,0,0,0,0,-1,-1};

__device__ __forceinline__ int rl_i(int v, int l) { return __builtin_amdgcn_readlane(v, l); }
__device__ __forceinline__ float rl_f(float v, int l) { return __int_as_float(__builtin_amdgcn_readlane(__float_as_int(v), l)); }
#define LANE_OF(k) ((((k) >> 3) & 1) * 32 + (((k) >> 2) & 1) * 16 + (((k) >> 1) & 1) * 8 + ((k) & 1) * 4)
constexpr size_t B_KEYSB = 15 * MiB;
constexpr size_t B_QB = B_Y;

typedef float f32x2v __attribute__((ext_vector_type(2)));
#define PKFMA_LO(fv, xv, wsv) do { f32x2v _t; asm("v_cvt_pk_f32_fp8 %1, %2\n\tv_pk_fma_f32 %0, %3, %1, %0" : "+v"(fv), "=&v"(_t) : "v"(xv), "v"(wsv)); } while (0)
#define PKFMA_HI(fv, xv, wsv) do { f32x2v _t; asm("v_cvt_pk_f32_fp8_sdwa %1, %2 src0_sel:WORD_1\n\tv_pk_fma_f32 %0, %3, %1, %0" : "+v"(fv), "=&v"(_t) : "v"(xv), "v"(wsv)); } while (0)
#define FACC(i) (f2[((i) >> 3) * 4 + (((i) & 1) ? 2 : 0) + (((i) & 7) >> 2)][(((i) & 7) >> 1) & 1])
__device__ __forceinline__ void gather_token(const Params& p, int t, const int* sel_idx, const float* sel_g, int lane) {
    const bf16_t* x1 = (const bf16_t*)((const char*)p.ws + B_X1); const float* ada = p.ws + W_ADA;
    const char* uq = (const char*)p.ws + B_TQ; const char* vq = uq + (size_t)16384 * VROW; const char* u2q = (const char*)p.ws + B_U2Q;
    const __amdgpu_buffer_rsrc_t ursrc = __builtin_amdgcn_make_buffer_rsrc((void*)uq, 0, 16384 * VROW, 0x00020000);
    const __amdgpu_buffer_rsrc_t vrsrc = __builtin_amdgcn_make_buffer_rsrc((void*)vq, 0, 16384 * VROW, 0x00020000);
    const float* su2 = p.ws + W_SU2; const float* rsu = p.ws + W_SU; const float* rsv = p.ws + W_SV;
    const float* g2 = p.in[I_LN2G]; const float* b2 = p.in[I_LN2B];
    const int b = t / SL;
    unsigned ue[4], uo[4]; int us0, us1;
    {
        const uint4 ua_ = nt_load4u(u2q + (size_t)t * D + lane * 32), ub_ = nt_load4u(u2q + (size_t)t * D + lane * 32 + 16);
        const int4 ua = make_int4((int)ua_.x, (int)ua_.y, (int)ua_.z, (int)ua_.w), ub = make_int4((int)ub_.x, (int)ub_.y, (int)ub_.z, (int)ub_.w);
        ue[0] = __builtin_amdgcn_perm((unsigned)ua.y, (unsigned)ua.x, 0x06040200u); uo[0] = __builtin_amdgcn_perm((unsigned)ua.y, (unsigned)ua.x, 0x07050301u);
        ue[1] = __builtin_amdgcn_perm((unsigned)ua.w, (unsigned)ua.z, 0x06040200u); uo[1] = __builtin_amdgcn_perm((unsigned)ua.w, (unsigned)ua.z, 0x07050301u);
        ue[2] = __builtin_amdgcn_perm((unsigned)ub.y, (unsigned)ub.x, 0x06040200u); uo[2] = __builtin_amdgcn_perm((unsigned)ub.y, (unsigned)ub.x, 0x07050301u);
        ue[3] = __builtin_amdgcn_perm((unsigned)ub.w, (unsigned)ub.z, 0x06040200u); uo[3] = __builtin_amdgcn_perm((unsigned)ub.w, (unsigned)ub.z, 0x07050301u);
        us0 = __builtin_amdgcn_sdot4(ua.x, 0x01010101, 0, false); us0 = __builtin_amdgcn_sdot4(ua.y, 0x01010101, us0, false); us0 = __builtin_amdgcn_sdot4(ua.z, 0x01010101, us0, false); us0 = __builtin_amdgcn_sdot4(ua.w, 0x01010101, us0, false);
        us1 = __builtin_amdgcn_sdot4(ub.x, 0x01010101, 0, false); us1 = __builtin_amdgcn_sdot4(ub.y, 0x01010101, us1, false); us1 = __builtin_amdgcn_sdot4(ub.z, 0x01010101, us1, false); us1 = __builtin_amdgcn_sdot4(ub.w, 0x01010101, us1, false);
    }
    const float s2 = su2[t];
    f32x2v f2[16];
#pragma unroll
    for (int i = 0; i < 16; ++i) f2[i] = (f32x2v){0.f, 0.f};
    float fb0 = 0.f, fb1 = 0.f;
    const int kk8 = ((lane >> 5) & 1) * 4 + ((lane >> 4) & 1) * 2 + ((lane >> 3) & 1);
#define LANE_OF8(k) ((((k) >> 2) & 1) * 32 + (((k) >> 1) & 1) * 16 + ((k) & 1) * 8)
    int e_cur = sel_idx[kk8]; float g_cur = sel_g[kk8];
    uint4 un[8]; unsigned usc[8];
#pragma unroll
    for (int k = 0; k < 8; ++k) { const int ro = rl_i(e_cur, LANE_OF8(k)) * VROW; un[k] = __builtin_bit_cast(uint4, __builtin_amdgcn_raw_buffer_load_b128(ursrc, lane * 16, ro, 0)); usc[k] = __builtin_amdgcn_raw_buffer_load_b16(ursrc, 1024 + lane * 2, ro, 0); }
#pragma unroll 1
    for (int bt = 0; bt < 16; ++bt) {
        uint4 vn[8]; unsigned vsc[8];
#pragma unroll
        for (int k = 0; k < 8; ++k) { const int ro = rl_i(e_cur, LANE_OF8(k)) * VROW; vn[k] = __builtin_bit_cast(uint4, __builtin_amdgcn_raw_buffer_load_b128(vrsrc, lane * 16, ro, 0)); vsc[k] = __builtin_amdgcn_raw_buffer_load_b16(vrsrc, 1024 + lane * 2, ro, 0); }
        __builtin_amdgcn_sched_barrier(0);
        float part[8];
#pragma unroll
        for (int k = 0; k < 8; ++k) {
            const uint4 nq = un[k]; const unsigned scw = usc[k];
            int d0 = __builtin_amdgcn_sdot4((int)ue[0], (int)(nq.x & 0x0F0F0F0Fu), -8 * us0, false); d0 = __builtin_amdgcn_sdot4((int)uo[0], (int)((nq.x >> 4) & 0x0F0F0F0Fu), d0, false);
            d0 = __builtin_amdgcn_sdot4((int)ue[1], (int)(nq.y & 0x0F0F0F0Fu), d0, false); d0 = __builtin_amdgcn_sdot4((int)uo[1], (int)((nq.y >> 4) & 0x0F0F0F0Fu), d0, false);
            int d1 = __builtin_amdgcn_sdot4((int)ue[2], (int)(nq.z & 0x0F0F0F0Fu), -8 * us1, false); d1 = __builtin_amdgcn_sdot4((int)uo[2], (int)((nq.z >> 4) & 0x0F0F0F0Fu), d1, false);
            d1 = __builtin_amdgcn_sdot4((int)ue[3], (int)(nq.w & 0x0F0F0F0Fu), d1, false); d1 = __builtin_amdgcn_sdot4((int)uo[3], (int)((nq.w >> 4) & 0x0F0F0F0Fu), d1, false);
            { const f32x2v sc2 = __builtin_amdgcn_cvt_pk_f32_fp8((int)scw, false); part[k] = (float)d0 * sc2[0] + (float)d1 * sc2[1]; }
            __builtin_amdgcn_sched_barrier(0);
        }
        const int bn = (bt + 1) & 15;
        const int e_nxt = sel_idx[bn * 8 + kk8]; const float g_nxt = sel_g[bn * 8 + kk8];
#pragma unroll
        for (int k = 0; k < 8; ++k) { const int ro = rl_i(e_nxt, LANE_OF8(k)) * VROW; un[k] = __builtin_bit_cast(uint4, __builtin_amdgcn_raw_buffer_load_b128(ursrc, lane * 16, ro, 0)); usc[k] = __builtin_amdgcn_raw_buffer_load_b16(ursrc, 1024 + lane * 2, ro, 0); }
        __builtin_amdgcn_sched_barrier(0);
        { const bool up = (lane & 32) != 0;
#pragma unroll
          for (int i = 0; i < 4; ++i) { const float keep = up ? part[i + 4] : part[i], send = up ? part[i] : part[i + 4]; part[i] = keep + __shfl_xor(send, 32); } }
        { const bool up = (lane & 16) != 0;
#pragma unroll
          for (int i = 0; i < 2; ++i) { const float keep = up ? part[i + 2] : part[i], send = up ? part[i] : part[i + 2]; part[i] = keep + __shfl_xor(send, 16); } }
        { const bool up = (lane & 8) != 0;
          const float keep = up ? part[1] : part[0], send = up ? part[0] : part[1]; part[0] = keep + __shfl_xor(send, 8); }
        float tot = part[0]; tot += __shfl_xor(tot, 1); tot += __shfl_xor(tot, 2); tot += __shfl_xor(tot, 4);
        const float dt = tot * s2 * rsu[e_cur];
        const float act = 0.5f * dt * (1.0f + erff(dt * 0.7071067811865476f));
        const float w_l = g_cur * act * rsv[e_cur];
#pragma unroll
        for (int k = 0; k < 8; ++k) {
            const float w = rl_f(w_l, LANE_OF8(k));
            const unsigned scw = vsc[k];
            const f32x2v sc2 = __builtin_amdgcn_cvt_pk_f32_fp8((int)scw, false); const float ws0 = w * sc2[0], ws1 = w * sc2[1];
            fb0 += ws0; fb1 += ws1;
            const f32x2v wp0 = {ws0 * 512.f, ws0 * 512.f}, wp1 = {ws1 * 512.f, ws1 * 512.f};
            const unsigned wd[4] = {vn[k].x, vn[k].y, vn[k].z, vn[k].w};
#pragma unroll
            for (int q = 0; q < 4; ++q) {
                const unsigned ev = wd[q] & 0x0F0F0F0Fu, od = (wd[q] >> 4) & 0x0F0F0F0Fu;
                if (q < 2) { PKFMA_LO(f2[q * 4 + 0], ev, wp0); PKFMA_HI(f2[q * 4 + 1], ev, wp0); PKFMA_LO(f2[q * 4 + 2], od, wp0); PKFMA_HI(f2[q * 4 + 3], od, wp0); }
                else       { PKFMA_LO(f2[q * 4 + 0], ev, wp1); PKFMA_HI(f2[q * 4 + 1], ev, wp1); PKFMA_LO(f2[q * 4 + 2], od, wp1); PKFMA_HI(f2[q * 4 + 3], od, wp1); }
            }
        }
        e_cur = e_nxt; g_cur = g_nxt;
    }
#undef LANE_OF8
    asm volatile("" ::: "memory");
    float v[32]; float s = 0.f;
#pragma unroll
    for (int q = 0; q < 8; ++q) {
        const int col = q * 256 + lane * 4, o = q * 4;
        const uint2 xb = nt_load2u(x1 + (size_t)t * D + col); const float4 gt = *(const float4*)(ada + b * 12288 + 5 * 2048 + col);
        const float4 xv = make_float4(__uint_as_float(xb.x << 16), __uint_as_float(xb.x & 0xffff0000u), __uint_as_float(xb.y << 16), __uint_as_float(xb.y & 0xffff0000u));
        const float fbh = 8.f * (q < 4 ? fb0 : fb1);
        v[o] = ALPHA * xv.x + gt.x * (FACC(o) - fbh); v[o + 1] = ALPHA * xv.y + gt.y * (FACC(o + 1) - fbh);
        v[o + 2] = ALPHA * xv.z + gt.z * (FACC(o + 2) - fbh); v[o + 3] = ALPHA * xv.w + gt.w * (FACC(o + 3) - fbh);
        s += (v[o] + v[o + 1]) + (v[o + 2] + v[o + 3]);
    }
    const float mean = wave_sum(s) * (1.0f / 2048.0f);
    float q2 = 0.f;
#pragma unroll
    for (int i = 0; i < 32; ++i) { v[i] -= mean; q2 += v[i] * v[i]; }
    const float rstd = rsqrtf(wave_sum(q2) * (1.0f / 2048.0f) + LN_EPS);
    asm volatile("" ::: "memory");
#pragma unroll
    for (int q = 0; q < 8; ++q) {
        const int col = q * 256 + lane * 4, o = q * 4;
        const float4 gv = *(const float4*)(g2 + col), bv = *(const float4*)(b2 + col);
        nt_store4(p.out + (size_t)t * D + col, v[o] * rstd * gv.x + bv.x, v[o + 1] * rstd * gv.y + bv.y, v[o + 2] * rstd * gv.z + bv.z, v[o + 3] * rstd * gv.w + bv.w);
    }
}

__device__ __forceinline__ void phase_jk(const Params& p, unsigned char* smem) {
    const int tid0 = opaque_tid();
    const bf16_t* qb = (const bf16_t*)((const char*)p.ws + B_QB); const bf16_t* keysb = (const bf16_t*)((const char*)p.ws + B_KEYSB);
    int* sel_idx = (int*)smem; float* sel_g = (float*)(smem + 8192);
#pragma unroll 1
    for (int item = blockIdx.x; item < NT / 16; item += gridDim.x) {
        int tid = tid0; asm volatile("" : "+v"(tid));
        const int lane = tid & 63, wv = tid >> 6, ql = lane & 15, g = lane >> 4;
        const int t0 = item * 16, h = wv;
        __syncthreads();
        float ta[16], tb[16];
#pragma unroll
        for (int i = 0; i < 16; ++i) { ta[i] = 0.f; tb[i] = 0.f; }
#pragma unroll 1
        for (int pp = 0; pp < 2; ++pp) {
            const bf16_t* qrow = qb + ((size_t)((((t0 >> 4) * 8 + h) * 2 + pp) * 4) * 64 + lane) * 8;
            bf16x8v qf[4];
#pragma unroll
            for (int kc = 0; kc < 4; ++kc) qf[kc] = __builtin_nontemporal_load((const bf16x8v*)(qrow + kc * 512));
            const bf16_t* kbase = keysb + (size_t)((h * 2 + pp) * 8) * 2048 + lane * 8;
            float sc[32];
#pragma unroll
            for (int nb = 0; nb < 8; ++nb) {
                f32x4v acc = {0.f, 0.f, 0.f, 0.f};
#pragma unroll
                for (int kc = 0; kc < 4; ++kc) acc = __builtin_amdgcn_mfma_f32_16x16x32_bf16(*(const bf16x8v*)(kbase + (nb * 4 + kc) * 512), qf[kc], acc, 0, 0, 0);
#pragma unroll
                for (int rr = 0; rr < 4; ++rr) sc[nb * 4 + rr] = __int_as_float((__float_as_int(acc[rr]) & ~127) | (16 * nb + 4 * g + rr));
                if (nb == 3) asm volatile("" ::: "memory");
            }
            float top[16];
            top16_of_128(sc, top);
#pragma unroll
            for (int i = 0; i < 16; ++i) { if (pp == 0) ta[i] = top[i]; else tb[i] = top[i]; }
        }
        float cv[16]; int cx[16];
#pragma unroll
        for (int sidx = 0; sidx < 13; ++sidx) {
            float vv[4]; int xx[4];
#pragma unroll
            for (int q = 0; q < 4; ++q) {
                const int ci = CAND_I[4 * sidx + q], cj = CAND_J[4 * sidx + q];
                if (ci >= 0) { vv[q] = ta[ci] + tb[cj]; xx[q] = ((__float_as_int(ta[ci]) & 127) << 7) | (__float_as_int(tb[cj]) & 127); } else { vv[q] = -3.0e38f; xx[q] = 0; }
            }
            cv[sidx] = g == 0 ? vv[0] : (g == 1 ? vv[1] : (g == 2 ? vv[2] : vv[3]));
            cx[sidx] = g == 0 ? xx[0] : (g == 1 ? xx[1] : (g == 2 ? xx[2] : xx[3]));
        }
#pragma unroll
        for (int sidx = 13; sidx < 16; ++sidx) { cv[sidx] = -3.0e38f; cx[sidx] = 0; }
#pragma unroll
        for (int k = 2; k <= 16; k <<= 1)
#pragma unroll
            for (int j = k >> 1; j > 0; j >>= 1)
#pragma unroll
                for (int i = 0; i < 16; ++i) { const int l = i ^ j; if (l > i) ce_carry(cv[i], cx[i], cv[l], cx[l], (i & k) == 0); }
#pragma unroll
        for (int off = 16; off <= 32; off <<= 1) {
            float ov[16]; int ox[16];
#pragma unroll
            for (int i = 0; i < 16; ++i) { ov[i] = __shfl_xor(cv[15 - i], off); ox[i] = __shfl_xor(cx[15 - i], off); }
#pragma unroll
            for (int i = 0; i < 16; ++i) { const bool tk = ov[i] > cv[i]; cv[i] = tk ? ov[i] : cv[i]; cx[i] = tk ? ox[i] : cx[i]; }
            bitonic_merge16_desc_carry(cv, cx);
        }
        {
            float ex[16]; float sum = 0.f;
#pragma unroll
            for (int i = 0; i < 16; ++i) { ex[i] = __expf(cv[i] - cv[0]); sum += ex[i]; }
            const float inv = 1.0f / sum;
            if (g == 0) {
#pragma unroll
                for (int q = 0; q < 4; ++q) {
                    *(int4*)(sel_idx + ql * 128 + h * 16 + q * 4) = make_int4(cx[q * 4], cx[q * 4 + 1], cx[q * 4 + 2], cx[q * 4 + 3]);
                    *(float4*)(sel_g + ql * 128 + h * 16 + q * 4) = make_float4(ex[q * 4] * inv, ex[q * 4 + 1] * inv, ex[q * 4 + 2] * inv, ex[q * 4 + 3] * inv);
                }
            }
        }
        __syncthreads();
#pragma unroll 1
        for (int k = 0; k < 2; ++k) { int lane2 = lane; asm volatile("" : "+v"(lane2)); gather_token(p, t0 + 2 * wv + k, sel_idx + (2 * wv + k) * 128, sel_g + (2 * wv + k) * 128, lane2); }
    }
}

__device__ __forceinline__ void map_tile(int L, int nM, int nN, int& pm, int& pn) {
    const int nwg = nM * nN; int wgid = L;
    { const int q = nwg / 8, r = nwg % 8, xcd = wgid % 8, off = wgid / 8; wgid = (xcd < r ? xcd * (q + 1) : r * (q + 1) + (xcd - r) * q) + off; }
    const int nig = 8 * nN, gid = wgid / nig, fm = gid * 8, gsz = (nM - fm) < 8 ? (nM - fm) : 8;
    pm = fm + ((wgid % nig) % gsz); pn = (wgid % nig) / gsz;
}
struct ProjOrder {
    int G, c; const bf16_t* ub; const bf16_t* wint;
    __device__ bool next(int i, pg8::Unit& u) const {
        const int L = i * G + c; if (L >= 800) return false;
        if (L < 384) { u.kind = 0; map_tile(L, 12, 32, u.pm, u.pn); }
        else if (L < 512) { u.kind = 1; map_tile(L - 384, 4, 32, u.pm, u.pn); }
        else if (L < 768) { u.kind = 2; map_tile(L - 512, 32, 8, u.pm, u.pn); }
        else if (L < 784) { u.kind = 3; u.pm = (L - 768) >> 2; u.pn = (L - 768) & 3; }
        else { u.kind = 4; u.pm = (L - 784) >> 2; u.pn = (L - 784) & 3; }
        return true;
    }
    __device__ __forceinline__ void a_ready(const pg8::Unit&) const {}
    __device__ __forceinline__ void done(const pg8::Unit&) const {}
    template <class G_> __device__ __forceinline__ const char* pa(const G_&, const pg8::Unit& u) const {
        const size_t ts = (size_t)256 * D * 2;
        switch (u.kind) { case 0: return (const char*)wint + (size_t)u.pm * ts; case 1: return (const char*)wint + (size_t)(20 + u.pm) * ts; case 2: return (const char*)ub + (size_t)u.pm * ts;
                          case 3: return (const char*)ub + (size_t)(32 + u.pm) * ts; default: return (const char*)wint + (size_t)(20 + u.pm) * ts; }
    }
    template <class G_> __device__ __forceinline__ const char* pb(const G_&, const pg8::Unit& u) const {
        const size_t ts = (size_t)256 * D * 2;
        switch (u.kind) { case 0: case 1: return (const char*)ub + (size_t)u.pn * ts; case 2: return (const char*)wint + (size_t)(12 + u.pn) * ts;
                          case 3: return (const char*)wint + (size_t)(16 + u.pn) * ts; default: return (const char*)ub + (size_t)(32 + u.pn) * ts; }
    }
};
struct EpiProj {
    static constexpr bool PERM = true, AFTER_DRAIN = false;
    unsigned char* ws;
    __device__ __forceinline__ void operator()(const pg8::f32x4 (&acc)[2][2][4][2], const pg8::Unit& u, int wr, int wc, int fr, int fq) const {
        bf16_t* const zT = (bf16_t*)(ws + B_ZT); bf16_t* const vT = (bf16_t*)(ws + B_VT); bf16_t* const qh = (bf16_t*)(ws + B_QH); bf16_t* const kh = (bf16_t*)(ws + B_KH);
        bf16_t* const kch = (bf16_t*)(ws + B_KCH); bf16_t* const vcT = (bf16_t*)(ws + B_VCT);
#pragma unroll
        for (int ai = 0; ai < 2; ++ai)
#pragma unroll
            for (int m = 0; m < 4; ++m) {
                const int r = u.pm * 256 + ai * 128 + wr * 64 + m * 16 + fr;
#pragma unroll
                for (int bj = 0; bj < 2; ++bj) {
                    const int cc = u.pn * 256 + bj * 128 + wc * 32 + 8 * fq;
                    bf16_t* dst;
                    if (u.kind == 0) dst = zT + (size_t)r * NT + cc;
                    else if (u.kind == 1) {
                        const int bb = cc >> 11, t = cc & 2047, hh = r >> 6, dd = r & 63;
                        dst = vT + (size_t)((bb * 16 + hh) * 256 + (t >> 3)) * 512 + (dd >> 4) * 128 + (dd & 15) * 8;
                    } else if (u.kind == 2) {
                        const int bb = r >> 11, t = r & 2047, hc = cc & 1023, hh = hc >> 6, dd = hc & 63;
                        if (cc < 1024) dst = qh + ((size_t)((bb * 16 + hh) * SL + t)) * 64 + dd;
                        else dst = kh + (size_t)((bb * 16 + hh) * 256 + (t >> 3)) * 512 + (dd >> 5) * 256 + ((t & 7) >> 2) * 128 + ((dd & 31) >> 3) * 32 + (t & 3) * 8;
                    } else if (u.kind == 3) {
                        const int bb = r >> 8, jj = r & 255, hh = cc >> 6, dd = cc & 63;
                        dst = kch + (size_t)((bb * 16 + hh) * 32 + (jj >> 3)) * 512 + (dd >> 5) * 256 + ((jj & 7) >> 2) * 128 + ((dd & 31) >> 3) * 32 + (jj & 3) * 8;
                    } else {
                        const int bb = cc >> 8, jj = cc & 255, hh = r >> 6, dd = r & 63;
                        dst = vcT + (size_t)((bb * 16 + hh) * 32 + (jj >> 3)) * 512 + (dd >> 4) * 128 + (dd & 15) * 8;
                    }
                    const pg8::f32x4 v0 = acc[ai][bj][m][0], v1 = acc[ai][bj][m][1];
                    pg8::u32x4 w; w.x = pg8::cvt_pk_bf16(v0[0], v0[1]); w.y = pg8::cvt_pk_bf16(v0[2], v0[3]); w.z = pg8::cvt_pk_bf16(v1[0], v1[1]); w.w = pg8::cvt_pk_bf16(v1[2], v1[3]);
                    *(pg8::u32x4*)dst = w;
                }
            }
    }
};

struct EpiQFrag {
    static constexpr bool PERM = true, AFTER_DRAIN = false;
    bf16_t* O;
    __device__ __forceinline__ void operator()(const pg8::f32x4 (&acc)[2][2][4][2], const pg8::Unit& u, int wr, int wc, int fr, int fq) const {
#pragma unroll
        for (int ai = 0; ai < 2; ++ai)
#pragma unroll
            for (int m = 0; m < 4; ++m) {
                const int t = u.pm * 256 + ai * 128 + wr * 64 + m * 16 + fr;
#pragma unroll
                for (int bj = 0; bj < 2; ++bj) {
                    const int c = u.pn * 256 + bj * 128 + wc * 32 + 8 * fq;
                    const int hh = c >> 8, pp = (c >> 7) & 1, d = c & 127;
                    bf16_t* dst = O + ((size_t)(((((t >> 4) * 8 + hh) * 2 + pp) * 4 + (d >> 5)) * 64 + ((d & 31) >> 3) * 16 + (t & 15))) * 8;
                    const pg8::f32x4 v0 = acc[ai][bj][m][0], v1 = acc[ai][bj][m][1];
                    pg8::u32x4 w; w.x = pg8::cvt_pk_bf16(v0[0], v0[1]); w.y = pg8::cvt_pk_bf16(v0[2], v0[3]); w.z = pg8::cvt_pk_bf16(v1[0], v1[1]); w.w = pg8::cvt_pk_bf16(v1[2], v1[3]);
                    __builtin_nontemporal_store(w, (pg8::u32x4*)dst);
                }
            }
    }
};

#define XB_TMO      128
#define XB_XCNT(j)  (256  + 64 * (j))
#define XB_XSUB(j)  (1280 + 64 * (j))
#define XB_XGEN(j)  (2304 + 64 * (j))
#define XB_TOP      3328
#define XB_TOPGEN   3392
#define XCD_BAR_WORDS 3456
#define XB_SPIN_CAP (1u << 18)
#define LAS __attribute__((address_space(3)))

__device__ __forceinline__ unsigned xb_ld(unsigned* p)              { return __hip_atomic_load(p, __ATOMIC_RELAXED, __HIP_MEMORY_SCOPE_AGENT); }
__device__ __forceinline__ unsigned xb_add(unsigned* p, unsigned v) { return __hip_atomic_fetch_add(p, v, __ATOMIC_RELAXED, __HIP_MEMORY_SCOPE_AGENT); }
__device__ __forceinline__ unsigned xb_xcc_id() { return (unsigned)__builtin_amdgcn_s_getreg((3 << 11) | 20) & 0xFu; }
#define XB_SPIN(cond, bar) do { unsigned _sp = 0; while (cond) { __builtin_amdgcn_s_sleep(1); \
    if ((++_sp & 255u) == 0u) { if (xb_ld(&(bar)[XB_TMO])) break; if (_sp > XB_SPIN_CAP) { atomicAdd(&(bar)[XB_TMO], 1u); break; } } } } while (0)

struct XcdBarrier {
    unsigned* bar; unsigned x;
    volatile LAS unsigned* st;
};

__device__ __forceinline__ XcdBarrier xcd_barrier_post(unsigned* bar, volatile LAS unsigned* st) {
    XcdBarrier b; b.bar = bar; b.x = xb_xcc_id(); b.st = st;
    if (threadIdx.x == 0) (void)xb_add(&bar[XB_XCNT(b.x)], 1u);
    return b;
}
__device__ __forceinline__ void xcd_barrier_complete(unsigned* bar, unsigned x, unsigned& nloc, unsigned& nx) {
    const unsigned G = gridDim.x * gridDim.y * gridDim.z;
    unsigned sum, cnt, mine, sp = 0u;
    for (;;) {
        sum = 0u; cnt = 0u; mine = 0u;
#pragma unroll
        for (unsigned j = 0; j < 16; ++j) { const unsigned c = xb_ld(&bar[XB_XCNT(j)]); sum += c; cnt += (c > 0u) ? 1u : 0u; mine = (j == x) ? c : mine; }
        if (sum == G) break;
        __builtin_amdgcn_s_sleep(1);
        if ((++sp & 255u) == 0u) { if (xb_ld(&bar[XB_TMO])) break; if (sp > XB_SPIN_CAP) { atomicAdd(&bar[XB_TMO], 1u); break; } }
    }
    nloc = mine > 0u ? mine : 1u; nx = cnt > 0u ? cnt : 1u;
}

__device__ __forceinline__ void xcd_barrier(const XcdBarrier& b) {
    asm volatile("s_waitcnt vmcnt(0)" ::: "memory");
    __syncthreads();
    if (threadIdx.x == 0) {
        unsigned* bar = b.bar;
        __builtin_amdgcn_s_waitcnt(0);
        unsigned nloc = b.st[0], nx = b.st[1];
        if (nloc == 0u) { xcd_barrier_complete(bar, b.x, nloc, nx); b.st[0] = nloc; b.st[1] = nx; }
        const unsigned old = xb_add(&bar[XB_XSUB(b.x)], 1u);
        const unsigned gen = old / nloc;
        if (old + 1u == (gen + 1u) * nloc) {
            __builtin_amdgcn_fence(__ATOMIC_RELEASE, "agent");
            asm volatile("s_waitcnt vmcnt(0)" ::: "memory");
            const unsigned og = xb_add(&bar[XB_TOP], 1u);
            const unsigned tg = og / nx;
            if (og + 1u == (tg + 1u) * nx) xb_add(&bar[XB_TOPGEN], 1u);
            else XB_SPIN(xb_ld(&bar[XB_TOPGEN]) == tg, bar);
            __builtin_amdgcn_fence(__ATOMIC_ACQUIRE, "agent");
            xb_add(&bar[XB_XGEN(b.x)], 1u);
            asm volatile("s_waitcnt vmcnt(0)" ::: "memory");
        } else {
            XB_SPIN(xb_ld(&bar[XB_XGEN(b.x)]) == gen, bar);
            __builtin_amdgcn_fence(__ATOMIC_ACQUIRE, "agent");
            asm volatile("s_waitcnt vmcnt(0)" ::: "memory");
        }
    }
    __syncthreads();
}
constexpr size_t B_BAR = 14 * MiB;

__global__ void __launch_bounds__(NTHREADS) fwd_megakernel(Params p) {
    extern __shared__ __attribute__((aligned(16))) unsigned char smem[];
    float* lds = (float*)smem; float* red = (float*)(smem + RED_OFF);
    PG8_LAS unsigned char* glds = (PG8_LAS unsigned char*)smem;
    volatile LAS unsigned* xst = (volatile LAS unsigned*)(smem + LDS_BYTES - 16);
    if (threadIdx.x < 4) xst[threadIdx.x] = 0u;
    __syncthreads();
    XcdBarrier xb = xcd_barrier_post((unsigned*)((char*)p.ws + B_BAR), xst);
    bf16_t* wint = (bf16_t*)((char*)p.ws + B_WINT); bf16_t* woutt = (bf16_t*)((char*)p.ws + B_WOUTT); bf16_t* wqt = (bf16_t*)((char*)p.ws + B_WQT);
    bf16_t* ub = (bf16_t*)((char*)p.ws + B_UB);
    phase_a(p, lds);
    transpose_convert(p.in[I_WIN], wint, D, DPROJ, lds, 0, (int)gridDim.x);
    phase_filters(p, lds);
    {
        const float* ks = p.in[I_KEYS]; bf16_t* kd = (bf16_t*)((char*)p.ws + B_KEYSB);
        for (int e = blockIdx.x * NTHREADS + threadIdx.x; e < 16 * 128 * 128 / 4; e += gridDim.x * NTHREADS) {
            const float4 v = *(const float4*)(ks + e * 4); uint2 o; o.x = pk_bf16(v.x, v.y); o.y = pk_bf16(v.z, v.w);
            const int d = (e * 4) & 127, n = ((e * 4) >> 7) & 127, hp = (e * 4) >> 14;
            *(uint2*)(kd + ((size_t)(((hp * 8 + (n >> 4)) * 4 + (d >> 5)) * 64 + ((d & 31) >> 3) * 16 + (n & 15))) * 8 + (d & 7)) = o;
        }
    }
    xcd_barrier(xb);
    phase_b(p);
    xcd_barrier(xb);
    phase_c(p);
    xcd_barrier(xb);
    {
        pg8::Gemm g{ub, wint, NT + NTC, DPROJ, D}; ProjOrder S{(int)gridDim.x, (int)blockIdx.x, ub, wint};
        EpiProj E{(unsigned char*)p.ws};
        pg8::gemm_phase<EpiProj, ProjOrder>(glds, g, S, E, nullptr);
    }
    if (gridDim.x == 256 && blockIdx.x >= 32) {
        quant_tables(p, 32, 224);
        transpose_convert(p.in[I_WOUT], woutt, D, D, lds, 32, 224);
        transpose_convert(p.in[I_WQ], wqt, D, D, lds, 32, 224);
    } else if (gridDim.x != 256) {
        quant_tables(p, 0, (int)gridDim.x);
        transpose_convert(p.in[I_WOUT], woutt, D, D, lds, 0, (int)gridDim.x);
        transpose_convert(p.in[I_WQ], wqt, D, D, lds, 0, (int)gridDim.x);
    }
    xcd_barrier(xb);
    phase_hyena(p, smem);
    phase_na(p, smem);
    xcd_barrier(xb);
    phase_f(p, lds);
    xcd_barrier(xb);
    {
        pg8::Gemm g{ub, woutt, NT, D, D}; pg8::StaticOrder S; S.init(NT, D, (int)gridDim.x, (int)blockIdx.x);
        pg8::EpiBf16<0> E{(bf16_t*)((char*)p.ws + B_Y), D, nullptr, 0, 0};
        pg8::gemm_phase<pg8::EpiBf16<0>, pg8::StaticOrder>(glds, g, S, E, nullptr);
    }
    xcd_barrier(xb);
    phase_h(p);
    xcd_barrier(xb);
    {
        pg8::Gemm g{ub, wqt, NT, D, D}; pg8::StaticOrder S; S.init(NT, D, (int)gridDim.x, (int)blockIdx.x);
        EpiQFrag E{(bf16_t*)((char*)p.ws + B_QB)};
        pg8::gemm_phase<EpiQFrag, pg8::StaticOrder>(glds, g, S, E, nullptr);
    }
    xcd_barrier(xb);
    phase_jk(p, smem);
}

extern "C" void kernel_launch(void* const* d_in, const int* in_sizes, int n_in, void* d_out, int out_size, void* d_ws, size_t ws_size, hipStream_t stream) {
    static int grid_blocks = 0;
    if (grid_blocks == 0) {
        if (n_in != N_IN || out_size != NT * D || ws_size < W_END * sizeof(float)) {
            fprintf(stderr, "kernel_launch: unexpected shapes: n_in %d out %d ws %zu (need %zu)\n", n_in, out_size, ws_size, (size_t)W_END * 4); grid_blocks = -1; return; }
        int dev = 0, cus = 0, per_cu = 0;
        hipGetDevice(&dev);
        hipDeviceGetAttribute(&cus, hipDeviceAttributeMultiprocessorCount, dev);
        if (hipFuncSetAttribute((const void*)fwd_megakernel, hipFuncAttributeMaxDynamicSharedMemorySize, LDS_BYTES) != hipSuccess) { fprintf(stderr, "kernel_launch: hipFuncSetAttribute failed\n"); grid_blocks = -1; return; }
        if (hipOccupancyMaxActiveBlocksPerMultiprocessor(&per_cu, (const void*)fwd_megakernel, NTHREADS, LDS_BYTES) != hipSuccess || per_cu < 1) { fprintf(stderr, "kernel_launch: occupancy query failed (%d)\n", per_cu); (void)hipGetLastError(); grid_blocks = -1; return; }
        grid_blocks = cus * (per_cu > 1 ? 1 : per_cu);
        fprintf(stderr, "kernel_launch: cus %d per_cu %d grid %d\n", cus, per_cu, grid_blocks);
    }
    if (grid_blocks < 0) return;
    Params p{};
    for (int i = 0; i < N_IN; ++i) p.in[i] = (const float*)d_in[i];
    p.out = (float*)d_out; p.ws = (float*)d_ws;
    if (hipMemsetAsync((char*)d_ws + B_BAR, 0, XCD_BAR_WORDS * sizeof(unsigned), stream) != hipSuccess) { fprintf(stderr, "kernel_launch: memset failed\n"); return; }
    void* args[] = {&p};
    hipLaunchKernelGGL(fwd_megakernel, dim3(grid_blocks), dim3(NTHREADS), LDS_BYTES, stream, p);
    const hipError_t e = hipPeekAtLastError();
    if (e != hipSuccess) fprintf(stderr, "launch failed: %s (grid %d)\n", hipGetErrorString(e), grid_blocks);
}
```

```cpp
#include <hip/hip_runtime.h>
#include <hip/hip_cooperative_groups.h>
#include <cstdio>
namespace cg = cooperative_groups;

constexpr int D = 2048, NB = 4, SL = 2048, NT = NB * SL, CL = 256, NTC = NB * CL;
constexpr int DHY = 1024, DNA = 1024, DPROJ = 6144, OFFQ = 3072, OFFK = 4096, OFFV = 5120;
constexpr int NTHREADS = 512, NWAVES = 8;
constexpr float LN_EPS = 1e-5f;
constexpr float ALPHA = 1.189207115002721f;

enum { I_X = 0, I_C, I_CTX, I_CCTX, I_WADA, I_BADA, I_WIN, I_CONVW, I_CONVB, I_FW1, I_FB1, I_FW2, I_FB2, I_FW3, I_FB3, I_FW4,
       I_FREQ, I_SKIP, I_RPB, I_GHY, I_GNA, I_WOUT, I_LN1G, I_LN1B, I_WQ, I_KEYS, I_PU, I_PV, I_LN2G, I_LN2B, N_IN };

constexpr size_t W_ADAP = 0;
constexpr size_t W_ADA  = W_ADAP + 32 * 5 * 12288;
constexpr size_t W_FS   = W_ADA + 5 * 12288;
constexpr size_t W_SP   = W_FS + 4096;
constexpr size_t W_SU   = W_SP + 32 * 4096;
constexpr size_t W_SV   = W_SU + 16384;
constexpr size_t W_SU2  = W_SV + 16384;
static_assert((W_SU2 + 8192) * 4 <= 14 * 1048576, "small region overflow");
constexpr size_t MiB = 1048576;
constexpr size_t B_WINT  = 16 * MiB;
constexpr size_t B_WOUTT = B_WINT + 24 * MiB;
constexpr size_t B_WQT   = B_WOUTT + 8 * MiB;
constexpr size_t B_UB    = B_WQT + 8 * MiB;
constexpr size_t B_ZT    = B_UB + 36 * MiB;
constexpr size_t B_VT    = B_ZT + 48 * MiB;
constexpr size_t B_QH    = B_VT + 16 * MiB;
constexpr size_t B_KH    = B_QH + 16 * MiB;
constexpr size_t B_KCH   = B_KH + 16 * MiB;
constexpr size_t B_VCT   = B_KCH + 2 * MiB;
constexpr size_t B_KF    = B_VCT + 2 * MiB;
constexpr size_t B_HRAW  = B_KF + 32 * MiB;
constexpr size_t B_HYT   = B_HRAW;
constexpr size_t B_NA    = B_HRAW + 16 * MiB;
constexpr size_t B_Y     = B_HRAW + 32 * MiB;
constexpr size_t B_X1    = B_Y + 64 * MiB;
constexpr size_t B_U2Q   = B_X1 + 64 * MiB;
constexpr size_t B_TQ    = B_U2Q + 16 * MiB;
constexpr size_t B_END   = B_TQ + 64 * MiB;
constexpr size_t W_KF = B_KF / 4, W_X1 = B_X1 / 4, W_HRAW = B_HRAW / 4, W_Y = B_Y / 4, W_END = B_END / 4;
static_assert(B_END <= 512 * MiB, "workspace");

constexpr int LDS_BYTES = 156 * 1024;
constexpr int RED_OFF = 155 * 1024;

struct Params { const float* in[N_IN]; float* out; float* ws; };

namespace pg8 {
#define PG8_LAS __attribute__((address_space(3)))
typedef unsigned short bf16_t;
typedef short bf16x8 __attribute__((ext_vector_type(8)));
typedef float f32x4 __attribute__((ext_vector_type(4)));
typedef unsigned u32x4 __attribute__((ext_vector_type(4)));
constexpr int BM = 256, BK = 64, HALF = 128, HTB = HALF * BK * 2  , STAGE_BYTES = 8 * HTB, NXCD = 8, WGM = 8;

__host__ __device__ __forceinline__ int lds_byte(int r, int c) { const int st = (r >> 4) * 2 + (c >> 5), rr = r & 15, cc = c & 31, ob = rr * 64 + cc * 2; return st * 1024 + (ob ^ (((ob >> 9) & 1) << 5)); }
__host__ __device__ __forceinline__ void stage_rc(int b, int& R, int& C) { const int st = b / 1024, sb = b % 1024, swz = sb ^ (((sb >> 9) & 1) << 5); R = (st >> 1) * 16 + swz / 64; C = (st & 1) * 32 + (swz % 64) / 2; }
__host__ __device__ __forceinline__ int perm32(int rho) { const int n = rho >> 4, i = rho & 15; return 8 * (i >> 2) + 4 * n + (i & 3); }

struct Unit { int pm, pn, kind; };
struct Gemm { const bf16_t* A; const bf16_t* Bt; int M, N, K; };

struct StaticOrder {
    int nM, nN, nwg, G, c;
    __host__ __device__ void init(int M, int N, int G_, int c_) { nM = M / BM; nN = N / BM; nwg = nM * nN; G = G_; c = c_; }
    __host__ __device__ bool next(int i, Unit& u) const {
        const long L = (long)i * G + c; if (L >= nwg) return false;
        int wgid = (int)L; { const int q = nwg / NXCD, r = nwg % NXCD, xcd = wgid % NXCD, off = wgid / NXCD; wgid = (xcd < r ? xcd * (q + 1) : r * (q + 1) + (xcd - r) * q) + off; }
        const int nig = WGM * nN, gid = wgid / nig, fm = gid * WGM, gsz = (nM - fm) < WGM ? (nM - fm) : WGM;
        u.pm = fm + ((wgid % nig) % gsz); u.pn = (wgid % nig) / gsz; return true;
    }
    __device__ __forceinline__ void a_ready(const Unit&) const {}
    __device__ __forceinline__ void done(const Unit&) const {}
    template <class G_> __device__ __forceinline__ const char* pa(const G_& g, const Unit& u) const { return (const char*)g.A + (size_t)u.pm * (size_t)(BM * 2) * g.K; }
    template <class G_> __device__ __forceinline__ const char* pb(const G_& g, const Unit& u) const { return (const char*)g.Bt + (size_t)u.pn * (size_t)(BM * 2) * g.K; }
};
__device__ __forceinline__ unsigned cvt_pk_bf16(float lo, float hi) { unsigned r; asm volatile("v_cvt_pk_bf16_f32 %0, %1, %2" : "=v"(r) : "v"(lo), "v"(hi)); return r; }
typedef float f32x2 __attribute__((ext_vector_type(2)));
__device__ __forceinline__ f32x2 gelu_pk(f32x2 v) {
    const f32x2 av = __builtin_elementwise_abs(v), d = av * 0.2316418882f + 1.0f;
    f32x2 t; t.x = __builtin_amdgcn_rcpf(d.x); t.y = __builtin_amdgcn_rcpf(d.y);
    f32x2 q = t * 0.5307027145f + (-0.7265760135f); q = q * t + 0.7107068705f; q = q * t + (-0.142248368f); q = q * t + 0.127414796f; q = q * t;
    const f32x2 s = (v * v) * (-0.72134752044f);
    f32x2 e; e.x = __builtin_amdgcn_exp2f(s.x); e.y = __builtin_amdgcn_exp2f(s.y);
    const f32x2 m = v * (q * e), r = v - m;
    f32x2 o; o.x = v.x < 0.f ? m.x : r.x; o.y = v.y < 0.f ? m.y : r.y; return o;
}

struct EpiF32 {
    static constexpr bool PERM = false, AFTER_DRAIN = false;
    float* C; int ldc; const float* bias;
    __device__ __forceinline__ void operator()(const f32x4 (&acc)[2][2][4][2], const Unit& u, int wr, int wc, int fr, int fq) const {
        const int row0 = u.pm * BM + wr * 64 + fr, col0 = u.pn * BM + wc * 32 + 4 * fq;
        f32x4 bv[2][2];
#pragma unroll
        for (int bj = 0; bj < 2; ++bj)
#pragma unroll
            for (int n = 0; n < 2; ++n) bv[bj][n] = bias ? *(const f32x4*)(bias + col0 + bj * HALF + n * 16) : (f32x4){0.f, 0.f, 0.f, 0.f};
#pragma unroll
        for (int ai = 0; ai < 2; ++ai)
#pragma unroll
            for (int m = 0; m < 4; ++m) { float* rowp = C + (size_t)(row0 + ai * HALF + m * 16) * ldc + col0;
#pragma unroll
                for (int bj = 0; bj < 2; ++bj)
#pragma unroll
                    for (int n = 0; n < 2; ++n) *(f32x4*)(rowp + bj * HALF + n * 16) = acc[ai][bj][m][n] + bv[bj][n]; }
    }
};
template <int ACT  > struct EpiBf16 {
    static constexpr bool PERM = true, AFTER_DRAIN = false;
    bf16_t* O; int ldc; const float* bias; int split_cols; size_t split_stride;
    __device__ __forceinline__ void operator()(const f32x4 (&acc)[2][2][4][2], const Unit& u, int wr, int wc, int fr, int fq) const {
        const int row0 = u.pm * BM + wr * 64 + fr; int colt = u.pn * BM; bf16_t* base = O;
        if (split_cols) { const int t = colt / split_cols; base += (size_t)t * split_stride; colt -= t * split_cols; }
        const int col0 = colt + wc * 32 + 8 * fq, bcol0 = u.pn * BM + wc * 32 + 8 * fq;
        f32x4 bv[2][2];
#pragma unroll
        for (int bj = 0; bj < 2; ++bj)
#pragma unroll
            for (int n = 0; n < 2; ++n) bv[bj][n] = bias ? *(const f32x4*)(bias + bcol0 + bj * HALF + 4 * n) : (f32x4){0.f, 0.f, 0.f, 0.f};
#pragma unroll
        for (int ai = 0; ai < 2; ++ai)
#pragma unroll
            for (int m = 0; m < 4; ++m) { bf16_t* rowp = base + (size_t)(row0 + ai * HALF + m * 16) * ldc + col0;
#pragma unroll
                for (int bj = 0; bj < 2; ++bj) { f32x4 v0 = acc[ai][bj][m][0] + bv[bj][0], v1 = acc[ai][bj][m][1] + bv[bj][1];
                    if (ACT == 1) { f32x2 a = gelu_pk((f32x2){v0[0], v0[1]}), b = gelu_pk((f32x2){v0[2], v0[3]}), c = gelu_pk((f32x2){v1[0], v1[1]}), d = gelu_pk((f32x2){v1[2], v1[3]});
                        v0 = (f32x4){a.x, a.y, b.x, b.y}; v1 = (f32x4){c.x, c.y, d.x, d.y}; }
                    if (ACT == 2) {
#pragma unroll
                        for (int j = 0; j < 4; ++j) { v0[j] = 0.5f * v0[j] * (1.0f + erff(v0[j] * 0.70710678f)); v1[j] = 0.5f * v1[j] * (1.0f + erff(v1[j] * 0.70710678f)); } }
                    u32x4 w; w.x = cvt_pk_bf16(v0[0], v0[1]); w.y = cvt_pk_bf16(v0[2], v0[3]); w.z = cvt_pk_bf16(v1[0], v1[1]); w.w = cvt_pk_bf16(v1[2], v1[3]);
                    *(u32x4*)(rowp + bj * HALF) = w; } }
    }
};
template <class Epi, class Sched, bool STAMP = false>
__device__ __forceinline__ void gemm_phase(PG8_LAS unsigned char* lds, const Gemm g, const Sched& S, const Epi& E, unsigned long long* stamps) {
    const int tid = threadIdx.x, wid = __builtin_amdgcn_readfirstlane(tid >> 6), lane = tid & 63, wr = wid >> 2, wc = wid & 3, fr = lane & 15, fq = lane >> 4;
    const int K = g.K, nt = K / BK;
    int ts_lo = 0, ts_hi = 0, nts = 0; const unsigned long long rt_entry = STAMP ? (unsigned long long)wall_clock64() : 0ull;
#define PG8_STAMP() do { if (STAMP && wid == 0 && nts < 64) { const unsigned long long _c = (unsigned long long)clock64(); \
        ts_lo = (lane == nts) ? (int)(unsigned)_c : ts_lo; ts_hi = (lane == nts) ? (int)(unsigned)(_c >> 32) : ts_hi; ++nts; } } while (0)
    PG8_STAMP();
    unsigned voffA[2], voffB[2];
#pragma unroll
    for (int i = 0; i < 2; ++i) { int R, C; stage_rc(tid * 16 + i * 8192, R, C); const int Rb = Epi::PERM ? ((R & ~31) + perm32(R & 31)) : R;
        voffA[i] = (unsigned)(R * K + C) * 2u; voffB[i] = (unsigned)(Rb * K + C) * 2u; }
    const size_t kstep = (size_t)(BK * 2);
    const size_t hstep = (size_t)HALF * K * 2;
    const size_t tstep = 2 * hstep;
    const unsigned ldsw = (unsigned)wid * 1024u;
    const int aoff = lds_byte(wr * 64 + fr, fq * 8), boff = lds_byte(wc * 32 + fr, fq * 8);
#define PG8_SA(b, h) (((b) * 2 + (h)) * HTB)
#define PG8_SB(b, h) ((4 + (b) * 2 + (h)) * HTB)
#define PG8_STAGE(bufoff, gbase, voff) do { _Pragma("unroll") for (int _i = 0; _i < 2; ++_i) \
        __builtin_amdgcn_global_load_lds((const unsigned*)((const char*)(gbase) + (voff)[_i]), (PG8_LAS unsigned*)(lds + (bufoff) + ldsw + _i * 8192), 16, 0, 0); } while (0)
#define PG8_LDA(dst, b, h) do { _Pragma("unroll") for (int m = 0; m < 4; ++m) _Pragma("unroll") for (int k = 0; k < 2; ++k) dst[m][k] = *(const PG8_LAS bf16x8*)(lds + PG8_SA(b, h) + aoff + m * 2048 + k * 1024); } while (0)
#define PG8_LDB(dst, b, h) do { _Pragma("unroll") for (int n = 0; n < 2; ++n) _Pragma("unroll") for (int k = 0; k < 2; ++k) dst[n][k] = *(const PG8_LAS bf16x8*)(lds + PG8_SB(b, h) + boff + n * 2048 + k * 1024); } while (0)
#define PG8_MMA(ai, bj, At, Bt) do { __builtin_amdgcn_s_setprio(1); _Pragma("unroll") for (int m = 0; m < 4; ++m) _Pragma("unroll") for (int n = 0; n < 2; ++n) _Pragma("unroll") for (int k = 0; k < 2; ++k) \
        acc[ai][bj][m][n] = __builtin_amdgcn_mfma_f32_16x16x32_bf16(Bt[n][k], At[m][k], acc[ai][bj][m][n], 0, 0, 0); __builtin_amdgcn_s_setprio(0); } while (0)
#define PG8_WAIT_V(n) asm volatile("s_waitcnt vmcnt(" #n ")" ::: "memory")
#define PG8_WAIT_L(n) asm volatile("s_waitcnt lgkmcnt(" #n ")" ::: "memory")
#define PG8_BAR __builtin_amdgcn_s_barrier()
#define PG8_SCHED __builtin_amdgcn_sched_barrier(0)
    Unit cur, nxt; int ui = 0;
    if (!S.next(0, cur)) return;
    f32x4 acc[2][2][4][2];
#pragma unroll
    for (int a = 0; a < 2; ++a)
#pragma unroll
        for (int b = 0; b < 2; ++b)
#pragma unroll
            for (int m = 0; m < 4; ++m)
#pragma unroll
                for (int n = 0; n < 2; ++n) acc[a][b][m][n] = (f32x4){0.f, 0.f, 0.f, 0.f};
    bf16x8 At[4][2], B0[2][2], B1[2][2];
    const char* cA = S.pa(g, cur); const char* cB = S.pb(g, cur);
    S.a_ready(cur);
    PG8_STAGE(PG8_SB(0, 0), cB, voffB); PG8_STAGE(PG8_SA(0, 0), cA, voffA); PG8_STAGE(PG8_SB(0, 1), cB + hstep, voffB); PG8_STAGE(PG8_SA(0, 1), cA + hstep, voffA);
    if (wr == 1) PG8_BAR;
    PG8_WAIT_V(4); PG8_BAR;
    PG8_STAGE(PG8_SB(1, 0), cB + kstep, voffB); PG8_STAGE(PG8_SA(1, 0), cA + kstep, voffA); PG8_STAGE(PG8_SB(1, 1), cB + hstep + kstep, voffB);
    PG8_WAIT_V(6); PG8_BAR;
    PG8_STAMP();
    for (;;) {
        const bool has_next = S.next(ui + 1, nxt);
        const char* nA = has_next ? S.pa(g, nxt) : cA; const char* nB = has_next ? S.pb(g, nxt) : cB;
        for (int t = 0; t < nt; t += 2) {
            const bool last = (t == nt - 2);
            const char* a1 = cA + (size_t)(t + 1) * kstep;
            const char* a2 = last ? nA : cA + (size_t)(t + 2) * kstep; const char* b2 = last ? nB : cB + (size_t)(t + 2) * kstep;
            const char* a3 = a2 + kstep; const char* b3 = b2 + kstep;
            if (last && has_next) S.a_ready(nxt);
            PG8_LDB(B0, 0, 0); PG8_SCHED; PG8_LDA(At, 0, 0); PG8_STAGE(PG8_SA(1, 1), a1 + hstep, voffA);
            PG8_WAIT_L(8); PG8_BAR; PG8_WAIT_L(0); PG8_MMA(0, 0, At, B0); PG8_BAR; PG8_SCHED;
            PG8_LDB(B1, 0, 1); PG8_STAGE(PG8_SB(0, 0), b2, voffB);
            PG8_BAR; PG8_WAIT_L(0); PG8_MMA(0, 1, At, B1); PG8_BAR;
            PG8_LDA(At, 0, 1); PG8_STAGE(PG8_SA(0, 0), a2, voffA);
            PG8_BAR; PG8_WAIT_L(0); PG8_MMA(1, 0, At, B0); PG8_BAR; PG8_SCHED;
            PG8_STAGE(PG8_SB(0, 1), b2 + hstep, voffB);
            PG8_WAIT_V(6); PG8_BAR; PG8_MMA(1, 1, At, B1); PG8_BAR;
            PG8_LDB(B0, 1, 0); PG8_SCHED; PG8_LDA(At, 1, 0); PG8_STAGE(PG8_SA(0, 1), a2 + hstep, voffA);
            PG8_WAIT_L(8); PG8_BAR; PG8_WAIT_L(0); PG8_MMA(0, 0, At, B0); PG8_BAR; PG8_SCHED;
            PG8_LDB(B1, 1, 1); PG8_STAGE(PG8_SB(1, 0), b3, voffB);
            PG8_BAR; PG8_WAIT_L(0); PG8_MMA(0, 1, At, B1); PG8_BAR;
            PG8_LDA(At, 1, 1); PG8_STAGE(PG8_SA(1, 0), a3, voffA);
            PG8_BAR; PG8_WAIT_L(0); PG8_MMA(1, 0, At, B0); PG8_BAR; PG8_SCHED;
            PG8_STAGE(PG8_SB(1, 1), b3 + hstep, voffB);
            PG8_WAIT_V(6); PG8_BAR; PG8_MMA(1, 1, At, B1); PG8_BAR;
        }
        PG8_STAMP();
        if constexpr (!Epi::AFTER_DRAIN) { E(acc, cur, wr, wc, fr, fq); S.done(cur); }
        PG8_STAMP();
        if (!has_next) break;
#pragma unroll
        for (int a = 0; a < 2; ++a)
#pragma unroll
            for (int b = 0; b < 2; ++b)
#pragma unroll
                for (int m = 0; m < 4; ++m)
#pragma unroll
                    for (int n = 0; n < 2; ++n) acc[a][b][m][n] = (f32x4){0.f, 0.f, 0.f, 0.f};
        cur = nxt; cA = nA; cB = nB; ++ui;
    }
    PG8_WAIT_V(0);
    if (wr == 0) PG8_BAR;
    PG8_BAR;
    if constexpr (Epi::AFTER_DRAIN) { E.fused(acc, cur, wr, wc, fr, fq, lds, wid, lane); S.done(cur); }
    PG8_STAMP();
    if (STAMP && wid == 0) { stamps[lane] = lane < nts ? (((unsigned long long)(unsigned)ts_hi << 32) | (unsigned)ts_lo) : 0ull;
        if (lane == 62) stamps[62] = rt_entry; if (lane == 63) stamps[63] = (unsigned long long)wall_clock64(); }
#undef PG8_STAMP
#undef PG8_SA
#undef PG8_SB
#undef PG8_STAGE
#undef PG8_LDA
#undef PG8_LDB
#undef PG8_MMA
#undef PG8_WAIT_V
#undef PG8_WAIT_L
#undef PG8_BAR
#undef PG8_SCHED
}
}

typedef unsigned short bf16_t;
__device__ __forceinline__ float wave_sum(float v) {
#pragma unroll
    for (int o = 32; o; o >>= 1) v += __shfl_xor(v, o);
    return v;
}
__device__ __forceinline__ float block_sum(float v, float* red) {
    v = wave_sum(v);
    __syncthreads();
    if ((threadIdx.x & 63) == 0) red[threadIdx.x >> 6] = v;
    __syncthreads();
    float s = 0.f;
#pragma unroll
    for (int i = 0; i < NWAVES; ++i) s += red[i];
    return s;
}
__device__ __forceinline__ int opaque_tid() { int t = threadIdx.x; asm volatile("" : "+v"(t)); return t; }
typedef float nt_f32x4 __attribute__((ext_vector_type(4)));
__device__ __forceinline__ float4 nt_load4(const float* p) { const nt_f32x4 v = __builtin_nontemporal_load((const nt_f32x4*)p); return make_float4(v[0], v[1], v[2], v[3]); }
typedef unsigned nt_u32x4 __attribute__((ext_vector_type(4)));
typedef unsigned nt_u32x2 __attribute__((ext_vector_type(2)));
__device__ __forceinline__ uint4 nt_load4u(const void* p) { const nt_u32x4 v = __builtin_nontemporal_load((const nt_u32x4*)p); return make_uint4(v[0], v[1], v[2], v[3]); }
__device__ __forceinline__ uint2 nt_load2u(const void* p) { const nt_u32x2 v = __builtin_nontemporal_load((const nt_u32x2*)p); return make_uint2(v[0], v[1]); }
__device__ __forceinline__ void nt_store4(float* p, float a, float b, float c, float d) { nt_f32x4 v = {a, b, c, d}; __builtin_nontemporal_store(v, (nt_f32x4*)p); }
__device__ __forceinline__ void nt_store4u(void* p, uint4 v) { nt_u32x4 w = {v.x, v.y, v.z, v.w}; __builtin_nontemporal_store(w, (nt_u32x4*)p); }
__device__ __forceinline__ void nt_store2u(void* p, uint2 v) { nt_u32x2 w = {v.x, v.y}; __builtin_nontemporal_store(w, (nt_u32x2*)p); }
__device__ __forceinline__ float silu(float x) { return x / (1.0f + expf(-x)); }


__device__ __forceinline__ unsigned pk_bf16(float lo, float hi) { unsigned r; asm volatile("v_cvt_pk_bf16_f32 %0, %1, %2" : "=v"(r) : "v"(lo), "v"(hi)); return r; }
__device__ __forceinline__ void transpose_convert(const float* __restrict__ W, bf16_t* __restrict__ Wt, int K, int N, float* lds, int wb0, int nwb) {
    const int tid = opaque_tid();
    const int tk = K / 64, tn = N / 256;
    for (int tile = (int)blockIdx.x - wb0; tile < tk * tn; tile += nwb) {
        const int k0 = (tile / tn) * 64, n0 = (tile % tn) * 256;
        __syncthreads();
        float4 v[8];
#pragma unroll
        for (int i = 0; i < 8; ++i) v[i] = nt_load4(W + (size_t)(k0 + (tid >> 6) + 8 * i) * N + n0 + (tid & 63) * 4);
#pragma unroll
        for (int i = 0; i < 8; ++i) { float* d = lds + ((tid >> 6) + 8 * i) * 257 + (tid & 63) * 4; d[0] = v[i].x; d[1] = v[i].y; d[2] = v[i].z; d[3] = v[i].w; }
        __syncthreads();
#pragma unroll
        for (int q = 0; q < 4; ++q) {
            const int c = q * NTHREADS + tid, n = c >> 3, k8 = (c & 7) * 8;
            uint4 o;
            o.x = pk_bf16(lds[(k8 + 0) * 257 + n], lds[(k8 + 1) * 257 + n]); o.y = pk_bf16(lds[(k8 + 2) * 257 + n], lds[(k8 + 3) * 257 + n]);
            o.z = pk_bf16(lds[(k8 + 4) * 257 + n], lds[(k8 + 5) * 257 + n]); o.w = pk_bf16(lds[(k8 + 6) * 257 + n], lds[(k8 + 7) * 257 + n]);
            *(uint4*)(Wt + (size_t)(n0 + n) * K + k0 + k8) = o;
        }
    }
}
__device__ __forceinline__ float wave_max(float v) {
#pragma unroll
    for (int o = 32; o; o >>= 1) v = fmaxf(v, __shfl_xor(v, o));
    return v;
}
__device__ __forceinline__ float block_max(float v, float* red) {
    v = wave_max(v);
    __syncthreads();
    if ((threadIdx.x & 63) == 0) red[threadIdx.x >> 6] = v;
    __syncthreads();
    float s = red[0];
#pragma unroll
    for (int i = 1; i < NWAVES; ++i) s = fmaxf(s, red[i]);
    return s;
}
__device__ __forceinline__ unsigned q4(float a, float b, float c, float d, float inv, int off) {
    const int x = __float2int_rn(a * inv) + off, y = __float2int_rn(b * inv) + off, z = __float2int_rn(c * inv) + off, w = __float2int_rn(d * inv) + off;
    return (unsigned)(x & 255) | ((unsigned)(y & 255) << 8) | ((unsigned)(z & 255) << 16) | ((unsigned)(w & 255) << 24);
}
constexpr int VROW = 1152;
template <int O> __device__ __forceinline__ unsigned nib8(const float (&x)[16], float inv) {
    unsigned r = 0;
#pragma unroll
    for (int i = 0; i < 8; ++i) r |= (unsigned)(min(max(__float2int_rn(x[O + i] * inv), -7), 7) + 8) << (4 * i);
    return r;
}
__device__ __forceinline__ void quant_tables(const Params& p, int wb0, int nwb) {
    const int tid = opaque_tid(), lane = tid & 63, wv = tid >> 6;
    unsigned char* tq = (unsigned char*)p.ws + B_TQ; float* rsc = p.ws + W_SU;
    const int nw = nwb * NWAVES;
    for (int row0 = ((int)blockIdx.x - wb0) * NWAVES + wv; row0 < 2 * 16384; row0 += 2 * nw) {
        float x[2][2][16]; float mx[2][2];
#pragma unroll
        for (int u = 0; u < 2; ++u) {
            const int row = min(row0 + u * nw, 2 * 16384 - 1);
            const float* src = (row < 16384 ? p.in[I_PU] : p.in[I_PV]) + (size_t)(row & 16383) * D + lane * 4;
#pragma unroll
            for (int h = 0; h < 2; ++h) {
                mx[u][h] = 0.f;
#pragma unroll
                for (int q = 0; q < 4; ++q) { const float4 v = nt_load4(src + (h * 4 + q) * 256); x[u][h][q * 4] = v.x; x[u][h][q * 4 + 1] = v.y; x[u][h][q * 4 + 2] = v.z; x[u][h][q * 4 + 3] = v.w;
                    mx[u][h] = fmaxf(mx[u][h], fmaxf(fmaxf(fabsf(v.x), fabsf(v.y)), fmaxf(fabsf(v.z), fabsf(v.w)))); }
            }
        }
#pragma unroll
        for (int u = 0; u < 2; ++u) {
            const int row = row0 + u * nw;
            if (row < 2 * 16384) {
                unsigned char* dst = tq + (size_t)row * VROW;
                const float rmx = wave_max(fmaxf(mx[u][0], mx[u][1]));
                const float R = rmx > 0.f ? rmx * (1.0f / (7.0f * 240.0f)) : 1.0f, invR = 1.0f / R;
                const int pk = __builtin_amdgcn_cvt_pk_fp8_f32(mx[u][0] * (1.03f / 7.0f) * invR, mx[u][1] * (1.03f / 7.0f) * invR, 0, false);
                const float s0 = __builtin_amdgcn_cvt_f32_fp8(pk, 0) * R, s1 = __builtin_amdgcn_cvt_f32_fp8(pk, 1) * R;
                const float i0 = s0 > 0.f ? 1.0f / s0 : 0.f, i1 = s1 > 0.f ? 1.0f / s1 : 0.f;
                nt_store4u(dst + lane * 16, make_uint4(nib8<0>(x[u][0], i0), nib8<8>(x[u][0], i0), nib8<0>(x[u][1], i1), nib8<8>(x[u][1], i1)));
                *(unsigned short*)(dst + 1024 + lane * 2) = (unsigned short)(pk & 0xffff);
                if (lane == 0) rsc[row] = R;
            }
        }
    }
}

__device__ __forceinline__ void naive_gemm(const float* __restrict__ A, int lda, const float* __restrict__ Bm, int ldb,
                                           float* __restrict__ C, int ldc, int M, int N, int K, float* lds) {
    float* As = lds;
    float* Bs = lds + 16 * 132;
    const int tid = opaque_tid(), tx = tid & 31, ty = tid >> 5;
    const int tilesN = N / 128, ntiles = (M / 128) * tilesN;
    for (int tile = blockIdx.x; tile < ntiles; tile += gridDim.x) {
        const int m0 = (tile / tilesN) * 128, n0 = (tile % tilesN) * 128;
        float acc[8][4];
#pragma unroll
        for (int i = 0; i < 8; ++i)
#pragma unroll
            for (int j = 0; j < 4; ++j) acc[i][j] = 0.f;
        for (int k0 = 0; k0 < K; k0 += 16) {
            {
                const int row = tid >> 2, kq = (tid & 3) * 4;
                const float4 a = *(const float4*)(A + (size_t)(m0 + row) * lda + k0 + kq);
                As[(kq + 0) * 132 + row] = a.x; As[(kq + 1) * 132 + row] = a.y; As[(kq + 2) * 132 + row] = a.z; As[(kq + 3) * 132 + row] = a.w;
                const int kk = tid >> 5, n4 = (tid & 31) * 4;
                *(float4*)(Bs + kk * 128 + n4) = *(const float4*)(Bm + (size_t)(k0 + kk) * ldb + n0 + n4);
            }
            __syncthreads();
#pragma unroll 4
            for (int k = 0; k < 16; ++k) {
                const float4 a0 = *(const float4*)(As + k * 132 + ty * 8), a1 = *(const float4*)(As + k * 132 + ty * 8 + 4);
                const float4 b = *(const float4*)(Bs + k * 128 + tx * 4);
                const float av[8] = {a0.x, a0.y, a0.z, a0.w, a1.x, a1.y, a1.z, a1.w};
                const float bv[4] = {b.x, b.y, b.z, b.w};
#pragma unroll
                for (int i = 0; i < 8; ++i)
#pragma unroll
                    for (int j = 0; j < 4; ++j) acc[i][j] += av[i] * bv[j];
            }
            __syncthreads();
        }
#pragma unroll
        for (int i = 0; i < 8; ++i)
            *(float4*)(C + (size_t)(m0 + ty * 8 + i) * ldc + n0 + tx * 4) = make_float4(acc[i][0], acc[i][1], acc[i][2], acc[i][3]);
    }
}

__device__ __forceinline__ void phase_a(const Params& p, float* lds) {
    const int tid = opaque_tid();
    const float* c = p.in[I_C]; const float* cctx = p.in[I_CCTX]; const float* wada = p.in[I_WADA];
    float* part = p.ws + W_ADAP;
    for (int item = blockIdx.x; item < 32 * 24; item += gridDim.x) {
        const int ks = item / 24, j = (item % 24) * 512 + tid;
        __syncthreads();
        if (tid < 5 * 64) { const int n = tid >> 6, k = ks * 64 + (tid & 63); lds[tid] = silu(n < 4 ? c[n * 2048 + k] : cctx[k]); }
        __syncthreads();
        float a0 = 0.f, a1 = 0.f, a2 = 0.f, a3 = 0.f, a4 = 0.f;
#pragma unroll 32
        for (int kk = 0; kk < 64; ++kk) {
            const float w = __builtin_nontemporal_load(wada + (size_t)(ks * 64 + kk) * 12288 + j);
            a0 += lds[kk] * w; a1 += lds[64 + kk] * w; a2 += lds[128 + kk] * w; a3 += lds[192 + kk] * w; a4 += lds[256 + kk] * w;
        }
        part[(size_t)(ks * 5 + 0) * 12288 + j] = a0; part[(size_t)(ks * 5 + 1) * 12288 + j] = a1; part[(size_t)(ks * 5 + 2) * 12288 + j] = a2;
        part[(size_t)(ks * 5 + 3) * 12288 + j] = a3; part[(size_t)(ks * 5 + 4) * 12288 + j] = a4;
    }
}
typedef short bf16x8v __attribute__((ext_vector_type(8)));
typedef float f32x4v __attribute__((ext_vector_type(4)));
typedef float f32x16v __attribute__((ext_vector_type(16)));
__device__ __forceinline__ void phase_filters(const Params& p, float* lds) {
    const int tid = opaque_tid();
    const float* w1 = p.in[I_FW1]; const float* b1 = p.in[I_FB1]; const float* w2 = p.in[I_FW2]; const float* b2 = p.in[I_FB2];
    const float* w3 = p.in[I_FW3]; const float* b3 = p.in[I_FB3]; const float* w4 = p.in[I_FW4]; const float* freq = p.in[I_FREQ];
    float* hT = (float*)((char*)p.ws + B_KF); float* sp = p.ws + W_SP;
    float* zf = lds; float* ha = lds + 64 * 36; float* hb = ha + 64 * 68; float* red2 = hb + 64 * 68;
    float* W1 = red2 + 256; float* W2 = W1 + 33 * 64; float* W3 = W2 + 64 * 64;
    __syncthreads();
    for (int e = tid; e < 33 * 64; e += NTHREADS) W1[e] = w1[e];
    for (int e = tid; e < 64 * 64; e += NTHREADS) { W2[e] = w2[e]; W3[e] = w3[e]; }
    for (int item = blockIdx.x; item < 256; item += gridDim.x) {
        const int pt = item >> 3;
        __syncthreads();
        for (int e = tid; e < 64 * 33; e += NTHREADS) {
            const int pos = e / 33, m = e % 33, i = pt * 64 + pos;
            const float t = (float)i / 2047.0f, w = 6.283185307179586f * (float)i / 2048.0f;
            float v;
            if (m == 0) v = t;
            else if (m <= 16) { const float f = 1e-4f + (float)(m - 1) * ((15.0f - 1e-4f) / 15.0f); v = __cosf(f * w); }
            else { const float f = 1e-4f + (float)(m - 17) * ((15.0f - 1e-4f) / 15.0f); v = -__sinf(f * w); }
            zf[pos * 36 + m] = v;
        }
        __syncthreads();
        const int pos = tid >> 3, u0 = (tid & 7) * 8;
        {
            float a[8];
#pragma unroll
            for (int u = 0; u < 8; ++u) a[u] = b1[u0 + u];
#pragma unroll 11
            for (int m = 0; m < 33; ++m) { const float zv = zf[pos * 36 + m]; const float4 wa = *(const float4*)(W1 + m * 64 + u0), wb = *(const float4*)(W1 + m * 64 + u0 + 4);
                a[0] += zv * wa.x; a[1] += zv * wa.y; a[2] += zv * wa.z; a[3] += zv * wa.w; a[4] += zv * wb.x; a[5] += zv * wb.y; a[6] += zv * wb.z; a[7] += zv * wb.w; }
#pragma unroll
            for (int u = 0; u < 8; ++u) ha[pos * 68 + u0 + u] = __sinf(freq[u0 + u] * a[u]);
        }
        __syncthreads();
        {
            float a[8];
#pragma unroll
            for (int u = 0; u < 8; ++u) a[u] = b2[u0 + u];
#pragma unroll 16
            for (int m = 0; m < 64; ++m) { const float zv = ha[pos * 68 + m]; const float4 wa = *(const float4*)(W2 + m * 64 + u0), wb = *(const float4*)(W2 + m * 64 + u0 + 4);
                a[0] += zv * wa.x; a[1] += zv * wa.y; a[2] += zv * wa.z; a[3] += zv * wa.w; a[4] += zv * wb.x; a[5] += zv * wb.y; a[6] += zv * wb.z; a[7] += zv * wb.w; }
#pragma unroll
            for (int u = 0; u < 8; ++u) hb[pos * 68 + u0 + u] = __sinf(freq[64 + u0 + u] * a[u]);
        }
        __syncthreads();
        {
            float a[8];
#pragma unroll
            for (int u = 0; u < 8; ++u) a[u] = b3[u0 + u];
#pragma unroll 16
            for (int m = 0; m < 64; ++m) { const float zv = hb[pos * 68 + m]; const float4 wa = *(const float4*)(W3 + m * 64 + u0), wb = *(const float4*)(W3 + m * 64 + u0 + 4);
                a[0] += zv * wa.x; a[1] += zv * wa.y; a[2] += zv * wa.z; a[3] += zv * wa.w; a[4] += zv * wb.x; a[5] += zv * wb.y; a[6] += zv * wb.z; a[7] += zv * wb.w; }
#pragma unroll
            for (int u = 0; u < 8; ++u) ha[pos * 68 + u0 + u] = __sinf(freq[128 + u0 + u] * a[u]);
        }
        __syncthreads();
#pragma unroll 1
        for (int jt = (item & 7) * 2; jt < (item & 7) * 2 + 2; ++jt) {
            const int lane = tid & 63, wv = tid >> 6, cl = lane & 15, g = lane >> 4;
            union frag { unsigned u[4]; bf16x8v v; };
            frag af[2][2];
#pragma unroll
            for (int mt = 0; mt < 2; ++mt)
#pragma unroll
                for (int ks = 0; ks < 2; ++ks) {
                    const float* wp = w4 + (size_t)(ks * 32 + 8 * g) * 4096 + jt * 256 + wv * 32 + mt * 16 + cl;
                    float x[8];
#pragma unroll
                    for (int i = 0; i < 8; ++i) x[i] = wp[(size_t)i * 4096];
                    af[mt][ks].u[0] = pk_bf16(x[0], x[1]); af[mt][ks].u[1] = pk_bf16(x[2], x[3]); af[mt][ks].u[2] = pk_bf16(x[4], x[5]); af[mt][ks].u[3] = pk_bf16(x[6], x[7]);
                }
            f32x4v acc[2][4];
#pragma unroll
            for (int mt = 0; mt < 2; ++mt)
#pragma unroll
                for (int nt = 0; nt < 4; ++nt) acc[mt][nt] = (f32x4v){0.f, 0.f, 0.f, 0.f};
#pragma unroll
            for (int nt = 0; nt < 4; ++nt)
#pragma unroll
                for (int ks = 0; ks < 2; ++ks) {
                    const float4 h0 = *(const float4*)(ha + (nt * 16 + cl) * 68 + ks * 32 + 8 * g), h1 = *(const float4*)(ha + (nt * 16 + cl) * 68 + ks * 32 + 8 * g + 4);
                    frag bf; bf.u[0] = pk_bf16(h0.x, h0.y); bf.u[1] = pk_bf16(h0.z, h0.w); bf.u[2] = pk_bf16(h1.x, h1.y); bf.u[3] = pk_bf16(h1.z, h1.w);
#pragma unroll
                    for (int mt = 0; mt < 2; ++mt) acc[mt][nt] = __builtin_amdgcn_mfma_f32_16x16x32_bf16(af[mt][ks].v, bf.v, acc[mt][nt], 0, 0, 0);
                }
#pragma unroll
            for (int mt = 0; mt < 2; ++mt)
#pragma unroll
                for (int r = 0; r < 4; ++r) {
                    const int j = jt * 256 + wv * 32 + mt * 16 + 4 * g + r;
                    const float delta = 3.070113457f + (float)(j & 1023) * ((15.35056729f - 3.070113457f) / 1023.0f);
                    float asum = 0.f;
#pragma unroll
                    for (int nt = 0; nt < 4; ++nt) {
                        const int ps = pt * 64 + nt * 16 + cl;
                        const float val = acc[mt][nt][r] * __expf(-((float)ps / 2047.0f) * delta);
                        asum += fabsf(val);
                        __builtin_nontemporal_store(val, hT + (size_t)j * SL + ps);
                    }
                    asum += __shfl_xor(asum, 1); asum += __shfl_xor(asum, 2); asum += __shfl_xor(asum, 4); asum += __shfl_xor(asum, 8);
                    if (cl == 0) sp[(size_t)pt * 4096 + j] = asum;
                }
        }
    }
}

__device__ __forceinline__ void phase_b(const Params& p) {
    const int tid = opaque_tid();
    const float* part = p.ws + W_ADAP; float* ada = p.ws + W_ADA; const float* bada = p.in[I_BADA];
    for (int e = blockIdx.x * NTHREADS + tid; e < 5 * 12288; e += gridDim.x * NTHREADS) {
        float s = bada[e % 12288];
#pragma unroll 8
        for (int ks = 0; ks < 32; ++ks) s += part[(size_t)ks * 5 * 12288 + e];
        ada[e] = s;
    }
    const float* sp = p.ws + W_SP; float* fs = p.ws + W_FS;
    for (int j = blockIdx.x * NTHREADS + tid; j < 4096; j += gridDim.x * NTHREADS) {
        float s = 0.f;
#pragma unroll 8
        for (int pt = 0; pt < 32; ++pt) s += sp[(size_t)pt * 4096 + j];
        fs[j] = s;
    }
}

__device__ __forceinline__ void phase_c(const Params& p) {
    const int tid = opaque_tid();
    const float* ada = p.ws + W_ADA;
    const float* x = p.in[I_X]; bf16_t* ub = (bf16_t*)((char*)p.ws + B_UB);
    for (size_t e = (size_t)blockIdx.x * NTHREADS + tid; e < (size_t)NT * D / 4; e += (size_t)gridDim.x * NTHREADS) {
        const size_t row = e / (D / 4); const int col = (int)(e % (D / 4)) * 4; const int b = (int)(row / SL);
        const float4 xv = nt_load4(x + row * D + col);
        const float4 sh = *(const float4*)(ada + b * 12288 + col), sc = *(const float4*)(ada + b * 12288 + 2048 + col);
        uint2 o; o.x = pk_bf16(xv.x * (1.f + sc.x) + sh.x, xv.y * (1.f + sc.y) + sh.y); o.y = pk_bf16(xv.z * (1.f + sc.z) + sh.z, xv.w * (1.f + sc.w) + sh.w);
        *(uint2*)(ub + row * D + col) = o;
    }
    const float* ctx = p.in[I_CTX]; bf16_t* ucb = ub + (size_t)NT * D;
    for (size_t e = (size_t)blockIdx.x * NTHREADS + tid; e < (size_t)NTC * D / 4; e += (size_t)gridDim.x * NTHREADS) {
        const size_t row = e / (D / 4); const int col = (int)(e % (D / 4)) * 4;
        const float4 xv = nt_load4(ctx + row * D + col);
        const float4 sh = *(const float4*)(ada + 4 * 12288 + col), sc = *(const float4*)(ada + 4 * 12288 + 2048 + col);
        uint2 o; o.x = pk_bf16(xv.x * (1.f + sc.x) + sh.x, xv.y * (1.f + sc.y) + sh.y); o.y = pk_bf16(xv.z * (1.f + sc.z) + sh.z, xv.w * (1.f + sc.w) + sh.w);
        *(uint2*)(ucb + row * D + col) = o;
    }
}

__device__ __forceinline__ float bf2f(bf16_t v) { return __uint_as_float(((unsigned)v) << 16); }
constexpr int HY_PB = 4416, HY_PJ = 272, HY_R0 = 4 * HY_PB, HY_R1 = HY_R0 + 8192 + 64, HY_SLOT = HY_R1 + 8192 + 64;
static_assert(HY_SLOT % 16 == 0 && 4 * HY_SLOT + 64 <= 155 * 1024, "hyena LDS");
__device__ __forceinline__ bf16x8v hy_lda(const unsigned char* base, int off) {
    const unsigned* q = (const unsigned*)(base + off);
    union { unsigned u[4]; bf16x8v v; } r; r.u[0] = q[0]; r.u[1] = q[1]; r.u[2] = q[2]; r.u[3] = q[3];
    return r.v;
}
__device__ __forceinline__ void hy_stage_rows(const bf16_t* zT, const float* cw, const float* cb, int ch, int half, int lane, unsigned char* sl) {
    const float w0 = cw[ch], w1 = cw[3072 + ch], w2 = cw[6144 + ch], bs = cb[ch];
#pragma unroll 4
    for (int q = 0; q < 8; ++q) {
        const int bsel = 2 * half + (q >> 2), t0 = ((q & 3) * 64 + lane) * 8;
        const bf16_t* zrow = zT + (size_t)ch * NT + bsel * SL;
        const uint4 raw = nt_load4u(zrow + t0);
        float z[10];
        z[0] = t0 > 0 ? bf2f(zrow[t0 - 1]) : 0.f; z[9] = t0 + 8 < SL ? bf2f(zrow[t0 + 8]) : 0.f;
        z[1] = __uint_as_float(raw.x << 16); z[2] = __uint_as_float(raw.x & 0xffff0000u); z[3] = __uint_as_float(raw.y << 16); z[4] = __uint_as_float(raw.y & 0xffff0000u);
        z[5] = __uint_as_float(raw.z << 16); z[6] = __uint_as_float(raw.z & 0xffff0000u); z[7] = __uint_as_float(raw.w << 16); z[8] = __uint_as_float(raw.w & 0xffff0000u);
        float sv[8];
#pragma unroll
        for (int i = 0; i < 8; ++i) sv[i] = w0 * z[i] + w1 * z[i + 1] + w2 * z[i + 2] + bs;
        uint4 o; o.x = pk_bf16(sv[0], sv[1]); o.y = pk_bf16(sv[2], sv[3]); o.z = pk_bf16(sv[4], sv[5]); o.w = pk_bf16(sv[6], sv[7]);
        *(uint4*)(sl + bsel * HY_PB + (t0 >> 7) * HY_PJ + (t0 & 127) * 2) = o;
    }
}
__device__ __forceinline__ void hy_pair_sync(volatile __attribute__((address_space(3))) unsigned* fl, int wv, unsigned n) {
    asm volatile("s_waitcnt lgkmcnt(0)" ::: "memory");
    fl[wv] = n;
    while (fl[wv ^ 1] < n) __builtin_amdgcn_s_sleep(0);
    asm volatile("" ::: "memory");
}
__device__ __forceinline__ void phase_hyena(const Params& p, unsigned char* smem) {
    const int tid = opaque_tid(), lane = tid & 63, wv = tid >> 6, slot = wv >> 1, half = wv & 1, pt = tid & 127;
    const bf16_t* zT = (const bf16_t*)((const char*)p.ws + B_ZT); const float* hT = (const float*)((const char*)p.ws + B_KF); const float* fs = p.ws + W_FS; bf16_t* hyT = (bf16_t*)((char*)p.ws + B_HYT);
    const float* cw = p.in[I_CONVW]; const float* cb = p.in[I_CONVB]; const float* skip = p.in[I_SKIP];
    unsigned char* sl = smem + slot * HY_SLOT;
    const int a_ = lane & 31, hh = lane >> 5, i_local = a_ >> 2, batch = a_ & 3, I0 = 8 * half;
    const int laneA = ((a_ & 1) ? HY_R0 : HY_R1) + 2 * (2047 - a_ - (1 - (a_ & 1)) + 8 * hh);
    volatile __attribute__((address_space(3))) unsigned* fl = (volatile __attribute__((address_space(3))) unsigned*)(smem + 4 * HY_SLOT);
    unsigned seq = 0u;
    __syncthreads();
    if (tid < 8) fl[tid] = 0u;
    if (wv < 4) __builtin_amdgcn_s_setprio(2);
    for (int item = blockIdx.x; item < DHY / 4; item += gridDim.x) {
        const int c = item * 4 + slot;
        __syncthreads();
        hy_stage_rows(zT, cw, cb, c, half, lane, sl);
#pragma unroll 1
        for (int ord = 0; ord < 2; ++ord) {
            {
                const float* hf = hT + (size_t)((ord * 2 + 0) * 1024 + c) * SL; const float* hbk = hT + (size_t)((ord * 2 + 1) * 1024 + c) * SL;
                const float sk = skip[ord * 1024 + c]; const float invs = 1.0f / (fs[(ord * 2 + 0) * 1024 + c] + fs[(ord * 2 + 1) * 1024 + c]);
#pragma unroll
                for (int q = 0; q < 4; ++q) {
                    const int X0 = (q * 128 + pt) * 8;
                    float rv[9];
#pragma unroll
                    for (int i = 0; i < 9; ++i) { const int dp = 2047 - X0 - i; rv[i] = (dp >= 0 ? __builtin_nontemporal_load(hf + dp) : (dp >= -2047 ? __builtin_nontemporal_load(hbk - dp) : 0.f)) * invs; if (dp == 0) rv[i] += sk; }
                    uint4 o0, o1;
                    o0.x = pk_bf16(rv[0], rv[1]); o0.y = pk_bf16(rv[2], rv[3]); o0.z = pk_bf16(rv[4], rv[5]); o0.w = pk_bf16(rv[6], rv[7]);
                    o1.x = pk_bf16(rv[1], rv[2]); o1.y = pk_bf16(rv[3], rv[4]); o1.z = pk_bf16(rv[5], rv[6]); o1.w = pk_bf16(rv[7], rv[8]);
                    *(uint4*)(sl + HY_R0 + X0 * 2) = o0; *(uint4*)(sl + HY_R1 + X0 * 2) = o1;
                }
            }
            hy_pair_sync(fl, wv, ++seq);
            f32x16v acc[4];
#pragma unroll
            for (int mb = 0; mb < 4; ++mb)
#pragma unroll
                for (int e = 0; e < 16; ++e) acc[mb][e] = 0.f;
            {
                const int dlo = I0 - 15, dhi = I0 + 7;
                bf16x8v As[7][2];
#pragma unroll
                for (int s2 = 0; s2 < 3; ++s2)
#pragma unroll
                    for (int k2 = 0; k2 < 2; ++k2) As[4 + s2][k2] = hy_lda(sl, laneA - 64 * (4 * dlo - 3 + s2) + 32 * k2);
#pragma unroll 1
                for (int d = dlo; d <= dhi; ++d) {
#pragma unroll
                    for (int k2 = 0; k2 < 2; ++k2) { As[0][k2] = As[4][k2]; As[1][k2] = As[5][k2]; As[2][k2] = As[6][k2]; }
#pragma unroll
                    for (int s2 = 3; s2 < 7; ++s2)
#pragma unroll
                        for (int k2 = 0; k2 < 2; ++k2) As[s2][k2] = hy_lda(sl, laneA - 64 * (4 * d - 3 + s2) + 32 * k2);
                    const int jl = I0 + i_local - d; const bool valid = (unsigned)jl < 16u;
                    const unsigned char* bp = sl + batch * HY_PB + (valid ? jl : 0) * HY_PJ + hh * 16;
                    bf16x8v Bq[8];
#pragma unroll
                    for (int q = 0; q < 8; ++q) { const bf16x8v v = *(const bf16x8v*)(bp + q * 32); const bf16x8v zero = {0, 0, 0, 0, 0, 0, 0, 0}; Bq[q] = valid ? v : zero; }
#pragma unroll
                    for (int kb = 0; kb < 4; ++kb)
#pragma unroll
                        for (int k2 = 0; k2 < 2; ++k2)
#pragma unroll
                            for (int mb = 0; mb < 4; ++mb) acc[mb] = __builtin_amdgcn_mfma_f32_32x32x16_bf16(As[mb - kb + 3][k2], Bq[2 * kb + k2], acc[mb], 0, 0, 0);
                }
            }
            hy_pair_sync(fl, wv, ++seq);
            hy_stage_rows(zT, cw, cb, (ord == 0 ? 1024 : 2048) + c, half, lane, sl);
            hy_pair_sync(fl, wv, ++seq);
            {
#pragma unroll
                for (int mb = 0; mb < 4; ++mb)
#pragma unroll
                    for (int q4 = 0; q4 < 4; ++q4) {
                        const int t4 = 128 * (I0 + i_local) + 32 * mb + 8 * q4 + 4 * hh;
                        uint2* gp = (uint2*)(sl + batch * HY_PB + (t4 >> 7) * HY_PJ + (t4 & 127) * 2);
                        const uint2 gv = *gp;
                        uint2 o; o.x = pk_bf16(__uint_as_float(gv.x << 16) * acc[mb][q4 * 4 + 0], __uint_as_float(gv.x & 0xffff0000u) * acc[mb][q4 * 4 + 1]);
                        o.y = pk_bf16(__uint_as_float(gv.y << 16) * acc[mb][q4 * 4 + 2], __uint_as_float(gv.y & 0xffff0000u) * acc[mb][q4 * 4 + 3]);
                        *gp = o;
                    }
            }
            if (ord == 1) {
                hy_pair_sync(fl, wv, ++seq);
#pragma unroll
                for (int q = 0; q < 8; ++q) {
                    const int bsel = 2 * half + (q >> 2), t0 = ((q & 3) * 64 + lane) * 8;
                    nt_store4u(hyT + (size_t)c * NT + bsel * SL + t0, *(const uint4*)(sl + bsel * HY_PB + (t0 >> 7) * HY_PJ + (t0 & 127) * 2));
                }
            }
        }
    }
    __builtin_amdgcn_s_setprio(0);
}

__device__ __forceinline__ bf16x8v pack_p(const f32x4v& lo, const f32x4v& hi) {
    union { unsigned u[4]; bf16x8v v; } r;
    r.u[0] = pk_bf16(lo[0], lo[1]); r.u[1] = pk_bf16(lo[2], lo[3]); r.u[2] = pk_bf16(hi[0], hi[1]); r.u[3] = pk_bf16(hi[2], hi[3]);
    return r.v;
}
__device__ __forceinline__ bf16x8v ld_pair8(const bf16_t* lo, const bf16_t* hi) {
    union { uint2 d[2]; bf16x8v v; } r;
    r.d[0] = *(const uint2*)lo; r.d[1] = *(const uint2*)hi;
    return r.v;
}
typedef __attribute__((address_space(3))) const bf16_t* lds_bf16p;
#define LDS_FRAG(pe) (*(const __attribute__((address_space(3))) bf16x8v*)(pe))
constexpr int NA_KC = 0, NA_VC = 32768, NA_KL = 65536, NA_RPB = 155648;
__device__ __forceinline__ void phase_na(const Params& p, unsigned char* smem) {
    const int tid = opaque_tid(), lane = tid & 63, wv = tid >> 6, ql = lane & 15, g = lane >> 4;
    const bf16_t* qh = (const bf16_t*)((const char*)p.ws + B_QH); const bf16_t* kh = (const bf16_t*)((const char*)p.ws + B_KH);
    const bf16_t* kch = (const bf16_t*)((const char*)p.ws + B_KCH); const bf16_t* vT = (const bf16_t*)((const char*)p.ws + B_VT);
    const bf16_t* vcT = (const bf16_t*)((const char*)p.ws + B_VCT); bf16_t* na = (bf16_t*)((char*)p.ws + B_NA);
    const float* rpb = p.in[I_RPB];
    const lds_bf16p kcl = (lds_bf16p)((__attribute__((address_space(3))) unsigned char*)smem + NA_KC);
    const lds_bf16p vcl = (lds_bf16p)((__attribute__((address_space(3))) unsigned char*)smem + NA_VC);
    const lds_bf16p kll = (lds_bf16p)((__attribute__((address_space(3))) unsigned char*)smem + NA_KL);
    for (int sitem = blockIdx.x; sitem < 256; sitem += gridDim.x) {
      const int b = sitem >> 6, h = (sitem >> 2) & 15, rqp = sitem & 3;
      __syncthreads();
      {
          const uint4* s0 = (const uint4*)(kch + (size_t)((b * 16 + h) * 32) * 512); const uint4* s1 = (const uint4*)(vcT + (size_t)((b * 16 + h) * 32) * 512);
          uint4* d0 = (uint4*)(smem + NA_KC); uint4* d1 = (uint4*)(smem + NA_VC);
#pragma unroll
          for (int i = 0; i < 4; ++i) { d0[tid + i * NTHREADS] = s0[tid + i * NTHREADS]; d1[tid + i * NTHREADS] = s1[tid + i * NTHREADS]; }
          if (tid < 465) ((float*)(smem + NA_RPB))[tid] = rpb[h * 465 + tid];
      }
#pragma unroll 1
      for (int half = 0; half < 2; ++half) {
        const int r0 = rqp * 8 + half * 4;
        const int rs_min = min(max(r0 - 4, 0), 24), rs_max = min(max(r0 - 1, 0), 24), nrows = rs_max - rs_min + 8;
        if (half) __syncthreads();
        {
            const uint4* s0 = (const uint4*)(kh + (size_t)((b * 16 + h) * 256 + rs_min * 8) * 512); uint4* d0 = (uint4*)(smem + NA_KL);
            for (int e = tid; e < nrows * 512; e += NTHREADS) d0[e] = s0[e];
        }
        __syncthreads();
#pragma unroll 1
        for (int ti = 0; ti < 2; ++ti) {
        const int r = r0 + (wv >> 2) + 2 * ti, j = wv & 3;
        const int rs = min(max(r - 4, 0), 24), cs = min(max(16 * j - 8, 0), 32);
        const int x = 16 * j + ql, wsx = min(max(x - 8, 0), 48);
        const bf16_t* qrow = qh + ((size_t)((b * 16 + h) * SL + r * 64 + x)) * 64;
        const bf16x8v qf0 = __builtin_nontemporal_load((const bf16x8v*)(qrow + 8 * g)), qf1 = __builtin_nontemporal_load((const bf16x8v*)(qrow + 32 + 8 * g));
        const __attribute__((address_space(3))) float* rp_h = (const __attribute__((address_space(3))) float*)((__attribute__((address_space(3))) unsigned char*)smem + NA_RPB);
        f32x4v o1[4], o2[4]; float m1 = -1e30f, l1 = 0.f, m2 = -1e30f, l2 = 0.f;
#pragma unroll
        for (int d = 0; d < 4; ++d) { o1[d] = (f32x4v){0.f, 0.f, 0.f, 0.f}; o2[d] = (f32x4v){0.f, 0.f, 0.f, 0.f}; }
        const int koff = (ql >> 2) * 512 + g * 32 + (ql & 3) * 8;
        const bf16_t* vb = vT + (size_t)((b * 16 + h) * 256 + g) * 512 + ql * 8;
        {
            f32x4v st[16];
#pragma unroll
            for (int kb = 0; kb < 16; ++kb) {
                const lds_bf16p kp = kcl + koff + (kb >> 1) * 2048 + (kb & 1) * 128;
                const bf16x8v a0 = LDS_FRAG(kp), a1 = LDS_FRAG(kp + 256);
                f32x4v acc = {0.f, 0.f, 0.f, 0.f};
                acc = __builtin_amdgcn_mfma_f32_16x16x32_bf16(a0, qf0, acc, 0, 0, 0);
                acc = __builtin_amdgcn_mfma_f32_16x16x32_bf16(a1, qf1, acc, 0, 0, 0);
#pragma unroll
                for (int rr = 0; rr < 4; ++rr) { acc[rr] *= 0.125f; m1 = fmaxf(m1, acc[rr]); }
                st[kb] = acc;
            }
            m1 = fmaxf(m1, __shfl_xor(m1, 16)); m1 = fmaxf(m1, __shfl_xor(m1, 32));
#pragma unroll
            for (int kb = 0; kb < 16; ++kb)
#pragma unroll
                for (int rr = 0; rr < 4; ++rr) { const float e = __expf(st[kb][rr] - m1); st[kb][rr] = e; l1 += e; }
            l1 += __shfl_xor(l1, 16); l1 += __shfl_xor(l1, 32);
#pragma unroll
            for (int kp = 0; kp < 8; ++kp) {
                const bf16x8v pb = pack_p(st[2 * kp], st[2 * kp + 1]);
#pragma unroll
                for (int d = 0; d < 4; ++d) o1[d] = __builtin_amdgcn_mfma_f32_16x16x32_bf16(LDS_FRAG(vcl + g * 512 + ql * 8 + kp * 2048 + d * 128), pb, o1[d], 0, 0, 0);
            }
        }
        {
            f32x4v st[16];
#pragma unroll
            for (int kb = 0; kb < 16; ++kb) {
                const lds_bf16p kp = kll + koff + ((((rs + (kb >> 1) - rs_min) * 64 + cs) >> 3) * 512) + (kb & 1) * 128;
                const bf16x8v a0 = LDS_FRAG(kp), a1 = LDS_FRAG(kp + 256);
                f32x4v acc = {0.f, 0.f, 0.f, 0.f};
                acc = __builtin_amdgcn_mfma_f32_16x16x32_bf16(a0, qf0, acc, 0, 0, 0);
                acc = __builtin_amdgcn_mfma_f32_16x16x32_bf16(a1, qf1, acc, 0, 0, 0);
                const int dr = rs + (kb >> 1) - r + 7;
#pragma unroll
                for (int rr = 0; rr < 4; ++rr) {
                    const int kc = cs + 8 * g + 4 * (kb & 1) + rr, rel = kc - wsx;
                    const bool ok = rel >= 0 && rel < 16;
                    const int dc = min(max(kc - x + 15, 0), 30);
                    const float sv = ok ? acc[rr] * 0.125f + rp_h[dr * 31 + dc] : -1e30f;
                    acc[rr] = sv; m2 = fmaxf(m2, sv);
                }
                st[kb] = acc;
                if ((kb & 7) == 7) asm volatile("" ::: "memory");
            }
            m2 = fmaxf(m2, __shfl_xor(m2, 16)); m2 = fmaxf(m2, __shfl_xor(m2, 32));
#pragma unroll
            for (int kb = 0; kb < 16; ++kb)
#pragma unroll
                for (int rr = 0; rr < 4; ++rr) { const float e = __expf(st[kb][rr] - m2); st[kb][rr] = e; l2 += e; }
            l2 += __shfl_xor(l2, 16); l2 += __shfl_xor(l2, 32);
#pragma unroll
            for (int kp = 0; kp < 8; ++kp) {
                const bf16x8v pb = pack_p(st[2 * kp], st[2 * kp + 1]);
                const bf16_t* vp = vb + (size_t)(((rs + kp) * 64 + cs) >> 3) * 512;
#pragma unroll
                for (int d = 0; d < 4; ++d) o2[d] = __builtin_amdgcn_mfma_f32_16x16x32_bf16(*(const bf16x8v*)(vp + d * 128), pb, o2[d], 0, 0, 0);
                if ((kp & 3) == 3) asm volatile("" ::: "memory");
            }
        }
        const float mm = fmaxf(m1, m2), c1 = __expf(m1 - mm), c2 = __expf(m2 - mm);
        const float inv = 1.0f / (c1 * l1 + c2 * l2);
        const float w1 = c1 * inv, w2 = c2 * inv;
        f32x4v o[4];
#pragma unroll
        for (int d = 0; d < 4; ++d) o[d] = o1[d] * w1 + o2[d] * w2;
        bf16_t* op = na + (size_t)(b * SL + r * 64 + x) * DNA + h * 64 + 4 * g;
#pragma unroll
        for (int d = 0; d < 4; ++d) { uint2 w; w.x = pk_bf16(o[d][0], o[d][1]); w.y = pk_bf16(o[d][2], o[d][3]); nt_store2u(op + 16 * d, w); }
        }
      }
    }
}

__device__ __forceinline__ void phase_f(const Params& p, float* ldsf) {
    const int tid = opaque_tid();
    const bf16_t* hyT = (const bf16_t*)((const char*)p.ws + B_HYT); const bf16_t* na = (const bf16_t*)((const char*)p.ws + B_NA);
    bf16_t* ob = (bf16_t*)((char*)p.ws + B_UB);
    const float* ghy = p.in[I_GHY]; const float* gna = p.in[I_GNA];
    bf16_t* tile = (bf16_t*)ldsf;
    for (int item = blockIdx.x; item < NT / 32; item += gridDim.x) {
        const int t0 = item * 32;
        __syncthreads();
        uint4 hvv[8];
#pragma unroll
        for (int q = 0; q < 8; ++q) { const int e = q * NTHREADS + tid; hvv[q] = nt_load4u(hyT + (size_t)(e >> 2) * NT + t0 + (e & 3) * 8); }
#pragma unroll
        for (int q = 0; q < 8; ++q) {
            const int e = q * NTHREADS + tid, ch = e >> 2, part = e & 3;
            const unsigned wd[4] = {hvv[q].x, hvv[q].y, hvv[q].z, hvv[q].w};
#pragma unroll
            for (int i = 0; i < 4; ++i) { tile[(part * 8 + 2 * i) * 1032 + ch] = (bf16_t)(wd[i] & 0xffffu); tile[(part * 8 + 2 * i + 1) * 1032 + ch] = (bf16_t)(wd[i] >> 16); }
        }
        __syncthreads();
        const int tk = tid >> 4, sub = tid & 15;
        float hv[64]; float sh = 0.f, sn = 0.f;
#pragma unroll
        for (int i = 0; i < 8; ++i) {
            const uint4 v = *(const uint4*)(tile + tk * 1032 + (i * 16 + sub) * 8);
            const unsigned wd[4] = {v.x, v.y, v.z, v.w};
#pragma unroll
            for (int k = 0; k < 4; ++k) { const float a = __uint_as_float(wd[k] << 16), c = __uint_as_float(wd[k] & 0xffff0000u); hv[i * 8 + 2 * k] = a; hv[i * 8 + 2 * k + 1] = c; sh += a * a + c * c; }
        }
        const bf16_t* nrow = na + (size_t)(t0 + tk) * DNA;
        uint4 nv[8];
#pragma unroll
        for (int i = 0; i < 8; ++i) { nv[i] = nt_load4u(nrow + (i * 16 + sub) * 8);
            const unsigned wd[4] = {nv[i].x, nv[i].y, nv[i].z, nv[i].w};
#pragma unroll
            for (int k = 0; k < 4; ++k) { const float a = __uint_as_float(wd[k] << 16), c = __uint_as_float(wd[k] & 0xffff0000u); sn += a * a + c * c; } }
        sh += __shfl_xor(sh, 1); sh += __shfl_xor(sh, 2); sh += __shfl_xor(sh, 4); sh += __shfl_xor(sh, 8);
        sn += __shfl_xor(sn, 1); sn += __shfl_xor(sn, 2); sn += __shfl_xor(sn, 4); sn += __shfl_xor(sn, 8);
        const float rh = rsqrtf(sh * (1.0f / 1024.0f) + LN_EPS), rn = rsqrtf(sn * (1.0f / 1024.0f) + LN_EPS);
        bf16_t* orow = ob + (size_t)(t0 + tk) * D;
#pragma unroll
        for (int i = 0; i < 8; ++i) {
            const float4 g0 = *(const float4*)(ghy + (i * 16 + sub) * 8), g1 = *(const float4*)(ghy + (i * 16 + sub) * 8 + 4);
            uint4 w; w.x = pk_bf16(hv[i * 8] * rh * g0.x, hv[i * 8 + 1] * rh * g0.y); w.y = pk_bf16(hv[i * 8 + 2] * rh * g0.z, hv[i * 8 + 3] * rh * g0.w);
            w.z = pk_bf16(hv[i * 8 + 4] * rh * g1.x, hv[i * 8 + 5] * rh * g1.y); w.w = pk_bf16(hv[i * 8 + 6] * rh * g1.z, hv[i * 8 + 7] * rh * g1.w);
            *(uint4*)(orow + (i * 16 + sub) * 8) = w;
        }
#pragma unroll
        for (int i = 0; i < 8; ++i) {
            const float4 g0 = *(const float4*)(gna + (i * 16 + sub) * 8), g1 = *(const float4*)(gna + (i * 16 + sub) * 8 + 4);
            const unsigned wd[4] = {nv[i].x, nv[i].y, nv[i].z, nv[i].w};
            float a[8];
#pragma unroll
            for (int k = 0; k < 4; ++k) { a[2 * k] = __uint_as_float(wd[k] << 16); a[2 * k + 1] = __uint_as_float(wd[k] & 0xffff0000u); }
            uint4 w; w.x = pk_bf16(a[0] * rn * g0.x, a[1] * rn * g0.y); w.y = pk_bf16(a[2] * rn * g0.z, a[3] * rn * g0.w);
            w.z = pk_bf16(a[4] * rn * g1.x, a[5] * rn * g1.y); w.w = pk_bf16(a[6] * rn * g1.z, a[7] * rn * g1.w);
            *(uint4*)(orow + DHY + (i * 16 + sub) * 8) = w;
        }
    }
}

__device__ __forceinline__ void phase_h(const Params& p) {
    const int tid = opaque_tid(), lane = tid & 63, wv = tid >> 6;
    const float* x = p.in[I_X]; const bf16_t* y = (const bf16_t*)((const char*)p.ws + B_Y); const float* ada = p.ws + W_ADA;
    const float* g = p.in[I_LN1G]; const float* be = p.in[I_LN1B];
    bf16_t* x1 = (bf16_t*)((char*)p.ws + B_X1); bf16_t* u2b = (bf16_t*)((char*)p.ws + B_UB); unsigned* u2q = (unsigned*)((char*)p.ws + B_U2Q); float* su2 = p.ws + W_SU2;
#pragma unroll 1
    for (int tp = blockIdx.x * NWAVES + wv; tp < NT / 2; tp += gridDim.x * NWAVES) {
        const int b = (2 * tp) / SL;
        float v[2][32]; float s[2] = {0.f, 0.f};
#pragma unroll
        for (int u = 0; u < 2; ++u)
#pragma unroll
            for (int j = 0; j < 8; ++j) {
                const int col = j * 256 + lane * 4; const size_t t = (size_t)(2 * tp + u);
                const float4 xv = nt_load4(x + t * D + col); const uint2 yb = nt_load2u(y + t * D + col);
                const float4 yv = make_float4(__uint_as_float(yb.x << 16), __uint_as_float(yb.x & 0xffff0000u), __uint_as_float(yb.y << 16), __uint_as_float(yb.y & 0xffff0000u));
                const float4 gt = *(const float4*)(ada + b * 12288 + 2 * 2048 + col);
                v[u][j * 4] = ALPHA * xv.x + gt.x * yv.x; v[u][j * 4 + 1] = ALPHA * xv.y + gt.y * yv.y; v[u][j * 4 + 2] = ALPHA * xv.z + gt.z * yv.z; v[u][j * 4 + 3] = ALPHA * xv.w + gt.w * yv.w;
                s[u] += (v[u][j * 4] + v[u][j * 4 + 1]) + (v[u][j * 4 + 2] + v[u][j * 4 + 3]);
            }
        float rstd[2];
#pragma unroll
        for (int u = 0; u < 2; ++u) {
            const float mean = wave_sum(s[u]) * (1.0f / 2048.0f);
            float q2 = 0.f;
#pragma unroll
            for (int i = 0; i < 32; ++i) { v[u][i] -= mean; q2 += v[u][i] * v[u][i]; }
            rstd[u] = rsqrtf(wave_sum(q2) * (1.0f / 2048.0f) + LN_EPS);
        }
        asm volatile("" ::: "memory");
        float umx[2] = {0.f, 0.f};
#pragma unroll
        for (int j = 0; j < 8; ++j) {
            const int col = j * 256 + lane * 4;
            const float4 gv = *(const float4*)(g + col), bv = *(const float4*)(be + col);
            const float4 sh = *(const float4*)(ada + b * 12288 + 3 * 2048 + col), sc = *(const float4*)(ada + b * 12288 + 4 * 2048 + col);
#pragma unroll
            for (int u = 0; u < 2; ++u) {
                const size_t t = (size_t)(2 * tp + u);
                const float4 o = make_float4(v[u][j * 4] * rstd[u] * gv.x + bv.x, v[u][j * 4 + 1] * rstd[u] * gv.y + bv.y, v[u][j * 4 + 2] * rstd[u] * gv.z + bv.z, v[u][j * 4 + 3] * rstd[u] * gv.w + bv.w);
                { uint2 xb; xb.x = pk_bf16(o.x, o.y); xb.y = pk_bf16(o.z, o.w); nt_store2u(x1 + t * D + col, xb); }
                const float4 uv = make_float4(o.x * (1.f + sc.x) + sh.x, o.y * (1.f + sc.y) + sh.y, o.z * (1.f + sc.z) + sh.z, o.w * (1.f + sc.w) + sh.w);
                v[u][j * 4] = uv.x; v[u][j * 4 + 1] = uv.y; v[u][j * 4 + 2] = uv.z; v[u][j * 4 + 3] = uv.w;
                uint2 ub2; ub2.x = pk_bf16(uv.x, uv.y); ub2.y = pk_bf16(uv.z, uv.w);
                *(uint2*)(u2b + t * D + col) = ub2;
                umx[u] = fmaxf(umx[u], fmaxf(fmaxf(fabsf(uv.x), fabsf(uv.y)), fmaxf(fabsf(uv.z), fabsf(uv.w))));
            }
        }
#pragma unroll
        for (int u = 0; u < 2; ++u) {
            const size_t t = (size_t)(2 * tp + u);
            const float um = wave_max(umx[u]);
            const float inv = um > 0.f ? 127.0f / um : 0.f;
            uint4 qa, qb;
            qa.x = q4(v[u][0], v[u][1], v[u][2], v[u][3], inv, 0); qa.y = q4(v[u][4], v[u][5], v[u][6], v[u][7], inv, 0); qa.z = q4(v[u][8], v[u][9], v[u][10], v[u][11], inv, 0); qa.w = q4(v[u][12], v[u][13], v[u][14], v[u][15], inv, 0);
            qb.x = q4(v[u][16], v[u][17], v[u][18], v[u][19], inv, 0); qb.y = q4(v[u][20], v[u][21], v[u][22], v[u][23], inv, 0); qb.z = q4(v[u][24], v[u][25], v[u][26], v[u][27], inv, 0); qb.w = q4(v[u][28], v[u][29], v[u][30], v[u][31], inv, 0);
            nt_store4u(u2q + t * 512 + lane * 8, qa); nt_store4u(u2q + t * 512 + lane * 8 + 4, qb);
            if (lane == 0) su2[t] = um * (1.0f / 127.0f);
        }
    }
}

template <int N> __device__ __forceinline__ void bitonic_desc(float (&v)[N]) {
#pragma unroll
    for (int k = 2; k <= N; k <<= 1)
#pragma unroll
        for (int j = k >> 1; j > 0; j >>= 1)
#pragma unroll
            for (int i = 0; i < N; ++i) { const int l = i ^ j; if (l > i) { const float x = v[i], y = v[l]; const float mx = fmaxf(x, y), mn = fminf(x, y); if ((i & k) == 0) { v[i] = mx; v[l] = mn; } else { v[i] = mn; v[l] = mx; } } }
}
__device__ __forceinline__ void bitonic_merge16_desc(float (&v)[16]) {
#pragma unroll
    for (int j = 8; j > 0; j >>= 1)
#pragma unroll
        for (int i = 0; i < 16; ++i) { const int l = i ^ j; if (l > i) { const float x = v[i], y = v[l]; v[i] = fmaxf(x, y); v[l] = fminf(x, y); } }
}
__device__ __forceinline__ void top16_of_128(float (&sc)[32], float (&top)[16]) {
    float lo[16], hi[16];
#pragma unroll
    for (int i = 0; i < 16; ++i) { lo[i] = sc[i]; hi[i] = sc[16 + i]; }
    bitonic_desc<16>(lo); bitonic_desc<16>(hi);
#pragma unroll
    for (int i = 0; i < 16; ++i) top[i] = fmaxf(lo[i], hi[15 - i]);
    bitonic_merge16_desc(top);
#pragma unroll
    for (int off = 16; off <= 32; off <<= 1) {
        float o[16];
#pragma unroll
        for (int i = 0; i < 16; ++i) o[i] = __shfl_xor(top[15 - i], off);
#pragma unroll
        for (int i = 0; i < 16; ++i) top[i] = fmaxf(top[i], o[i]);
        bitonic_merge16_desc(top);
    }
}
__device__ __forceinline__ void ce_carry(float& va, int& xa, float& vb, int& xb, bool desc) {
    const bool sw = desc ? (vb > va) : (vb < va);
    const float tv = sw ? vb : va, uv = sw ? va : vb; const int tx = sw ? xb : xa, ux = sw ? xa : xb;
    va = tv; vb = uv; xa = tx; xb = ux;
}
__device__ __forceinline__ void bitonic_merge16_desc_carry(float (&v)[16], int (&x)[16]) {
#pragma unroll
    for (int j = 8; j > 0; j >>= 1)
#pragma unroll
        for (int i = 0; i < 16; ++i) { const int l = i ^ j; if (l > i) ce_carry(v[i], x[i], v[l], x[l], true); }
}
constexpr int CAND_I[52] = {0,0,0,0,0,0,0,0,0,0,0,0,0,0,0,0,1,1,1,1,1,1,1,1,2,2,2,2,2,3,3,3,3,4,4,4,5,5,6,6,7,7,8,9,10,11,12,13,14,15,-1,-1};
constexpr int CAND_J[52] = {0,1,2,3,4,5,6,7,8,9,10,11,12,13,14,15,0,1,2,3,4,5,6,7,0,1,2,3,4,0,1,2,3,0,1,2,0,1,0,1,0,1,0,0,0,0,0,0,0,0,-1,-1};

__device__ __forceinline__ int rl_i(int v, int l) { return __builtin_amdgcn_readlane(v, l); }
__device__ __forceinline__ float rl_f(float v, int l) { return __int_as_float(__builtin_amdgcn_readlane(__float_as_int(v), l)); }
#define LANE_OF(k) ((((k) >> 3) & 1) * 32 + (((k) >> 2) & 1) * 16 + (((k) >> 1) & 1) * 8 + ((k) & 1) * 4)
constexpr size_t B_KEYSB = 15 * MiB;
constexpr size_t B_QB = B_Y;

typedef float f32x2v __attribute__((ext_vector_type(2)));
#define PKFMA_LO(fv, xv, wsv) do { f32x2v _t; asm("v_cvt_pk_f32_fp8 %1, %2\n\tv_pk_fma_f32 %0, %3, %1, %0" : "+v"(fv), "=&v"(_t) : "v"(xv), "v"(wsv)); } while (0)
#define PKFMA_HI(fv, xv, wsv) do { f32x2v _t; asm("v_cvt_pk_f32_fp8_sdwa %1, %2 src0_sel:WORD_1\n\tv_pk_fma_f32 %0, %3, %1, %0" : "+v"(fv), "=&v"(_t) : "v"(xv), "v"(wsv)); } while (0)
#define FACC(i) (f2[((i) >> 3) * 4 + (((i) & 1) ? 2 : 0) + (((i) & 7) >> 2)][(((i) & 7) >> 1) & 1])
__device__ __forceinline__ void gather_token(const Params& p, int t, const int* sel_idx, const float* sel_g, int lane) {
    const bf16_t* x1 = (const bf16_t*)((const char*)p.ws + B_X1); const float* ada = p.ws + W_ADA;
    const char* uq = (const char*)p.ws + B_TQ; const char* vq = uq + (size_t)16384 * VROW; const char* u2q = (const char*)p.ws + B_U2Q;
    const __amdgpu_buffer_rsrc_t ursrc = __builtin_amdgcn_make_buffer_rsrc((void*)uq, 0, 16384 * VROW, 0x00020000);
    const __amdgpu_buffer_rsrc_t vrsrc = __builtin_amdgcn_make_buffer_rsrc((void*)vq, 0, 16384 * VROW, 0x00020000);
    const float* su2 = p.ws + W_SU2; const float* rsu = p.ws + W_SU; const float* rsv = p.ws + W_SV;
    const float* g2 = p.in[I_LN2G]; const float* b2 = p.in[I_LN2B];
    const int b = t / SL;
    unsigned ue[4], uo[4]; int us0, us1;
    {
        const uint4 ua_ = nt_load4u(u2q + (size_t)t * D + lane * 32), ub_ = nt_load4u(u2q + (size_t)t * D + lane * 32 + 16);
        const int4 ua = make_int4((int)ua_.x, (int)ua_.y, (int)ua_.z, (int)ua_.w), ub = make_int4((int)ub_.x, (int)ub_.y, (int)ub_.z, (int)ub_.w);
        ue[0] = __builtin_amdgcn_perm((unsigned)ua.y, (unsigned)ua.x, 0x06040200u); uo[0] = __builtin_amdgcn_perm((unsigned)ua.y, (unsigned)ua.x, 0x07050301u);
        ue[1] = __builtin_amdgcn_perm((unsigned)ua.w, (unsigned)ua.z, 0x06040200u); uo[1] = __builtin_amdgcn_perm((unsigned)ua.w, (unsigned)ua.z, 0x07050301u);
        ue[2] = __builtin_amdgcn_perm((unsigned)ub.y, (unsigned)ub.x, 0x06040200u); uo[2] = __builtin_amdgcn_perm((unsigned)ub.y, (unsigned)ub.x, 0x07050301u);
        ue[3] = __builtin_amdgcn_perm((unsigned)ub.w, (unsigned)ub.z, 0x06040200u); uo[3] = __builtin_amdgcn_perm((unsigned)ub.w, (unsigned)ub.z, 0x07050301u);
        us0 = __builtin_amdgcn_sdot4(ua.x, 0x01010101, 0, false); us0 = __builtin_amdgcn_sdot4(ua.y, 0x01010101, us0, false); us0 = __builtin_amdgcn_sdot4(ua.z, 0x01010101, us0, false); us0 = __builtin_amdgcn_sdot4(ua.w, 0x01010101, us0, false);
        us1 = __builtin_amdgcn_sdot4(ub.x, 0x01010101, 0, false); us1 = __builtin_amdgcn_sdot4(ub.y, 0x01010101, us1, false); us1 = __builtin_amdgcn_sdot4(ub.z, 0x01010101, us1, false); us1 = __builtin_amdgcn_sdot4(ub.w, 0x01010101, us1, false);
    }
    const float s2 = su2[t];
    f32x2v f2[16];
#pragma unroll
    for (int i = 0; i < 16; ++i) f2[i] = (f32x2v){0.f, 0.f};
    float fb0 = 0.f, fb1 = 0.f;
    const int kk8 = ((lane >> 5) & 1) * 4 + ((lane >> 4) & 1) * 2 + ((lane >> 3) & 1);
#define LANE_OF8(k) ((((k) >> 2) & 1) * 32 + (((k) >> 1) & 1) * 16 + ((k) & 1) * 8)
    int e_cur = sel_idx[kk8]; float g_cur = sel_g[kk8];
    uint4 un[8]; unsigned usc[8];
#pragma unroll
    for (int k = 0; k < 8; ++k) { const int ro = rl_i(e_cur, LANE_OF8(k)) * VROW; un[k] = __builtin_bit_cast(uint4, __builtin_amdgcn_raw_buffer_load_b128(ursrc, lane * 16, ro, 0)); usc[k] = __builtin_amdgcn_raw_buffer_load_b16(ursrc, 1024 + lane * 2, ro, 0); }
#pragma unroll 1
    for (int bt = 0; bt < 16; ++bt) {
        uint4 vn[8]; unsigned vsc[8];
#pragma unroll
        for (int k = 0; k < 8; ++k) { const int ro = rl_i(e_cur, LANE_OF8(k)) * VROW; vn[k] = __builtin_bit_cast(uint4, __builtin_amdgcn_raw_buffer_load_b128(vrsrc, lane * 16, ro, 0)); vsc[k] = __builtin_amdgcn_raw_buffer_load_b16(vrsrc, 1024 + lane * 2, ro, 0); }
        __builtin_amdgcn_sched_barrier(0);
        float part[8];
#pragma unroll
        for (int k = 0; k < 8; ++k) {
            const uint4 nq = un[k]; const unsigned scw = usc[k];
            int d0 = __builtin_amdgcn_sdot4((int)ue[0], (int)(nq.x & 0x0F0F0F0Fu), -8 * us0, false); d0 = __builtin_amdgcn_sdot4((int)uo[0], (int)((nq.x >> 4) & 0x0F0F0F0Fu), d0, false);
            d0 = __builtin_amdgcn_sdot4((int)ue[1], (int)(nq.y & 0x0F0F0F0Fu), d0, false); d0 = __builtin_amdgcn_sdot4((int)uo[1], (int)((nq.y >> 4) & 0x0F0F0F0Fu), d0, false);
            int d1 = __builtin_amdgcn_sdot4((int)ue[2], (int)(nq.z & 0x0F0F0F0Fu), -8 * us1, false); d1 = __builtin_amdgcn_sdot4((int)uo[2], (int)((nq.z >> 4) & 0x0F0F0F0Fu), d1, false);
            d1 = __builtin_amdgcn_sdot4((int)ue[3], (int)(nq.w & 0x0F0F0F0Fu), d1, false); d1 = __builtin_amdgcn_sdot4((int)uo[3], (int)((nq.w >> 4) & 0x0F0F0F0Fu), d1, false);
            { const f32x2v sc2 = __builtin_amdgcn_cvt_pk_f32_fp8((int)scw, false); part[k] = (float)d0 * sc2[0] + (float)d1 * sc2[1]; }
            __builtin_amdgcn_sched_barrier(0);
        }
        const int bn = (bt + 1) & 15;
        const int e_nxt = sel_idx[bn * 8 + kk8]; const float g_nxt = sel_g[bn * 8 + kk8];
#pragma unroll
        for (int k = 0; k < 8; ++k) { const int ro = rl_i(e_nxt, LANE_OF8(k)) * VROW; un[k] = __builtin_bit_cast(uint4, __builtin_amdgcn_raw_buffer_load_b128(ursrc, lane * 16, ro, 0)); usc[k] = __builtin_amdgcn_raw_buffer_load_b16(ursrc, 1024 + lane * 2, ro, 0); }
        __builtin_amdgcn_sched_barrier(0);
        { const bool up = (lane & 32) != 0;
#pragma unroll
          for (int i = 0; i < 4; ++i) { const float keep = up ? part[i + 4] : part[i], send = up ? part[i] : part[i + 4]; part[i] = keep + __shfl_xor(send, 32); } }
        { const bool up = (lane & 16) != 0;
#pragma unroll
          for (int i = 0; i < 2; ++i) { const float keep = up ? part[i + 2] : part[i], send = up ? part[i] : part[i + 2]; part[i] = keep + __shfl_xor(send, 16); } }
        { const bool up = (lane & 8) != 0;
          const float keep = up ? part[1] : part[0], send = up ? part[0] : part[1]; part[0] = keep + __shfl_xor(send, 8); }
        float tot = part[0]; tot += __shfl_xor(tot, 1); tot += __shfl_xor(tot, 2); tot += __shfl_xor(tot, 4);
        const float dt = tot * s2 * rsu[e_cur];
        const float act = 0.5f * dt * (1.0f + erff(dt * 0.7071067811865476f));
        const float w_l = g_cur * act * rsv[e_cur];
#pragma unroll
        for (int k = 0; k < 8; ++k) {
            const float w = rl_f(w_l, LANE_OF8(k));
            const unsigned scw = vsc[k];
            const f32x2v sc2 = __builtin_amdgcn_cvt_pk_f32_fp8((int)scw, false); const float ws0 = w * sc2[0], ws1 = w * sc2[1];
            fb0 += ws0; fb1 += ws1;
            const f32x2v wp0 = {ws0 * 512.f, ws0 * 512.f}, wp1 = {ws1 * 512.f, ws1 * 512.f};
            const unsigned wd[4] = {vn[k].x, vn[k].y, vn[k].z, vn[k].w};
#pragma unroll
            for (int q = 0; q < 4; ++q) {
                const unsigned ev = wd[q] & 0x0F0F0F0Fu, od = (wd[q] >> 4) & 0x0F0F0F0Fu;
                if (q < 2) { PKFMA_LO(f2[q * 4 + 0], ev, wp0); PKFMA_HI(f2[q * 4 + 1], ev, wp0); PKFMA_LO(f2[q * 4 + 2], od, wp0); PKFMA_HI(f2[q * 4 + 3], od, wp0); }
                else       { PKFMA_LO(f2[q * 4 + 0], ev, wp1); PKFMA_HI(f2[q * 4 + 1], ev, wp1); PKFMA_LO(f2[q * 4 + 2], od, wp1); PKFMA_HI(f2[q * 4 + 3], od, wp1); }
            }
        }
        e_cur = e_nxt; g_cur = g_nxt;
    }
#undef LANE_OF8
    asm volatile("" ::: "memory");
    float v[32]; float s = 0.f;
#pragma unroll
    for (int q = 0; q < 8; ++q) {
        const int col = q * 256 + lane * 4, o = q * 4;
        const uint2 xb = nt_load2u(x1 + (size_t)t * D + col); const float4 gt = *(const float4*)(ada + b * 12288 + 5 * 2048 + col);
        const float4 xv = make_float4(__uint_as_float(xb.x << 16), __uint_as_float(xb.x & 0xffff0000u), __uint_as_float(xb.y << 16), __uint_as_float(xb.y & 0xffff0000u));
        const float fbh = 8.f * (q < 4 ? fb0 : fb1);
        v[o] = ALPHA * xv.x + gt.x * (FACC(o) - fbh); v[o + 1] = ALPHA * xv.y + gt.y * (FACC(o + 1) - fbh);
        v[o + 2] = ALPHA * xv.z + gt.z * (FACC(o + 2) - fbh); v[o + 3] = ALPHA * xv.w + gt.w * (FACC(o + 3) - fbh);
        s += (v[o] + v[o + 1]) + (v[o + 2] + v[o + 3]);
    }
    const float mean = wave_sum(s) * (1.0f / 2048.0f);
    float q2 = 0.f;
#pragma unroll
    for (int i = 0; i < 32; ++i) { v[i] -= mean; q2 += v[i] * v[i]; }
    const float rstd = rsqrtf(wave_sum(q2) * (1.0f / 2048.0f) + LN_EPS);
    asm volatile("" ::: "memory");
#pragma unroll
    for (int q = 0; q < 8; ++q) {
        const int col = q * 256 + lane * 4, o = q * 4;
        const float4 gv = *(const float4*)(g2 + col), bv = *(const float4*)(b2 + col);
        nt_store4(p.out + (size_t)t * D + col, v[o] * rstd * gv.x + bv.x, v[o + 1] * rstd * gv.y + bv.y, v[o + 2] * rstd * gv.z + bv.z, v[o + 3] * rstd * gv.w + bv.w);
    }
}

__device__ __forceinline__ void phase_jk(const Params& p, unsigned char* smem) {
    const int tid0 = opaque_tid();
    const bf16_t* qb = (const bf16_t*)((const char*)p.ws + B_QB); const bf16_t* keysb = (const bf16_t*)((const char*)p.ws + B_KEYSB);
    int* sel_idx = (int*)smem; float* sel_g = (float*)(smem + 8192);
#pragma unroll 1
    for (int item = blockIdx.x; item < NT / 16; item += gridDim.x) {
        int tid = tid0; asm volatile("" : "+v"(tid));
        const int lane = tid & 63, wv = tid >> 6, ql = lane & 15, g = lane >> 4;
        const int t0 = item * 16, h = wv;
        __syncthreads();
        float ta[16], tb[16];
#pragma unroll
        for (int i = 0; i < 16; ++i) { ta[i] = 0.f; tb[i] = 0.f; }
#pragma unroll 1
        for (int pp = 0; pp < 2; ++pp) {
            const bf16_t* qrow = qb + ((size_t)((((t0 >> 4) * 8 + h) * 2 + pp) * 4) * 64 + lane) * 8;
            bf16x8v qf[4];
#pragma unroll
            for (int kc = 0; kc < 4; ++kc) qf[kc] = __builtin_nontemporal_load((const bf16x8v*)(qrow + kc * 512));
            const bf16_t* kbase = keysb + (size_t)((h * 2 + pp) * 8) * 2048 + lane * 8;
            float sc[32];
#pragma unroll
            for (int nb = 0; nb < 8; ++nb) {
                f32x4v acc = {0.f, 0.f, 0.f, 0.f};
#pragma unroll
                for (int kc = 0; kc < 4; ++kc) acc = __builtin_amdgcn_mfma_f32_16x16x32_bf16(*(const bf16x8v*)(kbase + (nb * 4 + kc) * 512), qf[kc], acc, 0, 0, 0);
#pragma unroll
                for (int rr = 0; rr < 4; ++rr) sc[nb * 4 + rr] = __int_as_float((__float_as_int(acc[rr]) & ~127) | (16 * nb + 4 * g + rr));
                if (nb == 3) asm volatile("" ::: "memory");
            }
            float top[16];
            top16_of_128(sc, top);
#pragma unroll
            for (int i = 0; i < 16; ++i) { if (pp == 0) ta[i] = top[i]; else tb[i] = top[i]; }
        }
        float cv[16]; int cx[16];
#pragma unroll
        for (int sidx = 0; sidx < 13; ++sidx) {
            float vv[4]; int xx[4];
#pragma unroll
            for (int q = 0; q < 4; ++q) {
                const int ci = CAND_I[4 * sidx + q], cj = CAND_J[4 * sidx + q];
                if (ci >= 0) { vv[q] = ta[ci] + tb[cj]; xx[q] = ((__float_as_int(ta[ci]) & 127) << 7) | (__float_as_int(tb[cj]) & 127); } else { vv[q] = -3.0e38f; xx[q] = 0; }
            }
            cv[sidx] = g == 0 ? vv[0] : (g == 1 ? vv[1] : (g == 2 ? vv[2] : vv[3]));
            cx[sidx] = g == 0 ? xx[0] : (g == 1 ? xx[1] : (g == 2 ? xx[2] : xx[3]));
        }
#pragma unroll
        for (int sidx = 13; sidx < 16; ++sidx) { cv[sidx] = -3.0e38f; cx[sidx] = 0; }
#pragma unroll
        for (int k = 2; k <= 16; k <<= 1)
#pragma unroll
            for (int j = k >> 1; j > 0; j >>= 1)
#pragma unroll
                for (int i = 0; i < 16; ++i) { const int l = i ^ j; if (l > i) ce_carry(cv[i], cx[i], cv[l], cx[l], (i & k) == 0); }
#pragma unroll
        for (int off = 16; off <= 32; off <<= 1) {
            float ov[16]; int ox[16];
#pragma unroll
            for (int i = 0; i < 16; ++i) { ov[i] = __shfl_xor(cv[15 - i], off); ox[i] = __shfl_xor(cx[15 - i], off); }
#pragma unroll
            for (int i = 0; i < 16; ++i) { const bool tk = ov[i] > cv[i]; cv[i] = tk ? ov[i] : cv[i]; cx[i] = tk ? ox[i] : cx[i]; }
            bitonic_merge16_desc_carry(cv, cx);
        }
        {
            float ex[16]; float sum = 0.f;
#pragma unroll
            for (int i = 0; i < 16; ++i) { ex[i] = __expf(cv[i] - cv[0]); sum += ex[i]; }
            const float inv = 1.0f / sum;
            if (g == 0) {
#pragma unroll
                for (int q = 0; q < 4; ++q) {
                    *(int4*)(sel_idx + ql * 128 + h * 16 + q * 4) = make_int4(cx[q * 4], cx[q * 4 + 1], cx[q * 4 + 2], cx[q * 4 + 3]);
                    *(float4*)(sel_g + ql * 128 + h * 16 + q * 4) = make_float4(ex[q * 4] * inv, ex[q * 4 + 1] * inv, ex[q * 4 + 2] * inv, ex[q * 4 + 3] * inv);
                }
            }
        }
        __syncthreads();
#pragma unroll 1
        for (int k = 0; k < 2; ++k) { int lane2 = lane; asm volatile("" : "+v"(lane2)); gather_token(p, t0 + 2 * wv + k, sel_idx + (2 * wv + k) * 128, sel_g + (2 * wv + k) * 128, lane2); }
    }
}

__device__ __forceinline__ void map_tile(int L, int nM, int nN, int& pm, int& pn) {
    const int nwg = nM * nN; int wgid = L;
    { const int q = nwg / 8, r = nwg % 8, xcd = wgid % 8, off = wgid / 8; wgid = (xcd < r ? xcd * (q + 1) : r * (q + 1) + (xcd - r) * q) + off; }
    const int nig = 8 * nN, gid = wgid / nig, fm = gid * 8, gsz = (nM - fm) < 8 ? (nM - fm) : 8;
    pm = fm + ((wgid % nig) % gsz); pn = (wgid % nig) / gsz;
}
struct ProjOrder {
    int G, c; const bf16_t* ub; const bf16_t* wint;
    __device__ bool next(int i, pg8::Unit& u) const {
        const int L = i * G + c; if (L >= 800) return false;
        if (L < 384) { u.kind = 0; map_tile(L, 12, 32, u.pm, u.pn); }
        else if (L < 512) { u.kind = 1; map_tile(L - 384, 4, 32, u.pm, u.pn); }
        else if (L < 768) { u.kind = 2; map_tile(L - 512, 32, 8, u.pm, u.pn); }
        else if (L < 784) { u.kind = 3; u.pm = (L - 768) >> 2; u.pn = (L - 768) & 3; }
        else { u.kind = 4; u.pm = (L - 784) >> 2; u.pn = (L - 784) & 3; }
        return true;
    }
    __device__ __forceinline__ void a_ready(const pg8::Unit&) const {}
    __device__ __forceinline__ void done(const pg8::Unit&) const {}
    template <class G_> __device__ __forceinline__ const char* pa(const G_&, const pg8::Unit& u) const {
        const size_t ts = (size_t)256 * D * 2;
        switch (u.kind) { case 0: return (const char*)wint + (size_t)u.pm * ts; case 1: return (const char*)wint + (size_t)(20 + u.pm) * ts; case 2: return (const char*)ub + (size_t)u.pm * ts;
                          case 3: return (const char*)ub + (size_t)(32 + u.pm) * ts; default: return (const char*)wint + (size_t)(20 + u.pm) * ts; }
    }
    template <class G_> __device__ __forceinline__ const char* pb(const G_&, const pg8::Unit& u) const {
        const size_t ts = (size_t)256 * D * 2;
        switch (u.kind) { case 0: case 1: return (const char*)ub + (size_t)u.pn * ts; case 2: return (const char*)wint + (size_t)(12 + u.pn) * ts;
                          case 3: return (const char*)wint + (size_t)(16 + u.pn) * ts; default: return (const char*)ub + (size_t)(32 + u.pn) * ts; }
    }
};
struct EpiProj {
    static constexpr bool PERM = true, AFTER_DRAIN = false;
    unsigned char* ws;
    __device__ __forceinline__ void operator()(const pg8::f32x4 (&acc)[2][2][4][2], const pg8::Unit& u, int wr, int wc, int fr, int fq) const {
        bf16_t* const zT = (bf16_t*)(ws + B_ZT); bf16_t* const vT = (bf16_t*)(ws + B_VT); bf16_t* const qh = (bf16_t*)(ws + B_QH); bf16_t* const kh = (bf16_t*)(ws + B_KH);
        bf16_t* const kch = (bf16_t*)(ws + B_KCH); bf16_t* const vcT = (bf16_t*)(ws + B_VCT);
#pragma unroll
        for (int ai = 0; ai < 2; ++ai)
#pragma unroll
            for (int m = 0; m < 4; ++m) {
                const int r = u.pm * 256 + ai * 128 + wr * 64 + m * 16 + fr;
#pragma unroll
                for (int bj = 0; bj < 2; ++bj) {
                    const int cc = u.pn * 256 + bj * 128 + wc * 32 + 8 * fq;
                    bf16_t* dst;
                    if (u.kind == 0) dst = zT + (size_t)r * NT + cc;
                    else if (u.kind == 1) {
                        const int bb = cc >> 11, t = cc & 2047, hh = r >> 6, dd = r & 63;
                        dst = vT + (size_t)((bb * 16 + hh) * 256 + (t >> 3)) * 512 + (dd >> 4) * 128 + (dd & 15) * 8;
                    } else if (u.kind == 2) {
                        const int bb = r >> 11, t = r & 2047, hc = cc & 1023, hh = hc >> 6, dd = hc & 63;
                        if (cc < 1024) dst = qh + ((size_t)((bb * 16 + hh) * SL + t)) * 64 + dd;
                        else dst = kh + (size_t)((bb * 16 + hh) * 256 + (t >> 3)) * 512 + (dd >> 5) * 256 + ((t & 7) >> 2) * 128 + ((dd & 31) >> 3) * 32 + (t & 3) * 8;
                    } else if (u.kind == 3) {
                        const int bb = r >> 8, jj = r & 255, hh = cc >> 6, dd = cc & 63;
                        dst = kch + (size_t)((bb * 16 + hh) * 32 + (jj >> 3)) * 512 + (dd >> 5) * 256 + ((jj & 7) >> 2) * 128 + ((dd & 31) >> 3) * 32 + (jj & 3) * 8;
                    } else {
                        const int bb = cc >> 8, jj = cc & 255, hh = r >> 6, dd = r & 63;
                        dst = vcT + (size_t)((bb * 16 + hh) * 32 + (jj >> 3)) * 512 + (dd >> 4) * 128 + (dd & 15) * 8;
                    }
                    const pg8::f32x4 v0 = acc[ai][bj][m][0], v1 = acc[ai][bj][m][1];
                    pg8::u32x4 w; w.x = pg8::cvt_pk_bf16(v0[0], v0[1]); w.y = pg8::cvt_pk_bf16(v0[2], v0[3]); w.z = pg8::cvt_pk_bf16(v1[0], v1[1]); w.w = pg8::cvt_pk_bf16(v1[2], v1[3]);
                    *(pg8::u32x4*)dst = w;
                }
            }
    }
};

struct EpiQFrag {
    static constexpr bool PERM = true, AFTER_DRAIN = false;
    bf16_t* O;
    __device__ __forceinline__ void operator()(const pg8::f32x4 (&acc)[2][2][4][2], const pg8::Unit& u, int wr, int wc, int fr, int fq) const {
#pragma unroll
        for (int ai = 0; ai < 2; ++ai)
#pragma unroll
            for (int m = 0; m < 4; ++m) {
                const int t = u.pm * 256 + ai * 128 + wr * 64 + m * 16 + fr;
#pragma unroll
                for (int bj = 0; bj < 2; ++bj) {
                    const int c = u.pn * 256 + bj * 128 + wc * 32 + 8 * fq;
                    const int hh = c >> 8, pp = (c >> 7) & 1, d = c & 127;
                    bf16_t* dst = O + ((size_t)(((((t >> 4) * 8 + hh) * 2 + pp) * 4 + (d >> 5)) * 64 + ((d & 31) >> 3) * 16 + (t & 15))) * 8;
                    const pg8::f32x4 v0 = acc[ai][bj][m][0], v1 = acc[ai][bj][m][1];
                    pg8::u32x4 w; w.x = pg8::cvt_pk_bf16(v0[0], v0[1]); w.y = pg8::cvt_pk_bf16(v0[2], v0[3]); w.z = pg8::cvt_pk_bf16(v1[0], v1[1]); w.w = pg8::cvt_pk_bf16(v1[2], v1[3]);
                    __builtin_nontemporal_store(w, (pg8::u32x4*)dst);
                }
            }
    }
};

#define XB_TMO      128
#define XB_XCNT(j)  (256  + 64 * (j))
#define XB_XSUB(j)  (1280 + 64 * (j))
#define XB_XGEN(j)  (2304 + 64 * (j))
#define XB_TOP      3328
#define XB_TOPGEN   3392
#define XCD_BAR_WORDS 3456
#define XB_SPIN_CAP (1u << 18)
#define LAS __attribute__((address_space(3)))

__device__ __forceinline__ unsigned xb_ld(unsigned* p)              { return __hip_atomic_load(p, __ATOMIC_RELAXED, __HIP_MEMORY_SCOPE_AGENT); }
__device__ __forceinline__ unsigned xb_add(unsigned* p, unsigned v) { return __hip_atomic_fetch_add(p, v, __ATOMIC_RELAXED, __HIP_MEMORY_SCOPE_AGENT); }
__device__ __forceinline__ unsigned xb_xcc_id() { return (unsigned)__builtin_amdgcn_s_getreg((3 << 11) | 20) & 0xFu; }
#define XB_SPIN(cond, bar) do { unsigned _sp = 0; while (cond) { __builtin_amdgcn_s_sleep(1); \
    if ((++_sp & 255u) == 0u) { if (xb_ld(&(bar)[XB_TMO])) break; if (_sp > XB_SPIN_CAP) { atomicAdd(&(bar)[XB_TMO], 1u); break; } } } } while (0)

struct XcdBarrier {
    unsigned* bar; unsigned x;
    volatile LAS unsigned* st;
};

__device__ __forceinline__ XcdBarrier xcd_barrier_post(unsigned* bar, volatile LAS unsigned* st) {
    XcdBarrier b; b.bar = bar; b.x = xb_xcc_id(); b.st = st;
    if (threadIdx.x == 0) (void)xb_add(&bar[XB_XCNT(b.x)], 1u);
    return b;
}
__device__ __forceinline__ void xcd_barrier_complete(unsigned* bar, unsigned x, unsigned& nloc, unsigned& nx) {
    const unsigned G = gridDim.x * gridDim.y * gridDim.z;
    unsigned sum, cnt, mine, sp = 0u;
    for (;;) {
        sum = 0u; cnt = 0u; mine = 0u;
#pragma unroll
        for (unsigned j = 0; j < 16; ++j) { const unsigned c = xb_ld(&bar[XB_XCNT(j)]); sum += c; cnt += (c > 0u) ? 1u : 0u; mine = (j == x) ? c : mine; }
        if (sum == G) break;
        __builtin_amdgcn_s_sleep(1);
        if ((++sp & 255u) == 0u) { if (xb_ld(&bar[XB_TMO])) break; if (sp > XB_SPIN_CAP) { atomicAdd(&bar[XB_TMO], 1u); break; } }
    }
    nloc = mine > 0u ? mine : 1u; nx = cnt > 0u ? cnt : 1u;
}

__device__ __forceinline__ void xcd_barrier(const XcdBarrier& b) {
    asm volatile("s_waitcnt vmcnt(0)" ::: "memory");
    __syncthreads();
    if (threadIdx.x == 0) {
        unsigned* bar = b.bar;
        __builtin_amdgcn_s_waitcnt(0);
        unsigned nloc = b.st[0], nx = b.st[1];
        if (nloc == 0u) { xcd_barrier_complete(bar, b.x, nloc, nx); b.st[0] = nloc; b.st[1] = nx; }
        const unsigned old = xb_add(&bar[XB_XSUB(b.x)], 1u);
        const unsigned gen = old / nloc;
        if (old + 1u == (gen + 1u) * nloc) {
            __builtin_amdgcn_fence(__ATOMIC_RELEASE, "agent");
            asm volatile("s_waitcnt vmcnt(0)" ::: "memory");
            const unsigned og = xb_add(&bar[XB_TOP], 1u);
            const unsigned tg = og / nx;
            if (og + 1u == (tg + 1u) * nx) xb_add(&bar[XB_TOPGEN], 1u);
            else XB_SPIN(xb_ld(&bar[XB_TOPGEN]) == tg, bar);
            __builtin_amdgcn_fence(__ATOMIC_ACQUIRE, "agent");
            xb_add(&bar[XB_XGEN(b.x)], 1u);
            asm volatile("s_waitcnt vmcnt(0)" ::: "memory");
        } else {
            XB_SPIN(xb_ld(&bar[XB_XGEN(b.x)]) == gen, bar);
            __builtin_amdgcn_fence(__ATOMIC_ACQUIRE, "agent");
            asm volatile("s_waitcnt vmcnt(0)" ::: "memory");
        }
    }
    __syncthreads();
}
constexpr size_t B_BAR = 14 * MiB;

__global__ void __launch_bounds__(NTHREADS) fwd_megakernel(Params p) {
    extern __shared__ __attribute__((aligned(16))) unsigned char smem[];
    float* lds = (float*)smem; float* red = (float*)(smem + RED_OFF);
    PG8_LAS unsigned char* glds = (PG8_LAS unsigned char*)smem;
    volatile LAS unsigned* xst = (volatile LAS unsigned*)(smem + LDS_BYTES - 16);
    if (threadIdx.x < 4) xst[threadIdx.x] = 0u;
    __syncthreads();
    XcdBarrier xb = xcd_barrier_post((unsigned*)((char*)p.ws + B_BAR), xst);
    bf16_t* wint = (bf16_t*)((char*)p.ws + B_WINT); bf16_t* woutt = (bf16_t*)((char*)p.ws + B_WOUTT); bf16_t* wqt = (bf16_t*)((char*)p.ws + B_WQT);
    bf16_t* ub = (bf16_t*)((char*)p.ws + B_UB);
    phase_a(p, lds);
    transpose_convert(p.in[I_WIN], wint, D, DPROJ, lds, 0, (int)gridDim.x);
    phase_filters(p, lds);
    {
        const float* ks = p.in[I_KEYS]; bf16_t* kd = (bf16_t*)((char*)p.ws + B_KEYSB);
        for (int e = blockIdx.x * NTHREADS + threadIdx.x; e < 16 * 128 * 128 / 4; e += gridDim.x * NTHREADS) {
            const float4 v = *(const float4*)(ks + e * 4); uint2 o; o.x = pk_bf16(v.x, v.y); o.y = pk_bf16(v.z, v.w);
            const int d = (e * 4) & 127, n = ((e * 4) >> 7) & 127, hp = (e * 4) >> 14;
            *(uint2*)(kd + ((size_t)(((hp * 8 + (n >> 4)) * 4 + (d >> 5)) * 64 + ((d & 31) >> 3) * 16 + (n & 15))) * 8 + (d & 7)) = o;
        }
    }
    xcd_barrier(xb);
    phase_b(p);
    xcd_barrier(xb);
    phase_c(p);
    xcd_barrier(xb);
    {
        pg8::Gemm g{ub, wint, NT + NTC, DPROJ, D}; ProjOrder S{(int)gridDim.x, (int)blockIdx.x, ub, wint};
        EpiProj E{(unsigned char*)p.ws};
        pg8::gemm_phase<EpiProj, ProjOrder>(glds, g, S, E, nullptr);
    }
    if (gridDim.x == 256 && blockIdx.x >= 32) {
        quant_tables(p, 32, 224);
        transpose_convert(p.in[I_WOUT], woutt, D, D, lds, 32, 224);
        transpose_convert(p.in[I_WQ], wqt, D, D, lds, 32, 224);
    } else if (gridDim.x != 256) {
        quant_tables(p, 0, (int)gridDim.x);
        transpose_convert(p.in[I_WOUT], woutt, D, D, lds, 0, (int)gridDim.x);
        transpose_convert(p.in[I_WQ], wqt, D, D, lds, 0, (int)gridDim.x);
    }
    xcd_barrier(xb);
    phase_hyena(p, smem);
    phase_na(p, smem);
    xcd_barrier(xb);
    phase_f(p, lds);
    xcd_barrier(xb);
    {
        pg8::Gemm g{ub, woutt, NT, D, D}; pg8::StaticOrder S; S.init(NT, D, (int)gridDim.x, (int)blockIdx.x);
        pg8::EpiBf16<0> E{(bf16_t*)((char*)p.ws + B_Y), D, nullptr, 0, 0};
        pg8::gemm_phase<pg8::EpiBf16<0>, pg8::StaticOrder>(glds, g, S, E, nullptr);
    }
    xcd_barrier(xb);
    phase_h(p);
    xcd_barrier(xb);
    {
        pg8::Gemm g{ub, wqt, NT, D, D}; pg8::StaticOrder S; S.init(NT, D, (int)gridDim.x, (int)blockIdx.x);
        EpiQFrag E{(bf16_t*)((char*)p.ws + B_QB)};
        pg8::gemm_phase<EpiQFrag, pg8::StaticOrder>(glds, g, S, E, nullptr);
    }
    xcd_barrier(xb);
    phase_jk(p, smem);
}

extern "C" void kernel_launch(void* const* d_in, const int* in_sizes, int n_in, void* d_out, int out_size, void* d_ws, size_t ws_size, hipStream_t stream) {
    static int grid_blocks = 0;
    if (grid_blocks == 0) {
        if (n_in != N_IN || out_size != NT * D || ws_size < W_END * sizeof(float)) {
            fprintf(stderr, "kernel_launch: unexpected shapes: n_in %d out %d ws %zu (need %zu)\n", n_in, out_size, ws_size, (size_t)W_END * 4); grid_blocks = -1; return; }
        int dev = 0, cus = 0, per_cu = 0;
        hipGetDevice(&dev);
        hipDeviceGetAttribute(&cus, hipDeviceAttributeMultiprocessorCount, dev);
        if (hipFuncSetAttribute((const void*)fwd_megakernel, hipFuncAttributeMaxDynamicSharedMemorySize, LDS_BYTES) != hipSuccess) { fprintf(stderr, "kernel_launch: hipFuncSetAttribute failed\n"); grid_blocks = -1; return; }
        if (hipOccupancyMaxActiveBlocksPerMultiprocessor(&per_cu, (const void*)fwd_megakernel, NTHREADS, LDS_BYTES) != hipSuccess || per_cu < 1) { fprintf(stderr, "kernel_launch: occupancy query failed (%d)\n", per_cu); (void)hipGetLastError(); grid_blocks = -1; return; }
        grid_blocks = cus * (per_cu > 1 ? 1 : per_cu);
        fprintf(stderr, "kernel_launch: cus %d per_cu %d grid %d\n", cus, per_cu, grid_blocks);
    }
    if (grid_blocks < 0) return;
    Params p{};
    for (int i = 0; i < N_IN; ++i) p.in[i] = (const float*)d_in[i];
    p.out = (float*)d_out; p.ws = (float*)d_ws;
    if (hipMemsetAsync((char*)d_ws + B_BAR, 0, XCD_BAR_WORDS * sizeof(unsigned), stream) != hipSuccess) { fprintf(stderr, "kernel_launch: memset failed\n"); return; }
    void* args[] = {&p};
    hipLaunchKernelGGL(fwd_megakernel, dim3(grid_blocks), dim3(NTHREADS), LDS_BYTES, stream, p);
    const hipError_t e = hipPeekAtLastError();
    if (e != hipSuccess) fprintf(stderr, "launch failed: %s (grid %d)\n", hipGetErrorString(e), grid_blocks);
}
```

```cpp
#include <hip/hip_runtime.h>
#include <hip/hip_cooperative_groups.h>
#include <cstdio>
namespace cg = cooperative_groups;

constexpr int D = 2048, NB = 4, SL = 2048, NT = NB * SL, CL = 256, NTC = NB * CL;
constexpr int DHY = 1024, DNA = 1024, DPROJ = 6144, OFFQ = 3072, OFFK = 4096, OFFV = 5120;
constexpr int NTHREADS = 512, NWAVES = 8;
constexpr float LN_EPS = 1e-5f;
constexpr float ALPHA = 1.189207115002721f;

enum { I_X = 0, I_C, I_CTX, I_CCTX, I_WADA, I_BADA, I_WIN, I_CONVW, I_CONVB, I_FW1, I_FB1, I_FW2, I_FB2, I_FW3, I_FB3, I_FW4,
       I_FREQ, I_SKIP, I_RPB, I_GHY, I_GNA, I_WOUT, I_LN1G, I_LN1B, I_WQ, I_KEYS, I_PU, I_PV, I_LN2G, I_LN2B, N_IN };

constexpr size_t W_ADAP = 0;
constexpr size_t W_ADA  = W_ADAP + 32 * 5 * 12288;
constexpr size_t W_FS   = W_ADA + 5 * 12288;
constexpr size_t W_SP   = W_FS + 4096;
constexpr size_t W_SU   = W_SP + 32 * 4096;
constexpr size_t W_SV   = W_SU + 16384;
constexpr size_t W_SU2  = W_SV + 16384;
static_assert((W_SU2 + 8192) * 4 <= 14 * 1048576, "small region overflow");
constexpr size_t MiB = 1048576;
constexpr size_t B_WINT  = 16 * MiB;
constexpr size_t B_WOUTT = B_WINT + 24 * MiB;
constexpr size_t B_WQT   = B_WOUTT + 8 * MiB;
constexpr size_t B_UB    = B_WQT + 8 * MiB;
constexpr size_t B_ZT    = B_UB + 36 * MiB;
constexpr size_t B_VT    = B_ZT + 48 * MiB;
constexpr size_t B_QH    = B_VT + 16 * MiB;
constexpr size_t B_KH    = B_QH + 16 * MiB;
constexpr size_t B_KCH   = B_KH + 16 * MiB;
constexpr size_t B_VCT   = B_KCH + 2 * MiB;
constexpr size_t B_KF    = B_VCT + 2 * MiB;
constexpr size_t B_HRAW  = B_KF + 32 * MiB;
constexpr size_t B_HYT   = B_HRAW;
constexpr size_t B_NA    = B_HRAW + 16 * MiB;
constexpr size_t B_Y     = B_HRAW + 32 * MiB;
constexpr size_t B_X1    = B_Y + 64 * MiB;
constexpr size_t B_U2Q   = B_X1 + 64 * MiB;
constexpr size_t B_TQ    = B_U2Q + 16 * MiB;
constexpr size_t B_END   = B_TQ + 64 * MiB;
constexpr size_t W_KF = B_KF / 4, W_X1 = B_X1 / 4, W_HRAW = B_HRAW / 4, W_Y = B_Y / 4, W_END = B_END / 4;
static_assert(B_END <= 512 * MiB, "workspace");

constexpr int LDS_BYTES = 156 * 1024;
constexpr int RED_OFF = 155 * 1024;

struct Params { const float* in[N_IN]; float* out; float* ws; };

namespace pg8 {
#define PG8_LAS __attribute__((address_space(3)))
typedef unsigned short bf16_t;
typedef short bf16x8 __attribute__((ext_vector_type(8)));
typedef float f32x4 __attribute__((ext_vector_type(4)));
typedef unsigned u32x4 __attribute__((ext_vector_type(4)));
constexpr int BM = 256, BK = 64, HALF = 128, HTB = HALF * BK * 2  , STAGE_BYTES = 8 * HTB, NXCD = 8, WGM = 8;

__host__ __device__ __forceinline__ int lds_byte(int r, int c) { const int st = (r >> 4) * 2 + (c >> 5), rr = r & 15, cc = c & 31, ob = rr * 64 + cc * 2; return st * 1024 + (ob ^ (((ob >> 9) & 1) << 5)); }
__host__ __device__ __forceinline__ void stage_rc(int b, int& R, int& C) { const int st = b / 1024, sb = b % 1024, swz = sb ^ (((sb >> 9) & 1) << 5); R = (st >> 1) * 16 + swz / 64; C = (st & 1) * 32 + (swz % 64) / 2; }
__host__ __device__ __forceinline__ int perm32(int rho) { const int n = rho >> 4, i = rho & 15; return 8 * (i >> 2) + 4 * n + (i & 3); }

struct Unit { int pm, pn, kind; };
struct Gemm { const bf16_t* A; const bf16_t* Bt; int M, N, K; };

struct StaticOrder {
    int nM, nN, nwg, G, c;
    __host__ __device__ void init(int M, int N, int G_, int c_) { nM = M / BM; nN = N / BM; nwg = nM * nN; G = G_; c = c_; }
    __host__ __device__ bool next(int i, Unit& u) const {
        const long L = (long)i * G + c; if (L >= nwg) return false;
        int wgid = (int)L; { const int q = nwg / NXCD, r = nwg % NXCD, xcd = wgid % NXCD, off = wgid / NXCD; wgid = (xcd < r ? xcd * (q + 1) : r * (q + 1) + (xcd - r) * q) + off; }
        const int nig = WGM * nN, gid = wgid / nig, fm = gid * WGM, gsz = (nM - fm) < WGM ? (nM - fm) : WGM;
        u.pm = fm + ((wgid % nig) % gsz); u.pn = (wgid % nig) / gsz; return true;
    }
    __device__ __forceinline__ void a_ready(const Unit&) const {}
    __device__ __forceinline__ void done(const Unit&) const {}
    template <class G_> __device__ __forceinline__ const char* pa(const G_& g, const Unit& u) const { return (const char*)g.A + (size_t)u.pm * (size_t)(BM * 2) * g.K; }
    template <class G_> __device__ __forceinline__ const char* pb(const G_& g, const Unit& u) const { return (const char*)g.Bt + (size_t)u.pn * (size_t)(BM * 2) * g.K; }
};
__device__ __forceinline__ unsigned cvt_pk_bf16(float lo, float hi) { unsigned r; asm volatile("v_cvt_pk_bf16_f32 %0, %1, %2" : "=v"(r) : "v"(lo), "v"(hi)); return r; }
typedef float f32x2 __attribute__((ext_vector_type(2)));
__device__ __forceinline__ f32x2 gelu_pk(f32x2 v) {
    const f32x2 av = __builtin_elementwise_abs(v), d = av * 0.2316418882f + 1.0f;
    f32x2 t; t.x = __builtin_amdgcn_rcpf(d.x); t.y = __builtin_amdgcn_rcpf(d.y);
    f32x2 q = t * 0.5307027145f + (-0.7265760135f); q = q * t + 0.7107068705f; q = q * t + (-0.142248368f); q = q * t + 0.127414796f; q = q * t;
    const f32x2 s = (v * v) * (-0.72134752044f);
    f32x2 e; e.x = __builtin_amdgcn_exp2f(s.x); e.y = __builtin_amdgcn_exp2f(s.y);
    const f32x2 m = v * (q * e), r = v - m;
    f32x2 o; o.x = v.x < 0.f ? m.x : r.x; o.y = v.y < 0.f ? m.y : r.y; return o;
}

struct EpiF32 {
    static constexpr bool PERM = false, AFTER_DRAIN = false;
    float* C; int ldc; const float* bias;
    __device__ __forceinline__ void operator()(const f32x4 (&acc)[2][2][4][2], const Unit& u, int wr, int wc, int fr, int fq) const {
        const int row0 = u.pm * BM + wr * 64 + fr, col0 = u.pn * BM + wc * 32 + 4 * fq;
        f32x4 bv[2][2];
#pragma unroll
        for (int bj = 0; bj < 2; ++bj)
#pragma unroll
            for (int n = 0; n < 2; ++n) bv[bj][n] = bias ? *(const f32x4*)(bias + col0 + bj * HALF + n * 16) : (f32x4){0.f, 0.f, 0.f, 0.f};
#pragma unroll
        for (int ai = 0; ai < 2; ++ai)
#pragma unroll
            for (int m = 0; m < 4; ++m) { float* rowp = C + (size_t)(row0 + ai * HALF + m * 16) * ldc + col0;
#pragma unroll
                for (int bj = 0; bj < 2; ++bj)
#pragma unroll
                    for (int n = 0; n < 2; ++n) *(f32x4*)(rowp + bj * HALF + n * 16) = acc[ai][bj][m][n] + bv[bj][n]; }
    }
};
template <int ACT  > struct EpiBf16 {
    static constexpr bool PERM = true, AFTER_DRAIN = false;
    bf16_t* O; int ldc; const float* bias; int split_cols; size_t split_stride;
    __device__ __forceinline__ void operator()(const f32x4 (&acc)[2][2][4][2], const Unit& u, int wr, int wc, int fr, int fq) const {
        const int row0 = u.pm * BM + wr * 64 + fr; int colt = u.pn * BM; bf16_t* base = O;
        if (split_cols) { const int t = colt / split_cols; base += (size_t)t * split_stride; colt -= t * split_cols; }
        const int col0 = colt + wc * 32 + 8 * fq, bcol0 = u.pn * BM + wc * 32 + 8 * fq;
        f32x4 bv[2][2];
#pragma unroll
        for (int bj = 0; bj < 2; ++bj)
#pragma unroll
            for (int n = 0; n < 2; ++n) bv[bj][n] = bias ? *(const f32x4*)(bias + bcol0 + bj * HALF + 4 * n) : (f32x4){0.f, 0.f, 0.f, 0.f};
#pragma unroll
        for (int ai = 0; ai < 2; ++ai)
#pragma unroll
            for (int m = 0; m < 4; ++m) { bf16_t* rowp = base + (size_t)(row0 + ai * HALF + m * 16) * ldc + col0;
#pragma unroll
                for (int bj = 0; bj < 2; ++bj) { f32x4 v0 = acc[ai][bj][m][0] + bv[bj][0], v1 = acc[ai][bj][m][1] + bv[bj][1];
                    if (ACT == 1) { f32x2 a = gelu_pk((f32x2){v0[0], v0[1]}), b = gelu_pk((f32x2){v0[2], v0[3]}), c = gelu_pk((f32x2){v1[0], v1[1]}), d = gelu_pk((f32x2){v1[2], v1[3]});
                        v0 = (f32x4){a.x, a.y, b.x, b.y}; v1 = (f32x4){c.x, c.y, d.x, d.y}; }
                    if (ACT == 2) {
#pragma unroll
                        for (int j = 0; j < 4; ++j) { v0[j] = 0.5f * v0[j] * (1.0f + erff(v0[j] * 0.70710678f)); v1[j] = 0.5f * v1[j] * (1.0f + erff(v1[j] * 0.70710678f)); } }
                    u32x4 w; w.x = cvt_pk_bf16(v0[0], v0[1]); w.y = cvt_pk_bf16(v0[2], v0[3]); w.z = cvt_pk_bf16(v1[0], v1[1]); w.w = cvt_pk_bf16(v1[2], v1[3]);
                    *(u32x4*)(rowp + bj * HALF) = w; } }
    }
};
template <class Epi, class Sched, bool STAMP = false>
__device__ __forceinline__ void gemm_phase(PG8_LAS unsigned char* lds, const Gemm g, const Sched& S, const Epi& E, unsigned long long* stamps) {
    const int tid = threadIdx.x, wid = __builtin_amdgcn_readfirstlane(tid >> 6), lane = tid & 63, wr = wid >> 2, wc = wid & 3, fr = lane & 15, fq = lane >> 4;
    const int K = g.K, nt = K / BK;
    int ts_lo = 0, ts_hi = 0, nts = 0; const unsigned long long rt_entry = STAMP ? (unsigned long long)wall_clock64() : 0ull;
#define PG8_STAMP() do { if (STAMP && wid == 0 && nts < 64) { const unsigned long long _c = (unsigned long long)clock64(); \
        ts_lo = (lane == nts) ? (int)(unsigned)_c : ts_lo; ts_hi = (lane == nts) ? (int)(unsigned)(_c >> 32) : ts_hi; ++nts; } } while (0)
    PG8_STAMP();
    unsigned voffA[2], voffB[2];
#pragma unroll
    for (int i = 0; i < 2; ++i) { int R, C; stage_rc(tid * 16 + i * 8192, R, C); const int Rb = Epi::PERM ? ((R & ~31) + perm32(R & 31)) : R;
        voffA[i] = (unsigned)(R * K + C) * 2u; voffB[i] = (unsigned)(Rb * K + C) * 2u; }
    const size_t kstep = (size_t)(BK * 2);
    const size_t hstep = (size_t)HALF * K * 2;
    const size_t tstep = 2 * hstep;
    const unsigned ldsw = (unsigned)wid * 1024u;
    const int aoff = lds_byte(wr * 64 + fr, fq * 8), boff = lds_byte(wc * 32 + fr, fq * 8);
#define PG8_SA(b, h) (((b) * 2 + (h)) * HTB)
#define PG8_SB(b, h) ((4 + (b) * 2 + (h)) * HTB)
#define PG8_STAGE(bufoff, gbase, voff) do { _Pragma("unroll") for (int _i = 0; _i < 2; ++_i) \
        __builtin_amdgcn_global_load_lds((const unsigned*)((const char*)(gbase) + (voff)[_i]), (PG8_LAS unsigned*)(lds + (bufoff) + ldsw + _i * 8192), 16, 0, 0); } while (0)
#define PG8_LDA(dst, b, h) do { _Pragma("unroll") for (int m = 0; m < 4; ++m) _Pragma("unroll") for (int k = 0; k < 2; ++k) dst[m][k] = *(const PG8_LAS bf16x8*)(lds + PG8_SA(b, h) + aoff + m * 2048 + k * 1024); } while (0)
#define PG8_LDB(dst, b, h) do { _Pragma("unroll") for (int n = 0; n < 2; ++n) _Pragma("unroll") for (int k = 0; k < 2; ++k) dst[n][k] = *(const PG8_LAS bf16x8*)(lds + PG8_SB(b, h) + boff + n * 2048 + k * 1024); } while (0)
#define PG8_MMA(ai, bj, At, Bt) do { __builtin_amdgcn_s_setprio(1); _Pragma("unroll") for (int m = 0; m < 4; ++m) _Pragma("unroll") for (int n = 0; n < 2; ++n) _Pragma("unroll") for (int k = 0; k < 2; ++k) \
        acc[ai][bj][m][n] = __builtin_amdgcn_mfma_f32_16x16x32_bf16(Bt[n][k], At[m][k], acc[ai][bj][m][n], 0, 0, 0); __builtin_amdgcn_s_setprio(0); } while (0)
#define PG8_WAIT_V(n) asm volatile("s_waitcnt vmcnt(" #n ")" ::: "memory")
#define PG8_WAIT_L(n) asm volatile("s_waitcnt lgkmcnt(" #n ")" ::: "memory")
#define PG8_BAR __builtin_amdgcn_s_barrier()
#define PG8_SCHED __builtin_amdgcn_sched_barrier(0)
    Unit cur, nxt; int ui = 0;
    if (!S.next(0, cur)) return;
    f32x4 acc[2][2][4][2];
#pragma unroll
    for (int a = 0; a < 2; ++a)
#pragma unroll
        for (int b = 0; b < 2; ++b)
#pragma unroll
            for (int m = 0; m < 4; ++m)
#pragma unroll
                for (int n = 0; n < 2; ++n) acc[a][b][m][n] = (f32x4){0.f, 0.f, 0.f, 0.f};
    bf16x8 At[4][2], B0[2][2], B1[2][2];
    const char* cA = S.pa(g, cur); const char* cB = S.pb(g, cur);
    S.a_ready(cur);
    PG8_STAGE(PG8_SB(0, 0), cB, voffB); PG8_STAGE(PG8_SA(0, 0), cA, voffA); PG8_STAGE(PG8_SB(0, 1), cB + hstep, voffB); PG8_STAGE(PG8_SA(0, 1), cA + hstep, voffA);
    if (wr == 1) PG8_BAR;
    PG8_WAIT_V(4); PG8_BAR;
    PG8_STAGE(PG8_SB(1, 0), cB + kstep, voffB); PG8_STAGE(PG8_SA(1, 0), cA + kstep, voffA); PG8_STAGE(PG8_SB(1, 1), cB + hstep + kstep, voffB);
    PG8_WAIT_V(6); PG8_BAR;
    PG8_STAMP();
    for (;;) {
        const bool has_next = S.next(ui + 1, nxt);
        const char* nA = has_next ? S.pa(g, nxt) : cA; const char* nB = has_next ? S.pb(g, nxt) : cB;
        for (int t = 0; t < nt; t += 2) {
            const bool last = (t == nt - 2);
            const char* a1 = cA + (size_t)(t + 1) * kstep;
            const char* a2 = last ? nA : cA + (size_t)(t + 2) * kstep; const char* b2 = last ? nB : cB + (size_t)(t + 2) * kstep;
            const char* a3 = a2 + kstep; const char* b3 = b2 + kstep;
            if (last && has_next) S.a_ready(nxt);
            PG8_LDB(B0, 0, 0); PG8_SCHED; PG8_LDA(At, 0, 0); PG8_STAGE(PG8_SA(1, 1), a1 + hstep, voffA);
            PG8_WAIT_L(8); PG8_BAR; PG8_WAIT_L(0); PG8_MMA(0, 0, At, B0); PG8_BAR; PG8_SCHED;
            PG8_LDB(B1, 0, 1); PG8_STAGE(PG8_SB(0, 0), b2, voffB);
            PG8_BAR; PG8_WAIT_L(0); PG8_MMA(0, 1, At, B1); PG8_BAR;
            PG8_LDA(At, 0, 1); PG8_STAGE(PG8_SA(0, 0), a2, voffA);
            PG8_BAR; PG8_WAIT_L(0); PG8_MMA(1, 0, At, B0); PG8_BAR; PG8_SCHED;
            PG8_STAGE(PG8_SB(0, 1), b2 + hstep, voffB);
            PG8_WAIT_V(6); PG8_BAR; PG8_MMA(1, 1, At, B1); PG8_BAR;
            PG8_LDB(B0, 1, 0); PG8_SCHED; PG8_LDA(At, 1, 0); PG8_STAGE(PG8_SA(0, 1), a2 + hstep, voffA);
            PG8_WAIT_L(8); PG8_BAR; PG8_WAIT_L(0); PG8_MMA(0, 0, At, B0); PG8_BAR; PG8_SCHED;
            PG8_LDB(B1, 1, 1); PG8_STAGE(PG8_SB(1, 0), b3, voffB);
            PG8_BAR; PG8_WAIT_L(0); PG8_MMA(0, 1, At, B1); PG8_BAR;
            PG8_LDA(At, 1, 1); PG8_STAGE(PG8_SA(1, 0), a3, voffA);
            PG8_BAR; PG8_WAIT_L(0); PG8_MMA(1, 0, At, B0); PG8_BAR; PG8_SCHED;
            PG8_STAGE(PG8_SB(1, 1), b3 + hstep, voffB);
            PG8_WAIT_V(6); PG8_BAR; PG8_MMA(1, 1, At, B1); PG8_BAR;
        }
        PG8_STAMP();
        if constexpr (!Epi::AFTER_DRAIN) { E(acc, cur, wr, wc, fr, fq); S.done(cur); }
        PG8_STAMP();
        if (!has_next) break;
#pragma unroll
        for (int a = 0; a < 2; ++a)
#pragma unroll
            for (int b = 0; b < 2; ++b)
#pragma unroll
                for (int m = 0; m < 4; ++m)
#pragma unroll
                    for (int n = 0; n < 2; ++n) acc[a][b][m][n] = (f32x4){0.f, 0.f, 0.f, 0.f};
        cur = nxt; cA = nA; cB = nB; ++ui;
    }
    PG8_WAIT_V(0);
    if (wr == 0) PG8_BAR;
    PG8_BAR;
    if constexpr (Epi::AFTER_DRAIN) { E.fused(acc, cur, wr, wc, fr, fq, lds, wid, lane); S.done(cur); }
    PG8_STAMP();
    if (STAMP && wid == 0) { stamps[lane] = lane < nts ? (((unsigned long long)(unsigned)ts_hi << 32) | (unsigned)ts_lo) : 0ull;
        if (lane == 62) stamps[62] = rt_entry; if (lane == 63) stamps[63] = (unsigned long long)wall_clock64(); }
#undef PG8_STAMP
#undef PG8_SA
#undef PG8_SB
#undef PG8_STAGE
#undef PG8_LDA
#undef PG8_LDB
#undef PG8_MMA
#undef PG8_WAIT_V
#undef PG8_WAIT_L
#undef PG8_BAR
#undef PG8_SCHED
}
}

typedef unsigned short bf16_t;
__device__ __forceinline__ float wave_sum(float v) {
#pragma unroll
    for (int o = 32; o; o >>= 1) v += __shfl_xor(v, o);
    return v;
}
__device__ __forceinline__ float block_sum(float v, float* red) {
    v = wave_sum(v);
    __syncthreads();
    if ((threadIdx.x & 63) == 0) red[threadIdx.x >> 6] = v;
    __syncthreads();
    float s = 0.f;
#pragma unroll
    for (int i = 0; i < NWAVES; ++i) s += red[i];
    return s;
}
__device__ __forceinline__ int opaque_tid() { int t = threadIdx.x; asm volatile("" : "+v"(t)); return t; }
typedef float nt_f32x4 __attribute__((ext_vector_type(4)));
__device__ __forceinline__ float4 nt_load4(const float* p) { const nt_f32x4 v = __builtin_nontemporal_load((const nt_f32x4*)p); return make_float4(v[0], v[1], v[2], v[3]); }
typedef unsigned nt_u32x4 __attribute__((ext_vector_type(4)));
typedef unsigned nt_u32x2 __attribute__((ext_vector_type(2)));
__device__ __forceinline__ uint4 nt_load4u(const void* p) { const nt_u32x4 v = __builtin_nontemporal_load((const nt_u32x4*)p); return make_uint4(v[0], v[1], v[2], v[3]); }
__device__ __forceinline__ uint2 nt_load2u(const void* p) { const nt_u32x2 v = __builtin_nontemporal_load((const nt_u32x2*)p); return make_uint2(v[0], v[1]); }
__device__ __forceinline__ void nt_store4(float* p, float a, float b, float c, float d) { nt_f32x4 v = {a, b, c, d}; __builtin_nontemporal_store(v, (nt_f32x4*)p); }
__device__ __forceinline__ void nt_store4u(void* p, uint4 v) { nt_u32x4 w = {v.x, v.y, v.z, v.w}; __builtin_nontemporal_store(w, (nt_u32x4*)p); }
__device__ __forceinline__ void nt_store2u(void* p, uint2 v) { nt_u32x2 w = {v.x, v.y}; __builtin_nontemporal_store(w, (nt_u32x2*)p); }
__device__ __forceinline__ float silu(float x) { return x / (1.0f + expf(-x)); }


__device__ __forceinline__ unsigned pk_bf16(float lo, float hi) { unsigned r; asm volatile("v_cvt_pk_bf16_f32 %0, %1, %2" : "=v"(r) : "v"(lo), "v"(hi)); return r; }
__device__ __forceinline__ void transpose_convert(const float* __restrict__ W, bf16_t* __restrict__ Wt, int K, int N, float* lds, int wb0, int nwb) {
    const int tid = opaque_tid();
    const int tk = K / 64, tn = N / 256;
    for (int tile = (int)blockIdx.x - wb0; tile < tk * tn; tile += nwb) {
        const int k0 = (tile / tn) * 64, n0 = (tile % tn) * 256;
        __syncthreads();
        float4 v[8];
#pragma unroll
        for (int i = 0; i < 8; ++i) v[i] = nt_load4(W + (size_t)(k0 + (tid >> 6) + 8 * i) * N + n0 + (tid & 63) * 4);
#pragma unroll
        for (int i = 0; i < 8; ++i) { float* d = lds + ((tid >> 6) + 8 * i) * 257 + (tid & 63) * 4; d[0] = v[i].x; d[1] = v[i].y; d[2] = v[i].z; d[3] = v[i].w; }
        __syncthreads();
#pragma unroll
        for (int q = 0; q < 4; ++q) {
            const int c = q * NTHREADS + tid, n = c >> 3, k8 = (c & 7) * 8;
            uint4 o;
            o.x = pk_bf16(lds[(k8 + 0) * 257 + n], lds[(k8 + 1) * 257 + n]); o.y = pk_bf16(lds[(k8 + 2) * 257 + n], lds[(k8 + 3) * 257 + n]);
            o.z = pk_bf16(lds[(k8 + 4) * 257 + n], lds[(k8 + 5) * 257 + n]); o.w = pk_bf16(lds[(k8 + 6) * 257 + n], lds[(k8 + 7) * 257 + n]);
            *(uint4*)(Wt + (size_t)(n0 + n) * K + k0 + k8) = o;
        }
    }
}
__device__ __forceinline__ float wave_max(float v) {
#pragma unroll
    for (int o = 32; o; o >>= 1) v = fmaxf(v, __shfl_xor(v, o));
    return v;
}
__device__ __forceinline__ float block_max(float v, float* red) {
    v = wave_max(v);
    __syncthreads();
    if ((threadIdx.x & 63) == 0) red[threadIdx.x >> 6] = v;
    __syncthreads();
    float s = red[0];
#pragma unroll
    for (int i = 1; i < NWAVES; ++i) s = fmaxf(s, red[i]);
    return s;
}
__device__ __forceinline__ unsigned q4(float a, float b, float c, float d, float inv, int off) {
    const int x = __float2int_rn(a * inv) + off, y = __float2int_rn(b * inv) + off, z = __float2int_rn(c * inv) + off, w = __float2int_rn(d * inv) + off;
    return (unsigned)(x & 255) | ((unsigned)(y & 255) << 8) | ((unsigned)(z & 255) << 16) | ((unsigned)(w & 255) << 24);
}
constexpr int VROW = 1152;
template <int O> __device__ __forceinline__ unsigned nib8(const float (&x)[16], float inv) {
    unsigned r = 0;
#pragma unroll
    for (int i = 0; i < 8; ++i) r |= (unsigned)(min(max(__float2int_rn(x[O + i] * inv), -7), 7) + 8) << (4 * i);
    return r;
}
__device__ __forceinline__ void quant_tables(const Params& p, int wb0, int nwb) {
    const int tid = opaque_tid(), lane = tid & 63, wv = tid >> 6;
    unsigned char* tq = (unsigned char*)p.ws + B_TQ; float* rsc = p.ws + W_SU;
    const int nw = nwb * NWAVES;
    for (int row0 = ((int)blockIdx.x - wb0) * NWAVES + wv; row0 < 2 * 16384; row0 += 2 * nw) {
        float x[2][2][16]; float mx[2][2];
#pragma unroll
        for (int u = 0; u < 2; ++u) {
            const int row = min(row0 + u * nw, 2 * 16384 - 1);
            const float* src = (row < 16384 ? p.in[I_PU] : p.in[I_PV]) + (size_t)(row & 16383) * D + lane * 4;
#pragma unroll
            for (int h = 0; h < 2; ++h) {
                mx[u][h] = 0.f;
#pragma unroll
                for (int q = 0; q < 4; ++q) { const float4 v = nt_load4(src + (h * 4 + q) * 256); x[u][h][q * 4] = v.x; x[u][h][q * 4 + 1] = v.y; x[u][h][q * 4 + 2] = v.z; x[u][h][q * 4 + 3] = v.w;
                    mx[u][h] = fmaxf(mx[u][h], fmaxf(fmaxf(fabsf(v.x), fabsf(v.y)), fmaxf(fabsf(v.z), fabsf(v.w)))); }
            }
        }
#pragma unroll
        for (int u = 0; u < 2; ++u) {
            const int row = row0 + u * nw;
            if (row < 2 * 16384) {
                unsigned char* dst = tq + (size_t)row * VROW;
                const float rmx = wave_max(fmaxf(mx[u][0], mx[u][1]));
                const float R = rmx > 0.f ? rmx * (1.0f / (7.0f * 240.0f)) : 1.0f, invR = 1.0f / R;
                const int pk = __builtin_amdgcn_cvt_pk_fp8_f32(mx[u][0] * (1.03f / 7.0f) * invR, mx[u][1] * (1.03f / 7.0f) * invR, 0, false);
                const float s0 = __builtin_amdgcn_cvt_f32_fp8(pk, 0) * R, s1 = __builtin_amdgcn_cvt_f32_fp8(pk, 1) * R;
                const float i0 = s0 > 0.f ? 1.0f / s0 : 0.f, i1 = s1 > 0.f ? 1.0f / s1 : 0.f;
                nt_store4u(dst + lane * 16, make_uint4(nib8<0>(x[u][0], i0), nib8<8>(x[u][0], i0), nib8<0>(x[u][1], i1), nib8<8>(x[u][1], i1)));
                *(unsigned short*)(dst + 1024 + lane * 2) = (unsigned short)(pk & 0xffff);
                if (lane == 0) rsc[row] = R;
            }
        }
    }
}

__device__ __forceinline__ void naive_gemm(const float* __restrict__ A, int lda, const float* __restrict__ Bm, int ldb,
                                           float* __restrict__ C, int ldc, int M, int N, int K, float* lds) {
    float* As = lds;
    float* Bs = lds + 16 * 132;
    const int tid = opaque_tid(), tx = tid & 31, ty = tid >> 5;
    const int tilesN = N / 128, ntiles = (M / 128) * tilesN;
    for (int tile = blockIdx.x; tile < ntiles; tile += gridDim.x) {
        const int m0 = (tile / tilesN) * 128, n0 = (tile % tilesN) * 128;
        float acc[8][4];
#pragma unroll
        for (int i = 0; i < 8; ++i)
#pragma unroll
            for (int j = 0; j < 4; ++j) acc[i][j] = 0.f;
        for (int k0 = 0; k0 < K; k0 += 16) {
            {
                const int row = tid >> 2, kq = (tid & 3) * 4;
                const float4 a = *(const float4*)(A + (size_t)(m0 + row) * lda + k0 + kq);
                As[(kq + 0) * 132 + row] = a.x; As[(kq + 1) * 132 + row] = a.y; As[(kq + 2) * 132 + row] = a.z; As[(kq + 3) * 132 + row] = a.w;
                const int kk = tid >> 5, n4 = (tid & 31) * 4;
                *(float4*)(Bs + kk * 128 + n4) = *(const float4*)(Bm + (size_t)(k0 + kk) * ldb + n0 + n4);
            }
            __syncthreads();
#pragma unroll 4
            for (int k = 0; k < 16; ++k) {
                const float4 a0 = *(const float4*)(As + k * 132 + ty * 8), a1 = *(const float4*)(As + k * 132 + ty * 8 + 4);
                const float4 b = *(const float4*)(Bs + k * 128 + tx * 4);
                const float av[8] = {a0.x, a0.y, a0.z, a0.w, a1.x, a1.y, a1.z, a1.w};
                const float bv[4] = {b.x, b.y, b.z, b.w};
#pragma unroll
                for (int i = 0; i < 8; ++i)
#pragma unroll
                    for (int j = 0; j < 4; ++j) acc[i][j] += av[i] * bv[j];
            }
            __syncthreads();
        }
#pragma unroll
        for (int i = 0; i < 8; ++i)
            *(float4*)(C + (size_t)(m0 + ty * 8 + i) * ldc + n0 + tx * 4) = make_float4(acc[i][0], acc[i][1], acc[i][2], acc[i][3]);
    }
}

__device__ __forceinline__ void phase_a(const Params& p, float* lds) {
    const int tid = opaque_tid();
    const float* c = p.in[I_C]; const float* cctx = p.in[I_CCTX]; const float* wada = p.in[I_WADA];
    float* part = p.ws + W_ADAP;
    for (int item = blockIdx.x; item < 32 * 24; item += gridDim.x) {
        const int ks = item / 24, j = (item % 24) * 512 + tid;
        __syncthreads();
        if (tid < 5 * 64) { const int n = tid >> 6, k = ks * 64 + (tid & 63); lds[tid] = silu(n < 4 ? c[n * 2048 + k] : cctx[k]); }
        __syncthreads();
        float a0 = 0.f, a1 = 0.f, a2 = 0.f, a3 = 0.f, a4 = 0.f;
#pragma unroll 32
        for (int kk = 0; kk < 64; ++kk) {
            const float w = __builtin_nontemporal_load(wada + (size_t)(ks * 64 + kk) * 12288 + j);
            a0 += lds[kk] * w; a1 += lds[64 + kk] * w; a2 += lds[128 + kk] * w; a3 += lds[192 + kk] * w; a4 += lds[256 + kk] * w;
        }
        part[(size_t)(ks * 5 + 0) * 12288 + j] = a0; part[(size_t)(ks * 5 + 1) * 12288 + j] = a1; part[(size_t)(ks * 5 + 2) * 12288 + j] = a2;
        part[(size_t)(ks * 5 + 3) * 12288 + j] = a3; part[(size_t)(ks * 5 + 4) * 12288 + j] = a4;
    }
}
typedef short bf16x8v __attribute__((ext_vector_type(8)));
typedef float f32x4v __attribute__((ext_vector_type(4)));
typedef float f32x16v __attribute__((ext_vector_type(16)));
__device__ __forceinline__ void phase_filters(const Params& p, float* lds) {
    const int tid = opaque_tid();
    const float* w1 = p.in[I_FW1]; const float* b1 = p.in[I_FB1]; const float* w2 = p.in[I_FW2]; const float* b2 = p.in[I_FB2];
    const float* w3 = p.in[I_FW3]; const float* b3 = p.in[I_FB3]; const float* w4 = p.in[I_FW4]; const float* freq = p.in[I_FREQ];
    float* hT = (float*)((char*)p.ws + B_KF); float* sp = p.ws + W_SP;
    float* zf = lds; float* ha = lds + 64 * 36; float* hb = ha + 64 * 68; float* red2 = hb + 64 * 68;
    float* W1 = red2 + 256; float* W2 = W1 + 33 * 64; float* W3 = W2 + 64 * 64;
    __syncthreads();
    for (int e = tid; e < 33 * 64; e += NTHREADS) W1[e] = w1[e];
    for (int e = tid; e < 64 * 64; e += NTHREADS) { W2[e] = w2[e]; W3[e] = w3[e]; }
    for (int item = blockIdx.x; item < 256; item += gridDim.x) {
        const int pt = item >> 3;
        __syncthreads();
        for (int e = tid; e < 64 * 33; e += NTHREADS) {
            const int pos = e / 33, m = e % 33, i = pt * 64 + pos;
            const float t = (float)i / 2047.0f, w = 6.283185307179586f * (float)i / 2048.0f;
            float v;
            if (m == 0) v = t;
            else if (m <= 16) { const float f = 1e-4f + (float)(m - 1) * ((15.0f - 1e-4f) / 15.0f); v = __cosf(f * w); }
            else { const float f = 1e-4f + (float)(m - 17) * ((15.0f - 1e-4f) / 15.0f); v = -__sinf(f * w); }
            zf[pos * 36 + m] = v;
        }
        __syncthreads();
        const int pos = tid >> 3, u0 = (tid & 7) * 8;
        {
            float a[8];
#pragma unroll
            for (int u = 0; u < 8; ++u) a[u] = b1[u0 + u];
#pragma unroll 11
            for (int m = 0; m < 33; ++m) { const float zv = zf[pos * 36 + m]; const float4 wa = *(const float4*)(W1 + m * 64 + u0), wb = *(const float4*)(W1 + m * 64 + u0 + 4);
                a[0] += zv * wa.x; a[1] += zv * wa.y; a[2] += zv * wa.z; a[3] += zv * wa.w; a[4] += zv * wb.x; a[5] += zv * wb.y; a[6] += zv * wb.z; a[7] += zv * wb.w; }
#pragma unroll
            for (int u = 0; u < 8; ++u) ha[pos * 68 + u0 + u] = __sinf(freq[u0 + u] * a[u]);
        }
        __syncthreads();
        {
            float a[8];
#pragma unroll
            for (int u = 0; u < 8; ++u) a[u] = b2[u0 + u];
#pragma unroll 16
            for (int m = 0; m < 64; ++m) { const float zv = ha[pos * 68 + m]; const float4 wa = *(const float4*)(W2 + m * 64 + u0), wb = *(const float4*)(W2 + m * 64 + u0 + 4);
                a[0] += zv * wa.x; a[1] += zv * wa.y; a[2] += zv * wa.z; a[3] += zv * wa.w; a[4] += zv * wb.x; a[5] += zv * wb.y; a[6] += zv * wb.z; a[7] += zv * wb.w; }
#pragma unroll
            for (int u = 0; u < 8; ++u) hb[pos * 68 + u0 + u] = __sinf(freq[64 + u0 + u] * a[u]);
        }
        __syncthreads();
        {
            float a[8];
#pragma unroll
            for (int u = 0; u < 8; ++u) a[u] = b3[u0 + u];
#pragma unroll 16
            for (int m = 0; m < 64; ++m) { const float zv = hb[pos * 68 + m]; const float4 wa = *(const float4*)(W3 + m * 64 + u0), wb = *(const float4*)(W3 + m * 64 + u0 + 4);
                a[0] += zv * wa.x; a[1] += zv * wa.y; a[2] += zv * wa.z; a[3] += zv * wa.w; a[4] += zv * wb.x; a[5] += zv * wb.y; a[6] += zv * wb.z; a[7] += zv * wb.w; }
#pragma unroll
            for (int u = 0; u < 8; ++u) ha[pos * 68 + u0 + u] = __sinf(freq[128 + u0 + u] * a[u]);
        }
        __syncthreads();
#pragma unroll 1
        for (int jt = (item & 7) * 2; jt < (item & 7) * 2 + 2; ++jt) {
            const int lane = tid & 63, wv = tid >> 6, cl = lane & 15, g = lane >> 4;
            union frag { unsigned u[4]; bf16x8v v; };
            frag af[2][2];
#pragma unroll
            for (int mt = 0; mt < 2; ++mt)
#pragma unroll
                for (int ks = 0; ks < 2; ++ks) {
                    const float* wp = w4 + (size_t)(ks * 32 + 8 * g) * 4096 + jt * 256 + wv * 32 + mt * 16 + cl;
                    float x[8];
#pragma unroll
                    for (int i = 0; i < 8; ++i) x[i] = wp[(size_t)i * 4096];
                    af[mt][ks].u[0] = pk_bf16(x[0], x[1]); af[mt][ks].u[1] = pk_bf16(x[2], x[3]); af[mt][ks].u[2] = pk_bf16(x[4], x[5]); af[mt][ks].u[3] = pk_bf16(x[6], x[7]);
                }
            f32x4v acc[2][4];
#pragma unroll
            for (int mt = 0; mt < 2; ++mt)
#pragma unroll
                for (int nt = 0; nt < 4; ++nt) acc[mt][nt] = (f32x4v){0.f, 0.f, 0.f, 0.f};
#pragma unroll
            for (int nt = 0; nt < 4; ++nt)
#pragma unroll
                for (int ks = 0; ks < 2; ++ks) {
                    const float4 h0 = *(const float4*)(ha + (nt * 16 + cl) * 68 + ks * 32 + 8 * g), h1 = *(const float4*)(ha + (nt * 16 + cl) * 68 + ks * 32 + 8 * g + 4);
                    frag bf; bf.u[0] = pk_bf16(h0.x, h0.y); bf.u[1] = pk_bf16(h0.z, h0.w); bf.u[2] = pk_bf16(h1.x, h1.y); bf.u[3] = pk_bf16(h1.z, h1.w);
#pragma unroll
                    for (int mt = 0; mt < 2; ++mt) acc[mt][nt] = __builtin_amdgcn_mfma_f32_16x16x32_bf16(af[mt][ks].v, bf.v, acc[mt][nt], 0, 0, 0);
                }
#pragma unroll
            for (int mt = 0; mt < 2; ++mt)
#pragma unroll
                for (int r = 0; r < 4; ++r) {
                    const int j = jt * 256 + wv * 32 + mt * 16 + 4 * g + r;
                    const float delta = 3.070113457f + (float)(j & 1023) * ((15.35056729f - 3.070113457f) / 1023.0f);
                    float asum = 0.f;
#pragma unroll
                    for (int nt = 0; nt < 4; ++nt) {
                        const int ps = pt * 64 + nt * 16 + cl;
                        const float val = acc[mt][nt][r] * __expf(-((float)ps / 2047.0f) * delta);
                        asum += fabsf(val);
                        __builtin_nontemporal_store(val, hT + (size_t)j * SL + ps);
                    }
                    asum += __shfl_xor(asum, 1); asum += __shfl_xor(asum, 2); asum += __shfl_xor(asum, 4); asum += __shfl_xor(asum, 8);
                    if (cl == 0) sp[(size_t)pt * 4096 + j] = asum;
                }
        }
    }
}

__device__ __forceinline__ void phase_b(const Params& p) {
    const int tid = opaque_tid();
    const float* part = p.ws + W_ADAP; float* ada = p.ws + W_ADA; const float* bada = p.in[I_BADA];
    for (int e = blockIdx.x * NTHREADS + tid; e < 5 * 12288; e += gridDim.x * NTHREADS) {
        float s = bada[e % 12288];
#pragma unroll 8
        for (int ks = 0; ks < 32; ++ks) s += part[(size_t)ks * 5 * 12288 + e];
        ada[e] = s;
    }
    const float* sp = p.ws + W_SP; float* fs = p.ws + W_FS;
    for (int j = blockIdx.x * NTHREADS + tid; j < 4096; j += gridDim.x * NTHREADS) {
        float s = 0.f;
#pragma unroll 8
        for (int pt = 0; pt < 32; ++pt) s += sp[(size_t)pt * 4096 + j];
        fs[j] = s;
    }
}

__device__ __forceinline__ void phase_c(const Params& p) {
    const int tid = opaque_tid();
    const float* ada = p.ws + W_ADA;
    const float* x = p.in[I_X]; bf16_t* ub = (bf16_t*)((char*)p.ws + B_UB);
    for (size_t e = (size_t)blockIdx.x * NTHREADS + tid; e < (size_t)NT * D / 4; e += (size_t)gridDim.x * NTHREADS) {
        const size_t row = e / (D / 4); const int col = (int)(e % (D / 4)) * 4; const int b = (int)(row / SL);
        const float4 xv = nt_load4(x + row * D + col);
        const float4 sh = *(const float4*)(ada + b * 12288 + col), sc = *(const float4*)(ada + b * 12288 + 2048 + col);
        uint2 o; o.x = pk_bf16(xv.x * (1.f + sc.x) + sh.x, xv.y * (1.f + sc.y) + sh.y); o.y = pk_bf16(xv.z * (1.f + sc.z) + sh.z, xv.w * (1.f + sc.w) + sh.w);
        *(uint2*)(ub + row * D + col) = o;
    }
    const float* ctx = p.in[I_CTX]; bf16_t* ucb = ub + (size_t)NT * D;
    for (size_t e = (size_t)blockIdx.x * NTHREADS + tid; e < (size_t)NTC * D / 4; e += (size_t)gridDim.x * NTHREADS) {
        const size_t row = e / (D / 4); const int col = (int)(e % (D / 4)) * 4;
        const float4 xv = nt_load4(ctx + row * D + col);
        const float4 sh = *(const float4*)(ada + 4 * 12288 + col), sc = *(const float4*)(ada + 4 * 12288 + 2048 + col);
        uint2 o; o.x = pk_bf16(xv.x * (1.f + sc.x) + sh.x, xv.y * (1.f + sc.y) + sh.y); o.y = pk_bf16(xv.z * (1.f + sc.z) + sh.z, xv.w * (1.f + sc.w) + sh.w);
        *(uint2*)(ucb + row * D + col) = o;
    }
}

__device__ __forceinline__ float bf2f(bf16_t v) { return __uint_as_float(((unsigned)v) << 16); }
constexpr int HY_PB = 4416, HY_PJ = 272, HY_R0 = 4 * HY_PB, HY_R1 = HY_R0 + 8192 + 64, HY_SLOT = HY_R1 + 8192 + 64;
static_assert(HY_SLOT % 16 == 0 && 4 * HY_SLOT + 64 <= 155 * 1024, "hyena LDS");
__device__ __forceinline__ bf16x8v hy_lda(const unsigned char* base, int off) {
    const unsigned* q = (const unsigned*)(base + off);
    union { unsigned u[4]; bf16x8v v; } r; r.u[0] = q[0]; r.u[1] = q[1]; r.u[2] = q[2]; r.u[3] = q[3];
    return r.v;
}
__device__ __forceinline__ void hy_stage_rows(const bf16_t* zT, const float* cw, const float* cb, int ch, int half, int lane, unsigned char* sl) {
    const float w0 = cw[ch], w1 = cw[3072 + ch], w2 = cw[6144 + ch], bs = cb[ch];
#pragma unroll 4
    for (int q = 0; q < 8; ++q) {
        const int bsel = 2 * half + (q >> 2), t0 = ((q & 3) * 64 + lane) * 8;
        const bf16_t* zrow = zT + (size_t)ch * NT + bsel * SL;
        const uint4 raw = nt_load4u(zrow + t0);
        float z[10];
        z[0] = t0 > 0 ? bf2f(zrow[t0 - 1]) : 0.f; z[9] = t0 + 8 < SL ? bf2f(zrow[t0 + 8]) : 0.f;
        z[1] = __uint_as_float(raw.x << 16); z[2] = __uint_as_float(raw.x & 0xffff0000u); z[3] = __uint_as_float(raw.y << 16); z[4] = __uint_as_float(raw.y & 0xffff0000u);
        z[5] = __uint_as_float(raw.z << 16); z[6] = __uint_as_float(raw.z & 0xffff0000u); z[7] = __uint_as_float(raw.w << 16); z[8] = __uint_as_float(raw.w & 0xffff0000u);
        float sv[8];
#pragma unroll
        for (int i = 0; i < 8; ++i) sv[i] = w0 * z[i] + w1 * z[i + 1] + w2 * z[i + 2] + bs;
        uint4 o; o.x = pk_bf16(sv[0], sv[1]); o.y = pk_bf16(sv[2], sv[3]); o.z = pk_bf16(sv[4], sv[5]); o.w = pk_bf16(sv[6], sv[7]);
        *(uint4*)(sl + bsel * HY_PB + (t0 >> 7) * HY_PJ + (t0 & 127) * 2) = o;
    }
}
__device__ __forceinline__ void hy_pair_sync(volatile __attribute__((address_space(3))) unsigned* fl, int wv, unsigned n) {
    asm volatile("s_waitcnt lgkmcnt(0)" ::: "memory");
    fl[wv] = n;
    while (fl[wv ^ 1] < n) __builtin_amdgcn_s_sleep(0);
    asm volatile("" ::: "memory");
}
__device__ __forceinline__ void phase_hyena(const Params& p, unsigned char* smem) {
    const int tid = opaque_tid(), lane = tid & 63, wv = tid >> 6, slot = wv >> 1, half = wv & 1, pt = tid & 127;
    const bf16_t* zT = (const bf16_t*)((const char*)p.ws + B_ZT); const float* hT = (const float*)((const char*)p.ws + B_KF); const float* fs = p.ws + W_FS; bf16_t* hyT = (bf16_t*)((char*)p.ws + B_HYT);
    const float* cw = p.in[I_CONVW]; const float* cb = p.in[I_CONVB]; const float* skip = p.in[I_SKIP];
    unsigned char* sl = smem + slot * HY_SLOT;
    const int a_ = lane & 31, hh = lane >> 5, i_local = a_ >> 2, batch = a_ & 3, I0 = 8 * half;
    const int laneA = ((a_ & 1) ? HY_R0 : HY_R1) + 2 * (2047 - a_ - (1 - (a_ & 1)) + 8 * hh);
    volatile __attribute__((address_space(3))) unsigned* fl = (volatile __attribute__((address_space(3))) unsigned*)(smem + 4 * HY_SLOT);
    unsigned seq = 0u;
    __syncthreads();
    if (tid < 8) fl[tid] = 0u;
    if (wv < 4) __builtin_amdgcn_s_setprio(2);
    for (int item = blockIdx.x; item < DHY / 4; item += gridDim.x) {
        const int c = item * 4 + slot;
        __syncthreads();
        hy_stage_rows(zT, cw, cb, c, half, lane, sl);
#pragma unroll 1
        for (int ord = 0; ord < 2; ++ord) {
            {
                const float* hf = hT + (size_t)((ord * 2 + 0) * 1024 + c) * SL; const float* hbk = hT + (size_t)((ord * 2 + 1) * 1024 + c) * SL;
                const float sk = skip[ord * 1024 + c]; const float invs = 1.0f / (fs[(ord * 2 + 0) * 1024 + c] + fs[(ord * 2 + 1) * 1024 + c]);
#pragma unroll
                for (int q = 0; q < 4; ++q) {
                    const int X0 = (q * 128 + pt) * 8;
                    float rv[9];
#pragma unroll
                    for (int i = 0; i < 9; ++i) { const int dp = 2047 - X0 - i; rv[i] = (dp >= 0 ? __builtin_nontemporal_load(hf + dp) : (dp >= -2047 ? __builtin_nontemporal_load(hbk - dp) : 0.f)) * invs; if (dp == 0) rv[i] += sk; }
                    uint4 o0, o1;
                    o0.x = pk_bf16(rv[0], rv[1]); o0.y = pk_bf16(rv[2], rv[3]); o0.z = pk_bf16(rv[4], rv[5]); o0.w = pk_bf16(rv[6], rv[7]);
                    o1.x = pk_bf16(rv[1], rv[2]); o1.y = pk_bf16(rv[3], rv[4]); o1.z = pk_bf16(rv[5], rv[6]); o1.w = pk_bf16(rv[7], rv[8]);
                    *(uint4*)(sl + HY_R0 + X0 * 2) = o0; *(uint4*)(sl + HY_R1 + X0 * 2) = o1;
                }
            }
            hy_pair_sync(fl, wv, ++seq);
            f32x16v acc[4];
#pragma unroll
            for (int mb = 0; mb < 4; ++mb)
#pragma unroll
                for (int e = 0; e < 16; ++e) acc[mb][e] = 0.f;
            {
                const int dlo = I0 - 15, dhi = I0 + 7;
                bf16x8v As[7][2];
#pragma unroll
                for (int s2 = 0; s2 < 3; ++s2)
#pragma unroll
                    for (int k2 = 0; k2 < 2; ++k2) As[4 + s2][k2] = hy_lda(sl, laneA - 64 * (4 * dlo - 3 + s2) + 32 * k2);
#pragma unroll 1
                for (int d = dlo; d <= dhi; ++d) {
#pragma unroll
                    for (int k2 = 0; k2 < 2; ++k2) { As[0][k2] = As[4][k2]; As[1][k2] = As[5][k2]; As[2][k2] = As[6][k2]; }
#pragma unroll
                    for (int s2 = 3; s2 < 7; ++s2)
#pragma unroll
                        for (int k2 = 0; k2 < 2; ++k2) As[s2][k2] = hy_lda(sl, laneA - 64 * (4 * d - 3 + s2) + 32 * k2);
                    const int jl = I0 + i_local - d; const bool valid = (unsigned)jl < 16u;
                    const unsigned char* bp = sl + batch * HY_PB + (valid ? jl : 0) * HY_PJ + hh * 16;
                    bf16x8v Bq[8];
#pragma unroll
                    for (int q = 0; q < 8; ++q) { const bf16x8v v = *(const bf16x8v*)(bp + q * 32); const bf16x8v zero = {0, 0, 0, 0, 0, 0, 0, 0}; Bq[q] = valid ? v : zero; }
#pragma unroll
                    for (int kb = 0; kb < 4; ++kb)
#pragma unroll
                        for (int k2 = 0; k2 < 2; ++k2)
#pragma unroll
                            for (int mb = 0; mb < 4; ++mb) acc[mb] = __builtin_amdgcn_mfma_f32_32x32x16_bf16(As[mb - kb + 3][k2], Bq[2 * kb + k2], acc[mb], 0, 0, 0);
                }
            }
            hy_pair_sync(fl, wv, ++seq);
            hy_stage_rows(zT, cw, cb, (ord == 0 ? 1024 : 2048) + c, half, lane, sl);
            hy_pair_sync(fl, wv, ++seq);
            {
#pragma unroll
                for (int mb = 0; mb < 4; ++mb)
#pragma unroll
                    for (int q4 = 0; q4 < 4; ++q4) {
                        const int t4 = 128 * (I0 + i_local) + 32 * mb + 8 * q4 + 4 * hh;
                        uint2* gp = (uint2*)(sl + batch * HY_PB + (t4 >> 7) * HY_PJ + (t4 & 127) * 2);
                        const uint2 gv = *gp;
                        uint2 o; o.x = pk_bf16(__uint_as_float(gv.x << 16) * acc[mb][q4 * 4 + 0], __uint_as_float(gv.x & 0xffff0000u) * acc[mb][q4 * 4 + 1]);
                        o.y = pk_bf16(__uint_as_float(gv.y << 16) * acc[mb][q4 * 4 + 2], __uint_as_float(gv.y & 0xffff0000u) * acc[mb][q4 * 4 + 3]);
                        *gp = o;
                    }
            }
            if (ord == 1) {
                hy_pair_sync(fl, wv, ++seq);
#pragma unroll
                for (int q = 0; q < 8; ++q) {
                    const int bsel = 2 * half + (q >> 2), t0 = ((q & 3) * 64 + lane) * 8;
                    nt_store4u(hyT + (size_t)c * NT + bsel * SL + t0, *(const uint4*)(sl + bsel * HY_PB + (t0 >> 7) * HY_PJ + (t0 & 127) * 2));
                }
            }
        }
    }
    __builtin_amdgcn_s_setprio(0);
}

__device__ __forceinline__ bf16x8v pack_p(const f32x4v& lo, const f32x4v& hi) {
    union { unsigned u[4]; bf16x8v v; } r;
    r.u[0] = pk_bf16(lo[0], lo[1]); r.u[1] = pk_bf16(lo[2], lo[3]); r.u[2] = pk_bf16(hi[0], hi[1]); r.u[3] = pk_bf16(hi[2], hi[3]);
    return r.v;
}
__device__ __forceinline__ bf16x8v ld_pair8(const bf16_t* lo, const bf16_t* hi) {
    union { uint2 d[2]; bf16x8v v; } r;
    r.d[0] = *(const uint2*)lo; r.d[1] = *(const uint2*)hi;
    return r.v;
}
typedef __attribute__((address_space(3))) const bf16_t* lds_bf16p;
#define LDS_FRAG(pe) (*(const __attribute__((address_space(3))) bf16x8v*)(pe))
constexpr int NA_KC = 0, NA_VC = 32768, NA_KL = 65536, NA_RPB = 155648;
__device__ __forceinline__ void phase_na(const Params& p, unsigned char* smem) {
    const int tid = opaque_tid(), lane = tid & 63, wv = tid >> 6, ql = lane & 15, g = lane >> 4;
    const bf16_t* qh = (const bf16_t*)((const char*)p.ws + B_QH); const bf16_t* kh = (const bf16_t*)((const char*)p.ws + B_KH);
    const bf16_t* kch = (const bf16_t*)((const char*)p.ws + B_KCH); const bf16_t* vT = (const bf16_t*)((const char*)p.ws + B_VT);
    const bf16_t* vcT = (const bf16_t*)((const char*)p.ws + B_VCT); bf16_t* na = (bf16_t*)((char*)p.ws + B_NA);
    const float* rpb = p.in[I_RPB];
    const lds_bf16p kcl = (lds_bf16p)((__attribute__((address_space(3))) unsigned char*)smem + NA_KC);
    const lds_bf16p vcl = (lds_bf16p)((__attribute__((address_space(3))) unsigned char*)smem + NA_VC);
    const lds_bf16p kll = (lds_bf16p)((__attribute__((address_space(3))) unsigned char*)smem + NA_KL);
    for (int sitem = blockIdx.x; sitem < 256; sitem += gridDim.x) {
      const int b = sitem >> 6, h = (sitem >> 2) & 15, rqp = sitem & 3;
      __syncthreads();
      {
          const uint4* s0 = (const uint4*)(kch + (size_t)((b * 16 + h) * 32) * 512); const uint4* s1 = (const uint4*)(vcT + (size_t)((b * 16 + h) * 32) * 512);
          uint4* d0 = (uint4*)(smem + NA_KC); uint4* d1 = (uint4*)(smem + NA_VC);
#pragma unroll
          for (int i = 0; i < 4; ++i) { d0[tid + i * NTHREADS] = s0[tid + i * NTHREADS]; d1[tid + i * NTHREADS] = s1[tid + i * NTHREADS]; }
          if (tid < 465) ((float*)(smem + NA_RPB))[tid] = rpb[h * 465 + tid];
      }
#pragma unroll 1
      for (int half = 0; half < 2; ++half) {
        const int r0 = rqp * 8 + half * 4;
        const int rs_min = min(max(r0 - 4, 0), 24), rs_max = min(max(r0 - 1, 0), 24), nrows = rs_max - rs_min + 8;
        if (half) __syncthreads();
        {
            const uint4* s0 = (const uint4*)(kh + (size_t)((b * 16 + h) * 256 + rs_min * 8) * 512); uint4* d0 = (uint4*)(smem + NA_KL);
            for (int e = tid; e < nrows * 512; e += NTHREADS) d0[e] = s0[e];
        }
        __syncthreads();
#pragma unroll 1
        for (int ti = 0; ti < 2; ++ti) {
        const int r = r0 + (wv >> 2) + 2 * ti, j = wv & 3;
        const int rs = min(max(r - 4, 0), 24), cs = min(max(16 * j - 8, 0), 32);
        const int x = 16 * j + ql, wsx = min(max(x - 8, 0), 48);
        const bf16_t* qrow = qh + ((size_t)((b * 16 + h) * SL + r * 64 + x)) * 64;
        const bf16x8v qf0 = __builtin_nontemporal_load((const bf16x8v*)(qrow + 8 * g)), qf1 = __builtin_nontemporal_load((const bf16x8v*)(qrow + 32 + 8 * g));
        const __attribute__((address_space(3))) float* rp_h = (const __attribute__((address_space(3))) float*)((__attribute__((address_space(3))) unsigned char*)smem + NA_RPB);
        f32x4v o1[4], o2[4]; float m1 = -1e30f, l1 = 0.f, m2 = -1e30f, l2 = 0.f;
#pragma unroll
        for (int d = 0; d < 4; ++d) { o1[d] = (f32x4v){0.f, 0.f, 0.f, 0.f}; o2[d] = (f32x4v){0.f, 0.f, 0.f, 0.f}; }
        const int koff = (ql >> 2) * 512 + g * 32 + (ql & 3) * 8;
        const bf16_t* vb = vT + (size_t)((b * 16 + h) * 256 + g) * 512 + ql * 8;
        {
            f32x4v st[16];
#pragma unroll
            for (int kb = 0; kb < 16; ++kb) {
                const lds_bf16p kp = kcl + koff + (kb >> 1) * 2048 + (kb & 1) * 128;
                const bf16x8v a0 = LDS_FRAG(kp), a1 = LDS_FRAG(kp + 256);
                f32x4v acc = {0.f, 0.f, 0.f, 0.f};
                acc = __builtin_amdgcn_mfma_f32_16x16x32_bf16(a0, qf0, acc, 0, 0, 0);
                acc = __builtin_amdgcn_mfma_f32_16x16x32_bf16(a1, qf1, acc, 0, 0, 0);
#pragma unroll
                for (int rr = 0; rr < 4; ++rr) { acc[rr] *= 0.125f; m1 = fmaxf(m1, acc[rr]); }
                st[kb] = acc;
            }
            m1 = fmaxf(m1, __shfl_xor(m1, 16)); m1 = fmaxf(m1, __shfl_xor(m1, 32));
#pragma unroll
            for (int kb = 0; kb < 16; ++kb)
#pragma unroll
                for (int rr = 0; rr < 4; ++rr) { const float e = __expf(st[kb][rr] - m1); st[kb][rr] = e; l1 += e; }
            l1 += __shfl_xor(l1, 16); l1 += __shfl_xor(l1, 32);
#pragma unroll
            for (int kp = 0; kp < 8; ++kp) {
                const bf16x8v pb = pack_p(st[2 * kp], st[2 * kp + 1]);
#pragma unroll
                for (int d = 0; d < 4; ++d) o1[d] = __builtin_amdgcn_mfma_f32_16x16x32_bf16(LDS_FRAG(vcl + g * 512 + ql * 8 + kp * 2048 + d * 128), pb, o1[d], 0, 0, 0);
            }
        }
        {
            f32x4v st[16];
#pragma unroll
            for (int kb = 0; kb < 16; ++kb) {
                const lds_bf16p kp = kll + koff + ((((rs + (kb >> 1) - rs_min) * 64 + cs) >> 3) * 512) + (kb & 1) * 128;
                const bf16x8v a0 = LDS_FRAG(kp), a1 = LDS_FRAG(kp + 256);
                f32x4v acc = {0.f, 0.f, 0.f, 0.f};
                acc = __builtin_amdgcn_mfma_f32_16x16x32_bf16(a0, qf0, acc, 0, 0, 0);
                acc = __builtin_amdgcn_mfma_f32_16x16x32_bf16(a1, qf1, acc, 0, 0, 0);
                const int dr = rs + (kb >> 1) - r + 7;
#pragma unroll
                for (int rr = 0; rr < 4; ++rr) {
                    const int kc = cs + 8 * g + 4 * (kb & 1) + rr, rel = kc - wsx;
                    const bool ok = rel >= 0 && rel < 16;
                    const int dc = min(max(kc - x + 15, 0), 30);
                    const float sv = ok ? acc[rr] * 0.125f + rp_h[dr * 31 + dc] : -1e30f;
                    acc[rr] = sv; m2 = fmaxf(m2, sv);
                }
                st[kb] = acc;
                if ((kb & 7) == 7) asm volatile("" ::: "memory");
            }
            m2 = fmaxf(m2, __shfl_xor(m2, 16)); m2 = fmaxf(m2, __shfl_xor(m2, 32));
#pragma unroll
            for (int kb = 0; kb < 16; ++kb)
#pragma unroll
                for (int rr = 0; rr < 4; ++rr) { const float e = __expf(st[kb][rr] - m2); st[kb][rr] = e; l2 += e; }
            l2 += __shfl_xor(l2, 16); l2 += __shfl_xor(l2, 32);
#pragma unroll
            for (int kp = 0; kp < 8; ++kp) {
                const bf16x8v pb = pack_p(st[2 * kp], st[2 * kp + 1]);
                const bf16_t* vp = vb + (size_t)(((rs + kp) * 64 + cs) >> 3) * 512;
#pragma unroll
                for (int d = 0; d < 4; ++d) o2[d] = __builtin_amdgcn_mfma_f32_16x16x32_bf16(*(const bf16x8v*)(vp + d * 128), pb, o2[d], 0, 0, 0);
                if ((kp & 3) == 3) asm volatile("" ::: "memory");
            }
        }
        const float mm = fmaxf(m1, m2), c1 = __expf(m1 - mm), c2 = __expf(m2 - mm);
        const float inv = 1.0f / (c1 * l1 + c2 * l2);
        const float w1 = c1 * inv, w2 = c2 * inv;
        f32x4v o[4];
#pragma unroll
        for (int d = 0; d < 4; ++d) o[d] = o1[d] * w1 + o2[d] * w2;
        bf16_t* op = na + (size_t)(b * SL + r * 64 + x) * DNA + h * 64 + 4 * g;
#pragma unroll
        for (int d = 0; d < 4; ++d) { uint2 w; w.x = pk_bf16(o[d][0], o[d][1]); w.y = pk_bf16(o[d][2], o[d][3]); nt_store2u(op + 16 * d, w); }
        }
      }
    }
}

__device__ __forceinline__ void phase_f(const Params& p, float* ldsf) {
    const int tid = opaque_tid();
    const bf16_t* hyT = (const bf16_t*)((const char*)p.ws + B_HYT); const bf16_t* na = (const bf16_t*)((const char*)p.ws + B_NA);
    bf16_t* ob = (bf16_t*)((char*)p.ws + B_UB);
    const float* ghy = p.in[I_GHY]; const float* gna = p.in[I_GNA];
    bf16_t* tile = (bf16_t*)ldsf;
    for (int item = blockIdx.x; item < NT / 32; item += gridDim.x) {
        const int t0 = item * 32;
        __syncthreads();
        uint4 hvv[8];
#pragma unroll
        for (int q = 0; q < 8; ++q) { const int e = q * NTHREADS + tid; hvv[q] = nt_load4u(hyT + (size_t)(e >> 2) * NT + t0 + (e & 3) * 8); }
#pragma unroll
        for (int q = 0; q < 8; ++q) {
            const int e = q * NTHREADS + tid, ch = e >> 2, part = e & 3;
            const unsigned wd[4] = {hvv[q].x, hvv[q].y, hvv[q].z, hvv[q].w};
#pragma unroll
            for (int i = 0; i < 4; ++i) { tile[(part * 8 + 2 * i) * 1032 + ch] = (bf16_t)(wd[i] & 0xffffu); tile[(part * 8 + 2 * i + 1) * 1032 + ch] = (bf16_t)(wd[i] >> 16); }
        }
        __syncthreads();
        const int tk = tid >> 4, sub = tid & 15;
        float hv[64]; float sh = 0.f, sn = 0.f;
#pragma unroll
        for (int i = 0; i < 8; ++i) {
            const uint4 v = *(const uint4*)(tile + tk * 1032 + (i * 16 + sub) * 8);
            const unsigned wd[4] = {v.x, v.y, v.z, v.w};
#pragma unroll
            for (int k = 0; k < 4; ++k) { const float a = __uint_as_float(wd[k] << 16), c = __uint_as_float(wd[k] & 0xffff0000u); hv[i * 8 + 2 * k] = a; hv[i * 8 + 2 * k + 1] = c; sh += a * a + c * c; }
        }
        const bf16_t* nrow = na + (size_t)(t0 + tk) * DNA;
        uint4 nv[8];
#pragma unroll
        for (int i = 0; i < 8; ++i) { nv[i] = nt_load4u(nrow + (i * 16 + sub) * 8);
            const unsigned wd[4] = {nv[i].x, nv[i].y, nv[i].z, nv[i].w};
#pragma unroll
            for (int k = 0; k < 4; ++k) { const float a = __uint_as_float(wd[k] << 16), c = __uint_as_float(wd[k] & 0xffff0000u); sn += a * a + c * c; } }
        sh += __shfl_xor(sh, 1); sh += __shfl_xor(sh, 2); sh += __shfl_xor(sh, 4); sh += __shfl_xor(sh, 8);
        sn += __shfl_xor(sn, 1); sn += __shfl_xor(sn, 2); sn += __shfl_xor(sn, 4); sn += __shfl_xor(sn, 8);
        const float rh = rsqrtf(sh * (1.0f / 1024.0f) + LN_EPS), rn = rsqrtf(sn * (1.0f / 1024.0f) + LN_EPS);
        bf16_t* orow = ob + (size_t)(t0 + tk) * D;
#pragma unroll
        for (int i = 0; i < 8; ++i) {
            const float4 g0 = *(const float4*)(ghy + (i * 16 + sub) * 8), g1 = *(const float4*)(ghy + (i * 16 + sub) * 8 + 4);
            uint4 w; w.x = pk_bf16(hv[i * 8] * rh * g0.x, hv[i * 8 + 1] * rh * g0.y); w.y = pk_bf16(hv[i * 8 + 2] * rh * g0.z, hv[i * 8 + 3] * rh * g0.w);
            w.z = pk_bf16(hv[i * 8 + 4] * rh * g1.x, hv[i * 8 + 5] * rh * g1.y); w.w = pk_bf16(hv[i * 8 + 6] * rh * g1.z, hv[i * 8 + 7] * rh * g1.w);
            *(uint4*)(orow + (i * 16 + sub) * 8) = w;
        }
#pragma unroll
        for (int i = 0; i < 8; ++i) {
            const float4 g0 = *(const float4*)(gna + (i * 16 + sub) * 8), g1 = *(const float4*)(gna + (i * 16 + sub) * 8 + 4);
            const unsigned wd[4] = {nv[i].x, nv[i].y, nv[i].z, nv[i].w};
            float a[8];
#pragma unroll
            for (int k = 0; k < 4; ++k) { a[2 * k] = __uint_as_float(wd[k] << 16); a[2 * k + 1] = __uint_as_float(wd[k] & 0xffff0000u); }
            uint4 w; w.x = pk_bf16(a[0] * rn * g0.x, a[1] * rn * g0.y); w.y = pk_bf16(a[2] * rn * g0.z, a[3] * rn * g0.w);
            w.z = pk_bf16(a[4] * rn * g1.x, a[5] * rn * g1.y); w.w = pk_bf16(a[6] * rn * g1.z, a[7] * rn * g1.w);
            *(uint4*)(orow + DHY + (i * 16 + sub) * 8) = w;
        }
    }
}

__device__ __forceinline__ void phase_h(const Params& p) {
    const int tid = opaque_tid(), lane = tid & 63, wv = tid >> 6;
    const float* x = p.in[I_X]; const bf16_t* y = (const bf16_t*)((const char*)p.ws + B_Y); const float* ada = p.ws + W_ADA;
    const float* g = p.in[I_LN1G]; const float* be = p.in[I_LN1B];
    bf16_t* x1 = (bf16_t*)((char*)p.ws + B_X1); bf16_t* u2b = (bf16_t*)((char*)p.ws + B_UB); unsigned* u2q = (unsigned*)((char*)p.ws + B_U2Q); float* su2 = p.ws + W_SU2;
#pragma unroll 1
    for (int tp = blockIdx.x * NWAVES + wv; tp < NT / 2; tp += gridDim.x * NWAVES) {
        const int b = (2 * tp) / SL;
        float v[2][32]; float s[2] = {0.f, 0.f};
#pragma unroll
        for (int u = 0; u < 2; ++u)
#pragma unroll
            for (int j = 0; j < 8; ++j) {
                const int col = j * 256 + lane * 4; const size_t t = (size_t)(2 * tp + u);
                const float4 xv = nt_load4(x + t * D + col); const uint2 yb = nt_load2u(y + t * D + col);
                const float4 yv = make_float4(__uint_as_float(yb.x << 16), __uint_as_float(yb.x & 0xffff0000u), __uint_as_float(yb.y << 16), __uint_as_float(yb.y & 0xffff0000u));
                const float4 gt = *(const float4*)(ada + b * 12288 + 2 * 2048 + col);
                v[u][j * 4] = ALPHA * xv.x + gt.x * yv.x; v[u][j * 4 + 1] = ALPHA * xv.y + gt.y * yv.y; v[u][j * 4 + 2] = ALPHA * xv.z + gt.z * yv.z; v[u][j * 4 + 3] = ALPHA * xv.w + gt.w * yv.w;
                s[u] += (v[u][j * 4] + v[u][j * 4 + 1]) + (v[u][j * 4 + 2] + v[u][j * 4 + 3]);
            }
        float rstd[2];
#pragma unroll
        for (int u = 0; u < 2; ++u) {
            const float mean = wave_sum(s[u]) * (1.0f / 2048.0f);
            float q2 = 0.f;
#pragma unroll
            for (int i = 0; i < 32; ++i) { v[u][i] -= mean; q2 += v[u][i] * v[u][i]; }
            rstd[u] = rsqrtf(wave_sum(q2) * (1.0f / 2048.0f) + LN_EPS);
        }
        asm volatile("" ::: "memory");
        float umx[2] = {0.f, 0.f};
#pragma unroll
        for (int j = 0; j < 8; ++j) {
            const int col = j * 256 + lane * 4;
            const float4 gv = *(const float4*)(g + col), bv = *(const float4*)(be + col);
            const float4 sh = *(const float4*)(ada + b * 12288 + 3 * 2048 + col), sc = *(const float4*)(ada + b * 12288 + 4 * 2048 + col);
#pragma unroll
            for (int u = 0; u < 2; ++u) {
                const size_t t = (size_t)(2 * tp + u);
                const float4 o = make_float4(v[u][j * 4] * rstd[u] * gv.x + bv.x, v[u][j * 4 + 1] * rstd[u] * gv.y + bv.y, v[u][j * 4 + 2] * rstd[u] * gv.z + bv.z, v[u][j * 4 + 3] * rstd[u] * gv.w + bv.w);
                { uint2 xb; xb.x = pk_bf16(o.x, o.y); xb.y = pk_bf16(o.z, o.w); nt_store2u(x1 + t * D + col, xb); }
                const float4 uv = make_float4(o.x * (1.f + sc.x) + sh.x, o.y * (1.f + sc.y) + sh.y, o.z * (1.f + sc.z) + sh.z, o.w * (1.f + sc.w) + sh.w);
                v[u][j * 4] = uv.x; v[u][j * 4 + 1] = uv.y; v[u][j * 4 + 2] = uv.z; v[u][j * 4 + 3] = uv.w;
                uint2 ub2; ub2.x = pk_bf16(uv.x, uv.y); ub2.y = pk_bf16(uv.z, uv.w);
                *(uint2*)(u2b + t * D + col) = ub2;
                umx[u] = fmaxf(umx[u], fmaxf(fmaxf(fabsf(uv.x), fabsf(uv.y)), fmaxf(fabsf(uv.z), fabsf(uv.w))));
            }
        }
#pragma unroll
        for (int u = 0; u < 2; ++u) {
            const size_t t = (size_t)(2 * tp + u);
            const float um = wave_max(umx[u]);
            const float inv = um > 0.f ? 127.0f / um : 0.f;
            uint4 qa, qb;
            qa.x = q4(v[u][0], v[u][1], v[u][2], v[u][3], inv, 0); qa.y = q4(v[u][4], v[u][5], v[u][6], v[u][7], inv, 0); qa.z = q4(v[u][8], v[u][9], v[u][10], v[u][11], inv, 0); qa.w = q4(v[u][12], v[u][13], v[u][14], v[u][15], inv, 0);
            qb.x = q4(v[u][16], v[u][17], v[u][18], v[u][19], inv, 0); qb.y = q4(v[u][20], v[u][21], v[u][22], v[u][23], inv, 0); qb.z = q4(v[u][24], v[u][25], v[u][26], v[u][27], inv, 0); qb.w = q4(v[u][28], v[u][29], v[u][30], v[u][31], inv, 0);
            nt_store4u(u2q + t * 512 + lane * 8, qa); nt_store4u(u2q + t * 512 + lane * 8 + 4, qb);
            if (lane == 0) su2[t] = um * (1.0f / 127.0f);
        }
    }
}

template <int N> __device__ __forceinline__ void bitonic_desc(float (&v)[N]) {
#pragma unroll
    for (int k = 2; k <= N; k <<= 1)
#pragma unroll
        for (int j = k >> 1; j > 0; j >>= 1)
#pragma unroll
            for (int i = 0; i < N; ++i) { const int l = i ^ j; if (l > i) { const float x = v[i], y = v[l]; const float mx = fmaxf(x, y), mn = fminf(x, y); if ((i & k) == 0) { v[i] = mx; v[l] = mn; } else { v[i] = mn; v[l] = mx; } } }
}
__device__ __forceinline__ void bitonic_merge16_desc(float (&v)[16]) {
#pragma unroll
    for (int j = 8; j > 0; j >>= 1)
#pragma unroll
        for (int i = 0; i < 16; ++i) { const int l = i ^ j; if (l > i) { const float x = v[i], y = v[l]; v[i] = fmaxf(x, y); v[l] = fminf(x, y); } }
}
__device__ __forceinline__ void top16_of_128(float (&sc)[32], float (&top)[16]) {
    float lo[16], hi[16];
#pragma unroll
    for (int i = 0; i < 16; ++i) { lo[i] = sc[i]; hi[i] = sc[16 + i]; }
    bitonic_desc<16>(lo); bitonic_desc<16>(hi);
#pragma unroll
    for (int i = 0; i < 16; ++i) top[i] = fmaxf(lo[i], hi[15 - i]);
    bitonic_merge16_desc(top);
#pragma unroll
    for (int off = 16; off <= 32; off <<= 1) {
        float o[16];
#pragma unroll
        for (int i = 0; i < 16; ++i) o[i] = __shfl_xor(top[15 - i], off);
#pragma unroll
        for (int i = 0; i < 16; ++i) top[i] = fmaxf(top[i], o[i]);
        bitonic_merge16_desc(top);
    }
}
__device__ __forceinline__ void ce_carry(float& va, int& xa, float& vb, int& xb, bool desc) {
    const bool sw = desc ? (vb > va) : (vb < va);
    const float tv = sw ? vb : va, uv = sw ? va : vb; const int tx = sw ? xb : xa, ux = sw ? xa : xb;
    va = tv; vb = uv; xa = tx; xb = ux;
}
__device__ __forceinline__ void bitonic_merge16_desc_carry(float (&v)[16], int (&x)[16]) {
#pragma unroll
    for (int j = 8; j > 0; j >>= 1)
#pragma unroll
        for (int i = 0; i < 16; ++i) { const int l = i ^ j; if (l > i) ce_carry(v[i], x[i], v[l], x[l], true); }
}
constexpr int CAND_I[52] = {0,0,0,0,0,0,0,0,0,0,0,0,0,0,0,0,1,1,1,1,1,1,1,1,2,2,2,2,2,3,3,3,3,4,4,4,5,5,6,6,7,7,8,9,10,11,12,13,14,15,-1,-1};
constexpr int CAND_J[52] = {0,1,2,3,4,5,6,7,8,9,10,11,12,13,14,15,0,1,2,3,4,5,6,7,0,1,2,3,4,0,1,2,3,0,1,2,0,1,0,1,0,1,0,0,0,0,0,0,0,0,-1,-1};

__device__ __forceinline__ int rl_i(int v, int l) { return __builtin_amdgcn_readlane(v, l); }
__device__ __forceinline__ float rl_f(float v, int l) { return __int_as_float(__builtin_amdgcn_readlane(__float_as_int(v), l)); }
#define LANE_OF(k) ((((k) >> 3) & 1) * 32 + (((k) >> 2) & 1) * 16 + (((k) >> 1) & 1) * 8 + ((k) & 1) * 4)
constexpr size_t B_KEYSB = 15 * MiB;
constexpr size_t B_QB = B_Y;

typedef float f32x2v __attribute__((ext_vector_type(2)));
#define PKFMA_LO(fv, xv, wsv) do { f32x2v _t; asm("v_cvt_pk_f32_fp8 %1, %2\n\tv_pk_fma_f32 %0, %3, %1, %0" : "+v"(fv), "=&v"(_t) : "v"(xv), "v"(wsv)); } while (0)
#define PKFMA_HI(fv, xv, wsv) do { f32x2v _t; asm("v_cvt_pk_f32_fp8_sdwa %1, %2 src0_sel:WORD_1\n\tv_pk_fma_f32 %0, %3, %1, %0" : "+v"(fv), "=&v"(_t) : "v"(xv), "v"(wsv)); } while (0)
#define FACC(i) (f2[((i) >> 3) * 4 + (((i) & 1) ? 2 : 0) + (((i) & 7) >> 2)][(((i) & 7) >> 1) & 1])
__device__ __forceinline__ void gather_token(const Params& p, int t, const int* sel_idx, const float* sel_g, int lane) {
    const bf16_t* x1 = (const bf16_t*)((const char*)p.ws + B_X1); const float* ada = p.ws + W_ADA;
    const char* uq = (const char*)p.ws + B_TQ; const char* vq = uq + (size_t)16384 * VROW; const char* u2q = (const char*)p.ws + B_U2Q;
    const __amdgpu_buffer_rsrc_t ursrc = __builtin_amdgcn_make_buffer_rsrc((void*)uq, 0, 16384 * VROW, 0x00020000);
    const __amdgpu_buffer_rsrc_t vrsrc = __builtin_amdgcn_make_buffer_rsrc((void*)vq, 0, 16384 * VROW, 0x00020000);
    const float* su2 = p.ws + W_SU2; const float* rsu = p.ws + W_SU; const float* rsv = p.ws + W_SV;
    const float* g2 = p.in[I_LN2G]; const float* b2 = p.in[I_LN2B];
    const int b = t / SL;
    unsigned ue[4], uo[4]; int us0, us1;
    {
        const uint4 ua_ = nt_load4u(u2q + (size_t)t * D + lane * 32), ub_ = nt_load4u(u2q + (size_t)t * D + lane * 32 + 16);
        const int4 ua = make_int4((int)ua_.x, (int)ua_.y, (int)ua_.z, (int)ua_.w), ub = make_int4((int)ub_.x, (int)ub_.y, (int)ub_.z, (int)ub_.w);
        ue[0] = __builtin_amdgcn_perm((unsigned)ua.y, (unsigned)ua.x, 0x06040200u); uo[0] = __builtin_amdgcn_perm((unsigned)ua.y, (unsigned)ua.x, 0x07050301u);
        ue[1] = __builtin_amdgcn_perm((unsigned)ua.w, (unsigned)ua.z, 0x06040200u); uo[1] = __builtin_amdgcn_perm((unsigned)ua.w, (unsigned)ua.z, 0x07050301u);
        ue[2] = __builtin_amdgcn_perm((unsigned)ub.y, (unsigned)ub.x, 0x06040200u); uo[2] = __builtin_amdgcn_perm((unsigned)ub.y, (unsigned)ub.x, 0x07050301u);
        ue[3] = __builtin_amdgcn_perm((unsigned)ub.w, (unsigned)ub.z, 0x06040200u); uo[3] = __builtin_amdgcn_perm((unsigned)ub.w, (unsigned)ub.z, 0x07050301u);
        us0 = __builtin_amdgcn_sdot4(ua.x, 0x01010101, 0, false); us0 = __builtin_amdgcn_sdot4(ua.y, 0x01010101, us0, false); us0 = __builtin_amdgcn_sdot4(ua.z, 0x01010101, us0, false); us0 = __builtin_amdgcn_sdot4(ua.w, 0x01010101, us0, false);
        us1 = __builtin_amdgcn_sdot4(ub.x, 0x01010101, 0, false); us1 = __builtin_amdgcn_sdot4(ub.y, 0x01010101, us1, false); us1 = __builtin_amdgcn_sdot4(ub.z, 0x01010101, us1, false); us1 = __builtin_amdgcn_sdot4(ub.w, 0x01010101, us1, false);
    }
    const float s2 = su2[t];
    f32x2v f2[16];
#pragma unroll
    for (int i = 0; i < 16; ++i) f2[i] = (f32x2v){0.f, 0.f};
    float fb0 = 0.f, fb1 = 0.f;
    const int kk8 = ((lane >> 5) & 1) * 4 + ((lane >> 4) & 1) * 2 + ((lane >> 3) & 1);
#define LANE_OF8(k) ((((k) >> 2) & 1) * 32 + (((k) >> 1) & 1) * 16 + ((k) & 1) * 8)
    int e_cur = sel_idx[kk8]; float g_cur = sel_g[kk8];
    uint4 un[8]; unsigned usc[8];
#pragma unroll
    for (int k = 0; k < 8; ++k) { const int ro = rl_i(e_cur, LANE_OF8(k)) * VROW; un[k] = __builtin_bit_cast(uint4, __builtin_amdgcn_raw_buffer_load_b128(ursrc, lane * 16, ro, 0)); usc[k] = __builtin_amdgcn_raw_buffer_load_b16(ursrc, 1024 + lane * 2, ro, 0); }
#pragma unroll 1
    for (int bt = 0; bt < 16; ++bt) {
        uint4 vn[8]; unsigned vsc[8];
#pragma unroll
        for (int k = 0; k < 8; ++k) { const int ro = rl_i(e_cur, LANE_OF8(k)) * VROW; vn[k] = __builtin_bit_cast(uint4, __builtin_amdgcn_raw_buffer_load_b128(vrsrc, lane * 16, ro, 0)); vsc[k] = __builtin_amdgcn_raw_buffer_load_b16(vrsrc, 1024 + lane * 2, ro, 0); }
        __builtin_amdgcn_sched_barrier(0);
        float part[8];
#pragma unroll
        for (int k = 0; k < 8; ++k) {
            const uint4 nq = un[k]; const unsigned scw = usc[k];
            int d0 = __builtin_amdgcn_sdot4((int)ue[0], (int)(nq.x & 0x0F0F0F0Fu), -8 * us0, false); d0 = __builtin_amdgcn_sdot4((int)uo[0], (int)((nq.x >> 4) & 0x0F0F0F0Fu), d0, false);
            d0 = __builtin_amdgcn_sdot4((int)ue[1], (int)(nq.y & 0x0F0F0F0Fu), d0, false); d0 = __builtin_amdgcn_sdot4((int)uo[1], (int)((nq.y >> 4) & 0x0F0F0F0Fu), d0, false);
            int d1 = __builtin_amdgcn_sdot4((int)ue[2], (int)(nq.z & 0x0F0F0F0Fu), -8 * us1, false); d1 = __builtin_amdgcn_sdot4((int)uo[2], (int)((nq.z >> 4) & 0x0F0F0F0Fu), d1, false);
            d1 = __builtin_amdgcn_sdot4((int)ue[3], (int)(nq.w & 0x0F0F0F0Fu), d1, false); d1 = __builtin_amdgcn_sdot4((int)uo[3], (int)((nq.w >> 4) & 0x0F0F0F0Fu), d1, false);
            { const f32x2v sc2 = __builtin_amdgcn_cvt_pk_f32_fp8((int)scw, false); part[k] = (float)d0 * sc2[0] + (float)d1 * sc2[1]; }
            __builtin_amdgcn_sched_barrier(0);
        }
        const int bn = (bt + 1) & 15;
        const int e_nxt = sel_idx[bn * 8 + kk8]; const float g_nxt = sel_g[bn * 8 + kk8];
#pragma unroll
        for (int k = 0; k < 8; ++k) { const int ro = rl_i(e_nxt, LANE_OF8(k)) * VROW; un[k] = __builtin_bit_cast(uint4, __builtin_amdgcn_raw_buffer_load_b128(ursrc, lane * 16, ro, 0)); usc[k] = __builtin_amdgcn_raw_buffer_load_b16(ursrc, 1024 + lane * 2, ro, 0); }
        __builtin_amdgcn_sched_barrier(0);
        { const bool up = (lane & 32) != 0;
#pragma unroll
          for (int i = 0; i < 4; ++i) { const float keep = up ? part[i + 4] : part[i], send = up ? part[i] : part[i + 4]; part[i] = keep + __shfl_xor(send, 32); } }
        { const bool up = (lane & 16) != 0;
#pragma unroll
          for (int i = 0; i < 2; ++i) { const float keep = up ? part[i + 2] : part[i], send = up ? part[i] : part[i + 2]; part[i] = keep + __shfl_xor(send, 16); } }
        { const bool up = (lane & 8) != 0;
          const float keep = up ? part[1] : part[0], send = up ? part[0] : part[1]; part[0] = keep + __shfl_xor(send, 8); }
        float tot = part[0]; tot += __shfl_xor(tot, 1); tot += __shfl_xor(tot, 2); tot += __shfl_xor(tot, 4);
        const float dt = tot * s2 * rsu[e_cur];
        const float act = 0.5f * dt * (1.0f + erff(dt * 0.7071067811865476f));
        const float w_l = g_cur * act * rsv[e_cur];
#pragma unroll
        for (int k = 0; k < 8; ++k) {
            const float w = rl_f(w_l, LANE_OF8(k));
            const unsigned scw = vsc[k];
            const f32x2v sc2 = __builtin_amdgcn_cvt_pk_f32_fp8((int)scw, false); const float ws0 = w * sc2[0], ws1 = w * sc2[1];
            fb0 += ws0; fb1 += ws1;
            const f32x2v wp0 = {ws0 * 512.f, ws0 * 512.f}, wp1 = {ws1 * 512.f, ws1 * 512.f};
            const unsigned wd[4] = {vn[k].x, vn[k].y, vn[k].z, vn[k].w};
#pragma unroll
            for (int q = 0; q < 4; ++q) {
                const unsigned ev = wd[q] & 0x0F0F0F0Fu, od = (wd[q] >> 4) & 0x0F0F0F0Fu;
                if (q < 2) { PKFMA_LO(f2[q * 4 + 0], ev, wp0); PKFMA_HI(f2[q * 4 + 1], ev, wp0); PKFMA_LO(f2[q * 4 + 2], od, wp0); PKFMA_HI(f2[q * 4 + 3], od, wp0); }
                else       { PKFMA_LO(f2[q * 4 + 0], ev, wp1); PKFMA_HI(f2[q * 4 + 1], ev, wp1); PKFMA_LO(f2[q * 4 + 2], od, wp1); PKFMA_HI(f2[q * 4 + 3], od, wp1); }
            }
        }
        e_cur = e_nxt; g_cur = g_nxt;
    }
#undef LANE_OF8
    asm volatile("" ::: "memory");
    float v[32]; float s = 0.f;
#pragma unroll
    for (int q = 0; q < 8; ++q) {
        const int col = q * 256 + lane * 4, o = q * 4;
        const uint2 xb = nt_load2u(x1 + (size_t)t * D + col); const float4 gt = *(const float4*)(ada + b * 12288 + 5 * 2048 + col);
        const float4 xv = make_float4(__uint_as_float(xb.x << 16), __uint_as_float(xb.x & 0xffff0000u), __uint_as_float(xb.y << 16), __uint_as_float(xb.y & 0xffff0000u));
        const float fbh = 8.f * (q < 4 ? fb0 : fb1);
        v[o] = ALPHA * xv.x + gt.x * (FACC(o) - fbh); v[o + 1] = ALPHA * xv.y + gt.y * (FACC(o + 1) - fbh);
        v[o + 2] = ALPHA * xv.z + gt.z * (FACC(o + 2) - fbh); v[o + 3] = ALPHA * xv.w + gt.w * (FACC(o + 3) - fbh);
        s += (v[o] + v[o + 1]) + (v[o + 2] + v[o + 3]);
    }
    const float mean = wave_sum(s) * (1.0f / 2048.0f);
    float q2 = 0.f;
#pragma unroll
    for (int i = 0; i < 32; ++i) { v[i] -= mean; q2 += v[i] * v[i]; }
    const float rstd = rsqrtf(wave_sum(q2) * (1.0f / 2048.0f) + LN_EPS);
    asm volatile("" ::: "memory");
#pragma unroll
    for (int q = 0; q < 8; ++q) {
        const int col = q * 256 + lane * 4, o = q * 4;
        const float4 gv = *(const float4*)(g2 + col), bv = *(const float4*)(b2 + col);
        nt_store4(p.out + (size_t)t * D + col, v[o] * rstd * gv.x + bv.x, v[o + 1] * rstd * gv.y + bv.y, v[o + 2] * rstd * gv.z + bv.z, v[o + 3] * rstd * gv.w + bv.w);
    }
}

__device__ __forceinline__ void phase_jk(const Params& p, unsigned char* smem) {
    const int tid0 = opaque_tid();
    const bf16_t* qb = (const bf16_t*)((const char*)p.ws + B_QB); const bf16_t* keysb = (const bf16_t*)((const char*)p.ws + B_KEYSB);
    int* sel_idx = (int*)smem; float* sel_g = (float*)(smem + 8192);
#pragma unroll 1
    for (int item = blockIdx.x; item < NT / 16; item += gridDim.x) {
        int tid = tid0; asm volatile("" : "+v"(tid));
        const int lane = tid & 63, wv = tid >> 6, ql = lane & 15, g = lane >> 4;
        const int t0 = item * 16, h = wv;
        __syncthreads();
        float ta[16], tb[16];
#pragma unroll
        for (int i = 0; i < 16; ++i) { ta[i] = 0.f; tb[i] = 0.f; }
#pragma unroll 1
        for (int pp = 0; pp < 2; ++pp) {
            const bf16_t* qrow = qb + ((size_t)((((t0 >> 4) * 8 + h) * 2 + pp) * 4) * 64 + lane) * 8;
            bf16x8v qf[4];
#pragma unroll
            for (int kc = 0; kc < 4; ++kc) qf[kc] = __builtin_nontemporal_load((const bf16x8v*)(qrow + kc * 512));
            const bf16_t* kbase = keysb + (size_t)((h * 2 + pp) * 8) * 2048 + lane * 8;
            float sc[32];
#pragma unroll
            for (int nb = 0; nb < 8; ++nb) {
                f32x4v acc = {0.f, 0.f, 0.f, 0.f};
#pragma unroll
                for (int kc = 0; kc < 4; ++kc) acc = __builtin_amdgcn_mfma_f32_16x16x32_bf16(*(const bf16x8v*)(kbase + (nb * 4 + kc) * 512), qf[kc], acc, 0, 0, 0);
#pragma unroll
                for (int rr = 0; rr < 4; ++rr) sc[nb * 4 + rr] = __int_as_float((__float_as_int(acc[rr]) & ~127) | (16 * nb + 4 * g + rr));
                if (nb == 3) asm volatile("" ::: "memory");
            }
            float top[16];
            top16_of_128(sc, top);
#pragma unroll
            for (int i = 0; i < 16; ++i) { if (pp == 0) ta[i] = top[i]; else tb[i] = top[i]; }
        }
        float cv[16]; int cx[16];
#pragma unroll
        for (int sidx = 0; sidx < 13; ++sidx) {
            float vv[4]; int xx[4];
#pragma unroll
            for (int q = 0; q < 4; ++q) {
                const int ci = CAND_I[4 * sidx + q], cj = CAND_J[4 * sidx + q];
                if (ci >= 0) { vv[q] = ta[ci] + tb[cj]; xx[q] = ((__float_as_int(ta[ci]) & 127) << 7) | (__float_as_int(tb[cj]) & 127); } else { vv[q] = -3.0e38f; xx[q] = 0; }
            }
            cv[sidx] = g == 0 ? vv[0] : (g == 1 ? vv[1] : (g == 2 ? vv[2] : vv[3]));
            cx[sidx] = g == 0 ? xx[0] : (g == 1 ? xx[1] : (g == 2 ? xx[2] : xx[3]));
        }
#pragma unroll
        for (int sidx = 13; sidx < 16; ++sidx) { cv[sidx] = -3.0e38f; cx[sidx] = 0; }
#pragma unroll
        for (int k = 2; k <= 16; k <<= 1)
#pragma unroll
            for (int j = k >> 1; j > 0; j >>= 1)
#pragma unroll
                for (int i = 0; i < 16; ++i) { const int l = i ^ j; if (l > i) ce_carry(cv[i], cx[i], cv[l], cx[l], (i & k) == 0); }
#pragma unroll
        for (int off = 16; off <= 32; off <<= 1) {
            float ov[16]; int ox[16];
#pragma unroll
            for (int i = 0; i < 16; ++i) { ov[i] = __shfl_xor(cv[15 - i], off); ox[i] = __shfl_xor(cx[15 - i], off); }
#pragma unroll
            for (int i = 0; i < 16; ++i) { const bool tk = ov[i] > cv[i]; cv[i] = tk ? ov[i] : cv[i]; cx[i] = tk ? ox[i] : cx[i]; }
            bitonic_merge16_desc_carry(cv, cx);
        }
        {
            float ex[16]; float sum = 0.f;
#pragma unroll
            for (int i = 0; i < 16; ++i) { ex[i] = __expf(cv[i] - cv[0]); sum += ex[i]; }
            const float inv = 1.0f / sum;
            if (g == 0) {
#pragma unroll
                for (int q = 0; q < 4; ++q) {
                    *(int4*)(sel_idx + ql * 128 + h * 16 + q * 4) = make_int4(cx[q * 4], cx[q * 4 + 1], cx[q * 4 + 2], cx[q * 4 + 3]);
                    *(float4*)(sel_g + ql * 128 + h * 16 + q * 4) = make_float4(ex[q * 4] * inv, ex[q * 4 + 1] * inv, ex[q * 4 + 2] * inv, ex[q * 4 + 3] * inv);
                }
            }
        }
        __syncthreads();
#pragma unroll 1
        for (int k = 0; k < 2; ++k) { int lane2 = lane; asm volatile("" : "+v"(lane2)); gather_token(p, t0 + 2 * wv + k, sel_idx + (2 * wv + k) * 128, sel_g + (2 * wv + k) * 128, lane2); }
    }
}

__device__ __forceinline__ void map_tile(int L, int nM, int nN, int& pm, int& pn) {
    const int nwg = nM * nN; int wgid = L;
    { const int q = nwg / 8, r = nwg % 8, xcd = wgid % 8, off = wgid / 8; wgid = (xcd < r ? xcd * (q + 1) : r * (q + 1) + (xcd - r) * q) + off; }
    const int nig = 8 * nN, gid = wgid / nig, fm = gid * 8, gsz = (nM - fm) < 8 ? (nM - fm) : 8;
    pm = fm + ((wgid % nig) % gsz); pn = (wgid % nig) / gsz;
}
struct ProjOrder {
    int G, c; const bf16_t* ub; const bf16_t* wint;
    __device__ bool next(int i, pg8::Unit& u) const {
        const int L = i * G + c; if (L >= 800) return false;
        if (L < 384) { u.kind = 0; map_tile(L, 12, 32, u.pm, u.pn); }
        else if (L < 512) { u.kind = 1; map_tile(L - 384, 4, 32, u.pm, u.pn); }
        else if (L < 768) { u.kind = 2; map_tile(L - 512, 32, 8, u.pm, u.pn); }
        else if (L < 784) { u.kind = 3; u.pm = (L - 768) >> 2; u.pn = (L - 768) & 3; }
        else { u.kind = 4; u.pm = (L - 784) >> 2; u.pn = (L - 784) & 3; }
        return true;
    }
    __device__ __forceinline__ void a_ready(const pg8::Unit&) const {}
    __device__ __forceinline__ void done(const pg8::Unit&) const {}
    template <class G_> __device__ __forceinline__ const char* pa(const G_&, const pg8::Unit& u) const {
        const size_t ts = (size_t)256 * D * 2;
        switch (u.kind) { case 0: return (const char*)wint + (size_t)u.pm * ts; case 1: return (const char*)wint + (size_t)(20 + u.pm) * ts; case 2: return (const char*)ub + (size_t)u.pm * ts;
                          case 3: return (const char*)ub + (size_t)(32 + u.pm) * ts; default: return (const char*)wint + (size_t)(20 + u.pm) * ts; }
    }
    template <class G_> __device__ __forceinline__ const char* pb(const G_&, const pg8::Unit& u) const {
        const size_t ts = (size_t)256 * D * 2;
        switch (u.kind) { case 0: case 1: return (const char*)ub + (size_t)u.pn * ts; case 2: return (const char*)wint + (size_t)(12 + u.pn) * ts;
                          case 3: return (const char*)wint + (size_t)(16 + u.pn) * ts; default: return (const char*)ub + (size_t)(32 + u.pn) * ts; }
    }
};
struct EpiProj {
    static constexpr bool PERM = true, AFTER_DRAIN = false;
    unsigned char* ws;
    __device__ __forceinline__ void operator()(const pg8::f32x4 (&acc)[2][2][4][2], const pg8::Unit& u, int wr, int wc, int fr, int fq) const {
        bf16_t* const zT = (bf16_t*)(ws + B_ZT); bf16_t* const vT = (bf16_t*)(ws + B_VT); bf16_t* const qh = (bf16_t*)(ws + B_QH); bf16_t* const kh = (bf16_t*)(ws + B_KH);
        bf16_t* const kch = (bf16_t*)(ws + B_KCH); bf16_t* const vcT = (bf16_t*)(ws + B_VCT);
#pragma unroll
        for (int ai = 0; ai < 2; ++ai)
#pragma unroll
            for (int m = 0; m < 4; ++m) {
                const int r = u.pm * 256 + ai * 128 + wr * 64 + m * 16 + fr;
#pragma unroll
                for (int bj = 0; bj < 2; ++bj) {
                    const int cc = u.pn * 256 + bj * 128 + wc * 32 + 8 * fq;
                    bf16_t* dst;
                    if (u.kind == 0) dst = zT + (size_t)r * NT + cc;
                    else if (u.kind == 1) {
                        const int bb = cc >> 11, t = cc & 2047, hh = r >> 6, dd = r & 63;
                        dst = vT + (size_t)((bb * 16 + hh) * 256 + (t >> 3)) * 512 + (dd >> 4) * 128 + (dd & 15) * 8;
                    } else if (u.kind == 2) {
                        const int bb = r >> 11, t = r & 2047, hc = cc & 1023, hh = hc >> 6, dd = hc & 63;
                        if (cc < 1024) dst = qh + ((size_t)((bb * 16 + hh) * SL + t)) * 64 + dd;
                        else dst = kh + (size_t)((bb * 16 + hh) * 256 + (t >> 3)) * 512 + (dd >> 5) * 256 + ((t & 7) >> 2) * 128 + ((dd & 31) >> 3) * 32 + (t & 3) * 8;
                    } else if (u.kind == 3) {
                        const int bb = r >> 8, jj = r & 255, hh = cc >> 6, dd = cc & 63;
                        dst = kch + (size_t)((bb * 16 + hh) * 32 + (jj >> 3)) * 512 + (dd >> 5) * 256 + ((jj & 7) >> 2) * 128 + ((dd & 31) >> 3) * 32 + (jj & 3) * 8;
                    } else {
                        const int bb = cc >> 8, jj = cc & 255, hh = r >> 6, dd = r & 63;
                        dst = vcT + (size_t)((bb * 16 + hh) * 32 + (jj >> 3)) * 512 + (dd >> 4) * 128 + (dd & 15) * 8;
                    }
                    const pg8::f32x4 v0 = acc[ai][bj][m][0], v1 = acc[ai][bj][m][1];
                    pg8::u32x4 w; w.x = pg8::cvt_pk_bf16(v0[0], v0[1]); w.y = pg8::cvt_pk_bf16(v0[2], v0[3]); w.z = pg8::cvt_pk_bf16(v1[0], v1[1]); w.w = pg8::cvt_pk_bf16(v1[2], v1[3]);
                    *(pg8::u32x4*)dst = w;
                }
            }
    }
};

struct EpiQFrag {
    static constexpr bool PERM = true, AFTER_DRAIN = false;
    bf16_t* O;
    __device__ __forceinline__ void operator()(const pg8::f32x4 (&acc)[2][2][4][2], const pg8::Unit& u, int wr, int wc, int fr, int fq) const {
#pragma unroll
        for (int ai = 0; ai < 2; ++ai)
#pragma unroll
            for (int m = 0; m < 4; ++m) {
                const int t = u.pm * 256 + ai * 128 + wr * 64 + m * 16 + fr;
#pragma unroll
                for (int bj = 0; bj < 2; ++bj) {
                    const int c = u.pn * 256 + bj * 128 + wc * 32 + 8 * fq;
                    const int hh = c >> 8, pp = (c >> 7) & 1, d = c & 127;
                    bf16_t* dst = O + ((size_t)(((((t >> 4) * 8 + hh) * 2 + pp) * 4 + (d >> 5)) * 64 + ((d & 31) >> 3) * 16 + (t & 15))) * 8;
                    const pg8::f32x4 v0 = acc[ai][bj][m][0], v1 = acc[ai][bj][m][1];
                    pg8::u32x4 w; w.x = pg8::cvt_pk_bf16(v0[0], v0[1]); w.y = pg8::cvt_pk_bf16(v0[2], v0[3]); w.z = pg8::cvt_pk_bf16(v1[0], v1[1]); w.w = pg8::cvt_pk_bf16(v1[2], v1[3]);
                    __builtin_nontemporal_store(w, (pg8::u32x4*)dst);
                }
            }
    }
};

#define XB_TMO      128
#define XB_XCNT(j)  (256  + 64 * (j))
#define XB_XSUB(j)  (1280 + 64 * (j))
#define XB_XGEN(j)  (2304 + 64 * (j))
#define XB_TOP      3328
#define XB_TOPGEN   3392
#define XCD_BAR_WORDS 3456
#define XB_SPIN_CAP (1u << 18)
#define LAS __attribute__((address_space(3)))

__device__ __forceinline__ unsigned xb_ld(unsigned* p)              { return __hip_atomic_load(p, __ATOMIC_RELAXED, __HIP_MEMORY_SCOPE_AGENT); }
__device__ __forceinline__ unsigned xb_add(unsigned* p, unsigned v) { return __hip_atomic_fetch_add(p, v, __ATOMIC_RELAXED, __HIP_MEMORY_SCOPE_AGENT); }
__device__ __forceinline__ unsigned xb_xcc_id() { return (unsigned)__builtin_amdgcn_s_getreg((3 << 11) | 20) & 0xFu; }
#define XB_SPIN(cond, bar) do { unsigned _sp = 0; while (cond) { __builtin_amdgcn_s_sleep(1); \
    if ((++_sp & 255u) == 0u) { if (xb_ld(&(bar)[XB_TMO])) break; if (_sp > XB_SPIN_CAP) { atomicAdd(&(bar)[XB_TMO], 1u); break; } } } } while (0)

struct XcdBarrier {
    unsigned* bar; unsigned x;
    volatile LAS unsigned* st;
};

__device__ __forceinline__ XcdBarrier xcd_barrier_post(unsigned* bar, volatile LAS unsigned* st) {
    XcdBarrier b; b.bar = bar; b.x = xb_xcc_id(); b.st = st;
    if (threadIdx.x == 0) (void)xb_add(&bar[XB_XCNT(b.x)], 1u);
    return b;
}
__device__ __forceinline__ void xcd_barrier_complete(unsigned* bar, unsigned x, unsigned& nloc, unsigned& nx) {
    const unsigned G = gridDim.x * gridDim.y * gridDim.z;
    unsigned sum, cnt, mine, sp = 0u;
    for (;;) {
        sum = 0u; cnt = 0u; mine = 0u;
#pragma unroll
        for (unsigned j = 0; j < 16; ++j) { const unsigned c = xb_ld(&bar[XB_XCNT(j)]); sum += c; cnt += (c > 0u) ? 1u : 0u; mine = (j == x) ? c : mine; }
        if (sum == G) break;
        __builtin_amdgcn_s_sleep(1);
        if ((++sp & 255u) == 0u) { if (xb_ld(&bar[XB_TMO])) break; if (sp > XB_SPIN_CAP) { atomicAdd(&bar[XB_TMO], 1u); break; } }
    }
    nloc = mine > 0u ? mine : 1u; nx = cnt > 0u ? cnt : 1u;
}

__device__ __forceinline__ void xcd_barrier(const XcdBarrier& b) {
    asm volatile("s_waitcnt vmcnt(0)" ::: "memory");
    __syncthreads();
    if (threadIdx.x == 0) {
        unsigned* bar = b.bar;
        __builtin_amdgcn_s_waitcnt(0);
        unsigned nloc = b.st[0], nx = b.st[1]; const unsigned k = b.st[2];
        if (nloc == 0u) { xcd_barrier_complete(bar, b.x, nloc, nx); b.st[0] = nloc; b.st[1] = nx; }
        b.st[2] = k + 1u;
        const unsigned old = xb_add(&bar[XB_XSUB(b.x)], 1u);
        if (old + 1u == (k + 1u) * nloc) {
            __builtin_amdgcn_fence(__ATOMIC_RELEASE, "agent");
            asm volatile("s_waitcnt vmcnt(0)" ::: "memory");
            (void)xb_add(&bar[XB_TOP], 1u);
        }
        XB_SPIN(xb_ld(&bar[XB_TOP]) < (k + 1u) * nx, bar);
        __builtin_amdgcn_fence(__ATOMIC_ACQUIRE, "agent");
        asm volatile("s_waitcnt vmcnt(0)" ::: "memory");
    }
    __syncthreads();
}
constexpr size_t B_BAR = 14 * MiB;

__global__ void __launch_bounds__(NTHREADS) fwd_megakernel(Params p) {
    extern __shared__ __attribute__((aligned(16))) unsigned char smem[];
    float* lds = (float*)smem; float* red = (float*)(smem + RED_OFF);
    PG8_LAS unsigned char* glds = (PG8_LAS unsigned char*)smem;
    volatile LAS unsigned* xst = (volatile LAS unsigned*)(smem + LDS_BYTES - 16);
    if (threadIdx.x < 4) xst[threadIdx.x] = 0u;
    __syncthreads();
    XcdBarrier xb = xcd_barrier_post((unsigned*)((char*)p.ws + B_BAR), xst);
    bf16_t* wint = (bf16_t*)((char*)p.ws + B_WINT); bf16_t* woutt = (bf16_t*)((char*)p.ws + B_WOUTT); bf16_t* wqt = (bf16_t*)((char*)p.ws + B_WQT);
    bf16_t* ub = (bf16_t*)((char*)p.ws + B_UB);
    phase_a(p, lds);
    transpose_convert(p.in[I_WIN], wint, D, DPROJ, lds, 0, (int)gridDim.x);
    phase_filters(p, lds);
    {
        const float* ks = p.in[I_KEYS]; bf16_t* kd = (bf16_t*)((char*)p.ws + B_KEYSB);
        for (int e = blockIdx.x * NTHREADS + threadIdx.x; e < 16 * 128 * 128 / 4; e += gridDim.x * NTHREADS) {
            const float4 v = *(const float4*)(ks + e * 4); uint2 o; o.x = pk_bf16(v.x, v.y); o.y = pk_bf16(v.z, v.w);
            const int d = (e * 4) & 127, n = ((e * 4) >> 7) & 127, hp = (e * 4) >> 14;
            *(uint2*)(kd + ((size_t)(((hp * 8 + (n >> 4)) * 4 + (d >> 5)) * 64 + ((d & 31) >> 3) * 16 + (n & 15))) * 8 + (d & 7)) = o;
        }
    }
    xcd_barrier(xb);
    phase_b(p);
    xcd_barrier(xb);
    phase_c(p);
    xcd_barrier(xb);
    {
        pg8::Gemm g{ub, wint, NT + NTC, DPROJ, D}; ProjOrder S{(int)gridDim.x, (int)blockIdx.x, ub, wint};
        EpiProj E{(unsigned char*)p.ws};
        pg8::gemm_phase<EpiProj, ProjOrder>(glds, g, S, E, nullptr);
    }
    if (gridDim.x == 256 && blockIdx.x >= 32) {
        quant_tables(p, 32, 224);
        transpose_convert(p.in[I_WOUT], woutt, D, D, lds, 32, 224);
        transpose_convert(p.in[I_WQ], wqt, D, D, lds, 32, 224);
    } else if (gridDim.x != 256) {
        quant_tables(p, 0, (int)gridDim.x);
        transpose_convert(p.in[I_WOUT], woutt, D, D, lds, 0, (int)gridDim.x);
        transpose_convert(p.in[I_WQ], wqt, D, D, lds, 0, (int)gridDim.x);
    }
    xcd_barrier(xb);
    phase_hyena(p, smem);
    phase_na(p, smem);
    xcd_barrier(xb);
    phase_f(p, lds);
    xcd_barrier(xb);
    {
        pg8::Gemm g{ub, woutt, NT, D, D}; pg8::StaticOrder S; S.init(NT, D, (int)gridDim.x, (int)blockIdx.x);
        pg8::EpiBf16<0> E{(bf16_t*)((char*)p.ws + B_Y), D, nullptr, 0, 0};
        pg8::gemm_phase<pg8::EpiBf16<0>, pg8::StaticOrder>(glds, g, S, E, nullptr);
    }
    xcd_barrier(xb);
    phase_h(p);
    xcd_barrier(xb);
    {
        pg8::Gemm g{ub, wqt, NT, D, D}; pg8::StaticOrder S; S.init(NT, D, (int)gridDim.x, (int)blockIdx.x);
        EpiQFrag E{(bf16_t*)((char*)p.ws + B_QB)};
        pg8::gemm_phase<EpiQFrag, pg8::StaticOrder>(glds, g, S, E, nullptr);
    }
    xcd_barrier(xb);
    phase_jk(p, smem);
}

extern "C" void kernel_launch(void* const* d_in, const int* in_sizes, int n_in, void* d_out, int out_size, void* d_ws, size_t ws_size, hipStream_t stream) {
    static int grid_blocks = 0;
    if (grid_blocks == 0) {
        if (n_in != N_IN || out_size != NT * D || ws_size < W_END * sizeof(float)) {
            fprintf(stderr, "kernel_launch: unexpected shapes: n_in %d out %d ws %zu (need %zu)\n", n_in, out_size, ws_size, (size_t)W_END * 4); grid_blocks = -1; return; }
        int dev = 0, cus = 0, per_cu = 0;
        hipGetDevice(&dev);
        hipDeviceGetAttribute(&cus, hipDeviceAttributeMultiprocessorCount, dev);
        if (hipFuncSetAttribute((const void*)fwd_megakernel, hipFuncAttributeMaxDynamicSharedMemorySize, LDS_BYTES) != hipSuccess) { fprintf(stderr, "kernel_launch: hipFuncSetAttribute failed\n"); grid_blocks = -1; return; }
        if (hipOccupancyMaxActiveBlocksPerMultiprocessor(&per_cu, (const void*)fwd_megakernel, NTHREADS, LDS_BYTES) != hipSuccess || per_cu < 1) { fprintf(stderr, "kernel_launch: occupancy query failed (%d)\n", per_cu); (void)hipGetLastError(); grid_blocks = -1; return; }
        grid_blocks = cus * (per_cu > 1 ? 1 : per_cu);
        fprintf(stderr, "kernel_launch: cus %d per_cu %d grid %d\n", cus, per_cu, grid_blocks);
    }
    if (grid_blocks < 0) return;
    Params p{};
    for (int i = 0; i < N_IN; ++i) p.in[i] = (const float*)d_in[i];
    p.out = (float*)d_out; p.ws = (float*)d_ws;
    if (hipMemsetAsync((char*)d_ws + B_BAR, 0, XCD_BAR_WORDS * sizeof(unsigned), stream) != hipSuccess) { fprintf(stderr, "kernel_launch: memset failed\n"); return; }
    void* args[] = {&p};
    hipLaunchKernelGGL(fwd_megakernel, dim3(grid_blocks), dim3(NTHREADS), LDS_BYTES, stream, p);
    const hipError_t e = hipPeekAtLastError();
    if (e != hipSuccess) fprintf(stderr, "launch failed: %s (grid %d)\n", hipGetErrorString(e), grid_blocks);
}
```

```cpp
#include <hip/hip_runtime.h>
#include <hip/hip_cooperative_groups.h>
#include <cstdio>
namespace cg = cooperative_groups;

constexpr int D = 2048, NB = 4, SL = 2048, NT = NB * SL, CL = 256, NTC = NB * CL;
constexpr int DHY = 1024, DNA = 1024, DPROJ = 6144, OFFQ = 3072, OFFK = 4096, OFFV = 5120;
constexpr int NTHREADS = 512, NWAVES = 8;
constexpr float LN_EPS = 1e-5f;
constexpr float ALPHA = 1.189207115002721f;

enum { I_X = 0, I_C, I_CTX, I_CCTX, I_WADA, I_BADA, I_WIN, I_CONVW, I_CONVB, I_FW1, I_FB1, I_FW2, I_FB2, I_FW3, I_FB3, I_FW4,
       I_FREQ, I_SKIP, I_RPB, I_GHY, I_GNA, I_WOUT, I_LN1G, I_LN1B, I_WQ, I_KEYS, I_PU, I_PV, I_LN2G, I_LN2B, N_IN };

constexpr size_t W_ADAP = 0;
constexpr size_t W_ADA  = W_ADAP + 32 * 5 * 12288;
constexpr size_t W_FS   = W_ADA + 5 * 12288;
constexpr size_t W_SP   = W_FS + 4096;
constexpr size_t W_SU   = W_SP + 32 * 4096;
constexpr size_t W_SV   = W_SU + 16384;
constexpr size_t W_SU2  = W_SV + 16384;
static_assert((W_SU2 + 8192) * 4 <= 14 * 1048576, "small region overflow");
constexpr size_t MiB = 1048576;
constexpr size_t B_WINT  = 16 * MiB;
constexpr size_t B_WOUTT = B_WINT + 24 * MiB;
constexpr size_t B_WQT   = B_WOUTT + 8 * MiB;
constexpr size_t B_UB    = B_WQT + 8 * MiB;
constexpr size_t B_ZT    = B_UB + 36 * MiB;
constexpr size_t B_VT    = B_ZT + 48 * MiB;
constexpr size_t B_QH    = B_VT + 16 * MiB;
constexpr size_t B_KH    = B_QH + 16 * MiB;
constexpr size_t B_KCH   = B_KH + 16 * MiB;
constexpr size_t B_VCT   = B_KCH + 2 * MiB;
constexpr size_t B_KF    = B_VCT + 2 * MiB;
constexpr size_t B_HRAW  = B_KF + 32 * MiB;
constexpr size_t B_HYT   = B_HRAW;
constexpr size_t B_NA    = B_HRAW + 16 * MiB;
constexpr size_t B_Y     = B_HRAW + 32 * MiB;
constexpr size_t B_X1    = B_Y + 64 * MiB;
constexpr size_t B_U2Q   = B_X1 + 64 * MiB;
constexpr size_t B_TQ    = B_U2Q + 16 * MiB;
constexpr size_t B_END   = B_TQ + 64 * MiB;
constexpr size_t W_KF = B_KF / 4, W_X1 = B_X1 / 4, W_HRAW = B_HRAW / 4, W_Y = B_Y / 4, W_END = B_END / 4;
static_assert(B_END <= 512 * MiB, "workspace");

constexpr int LDS_BYTES = 156 * 1024;
constexpr int RED_OFF = 155 * 1024;

struct Params { const float* in[N_IN]; float* out; float* ws; };

namespace pg8 {
#define PG8_LAS __attribute__((address_space(3)))
typedef unsigned short bf16_t;
typedef short bf16x8 __attribute__((ext_vector_type(8)));
typedef float f32x4 __attribute__((ext_vector_type(4)));
typedef unsigned u32x4 __attribute__((ext_vector_type(4)));
constexpr int BM = 256, BK = 64, HALF = 128, HTB = HALF * BK * 2  , STAGE_BYTES = 8 * HTB, NXCD = 8, WGM = 8;

__host__ __device__ __forceinline__ int lds_byte(int r, int c) { const int st = (r >> 4) * 2 + (c >> 5), rr = r & 15, cc = c & 31, ob = rr * 64 + cc * 2; return st * 1024 + (ob ^ (((ob >> 9) & 1) << 5)); }
__host__ __device__ __forceinline__ void stage_rc(int b, int& R, int& C) { const int st = b / 1024, sb = b % 1024, swz = sb ^ (((sb >> 9) & 1) << 5); R = (st >> 1) * 16 + swz / 64; C = (st & 1) * 32 + (swz % 64) / 2; }
__host__ __device__ __forceinline__ int perm32(int rho) { const int n = rho >> 4, i = rho & 15; return 8 * (i >> 2) + 4 * n + (i & 3); }

struct Unit { int pm, pn, kind; };
struct Gemm { const bf16_t* A; const bf16_t* Bt; int M, N, K; };

struct StaticOrder {
    int nM, nN, nwg, G, c;
    __host__ __device__ void init(int M, int N, int G_, int c_) { nM = M / BM; nN = N / BM; nwg = nM * nN; G = G_; c = c_; }
    __host__ __device__ bool next(int i, Unit& u) const {
        const long L = (long)i * G + c; if (L >= nwg) return false;
        int wgid = (int)L; { const int q = nwg / NXCD, r = nwg % NXCD, xcd = wgid % NXCD, off = wgid / NXCD; wgid = (xcd < r ? xcd * (q + 1) : r * (q + 1) + (xcd - r) * q) + off; }
        const int nig = WGM * nN, gid = wgid / nig, fm = gid * WGM, gsz = (nM - fm) < WGM ? (nM - fm) : WGM;
        u.pm = fm + ((wgid % nig) % gsz); u.pn = (wgid % nig) / gsz; return true;
    }
    __device__ __forceinline__ void a_ready(const Unit&) const {}
    __device__ __forceinline__ void done(const Unit&) const {}
    template <class G_> __device__ __forceinline__ const char* pa(const G_& g, const Unit& u) const { return (const char*)g.A + (size_t)u.pm * (size_t)(BM * 2) * g.K; }
    template <class G_> __device__ __forceinline__ const char* pb(const G_& g, const Unit& u) const { return (const char*)g.Bt + (size_t)u.pn * (size_t)(BM * 2) * g.K; }
};
__device__ __forceinline__ unsigned cvt_pk_bf16(float lo, float hi) { unsigned r; asm volatile("v_cvt_pk_bf16_f32 %0, %1, %2" : "=v"(r) : "v"(lo), "v"(hi)); return r; }
typedef float f32x2 __attribute__((ext_vector_type(2)));
__device__ __forceinline__ f32x2 gelu_pk(f32x2 v) {
    const f32x2 av = __builtin_elementwise_abs(v), d = av * 0.2316418882f + 1.0f;
    f32x2 t; t.x = __builtin_amdgcn_rcpf(d.x); t.y = __builtin_amdgcn_rcpf(d.y);
    f32x2 q = t * 0.5307027145f + (-0.7265760135f); q = q * t + 0.7107068705f; q = q * t + (-0.142248368f); q = q * t + 0.127414796f; q = q * t;
    const f32x2 s = (v * v) * (-0.72134752044f);
    f32x2 e; e.x = __builtin_amdgcn_exp2f(s.x); e.y = __builtin_amdgcn_exp2f(s.y);
    const f32x2 m = v * (q * e), r = v - m;
    f32x2 o; o.x = v.x < 0.f ? m.x : r.x; o.y = v.y < 0.f ? m.y : r.y; return o;
}

struct EpiF32 {
    static constexpr bool PERM = false, AFTER_DRAIN = false;
    float* C; int ldc; const float* bias;
    __device__ __forceinline__ void operator()(const f32x4 (&acc)[2][2][4][2], const Unit& u, int wr, int wc, int fr, int fq) const {
        const int row0 = u.pm * BM + wr * 64 + fr, col0 = u.pn * BM + wc * 32 + 4 * fq;
        f32x4 bv[2][2];
#pragma unroll
        for (int bj = 0; bj < 2; ++bj)
#pragma unroll
            for (int n = 0; n < 2; ++n) bv[bj][n] = bias ? *(const f32x4*)(bias + col0 + bj * HALF + n * 16) : (f32x4){0.f, 0.f, 0.f, 0.f};
#pragma unroll
        for (int ai = 0; ai < 2; ++ai)
#pragma unroll
            for (int m = 0; m < 4; ++m) { float* rowp = C + (size_t)(row0 + ai * HALF + m * 16) * ldc + col0;
#pragma unroll
                for (int bj = 0; bj < 2; ++bj)
#pragma unroll
                    for (int n = 0; n < 2; ++n) *(f32x4*)(rowp + bj * HALF + n * 16) = acc[ai][bj][m][n] + bv[bj][n]; }
    }
};
template <int ACT  > struct EpiBf16 {
    static constexpr bool PERM = true, AFTER_DRAIN = false;
    bf16_t* O; int ldc; const float* bias; int split_cols; size_t split_stride;
    __device__ __forceinline__ void operator()(const f32x4 (&acc)[2][2][4][2], const Unit& u, int wr, int wc, int fr, int fq) const {
        const int row0 = u.pm * BM + wr * 64 + fr; int colt = u.pn * BM; bf16_t* base = O;
        if (split_cols) { const int t = colt / split_cols; base += (size_t)t * split_stride; colt -= t * split_cols; }
        const int col0 = colt + wc * 32 + 8 * fq, bcol0 = u.pn * BM + wc * 32 + 8 * fq;
        f32x4 bv[2][2];
#pragma unroll
        for (int bj = 0; bj < 2; ++bj)
#pragma unroll
            for (int n = 0; n < 2; ++n) bv[bj][n] = bias ? *(const f32x4*)(bias + bcol0 + bj * HALF + 4 * n) : (f32x4){0.f, 0.f, 0.f, 0.f};
#pragma unroll
        for (int ai = 0; ai < 2; ++ai)
#pragma unroll
            for (int m = 0; m < 4; ++m) { bf16_t* rowp = base + (size_t)(row0 + ai * HALF + m * 16) * ldc + col0;
#pragma unroll
                for (int bj = 0; bj < 2; ++bj) { f32x4 v0 = acc[ai][bj][m][0] + bv[bj][0], v1 = acc[ai][bj][m][1] + bv[bj][1];
                    if (ACT == 1) { f32x2 a = gelu_pk((f32x2){v0[0], v0[1]}), b = gelu_pk((f32x2){v0[2], v0[3]}), c = gelu_pk((f32x2){v1[0], v1[1]}), d = gelu_pk((f32x2){v1[2], v1[3]});
                        v0 = (f32x4){a.x, a.y, b.x, b.y}; v1 = (f32x4){c.x, c.y, d.x, d.y}; }
                    if (ACT == 2) {
#pragma unroll
                        for (int j = 0; j < 4; ++j) { v0[j] = 0.5f * v0[j] * (1.0f + erff(v0[j] * 0.70710678f)); v1[j] = 0.5f * v1[j] * (1.0f + erff(v1[j] * 0.70710678f)); } }
                    u32x4 w; w.x = cvt_pk_bf16(v0[0], v0[1]); w.y = cvt_pk_bf16(v0[2], v0[3]); w.z = cvt_pk_bf16(v1[0], v1[1]); w.w = cvt_pk_bf16(v1[2], v1[3]);
                    *(u32x4*)(rowp + bj * HALF) = w; } }
    }
};
template <class Epi, class Sched, bool STAMP = false>
__device__ __forceinline__ void gemm_phase(PG8_LAS unsigned char* lds, const Gemm g, const Sched& S, const Epi& E, unsigned long long* stamps) {
    const int tid = threadIdx.x, wid = __builtin_amdgcn_readfirstlane(tid >> 6), lane = tid & 63, wr = wid >> 2, wc = wid & 3, fr = lane & 15, fq = lane >> 4;
    const int K = g.K, nt = K / BK;
    int ts_lo = 0, ts_hi = 0, nts = 0; const unsigned long long rt_entry = STAMP ? (unsigned long long)wall_clock64() : 0ull;
#define PG8_STAMP() do { if (STAMP && wid == 0 && nts < 64) { const unsigned long long _c = (unsigned long long)clock64(); \
        ts_lo = (lane == nts) ? (int)(unsigned)_c : ts_lo; ts_hi = (lane == nts) ? (int)(unsigned)(_c >> 32) : ts_hi; ++nts; } } while (0)
    PG8_STAMP();
    unsigned voffA[2], voffB[2];
#pragma unroll
    for (int i = 0; i < 2; ++i) { int R, C; stage_rc(tid * 16 + i * 8192, R, C); const int Rb = Epi::PERM ? ((R & ~31) + perm32(R & 31)) : R;
        voffA[i] = (unsigned)(R * K + C) * 2u; voffB[i] = (unsigned)(Rb * K + C) * 2u; }
    const size_t kstep = (size_t)(BK * 2);
    const size_t hstep = (size_t)HALF * K * 2;
    const size_t tstep = 2 * hstep;
    const unsigned ldsw = (unsigned)wid * 1024u;
    const int aoff = lds_byte(wr * 64 + fr, fq * 8), boff = lds_byte(wc * 32 + fr, fq * 8);
#define PG8_SA(b, h) (((b) * 2 + (h)) * HTB)
#define PG8_SB(b, h) ((4 + (b) * 2 + (h)) * HTB)
#define PG8_STAGE(bufoff, gbase, voff) do { _Pragma("unroll") for (int _i = 0; _i < 2; ++_i) \
        __builtin_amdgcn_global_load_lds((const unsigned*)((const char*)(gbase) + (voff)[_i]), (PG8_LAS unsigned*)(lds + (bufoff) + ldsw + _i * 8192), 16, 0, 0); } while (0)
#define PG8_LDA(dst, b, h) do { _Pragma("unroll") for (int m = 0; m < 4; ++m) _Pragma("unroll") for (int k = 0; k < 2; ++k) dst[m][k] = *(const PG8_LAS bf16x8*)(lds + PG8_SA(b, h) + aoff + m * 2048 + k * 1024); } while (0)
#define PG8_LDB(dst, b, h) do { _Pragma("unroll") for (int n = 0; n < 2; ++n) _Pragma("unroll") for (int k = 0; k < 2; ++k) dst[n][k] = *(const PG8_LAS bf16x8*)(lds + PG8_SB(b, h) + boff + n * 2048 + k * 1024); } while (0)
#define PG8_MMA(ai, bj, At, Bt) do { __builtin_amdgcn_s_setprio(1); _Pragma("unroll") for (int m = 0; m < 4; ++m) _Pragma("unroll") for (int n = 0; n < 2; ++n) _Pragma("unroll") for (int k = 0; k < 2; ++k) \
        acc[ai][bj][m][n] = __builtin_amdgcn_mfma_f32_16x16x32_bf16(Bt[n][k], At[m][k], acc[ai][bj][m][n], 0, 0, 0); __builtin_amdgcn_s_setprio(0); } while (0)
#define PG8_WAIT_V(n) asm volatile("s_waitcnt vmcnt(" #n ")" ::: "memory")
#define PG8_WAIT_L(n) asm volatile("s_waitcnt lgkmcnt(" #n ")" ::: "memory")
#define PG8_BAR __builtin_amdgcn_s_barrier()
#define PG8_SCHED __builtin_amdgcn_sched_barrier(0)
    Unit cur, nxt; int ui = 0;
    if (!S.next(0, cur)) return;
    f32x4 acc[2][2][4][2];
#pragma unroll
    for (int a = 0; a < 2; ++a)
#pragma unroll
        for (int b = 0; b < 2; ++b)
#pragma unroll
            for (int m = 0; m < 4; ++m)
#pragma unroll
                for (int n = 0; n < 2; ++n) acc[a][b][m][n] = (f32x4){0.f, 0.f, 0.f, 0.f};
    bf16x8 At[4][2], B0[2][2], B1[2][2];
    const char* cA = S.pa(g, cur); const char* cB = S.pb(g, cur);
    S.a_ready(cur);
    PG8_STAGE(PG8_SB(0, 0), cB, voffB); PG8_STAGE(PG8_SA(0, 0), cA, voffA); PG8_STAGE(PG8_SB(0, 1), cB + hstep, voffB); PG8_STAGE(PG8_SA(0, 1), cA + hstep, voffA);
    if (wr == 1) PG8_BAR;
    PG8_WAIT_V(4); PG8_BAR;
    PG8_STAGE(PG8_SB(1, 0), cB + kstep, voffB); PG8_STAGE(PG8_SA(1, 0), cA + kstep, voffA); PG8_STAGE(PG8_SB(1, 1), cB + hstep + kstep, voffB);
    PG8_WAIT_V(6); PG8_BAR;
    PG8_STAMP();
    for (;;) {
        const bool has_next = S.next(ui + 1, nxt);
        const char* nA = has_next ? S.pa(g, nxt) : cA; const char* nB = has_next ? S.pb(g, nxt) : cB;
        for (int t = 0; t < nt; t += 2) {
            const bool last = (t == nt - 2);
            const char* a1 = cA + (size_t)(t + 1) * kstep;
            const char* a2 = last ? nA : cA + (size_t)(t + 2) * kstep; const char* b2 = last ? nB : cB + (size_t)(t + 2) * kstep;
            const char* a3 = a2 + kstep; const char* b3 = b2 + kstep;
            if (last && has_next) S.a_ready(nxt);
            PG8_LDB(B0, 0, 0); PG8_SCHED; PG8_LDA(At, 0, 0); PG8_STAGE(PG8_SA(1, 1), a1 + hstep, voffA);
            PG8_WAIT_L(8); PG8_BAR; PG8_WAIT_L(0); PG8_MMA(0, 0, At, B0); PG8_BAR; PG8_SCHED;
            PG8_LDB(B1, 0, 1); PG8_STAGE(PG8_SB(0, 0), b2, voffB);
            PG8_BAR; PG8_WAIT_L(0); PG8_MMA(0, 1, At, B1); PG8_BAR;
            PG8_LDA(At, 0, 1); PG8_STAGE(PG8_SA(0, 0), a2, voffA);
            PG8_BAR; PG8_WAIT_L(0); PG8_MMA(1, 0, At, B0); PG8_BAR; PG8_SCHED;
            PG8_STAGE(PG8_SB(0, 1), b2 + hstep, voffB);
            PG8_WAIT_V(6); PG8_BAR; PG8_MMA(1, 1, At, B1); PG8_BAR;
            PG8_LDB(B0, 1, 0); PG8_SCHED; PG8_LDA(At, 1, 0); PG8_STAGE(PG8_SA(0, 1), a2 + hstep, voffA);
            PG8_WAIT_L(8); PG8_BAR; PG8_WAIT_L(0); PG8_MMA(0, 0, At, B0); PG8_BAR; PG8_SCHED;
            PG8_LDB(B1, 1, 1); PG8_STAGE(PG8_SB(1, 0), b3, voffB);
            PG8_BAR; PG8_WAIT_L(0); PG8_MMA(0, 1, At, B1); PG8_BAR;
            PG8_LDA(At, 1, 1); PG8_STAGE(PG8_SA(1, 0), a3, voffA);
            PG8_BAR; PG8_WAIT_L(0); PG8_MMA(1, 0, At, B0); PG8_BAR; PG8_SCHED;
            PG8_STAGE(PG8_SB(1, 1), b3 + hstep, voffB);
            PG8_WAIT_V(6); PG8_BAR; PG8_MMA(1, 1, At, B1); PG8_BAR;
        }
        PG8_STAMP();
        if constexpr (!Epi::AFTER_DRAIN) { E(acc, cur, wr, wc, fr, fq); S.done(cur); }
        PG8_STAMP();
        if (!has_next) break;
#pragma unroll
        for (int a = 0; a < 2; ++a)
#pragma unroll
            for (int b = 0; b < 2; ++b)
#pragma unroll
                for (int m = 0; m < 4; ++m)
#pragma unroll
                    for (int n = 0; n < 2; ++n) acc[a][b][m][n] = (f32x4){0.f, 0.f, 0.f, 0.f};
        cur = nxt; cA = nA; cB = nB; ++ui;
    }
    PG8_WAIT_V(0);
    if (wr == 0) PG8_BAR;
    PG8_BAR;
    if constexpr (Epi::AFTER_DRAIN) { E.fused(acc, cur, wr, wc, fr, fq, lds, wid, lane); S.done(cur); }
    PG8_STAMP();
    if (STAMP && wid == 0) { stamps[lane] = lane < nts ? (((unsigned long long)(unsigned)ts_hi << 32) | (unsigned)ts_lo) : 0ull;
        if (lane == 62) stamps[62] = rt_entry; if (lane == 63) stamps[63] = (unsigned long long)wall_clock64(); }
#undef PG8_STAMP
#undef PG8_SA
#undef PG8_SB
#undef PG8_STAGE
#undef PG8_LDA
#undef PG8_LDB
#undef PG8_MMA
#undef PG8_WAIT_V
#undef PG8_WAIT_L
#undef PG8_BAR
#undef PG8_SCHED
}
}

typedef unsigned short bf16_t;
__device__ __forceinline__ float wave_sum(float v) {
#pragma unroll
    for (int o = 32; o; o >>= 1) v += __shfl_xor(v, o);
    return v;
}
__device__ __forceinline__ float block_sum(float v, float* red) {
    v = wave_sum(v);
    __syncthreads();
    if ((threadIdx.x & 63) == 0) red[threadIdx.x >> 6] = v;
    __syncthreads();
    float s = 0.f;
#pragma unroll
    for (int i = 0; i < NWAVES; ++i) s += red[i];
    return s;
}
__device__ __forceinline__ int opaque_tid() { int t = threadIdx.x; asm volatile("" : "+v"(t)); return t; }
typedef float nt_f32x4 __attribute__((ext_vector_type(4)));
__device__ __forceinline__ float4 nt_load4(const float* p) { const nt_f32x4 v = __builtin_nontemporal_load((const nt_f32x4*)p); return make_float4(v[0], v[1], v[2], v[3]); }
typedef unsigned nt_u32x4 __attribute__((ext_vector_type(4)));
typedef unsigned nt_u32x2 __attribute__((ext_vector_type(2)));
__device__ __forceinline__ uint4 nt_load4u(const void* p) { const nt_u32x4 v = __builtin_nontemporal_load((const nt_u32x4*)p); return make_uint4(v[0], v[1], v[2], v[3]); }
__device__ __forceinline__ uint2 nt_load2u(const void* p) { const nt_u32x2 v = __builtin_nontemporal_load((const nt_u32x2*)p); return make_uint2(v[0], v[1]); }
__device__ __forceinline__ void nt_store4(float* p, float a, float b, float c, float d) { nt_f32x4 v = {a, b, c, d}; __builtin_nontemporal_store(v, (nt_f32x4*)p); }
__device__ __forceinline__ void nt_store4u(void* p, uint4 v) { nt_u32x4 w = {v.x, v.y, v.z, v.w}; __builtin_nontemporal_store(w, (nt_u32x4*)p); }
__device__ __forceinline__ void nt_store2u(void* p, uint2 v) { nt_u32x2 w = {v.x, v.y}; __builtin_nontemporal_store(w, (nt_u32x2*)p); }
__device__ __forceinline__ float silu(float x) { return x / (1.0f + expf(-x)); }


__device__ __forceinline__ unsigned pk_bf16(float lo, float hi) { unsigned r; asm volatile("v_cvt_pk_bf16_f32 %0, %1, %2" : "=v"(r) : "v"(lo), "v"(hi)); return r; }
__device__ __forceinline__ void transpose_convert(const float* __restrict__ W, bf16_t* __restrict__ Wt, int K, int N, float* lds, int wb0, int nwb) {
    const int tid = opaque_tid();
    const int tk = K / 64, tn = N / 256;
    for (int tile = (int)blockIdx.x - wb0; tile < tk * tn; tile += nwb) {
        const int k0 = (tile / tn) * 64, n0 = (tile % tn) * 256;
        __syncthreads();
        float4 v[8];
#pragma unroll
        for (int i = 0; i < 8; ++i) v[i] = nt_load4(W + (size_t)(k0 + (tid >> 6) + 8 * i) * N + n0 + (tid & 63) * 4);
#pragma unroll
        for (int i = 0; i < 8; ++i) { float* d = lds + ((tid >> 6) + 8 * i) * 257 + (tid & 63) * 4; d[0] = v[i].x; d[1] = v[i].y; d[2] = v[i].z; d[3] = v[i].w; }
        __syncthreads();
#pragma unroll
        for (int q = 0; q < 4; ++q) {
            const int c = q * NTHREADS + tid, n = c >> 3, k8 = (c & 7) * 8;
            uint4 o;
            o.x = pk_bf16(lds[(k8 + 0) * 257 + n], lds[(k8 + 1) * 257 + n]); o.y = pk_bf16(lds[(k8 + 2) * 257 + n], lds[(k8 + 3) * 257 + n]);
            o.z = pk_bf16(lds[(k8 + 4) * 257 + n], lds[(k8 + 5) * 257 + n]); o.w = pk_bf16(lds[(k8 + 6) * 257 + n], lds[(k8 + 7) * 257 + n]);
            *(uint4*)(Wt + (size_t)(n0 + n) * K + k0 + k8) = o;
        }
    }
}
__device__ __forceinline__ float wave_max(float v) {
#pragma unroll
    for (int o = 32; o; o >>= 1) v = fmaxf(v, __shfl_xor(v, o));
    return v;
}
__device__ __forceinline__ float block_max(float v, float* red) {
    v = wave_max(v);
    __syncthreads();
    if ((threadIdx.x & 63) == 0) red[threadIdx.x >> 6] = v;
    __syncthreads();
    float s = red[0];
#pragma unroll
    for (int i = 1; i < NWAVES; ++i) s = fmaxf(s, red[i]);
    return s;
}
__device__ __forceinline__ unsigned q4(float a, float b, float c, float d, float inv, int off) {
    const int x = __float2int_rn(a * inv) + off, y = __float2int_rn(b * inv) + off, z = __float2int_rn(c * inv) + off, w = __float2int_rn(d * inv) + off;
    return (unsigned)(x & 255) | ((unsigned)(y & 255) << 8) | ((unsigned)(z & 255) << 16) | ((unsigned)(w & 255) << 24);
}
constexpr int VROW = 1152;
template <int O> __device__ __forceinline__ unsigned nib8(const float (&x)[16], float inv) {
    unsigned r = 0;
#pragma unroll
    for (int i = 0; i < 8; ++i) r |= (unsigned)(min(max(__float2int_rn(x[O + i] * inv), -7), 7) + 8) << (4 * i);
    return r;
}
__device__ __forceinline__ void quant_tables(const Params& p, int wb0, int nwb) {
    const int tid = opaque_tid(), lane = tid & 63, wv = tid >> 6;
    unsigned char* tq = (unsigned char*)p.ws + B_TQ; float* rsc = p.ws + W_SU;
    const int nw = nwb * NWAVES;
    for (int row0 = ((int)blockIdx.x - wb0) * NWAVES + wv; row0 < 2 * 16384; row0 += 2 * nw) {
        float x[2][2][16]; float mx[2][2];
#pragma unroll
        for (int u = 0; u < 2; ++u) {
            const int row = min(row0 + u * nw, 2 * 16384 - 1);
            const float* src = (row < 16384 ? p.in[I_PU] : p.in[I_PV]) + (size_t)(row & 16383) * D + lane * 4;
#pragma unroll
            for (int h = 0; h < 2; ++h) {
                mx[u][h] = 0.f;
#pragma unroll
                for (int q = 0; q < 4; ++q) { const float4 v = nt_load4(src + (h * 4 + q) * 256); x[u][h][q * 4] = v.x; x[u][h][q * 4 + 1] = v.y; x[u][h][q * 4 + 2] = v.z; x[u][h][q * 4 + 3] = v.w;
                    mx[u][h] = fmaxf(mx[u][h], fmaxf(fmaxf(fabsf(v.x), fabsf(v.y)), fmaxf(fabsf(v.z), fabsf(v.w)))); }
            }
        }
#pragma unroll
        for (int u = 0; u < 2; ++u) {
            const int row = row0 + u * nw;
            if (row < 2 * 16384) {
                unsigned char* dst = tq + (size_t)row * VROW;
                const float rmx = wave_max(fmaxf(mx[u][0], mx[u][1]));
                const float R = rmx > 0.f ? rmx * (1.0f / (7.0f * 240.0f)) : 1.0f, invR = 1.0f / R;
                const int pk = __builtin_amdgcn_cvt_pk_fp8_f32(mx[u][0] * (1.03f / 7.0f) * invR, mx[u][1] * (1.03f / 7.0f) * invR, 0, false);
                const float s0 = __builtin_amdgcn_cvt_f32_fp8(pk, 0) * R, s1 = __builtin_amdgcn_cvt_f32_fp8(pk, 1) * R;
                const float i0 = s0 > 0.f ? 1.0f / s0 : 0.f, i1 = s1 > 0.f ? 1.0f / s1 : 0.f;
                nt_store4u(dst + lane * 16, make_uint4(nib8<0>(x[u][0], i0), nib8<8>(x[u][0], i0), nib8<0>(x[u][1], i1), nib8<8>(x[u][1], i1)));
                *(unsigned short*)(dst + 1024 + lane * 2) = (unsigned short)(pk & 0xffff);
                if (lane == 0) rsc[row] = R;
            }
        }
    }
}

__device__ __forceinline__ void naive_gemm(const float* __restrict__ A, int lda, const float* __restrict__ Bm, int ldb,
                                           float* __restrict__ C, int ldc, int M, int N, int K, float* lds) {
    float* As = lds;
    float* Bs = lds + 16 * 132;
    const int tid = opaque_tid(), tx = tid & 31, ty = tid >> 5;
    const int tilesN = N / 128, ntiles = (M / 128) * tilesN;
    for (int tile = blockIdx.x; tile < ntiles; tile += gridDim.x) {
        const int m0 = (tile / tilesN) * 128, n0 = (tile % tilesN) * 128;
        float acc[8][4];
#pragma unroll
        for (int i = 0; i < 8; ++i)
#pragma unroll
            for (int j = 0; j < 4; ++j) acc[i][j] = 0.f;
        for (int k0 = 0; k0 < K; k0 += 16) {
            {
                const int row = tid >> 2, kq = (tid & 3) * 4;
                const float4 a = *(const float4*)(A + (size_t)(m0 + row) * lda + k0 + kq);
                As[(kq + 0) * 132 + row] = a.x; As[(kq + 1) * 132 + row] = a.y; As[(kq + 2) * 132 + row] = a.z; As[(kq + 3) * 132 + row] = a.w;
                const int kk = tid >> 5, n4 = (tid & 31) * 4;
                *(float4*)(Bs + kk * 128 + n4) = *(const float4*)(Bm + (size_t)(k0 + kk) * ldb + n0 + n4);
            }
            __syncthreads();
#pragma unroll 4
            for (int k = 0; k < 16; ++k) {
                const float4 a0 = *(const float4*)(As + k * 132 + ty * 8), a1 = *(const float4*)(As + k * 132 + ty * 8 + 4);
                const float4 b = *(const float4*)(Bs + k * 128 + tx * 4);
                const float av[8] = {a0.x, a0.y, a0.z, a0.w, a1.x, a1.y, a1.z, a1.w};
                const float bv[4] = {b.x, b.y, b.z, b.w};
#pragma unroll
                for (int i = 0; i < 8; ++i)
#pragma unroll
                    for (int j = 0; j < 4; ++j) acc[i][j] += av[i] * bv[j];
            }
            __syncthreads();
        }
#pragma unroll
        for (int i = 0; i < 8; ++i)
            *(float4*)(C + (size_t)(m0 + ty * 8 + i) * ldc + n0 + tx * 4) = make_float4(acc[i][0], acc[i][1], acc[i][2], acc[i][3]);
    }
}

__device__ __forceinline__ void phase_a(const Params& p, float* lds) {
    const int tid = opaque_tid();
    const float* c = p.in[I_C]; const float* cctx = p.in[I_CCTX]; const float* wada = p.in[I_WADA];
    float* part = p.ws + W_ADAP;
    for (int item = blockIdx.x; item < 32 * 24; item += gridDim.x) {
        const int ks = item / 24, j = (item % 24) * 512 + tid;
        __syncthreads();
        if (tid < 5 * 64) { const int n = tid >> 6, k = ks * 64 + (tid & 63); lds[tid] = silu(n < 4 ? c[n * 2048 + k] : cctx[k]); }
        __syncthreads();
        float a0 = 0.f, a1 = 0.f, a2 = 0.f, a3 = 0.f, a4 = 0.f;
#pragma unroll 32
        for (int kk = 0; kk < 64; ++kk) {
            const float w = __builtin_nontemporal_load(wada + (size_t)(ks * 64 + kk) * 12288 + j);
            a0 += lds[kk] * w; a1 += lds[64 + kk] * w; a2 += lds[128 + kk] * w; a3 += lds[192 + kk] * w; a4 += lds[256 + kk] * w;
        }
        part[(size_t)(ks * 5 + 0) * 12288 + j] = a0; part[(size_t)(ks * 5 + 1) * 12288 + j] = a1; part[(size_t)(ks * 5 + 2) * 12288 + j] = a2;
        part[(size_t)(ks * 5 + 3) * 12288 + j] = a3; part[(size_t)(ks * 5 + 4) * 12288 + j] = a4;
    }
}
typedef short bf16x8v __attribute__((ext_vector_type(8)));
typedef float f32x4v __attribute__((ext_vector_type(4)));
typedef float f32x16v __attribute__((ext_vector_type(16)));
__device__ __forceinline__ void phase_filters(const Params& p, float* lds) {
    const int tid = opaque_tid();
    const float* w1 = p.in[I_FW1]; const float* b1 = p.in[I_FB1]; const float* w2 = p.in[I_FW2]; const float* b2 = p.in[I_FB2];
    const float* w3 = p.in[I_FW3]; const float* b3 = p.in[I_FB3]; const float* w4 = p.in[I_FW4]; const float* freq = p.in[I_FREQ];
    float* hT = (float*)((char*)p.ws + B_KF); float* sp = p.ws + W_SP;
    float* zf = lds; float* ha = lds + 64 * 36; float* hb = ha + 64 * 68; float* red2 = hb + 64 * 68;
    float* W1 = red2 + 256; float* W2 = W1 + 33 * 64; float* W3 = W2 + 64 * 64;
    __syncthreads();
    for (int e = tid; e < 33 * 64; e += NTHREADS) W1[e] = w1[e];
    for (int e = tid; e < 64 * 64; e += NTHREADS) { W2[e] = w2[e]; W3[e] = w3[e]; }
    for (int item = blockIdx.x; item < 256; item += gridDim.x) {
        const int pt = item >> 3;
        __syncthreads();
        for (int e = tid; e < 64 * 33; e += NTHREADS) {
            const int pos = e / 33, m = e % 33, i = pt * 64 + pos;
            const float t = (float)i / 2047.0f, w = 6.283185307179586f * (float)i / 2048.0f;
            float v;
            if (m == 0) v = t;
            else if (m <= 16) { const float f = 1e-4f + (float)(m - 1) * ((15.0f - 1e-4f) / 15.0f); v = __cosf(f * w); }
            else { const float f = 1e-4f + (float)(m - 17) * ((15.0f - 1e-4f) / 15.0f); v = -__sinf(f * w); }
            zf[pos * 36 + m] = v;
        }
        __syncthreads();
        const int pos = tid >> 3, u0 = (tid & 7) * 8;
        {
            float a[8];
#pragma unroll
            for (int u = 0; u < 8; ++u) a[u] = b1[u0 + u];
#pragma unroll 11
            for (int m = 0; m < 33; ++m) { const float zv = zf[pos * 36 + m]; const float4 wa = *(const float4*)(W1 + m * 64 + u0), wb = *(const float4*)(W1 + m * 64 + u0 + 4);
                a[0] += zv * wa.x; a[1] += zv * wa.y; a[2] += zv * wa.z; a[3] += zv * wa.w; a[4] += zv * wb.x; a[5] += zv * wb.y; a[6] += zv * wb.z; a[7] += zv * wb.w; }
#pragma unroll
            for (int u = 0; u < 8; ++u) ha[pos * 68 + u0 + u] = __sinf(freq[u0 + u] * a[u]);
        }
        __syncthreads();
        {
            float a[8];
#pragma unroll
            for (int u = 0; u < 8; ++u) a[u] = b2[u0 + u];
#pragma unroll 16
            for (int m = 0; m < 64; ++m) { const float zv = ha[pos * 68 + m]; const float4 wa = *(const float4*)(W2 + m * 64 + u0), wb = *(const float4*)(W2 + m * 64 + u0 + 4);
                a[0] += zv * wa.x; a[1] += zv * wa.y; a[2] += zv * wa.z; a[3] += zv * wa.w; a[4] += zv * wb.x; a[5] += zv * wb.y; a[6] += zv * wb.z; a[7] += zv * wb.w; }
#pragma unroll
            for (int u = 0; u < 8; ++u) hb[pos * 68 + u0 + u] = __sinf(freq[64 + u0 + u] * a[u]);
        }
        __syncthreads();
        {
            float a[8];
#pragma unroll
            for (int u = 0; u < 8; ++u) a[u] = b3[u0 + u];
#pragma unroll 16
            for (int m = 0; m < 64; ++m) { const float zv = hb[pos * 68 + m]; const float4 wa = *(const float4*)(W3 + m * 64 + u0), wb = *(const float4*)(W3 + m * 64 + u0 + 4);
                a[0] += zv * wa.x; a[1] += zv * wa.y; a[2] += zv * wa.z; a[3] += zv * wa.w; a[4] += zv * wb.x; a[5] += zv * wb.y; a[6] += zv * wb.z; a[7] += zv * wb.w; }
#pragma unroll
            for (int u = 0; u < 8; ++u) ha[pos * 68 + u0 + u] = __sinf(freq[128 + u0 + u] * a[u]);
        }
        __syncthreads();
#pragma unroll 1
        for (int jt = (item & 7) * 2; jt < (item & 7) * 2 + 2; ++jt) {
            const int lane = tid & 63, wv = tid >> 6, cl = lane & 15, g = lane >> 4;
            union frag { unsigned u[4]; bf16x8v v; };
            frag af[2][2];
#pragma unroll
            for (int mt = 0; mt < 2; ++mt)
#pragma unroll
                for (int ks = 0; ks < 2; ++ks) {
                    const float* wp = w4 + (size_t)(ks * 32 + 8 * g) * 4096 + jt * 256 + wv * 32 + mt * 16 + cl;
                    float x[8];
#pragma unroll
                    for (int i = 0; i < 8; ++i) x[i] = wp[(size_t)i * 4096];
                    af[mt][ks].u[0] = pk_bf16(x[0], x[1]); af[mt][ks].u[1] = pk_bf16(x[2], x[3]); af[mt][ks].u[2] = pk_bf16(x[4], x[5]); af[mt][ks].u[3] = pk_bf16(x[6], x[7]);
                }
            f32x4v acc[2][4];
#pragma unroll
            for (int mt = 0; mt < 2; ++mt)
#pragma unroll
                for (int nt = 0; nt < 4; ++nt) acc[mt][nt] = (f32x4v){0.f, 0.f, 0.f, 0.f};
#pragma unroll
            for (int nt = 0; nt < 4; ++nt)
#pragma unroll
                for (int ks = 0; ks < 2; ++ks) {
                    const float4 h0 = *(const float4*)(ha + (nt * 16 + cl) * 68 + ks * 32 + 8 * g), h1 = *(const float4*)(ha + (nt * 16 + cl) * 68 + ks * 32 + 8 * g + 4);
                    frag bf; bf.u[0] = pk_bf16(h0.x, h0.y); bf.u[1] = pk_bf16(h0.z, h0.w); bf.u[2] = pk_bf16(h1.x, h1.y); bf.u[3] = pk_bf16(h1.z, h1.w);
#pragma unroll
                    for (int mt = 0; mt < 2; ++mt) acc[mt][nt] = __builtin_amdgcn_mfma_f32_16x16x32_bf16(af[mt][ks].v, bf.v, acc[mt][nt], 0, 0, 0);
                }
#pragma unroll
            for (int mt = 0; mt < 2; ++mt)
#pragma unroll
                for (int r = 0; r < 4; ++r) {
                    const int j = jt * 256 + wv * 32 + mt * 16 + 4 * g + r;
                    const float delta = 3.070113457f + (float)(j & 1023) * ((15.35056729f - 3.070113457f) / 1023.0f);
                    float asum = 0.f;
#pragma unroll
                    for (int nt = 0; nt < 4; ++nt) {
                        const int ps = pt * 64 + nt * 16 + cl;
                        const float val = acc[mt][nt][r] * __expf(-((float)ps / 2047.0f) * delta);
                        asum += fabsf(val);
                        __builtin_nontemporal_store(val, hT + (size_t)j * SL + ps);
                    }
                    asum += __shfl_xor(asum, 1); asum += __shfl_xor(asum, 2); asum += __shfl_xor(asum, 4); asum += __shfl_xor(asum, 8);
                    if (cl == 0) sp[(size_t)pt * 4096 + j] = asum;
                }
        }
    }
}

__device__ __forceinline__ void phase_b(const Params& p) {
    const int tid = opaque_tid();
    const float* part = p.ws + W_ADAP; float* ada = p.ws + W_ADA; const float* bada = p.in[I_BADA];
    for (int e = blockIdx.x * NTHREADS + tid; e < 5 * 12288; e += gridDim.x * NTHREADS) {
        float s = bada[e % 12288];
#pragma unroll 8
        for (int ks = 0; ks < 32; ++ks) s += part[(size_t)ks * 5 * 12288 + e];
        ada[e] = s;
    }
    const float* sp = p.ws + W_SP; float* fs = p.ws + W_FS;
    for (int j = blockIdx.x * NTHREADS + tid; j < 4096; j += gridDim.x * NTHREADS) {
        float s = 0.f;
#pragma unroll 8
        for (int pt = 0; pt < 32; ++pt) s += sp[(size_t)pt * 4096 + j];
        fs[j] = s;
    }
}

__device__ __forceinline__ void phase_c(const Params& p) {
    const int tid = opaque_tid();
    const float* ada = p.ws + W_ADA;
    const float* x = p.in[I_X]; bf16_t* ub = (bf16_t*)((char*)p.ws + B_UB);
    for (size_t e = (size_t)blockIdx.x * NTHREADS + tid; e < (size_t)NT * D / 4; e += (size_t)gridDim.x * NTHREADS) {
        const size_t row = e / (D / 4); const int col = (int)(e % (D / 4)) * 4; const int b = (int)(row / SL);
        const float4 xv = nt_load4(x + row * D + col);
        const float4 sh = *(const float4*)(ada + b * 12288 + col), sc = *(const float4*)(ada + b * 12288 + 2048 + col);
        uint2 o; o.x = pk_bf16(xv.x * (1.f + sc.x) + sh.x, xv.y * (1.f + sc.y) + sh.y); o.y = pk_bf16(xv.z * (1.f + sc.z) + sh.z, xv.w * (1.f + sc.w) + sh.w);
        *(uint2*)(ub + row * D + col) = o;
    }
    const float* ctx = p.in[I_CTX]; bf16_t* ucb = ub + (size_t)NT * D;
    for (size_t e = (size_t)blockIdx.x * NTHREADS + tid; e < (size_t)NTC * D / 4; e += (size_t)gridDim.x * NTHREADS) {
        const size_t row = e / (D / 4); const int col = (int)(e % (D / 4)) * 4;
        const float4 xv = nt_load4(ctx + row * D + col);
        const float4 sh = *(const float4*)(ada + 4 * 12288 + col), sc = *(const float4*)(ada + 4 * 12288 + 2048 + col);
        uint2 o; o.x = pk_bf16(xv.x * (1.f + sc.x) + sh.x, xv.y * (1.f + sc.y) + sh.y); o.y = pk_bf16(xv.z * (1.f + sc.z) + sh.z, xv.w * (1.f + sc.w) + sh.w);
        *(uint2*)(ucb + row * D + col) = o;
    }
}

__device__ __forceinline__ float bf2f(bf16_t v) { return __uint_as_float(((unsigned)v) << 16); }
constexpr int HY_PB = 4416, HY_PJ = 272, HY_R0 = 4 * HY_PB, HY_R1 = HY_R0 + 8192 + 64, HY_SLOT = HY_R1 + 8192 + 64;
static_assert(HY_SLOT % 16 == 0 && 4 * HY_SLOT + 64 <= 155 * 1024, "hyena LDS");
__device__ __forceinline__ bf16x8v hy_lda(const unsigned char* base, int off) {
    const unsigned* q = (const unsigned*)(base + off);
    union { unsigned u[4]; bf16x8v v; } r; r.u[0] = q[0]; r.u[1] = q[1]; r.u[2] = q[2]; r.u[3] = q[3];
    return r.v;
}
__device__ __forceinline__ void hy_stage_rows(const bf16_t* zT, const float* cw, const float* cb, int ch, int half, int lane, unsigned char* sl) {
    const float w0 = cw[ch], w1 = cw[3072 + ch], w2 = cw[6144 + ch], bs = cb[ch];
#pragma unroll 4
    for (int q = 0; q < 8; ++q) {
        const int bsel = 2 * half + (q >> 2), t0 = ((q & 3) * 64 + lane) * 8;
        const bf16_t* zrow = zT + (size_t)ch * NT + bsel * SL;
        const uint4 raw = nt_load4u(zrow + t0);
        float z[10];
        z[0] = t0 > 0 ? bf2f(zrow[t0 - 1]) : 0.f; z[9] = t0 + 8 < SL ? bf2f(zrow[t0 + 8]) : 0.f;
        z[1] = __uint_as_float(raw.x << 16); z[2] = __uint_as_float(raw.x & 0xffff0000u); z[3] = __uint_as_float(raw.y << 16); z[4] = __uint_as_float(raw.y & 0xffff0000u);
        z[5] = __uint_as_float(raw.z << 16); z[6] = __uint_as_float(raw.z & 0xffff0000u); z[7] = __uint_as_float(raw.w << 16); z[8] = __uint_as_float(raw.w & 0xffff0000u);
        float sv[8];
#pragma unroll
        for (int i = 0; i < 8; ++i) sv[i] = w0 * z[i] + w1 * z[i + 1] + w2 * z[i + 2] + bs;
        uint4 o; o.x = pk_bf16(sv[0], sv[1]); o.y = pk_bf16(sv[2], sv[3]); o.z = pk_bf16(sv[4], sv[5]); o.w = pk_bf16(sv[6], sv[7]);
        *(uint4*)(sl + bsel * HY_PB + (t0 >> 7) * HY_PJ + (t0 & 127) * 2) = o;
    }
}
__device__ __forceinline__ void hy_pair_sync(volatile __attribute__((address_space(3))) unsigned* fl, int wv, unsigned n) {
    asm volatile("s_waitcnt lgkmcnt(0)" ::: "memory");
    fl[wv] = n;
    while (fl[wv ^ 1] < n) __builtin_amdgcn_s_sleep(0);
    asm volatile("" ::: "memory");
}
__device__ __forceinline__ void phase_hyena(const Params& p, unsigned char* smem) {
    const int tid = opaque_tid(), lane = tid & 63, wv = tid >> 6, slot = wv >> 1, half = wv & 1, pt = tid & 127;
    const bf16_t* zT = (const bf16_t*)((const char*)p.ws + B_ZT); const float* hT = (const float*)((const char*)p.ws + B_KF); const float* fs = p.ws + W_FS; bf16_t* hyT = (bf16_t*)((char*)p.ws + B_HYT);
    const float* cw = p.in[I_CONVW]; const float* cb = p.in[I_CONVB]; const float* skip = p.in[I_SKIP];
    unsigned char* sl = smem + slot * HY_SLOT;
    const int a_ = lane & 31, hh = lane >> 5, i_local = a_ >> 2, batch = a_ & 3, I0 = 8 * half;
    const int laneA = ((a_ & 1) ? HY_R0 : HY_R1) + 2 * (2047 - a_ - (1 - (a_ & 1)) + 8 * hh);
    volatile __attribute__((address_space(3))) unsigned* fl = (volatile __attribute__((address_space(3))) unsigned*)(smem + 4 * HY_SLOT);
    unsigned seq = 0u;
    __syncthreads();
    if (tid < 8) fl[tid] = 0u;
    if (wv < 4) __builtin_amdgcn_s_setprio(2);
    for (int item = blockIdx.x; item < DHY / 4; item += gridDim.x) {
        const int c = item * 4 + slot;
        __syncthreads();
        hy_stage_rows(zT, cw, cb, c, half, lane, sl);
#pragma unroll 1
        for (int ord = 0; ord < 2; ++ord) {
            {
                const float* hf = hT + (size_t)((ord * 2 + 0) * 1024 + c) * SL; const float* hbk = hT + (size_t)((ord * 2 + 1) * 1024 + c) * SL;
                const float sk = skip[ord * 1024 + c]; const float invs = 1.0f / (fs[(ord * 2 + 0) * 1024 + c] + fs[(ord * 2 + 1) * 1024 + c]);
#pragma unroll
                for (int q = 0; q < 4; ++q) {
                    const int X0 = (q * 128 + pt) * 8;
                    float rv[9];
#pragma unroll
                    for (int i = 0; i < 9; ++i) { const int dp = 2047 - X0 - i; rv[i] = (dp >= 0 ? __builtin_nontemporal_load(hf + dp) : (dp >= -2047 ? __builtin_nontemporal_load(hbk - dp) : 0.f)) * invs; if (dp == 0) rv[i] += sk; }
                    uint4 o0, o1;
                    o0.x = pk_bf16(rv[0], rv[1]); o0.y = pk_bf16(rv[2], rv[3]); o0.z = pk_bf16(rv[4], rv[5]); o0.w = pk_bf16(rv[6], rv[7]);
                    o1.x = pk_bf16(rv[1], rv[2]); o1.y = pk_bf16(rv[3], rv[4]); o1.z = pk_bf16(rv[5], rv[6]); o1.w = pk_bf16(rv[7], rv[8]);
                    *(uint4*)(sl + HY_R0 + X0 * 2) = o0; *(uint4*)(sl + HY_R1 + X0 * 2) = o1;
                }
            }
            hy_pair_sync(fl, wv, ++seq);
            f32x16v acc[4];
#pragma unroll
            for (int mb = 0; mb < 4; ++mb)
#pragma unroll
                for (int e = 0; e < 16; ++e) acc[mb][e] = 0.f;
            {
                const int dlo = I0 - 15, dhi = I0 + 7;
                bf16x8v As[7][2];
#pragma unroll
                for (int s2 = 0; s2 < 3; ++s2)
#pragma unroll
                    for (int k2 = 0; k2 < 2; ++k2) As[4 + s2][k2] = hy_lda(sl, laneA - 64 * (4 * dlo - 3 + s2) + 32 * k2);
#pragma unroll 1
                for (int d = dlo; d <= dhi; ++d) {
#pragma unroll
                    for (int k2 = 0; k2 < 2; ++k2) { As[0][k2] = As[4][k2]; As[1][k2] = As[5][k2]; As[2][k2] = As[6][k2]; }
#pragma unroll
                    for (int s2 = 3; s2 < 7; ++s2)
#pragma unroll
                        for (int k2 = 0; k2 < 2; ++k2) As[s2][k2] = hy_lda(sl, laneA - 64 * (4 * d - 3 + s2) + 32 * k2);
                    const int jl = I0 + i_local - d; const bool valid = (unsigned)jl < 16u;
                    const unsigned char* bp = sl + batch * HY_PB + (valid ? jl : 0) * HY_PJ + hh * 16;
                    bf16x8v Bq[8];
#pragma unroll
                    for (int q = 0; q < 8; ++q) { const bf16x8v v = *(const bf16x8v*)(bp + q * 32); const bf16x8v zero = {0, 0, 0, 0, 0, 0, 0, 0}; Bq[q] = valid ? v : zero; }
#pragma unroll
                    for (int kb = 0; kb < 4; ++kb)
#pragma unroll
                        for (int k2 = 0; k2 < 2; ++k2)
#pragma unroll
                            for (int mb = 0; mb < 4; ++mb) acc[mb] = __builtin_amdgcn_mfma_f32_32x32x16_bf16(As[mb - kb + 3][k2], Bq[2 * kb + k2], acc[mb], 0, 0, 0);
                }
            }
            hy_pair_sync(fl, wv, ++seq);
            hy_stage_rows(zT, cw, cb, (ord == 0 ? 1024 : 2048) + c, half, lane, sl);
            hy_pair_sync(fl, wv, ++seq);
            {
#pragma unroll
                for (int mb = 0; mb < 4; ++mb)
#pragma unroll
                    for (int q4 = 0; q4 < 4; ++q4) {
                        const int t4 = 128 * (I0 + i_local) + 32 * mb + 8 * q4 + 4 * hh;
                        uint2* gp = (uint2*)(sl + batch * HY_PB + (t4 >> 7) * HY_PJ + (t4 & 127) * 2);
                        const uint2 gv = *gp;
                        uint2 o; o.x = pk_bf16(__uint_as_float(gv.x << 16) * acc[mb][q4 * 4 + 0], __uint_as_float(gv.x & 0xffff0000u) * acc[mb][q4 * 4 + 1]);
                        o.y = pk_bf16(__uint_as_float(gv.y << 16) * acc[mb][q4 * 4 + 2], __uint_as_float(gv.y & 0xffff0000u) * acc[mb][q4 * 4 + 3]);
                        *gp = o;
                    }
            }
            if (ord == 1) {
                hy_pair_sync(fl, wv, ++seq);
#pragma unroll
                for (int q = 0; q < 8; ++q) {
                    const int bsel = 2 * half + (q >> 2), t0 = ((q & 3) * 64 + lane) * 8;
                    nt_store4u(hyT + (size_t)c * NT + bsel * SL + t0, *(const uint4*)(sl + bsel * HY_PB + (t0 >> 7) * HY_PJ + (t0 & 127) * 2));
                }
            }
        }
    }
    __builtin_amdgcn_s_setprio(0);
}

__device__ __forceinline__ bf16x8v pack_p(const f32x4v& lo, const f32x4v& hi) {
    union { unsigned u[4]; bf16x8v v; } r;
    r.u[0] = pk_bf16(lo[0], lo[1]); r.u[1] = pk_bf16(lo[2], lo[3]); r.u[2] = pk_bf16(hi[0], hi[1]); r.u[3] = pk_bf16(hi[2], hi[3]);
    return r.v;
}
__device__ __forceinline__ bf16x8v ld_pair8(const bf16_t* lo, const bf16_t* hi) {
    union { uint2 d[2]; bf16x8v v; } r;
    r.d[0] = *(const uint2*)lo; r.d[1] = *(const uint2*)hi;
    return r.v;
}
typedef __attribute__((address_space(3))) const bf16_t* lds_bf16p;
#define LDS_FRAG(pe) (*(const __attribute__((address_space(3))) bf16x8v*)(pe))
constexpr int NA_KC = 0, NA_VC = 32768, NA_KL = 65536, NA_RPB = 155648;
__device__ __forceinline__ void phase_na(const Params& p, unsigned char* smem) {
    const int tid = opaque_tid(), lane = tid & 63, wv = tid >> 6, ql = lane & 15, g = lane >> 4;
    const bf16_t* qh = (const bf16_t*)((const char*)p.ws + B_QH); const bf16_t* kh = (const bf16_t*)((const char*)p.ws + B_KH);
    const bf16_t* kch = (const bf16_t*)((const char*)p.ws + B_KCH); const bf16_t* vT = (const bf16_t*)((const char*)p.ws + B_VT);
    const bf16_t* vcT = (const bf16_t*)((const char*)p.ws + B_VCT); bf16_t* na = (bf16_t*)((char*)p.ws + B_NA);
    const float* rpb = p.in[I_RPB];
    const lds_bf16p kcl = (lds_bf16p)((__attribute__((address_space(3))) unsigned char*)smem + NA_KC);
    const lds_bf16p vcl = (lds_bf16p)((__attribute__((address_space(3))) unsigned char*)smem + NA_VC);
    const lds_bf16p kll = (lds_bf16p)((__attribute__((address_space(3))) unsigned char*)smem + NA_KL);
    for (int sitem = blockIdx.x; sitem < 256; sitem += gridDim.x) {
      const int b = sitem >> 6, h = (sitem >> 2) & 15, rqp = sitem & 3;
      __syncthreads();
      {
          const uint4* s0 = (const uint4*)(kch + (size_t)((b * 16 + h) * 32) * 512); const uint4* s1 = (const uint4*)(vcT + (size_t)((b * 16 + h) * 32) * 512);
          uint4* d0 = (uint4*)(smem + NA_KC); uint4* d1 = (uint4*)(smem + NA_VC);
#pragma unroll
          for (int i = 0; i < 4; ++i) { d0[tid + i * NTHREADS] = s0[tid + i * NTHREADS]; d1[tid + i * NTHREADS] = s1[tid + i * NTHREADS]; }
          if (tid < 465) ((float*)(smem + NA_RPB))[tid] = rpb[h * 465 + tid];
      }
#pragma unroll 1
      for (int half = 0; half < 2; ++half) {
        const int r0 = rqp * 8 + half * 4;
        const int rs_min = min(max(r0 - 4, 0), 24), rs_max = min(max(r0 - 1, 0), 24), nrows = rs_max - rs_min + 8;
        if (half) __syncthreads();
        {
            const uint4* s0 = (const uint4*)(kh + (size_t)((b * 16 + h) * 256 + rs_min * 8) * 512); uint4* d0 = (uint4*)(smem + NA_KL);
            for (int e = tid; e < nrows * 512; e += NTHREADS) d0[e] = s0[e];
        }
        __syncthreads();
#pragma unroll 1
        for (int ti = 0; ti < 2; ++ti) {
        const int r = r0 + (wv >> 2) + 2 * ti, j = wv & 3;
        const int rs = min(max(r - 4, 0), 24), cs = min(max(16 * j - 8, 0), 32);
        const int x = 16 * j + ql, wsx = min(max(x - 8, 0), 48);
        const bf16_t* qrow = qh + ((size_t)((b * 16 + h) * SL + r * 64 + x)) * 64;
        const bf16x8v qf0 = __builtin_nontemporal_load((const bf16x8v*)(qrow + 8 * g)), qf1 = __builtin_nontemporal_load((const bf16x8v*)(qrow + 32 + 8 * g));
        const __attribute__((address_space(3))) float* rp_h = (const __attribute__((address_space(3))) float*)((__attribute__((address_space(3))) unsigned char*)smem + NA_RPB);
        f32x4v o1[4], o2[4]; float m1 = -1e30f, l1 = 0.f, m2 = -1e30f, l2 = 0.f;
#pragma unroll
        for (int d = 0; d < 4; ++d) { o1[d] = (f32x4v){0.f, 0.f, 0.f, 0.f}; o2[d] = (f32x4v){0.f, 0.f, 0.f, 0.f}; }
        const int koff = (ql >> 2) * 512 + g * 32 + (ql & 3) * 8;
        const bf16_t* vb = vT + (size_t)((b * 16 + h) * 256 + g) * 512 + ql * 8;
        {
            f32x4v st[16];
#pragma unroll
            for (int kb = 0; kb < 16; ++kb) {
                const lds_bf16p kp = kcl + koff + (kb >> 1) * 2048 + (kb & 1) * 128;
                const bf16x8v a0 = LDS_FRAG(kp), a1 = LDS_FRAG(kp + 256);
                f32x4v acc = {0.f, 0.f, 0.f, 0.f};
                acc = __builtin_amdgcn_mfma_f32_16x16x32_bf16(a0, qf0, acc, 0, 0, 0);
                acc = __builtin_amdgcn_mfma_f32_16x16x32_bf16(a1, qf1, acc, 0, 0, 0);
#pragma unroll
                for (int rr = 0; rr < 4; ++rr) { acc[rr] *= 0.125f; m1 = fmaxf(m1, acc[rr]); }
                st[kb] = acc;
            }
            m1 = fmaxf(m1, __shfl_xor(m1, 16)); m1 = fmaxf(m1, __shfl_xor(m1, 32));
#pragma unroll
            for (int kb = 0; kb < 16; ++kb)
#pragma unroll
                for (int rr = 0; rr < 4; ++rr) { const float e = __expf(st[kb][rr] - m1); st[kb][rr] = e; l1 += e; }
            l1 += __shfl_xor(l1, 16); l1 += __shfl_xor(l1, 32);
#pragma unroll
            for (int kp = 0; kp < 8; ++kp) {
                const bf16x8v pb = pack_p(st[2 * kp], st[2 * kp + 1]);
#pragma unroll
                for (int d = 0; d < 4; ++d) o1[d] = __builtin_amdgcn_mfma_f32_16x16x32_bf16(LDS_FRAG(vcl + g * 512 + ql * 8 + kp * 2048 + d * 128), pb, o1[d], 0, 0, 0);
            }
        }
        {
            f32x4v st[16];
#pragma unroll
            for (int kb = 0; kb < 16; ++kb) {
                const lds_bf16p kp = kll + koff + ((((rs + (kb >> 1) - rs_min) * 64 + cs) >> 3) * 512) + (kb & 1) * 128;
                const bf16x8v a0 = LDS_FRAG(kp), a1 = LDS_FRAG(kp + 256);
                f32x4v acc = {0.f, 0.f, 0.f, 0.f};
                acc = __builtin_amdgcn_mfma_f32_16x16x32_bf16(a0, qf0, acc, 0, 0, 0);
                acc = __builtin_amdgcn_mfma_f32_16x16x32_bf16(a1, qf1, acc, 0, 0, 0);
                const int dr = rs + (kb >> 1) - r + 7;
#pragma unroll
                for (int rr = 0; rr < 4; ++rr) {
                    const int kc = cs + 8 * g + 4 * (kb & 1) + rr, rel = kc - wsx;
                    const bool ok = rel >= 0 && rel < 16;
                    const int dc = min(max(kc - x + 15, 0), 30);
                    const float sv = ok ? acc[rr] * 0.125f + rp_h[dr * 31 + dc] : -1e30f;
                    acc[rr] = sv; m2 = fmaxf(m2, sv);
                }
                st[kb] = acc;
                if ((kb & 7) == 7) asm volatile("" ::: "memory");
            }
            m2 = fmaxf(m2, __shfl_xor(m2, 16)); m2 = fmaxf(m2, __shfl_xor(m2, 32));
#pragma unroll
            for (int kb = 0; kb < 16; ++kb)
#pragma unroll
                for (int rr = 0; rr < 4; ++rr) { const float e = __expf(st[kb][rr] - m2); st[kb][rr] = e; l2 += e; }
            l2 += __shfl_xor(l2, 16); l2 += __shfl_xor(l2, 32);
#pragma unroll
            for (int kp = 0; kp < 8; ++kp) {
                const bf16x8v pb = pack_p(st[2 * kp], st[2 * kp + 1]);
                const bf16_t* vp = vb + (size_t)(((rs + kp) * 64 + cs) >> 3) * 512;
#pragma unroll
                for (int d = 0; d < 4; ++d) o2[d] = __builtin_amdgcn_mfma_f32_16x16x32_bf16(*(const bf16x8v*)(vp + d * 128), pb, o2[d], 0, 0, 0);
                if ((kp & 3) == 3) asm volatile("" ::: "memory");
            }
        }
        const float mm = fmaxf(m1, m2), c1 = __expf(m1 - mm), c2 = __expf(m2 - mm);
        const float inv = 1.0f / (c1 * l1 + c2 * l2);
        const float w1 = c1 * inv, w2 = c2 * inv;
        f32x4v o[4];
#pragma unroll
        for (int d = 0; d < 4; ++d) o[d] = o1[d] * w1 + o2[d] * w2;
        bf16_t* op = na + (size_t)(b * SL + r * 64 + x) * DNA + h * 64 + 4 * g;
#pragma unroll
        for (int d = 0; d < 4; ++d) { uint2 w; w.x = pk_bf16(o[d][0], o[d][1]); w.y = pk_bf16(o[d][2], o[d][3]); nt_store2u(op + 16 * d, w); }
        }
      }
    }
}

__device__ __forceinline__ void phase_f(const Params& p, float* ldsf) {
    const int tid = opaque_tid();
    const bf16_t* hyT = (const bf16_t*)((const char*)p.ws + B_HYT); const bf16_t* na = (const bf16_t*)((const char*)p.ws + B_NA);
    bf16_t* ob = (bf16_t*)((char*)p.ws + B_UB);
    const float* ghy = p.in[I_GHY]; const float* gna = p.in[I_GNA];
    bf16_t* tile = (bf16_t*)ldsf;
    for (int item = blockIdx.x; item < NT / 32; item += gridDim.x) {
        const int t0 = item * 32;
        __syncthreads();
        uint4 hvv[8];
#pragma unroll
        for (int q = 0; q < 8; ++q) { const int e = q * NTHREADS + tid; hvv[q] = nt_load4u(hyT + (size_t)(e >> 2) * NT + t0 + (e & 3) * 8); }
#pragma unroll
        for (int q = 0; q < 8; ++q) {
            const int e = q * NTHREADS + tid, ch = e >> 2, part = e & 3;
            const unsigned wd[4] = {hvv[q].x, hvv[q].y, hvv[q].z, hvv[q].w};
#pragma unroll
            for (int i = 0; i < 4; ++i) { tile[(part * 8 + 2 * i) * 1032 + ch] = (bf16_t)(wd[i] & 0xffffu); tile[(part * 8 + 2 * i + 1) * 1032 + ch] = (bf16_t)(wd[i] >> 16); }
        }
        __syncthreads();
        const int tk = tid >> 4, sub = tid & 15;
        float hv[64]; float sh = 0.f, sn = 0.f;
#pragma unroll
        for (int i = 0; i < 8; ++i) {
            const uint4 v = *(const uint4*)(tile + tk * 1032 + (i * 16 + sub) * 8);
            const unsigned wd[4] = {v.x, v.y, v.z, v.w};
#pragma unroll
            for (int k = 0; k < 4; ++k) { const float a = __uint_as_float(wd[k] << 16), c = __uint_as_float(wd[k] & 0xffff0000u); hv[i * 8 + 2 * k] = a; hv[i * 8 + 2 * k + 1] = c; sh += a * a + c * c; }
        }
        const bf16_t* nrow = na + (size_t)(t0 + tk) * DNA;
        uint4 nv[8];
#pragma unroll
        for (int i = 0; i < 8; ++i) { nv[i] = nt_load4u(nrow + (i * 16 + sub) * 8);
            const unsigned wd[4] = {nv[i].x, nv[i].y, nv[i].z, nv[i].w};
#pragma unroll
            for (int k = 0; k < 4; ++k) { const float a = __uint_as_float(wd[k] << 16), c = __uint_as_float(wd[k] & 0xffff0000u); sn += a * a + c * c; } }
        sh += __shfl_xor(sh, 1); sh += __shfl_xor(sh, 2); sh += __shfl_xor(sh, 4); sh += __shfl_xor(sh, 8);
        sn += __shfl_xor(sn, 1); sn += __shfl_xor(sn, 2); sn += __shfl_xor(sn, 4); sn += __shfl_xor(sn, 8);
        const float rh = rsqrtf(sh * (1.0f / 1024.0f) + LN_EPS), rn = rsqrtf(sn * (1.0f / 1024.0f) + LN_EPS);
        bf16_t* orow = ob + (size_t)(t0 + tk) * D;
#pragma unroll
        for (int i = 0; i < 8; ++i) {
            const float4 g0 = *(const float4*)(ghy + (i * 16 + sub) * 8), g1 = *(const float4*)(ghy + (i * 16 + sub) * 8 + 4);
            uint4 w; w.x = pk_bf16(hv[i * 8] * rh * g0.x, hv[i * 8 + 1] * rh * g0.y); w.y = pk_bf16(hv[i * 8 + 2] * rh * g0.z, hv[i * 8 + 3] * rh * g0.w);
            w.z = pk_bf16(hv[i * 8 + 4] * rh * g1.x, hv[i * 8 + 5] * rh * g1.y); w.w = pk_bf16(hv[i * 8 + 6] * rh * g1.z, hv[i * 8 + 7] * rh * g1.w);
            *(uint4*)(orow + (i * 16 + sub) * 8) = w;
        }
#pragma unroll
        for (int i = 0; i < 8; ++i) {
            const float4 g0 = *(const float4*)(gna + (i * 16 + sub) * 8), g1 = *(const float4*)(gna + (i * 16 + sub) * 8 + 4);
            const unsigned wd[4] = {nv[i].x, nv[i].y, nv[i].z, nv[i].w};
            float a[8];
#pragma unroll
            for (int k = 0; k < 4; ++k) { a[2 * k] = __uint_as_float(wd[k] << 16); a[2 * k + 1] = __uint_as_float(wd[k] & 0xffff0000u); }
            uint4 w; w.x = pk_bf16(a[0] * rn * g0.x, a[1] * rn * g0.y); w.y = pk_bf16(a[2] * rn * g0.z, a[3] * rn * g0.w);
            w.z = pk_bf16(a[4] * rn * g1.x, a[5] * rn * g1.y); w.w = pk_bf16(a[6] * rn * g1.z, a[7] * rn * g1.w);
            *(uint4*)(orow + DHY + (i * 16 + sub) * 8) = w;
        }
    }
}

__device__ __forceinline__ void phase_h(const Params& p) {
    const int tid = opaque_tid(), lane = tid & 63, wv = tid >> 6;
    const float* x = p.in[I_X]; const bf16_t* y = (const bf16_t*)((const char*)p.ws + B_Y); const float* ada = p.ws + W_ADA;
    const float* g = p.in[I_LN1G]; const float* be = p.in[I_LN1B];
    bf16_t* x1 = (bf16_t*)((char*)p.ws + B_X1); bf16_t* u2b = (bf16_t*)((char*)p.ws + B_UB); unsigned* u2q = (unsigned*)((char*)p.ws + B_U2Q); float* su2 = p.ws + W_SU2;
#pragma unroll 1
    for (int tp = blockIdx.x * NWAVES + wv; tp < NT / 2; tp += gridDim.x * NWAVES) {
        const int b = (2 * tp) / SL;
        float v[2][32]; float s[2] = {0.f, 0.f};
#pragma unroll
        for (int u = 0; u < 2; ++u)
#pragma unroll
            for (int j = 0; j < 8; ++j) {
                const int col = j * 256 + lane * 4; const size_t t = (size_t)(2 * tp + u);
                const float4 xv = nt_load4(x + t * D + col); const uint2 yb = nt_load2u(y + t * D + col);
                const float4 yv = make_float4(__uint_as_float(yb.x << 16), __uint_as_float(yb.x & 0xffff0000u), __uint_as_float(yb.y << 16), __uint_as_float(yb.y & 0xffff0000u));
                const float4 gt = *(const float4*)(ada + b * 12288 + 2 * 2048 + col);
                v[u][j * 4] = ALPHA * xv.x + gt.x * yv.x; v[u][j * 4 + 1] = ALPHA * xv.y + gt.y * yv.y; v[u][j * 4 + 2] = ALPHA * xv.z + gt.z * yv.z; v[u][j * 4 + 3] = ALPHA * xv.w + gt.w * yv.w;
                s[u] += (v[u][j * 4] + v[u][j * 4 + 1]) + (v[u][j * 4 + 2] + v[u][j * 4 + 3]);
            }
        float rstd[2];
#pragma unroll
        for (int u = 0; u < 2; ++u) {
            const float mean = wave_sum(s[u]) * (1.0f / 2048.0f);
            float q2 = 0.f;
#pragma unroll
            for (int i = 0; i < 32; ++i) { v[u][i] -= mean; q2 += v[u][i] * v[u][i]; }
            rstd[u] = rsqrtf(wave_sum(q2) * (1.0f / 2048.0f) + LN_EPS);
        }
        asm volatile("" ::: "memory");
        float umx[2] = {0.f, 0.f};
#pragma unroll
        for (int j = 0; j < 8; ++j) {
            const int col = j * 256 + lane * 4;
            const float4 gv = *(const float4*)(g + col), bv = *(const float4*)(be + col);
            const float4 sh = *(const float4*)(ada + b * 12288 + 3 * 2048 + col), sc = *(const float4*)(ada + b * 12288 + 4 * 2048 + col);
#pragma unroll
            for (int u = 0; u < 2; ++u) {
                const size_t t = (size_t)(2 * tp + u);
                const float4 o = make_float4(v[u][j * 4] * rstd[u] * gv.x + bv.x, v[u][j * 4 + 1] * rstd[u] * gv.y + bv.y, v[u][j * 4 + 2] * rstd[u] * gv.z + bv.z, v[u][j * 4 + 3] * rstd[u] * gv.w + bv.w);
                { uint2 xb; xb.x = pk_bf16(o.x, o.y); xb.y = pk_bf16(o.z, o.w); nt_store2u(x1 + t * D + col, xb); }
                const float4 uv = make_float4(o.x * (1.f + sc.x) + sh.x, o.y * (1.f + sc.y) + sh.y, o.z * (1.f + sc.z) + sh.z, o.w * (1.f + sc.w) + sh.w);
                v[u][j * 4] = uv.x; v[u][j * 4 + 1] = uv.y; v[u][j * 4 + 2] = uv.z; v[u][j * 4 + 3] = uv.w;
                uint2 ub2; ub2.x = pk_bf16(uv.x, uv.y); ub2.y = pk_bf16(uv.z, uv.w);
                *(uint2*)(u2b + t * D + col) = ub2;
                umx[u] = fmaxf(umx[u], fmaxf(fmaxf(fabsf(uv.x), fabsf(uv.y)), fmaxf(fabsf(uv.z), fabsf(uv.w))));
            }
        }
#pragma unroll
        for (int u = 0; u < 2; ++u) {
            const size_t t = (size_t)(2 * tp + u);
            const float um = wave_max(umx[u]);
            const float inv = um > 0.f ? 127.0f / um : 0.f;
            uint4 qa, qb;
            qa.x = q4(v[u][0], v[u][1], v[u][2], v[u][3], inv, 0); qa.y = q4(v[u][4], v[u][5], v[u][6], v[u][7], inv, 0); qa.z = q4(v[u][8], v[u][9], v[u][10], v[u][11], inv, 0); qa.w = q4(v[u][12], v[u][13], v[u][14], v[u][15], inv, 0);
            qb.x = q4(v[u][16], v[u][17], v[u][18], v[u][19], inv, 0); qb.y = q4(v[u][20], v[u][21], v[u][22], v[u][23], inv, 0); qb.z = q4(v[u][24], v[u][25], v[u][26], v[u][27], inv, 0); qb.w = q4(v[u][28], v[u][29], v[u][30], v[u][31], inv, 0);
            nt_store4u(u2q + t * 512 + lane * 8, qa); nt_store4u(u2q + t * 512 + lane * 8 + 4, qb);
            if (lane == 0) su2[t] = um * (1.0f / 127.0f);
        }
    }
}

template <int N> __device__ __forceinline__ void bitonic_desc(float (&v)[N]) {
#pragma unroll
    for (int k = 2; k <= N; k <<= 1)
#pragma unroll
        for (int j = k >> 1; j > 0; j >>= 1)
#pragma unroll
            for (int i = 0; i < N; ++i) { const int l = i ^ j; if (l > i) { const float x = v[i], y = v[l]; const float mx = fmaxf(x, y), mn = fminf(x, y); if ((i & k) == 0) { v[i] = mx; v[l] = mn; } else { v[i] = mn; v[l] = mx; } } }
}
__device__ __forceinline__ void bitonic_merge16_desc(float (&v)[16]) {
#pragma unroll
    for (int j = 8; j > 0; j >>= 1)
#pragma unroll
        for (int i = 0; i < 16; ++i) { const int l = i ^ j; if (l > i) { const float x = v[i], y = v[l]; v[i] = fmaxf(x, y); v[l] = fminf(x, y); } }
}
__device__ __forceinline__ void top16_of_128(float (&sc)[32], float (&top)[16]) {
    float lo[16], hi[16];
#pragma unroll
    for (int i = 0; i < 16; ++i) { lo[i] = sc[i]; hi[i] = sc[16 + i]; }
    bitonic_desc<16>(lo); bitonic_desc<16>(hi);
#pragma unroll
    for (int i = 0; i < 16; ++i) top[i] = fmaxf(lo[i], hi[15 - i]);
    bitonic_merge16_desc(top);
#pragma unroll
    for (int off = 16; off <= 32; off <<= 1) {
        float o[16];
#pragma unroll
        for (int i = 0; i < 16; ++i) o[i] = __shfl_xor(top[15 - i], off);
#pragma unroll
        for (int i = 0; i < 16; ++i) top[i] = fmaxf(top[i], o[i]);
        bitonic_merge16_desc(top);
    }
}
__device__ __forceinline__ void ce_carry(float& va, int& xa, float& vb, int& xb, bool desc) {
    const bool sw = desc ? (vb > va) : (vb < va);
    const float tv = sw ? vb : va, uv = sw ? va : vb; const int tx = sw ? xb : xa, ux = sw ? xa : xb;
    va = tv; vb = uv; xa = tx; xb = ux;
}
__device__ __forceinline__ void bitonic_merge16_desc_carry(float (&v)[16], int (&x)[16]) {
#pragma unroll
    for (int j = 8; j > 0; j >>= 1)
#pragma unroll
        for (int i = 0; i < 16; ++i) { const int l = i ^ j; if (l > i) ce_carry(v[i], x[i], v[l], x[l], true); }
}
constexpr int CAND_I[52] = {0,0,0,0,0,0,0,0,0,0,0,0,0,0,0,0,1,1,1,1,1,1,1,1,2,2,2,2,2,3,3,3,3,4,4,4,5,5,6,6,7,7,8,9,10,11,12,13,14,15,-1,-1};
constexpr int CAND_J[52] = {0,1,2,3,4,5,6,7,8,9,10,11,12,13,14,15,0,1,2,3,4,5,6,7,0,1,2,3,4,0,1,2,3,0,1,2,0,1,0,1,0,1,0,0,0,0,0,0,0,0,-1,-1};

__device__ __forceinline__ int rl_i(int v, int l) { return __builtin_amdgcn_readlane(v, l); }
__device__ __forceinline__ float rl_f(float v, int l) { return __int_as_float(__builtin_amdgcn_readlane(__float_as_int(v), l)); }
#define LANE_OF(k) ((((k) >> 3) & 1) * 32 + (((k) >> 2) & 1) * 16 + (((k) >> 1) & 1) * 8 + ((k) & 1) * 4)
constexpr size_t B_KEYSB = 15 * MiB;
constexpr size_t B_QB = B_Y;

typedef float f32x2v __attribute__((ext_vector_type(2)));
#define PKFMA_LO(fv, xv, wsv) do { f32x2v _t; asm("v_cvt_pk_f32_fp8 %1, %2\n\tv_pk_fma_f32 %0, %3, %1, %0" : "+v"(fv), "=&v"(_t) : "v"(xv), "v"(wsv)); } while (0)
#define PKFMA_HI(fv, xv, wsv) do { f32x2v _t; asm("v_cvt_pk_f32_fp8_sdwa %1, %2 src0_sel:WORD_1\n\tv_pk_fma_f32 %0, %3, %1, %0" : "+v"(fv), "=&v"(_t) : "v"(xv), "v"(wsv)); } while (0)
#define FACC(i) (f2[((i) >> 3) * 4 + (((i) & 1) ? 2 : 0) + (((i) & 7) >> 2)][(((i) & 7) >> 1) & 1])
__device__ __forceinline__ void gather_token(const Params& p, int t, const int* sel_idx, const float* sel_g, int lane) {
    const bf16_t* x1 = (const bf16_t*)((const char*)p.ws + B_X1); const float* ada = p.ws + W_ADA;
    const char* uq = (const char*)p.ws + B_TQ; const char* vq = uq + (size_t)16384 * VROW; const char* u2q = (const char*)p.ws + B_U2Q;
    const __amdgpu_buffer_rsrc_t ursrc = __builtin_amdgcn_make_buffer_rsrc((void*)uq, 0, 16384 * VROW, 0x00020000);
    const __amdgpu_buffer_rsrc_t vrsrc = __builtin_amdgcn_make_buffer_rsrc((void*)vq, 0, 16384 * VROW, 0x00020000);
    const float* su2 = p.ws + W_SU2; const float* rsu = p.ws + W_SU; const float* rsv = p.ws + W_SV;
    const float* g2 = p.in[I_LN2G]; const float* b2 = p.in[I_LN2B];
    const int b = t / SL;
    unsigned ue[4], uo[4]; int us0, us1;
    {
        const uint4 ua_ = nt_load4u(u2q + (size_t)t * D + lane * 32), ub_ = nt_load4u(u2q + (size_t)t * D + lane * 32 + 16);
        const int4 ua = make_int4((int)ua_.x, (int)ua_.y, (int)ua_.z, (int)ua_.w), ub = make_int4((int)ub_.x, (int)ub_.y, (int)ub_.z, (int)ub_.w);
        ue[0] = __builtin_amdgcn_perm((unsigned)ua.y, (unsigned)ua.x, 0x06040200u); uo[0] = __builtin_amdgcn_perm((unsigned)ua.y, (unsigned)ua.x, 0x07050301u);
        ue[1] = __builtin_amdgcn_perm((unsigned)ua.w, (unsigned)ua.z, 0x06040200u); uo[1] = __builtin_amdgcn_perm((unsigned)ua.w, (unsigned)ua.z, 0x07050301u);
        ue[2] = __builtin_amdgcn_perm((unsigned)ub.y, (unsigned)ub.x, 0x06040200u); uo[2] = __builtin_amdgcn_perm((unsigned)ub.y, (unsigned)ub.x, 0x07050301u);
        ue[3] = __builtin_amdgcn_perm((unsigned)ub.w, (unsigned)ub.z, 0x06040200u); uo[3] = __builtin_amdgcn_perm((unsigned)ub.w, (unsigned)ub.z, 0x07050301u);
        us0 = __builtin_amdgcn_sdot4(ua.x, 0x01010101, 0, false); us0 = __builtin_amdgcn_sdot4(ua.y, 0x01010101, us0, false); us0 = __builtin_amdgcn_sdot4(ua.z, 0x01010101, us0, false); us0 = __builtin_amdgcn_sdot4(ua.w, 0x01010101, us0, false);
        us1 = __builtin_amdgcn_sdot4(ub.x, 0x01010101, 0, false); us1 = __builtin_amdgcn_sdot4(ub.y, 0x01010101, us1, false); us1 = __builtin_amdgcn_sdot4(ub.z, 0x01010101, us1, false); us1 = __builtin_amdgcn_sdot4(ub.w, 0x01010101, us1, false);
    }
    const float s2 = su2[t];
    f32x2v f2[16];
#pragma unroll
    for (int i = 0; i < 16; ++i) f2[i] = (f32x2v){0.f, 0.f};
    float fb0 = 0.f, fb1 = 0.f;
    const int kk8 = ((lane >> 5) & 1) * 4 + ((lane >> 4) & 1) * 2 + ((lane >> 3) & 1);
#define LANE_OF8(k) ((((k) >> 2) & 1) * 32 + (((k) >> 1) & 1) * 16 + ((k) & 1) * 8)
    int e_cur = sel_idx[kk8]; float g_cur = sel_g[kk8];
    uint4 un[8]; unsigned usc[8];
#pragma unroll
    for (int k = 0; k < 8; ++k) { const int ro = rl_i(e_cur, LANE_OF8(k)) * VROW; un[k] = __builtin_bit_cast(uint4, __builtin_amdgcn_raw_buffer_load_b128(ursrc, lane * 16, ro, 0)); usc[k] = __builtin_amdgcn_raw_buffer_load_b16(ursrc, 1024 + lane * 2, ro, 0); }
#pragma unroll 1
    for (int bt = 0; bt < 16; ++bt) {
        uint4 vn[8]; unsigned vsc[8];
#pragma unroll
        for (int k = 0; k < 8; ++k) { const int ro = rl_i(e_cur, LANE_OF8(k)) * VROW; vn[k] = __builtin_bit_cast(uint4, __builtin_amdgcn_raw_buffer_load_b128(vrsrc, lane * 16, ro, 0)); vsc[k] = __builtin_amdgcn_raw_buffer_load_b16(vrsrc, 1024 + lane * 2, ro, 0); }
        __builtin_amdgcn_sched_barrier(0);
        float part[8];
#pragma unroll
        for (int k = 0; k < 8; ++k) {
            const uint4 nq = un[k]; const unsigned scw = usc[k];
            int d0 = __builtin_amdgcn_sdot4((int)ue[0], (int)(nq.x & 0x0F0F0F0Fu), -8 * us0, false); d0 = __builtin_amdgcn_sdot4((int)uo[0], (int)((nq.x >> 4) & 0x0F0F0F0Fu), d0, false);
            d0 = __builtin_amdgcn_sdot4((int)ue[1], (int)(nq.y & 0x0F0F0F0Fu), d0, false); d0 = __builtin_amdgcn_sdot4((int)uo[1], (int)((nq.y >> 4) & 0x0F0F0F0Fu), d0, false);
            int d1 = __builtin_amdgcn_sdot4((int)ue[2], (int)(nq.z & 0x0F0F0F0Fu), -8 * us1, false); d1 = __builtin_amdgcn_sdot4((int)uo[2], (int)((nq.z >> 4) & 0x0F0F0F0Fu), d1, false);
            d1 = __builtin_amdgcn_sdot4((int)ue[3], (int)(nq.w & 0x0F0F0F0Fu), d1, false); d1 = __builtin_amdgcn_sdot4((int)uo[3], (int)((nq.w >> 4) & 0x0F0F0F0Fu), d1, false);
            { const f32x2v sc2 = __builtin_amdgcn_cvt_pk_f32_fp8((int)scw, false); part[k] = (float)d0 * sc2[0] + (float)d1 * sc2[1]; }
            __builtin_amdgcn_sched_barrier(0);
        }
        const int bn = (bt + 1) & 15;
        const int e_nxt = sel_idx[bn * 8 + kk8]; const float g_nxt = sel_g[bn * 8 + kk8];
#pragma unroll
        for (int k = 0; k < 8; ++k) { const int ro = rl_i(e_nxt, LANE_OF8(k)) * VROW; un[k] = __builtin_bit_cast(uint4, __builtin_amdgcn_raw_buffer_load_b128(ursrc, lane * 16, ro, 0)); usc[k] = __builtin_amdgcn_raw_buffer_load_b16(ursrc, 1024 + lane * 2, ro, 0); }
        __builtin_amdgcn_sched_barrier(0);
        { const bool up = (lane & 32) != 0;
#pragma unroll
          for (int i = 0; i < 4; ++i) { const float keep = up ? part[i + 4] : part[i], send = up ? part[i] : part[i + 4]; part[i] = keep + __shfl_xor(send, 32); } }
        { const bool up = (lane & 16) != 0;
#pragma unroll
          for (int i = 0; i < 2; ++i) { const float keep = up ? part[i + 2] : part[i], send = up ? part[i] : part[i + 2]; part[i] = keep + __shfl_xor(send, 16); } }
        { const bool up = (lane & 8) != 0;
          const float keep = up ? part[1] : part[0], send = up ? part[0] : part[1]; part[0] = keep + __shfl_xor(send, 8); }
        float tot = part[0]; tot += __shfl_xor(tot, 1); tot += __shfl_xor(tot, 2); tot += __shfl_xor(tot, 4);
        const float dt = tot * s2 * rsu[e_cur];
        const float act = 0.5f * dt * (1.0f + erff(dt * 0.7071067811865476f));
        const float w_l = g_cur * act * rsv[e_cur];
#pragma unroll
        for (int k = 0; k < 8; ++k) {
            const float w = rl_f(w_l, LANE_OF8(k));
            const unsigned scw = vsc[k];
            const f32x2v sc2 = __builtin_amdgcn_cvt_pk_f32_fp8((int)scw, false); const float ws0 = w * sc2[0], ws1 = w * sc2[1];
            fb0 += ws0; fb1 += ws1;
            const f32x2v wp0 = {ws0 * 512.f, ws0 * 512.f}, wp1 = {ws1 * 512.f, ws1 * 512.f};
            const unsigned wd[4] = {vn[k].x, vn[k].y, vn[k].z, vn[k].w};
#pragma unroll
            for (int q = 0; q < 4; ++q) {
                const unsigned ev = wd[q] & 0x0F0F0F0Fu, od = (wd[q] >> 4) & 0x0F0F0F0Fu;
                if (q < 2) { PKFMA_LO(f2[q * 4 + 0], ev, wp0); PKFMA_HI(f2[q * 4 + 1], ev, wp0); PKFMA_LO(f2[q * 4 + 2], od, wp0); PKFMA_HI(f2[q * 4 + 3], od, wp0); }
                else       { PKFMA_LO(f2[q * 4 + 0], ev, wp1); PKFMA_HI(f2[q * 4 + 1], ev, wp1); PKFMA_LO(f2[q * 4 + 2], od, wp1); PKFMA_HI(f2[q * 4 + 3], od, wp1); }
            }
        }
        e_cur = e_nxt; g_cur = g_nxt;
    }
#undef LANE_OF8
    asm volatile("" ::: "memory");
    float v[32]; float s = 0.f;
#pragma unroll
    for (int q = 0; q < 8; ++q) {
        const int col = q * 256 + lane * 4, o = q * 4;
        const uint2 xb = nt_load2u(x1 + (size_t)t * D + col); const float4 gt = *(const float4*)(ada + b * 12288 + 5 * 2048 + col);
        const float4 xv = make_float4(__uint_as_float(xb.x << 16), __uint_as_float(xb.x & 0xffff0000u), __uint_as_float(xb.y << 16), __uint_as_float(xb.y & 0xffff0000u));
        const float fbh = 8.f * (q < 4 ? fb0 : fb1);
        v[o] = ALPHA * xv.x + gt.x * (FACC(o) - fbh); v[o + 1] = ALPHA * xv.y + gt.y * (FACC(o + 1) - fbh);
        v[o + 2] = ALPHA * xv.z + gt.z * (FACC(o + 2) - fbh); v[o + 3] = ALPHA * xv.w + gt.w * (FACC(o + 3) - fbh);
        s += (v[o] + v[o + 1]) + (v[o + 2] + v[o + 3]);
    }
    const float mean = wave_sum(s) * (1.0f / 2048.0f);
    float q2 = 0.f;
#pragma unroll
    for (int i = 0; i < 32; ++i) { v[i] -= mean; q2 += v[i] * v[i]; }
    const float rstd = rsqrtf(wave_sum(q2) * (1.0f / 2048.0f) + LN_EPS);
    asm volatile("" ::: "memory");
#pragma unroll
    for (int q = 0; q < 8; ++q) {
        const int col = q * 256 + lane * 4, o = q * 4;
        const float4 gv = *(const float4*)(g2 + col), bv = *(const float4*)(b2 + col);
        nt_store4(p.out + (size_t)t * D + col, v[o] * rstd * gv.x + bv.x, v[o + 1] * rstd * gv.y + bv.y, v[o + 2] * rstd * gv.z + bv.z, v[o + 3] * rstd * gv.w + bv.w);
    }
}

__device__ __forceinline__ void phase_jk(const Params& p, unsigned char* smem) {
    const int tid0 = opaque_tid();
    const bf16_t* qb = (const bf16_t*)((const char*)p.ws + B_QB); const bf16_t* keysb = (const bf16_t*)((const char*)p.ws + B_KEYSB);
    int* sel_idx = (int*)smem; float* sel_g = (float*)(smem + 8192);
#pragma unroll 1
    for (int item = blockIdx.x; item < NT / 16; item += gridDim.x) {
        int tid = tid0; asm volatile("" : "+v"(tid));
        const int lane = tid & 63, wv = tid >> 6, ql = lane & 15, g = lane >> 4;
        const int t0 = item * 16, h = wv;
        __syncthreads();
        float ta[16], tb[16];
#pragma unroll
        for (int i = 0; i < 16; ++i) { ta[i] = 0.f; tb[i] = 0.f; }
#pragma unroll 1
        for (int pp = 0; pp < 2; ++pp) {
            const bf16_t* qrow = qb + ((size_t)((((t0 >> 4) * 8 + h) * 2 + pp) * 4) * 64 + lane) * 8;
            bf16x8v qf[4];
#pragma unroll
            for (int kc = 0; kc < 4; ++kc) qf[kc] = __builtin_nontemporal_load((const bf16x8v*)(qrow + kc * 512));
            const bf16_t* kbase = keysb + (size_t)((h * 2 + pp) * 8) * 2048 + lane * 8;
            float sc[32];
#pragma unroll
            for (int nb = 0; nb < 8; ++nb) {
                f32x4v acc = {0.f, 0.f, 0.f, 0.f};
#pragma unroll
                for (int kc = 0; kc < 4; ++kc) acc = __builtin_amdgcn_mfma_f32_16x16x32_bf16(*(const bf16x8v*)(kbase + (nb * 4 + kc) * 512), qf[kc], acc, 0, 0, 0);
#pragma unroll
                for (int rr = 0; rr < 4; ++rr) sc[nb * 4 + rr] = __int_as_float((__float_as_int(acc[rr]) & ~127) | (16 * nb + 4 * g + rr));
                if (nb == 3) asm volatile("" ::: "memory");
            }
            float top[16];
            top16_of_128(sc, top);
#pragma unroll
            for (int i = 0; i < 16; ++i) { if (pp == 0) ta[i] = top[i]; else tb[i] = top[i]; }
        }
        float cv[16]; int cx[16];
#pragma unroll
        for (int sidx = 0; sidx < 13; ++sidx) {
            float vv[4]; int xx[4];
#pragma unroll
            for (int q = 0; q < 4; ++q) {
                const int ci = CAND_I[4 * sidx + q], cj = CAND_J[4 * sidx + q];
                if (ci >= 0) { vv[q] = ta[ci] + tb[cj]; xx[q] = ((__float_as_int(ta[ci]) & 127) << 7) | (__float_as_int(tb[cj]) & 127); } else { vv[q] = -3.0e38f; xx[q] = 0; }
            }
            cv[sidx] = g == 0 ? vv[0] : (g == 1 ? vv[1] : (g == 2 ? vv[2] : vv[3]));
            cx[sidx] = g == 0 ? xx[0] : (g == 1 ? xx[1] : (g == 2 ? xx[2] : xx[3]));
        }
#pragma unroll
        for (int sidx = 13; sidx < 16; ++sidx) { cv[sidx] = -3.0e38f; cx[sidx] = 0; }
#pragma unroll
        for (int k = 2; k <= 16; k <<= 1)
#pragma unroll
            for (int j = k >> 1; j > 0; j >>= 1)
#pragma unroll
                for (int i = 0; i < 16; ++i) { const int l = i ^ j; if (l > i) ce_carry(cv[i], cx[i], cv[l], cx[l], (i & k) == 0); }
#pragma unroll
        for (int off = 16; off <= 32; off <<= 1) {
            float ov[16]; int ox[16];
#pragma unroll
            for (int i = 0; i < 16; ++i) { ov[i] = __shfl_xor(cv[15 - i], off); ox[i] = __shfl_xor(cx[15 - i], off); }
#pragma unroll
            for (int i = 0; i < 16; ++i) { const bool tk = ov[i] > cv[i]; cv[i] = tk ? ov[i] : cv[i]; cx[i] = tk ? ox[i] : cx[i]; }
            bitonic_merge16_desc_carry(cv, cx);
        }
        {
            float ex[16]; float sum = 0.f;
#pragma unroll
            for (int i = 0; i < 16; ++i) { ex[i] = __expf(cv[i] - cv[0]); sum += ex[i]; }
            const float inv = 1.0f / sum;
            if (g == 0) {
#pragma unroll
                for (int q = 0; q < 4; ++q) {
                    *(int4*)(sel_idx + ql * 128 + h * 16 + q * 4) = make_int4(cx[q * 4], cx[q * 4 + 1], cx[q * 4 + 2], cx[q * 4 + 3]);
                    *(float4*)(sel_g + ql * 128 + h * 16 + q * 4) = make_float4(ex[q * 4] * inv, ex[q * 4 + 1] * inv, ex[q * 4 + 2] * inv, ex[q * 4 + 3] * inv);
                }
            }
        }
        __syncthreads();
#pragma unroll 1
        for (int k = 0; k < 2; ++k) { int lane2 = lane; asm volatile("" : "+v"(lane2)); gather_token(p, t0 + 2 * wv + k, sel_idx + (2 * wv + k) * 128, sel_g + (2 * wv + k) * 128, lane2); }
    }
}

__device__ __forceinline__ void map_tile(int L, int nM, int nN, int& pm, int& pn) {
    const int nwg = nM * nN; int wgid = L;
    { const int q = nwg / 8, r = nwg % 8, xcd = wgid % 8, off = wgid / 8; wgid = (xcd < r ? xcd * (q + 1) : r * (q + 1) + (xcd - r) * q) + off; }
    const int nig = 8 * nN, gid = wgid / nig, fm = gid * 8, gsz = (nM - fm) < 8 ? (nM - fm) : 8;
    pm = fm + ((wgid % nig) % gsz); pn = (wgid % nig) / gsz;
}
struct ProjOrder {
    int G, c; const bf16_t* ub; const bf16_t* wint;
    __device__ bool next(int i, pg8::Unit& u) const {
        const int L = i * G + c; if (L >= 800) return false;
        if (L < 384) { u.kind = 0; map_tile(L, 12, 32, u.pm, u.pn); }
        else if (L < 512) { u.kind = 1; map_tile(L - 384, 4, 32, u.pm, u.pn); }
        else if (L < 768) { u.kind = 2; map_tile(L - 512, 32, 8, u.pm, u.pn); }
        else if (L < 784) { u.kind = 3; u.pm = (L - 768) >> 2; u.pn = (L - 768) & 3; }
        else { u.kind = 4; u.pm = (L - 784) >> 2; u.pn = (L - 784) & 3; }
        return true;
    }
    __device__ __forceinline__ void a_ready(const pg8::Unit&) const {}
    __device__ __forceinline__ void done(const pg8::Unit&) const {}
    template <class G_> __device__ __forceinline__ const char* pa(const G_&, const pg8::Unit& u) const {
        const size_t ts = (size_t)256 * D * 2;
        switch (u.kind) { case 0: return (const char*)wint + (size_t)u.pm * ts; case 1: return (const char*)wint + (size_t)(20 + u.pm) * ts; case 2: return (const char*)ub + (size_t)u.pm * ts;
                          case 3: return (const char*)ub + (size_t)(32 + u.pm) * ts; default: return (const char*)wint + (size_t)(20 + u.pm) * ts; }
    }
    template <class G_> __device__ __forceinline__ const char* pb(const G_&, const pg8::Unit& u) const {
        const size_t ts = (size_t)256 * D * 2;
        switch (u.kind) { case 0: case 1: return (const char*)ub + (size_t)u.pn * ts; case 2: return (const char*)wint + (size_t)(12 + u.pn) * ts;
                          case 3: return (const char*)wint + (size_t)(16 + u.pn) * ts; default: return (const char*)ub + (size_t)(32 + u.pn) * ts; }
    }
};
struct EpiProj {
    static constexpr bool PERM = true, AFTER_DRAIN = false;
    unsigned char* ws;
    __device__ __forceinline__ void operator()(const pg8::f32x4 (&acc)[2][2][4][2], const pg8::Unit& u, int wr, int wc, int fr, int fq) const {
        bf16_t* const zT = (bf16_t*)(ws + B_ZT); bf16_t* const vT = (bf16_t*)(ws + B_VT); bf16_t* const qh = (bf16_t*)(ws + B_QH); bf16_t* const kh = (bf16_t*)(ws + B_KH);
        bf16_t* const kch = (bf16_t*)(ws + B_KCH); bf16_t* const vcT = (bf16_t*)(ws + B_VCT);
#pragma unroll
        for (int ai = 0; ai < 2; ++ai)
#pragma unroll
            for (int m = 0; m < 4; ++m) {
                const int r = u.pm * 256 + ai * 128 + wr * 64 + m * 16 + fr;
#pragma unroll
                for (int bj = 0; bj < 2; ++bj) {
                    const int cc = u.pn * 256 + bj * 128 + wc * 32 + 8 * fq;
                    bf16_t* dst;
                    if (u.kind == 0) dst = zT + (size_t)r * NT + cc;
                    else if (u.kind == 1) {
                        const int bb = cc >> 11, t = cc & 2047, hh = r >> 6, dd = r & 63;
                        dst = vT + (size_t)((bb * 16 + hh) * 256 + (t >> 3)) * 512 + (dd >> 4) * 128 + (dd & 15) * 8;
                    } else if (u.kind == 2) {
                        const int bb = r >> 11, t = r & 2047, hc = cc & 1023, hh = hc >> 6, dd = hc & 63;
                        if (cc < 1024) dst = qh + ((size_t)((bb * 16 + hh) * SL + t)) * 64 + dd;
                        else dst = kh + (size_t)((bb * 16 + hh) * 256 + (t >> 3)) * 512 + (dd >> 5) * 256 + ((t & 7) >> 2) * 128 + ((dd & 31) >> 3) * 32 + (t & 3) * 8;
                    } else if (u.kind == 3) {
                        const int bb = r >> 8, jj = r & 255, hh = cc >> 6, dd = cc & 63;
                        dst = kch + (size_t)((bb * 16 + hh) * 32 + (jj >> 3)) * 512 + (dd >> 5) * 256 + ((jj & 7) >> 2) * 128 + ((dd & 31) >> 3) * 32 + (jj & 3) * 8;
                    } else {
                        const int bb = cc >> 8, jj = cc & 255, hh = r >> 6, dd = r & 63;
                        dst = vcT + (size_t)((bb * 16 + hh) * 32 + (jj >> 3)) * 512 + (dd >> 4) * 128 + (dd & 15) * 8;
                    }
                    const pg8::f32x4 v0 = acc[ai][bj][m][0], v1 = acc[ai][bj][m][1];
                    pg8::u32x4 w; w.x = pg8::cvt_pk_bf16(v0[0], v0[1]); w.y = pg8::cvt_pk_bf16(v0[2], v0[3]); w.z = pg8::cvt_pk_bf16(v1[0], v1[1]); w.w = pg8::cvt_pk_bf16(v1[2], v1[3]);
                    *(pg8::u32x4*)dst = w;
                }
            }
    }
};

struct EpiQFrag {
    static constexpr bool PERM = true, AFTER_DRAIN = false;
    bf16_t* O;
    __device__ __forceinline__ void operator()(const pg8::f32x4 (&acc)[2][2][4][2], const pg8::Unit& u, int wr, int wc, int fr, int fq) const {
#pragma unroll
        for (int ai = 0; ai < 2; ++ai)
#pragma unroll
            for (int m = 0; m < 4; ++m) {
                const int t = u.pm * 256 + ai * 128 + wr * 64 + m * 16 + fr;
#pragma unroll
                for (int bj = 0; bj < 2; ++bj) {
                    const int c = u.pn * 256 + bj * 128 + wc * 32 + 8 * fq;
                    const int hh = c >> 8, pp = (c >> 7) & 1, d = c & 127;
                    bf16_t* dst = O + ((size_t)(((((t >> 4) * 8 + hh) * 2 + pp) * 4 + (d >> 5)) * 64 + ((d & 31) >> 3) * 16 + (t & 15))) * 8;
                    const pg8::f32x4 v0 = acc[ai][bj][m][0], v1 = acc[ai][bj][m][1];
                    pg8::u32x4 w; w.x = pg8::cvt_pk_bf16(v0[0], v0[1]); w.y = pg8::cvt_pk_bf16(v0[2], v0[3]); w.z = pg8::cvt_pk_bf16(v1[0], v1[1]); w.w = pg8::cvt_pk_bf16(v1[2], v1[3]);
                    __builtin_nontemporal_store(w, (pg8::u32x4*)dst);
                }
            }
    }
};

#define XB_TMO      128
#define XB_XCNT(j)  (256  + 64 * (j))
#define XB_XSUB(j)  (1280 + 64 * (j))
#define XB_XGEN(j)  (2304 + 64 * (j))
#define XB_TOP      3328
#define XB_TOPGEN   3392
#define XCD_BAR_WORDS 3456
#define XB_SPIN_CAP (1u << 18)
#define LAS __attribute__((address_space(3)))

__device__ __forceinline__ unsigned xb_ld(unsigned* p)              { return __hip_atomic_load(p, __ATOMIC_RELAXED, __HIP_MEMORY_SCOPE_AGENT); }
__device__ __forceinline__ unsigned xb_add(unsigned* p, unsigned v) { return __hip_atomic_fetch_add(p, v, __ATOMIC_RELAXED, __HIP_MEMORY_SCOPE_AGENT); }
__device__ __forceinline__ unsigned xb_xcc_id() { return (unsigned)__builtin_amdgcn_s_getreg((3 << 11) | 20) & 0xFu; }
#define XB_SPIN(cond, bar) do { unsigned _sp = 0; while (cond) { __builtin_amdgcn_s_sleep(1); \
    if ((++_sp & 255u) == 0u) { if (xb_ld(&(bar)[XB_TMO])) break; if (_sp > XB_SPIN_CAP) { atomicAdd(&(bar)[XB_TMO], 1u); break; } } } } while (0)

struct XcdBarrier {
    unsigned* bar; unsigned x;
    volatile LAS unsigned* st;
};

__device__ __forceinline__ XcdBarrier xcd_barrier_post(unsigned* bar, volatile LAS unsigned* st) {
    XcdBarrier b; b.bar = bar; b.x = xb_xcc_id(); b.st = st;
    if (threadIdx.x == 0) (void)xb_add(&bar[XB_XCNT(b.x)], 1u);
    return b;
}
__device__ __forceinline__ void xcd_barrier_complete(unsigned* bar, unsigned x, unsigned& nloc, unsigned& nx) {
    const unsigned G = gridDim.x * gridDim.y * gridDim.z;
    unsigned sum, cnt, mine, sp = 0u;
    for (;;) {
        sum = 0u; cnt = 0u; mine = 0u;
#pragma unroll
        for (unsigned j = 0; j < 16; ++j) { const unsigned c = xb_ld(&bar[XB_XCNT(j)]); sum += c; cnt += (c > 0u) ? 1u : 0u; mine = (j == x) ? c : mine; }
        if (sum == G) break;
        __builtin_amdgcn_s_sleep(1);
        if ((++sp & 255u) == 0u) { if (xb_ld(&bar[XB_TMO])) break; if (sp > XB_SPIN_CAP) { atomicAdd(&bar[XB_TMO], 1u); break; } }
    }
    nloc = mine > 0u ? mine : 1u; nx = cnt > 0u ? cnt : 1u;
}

__device__ __forceinline__ void xcd_barrier(const XcdBarrier& b) {
    asm volatile("s_waitcnt vmcnt(0)" ::: "memory");
    __syncthreads();
    if (threadIdx.x == 0) {
        unsigned* bar = b.bar;
        __builtin_amdgcn_s_waitcnt(0);
        unsigned nloc = b.st[0], nx = b.st[1]; const unsigned k = b.st[2];
        if (nloc == 0u) { xcd_barrier_complete(bar, b.x, nloc, nx); b.st[0] = nloc; b.st[1] = nx; }
        b.st[2] = k + 1u;
        const unsigned old = xb_add(&bar[XB_XSUB(b.x)], 1u);
        if (old + 1u == (k + 1u) * nloc) {
            __builtin_amdgcn_fence(__ATOMIC_RELEASE, "agent");
            asm volatile("s_waitcnt vmcnt(0)" ::: "memory");
            (void)xb_add(&bar[XB_TOP], 1u);
        }
        asm volatile("buffer_inv sc1" ::: "memory");
        XB_SPIN(xb_ld(&bar[XB_TOP]) < (k + 1u) * nx, bar);
        asm volatile("s_waitcnt vmcnt(0)" ::: "memory");
    }
    __syncthreads();
}
constexpr size_t B_BAR = 14 * MiB;

__global__ void __launch_bounds__(NTHREADS) fwd_megakernel(Params p) {
    extern __shared__ __attribute__((aligned(16))) unsigned char smem[];
    float* lds = (float*)smem; float* red = (float*)(smem + RED_OFF);
    PG8_LAS unsigned char* glds = (PG8_LAS unsigned char*)smem;
    volatile LAS unsigned* xst = (volatile LAS unsigned*)(smem + LDS_BYTES - 16);
    if (threadIdx.x < 4) xst[threadIdx.x] = 0u;
    __syncthreads();
    XcdBarrier xb = xcd_barrier_post((unsigned*)((char*)p.ws + B_BAR), xst);
    bf16_t* wint = (bf16_t*)((char*)p.ws + B_WINT); bf16_t* woutt = (bf16_t*)((char*)p.ws + B_WOUTT); bf16_t* wqt = (bf16_t*)((char*)p.ws + B_WQT);
    bf16_t* ub = (bf16_t*)((char*)p.ws + B_UB);
    phase_a(p, lds);
    transpose_convert(p.in[I_WIN], wint, D, DPROJ, lds, 0, (int)gridDim.x);
    phase_filters(p, lds);
    {
        const float* ks = p.in[I_KEYS]; bf16_t* kd = (bf16_t*)((char*)p.ws + B_KEYSB);
        for (int e = blockIdx.x * NTHREADS + threadIdx.x; e < 16 * 128 * 128 / 4; e += gridDim.x * NTHREADS) {
            const float4 v = *(const float4*)(ks + e * 4); uint2 o; o.x = pk_bf16(v.x, v.y); o.y = pk_bf16(v.z, v.w);
            const int d = (e * 4) & 127, n = ((e * 4) >> 7) & 127, hp = (e * 4) >> 14;
            *(uint2*)(kd + ((size_t)(((hp * 8 + (n >> 4)) * 4 + (d >> 5)) * 64 + ((d & 31) >> 3) * 16 + (n & 15))) * 8 + (d & 7)) = o;
        }
    }
    xcd_barrier(xb);
    phase_b(p);
    xcd_barrier(xb);
    phase_c(p);
    xcd_barrier(xb);
    {
        pg8::Gemm g{ub, wint, NT + NTC, DPROJ, D}; ProjOrder S{(int)gridDim.x, (int)blockIdx.x, ub, wint};
        EpiProj E{(unsigned char*)p.ws};
        pg8::gemm_phase<EpiProj, ProjOrder>(glds, g, S, E, nullptr);
    }
    if (gridDim.x == 256 && blockIdx.x >= 32) {
        quant_tables(p, 32, 224);
        transpose_convert(p.in[I_WOUT], woutt, D, D, lds, 32, 224);
        transpose_convert(p.in[I_WQ], wqt, D, D, lds, 32, 224);
    } else if (gridDim.x != 256) {
        quant_tables(p, 0, (int)gridDim.x);
        transpose_convert(p.in[I_WOUT], woutt, D, D, lds, 0, (int)gridDim.x);
        transpose_convert(p.in[I_WQ], wqt, D, D, lds, 0, (int)gridDim.x);
    }
    xcd_barrier(xb);
    phase_hyena(p, smem);
    phase_na(p, smem);
    xcd_barrier(xb);
    phase_f(p, lds);
    xcd_barrier(xb);
    {
        pg8::Gemm g{ub, woutt, NT, D, D}; pg8::StaticOrder S; S.init(NT, D, (int)gridDim.x, (int)blockIdx.x);
        pg8::EpiBf16<0> E{(bf16_t*)((char*)p.ws + B_Y), D, nullptr, 0, 0};
        pg8::gemm_phase<pg8::EpiBf16<0>, pg8::StaticOrder>(glds, g, S, E, nullptr);
    }
    xcd_barrier(xb);
    phase_h(p);
    xcd_barrier(xb);
    {
        pg8::Gemm g{ub, wqt, NT, D, D}; pg8::StaticOrder S; S.init(NT, D, (int)gridDim.x, (int)blockIdx.x);
        EpiQFrag E{(bf16_t*)((char*)p.ws + B_QB)};
        pg8::gemm_phase<EpiQFrag, pg8::StaticOrder>(glds, g, S, E, nullptr);
    }
    xcd_barrier(xb);
    phase_jk(p, smem);
}

extern "C" void kernel_launch(void* const* d_in, const int* in_sizes, int n_in, void* d_out, int out_size, void* d_ws, size_t ws_size, hipStream_t stream) {
    static int grid_blocks = 0;
    if (grid_blocks == 0) {
        if (n_in != N_IN || out_size != NT * D || ws_size < W_END * sizeof(float)) {
            fprintf(stderr, "kernel_launch: unexpected shapes: n_in %d out %d ws %zu (need %zu)\n", n_in, out_size, ws_size, (size_t)W_END * 4); grid_blocks = -1; return; }
        int dev = 0, cus = 0, per_cu = 0;
        hipGetDevice(&dev);
        hipDeviceGetAttribute(&cus, hipDeviceAttributeMultiprocessorCount, dev);
        if (hipFuncSetAttribute((const void*)fwd_megakernel, hipFuncAttributeMaxDynamicSharedMemorySize, LDS_BYTES) != hipSuccess) { fprintf(stderr, "kernel_launch: hipFuncSetAttribute failed\n"); grid_blocks = -1; return; }
        if (hipOccupancyMaxActiveBlocksPerMultiprocessor(&per_cu, (const void*)fwd_megakernel, NTHREADS, LDS_BYTES) != hipSuccess || per_cu < 1) { fprintf(stderr, "kernel_launch: occupancy query failed (%d)\n", per_cu); (void)hipGetLastError(); grid_blocks = -1; return; }
        grid_blocks = cus * (per_cu > 1 ? 1 : per_cu);
        fprintf(stderr, "kernel_launch: cus %d per_cu %d grid %d\n", cus, per_cu, grid_blocks);
    }
    if (grid_blocks < 0) return;
    Params p{};
    for (int i = 0; i < N_IN; ++i) p.in[i] = (const float*)d_in[i];
    p.out = (float*)d_out; p.ws = (float*)d_ws;
    if (hipMemsetAsync((char*)d_ws + B_BAR, 0, XCD_BAR_WORDS * sizeof(unsigned), stream) != hipSuccess) { fprintf(stderr, "kernel_launch: memset failed\n"); return; }
    void* args[] = {&p};
    hipLaunchKernelGGL(fwd_megakernel, dim3(grid_blocks), dim3(NTHREADS), LDS_BYTES, stream, p);
    const hipError_t e = hipPeekAtLastError();
    if (e != hipSuccess) fprintf(stderr, "launch failed: %s (grid %d)\n", hipGetErrorString(e), grid_blocks);
}
```

```cpp
#include <hip/hip_runtime.h>
#include <hip/hip_cooperative_groups.h>
#include <cstdio>
namespace cg = cooperative_groups;

constexpr int D = 2048, NB = 4, SL = 2048, NT = NB * SL, CL = 256, NTC = NB * CL;
constexpr int DHY = 1024, DNA = 1024, DPROJ = 6144, OFFQ = 3072, OFFK = 4096, OFFV = 5120;
constexpr int NTHREADS = 512, NWAVES = 8;
constexpr float LN_EPS = 1e-5f;
constexpr float ALPHA = 1.189207115002721f;

enum { I_X = 0, I_C, I_CTX, I_CCTX, I_WADA, I_BADA, I_WIN, I_CONVW, I_CONVB, I_FW1, I_FB1, I_FW2, I_FB2, I_FW3, I_FB3, I_FW4,
       I_FREQ, I_SKIP, I_RPB, I_GHY, I_GNA, I_WOUT, I_LN1G, I_LN1B, I_WQ, I_KEYS, I_PU, I_PV, I_LN2G, I_LN2B, N_IN };

constexpr size_t W_ADAP = 0;
constexpr size_t W_ADA  = W_ADAP + 32 * 5 * 12288;
constexpr size_t W_FS   = W_ADA + 5 * 12288;
constexpr size_t W_SP   = W_FS + 4096;
constexpr size_t W_SU   = W_SP + 32 * 4096;
constexpr size_t W_SV   = W_SU + 16384;
constexpr size_t W_SU2  = W_SV + 16384;
static_assert((W_SU2 + 8192) * 4 <= 14 * 1048576, "small region overflow");
constexpr size_t MiB = 1048576;
constexpr size_t B_WINT  = 16 * MiB;
constexpr size_t B_WOUTT = B_WINT + 24 * MiB;
constexpr size_t B_WQT   = B_WOUTT + 8 * MiB;
constexpr size_t B_UB    = B_WQT + 8 * MiB;
constexpr size_t B_ZT    = B_UB + 36 * MiB;
constexpr size_t B_VT    = B_ZT + 48 * MiB;
constexpr size_t B_QH    = B_VT + 16 * MiB;
constexpr size_t B_KH    = B_QH + 16 * MiB;
constexpr size_t B_KCH   = B_KH + 16 * MiB;
constexpr size_t B_VCT   = B_KCH + 2 * MiB;
constexpr size_t B_KF    = B_VCT + 2 * MiB;
constexpr size_t B_HRAW  = B_KF + 32 * MiB;
constexpr size_t B_HYT   = B_HRAW;
constexpr size_t B_NA    = B_HRAW + 16 * MiB;
constexpr size_t B_Y     = B_HRAW + 32 * MiB;
constexpr size_t B_X1    = B_Y + 64 * MiB;
constexpr size_t B_U2Q   = B_X1 + 64 * MiB;
constexpr size_t B_TQ    = B_U2Q + 16 * MiB;
constexpr size_t B_END   = B_TQ + 64 * MiB;
constexpr size_t W_KF = B_KF / 4, W_X1 = B_X1 / 4, W_HRAW = B_HRAW / 4, W_Y = B_Y / 4, W_END = B_END / 4;
static_assert(B_END <= 512 * MiB, "workspace");

constexpr int LDS_BYTES = 156 * 1024;
constexpr int RED_OFF = 155 * 1024;

struct Params { const float* in[N_IN]; float* out; float* ws; };

namespace pg8 {
#define PG8_LAS __attribute__((address_space(3)))
typedef unsigned short bf16_t;
typedef short bf16x8 __attribute__((ext_vector_type(8)));
typedef float f32x4 __attribute__((ext_vector_type(4)));
typedef unsigned u32x4 __attribute__((ext_vector_type(4)));
constexpr int BM = 256, BK = 64, HALF = 128, HTB = HALF * BK * 2  , STAGE_BYTES = 8 * HTB, NXCD = 8, WGM = 8;

__host__ __device__ __forceinline__ int lds_byte(int r, int c) { const int st = (r >> 4) * 2 + (c >> 5), rr = r & 15, cc = c & 31, ob = rr * 64 + cc * 2; return st * 1024 + (ob ^ (((ob >> 9) & 1) << 5)); }
__host__ __device__ __forceinline__ void stage_rc(int b, int& R, int& C) { const int st = b / 1024, sb = b % 1024, swz = sb ^ (((sb >> 9) & 1) << 5); R = (st >> 1) * 16 + swz / 64; C = (st & 1) * 32 + (swz % 64) / 2; }
__host__ __device__ __forceinline__ int perm32(int rho) { const int n = rho >> 4, i = rho & 15; return 8 * (i >> 2) + 4 * n + (i & 3); }

struct Unit { int pm, pn, kind; };
struct Gemm { const bf16_t* A; const bf16_t* Bt; int M, N, K; };

struct StaticOrder {
    int nM, nN, nwg, G, c;
    __host__ __device__ void init(int M, int N, int G_, int c_) { nM = M / BM; nN = N / BM; nwg = nM * nN; G = G_; c = c_; }
    __host__ __device__ bool next(int i, Unit& u) const {
        const long L = (long)i * G + c; if (L >= nwg) return false;
        int wgid = (int)L; { const int q = nwg / NXCD, r = nwg % NXCD, xcd = wgid % NXCD, off = wgid / NXCD; wgid = (xcd < r ? xcd * (q + 1) : r * (q + 1) + (xcd - r) * q) + off; }
        const int nig = WGM * nN, gid = wgid / nig, fm = gid * WGM, gsz = (nM - fm) < WGM ? (nM - fm) : WGM;
        u.pm = fm + ((wgid % nig) % gsz); u.pn = (wgid % nig) / gsz; return true;
    }
    __device__ __forceinline__ void a_ready(const Unit&) const {}
    __device__ __forceinline__ void done(const Unit&) const {}
    template <class G_> __device__ __forceinline__ const char* pa(const G_& g, const Unit& u) const { return (const char*)g.A + (size_t)u.pm * (size_t)(BM * 2) * g.K; }
    template <class G_> __device__ __forceinline__ const char* pb(const G_& g, const Unit& u) const { return (const char*)g.Bt + (size_t)u.pn * (size_t)(BM * 2) * g.K; }
};
__device__ __forceinline__ unsigned cvt_pk_bf16(float lo, float hi) { unsigned r; asm volatile("v_cvt_pk_bf16_f32 %0, %1, %2" : "=v"(r) : "v"(lo), "v"(hi)); return r; }
typedef float f32x2 __attribute__((ext_vector_type(2)));
__device__ __forceinline__ f32x2 gelu_pk(f32x2 v) {
    const f32x2 av = __builtin_elementwise_abs(v), d = av * 0.2316418882f + 1.0f;
    f32x2 t; t.x = __builtin_amdgcn_rcpf(d.x); t.y = __builtin_amdgcn_rcpf(d.y);
    f32x2 q = t * 0.5307027145f + (-0.7265760135f); q = q * t + 0.7107068705f; q = q * t + (-0.142248368f); q = q * t + 0.127414796f; q = q * t;
    const f32x2 s = (v * v) * (-0.72134752044f);
    f32x2 e; e.x = __builtin_amdgcn_exp2f(s.x); e.y = __builtin_amdgcn_exp2f(s.y);
    const f32x2 m = v * (q * e), r = v - m;
    f32x2 o; o.x = v.x < 0.f ? m.x : r.x; o.y = v.y < 0.f ? m.y : r.y; return o;
}

struct EpiF32 {
    static constexpr bool PERM = false, AFTER_DRAIN = false;
    float* C; int ldc; const float* bias;
    __device__ __forceinline__ void operator()(const f32x4 (&acc)[2][2][4][2], const Unit& u, int wr, int wc, int fr, int fq) const {
        const int row0 = u.pm * BM + wr * 64 + fr, col0 = u.pn * BM + wc * 32 + 4 * fq;
        f32x4 bv[2][2];
#pragma unroll
        for (int bj = 0; bj < 2; ++bj)
#pragma unroll
            for (int n = 0; n < 2; ++n) bv[bj][n] = bias ? *(const f32x4*)(bias + col0 + bj * HALF + n * 16) : (f32x4){0.f, 0.f, 0.f, 0.f};
#pragma unroll
        for (int ai = 0; ai < 2; ++ai)
#pragma unroll
            for (int m = 0; m < 4; ++m) { float* rowp = C + (size_t)(row0 + ai * HALF + m * 16) * ldc + col0;
#pragma unroll
                for (int bj = 0; bj < 2; ++bj)
#pragma unroll
                    for (int n = 0; n < 2; ++n) *(f32x4*)(rowp + bj * HALF + n * 16) = acc[ai][bj][m][n] + bv[bj][n]; }
    }
};
template <int ACT  > struct EpiBf16 {
    static constexpr bool PERM = true, AFTER_DRAIN = false;
    bf16_t* O; int ldc; const float* bias; int split_cols; size_t split_stride;
    __device__ __forceinline__ void operator()(const f32x4 (&acc)[2][2][4][2], const Unit& u, int wr, int wc, int fr, int fq) const {
        const int row0 = u.pm * BM + wr * 64 + fr; int colt = u.pn * BM; bf16_t* base = O;
        if (split_cols) { const int t = colt / split_cols; base += (size_t)t * split_stride; colt -= t * split_cols; }
        const int col0 = colt + wc * 32 + 8 * fq, bcol0 = u.pn * BM + wc * 32 + 8 * fq;
        f32x4 bv[2][2];
#pragma unroll
        for (int bj = 0; bj < 2; ++bj)
#pragma unroll
            for (int n = 0; n < 2; ++n) bv[bj][n] = bias ? *(const f32x4*)(bias + bcol0 + bj * HALF + 4 * n) : (f32x4){0.f, 0.f, 0.f, 0.f};
#pragma unroll
        for (int ai = 0; ai < 2; ++ai)
#pragma unroll
            for (int m = 0; m < 4; ++m) { bf16_t* rowp = base + (size_t)(row0 + ai * HALF + m * 16) * ldc + col0;
#pragma unroll
                for (int bj = 0; bj < 2; ++bj) { f32x4 v0 = acc[ai][bj][m][0] + bv[bj][0], v1 = acc[ai][bj][m][1] + bv[bj][1];
                    if (ACT == 1) { f32x2 a = gelu_pk((f32x2){v0[0], v0[1]}), b = gelu_pk((f32x2){v0[2], v0[3]}), c = gelu_pk((f32x2){v1[0], v1[1]}), d = gelu_pk((f32x2){v1[2], v1[3]});
                        v0 = (f32x4){a.x, a.y, b.x, b.y}; v1 = (f32x4){c.x, c.y, d.x, d.y}; }
                    if (ACT == 2) {
#pragma unroll
                        for (int j = 0; j < 4; ++j) { v0[j] = 0.5f * v0[j] * (1.0f + erff(v0[j] * 0.70710678f)); v1[j] = 0.5f * v1[j] * (1.0f + erff(v1[j] * 0.70710678f)); } }
                    u32x4 w; w.x = cvt_pk_bf16(v0[0], v0[1]); w.y = cvt_pk_bf16(v0[2], v0[3]); w.z = cvt_pk_bf16(v1[0], v1[1]); w.w = cvt_pk_bf16(v1[2], v1[3]);
                    *(u32x4*)(rowp + bj * HALF) = w; } }
    }
};
template <class Epi, class Sched, bool STAMP = false>
__device__ __forceinline__ void gemm_phase(PG8_LAS unsigned char* lds, const Gemm g, const Sched& S, const Epi& E, unsigned long long* stamps) {
    const int tid = threadIdx.x, wid = __builtin_amdgcn_readfirstlane(tid >> 6), lane = tid & 63, wr = wid >> 2, wc = wid & 3, fr = lane & 15, fq = lane >> 4;
    const int K = g.K, nt = K / BK;
    int ts_lo = 0, ts_hi = 0, nts = 0; const unsigned long long rt_entry = STAMP ? (unsigned long long)wall_clock64() : 0ull;
#define PG8_STAMP() do { if (STAMP && wid == 0 && nts < 64) { const unsigned long long _c = (unsigned long long)clock64(); \
        ts_lo = (lane == nts) ? (int)(unsigned)_c : ts_lo; ts_hi = (lane == nts) ? (int)(unsigned)(_c >> 32) : ts_hi; ++nts; } } while (0)
    PG8_STAMP();
    unsigned voffA[2], voffB[2];
#pragma unroll
    for (int i = 0; i < 2; ++i) { int R, C; stage_rc(tid * 16 + i * 8192, R, C); const int Rb = Epi::PERM ? ((R & ~31) + perm32(R & 31)) : R;
        voffA[i] = (unsigned)(R * K + C) * 2u; voffB[i] = (unsigned)(Rb * K + C) * 2u; }
    const size_t kstep = (size_t)(BK * 2);
    const size_t hstep = (size_t)HALF * K * 2;
    const size_t tstep = 2 * hstep;
    const unsigned ldsw = (unsigned)wid * 1024u;
    const int aoff = lds_byte(wr * 64 + fr, fq * 8), boff = lds_byte(wc * 32 + fr, fq * 8);
#define PG8_SA(b, h) (((b) * 2 + (h)) * HTB)
#define PG8_SB(b, h) ((4 + (b) * 2 + (h)) * HTB)
#define PG8_STAGE(bufoff, gbase, voff) do { _Pragma("unroll") for (int _i = 0; _i < 2; ++_i) \
        __builtin_amdgcn_global_load_lds((const unsigned*)((const char*)(gbase) + (voff)[_i]), (PG8_LAS unsigned*)(lds + (bufoff) + ldsw + _i * 8192), 16, 0, 0); } while (0)
#define PG8_LDA(dst, b, h) do { _Pragma("unroll") for (int m = 0; m < 4; ++m) _Pragma("unroll") for (int k = 0; k < 2; ++k) dst[m][k] = *(const PG8_LAS bf16x8*)(lds + PG8_SA(b, h) + aoff + m * 2048 + k * 1024); } while (0)
#define PG8_LDB(dst, b, h) do { _Pragma("unroll") for (int n = 0; n < 2; ++n) _Pragma("unroll") for (int k = 0; k < 2; ++k) dst[n][k] = *(const PG8_LAS bf16x8*)(lds + PG8_SB(b, h) + boff + n * 2048 + k * 1024); } while (0)
#define PG8_MMA(ai, bj, At, Bt) do { __builtin_amdgcn_s_setprio(1); _Pragma("unroll") for (int m = 0; m < 4; ++m) _Pragma("unroll") for (int n = 0; n < 2; ++n) _Pragma("unroll") for (int k = 0; k < 2; ++k) \
        acc[ai][bj][m][n] = __builtin_amdgcn_mfma_f32_16x16x32_bf16(Bt[n][k], At[m][k], acc[ai][bj][m][n], 0, 0, 0); __builtin_amdgcn_s_setprio(0); } while (0)
#define PG8_WAIT_V(n) asm volatile("s_waitcnt vmcnt(" #n ")" ::: "memory")
#define PG8_WAIT_L(n) asm volatile("s_waitcnt lgkmcnt(" #n ")" ::: "memory")
#define PG8_BAR __builtin_amdgcn_s_barrier()
#define PG8_SCHED __builtin_amdgcn_sched_barrier(0)
    Unit cur, nxt; int ui = 0;
    if (!S.next(0, cur)) return;
    f32x4 acc[2][2][4][2];
#pragma unroll
    for (int a = 0; a < 2; ++a)
#pragma unroll
        for (int b = 0; b < 2; ++b)
#pragma unroll
            for (int m = 0; m < 4; ++m)
#pragma unroll
                for (int n = 0; n < 2; ++n) acc[a][b][m][n] = (f32x4){0.f, 0.f, 0.f, 0.f};
    bf16x8 At[4][2], B0[2][2], B1[2][2];
    const char* cA = S.pa(g, cur); const char* cB = S.pb(g, cur);
    S.a_ready(cur);
    PG8_STAGE(PG8_SB(0, 0), cB, voffB); PG8_STAGE(PG8_SA(0, 0), cA, voffA); PG8_STAGE(PG8_SB(0, 1), cB + hstep, voffB); PG8_STAGE(PG8_SA(0, 1), cA + hstep, voffA);
    if (wr == 1) PG8_BAR;
    PG8_WAIT_V(4); PG8_BAR;
    PG8_STAGE(PG8_SB(1, 0), cB + kstep, voffB); PG8_STAGE(PG8_SA(1, 0), cA + kstep, voffA); PG8_STAGE(PG8_SB(1, 1), cB + hstep + kstep, voffB);
    PG8_WAIT_V(6); PG8_BAR;
    PG8_STAMP();
    for (;;) {
        const bool has_next = S.next(ui + 1, nxt);
        const char* nA = has_next ? S.pa(g, nxt) : cA; const char* nB = has_next ? S.pb(g, nxt) : cB;
        for (int t = 0; t < nt; t += 2) {
            const bool last = (t == nt - 2);
            const char* a1 = cA + (size_t)(t + 1) * kstep;
            const char* a2 = last ? nA : cA + (size_t)(t + 2) * kstep; const char* b2 = last ? nB : cB + (size_t)(t + 2) * kstep;
            const char* a3 = a2 + kstep; const char* b3 = b2 + kstep;
            if (last && has_next) S.a_ready(nxt);
            PG8_LDB(B0, 0, 0); PG8_SCHED; PG8_LDA(At, 0, 0); PG8_STAGE(PG8_SA(1, 1), a1 + hstep, voffA);
            PG8_WAIT_L(8); PG8_BAR; PG8_WAIT_L(0); PG8_MMA(0, 0, At, B0); PG8_BAR; PG8_SCHED;
            PG8_LDB(B1, 0, 1); PG8_STAGE(PG8_SB(0, 0), b2, voffB);
            PG8_BAR; PG8_WAIT_L(0); PG8_MMA(0, 1, At, B1); PG8_BAR;
            PG8_LDA(At, 0, 1); PG8_STAGE(PG8_SA(0, 0), a2, voffA);
            PG8_BAR; PG8_WAIT_L(0); PG8_MMA(1, 0, At, B0); PG8_BAR; PG8_SCHED;
            PG8_STAGE(PG8_SB(0, 1), b2 + hstep, voffB);
            PG8_WAIT_V(6); PG8_BAR; PG8_MMA(1, 1, At, B1); PG8_BAR;
            PG8_LDB(B0, 1, 0); PG8_SCHED; PG8_LDA(At, 1, 0); PG8_STAGE(PG8_SA(0, 1), a2 + hstep, voffA);
            PG8_WAIT_L(8); PG8_BAR; PG8_WAIT_L(0); PG8_MMA(0, 0, At, B0); PG8_BAR; PG8_SCHED;
            PG8_LDB(B1, 1, 1); PG8_STAGE(PG8_SB(1, 0), b3, voffB);
            PG8_BAR; PG8_WAIT_L(0); PG8_MMA(0, 1, At, B1); PG8_BAR;
            PG8_LDA(At, 1, 1); PG8_STAGE(PG8_SA(1, 0), a3, voffA);
            PG8_BAR; PG8_WAIT_L(0); PG8_MMA(1, 0, At, B0); PG8_BAR; PG8_SCHED;
            PG8_STAGE(PG8_SB(1, 1), b3 + hstep, voffB);
            PG8_WAIT_V(6); PG8_BAR; PG8_MMA(1, 1, At, B1); PG8_BAR;
        }
        PG8_STAMP();
        if constexpr (!Epi::AFTER_DRAIN) { E(acc, cur, wr, wc, fr, fq); S.done(cur); }
        PG8_STAMP();
        if (!has_next) break;
#pragma unroll
        for (int a = 0; a < 2; ++a)
#pragma unroll
            for (int b = 0; b < 2; ++b)
#pragma unroll
                for (int m = 0; m < 4; ++m)
#pragma unroll
                    for (int n = 0; n < 2; ++n) acc[a][b][m][n] = (f32x4){0.f, 0.f, 0.f, 0.f};
        cur = nxt; cA = nA; cB = nB; ++ui;
    }
    PG8_WAIT_V(0);
    if (wr == 0) PG8_BAR;
    PG8_BAR;
    if constexpr (Epi::AFTER_DRAIN) { E.fused(acc, cur, wr, wc, fr, fq, lds, wid, lane); S.done(cur); }
    PG8_STAMP();
    if (STAMP && wid == 0) { stamps[lane] = lane < nts ? (((unsigned long long)(unsigned)ts_hi << 32) | (unsigned)ts_lo) : 0ull;
        if (lane == 62) stamps[62] = rt_entry; if (lane == 63) stamps[63] = (unsigned long long)wall_clock64(); }
#undef PG8_STAMP
#undef PG8_SA
#undef PG8_SB
#undef PG8_STAGE
#undef PG8_LDA
#undef PG8_LDB
#undef PG8_MMA
#undef PG8_WAIT_V
#undef PG8_WAIT_L
#undef PG8_BAR
#undef PG8_SCHED
}
}

typedef unsigned short bf16_t;
__device__ __forceinline__ float wave_sum(float v) {
#pragma unroll
    for (int o = 32; o; o >>= 1) v += __shfl_xor(v, o);
    return v;
}
__device__ __forceinline__ float block_sum(float v, float* red) {
    v = wave_sum(v);
    __syncthreads();
    if ((threadIdx.x & 63) == 0) red[threadIdx.x >> 6] = v;
    __syncthreads();
    float s = 0.f;
#pragma unroll
    for (int i = 0; i < NWAVES; ++i) s += red[i];
    return s;
}
__device__ __forceinline__ int opaque_tid() { int t = threadIdx.x; asm volatile("" : "+v"(t)); return t; }
typedef float nt_f32x4 __attribute__((ext_vector_type(4)));
__device__ __forceinline__ float4 nt_load4(const float* p) { const nt_f32x4 v = __builtin_nontemporal_load((const nt_f32x4*)p); return make_float4(v[0], v[1], v[2], v[3]); }
typedef unsigned nt_u32x4 __attribute__((ext_vector_type(4)));
typedef unsigned nt_u32x2 __attribute__((ext_vector_type(2)));
__device__ __forceinline__ uint4 nt_load4u(const void* p) { const nt_u32x4 v = __builtin_nontemporal_load((const nt_u32x4*)p); return make_uint4(v[0], v[1], v[2], v[3]); }
__device__ __forceinline__ uint2 nt_load2u(const void* p) { const nt_u32x2 v = __builtin_nontemporal_load((const nt_u32x2*)p); return make_uint2(v[0], v[1]); }
__device__ __forceinline__ void nt_store4(float* p, float a, float b, float c, float d) { nt_f32x4 v = {a, b, c, d}; __builtin_nontemporal_store(v, (nt_f32x4*)p); }
__device__ __forceinline__ void nt_store4u(void* p, uint4 v) { nt_u32x4 w = {v.x, v.y, v.z, v.w}; __builtin_nontemporal_store(w, (nt_u32x4*)p); }
__device__ __forceinline__ void nt_store2u(void* p, uint2 v) { nt_u32x2 w = {v.x, v.y}; __builtin_nontemporal_store(w, (nt_u32x2*)p); }
__device__ __forceinline__ float silu(float x) { return x / (1.0f + expf(-x)); }


__device__ __forceinline__ unsigned pk_bf16(float lo, float hi) { unsigned r; asm volatile("v_cvt_pk_bf16_f32 %0, %1, %2" : "=v"(r) : "v"(lo), "v"(hi)); return r; }
__device__ __forceinline__ void transpose_convert(const float* __restrict__ W, bf16_t* __restrict__ Wt, int K, int N, float* lds, int wb0, int nwb) {
    const int tid = opaque_tid();
    const int tk = K / 64, tn = N / 256;
    for (int tile = (int)blockIdx.x - wb0; tile < tk * tn; tile += nwb) {
        const int k0 = (tile / tn) * 64, n0 = (tile % tn) * 256;
        __syncthreads();
        float4 v[8];
#pragma unroll
        for (int i = 0; i < 8; ++i) v[i] = nt_load4(W + (size_t)(k0 + (tid >> 6) + 8 * i) * N + n0 + (tid & 63) * 4);
#pragma unroll
        for (int i = 0; i < 8; ++i) { float* d = lds + ((tid >> 6) + 8 * i) * 257 + (tid & 63) * 4; d[0] = v[i].x; d[1] = v[i].y; d[2] = v[i].z; d[3] = v[i].w; }
        __syncthreads();
#pragma unroll
        for (int q = 0; q < 4; ++q) {
            const int c = q * NTHREADS + tid, n = c >> 3, k8 = (c & 7) * 8;
            uint4 o;
            o.x = pk_bf16(lds[(k8 + 0) * 257 + n], lds[(k8 + 1) * 257 + n]); o.y = pk_bf16(lds[(k8 + 2) * 257 + n], lds[(k8 + 3) * 257 + n]);
            o.z = pk_bf16(lds[(k8 + 4) * 257 + n], lds[(k8 + 5) * 257 + n]); o.w = pk_bf16(lds[(k8 + 6) * 257 + n], lds[(k8 + 7) * 257 + n]);
            *(uint4*)(Wt + (size_t)(n0 + n) * K + k0 + k8) = o;
        }
    }
}
__device__ __forceinline__ float wave_max(float v) {
#pragma unroll
    for (int o = 32; o; o >>= 1) v = fmaxf(v, __shfl_xor(v, o));
    return v;
}
__device__ __forceinline__ float block_max(float v, float* red) {
    v = wave_max(v);
    __syncthreads();
    if ((threadIdx.x & 63) == 0) red[threadIdx.x >> 6] = v;
    __syncthreads();
    float s = red[0];
#pragma unroll
    for (int i = 1; i < NWAVES; ++i) s = fmaxf(s, red[i]);
    return s;
}
__device__ __forceinline__ unsigned q4(float a, float b, float c, float d, float inv, int off) {
    const int x = __float2int_rn(a * inv) + off, y = __float2int_rn(b * inv) + off, z = __float2int_rn(c * inv) + off, w = __float2int_rn(d * inv) + off;
    return (unsigned)(x & 255) | ((unsigned)(y & 255) << 8) | ((unsigned)(z & 255) << 16) | ((unsigned)(w & 255) << 24);
}
constexpr int UROW = 1024;
template <int O> __device__ __forceinline__ unsigned nibh8(const float (&x)[16], float inv) {
    unsigned r = 0;
#pragma unroll
    for (int i = 0; i < 8; ++i) r |= (unsigned)min(max((int)floorf(x[O + i] * inv) + 8, 0), 15) << (4 * i);
    return r;
}
__device__ __forceinline__ void quant_tables(const Params& p, int wb0, int nwb) {
    const int tid = opaque_tid(), lane = tid & 63, wv = tid >> 6;
    unsigned char* tq = (unsigned char*)p.ws + B_TQ; float* rsc = p.ws + W_SU;
    const int nw = nwb * NWAVES;
    for (int row0 = ((int)blockIdx.x - wb0) * NWAVES + wv; row0 < 2 * 16384; row0 += 2 * nw) {
        float x[2][2][16]; float mx[2][2];
#pragma unroll
        for (int u = 0; u < 2; ++u) {
            const int row = min(row0 + u * nw, 2 * 16384 - 1);
            const float* src = (row < 16384 ? p.in[I_PU] : p.in[I_PV]) + (size_t)(row & 16383) * D + lane * 4;
#pragma unroll
            for (int h = 0; h < 2; ++h) {
                mx[u][h] = 0.f;
#pragma unroll
                for (int q = 0; q < 4; ++q) { const float4 v = nt_load4(src + (h * 4 + q) * 256); x[u][h][q * 4] = v.x; x[u][h][q * 4 + 1] = v.y; x[u][h][q * 4 + 2] = v.z; x[u][h][q * 4 + 3] = v.w;
                    mx[u][h] = fmaxf(mx[u][h], fmaxf(fmaxf(fabsf(v.x), fabsf(v.y)), fmaxf(fabsf(v.z), fabsf(v.w)))); }
            }
        }
#pragma unroll
        for (int u = 0; u < 2; ++u) {
            const int row = row0 + u * nw;
            if (row < 2 * 16384) {
                const float rmx = wave_max(fmaxf(mx[u][0], mx[u][1]));
                {
                    float ss = 0.f;
#pragma unroll
                    for (int h = 0; h < 2; ++h)
#pragma unroll
                        for (int i = 0; i < 16; ++i) ss += x[u][h][i] * x[u][h][i];
                    const float rms = sqrtf(wave_sum(ss) * (1.0f / 2048.0f));
                    const float clipv = fminf(rmx, 2.5125f * rms);
                    const float Ru = clipv > 0.f ? clipv * (1.0f / 7.5f) : 1.0f, iu = 1.0f / Ru;
                    nt_store4u(tq + (size_t)row * UROW + lane * 16, make_uint4(nibh8<0>(x[u][0], iu), nibh8<8>(x[u][0], iu), nibh8<0>(x[u][1], iu), nibh8<8>(x[u][1], iu)));
                    if (lane == 0) rsc[row] = Ru;
                }
            }
        }
    }
}

__device__ __forceinline__ void naive_gemm(const float* __restrict__ A, int lda, const float* __restrict__ Bm, int ldb,
                                           float* __restrict__ C, int ldc, int M, int N, int K, float* lds) {
    float* As = lds;
    float* Bs = lds + 16 * 132;
    const int tid = opaque_tid(), tx = tid & 31, ty = tid >> 5;
    const int tilesN = N / 128, ntiles = (M / 128) * tilesN;
    for (int tile = blockIdx.x; tile < ntiles; tile += gridDim.x) {
        const int m0 = (tile / tilesN) * 128, n0 = (tile % tilesN) * 128;
        float acc[8][4];
#pragma unroll
        for (int i = 0; i < 8; ++i)
#pragma unroll
            for (int j = 0; j < 4; ++j) acc[i][j] = 0.f;
        for (int k0 = 0; k0 < K; k0 += 16) {
            {
                const int row = tid >> 2, kq = (tid & 3) * 4;
                const float4 a = *(const float4*)(A + (size_t)(m0 + row) * lda + k0 + kq);
                As[(kq + 0) * 132 + row] = a.x; As[(kq + 1) * 132 + row] = a.y; As[(kq + 2) * 132 + row] = a.z; As[(kq + 3) * 132 + row] = a.w;
                const int kk = tid >> 5, n4 = (tid & 31) * 4;
                *(float4*)(Bs + kk * 128 + n4) = *(const float4*)(Bm + (size_t)(k0 + kk) * ldb + n0 + n4);
            }
            __syncthreads();
#pragma unroll 4
            for (int k = 0; k < 16; ++k) {
                const float4 a0 = *(const float4*)(As + k * 132 + ty * 8), a1 = *(const float4*)(As + k * 132 + ty * 8 + 4);
                const float4 b = *(const float4*)(Bs + k * 128 + tx * 4);
                const float av[8] = {a0.x, a0.y, a0.z, a0.w, a1.x, a1.y, a1.z, a1.w};
                const float bv[4] = {b.x, b.y, b.z, b.w};
#pragma unroll
                for (int i = 0; i < 8; ++i)
#pragma unroll
                    for (int j = 0; j < 4; ++j) acc[i][j] += av[i] * bv[j];
            }
            __syncthreads();
        }
#pragma unroll
        for (int i = 0; i < 8; ++i)
            *(float4*)(C + (size_t)(m0 + ty * 8 + i) * ldc + n0 + tx * 4) = make_float4(acc[i][0], acc[i][1], acc[i][2], acc[i][3]);
    }
}

__device__ __forceinline__ void phase_a(const Params& p, float* lds) {
    const int tid = opaque_tid();
    const float* c = p.in[I_C]; const float* cctx = p.in[I_CCTX]; const float* wada = p.in[I_WADA];
    float* part = p.ws + W_ADAP;
    for (int item = blockIdx.x; item < 32 * 24; item += gridDim.x) {
        const int ks = item / 24, j = (item % 24) * 512 + tid;
        __syncthreads();
        if (tid < 5 * 64) { const int n = tid >> 6, k = ks * 64 + (tid & 63); lds[tid] = silu(n < 4 ? c[n * 2048 + k] : cctx[k]); }
        __syncthreads();
        float a0 = 0.f, a1 = 0.f, a2 = 0.f, a3 = 0.f, a4 = 0.f;
#pragma unroll 32
        for (int kk = 0; kk < 64; ++kk) {
            const float w = __builtin_nontemporal_load(wada + (size_t)(ks * 64 + kk) * 12288 + j);
            a0 += lds[kk] * w; a1 += lds[64 + kk] * w; a2 += lds[128 + kk] * w; a3 += lds[192 + kk] * w; a4 += lds[256 + kk] * w;
        }
        part[(size_t)(ks * 5 + 0) * 12288 + j] = a0; part[(size_t)(ks * 5 + 1) * 12288 + j] = a1; part[(size_t)(ks * 5 + 2) * 12288 + j] = a2;
        part[(size_t)(ks * 5 + 3) * 12288 + j] = a3; part[(size_t)(ks * 5 + 4) * 12288 + j] = a4;
    }
}
typedef short bf16x8v __attribute__((ext_vector_type(8)));
typedef float f32x4v __attribute__((ext_vector_type(4)));
typedef float f32x16v __attribute__((ext_vector_type(16)));
__device__ __forceinline__ void phase_filters(const Params& p, float* lds) {
    const int tid = opaque_tid();
    const float* w1 = p.in[I_FW1]; const float* b1 = p.in[I_FB1]; const float* w2 = p.in[I_FW2]; const float* b2 = p.in[I_FB2];
    const float* w3 = p.in[I_FW3]; const float* b3 = p.in[I_FB3]; const float* w4 = p.in[I_FW4]; const float* freq = p.in[I_FREQ];
    float* hT = (float*)((char*)p.ws + B_KF); float* sp = p.ws + W_SP;
    float* zf = lds; float* ha = lds + 64 * 36; float* hb = ha + 64 * 68; float* red2 = hb + 64 * 68;
    float* W1 = red2 + 256; float* W2 = W1 + 33 * 64; float* W3 = W2 + 64 * 64;
    __syncthreads();
    for (int e = tid; e < 33 * 64; e += NTHREADS) W1[e] = w1[e];
    for (int e = tid; e < 64 * 64; e += NTHREADS) { W2[e] = w2[e]; W3[e] = w3[e]; }
    for (int item = blockIdx.x; item < 256; item += gridDim.x) {
        const int pt = item >> 3;
        __syncthreads();
        for (int e = tid; e < 64 * 33; e += NTHREADS) {
            const int pos = e / 33, m = e % 33, i = pt * 64 + pos;
            const float t = (float)i / 2047.0f, w = 6.283185307179586f * (float)i / 2048.0f;
            float v;
            if (m == 0) v = t;
            else if (m <= 16) { const float f = 1e-4f + (float)(m - 1) * ((15.0f - 1e-4f) / 15.0f); v = __cosf(f * w); }
            else { const float f = 1e-4f + (float)(m - 17) * ((15.0f - 1e-4f) / 15.0f); v = -__sinf(f * w); }
            zf[pos * 36 + m] = v;
        }
        __syncthreads();
        const int pos = tid >> 3, u0 = (tid & 7) * 8;
        {
            float a[8];
#pragma unroll
            for (int u = 0; u < 8; ++u) a[u] = b1[u0 + u];
#pragma unroll 11
            for (int m = 0; m < 33; ++m) { const float zv = zf[pos * 36 + m]; const float4 wa = *(const float4*)(W1 + m * 64 + u0), wb = *(const float4*)(W1 + m * 64 + u0 + 4);
                a[0] += zv * wa.x; a[1] += zv * wa.y; a[2] += zv * wa.z; a[3] += zv * wa.w; a[4] += zv * wb.x; a[5] += zv * wb.y; a[6] += zv * wb.z; a[7] += zv * wb.w; }
#pragma unroll
            for (int u = 0; u < 8; ++u) ha[pos * 68 + u0 + u] = __sinf(freq[u0 + u] * a[u]);
        }
        __syncthreads();
        {
            float a[8];
#pragma unroll
            for (int u = 0; u < 8; ++u) a[u] = b2[u0 + u];
#pragma unroll 16
            for (int m = 0; m < 64; ++m) { const float zv = ha[pos * 68 + m]; const float4 wa = *(const float4*)(W2 + m * 64 + u0), wb = *(const float4*)(W2 + m * 64 + u0 + 4);
                a[0] += zv * wa.x; a[1] += zv * wa.y; a[2] += zv * wa.z; a[3] += zv * wa.w; a[4] += zv * wb.x; a[5] += zv * wb.y; a[6] += zv * wb.z; a[7] += zv * wb.w; }
#pragma unroll
            for (int u = 0; u < 8; ++u) hb[pos * 68 + u0 + u] = __sinf(freq[64 + u0 + u] * a[u]);
        }
        __syncthreads();
        {
            float a[8];
#pragma unroll
            for (int u = 0; u < 8; ++u) a[u] = b3[u0 + u];
#pragma unroll 16
            for (int m = 0; m < 64; ++m) { const float zv = hb[pos * 68 + m]; const float4 wa = *(const float4*)(W3 + m * 64 + u0), wb = *(const float4*)(W3 + m * 64 + u0 + 4);
                a[0] += zv * wa.x; a[1] += zv * wa.y; a[2] += zv * wa.z; a[3] += zv * wa.w; a[4] += zv * wb.x; a[5] += zv * wb.y; a[6] += zv * wb.z; a[7] += zv * wb.w; }
#pragma unroll
            for (int u = 0; u < 8; ++u) ha[pos * 68 + u0 + u] = __sinf(freq[128 + u0 + u] * a[u]);
        }
        __syncthreads();
#pragma unroll 1
        for (int jt = (item & 7) * 2; jt < (item & 7) * 2 + 2; ++jt) {
            const int lane = tid & 63, wv = tid >> 6, cl = lane & 15, g = lane >> 4;
            union frag { unsigned u[4]; bf16x8v v; };
            frag af[2][2];
#pragma unroll
            for (int mt = 0; mt < 2; ++mt)
#pragma unroll
                for (int ks = 0; ks < 2; ++ks) {
                    const float* wp = w4 + (size_t)(ks * 32 + 8 * g) * 4096 + jt * 256 + wv * 32 + mt * 16 + cl;
                    float x[8];
#pragma unroll
                    for (int i = 0; i < 8; ++i) x[i] = wp[(size_t)i * 4096];
                    af[mt][ks].u[0] = pk_bf16(x[0], x[1]); af[mt][ks].u[1] = pk_bf16(x[2], x[3]); af[mt][ks].u[2] = pk_bf16(x[4], x[5]); af[mt][ks].u[3] = pk_bf16(x[6], x[7]);
                }
            f32x4v acc[2][4];
#pragma unroll
            for (int mt = 0; mt < 2; ++mt)
#pragma unroll
                for (int nt = 0; nt < 4; ++nt) acc[mt][nt] = (f32x4v){0.f, 0.f, 0.f, 0.f};
#pragma unroll
            for (int nt = 0; nt < 4; ++nt)
#pragma unroll
                for (int ks = 0; ks < 2; ++ks) {
                    const float4 h0 = *(const float4*)(ha + (nt * 16 + cl) * 68 + ks * 32 + 8 * g), h1 = *(const float4*)(ha + (nt * 16 + cl) * 68 + ks * 32 + 8 * g + 4);
                    frag bf; bf.u[0] = pk_bf16(h0.x, h0.y); bf.u[1] = pk_bf16(h0.z, h0.w); bf.u[2] = pk_bf16(h1.x, h1.y); bf.u[3] = pk_bf16(h1.z, h1.w);
#pragma unroll
                    for (int mt = 0; mt < 2; ++mt) acc[mt][nt] = __builtin_amdgcn_mfma_f32_16x16x32_bf16(af[mt][ks].v, bf.v, acc[mt][nt], 0, 0, 0);
                }
#pragma unroll
            for (int mt = 0; mt < 2; ++mt)
#pragma unroll
                for (int r = 0; r < 4; ++r) {
                    const int j = jt * 256 + wv * 32 + mt * 16 + 4 * g + r;
                    const float delta = 3.070113457f + (float)(j & 1023) * ((15.35056729f - 3.070113457f) / 1023.0f);
                    float asum = 0.f;
#pragma unroll
                    for (int nt = 0; nt < 4; ++nt) {
                        const int ps = pt * 64 + nt * 16 + cl;
                        const float val = acc[mt][nt][r] * __expf(-((float)ps / 2047.0f) * delta);
                        asum += fabsf(val);
                        __builtin_nontemporal_store(val, hT + (size_t)j * SL + ps);
                    }
                    asum += __shfl_xor(asum, 1); asum += __shfl_xor(asum, 2); asum += __shfl_xor(asum, 4); asum += __shfl_xor(asum, 8);
                    if (cl == 0) sp[(size_t)pt * 4096 + j] = asum;
                }
        }
    }
}

__device__ __forceinline__ void phase_b(const Params& p) {
    const int tid = opaque_tid();
    const float* part = p.ws + W_ADAP; float* ada = p.ws + W_ADA; const float* bada = p.in[I_BADA];
    for (int e = blockIdx.x * NTHREADS + tid; e < 5 * 12288; e += gridDim.x * NTHREADS) {
        float s = bada[e % 12288];
#pragma unroll 8
        for (int ks = 0; ks < 32; ++ks) s += part[(size_t)ks * 5 * 12288 + e];
        ada[e] = s;
    }
    const float* sp = p.ws + W_SP; float* fs = p.ws + W_FS;
    for (int j = blockIdx.x * NTHREADS + tid; j < 4096; j += gridDim.x * NTHREADS) {
        float s = 0.f;
#pragma unroll 8
        for (int pt = 0; pt < 32; ++pt) s += sp[(size_t)pt * 4096 + j];
        fs[j] = s;
    }
}

__device__ __forceinline__ void phase_c(const Params& p) {
    const int tid = opaque_tid();
    const float* ada = p.ws + W_ADA;
    const float* x = p.in[I_X]; bf16_t* ub = (bf16_t*)((char*)p.ws + B_UB);
    for (size_t e = (size_t)blockIdx.x * NTHREADS + tid; e < (size_t)NT * D / 4; e += (size_t)gridDim.x * NTHREADS) {
        const size_t row = e / (D / 4); const int col = (int)(e % (D / 4)) * 4; const int b = (int)(row / SL);
        const float4 xv = nt_load4(x + row * D + col);
        const float4 sh = *(const float4*)(ada + b * 12288 + col), sc = *(const float4*)(ada + b * 12288 + 2048 + col);
        uint2 o; o.x = pk_bf16(xv.x * (1.f + sc.x) + sh.x, xv.y * (1.f + sc.y) + sh.y); o.y = pk_bf16(xv.z * (1.f + sc.z) + sh.z, xv.w * (1.f + sc.w) + sh.w);
        *(uint2*)(ub + row * D + col) = o;
    }
    const float* ctx = p.in[I_CTX]; bf16_t* ucb = ub + (size_t)NT * D;
    for (size_t e = (size_t)blockIdx.x * NTHREADS + tid; e < (size_t)NTC * D / 4; e += (size_t)gridDim.x * NTHREADS) {
        const size_t row = e / (D / 4); const int col = (int)(e % (D / 4)) * 4;
        const float4 xv = nt_load4(ctx + row * D + col);
        const float4 sh = *(const float4*)(ada + 4 * 12288 + col), sc = *(const float4*)(ada + 4 * 12288 + 2048 + col);
        uint2 o; o.x = pk_bf16(xv.x * (1.f + sc.x) + sh.x, xv.y * (1.f + sc.y) + sh.y); o.y = pk_bf16(xv.z * (1.f + sc.z) + sh.z, xv.w * (1.f + sc.w) + sh.w);
        *(uint2*)(ucb + row * D + col) = o;
    }
}

__device__ __forceinline__ float bf2f(bf16_t v) { return __uint_as_float(((unsigned)v) << 16); }
constexpr int HY_PB = 4416, HY_PJ = 272, HY_R0 = 4 * HY_PB, HY_R1 = HY_R0 + 8192 + 64, HY_SLOT = HY_R1 + 8192 + 64;
static_assert(HY_SLOT % 16 == 0 && 4 * HY_SLOT + 64 <= 155 * 1024, "hyena LDS");
__device__ __forceinline__ bf16x8v hy_lda(const unsigned char* base, int off) {
    const unsigned* q = (const unsigned*)(base + off);
    union { unsigned u[4]; bf16x8v v; } r; r.u[0] = q[0]; r.u[1] = q[1]; r.u[2] = q[2]; r.u[3] = q[3];
    return r.v;
}
__device__ __forceinline__ void hy_stage_rows(const bf16_t* zT, const float* cw, const float* cb, int ch, int half, int lane, unsigned char* sl) {
    const float w0 = cw[ch], w1 = cw[3072 + ch], w2 = cw[6144 + ch], bs = cb[ch];
#pragma unroll 4
    for (int q = 0; q < 8; ++q) {
        const int bsel = 2 * half + (q >> 2), t0 = ((q & 3) * 64 + lane) * 8;
        const bf16_t* zrow = zT + (size_t)ch * NT + bsel * SL;
        const uint4 raw = nt_load4u(zrow + t0);
        float z[10];
        z[0] = t0 > 0 ? bf2f(zrow[t0 - 1]) : 0.f; z[9] = t0 + 8 < SL ? bf2f(zrow[t0 + 8]) : 0.f;
        z[1] = __uint_as_float(raw.x << 16); z[2] = __uint_as_float(raw.x & 0xffff0000u); z[3] = __uint_as_float(raw.y << 16); z[4] = __uint_as_float(raw.y & 0xffff0000u);
        z[5] = __uint_as_float(raw.z << 16); z[6] = __uint_as_float(raw.z & 0xffff0000u); z[7] = __uint_as_float(raw.w << 16); z[8] = __uint_as_float(raw.w & 0xffff0000u);
        float sv[8];
#pragma unroll
        for (int i = 0; i < 8; ++i) sv[i] = w0 * z[i] + w1 * z[i + 1] + w2 * z[i + 2] + bs;
        uint4 o; o.x = pk_bf16(sv[0], sv[1]); o.y = pk_bf16(sv[2], sv[3]); o.z = pk_bf16(sv[4], sv[5]); o.w = pk_bf16(sv[6], sv[7]);
        *(uint4*)(sl + bsel * HY_PB + (t0 >> 7) * HY_PJ + (t0 & 127) * 2) = o;
    }
}
__device__ __forceinline__ void hy_pair_sync(volatile __attribute__((address_space(3))) unsigned* fl, int wv, unsigned n) {
    asm volatile("s_waitcnt lgkmcnt(0)" ::: "memory");
    fl[wv] = n;
    while (fl[wv ^ 1] < n) __builtin_amdgcn_s_sleep(0);
    asm volatile("" ::: "memory");
}
__device__ __forceinline__ void phase_hyena(const Params& p, unsigned char* smem) {
    const int tid = opaque_tid(), lane = tid & 63, wv = tid >> 6, slot = wv >> 1, half = wv & 1, pt = tid & 127;
    const bf16_t* zT = (const bf16_t*)((const char*)p.ws + B_ZT); const float* hT = (const float*)((const char*)p.ws + B_KF); const float* fs = p.ws + W_FS; bf16_t* hyT = (bf16_t*)((char*)p.ws + B_HYT);
    const float* cw = p.in[I_CONVW]; const float* cb = p.in[I_CONVB]; const float* skip = p.in[I_SKIP];
    unsigned char* sl = smem + slot * HY_SLOT;
    const int a_ = lane & 31, hh = lane >> 5, i_local = a_ >> 2, batch = a_ & 3, I0 = 8 * half;
    const int laneA = ((a_ & 1) ? HY_R0 : HY_R1) + 2 * (2047 - a_ - (1 - (a_ & 1)) + 8 * hh);
    volatile __attribute__((address_space(3))) unsigned* fl = (volatile __attribute__((address_space(3))) unsigned*)(smem + 4 * HY_SLOT);
    unsigned seq = 0u;
    __syncthreads();
    if (tid < 8) fl[tid] = 0u;
    if (wv < 4) __builtin_amdgcn_s_setprio(2);
    for (int item = blockIdx.x; item < DHY / 4; item += gridDim.x) {
        const int c = item * 4 + slot;
        __syncthreads();
        hy_stage_rows(zT, cw, cb, c, half, lane, sl);
#pragma unroll 1
        for (int ord = 0; ord < 2; ++ord) {
            {
                const float* hf = hT + (size_t)((ord * 2 + 0) * 1024 + c) * SL; const float* hbk = hT + (size_t)((ord * 2 + 1) * 1024 + c) * SL;
                const float sk = skip[ord * 1024 + c]; const float invs = 1.0f / (fs[(ord * 2 + 0) * 1024 + c] + fs[(ord * 2 + 1) * 1024 + c]);
#pragma unroll
                for (int q = 0; q < 4; ++q) {
                    const int X0 = (q * 128 + pt) * 8;
                    float rv[9];
#pragma unroll
                    for (int i = 0; i < 9; ++i) { const int dp = 2047 - X0 - i; rv[i] = (dp >= 0 ? __builtin_nontemporal_load(hf + dp) : (dp >= -2047 ? __builtin_nontemporal_load(hbk - dp) : 0.f)) * invs; if (dp == 0) rv[i] += sk; }
                    uint4 o0, o1;
                    o0.x = pk_bf16(rv[0], rv[1]); o0.y = pk_bf16(rv[2], rv[3]); o0.z = pk_bf16(rv[4], rv[5]); o0.w = pk_bf16(rv[6], rv[7]);
                    o1.x = pk_bf16(rv[1], rv[2]); o1.y = pk_bf16(rv[3], rv[4]); o1.z = pk_bf16(rv[5], rv[6]); o1.w = pk_bf16(rv[7], rv[8]);
                    *(uint4*)(sl + HY_R0 + X0 * 2) = o0; *(uint4*)(sl + HY_R1 + X0 * 2) = o1;
                }
            }
            hy_pair_sync(fl, wv, ++seq);
            f32x16v acc[4];
#pragma unroll
            for (int mb = 0; mb < 4; ++mb)
#pragma unroll
                for (int e = 0; e < 16; ++e) acc[mb][e] = 0.f;
            {
                const int dlo = I0 - 15, dhi = I0 + 7;
                bf16x8v As[7][2];
#pragma unroll
                for (int s2 = 0; s2 < 3; ++s2)
#pragma unroll
                    for (int k2 = 0; k2 < 2; ++k2) As[4 + s2][k2] = hy_lda(sl, laneA - 64 * (4 * dlo - 3 + s2) + 32 * k2);
#pragma unroll 1
                for (int d = dlo; d <= dhi; ++d) {
#pragma unroll
                    for (int k2 = 0; k2 < 2; ++k2) { As[0][k2] = As[4][k2]; As[1][k2] = As[5][k2]; As[2][k2] = As[6][k2]; }
#pragma unroll
                    for (int s2 = 3; s2 < 7; ++s2)
#pragma unroll
                        for (int k2 = 0; k2 < 2; ++k2) As[s2][k2] = hy_lda(sl, laneA - 64 * (4 * d - 3 + s2) + 32 * k2);
                    const int jl = I0 + i_local - d; const bool valid = (unsigned)jl < 16u;
                    const unsigned char* bp = sl + batch * HY_PB + (valid ? jl : 0) * HY_PJ + hh * 16;
                    bf16x8v Bq[8];
#pragma unroll
                    for (int q = 0; q < 8; ++q) { const bf16x8v v = *(const bf16x8v*)(bp + q * 32); const bf16x8v zero = {0, 0, 0, 0, 0, 0, 0, 0}; Bq[q] = valid ? v : zero; }
#pragma unroll
                    for (int kb = 0; kb < 4; ++kb)
#pragma unroll
                        for (int k2 = 0; k2 < 2; ++k2)
#pragma unroll
                            for (int mb = 0; mb < 4; ++mb) acc[mb] = __builtin_amdgcn_mfma_f32_32x32x16_bf16(As[mb - kb + 3][k2], Bq[2 * kb + k2], acc[mb], 0, 0, 0);
                }
            }
            hy_pair_sync(fl, wv, ++seq);
            hy_stage_rows(zT, cw, cb, (ord == 0 ? 1024 : 2048) + c, half, lane, sl);
            hy_pair_sync(fl, wv, ++seq);
            {
#pragma unroll
                for (int mb = 0; mb < 4; ++mb)
#pragma unroll
                    for (int q4 = 0; q4 < 4; ++q4) {
                        const int t4 = 128 * (I0 + i_local) + 32 * mb + 8 * q4 + 4 * hh;
                        uint2* gp = (uint2*)(sl + batch * HY_PB + (t4 >> 7) * HY_PJ + (t4 & 127) * 2);
                        const uint2 gv = *gp;
                        uint2 o; o.x = pk_bf16(__uint_as_float(gv.x << 16) * acc[mb][q4 * 4 + 0], __uint_as_float(gv.x & 0xffff0000u) * acc[mb][q4 * 4 + 1]);
                        o.y = pk_bf16(__uint_as_float(gv.y << 16) * acc[mb][q4 * 4 + 2], __uint_as_float(gv.y & 0xffff0000u) * acc[mb][q4 * 4 + 3]);
                        *gp = o;
                    }
            }
            if (ord == 1) {
                hy_pair_sync(fl, wv, ++seq);
#pragma unroll
                for (int q = 0; q < 8; ++q) {
                    const int bsel = 2 * half + (q >> 2), t0 = ((q & 3) * 64 + lane) * 8;
                    nt_store4u(hyT + (size_t)c * NT + bsel * SL + t0, *(const uint4*)(sl + bsel * HY_PB + (t0 >> 7) * HY_PJ + (t0 & 127) * 2));
                }
            }
        }
    }
    __builtin_amdgcn_s_setprio(0);
}

__device__ __forceinline__ bf16x8v pack_p(const f32x4v& lo, const f32x4v& hi) {
    union { unsigned u[4]; bf16x8v v; } r;
    r.u[0] = pk_bf16(lo[0], lo[1]); r.u[1] = pk_bf16(lo[2], lo[3]); r.u[2] = pk_bf16(hi[0], hi[1]); r.u[3] = pk_bf16(hi[2], hi[3]);
    return r.v;
}
__device__ __forceinline__ bf16x8v ld_pair8(const bf16_t* lo, const bf16_t* hi) {
    union { uint2 d[2]; bf16x8v v; } r;
    r.d[0] = *(const uint2*)lo; r.d[1] = *(const uint2*)hi;
    return r.v;
}
typedef __attribute__((address_space(3))) const bf16_t* lds_bf16p;
#define LDS_FRAG(pe) (*(const __attribute__((address_space(3))) bf16x8v*)(pe))
constexpr int NA_KC = 0, NA_VC = 32768, NA_KL = 65536, NA_RPB = 155648;
__device__ __forceinline__ void phase_na(const Params& p, unsigned char* smem) {
    const int tid = opaque_tid(), lane = tid & 63, wv = tid >> 6, ql = lane & 15, g = lane >> 4;
    const bf16_t* qh = (const bf16_t*)((const char*)p.ws + B_QH); const bf16_t* kh = (const bf16_t*)((const char*)p.ws + B_KH);
    const bf16_t* kch = (const bf16_t*)((const char*)p.ws + B_KCH); const bf16_t* vT = (const bf16_t*)((const char*)p.ws + B_VT);
    const bf16_t* vcT = (const bf16_t*)((const char*)p.ws + B_VCT); bf16_t* na = (bf16_t*)((char*)p.ws + B_NA);
    const float* rpb = p.in[I_RPB];
    const lds_bf16p kcl = (lds_bf16p)((__attribute__((address_space(3))) unsigned char*)smem + NA_KC);
    const lds_bf16p vcl = (lds_bf16p)((__attribute__((address_space(3))) unsigned char*)smem + NA_VC);
    const lds_bf16p kll = (lds_bf16p)((__attribute__((address_space(3))) unsigned char*)smem + NA_KL);
    for (int sitem = blockIdx.x; sitem < 256; sitem += gridDim.x) {
      const int b = sitem >> 6, h = (sitem >> 2) & 15, rqp = sitem & 3;
      __syncthreads();
      {
          const uint4* s0 = (const uint4*)(kch + (size_t)((b * 16 + h) * 32) * 512); const uint4* s1 = (const uint4*)(vcT + (size_t)((b * 16 + h) * 32) * 512);
          uint4* d0 = (uint4*)(smem + NA_KC); uint4* d1 = (uint4*)(smem + NA_VC);
#pragma unroll
          for (int i = 0; i < 4; ++i) { d0[tid + i * NTHREADS] = s0[tid + i * NTHREADS]; d1[tid + i * NTHREADS] = s1[tid + i * NTHREADS]; }
          if (tid < 465) ((float*)(smem + NA_RPB))[tid] = rpb[h * 465 + tid];
      }
#pragma unroll 1
      for (int half = 0; half < 2; ++half) {
        const int r0 = rqp * 8 + half * 4;
        const int rs_min = min(max(r0 - 4, 0), 24), rs_max = min(max(r0 - 1, 0), 24), nrows = rs_max - rs_min + 8;
        if (half) __syncthreads();
        {
            const uint4* s0 = (const uint4*)(kh + (size_t)((b * 16 + h) * 256 + rs_min * 8) * 512); uint4* d0 = (uint4*)(smem + NA_KL);
            for (int e = tid; e < nrows * 512; e += NTHREADS) d0[e] = s0[e];
        }
        __syncthreads();
#pragma unroll 1
        for (int ti = 0; ti < 2; ++ti) {
        const int r = r0 + (wv >> 2) + 2 * ti, j = wv & 3;
        const int rs = min(max(r - 4, 0), 24), cs = min(max(16 * j - 8, 0), 32);
        const int x = 16 * j + ql, wsx = min(max(x - 8, 0), 48);
        const bf16_t* qrow = qh + ((size_t)((b * 16 + h) * SL + r * 64 + x)) * 64;
        const bf16x8v qf0 = __builtin_nontemporal_load((const bf16x8v*)(qrow + 8 * g)), qf1 = __builtin_nontemporal_load((const bf16x8v*)(qrow + 32 + 8 * g));
        const __attribute__((address_space(3))) float* rp_h = (const __attribute__((address_space(3))) float*)((__attribute__((address_space(3))) unsigned char*)smem + NA_RPB);
        f32x4v o1[4], o2[4]; float m1 = -1e30f, l1 = 0.f, m2 = -1e30f, l2 = 0.f;
#pragma unroll
        for (int d = 0; d < 4; ++d) { o1[d] = (f32x4v){0.f, 0.f, 0.f, 0.f}; o2[d] = (f32x4v){0.f, 0.f, 0.f, 0.f}; }
        const int koff = (ql >> 2) * 512 + g * 32 + (ql & 3) * 8;
        const bf16_t* vb = vT + (size_t)((b * 16 + h) * 256 + g) * 512 + ql * 8;
        {
            f32x4v st[16];
#pragma unroll
            for (int kb = 0; kb < 16; ++kb) {
                const lds_bf16p kp = kcl + koff + (kb >> 1) * 2048 + (kb & 1) * 128;
                const bf16x8v a0 = LDS_FRAG(kp), a1 = LDS_FRAG(kp + 256);
                f32x4v acc = {0.f, 0.f, 0.f, 0.f};
                acc = __builtin_amdgcn_mfma_f32_16x16x32_bf16(a0, qf0, acc, 0, 0, 0);
                acc = __builtin_amdgcn_mfma_f32_16x16x32_bf16(a1, qf1, acc, 0, 0, 0);
#pragma unroll
                for (int rr = 0; rr < 4; ++rr) { acc[rr] *= 0.125f; m1 = fmaxf(m1, acc[rr]); }
                st[kb] = acc;
            }
            m1 = fmaxf(m1, __shfl_xor(m1, 16)); m1 = fmaxf(m1, __shfl_xor(m1, 32));
#pragma unroll
            for (int kb = 0; kb < 16; ++kb)
#pragma unroll
                for (int rr = 0; rr < 4; ++rr) { const float e = __expf(st[kb][rr] - m1); st[kb][rr] = e; l1 += e; }
            l1 += __shfl_xor(l1, 16); l1 += __shfl_xor(l1, 32);
#pragma unroll
            for (int kp = 0; kp < 8; ++kp) {
                const bf16x8v pb = pack_p(st[2 * kp], st[2 * kp + 1]);
#pragma unroll
                for (int d = 0; d < 4; ++d) o1[d] = __builtin_amdgcn_mfma_f32_16x16x32_bf16(LDS_FRAG(vcl + g * 512 + ql * 8 + kp * 2048 + d * 128), pb, o1[d], 0, 0, 0);
            }
        }
        {
            f32x4v st[16];
#pragma unroll
            for (int kb = 0; kb < 16; ++kb) {
                const lds_bf16p kp = kll + koff + ((((rs + (kb >> 1) - rs_min) * 64 + cs) >> 3) * 512) + (kb & 1) * 128;
                const bf16x8v a0 = LDS_FRAG(kp), a1 = LDS_FRAG(kp + 256);
                f32x4v acc = {0.f, 0.f, 0.f, 0.f};
                acc = __builtin_amdgcn_mfma_f32_16x16x32_bf16(a0, qf0, acc, 0, 0, 0);
                acc = __builtin_amdgcn_mfma_f32_16x16x32_bf16(a1, qf1, acc, 0, 0, 0);
                const int dr = rs + (kb >> 1) - r + 7;
#pragma unroll
                for (int rr = 0; rr < 4; ++rr) {
                    const int kc = cs + 8 * g + 4 * (kb & 1) + rr, rel = kc - wsx;
                    const bool ok = rel >= 0 && rel < 16;
                    const int dc = min(max(kc - x + 15, 0), 30);
                    const float sv = ok ? acc[rr] * 0.125f + rp_h[dr * 31 + dc] : -1e30f;
                    acc[rr] = sv; m2 = fmaxf(m2, sv);
                }
                st[kb] = acc;
                if ((kb & 7) == 7) asm volatile("" ::: "memory");
            }
            m2 = fmaxf(m2, __shfl_xor(m2, 16)); m2 = fmaxf(m2, __shfl_xor(m2, 32));
#pragma unroll
            for (int kb = 0; kb < 16; ++kb)
#pragma unroll
                for (int rr = 0; rr < 4; ++rr) { const float e = __expf(st[kb][rr] - m2); st[kb][rr] = e; l2 += e; }
            l2 += __shfl_xor(l2, 16); l2 += __shfl_xor(l2, 32);
#pragma unroll
            for (int kp = 0; kp < 8; ++kp) {
                const bf16x8v pb = pack_p(st[2 * kp], st[2 * kp + 1]);
                const bf16_t* vp = vb + (size_t)(((rs + kp) * 64 + cs) >> 3) * 512;
#pragma unroll
                for (int d = 0; d < 4; ++d) o2[d] = __builtin_amdgcn_mfma_f32_16x16x32_bf16(*(const bf16x8v*)(vp + d * 128), pb, o2[d], 0, 0, 0);
                if ((kp & 3) == 3) asm volatile("" ::: "memory");
            }
        }
        const float mm = fmaxf(m1, m2), c1 = __expf(m1 - mm), c2 = __expf(m2 - mm);
        const float inv = 1.0f / (c1 * l1 + c2 * l2);
        const float w1 = c1 * inv, w2 = c2 * inv;
        f32x4v o[4];
#pragma unroll
        for (int d = 0; d < 4; ++d) o[d] = o1[d] * w1 + o2[d] * w2;
        bf16_t* op = na + (size_t)(b * SL + r * 64 + x) * DNA + h * 64 + 4 * g;
#pragma unroll
        for (int d = 0; d < 4; ++d) { uint2 w; w.x = pk_bf16(o[d][0], o[d][1]); w.y = pk_bf16(o[d][2], o[d][3]); nt_store2u(op + 16 * d, w); }
        }
      }
    }
}

__device__ __forceinline__ void phase_f(const Params& p, float* ldsf) {
    const int tid = opaque_tid();
    const bf16_t* hyT = (const bf16_t*)((const char*)p.ws + B_HYT); const bf16_t* na = (const bf16_t*)((const char*)p.ws + B_NA);
    bf16_t* ob = (bf16_t*)((char*)p.ws + B_UB);
    const float* ghy = p.in[I_GHY]; const float* gna = p.in[I_GNA];
    bf16_t* tile = (bf16_t*)ldsf;
    for (int item = blockIdx.x; item < NT / 32; item += gridDim.x) {
        const int t0 = item * 32;
        __syncthreads();
        uint4 hvv[8];
#pragma unroll
        for (int q = 0; q < 8; ++q) { const int e = q * NTHREADS + tid; hvv[q] = nt_load4u(hyT + (size_t)(e >> 2) * NT + t0 + (e & 3) * 8); }
#pragma unroll
        for (int q = 0; q < 8; ++q) {
            const int e = q * NTHREADS + tid, ch = e >> 2, part = e & 3;
            const unsigned wd[4] = {hvv[q].x, hvv[q].y, hvv[q].z, hvv[q].w};
#pragma unroll
            for (int i = 0; i < 4; ++i) { tile[(part * 8 + 2 * i) * 1032 + ch] = (bf16_t)(wd[i] & 0xffffu); tile[(part * 8 + 2 * i + 1) * 1032 + ch] = (bf16_t)(wd[i] >> 16); }
        }
        __syncthreads();
        const int tk = tid >> 4, sub = tid & 15;
        float hv[64]; float sh = 0.f, sn = 0.f;
#pragma unroll
        for (int i = 0; i < 8; ++i) {
            const uint4 v = *(const uint4*)(tile + tk * 1032 + (i * 16 + sub) * 8);
            const unsigned wd[4] = {v.x, v.y, v.z, v.w};
#pragma unroll
            for (int k = 0; k < 4; ++k) { const float a = __uint_as_float(wd[k] << 16), c = __uint_as_float(wd[k] & 0xffff0000u); hv[i * 8 + 2 * k] = a; hv[i * 8 + 2 * k + 1] = c; sh += a * a + c * c; }
        }
        const bf16_t* nrow = na + (size_t)(t0 + tk) * DNA;
        uint4 nv[8];
#pragma unroll
        for (int i = 0; i < 8; ++i) { nv[i] = nt_load4u(nrow + (i * 16 + sub) * 8);
            const unsigned wd[4] = {nv[i].x, nv[i].y, nv[i].z, nv[i].w};
#pragma unroll
            for (int k = 0; k < 4; ++k) { const float a = __uint_as_float(wd[k] << 16), c = __uint_as_float(wd[k] & 0xffff0000u); sn += a * a + c * c; } }
        sh += __shfl_xor(sh, 1); sh += __shfl_xor(sh, 2); sh += __shfl_xor(sh, 4); sh += __shfl_xor(sh, 8);
        sn += __shfl_xor(sn, 1); sn += __shfl_xor(sn, 2); sn += __shfl_xor(sn, 4); sn += __shfl_xor(sn, 8);
        const float rh = rsqrtf(sh * (1.0f / 1024.0f) + LN_EPS), rn = rsqrtf(sn * (1.0f / 1024.0f) + LN_EPS);
        bf16_t* orow = ob + (size_t)(t0 + tk) * D;
#pragma unroll
        for (int i = 0; i < 8; ++i) {
            const float4 g0 = *(const float4*)(ghy + (i * 16 + sub) * 8), g1 = *(const float4*)(ghy + (i * 16 + sub) * 8 + 4);
            uint4 w; w.x = pk_bf16(hv[i * 8] * rh * g0.x, hv[i * 8 + 1] * rh * g0.y); w.y = pk_bf16(hv[i * 8 + 2] * rh * g0.z, hv[i * 8 + 3] * rh * g0.w);
            w.z = pk_bf16(hv[i * 8 + 4] * rh * g1.x, hv[i * 8 + 5] * rh * g1.y); w.w = pk_bf16(hv[i * 8 + 6] * rh * g1.z, hv[i * 8 + 7] * rh * g1.w);
            *(uint4*)(orow + (i * 16 + sub) * 8) = w;
        }
#pragma unroll
        for (int i = 0; i < 8; ++i) {
            const float4 g0 = *(const float4*)(gna + (i * 16 + sub) * 8), g1 = *(const float4*)(gna + (i * 16 + sub) * 8 + 4);
            const unsigned wd[4] = {nv[i].x, nv[i].y, nv[i].z, nv[i].w};
            float a[8];
#pragma unroll
            for (int k = 0; k < 4; ++k) { a[2 * k] = __uint_as_float(wd[k] << 16); a[2 * k + 1] = __uint_as_float(wd[k] & 0xffff0000u); }
            uint4 w; w.x = pk_bf16(a[0] * rn * g0.x, a[1] * rn * g0.y); w.y = pk_bf16(a[2] * rn * g0.z, a[3] * rn * g0.w);
            w.z = pk_bf16(a[4] * rn * g1.x, a[5] * rn * g1.y); w.w = pk_bf16(a[6] * rn * g1.z, a[7] * rn * g1.w);
            *(uint4*)(orow + DHY + (i * 16 + sub) * 8) = w;
        }
    }
}

__device__ __forceinline__ void phase_h(const Params& p) {
    const int tid = opaque_tid(), lane = tid & 63, wv = tid >> 6;
    const float* x = p.in[I_X]; const bf16_t* y = (const bf16_t*)((const char*)p.ws + B_Y); const float* ada = p.ws + W_ADA;
    const float* g = p.in[I_LN1G]; const float* be = p.in[I_LN1B];
    bf16_t* x1 = (bf16_t*)((char*)p.ws + B_X1); bf16_t* u2b = (bf16_t*)((char*)p.ws + B_UB); unsigned* u2q = (unsigned*)((char*)p.ws + B_U2Q); float* su2 = p.ws + W_SU2;
#pragma unroll 1
    for (int tp = blockIdx.x * NWAVES + wv; tp < NT / 2; tp += gridDim.x * NWAVES) {
        const int b = (2 * tp) / SL;
        float v[2][32]; float s[2] = {0.f, 0.f};
#pragma unroll
        for (int u = 0; u < 2; ++u)
#pragma unroll
            for (int j = 0; j < 8; ++j) {
                const int col = j * 256 + lane * 4; const size_t t = (size_t)(2 * tp + u);
                const float4 xv = nt_load4(x + t * D + col); const uint2 yb = nt_load2u(y + t * D + col);
                const float4 yv = make_float4(__uint_as_float(yb.x << 16), __uint_as_float(yb.x & 0xffff0000u), __uint_as_float(yb.y << 16), __uint_as_float(yb.y & 0xffff0000u));
                const float4 gt = *(const float4*)(ada + b * 12288 + 2 * 2048 + col);
                v[u][j * 4] = ALPHA * xv.x + gt.x * yv.x; v[u][j * 4 + 1] = ALPHA * xv.y + gt.y * yv.y; v[u][j * 4 + 2] = ALPHA * xv.z + gt.z * yv.z; v[u][j * 4 + 3] = ALPHA * xv.w + gt.w * yv.w;
                s[u] += (v[u][j * 4] + v[u][j * 4 + 1]) + (v[u][j * 4 + 2] + v[u][j * 4 + 3]);
            }
        float rstd[2];
#pragma unroll
        for (int u = 0; u < 2; ++u) {
            const float mean = wave_sum(s[u]) * (1.0f / 2048.0f);
            float q2 = 0.f;
#pragma unroll
            for (int i = 0; i < 32; ++i) { v[u][i] -= mean; q2 += v[u][i] * v[u][i]; }
            rstd[u] = rsqrtf(wave_sum(q2) * (1.0f / 2048.0f) + LN_EPS);
        }
        asm volatile("" ::: "memory");
        float umx[2] = {0.f, 0.f};
#pragma unroll
        for (int j = 0; j < 8; ++j) {
            const int col = j * 256 + lane * 4;
            const float4 gv = *(const float4*)(g + col), bv = *(const float4*)(be + col);
            const float4 sh = *(const float4*)(ada + b * 12288 + 3 * 2048 + col), sc = *(const float4*)(ada + b * 12288 + 4 * 2048 + col);
#pragma unroll
            for (int u = 0; u < 2; ++u) {
                const size_t t = (size_t)(2 * tp + u);
                const float4 o = make_float4(v[u][j * 4] * rstd[u] * gv.x + bv.x, v[u][j * 4 + 1] * rstd[u] * gv.y + bv.y, v[u][j * 4 + 2] * rstd[u] * gv.z + bv.z, v[u][j * 4 + 3] * rstd[u] * gv.w + bv.w);
                { uint2 xb; xb.x = pk_bf16(o.x, o.y); xb.y = pk_bf16(o.z, o.w); nt_store2u(x1 + t * D + col, xb); }
                const float4 uv = make_float4(o.x * (1.f + sc.x) + sh.x, o.y * (1.f + sc.y) + sh.y, o.z * (1.f + sc.z) + sh.z, o.w * (1.f + sc.w) + sh.w);
                v[u][j * 4] = uv.x; v[u][j * 4 + 1] = uv.y; v[u][j * 4 + 2] = uv.z; v[u][j * 4 + 3] = uv.w;
                uint2 ub2; ub2.x = pk_bf16(uv.x, uv.y); ub2.y = pk_bf16(uv.z, uv.w);
                *(uint2*)(u2b + t * D + col) = ub2;
                umx[u] = fmaxf(umx[u], fmaxf(fmaxf(fabsf(uv.x), fabsf(uv.y)), fmaxf(fabsf(uv.z), fabsf(uv.w))));
            }
        }
#pragma unroll
        for (int u = 0; u < 2; ++u) {
            const size_t t = (size_t)(2 * tp + u);
            const float um = wave_max(umx[u]);
            const float inv = um > 0.f ? 127.0f / um : 0.f;
            uint4 qa, qb;
            qa.x = q4(v[u][0], v[u][1], v[u][2], v[u][3], inv, 0); qa.y = q4(v[u][4], v[u][5], v[u][6], v[u][7], inv, 0); qa.z = q4(v[u][8], v[u][9], v[u][10], v[u][11], inv, 0); qa.w = q4(v[u][12], v[u][13], v[u][14], v[u][15], inv, 0);
            qb.x = q4(v[u][16], v[u][17], v[u][18], v[u][19], inv, 0); qb.y = q4(v[u][20], v[u][21], v[u][22], v[u][23], inv, 0); qb.z = q4(v[u][24], v[u][25], v[u][26], v[u][27], inv, 0); qb.w = q4(v[u][28], v[u][29], v[u][30], v[u][31], inv, 0);
            nt_store4u(u2q + t * 512 + lane * 8, qa); nt_store4u(u2q + t * 512 + lane * 8 + 4, qb);
            if (lane == 0) su2[t] = um * (1.0f / 127.0f);
        }
    }
}

template <int N> __device__ __forceinline__ void bitonic_desc(float (&v)[N]) {
#pragma unroll
    for (int k = 2; k <= N; k <<= 1)
#pragma unroll
        for (int j = k >> 1; j > 0; j >>= 1)
#pragma unroll
            for (int i = 0; i < N; ++i) { const int l = i ^ j; if (l > i) { const float x = v[i], y = v[l]; const float mx = fmaxf(x, y), mn = fminf(x, y); if ((i & k) == 0) { v[i] = mx; v[l] = mn; } else { v[i] = mn; v[l] = mx; } } }
}
__device__ __forceinline__ void bitonic_merge16_desc(float (&v)[16]) {
#pragma unroll
    for (int j = 8; j > 0; j >>= 1)
#pragma unroll
        for (int i = 0; i < 16; ++i) { const int l = i ^ j; if (l > i) { const float x = v[i], y = v[l]; v[i] = fmaxf(x, y); v[l] = fminf(x, y); } }
}
__device__ __forceinline__ void top16_of_128(float (&sc)[32], float (&top)[16]) {
    float lo[16], hi[16];
#pragma unroll
    for (int i = 0; i < 16; ++i) { lo[i] = sc[i]; hi[i] = sc[16 + i]; }
    bitonic_desc<16>(lo); bitonic_desc<16>(hi);
#pragma unroll
    for (int i = 0; i < 16; ++i) top[i] = fmaxf(lo[i], hi[15 - i]);
    bitonic_merge16_desc(top);
#pragma unroll
    for (int off = 16; off <= 32; off <<= 1) {
        float o[16];
#pragma unroll
        for (int i = 0; i < 16; ++i) o[i] = __shfl_xor(top[15 - i], off);
#pragma unroll
        for (int i = 0; i < 16; ++i) top[i] = fmaxf(top[i], o[i]);
        bitonic_merge16_desc(top);
    }
}
__device__ __forceinline__ void ce_carry(float& va, int& xa, float& vb, int& xb, bool desc) {
    const bool sw = desc ? (vb > va) : (vb < va);
    const float tv = sw ? vb : va, uv = sw ? va : vb; const int tx = sw ? xb : xa, ux = sw ? xa : xb;
    va = tv; vb = uv; xa = tx; xb = ux;
}
__device__ __forceinline__ void bitonic_merge16_desc_carry(float (&v)[16], int (&x)[16]) {
#pragma unroll
    for (int j = 8; j > 0; j >>= 1)
#pragma unroll
        for (int i = 0; i < 16; ++i) { const int l = i ^ j; if (l > i) ce_carry(v[i], x[i], v[l], x[l], true); }
}
constexpr int CAND_I[52] = {0,0,0,0,0,0,0,0,0,0,0,0,0,0,0,0,1,1,1,1,1,1,1,1,2,2,2,2,2,3,3,3,3,4,4,4,5,5,6,6,7,7,8,9,10,11,12,13,14,15,-1,-1};
constexpr int CAND_J[52] = {0,1,2,3,4,5,6,7,8,9,10,11,12,13,14,15,0,1,2,3,4,5,6,7,0,1,2,3,4,0,1,2,3,0,1,2,0,1,0,1,0,1,0,0,0,0,0,0,0,0,-1,-1};

__device__ __forceinline__ int rl_i(int v, int l) { return __builtin_amdgcn_readlane(v, l); }
__device__ __forceinline__ float rl_f(float v, int l) { return __int_as_float(__builtin_amdgcn_readlane(__float_as_int(v), l)); }
#define LANE_OF(k) ((((k) >> 3) & 1) * 32 + (((k) >> 2) & 1) * 16 + (((k) >> 1) & 1) * 8 + ((k) & 1) * 4)
constexpr size_t B_KEYSB = 15 * MiB;
constexpr size_t B_QB = B_Y;

typedef float f32x2v __attribute__((ext_vector_type(2)));
#define PKFMA_LO(fv, xv, wsv) do { f32x2v _t; asm("v_cvt_pk_f32_fp8 %1, %2\n\tv_pk_fma_f32 %0, %3, %1, %0" : "+v"(fv), "=&v"(_t) : "v"(xv), "v"(wsv)); } while (0)
#define PKFMA_HI(fv, xv, wsv) do { f32x2v _t; asm("v_cvt_pk_f32_fp8_sdwa %1, %2 src0_sel:WORD_1\n\tv_pk_fma_f32 %0, %3, %1, %0" : "+v"(fv), "=&v"(_t) : "v"(xv), "v"(wsv)); } while (0)
#define FACC(i) (f2[((i) >> 3) * 4 + (((i) & 1) ? 2 : 0) + (((i) & 7) >> 2)][(((i) & 7) >> 1) & 1])
__device__ __forceinline__ void gather_token(const Params& p, int t, const int* sel_idx, const float* sel_g, int lane) {
    const bf16_t* x1 = (const bf16_t*)((const char*)p.ws + B_X1); const float* ada = p.ws + W_ADA;
    const char* uq = (const char*)p.ws + B_TQ; const char* vq = uq + (size_t)16384 * UROW; const char* u2q = (const char*)p.ws + B_U2Q;
    const __amdgpu_buffer_rsrc_t ursrc = __builtin_amdgcn_make_buffer_rsrc((void*)uq, 0, 16384 * UROW, 0x00020000);
    const __amdgpu_buffer_rsrc_t vrsrc = __builtin_amdgcn_make_buffer_rsrc((void*)vq, 0, 16384 * UROW, 0x00020000);
    const float* su2 = p.ws + W_SU2; const float* rsu = p.ws + W_SU; const float* rsv = p.ws + W_SV;
    const float* g2 = p.in[I_LN2G]; const float* b2 = p.in[I_LN2B];
    const int b = t / SL;
    unsigned ue[4], uo[4]; int us0, us1;
    {
        const uint4 ua_ = nt_load4u(u2q + (size_t)t * D + lane * 32), ub_ = nt_load4u(u2q + (size_t)t * D + lane * 32 + 16);
        const int4 ua = make_int4((int)ua_.x, (int)ua_.y, (int)ua_.z, (int)ua_.w), ub = make_int4((int)ub_.x, (int)ub_.y, (int)ub_.z, (int)ub_.w);
        ue[0] = __builtin_amdgcn_perm((unsigned)ua.y, (unsigned)ua.x, 0x06040200u); uo[0] = __builtin_amdgcn_perm((unsigned)ua.y, (unsigned)ua.x, 0x07050301u);
        ue[1] = __builtin_amdgcn_perm((unsigned)ua.w, (unsigned)ua.z, 0x06040200u); uo[1] = __builtin_amdgcn_perm((unsigned)ua.w, (unsigned)ua.z, 0x07050301u);
        ue[2] = __builtin_amdgcn_perm((unsigned)ub.y, (unsigned)ub.x, 0x06040200u); uo[2] = __builtin_amdgcn_perm((unsigned)ub.y, (unsigned)ub.x, 0x07050301u);
        ue[3] = __builtin_amdgcn_perm((unsigned)ub.w, (unsigned)ub.z, 0x06040200u); uo[3] = __builtin_amdgcn_perm((unsigned)ub.w, (unsigned)ub.z, 0x07050301u);
        us0 = __builtin_amdgcn_sdot4(ua.x, 0x01010101, 0, false); us0 = __builtin_amdgcn_sdot4(ua.y, 0x01010101, us0, false); us0 = __builtin_amdgcn_sdot4(ua.z, 0x01010101, us0, false); us0 = __builtin_amdgcn_sdot4(ua.w, 0x01010101, us0, false);
        us1 = __builtin_amdgcn_sdot4(ub.x, 0x01010101, 0, false); us1 = __builtin_amdgcn_sdot4(ub.y, 0x01010101, us1, false); us1 = __builtin_amdgcn_sdot4(ub.z, 0x01010101, us1, false); us1 = __builtin_amdgcn_sdot4(ub.w, 0x01010101, us1, false);
    }
    const float s2 = su2[t];
    const float uoff = 7.5f * wave_sum((float)(us0 + us1));
    f32x2v f2[16];
#pragma unroll
    for (int i = 0; i < 16; ++i) f2[i] = (f32x2v){0.f, 0.f};
    float fb0 = 0.f;
    const int kk8 = ((lane >> 5) & 1) * 4 + ((lane >> 4) & 1) * 2 + ((lane >> 3) & 1);
#define LANE_OF8(k) ((((k) >> 2) & 1) * 32 + (((k) >> 1) & 1) * 16 + ((k) & 1) * 8)
    int e_cur = sel_idx[kk8]; float g_cur = sel_g[kk8];
    uint4 un[8];
#pragma unroll
    for (int k = 0; k < 8; ++k) { const int ro = rl_i(e_cur, LANE_OF8(k)) * UROW; un[k] = __builtin_bit_cast(uint4, __builtin_amdgcn_raw_buffer_load_b128(ursrc, lane * 16, ro, 0)); }
#pragma unroll 1
    for (int bt = 0; bt < 16; ++bt) {
        uint4 vn[8];
#pragma unroll
        for (int k = 0; k < 8; ++k) { const int ro = rl_i(e_cur, LANE_OF8(k)) * UROW; vn[k] = __builtin_bit_cast(uint4, __builtin_amdgcn_raw_buffer_load_b128(vrsrc, lane * 16, ro, 0)); }
        __builtin_amdgcn_sched_barrier(0);
        float part[8];
#pragma unroll
        for (int k = 0; k < 8; ++k) {
            const uint4 nq = un[k];
            int d0 = __builtin_amdgcn_sdot4((int)ue[0], (int)(nq.x & 0x0F0F0F0Fu), 0, false); d0 = __builtin_amdgcn_sdot4((int)uo[0], (int)((nq.x >> 4) & 0x0F0F0F0Fu), d0, false);
            d0 = __builtin_amdgcn_sdot4((int)ue[1], (int)(nq.y & 0x0F0F0F0Fu), d0, false); d0 = __builtin_amdgcn_sdot4((int)uo[1], (int)((nq.y >> 4) & 0x0F0F0F0Fu), d0, false);
            d0 = __builtin_amdgcn_sdot4((int)ue[2], (int)(nq.z & 0x0F0F0F0Fu), d0, false); d0 = __builtin_amdgcn_sdot4((int)uo[2], (int)((nq.z >> 4) & 0x0F0F0F0Fu), d0, false);
            d0 = __builtin_amdgcn_sdot4((int)ue[3], (int)(nq.w & 0x0F0F0F0Fu), d0, false); d0 = __builtin_amdgcn_sdot4((int)uo[3], (int)((nq.w >> 4) & 0x0F0F0F0Fu), d0, false);
            part[k] = (float)d0;
            __builtin_amdgcn_sched_barrier(0);
        }
        const int bn = (bt + 1) & 15;
        const int e_nxt = sel_idx[bn * 8 + kk8]; const float g_nxt = sel_g[bn * 8 + kk8];
#pragma unroll
        for (int k = 0; k < 8; ++k) { const int ro = rl_i(e_nxt, LANE_OF8(k)) * UROW; un[k] = __builtin_bit_cast(uint4, __builtin_amdgcn_raw_buffer_load_b128(ursrc, lane * 16, ro, 0)); }
        __builtin_amdgcn_sched_barrier(0);
        { const bool up = (lane & 32) != 0;
#pragma unroll
          for (int i = 0; i < 4; ++i) { const float keep = up ? part[i + 4] : part[i], send = up ? part[i] : part[i + 4]; part[i] = keep + __shfl_xor(send, 32); } }
        { const bool up = (lane & 16) != 0;
#pragma unroll
          for (int i = 0; i < 2; ++i) { const float keep = up ? part[i + 2] : part[i], send = up ? part[i] : part[i + 2]; part[i] = keep + __shfl_xor(send, 16); } }
        { const bool up = (lane & 8) != 0;
          const float keep = up ? part[1] : part[0], send = up ? part[0] : part[1]; part[0] = keep + __shfl_xor(send, 8); }
        float tot = part[0]; tot += __shfl_xor(tot, 1); tot += __shfl_xor(tot, 2); tot += __shfl_xor(tot, 4);
        const float dt = (tot - uoff) * s2 * rsu[e_cur];
        const float act = 0.5f * dt * (1.0f + erff(dt * 0.7071067811865476f));
        const float w_l = g_cur * act * rsv[e_cur];
#pragma unroll
        for (int k = 0; k < 8; ++k) {
            const float w = rl_f(w_l, LANE_OF8(k));
            fb0 += w;
            const f32x2v wp0 = {w * 512.f, w * 512.f};
            const unsigned wd[4] = {vn[k].x, vn[k].y, vn[k].z, vn[k].w};
#pragma unroll
            for (int q = 0; q < 4; ++q) {
                const unsigned ev = wd[q] & 0x0F0F0F0Fu, od = (wd[q] >> 4) & 0x0F0F0F0Fu;
                PKFMA_LO(f2[q * 4 + 0], ev, wp0); PKFMA_HI(f2[q * 4 + 1], ev, wp0); PKFMA_LO(f2[q * 4 + 2], od, wp0); PKFMA_HI(f2[q * 4 + 3], od, wp0);
            }
        }
        e_cur = e_nxt; g_cur = g_nxt;
    }
#undef LANE_OF8
    asm volatile("" ::: "memory");
    float v[32]; float s = 0.f;
#pragma unroll
    for (int q = 0; q < 8; ++q) {
        const int col = q * 256 + lane * 4, o = q * 4;
        const uint2 xb = nt_load2u(x1 + (size_t)t * D + col); const float4 gt = *(const float4*)(ada + b * 12288 + 5 * 2048 + col);
        const float4 xv = make_float4(__uint_as_float(xb.x << 16), __uint_as_float(xb.x & 0xffff0000u), __uint_as_float(xb.y << 16), __uint_as_float(xb.y & 0xffff0000u));
        const float fbh = 7.5f * fb0;
        v[o] = ALPHA * xv.x + gt.x * (FACC(o) - fbh); v[o + 1] = ALPHA * xv.y + gt.y * (FACC(o + 1) - fbh);
        v[o + 2] = ALPHA * xv.z + gt.z * (FACC(o + 2) - fbh); v[o + 3] = ALPHA * xv.w + gt.w * (FACC(o + 3) - fbh);
        s += (v[o] + v[o + 1]) + (v[o + 2] + v[o + 3]);
    }
    const float mean = wave_sum(s) * (1.0f / 2048.0f);
    float q2 = 0.f;
#pragma unroll
    for (int i = 0; i < 32; ++i) { v[i] -= mean; q2 += v[i] * v[i]; }
    const float rstd = rsqrtf(wave_sum(q2) * (1.0f / 2048.0f) + LN_EPS);
    asm volatile("" ::: "memory");
#pragma unroll
    for (int q = 0; q < 8; ++q) {
        const int col = q * 256 + lane * 4, o = q * 4;
        const float4 gv = *(const float4*)(g2 + col), bv = *(const float4*)(b2 + col);
        nt_store4(p.out + (size_t)t * D + col, v[o] * rstd * gv.x + bv.x, v[o + 1] * rstd * gv.y + bv.y, v[o + 2] * rstd * gv.z + bv.z, v[o + 3] * rstd * gv.w + bv.w);
    }
}

__device__ __forceinline__ void phase_jk(const Params& p, unsigned char* smem) {
    const int tid0 = opaque_tid();
    const bf16_t* qb = (const bf16_t*)((const char*)p.ws + B_QB); const bf16_t* keysb = (const bf16_t*)((const char*)p.ws + B_KEYSB);
    int* sel_idx = (int*)smem; float* sel_g = (float*)(smem + 8192);
#pragma unroll 1
    for (int item = blockIdx.x; item < NT / 16; item += gridDim.x) {
        int tid = tid0; asm volatile("" : "+v"(tid));
        const int lane = tid & 63, wv = tid >> 6, ql = lane & 15, g = lane >> 4;
        const int t0 = item * 16, h = wv;
        __syncthreads();
        float ta[16], tb[16];
#pragma unroll
        for (int i = 0; i < 16; ++i) { ta[i] = 0.f; tb[i] = 0.f; }
#pragma unroll 1
        for (int pp = 0; pp < 2; ++pp) {
            const bf16_t* qrow = qb + ((size_t)((((t0 >> 4) * 8 + h) * 2 + pp) * 4) * 64 + lane) * 8;
            bf16x8v qf[4];
#pragma unroll
            for (int kc = 0; kc < 4; ++kc) qf[kc] = __builtin_nontemporal_load((const bf16x8v*)(qrow + kc * 512));
            const bf16_t* kbase = keysb + (size_t)((h * 2 + pp) * 8) * 2048 + lane * 8;
            float sc[32];
#pragma unroll
            for (int nb = 0; nb < 8; ++nb) {
                f32x4v acc = {0.f, 0.f, 0.f, 0.f};
#pragma unroll
                for (int kc = 0; kc < 4; ++kc) acc = __builtin_amdgcn_mfma_f32_16x16x32_bf16(*(const bf16x8v*)(kbase + (nb * 4 + kc) * 512), qf[kc], acc, 0, 0, 0);
#pragma unroll
                for (int rr = 0; rr < 4; ++rr) sc[nb * 4 + rr] = __int_as_float((__float_as_int(acc[rr]) & ~127) | (16 * nb + 4 * g + rr));
                if (nb == 3) asm volatile("" ::: "memory");
            }
            float top[16];
            top16_of_128(sc, top);
#pragma unroll
            for (int i = 0; i < 16; ++i) { if (pp == 0) ta[i] = top[i]; else tb[i] = top[i]; }
        }
        float cv[16]; int cx[16];
#pragma unroll
        for (int sidx = 0; sidx < 13; ++sidx) {
            float vv[4]; int xx[4];
#pragma unroll
            for (int q = 0; q < 4; ++q) {
                const int ci = CAND_I[4 * sidx + q], cj = CAND_J[4 * sidx + q];
                if (ci >= 0) { vv[q] = ta[ci] + tb[cj]; xx[q] = ((__float_as_int(ta[ci]) & 127) << 7) | (__float_as_int(tb[cj]) & 127); } else { vv[q] = -3.0e38f; xx[q] = 0; }
            }
            cv[sidx] = g == 0 ? vv[0] : (g == 1 ? vv[1] : (g == 2 ? vv[2] : vv[3]));
            cx[sidx] = g == 0 ? xx[0] : (g == 1 ? xx[1] : (g == 2 ? xx[2] : xx[3]));
        }
#pragma unroll
        for (int sidx = 13; sidx < 16; ++sidx) { cv[sidx] = -3.0e38f; cx[sidx] = 0; }
#pragma unroll
        for (int k = 2; k <= 16; k <<= 1)
#pragma unroll
            for (int j = k >> 1; j > 0; j >>= 1)
#pragma unroll
                for (int i = 0; i < 16; ++i) { const int l = i ^ j; if (l > i) ce_carry(cv[i], cx[i], cv[l], cx[l], (i & k) == 0); }
#pragma unroll
        for (int off = 16; off <= 32; off <<= 1) {
            float ov[16]; int ox[16];
#pragma unroll
            for (int i = 0; i < 16; ++i) { ov[i] = __shfl_xor(cv[15 - i], off); ox[i] = __shfl_xor(cx[15 - i], off); }
#pragma unroll
            for (int i = 0; i < 16; ++i) { const bool tk = ov[i] > cv[i]; cv[i] = tk ? ov[i] : cv[i]; cx[i] = tk ? ox[i] : cx[i]; }
            bitonic_merge16_desc_carry(cv, cx);
        }
        {
            float ex[16]; float sum = 0.f;
#pragma unroll
            for (int i = 0; i < 16; ++i) { ex[i] = __expf(cv[i] - cv[0]); sum += ex[i]; }
            const float inv = 1.0f / sum;
            if (g == 0) {
#pragma unroll
                for (int q = 0; q < 4; ++q) {
                    *(int4*)(sel_idx + ql * 128 + h * 16 + q * 4) = make_int4(cx[q * 4], cx[q * 4 + 1], cx[q * 4 + 2], cx[q * 4 + 3]);
                    *(float4*)(sel_g + ql * 128 + h * 16 + q * 4) = make_float4(ex[q * 4] * inv, ex[q * 4 + 1] * inv, ex[q * 4 + 2] * inv, ex[q * 4 + 3] * inv);
                }
            }
        }
        __syncthreads();
#pragma unroll 1
        for (int k = 0; k < 2; ++k) { int lane2 = lane; asm volatile("" : "+v"(lane2)); gather_token(p, t0 + 2 * wv + k, sel_idx + (2 * wv + k) * 128, sel_g + (2 * wv + k) * 128, lane2); }
    }
}

__device__ __forceinline__ void map_tile(int L, int nM, int nN, int& pm, int& pn) {
    const int nwg = nM * nN; int wgid = L;
    { const int q = nwg / 8, r = nwg % 8, xcd = wgid % 8, off = wgid / 8; wgid = (xcd < r ? xcd * (q + 1) : r * (q + 1) + (xcd - r) * q) + off; }
    const int nig = 8 * nN, gid = wgid / nig, fm = gid * 8, gsz = (nM - fm) < 8 ? (nM - fm) : 8;
    pm = fm + ((wgid % nig) % gsz); pn = (wgid % nig) / gsz;
}
struct ProjOrder {
    int G, c; const bf16_t* ub; const bf16_t* wint;
    __device__ bool next(int i, pg8::Unit& u) const {
        const int L = i * G + c; if (L >= 800) return false;
        if (L < 384) { u.kind = 0; map_tile(L, 12, 32, u.pm, u.pn); }
        else if (L < 512) { u.kind = 1; map_tile(L - 384, 4, 32, u.pm, u.pn); }
        else if (L < 768) { u.kind = 2; map_tile(L - 512, 32, 8, u.pm, u.pn); }
        else if (L < 784) { u.kind = 3; u.pm = (L - 768) >> 2; u.pn = (L - 768) & 3; }
        else { u.kind = 4; u.pm = (L - 784) >> 2; u.pn = (L - 784) & 3; }
        return true;
    }
    __device__ __forceinline__ void a_ready(const pg8::Unit&) const {}
    __device__ __forceinline__ void done(const pg8::Unit&) const {}
    template <class G_> __device__ __forceinline__ const char* pa(const G_&, const pg8::Unit& u) const {
        const size_t ts = (size_t)256 * D * 2;
        switch (u.kind) { case 0: return (const char*)wint + (size_t)u.pm * ts; case 1: return (const char*)wint + (size_t)(20 + u.pm) * ts; case 2: return (const char*)ub + (size_t)u.pm * ts;
                          case 3: return (const char*)ub + (size_t)(32 + u.pm) * ts; default: return (const char*)wint + (size_t)(20 + u.pm) * ts; }
    }
    template <class G_> __device__ __forceinline__ const char* pb(const G_&, const pg8::Unit& u) const {
        const size_t ts = (size_t)256 * D * 2;
        switch (u.kind) { case 0: case 1: return (const char*)ub + (size_t)u.pn * ts; case 2: return (const char*)wint + (size_t)(12 + u.pn) * ts;
                          case 3: return (const char*)wint + (size_t)(16 + u.pn) * ts; default: return (const char*)ub + (size_t)(32 + u.pn) * ts; }
    }
};
struct EpiProj {
    static constexpr bool PERM = true, AFTER_DRAIN = false;
    unsigned char* ws;
    __device__ __forceinline__ void operator()(const pg8::f32x4 (&acc)[2][2][4][2], const pg8::Unit& u, int wr, int wc, int fr, int fq) const {
        bf16_t* const zT = (bf16_t*)(ws + B_ZT); bf16_t* const vT = (bf16_t*)(ws + B_VT); bf16_t* const qh = (bf16_t*)(ws + B_QH); bf16_t* const kh = (bf16_t*)(ws + B_KH);
        bf16_t* const kch = (bf16_t*)(ws + B_KCH); bf16_t* const vcT = (bf16_t*)(ws + B_VCT);
#pragma unroll
        for (int ai = 0; ai < 2; ++ai)
#pragma unroll
            for (int m = 0; m < 4; ++m) {
                const int r = u.pm * 256 + ai * 128 + wr * 64 + m * 16 + fr;
#pragma unroll
                for (int bj = 0; bj < 2; ++bj) {
                    const int cc = u.pn * 256 + bj * 128 + wc * 32 + 8 * fq;
                    bf16_t* dst;
                    if (u.kind == 0) dst = zT + (size_t)r * NT + cc;
                    else if (u.kind == 1) {
                        const int bb = cc >> 11, t = cc & 2047, hh = r >> 6, dd = r & 63;
                        dst = vT + (size_t)((bb * 16 + hh) * 256 + (t >> 3)) * 512 + (dd >> 4) * 128 + (dd & 15) * 8;
                    } else if (u.kind == 2) {
                        const int bb = r >> 11, t = r & 2047, hc = cc & 1023, hh = hc >> 6, dd = hc & 63;
                        if (cc < 1024) dst = qh + ((size_t)((bb * 16 + hh) * SL + t)) * 64 + dd;
                        else dst = kh + (size_t)((bb * 16 + hh) * 256 + (t >> 3)) * 512 + (dd >> 5) * 256 + ((t & 7) >> 2) * 128 + ((dd & 31) >> 3) * 32 + (t & 3) * 8;
                    } else if (u.kind == 3) {
                        const int bb = r >> 8, jj = r & 255, hh = cc >> 6, dd = cc & 63;
                        dst = kch + (size_t)((bb * 16 + hh) * 32 + (jj >> 3)) * 512 + (dd >> 5) * 256 + ((jj & 7) >> 2) * 128 + ((dd & 31) >> 3) * 32 + (jj & 3) * 8;
                    } else {
                        const int bb = cc >> 8, jj = cc & 255, hh = r >> 6, dd = r & 63;
                        dst = vcT + (size_t)((bb * 16 + hh) * 32 + (jj >> 3)) * 512 + (dd >> 4) * 128 + (dd & 15) * 8;
                    }
                    const pg8::f32x4 v0 = acc[ai][bj][m][0], v1 = acc[ai][bj][m][1];
                    pg8::u32x4 w; w.x = pg8::cvt_pk_bf16(v0[0], v0[1]); w.y = pg8::cvt_pk_bf16(v0[2], v0[3]); w.z = pg8::cvt_pk_bf16(v1[0], v1[1]); w.w = pg8::cvt_pk_bf16(v1[2], v1[3]);
                    *(pg8::u32x4*)dst = w;
                }
            }
    }
};

struct EpiQFrag {
    static constexpr bool PERM = true, AFTER_DRAIN = false;
    bf16_t* O;
    __device__ __forceinline__ void operator()(const pg8::f32x4 (&acc)[2][2][4][2], const pg8::Unit& u, int wr, int wc, int fr, int fq) const {
#pragma unroll
        for (int ai = 0; ai < 2; ++ai)
#pragma unroll
            for (int m = 0; m < 4; ++m) {
                const int t = u.pm * 256 + ai * 128 + wr * 64 + m * 16 + fr;
#pragma unroll
                for (int bj = 0; bj < 2; ++bj) {
                    const int c = u.pn * 256 + bj * 128 + wc * 32 + 8 * fq;
                    const int hh = c >> 8, pp = (c >> 7) & 1, d = c & 127;
                    bf16_t* dst = O + ((size_t)(((((t >> 4) * 8 + hh) * 2 + pp) * 4 + (d >> 5)) * 64 + ((d & 31) >> 3) * 16 + (t & 15))) * 8;
                    const pg8::f32x4 v0 = acc[ai][bj][m][0], v1 = acc[ai][bj][m][1];
                    pg8::u32x4 w; w.x = pg8::cvt_pk_bf16(v0[0], v0[1]); w.y = pg8::cvt_pk_bf16(v0[2], v0[3]); w.z = pg8::cvt_pk_bf16(v1[0], v1[1]); w.w = pg8::cvt_pk_bf16(v1[2], v1[3]);
                    __builtin_nontemporal_store(w, (pg8::u32x4*)dst);
                }
            }
    }
};

#define XB_TMO      128
#define XB_XCNT(j)  (256  + 64 * (j))
#define XB_XSUB(j)  (1280 + 64 * (j))
#define XB_XGEN(j)  (2304 + 64 * (j))
#define XB_TOP      3328
#define XB_TOPGEN   3392
#define XCD_BAR_WORDS 3456
#define XB_SPIN_CAP (1u << 18)
#define LAS __attribute__((address_space(3)))

__device__ __forceinline__ unsigned xb_ld(unsigned* p)              { return __hip_atomic_load(p, __ATOMIC_RELAXED, __HIP_MEMORY_SCOPE_AGENT); }
__device__ __forceinline__ unsigned xb_add(unsigned* p, unsigned v) { return __hip_atomic_fetch_add(p, v, __ATOMIC_RELAXED, __HIP_MEMORY_SCOPE_AGENT); }
__device__ __forceinline__ unsigned xb_xcc_id() { return (unsigned)__builtin_amdgcn_s_getreg((3 << 11) | 20) & 0xFu; }
#define XB_SPIN(cond, bar) do { unsigned _sp = 0; while (cond) { __builtin_amdgcn_s_sleep(1); \
    if ((++_sp & 255u) == 0u) { if (xb_ld(&(bar)[XB_TMO])) break; if (_sp > XB_SPIN_CAP) { atomicAdd(&(bar)[XB_TMO], 1u); break; } } } } while (0)

struct XcdBarrier {
    unsigned* bar; unsigned x;
    volatile LAS unsigned* st;
};

__device__ __forceinline__ XcdBarrier xcd_barrier_post(unsigned* bar, volatile LAS unsigned* st) {
    XcdBarrier b; b.bar = bar; b.x = xb_xcc_id(); b.st = st;
    if (threadIdx.x == 0) (void)xb_add(&bar[XB_XCNT(b.x)], 1u);
    return b;
}
__device__ __forceinline__ void xcd_barrier_complete(unsigned* bar, unsigned x, unsigned& nloc, unsigned& nx) {
    const unsigned G = gridDim.x * gridDim.y * gridDim.z;
    unsigned sum, cnt, mine, sp = 0u;
    for (;;) {
        sum = 0u; cnt = 0u; mine = 0u;
#pragma unroll
        for (unsigned j = 0; j < 16; ++j) { const unsigned c = xb_ld(&bar[XB_XCNT(j)]); sum += c; cnt += (c > 0u) ? 1u : 0u; mine = (j == x) ? c : mine; }
        if (sum == G) break;
        __builtin_amdgcn_s_sleep(1);
        if ((++sp & 255u) == 0u) { if (xb_ld(&bar[XB_TMO])) break; if (sp > XB_SPIN_CAP) { atomicAdd(&bar[XB_TMO], 1u); break; } }
    }
    nloc = mine > 0u ? mine : 1u; nx = cnt > 0u ? cnt : 1u;
}

__device__ __forceinline__ void xcd_barrier(const XcdBarrier& b) {
    asm volatile("s_waitcnt vmcnt(0)" ::: "memory");
    __syncthreads();
    if (threadIdx.x == 0) {
        unsigned* bar = b.bar;
        __builtin_amdgcn_s_waitcnt(0);
        unsigned nloc = b.st[0], nx = b.st[1]; const unsigned k = b.st[2];
        if (nloc == 0u) { xcd_barrier_complete(bar, b.x, nloc, nx); b.st[0] = nloc; b.st[1] = nx; }
        b.st[2] = k + 1u;
        const unsigned old = xb_add(&bar[XB_XSUB(b.x)], 1u);
        if (old + 1u == (k + 1u) * nloc) {
            __builtin_amdgcn_fence(__ATOMIC_RELEASE, "agent");
            asm volatile("s_waitcnt vmcnt(0)" ::: "memory");
            (void)xb_add(&bar[XB_TOP], 1u);
        }
        asm volatile("buffer_inv sc1" ::: "memory");
        XB_SPIN(xb_ld(&bar[XB_TOP]) < (k + 1u) * nx, bar);
        asm volatile("s_waitcnt vmcnt(0)" ::: "memory");
    }
    __syncthreads();
}
constexpr size_t B_BAR = 14 * MiB;

__global__ void __launch_bounds__(NTHREADS) fwd_megakernel(Params p) {
    extern __shared__ __attribute__((aligned(16))) unsigned char smem[];
    float* lds = (float*)smem; float* red = (float*)(smem + RED_OFF);
    PG8_LAS unsigned char* glds = (PG8_LAS unsigned char*)smem;
    volatile LAS unsigned* xst = (volatile LAS unsigned*)(smem + LDS_BYTES - 16);
    if (threadIdx.x < 4) xst[threadIdx.x] = 0u;
    __syncthreads();
    XcdBarrier xb = xcd_barrier_post((unsigned*)((char*)p.ws + B_BAR), xst);
    bf16_t* wint = (bf16_t*)((char*)p.ws + B_WINT); bf16_t* woutt = (bf16_t*)((char*)p.ws + B_WOUTT); bf16_t* wqt = (bf16_t*)((char*)p.ws + B_WQT);
    bf16_t* ub = (bf16_t*)((char*)p.ws + B_UB);
    phase_a(p, lds);
    transpose_convert(p.in[I_WIN], wint, D, DPROJ, lds, 0, (int)gridDim.x);
    phase_filters(p, lds);
    {
        const float* ks = p.in[I_KEYS]; bf16_t* kd = (bf16_t*)((char*)p.ws + B_KEYSB);
        for (int e = blockIdx.x * NTHREADS + threadIdx.x; e < 16 * 128 * 128 / 4; e += gridDim.x * NTHREADS) {
            const float4 v = *(const float4*)(ks + e * 4); uint2 o; o.x = pk_bf16(v.x, v.y); o.y = pk_bf16(v.z, v.w);
            const int d = (e * 4) & 127, n = ((e * 4) >> 7) & 127, hp = (e * 4) >> 14;
            *(uint2*)(kd + ((size_t)(((hp * 8 + (n >> 4)) * 4 + (d >> 5)) * 64 + ((d & 31) >> 3) * 16 + (n & 15))) * 8 + (d & 7)) = o;
        }
    }
    xcd_barrier(xb);
    phase_b(p);
    xcd_barrier(xb);
    phase_c(p);
    xcd_barrier(xb);
    {
        pg8::Gemm g{ub, wint, NT + NTC, DPROJ, D}; ProjOrder S{(int)gridDim.x, (int)blockIdx.x, ub, wint};
        EpiProj E{(unsigned char*)p.ws};
        pg8::gemm_phase<EpiProj, ProjOrder>(glds, g, S, E, nullptr);
    }
    if (gridDim.x == 256 && blockIdx.x >= 32) {
        quant_tables(p, 32, 224);
        transpose_convert(p.in[I_WOUT], woutt, D, D, lds, 32, 224);
        transpose_convert(p.in[I_WQ], wqt, D, D, lds, 32, 224);
    } else if (gridDim.x != 256) {
        quant_tables(p, 0, (int)gridDim.x);
        transpose_convert(p.in[I_WOUT], woutt, D, D, lds, 0, (int)gridDim.x);
        transpose_convert(p.in[I_WQ], wqt, D, D, lds, 0, (int)gridDim.x);
    }
    xcd_barrier(xb);
    phase_hyena(p, smem);
    phase_na(p, smem);
    xcd_barrier(xb);
    phase_f(p, lds);
    xcd_barrier(xb);
    {
        pg8::Gemm g{ub, woutt, NT, D, D}; pg8::StaticOrder S; S.init(NT, D, (int)gridDim.x, (int)blockIdx.x);
        pg8::EpiBf16<0> E{(bf16_t*)((char*)p.ws + B_Y), D, nullptr, 0, 0};
        pg8::gemm_phase<pg8::EpiBf16<0>, pg8::StaticOrder>(glds, g, S, E, nullptr);
    }
    xcd_barrier(xb);
    phase_h(p);
    xcd_barrier(xb);
    {
        pg8::Gemm g{ub, wqt, NT, D, D}; pg8::StaticOrder S; S.init(NT, D, (int)gridDim.x, (int)blockIdx.x);
        EpiQFrag E{(bf16_t*)((char*)p.ws + B_QB)};
        pg8::gemm_phase<EpiQFrag, pg8::StaticOrder>(glds, g, S, E, nullptr);
    }
    xcd_barrier(xb);
    phase_jk(p, smem);
}

extern "C" void kernel_launch(void* const* d_in, const int* in_sizes, int n_in, void* d_out, int out_size, void* d_ws, size_t ws_size, hipStream_t stream) {
    static int grid_blocks = 0;
    if (grid_blocks == 0) {
        if (n_in != N_IN || out_size != NT * D || ws_size < W_END * sizeof(float)) {
            fprintf(stderr, "kernel_launch: unexpected shapes: n_in %d out %d ws %zu (need %zu)\n", n_in, out_size, ws_size, (size_t)W_END * 4); grid_blocks = -1; return; }
        int dev = 0, cus = 0, per_cu = 0;
        hipGetDevice(&dev);
        hipDeviceGetAttribute(&cus, hipDeviceAttributeMultiprocessorCount, dev);
        if (hipFuncSetAttribute((const void*)fwd_megakernel, hipFuncAttributeMaxDynamicSharedMemorySize, LDS_BYTES) != hipSuccess) { fprintf(stderr, "kernel_launch: hipFuncSetAttribute failed\n"); grid_blocks = -1; return; }
        if (hipOccupancyMaxActiveBlocksPerMultiprocessor(&per_cu, (const void*)fwd_megakernel, NTHREADS, LDS_BYTES) != hipSuccess || per_cu < 1) { fprintf(stderr, "kernel_launch: occupancy query failed (%d)\n", per_cu); (void)hipGetLastError(); grid_blocks = -1; return; }
        grid_blocks = cus * (per_cu > 1 ? 1 : per_cu);
        fprintf(stderr, "kernel_launch: cus %d per_cu %d grid %d\n", cus, per_cu, grid_blocks);
    }
    if (grid_blocks < 0) return;
    Params p{};
    for (int i = 0; i < N_IN; ++i) p.in[i] = (const float*)d_in[i];
    p.out = (float*)d_out; p.ws = (float*)d_ws;
    if (hipMemsetAsync((char*)d_ws + B_BAR, 0, XCD_BAR_WORDS * sizeof(unsigned), stream) != hipSuccess) { fprintf(stderr, "kernel_launch: memset failed\n"); return; }
    void* args[] = {&p};
    hipLaunchKernelGGL(fwd_megakernel, dim3(grid_blocks), dim3(NTHREADS), LDS_BYTES, stream, p);
    const hipError_t e = hipPeekAtLastError();
    if (e != hipSuccess) fprintf(stderr, "launch failed: %s (grid %d)\n", hipGetErrorString(e), grid_blocks);
}
```

```cpp
#include <hip/hip_runtime.h>
#include <hip/hip_cooperative_groups.h>
#include <cstdio>
namespace cg = cooperative_groups;

constexpr int D = 2048, NB = 4, SL = 2048, NT = NB * SL, CL = 256, NTC = NB * CL;
constexpr int DHY = 1024, DNA = 1024, DPROJ = 6144, OFFQ = 3072, OFFK = 4096, OFFV = 5120;
constexpr int NTHREADS = 512, NWAVES = 8;
constexpr float LN_EPS = 1e-5f;
constexpr float ALPHA = 1.189207115002721f;

enum { I_X = 0, I_C, I_CTX, I_CCTX, I_WADA, I_BADA, I_WIN, I_CONVW, I_CONVB, I_FW1, I_FB1, I_FW2, I_FB2, I_FW3, I_FB3, I_FW4,
       I_FREQ, I_SKIP, I_RPB, I_GHY, I_GNA, I_WOUT, I_LN1G, I_LN1B, I_WQ, I_KEYS, I_PU, I_PV, I_LN2G, I_LN2B, N_IN };

constexpr size_t W_ADAP = 0;
constexpr size_t W_ADA  = W_ADAP + 32 * 5 * 12288;
constexpr size_t W_FS   = W_ADA + 5 * 12288;
constexpr size_t W_SP   = W_FS + 4096;
constexpr size_t W_SU   = W_SP + 32 * 4096;
constexpr size_t W_SV   = W_SU + 16384;
constexpr size_t W_SU2  = W_SV + 16384;
static_assert((W_SU2 + 8192) * 4 <= 14 * 1048576, "small region overflow");
constexpr size_t MiB = 1048576;
constexpr size_t B_WINT  = 16 * MiB;
constexpr size_t B_WOUTT = B_WINT + 24 * MiB;
constexpr size_t B_WQT   = B_WOUTT + 8 * MiB;
constexpr size_t B_UB    = B_WQT + 8 * MiB;
constexpr size_t B_ZT    = B_UB + 36 * MiB;
constexpr size_t B_VT    = B_ZT + 48 * MiB;
constexpr size_t B_QH    = B_VT + 16 * MiB;
constexpr size_t B_KH    = B_QH + 16 * MiB;
constexpr size_t B_KCH   = B_KH + 16 * MiB;
constexpr size_t B_VCT   = B_KCH + 2 * MiB;
constexpr size_t B_KF    = B_VCT + 2 * MiB;
constexpr size_t B_HRAW  = B_KF + 32 * MiB;
constexpr size_t B_HYT   = B_HRAW;
constexpr size_t B_NA    = B_HRAW + 16 * MiB;
constexpr size_t B_Y     = B_HRAW + 32 * MiB;
constexpr size_t B_X1    = B_Y + 64 * MiB;
constexpr size_t B_U2Q   = B_X1 + 64 * MiB;
constexpr size_t B_TQ    = B_U2Q + 16 * MiB;
constexpr size_t B_END   = B_TQ + 64 * MiB;
constexpr size_t W_KF = B_KF / 4, W_X1 = B_X1 / 4, W_HRAW = B_HRAW / 4, W_Y = B_Y / 4, W_END = B_END / 4;
static_assert(B_END <= 512 * MiB, "workspace");

constexpr int LDS_BYTES = 156 * 1024;
constexpr int RED_OFF = 155 * 1024;

struct Params { const float* in[N_IN]; float* out; float* ws; };

namespace pg8 {
#define PG8_LAS __attribute__((address_space(3)))
typedef unsigned short bf16_t;
typedef short bf16x8 __attribute__((ext_vector_type(8)));
typedef float f32x4 __attribute__((ext_vector_type(4)));
typedef unsigned u32x4 __attribute__((ext_vector_type(4)));
constexpr int BM = 256, BK = 64, HALF = 128, HTB = HALF * BK * 2  , STAGE_BYTES = 8 * HTB, NXCD = 8, WGM = 8;

__host__ __device__ __forceinline__ int lds_byte(int r, int c) { const int st = (r >> 4) * 2 + (c >> 5), rr = r & 15, cc = c & 31, ob = rr * 64 + cc * 2; return st * 1024 + (ob ^ (((ob >> 9) & 1) << 5)); }
__host__ __device__ __forceinline__ void stage_rc(int b, int& R, int& C) { const int st = b / 1024, sb = b % 1024, swz = sb ^ (((sb >> 9) & 1) << 5); R = (st >> 1) * 16 + swz / 64; C = (st & 1) * 32 + (swz % 64) / 2; }
__host__ __device__ __forceinline__ int perm32(int rho) { const int n = rho >> 4, i = rho & 15; return 8 * (i >> 2) + 4 * n + (i & 3); }

struct Unit { int pm, pn, kind; };
struct Gemm { const bf16_t* A; const bf16_t* Bt; int M, N, K; };

struct StaticOrder {
    int nM, nN, nwg, G, c;
    __host__ __device__ void init(int M, int N, int G_, int c_) { nM = M / BM; nN = N / BM; nwg = nM * nN; G = G_; c = c_; }
    __host__ __device__ bool next(int i, Unit& u) const {
        const long L = (long)i * G + c; if (L >= nwg) return false;
        int wgid = (int)L; { const int q = nwg / NXCD, r = nwg % NXCD, xcd = wgid % NXCD, off = wgid / NXCD; wgid = (xcd < r ? xcd * (q + 1) : r * (q + 1) + (xcd - r) * q) + off; }
        const int nig = WGM * nN, gid = wgid / nig, fm = gid * WGM, gsz = (nM - fm) < WGM ? (nM - fm) : WGM;
        u.pm = fm + ((wgid % nig) % gsz); u.pn = (wgid % nig) / gsz; return true;
    }
    __device__ __forceinline__ void a_ready(const Unit&) const {}
    __device__ __forceinline__ void done(const Unit&) const {}
    template <class G_> __device__ __forceinline__ const char* pa(const G_& g, const Unit& u) const { return (const char*)g.A + (size_t)u.pm * (size_t)(BM * 2) * g.K; }
    template <class G_> __device__ __forceinline__ const char* pb(const G_& g, const Unit& u) const { return (const char*)g.Bt + (size_t)u.pn * (size_t)(BM * 2) * g.K; }
};
__device__ __forceinline__ unsigned cvt_pk_bf16(float lo, float hi) { unsigned r; asm volatile("v_cvt_pk_bf16_f32 %0, %1, %2" : "=v"(r) : "v"(lo), "v"(hi)); return r; }
typedef float f32x2 __attribute__((ext_vector_type(2)));
__device__ __forceinline__ f32x2 gelu_pk(f32x2 v) {
    const f32x2 av = __builtin_elementwise_abs(v), d = av * 0.2316418882f + 1.0f;
    f32x2 t; t.x = __builtin_amdgcn_rcpf(d.x); t.y = __builtin_amdgcn_rcpf(d.y);
    f32x2 q = t * 0.5307027145f + (-0.7265760135f); q = q * t + 0.7107068705f; q = q * t + (-0.142248368f); q = q * t + 0.127414796f; q = q * t;
    const f32x2 s = (v * v) * (-0.72134752044f);
    f32x2 e; e.x = __builtin_amdgcn_exp2f(s.x); e.y = __builtin_amdgcn_exp2f(s.y);
    const f32x2 m = v * (q * e), r = v - m;
    f32x2 o; o.x = v.x < 0.f ? m.x : r.x; o.y = v.y < 0.f ? m.y : r.y; return o;
}

struct EpiF32 {
    static constexpr bool PERM = false, AFTER_DRAIN = false;
    float* C; int ldc; const float* bias;
    __device__ __forceinline__ void operator()(const f32x4 (&acc)[2][2][4][2], const Unit& u, int wr, int wc, int fr, int fq) const {
        const int row0 = u.pm * BM + wr * 64 + fr, col0 = u.pn * BM + wc * 32 + 4 * fq;
        f32x4 bv[2][2];
#pragma unroll
        for (int bj = 0; bj < 2; ++bj)
#pragma unroll
            for (int n = 0; n < 2; ++n) bv[bj][n] = bias ? *(const f32x4*)(bias + col0 + bj * HALF + n * 16) : (f32x4){0.f, 0.f, 0.f, 0.f};
#pragma unroll
        for (int ai = 0; ai < 2; ++ai)
#pragma unroll
            for (int m = 0; m < 4; ++m) { float* rowp = C + (size_t)(row0 + ai * HALF + m * 16) * ldc + col0;
#pragma unroll
                for (int bj = 0; bj < 2; ++bj)
#pragma unroll
                    for (int n = 0; n < 2; ++n) *(f32x4*)(rowp + bj * HALF + n * 16) = acc[ai][bj][m][n] + bv[bj][n]; }
    }
};
template <int ACT  > struct EpiBf16 {
    static constexpr bool PERM = true, AFTER_DRAIN = false;
    bf16_t* O; int ldc; const float* bias; int split_cols; size_t split_stride;
    __device__ __forceinline__ void operator()(const f32x4 (&acc)[2][2][4][2], const Unit& u, int wr, int wc, int fr, int fq) const {
        const int row0 = u.pm * BM + wr * 64 + fr; int colt = u.pn * BM; bf16_t* base = O;
        if (split_cols) { const int t = colt / split_cols; base += (size_t)t * split_stride; colt -= t * split_cols; }
        const int col0 = colt + wc * 32 + 8 * fq, bcol0 = u.pn * BM + wc * 32 + 8 * fq;
        f32x4 bv[2][2];
#pragma unroll
        for (int bj = 0; bj < 2; ++bj)
#pragma unroll
            for (int n = 0; n < 2; ++n) bv[bj][n] = bias ? *(const f32x4*)(bias + bcol0 + bj * HALF + 4 * n) : (f32x4){0.f, 0.f, 0.f, 0.f};
#pragma unroll
        for (int ai = 0; ai < 2; ++ai)
#pragma unroll
            for (int m = 0; m < 4; ++m) { bf16_t* rowp = base + (size_t)(row0 + ai * HALF + m * 16) * ldc + col0;
#pragma unroll
                for (int bj = 0; bj < 2; ++bj) { f32x4 v0 = acc[ai][bj][m][0] + bv[bj][0], v1 = acc[ai][bj][m][1] + bv[bj][1];
                    if (ACT == 1) { f32x2 a = gelu_pk((f32x2){v0[0], v0[1]}), b = gelu_pk((f32x2){v0[2], v0[3]}), c = gelu_pk((f32x2){v1[0], v1[1]}), d = gelu_pk((f32x2){v1[2], v1[3]});
                        v0 = (f32x4){a.x, a.y, b.x, b.y}; v1 = (f32x4){c.x, c.y, d.x, d.y}; }
                    if (ACT == 2) {
#pragma unroll
                        for (int j = 0; j < 4; ++j) { v0[j] = 0.5f * v0[j] * (1.0f + erff(v0[j] * 0.70710678f)); v1[j] = 0.5f * v1[j] * (1.0f + erff(v1[j] * 0.70710678f)); } }
                    u32x4 w; w.x = cvt_pk_bf16(v0[0], v0[1]); w.y = cvt_pk_bf16(v0[2], v0[3]); w.z = cvt_pk_bf16(v1[0], v1[1]); w.w = cvt_pk_bf16(v1[2], v1[3]);
                    *(u32x4*)(rowp + bj * HALF) = w; } }
    }
};
template <class Epi, class Sched, bool STAMP = false>
__device__ __forceinline__ void gemm_phase(PG8_LAS unsigned char* lds, const Gemm g, const Sched& S, const Epi& E, unsigned long long* stamps) {
    const int tid = threadIdx.x, wid = __builtin_amdgcn_readfirstlane(tid >> 6), lane = tid & 63, wr = wid >> 2, wc = wid & 3, fr = lane & 15, fq = lane >> 4;
    const int K = g.K, nt = K / BK;
    int ts_lo = 0, ts_hi = 0, nts = 0; const unsigned long long rt_entry = STAMP ? (unsigned long long)wall_clock64() : 0ull;
#define PG8_STAMP() do { if (STAMP && wid == 0 && nts < 64) { const unsigned long long _c = (unsigned long long)clock64(); \
        ts_lo = (lane == nts) ? (int)(unsigned)_c : ts_lo; ts_hi = (lane == nts) ? (int)(unsigned)(_c >> 32) : ts_hi; ++nts; } } while (0)
    PG8_STAMP();
    unsigned voffA[2], voffB[2];
#pragma unroll
    for (int i = 0; i < 2; ++i) { int R, C; stage_rc(tid * 16 + i * 8192, R, C); const int Rb = Epi::PERM ? ((R & ~31) + perm32(R & 31)) : R;
        voffA[i] = (unsigned)(R * K + C) * 2u; voffB[i] = (unsigned)(Rb * K + C) * 2u; }
    const size_t kstep = (size_t)(BK * 2);
    const size_t hstep = (size_t)HALF * K * 2;
    const size_t tstep = 2 * hstep;
    const unsigned ldsw = (unsigned)wid * 1024u;
    const int aoff = lds_byte(wr * 64 + fr, fq * 8), boff = lds_byte(wc * 32 + fr, fq * 8);
#define PG8_SA(b, h) (((b) * 2 + (h)) * HTB)
#define PG8_SB(b, h) ((4 + (b) * 2 + (h)) * HTB)
#define PG8_STAGE(bufoff, gbase, voff) do { _Pragma("unroll") for (int _i = 0; _i < 2; ++_i) \
        __builtin_amdgcn_global_load_lds((const unsigned*)((const char*)(gbase) + (voff)[_i]), (PG8_LAS unsigned*)(lds + (bufoff) + ldsw + _i * 8192), 16, 0, 0); } while (0)
#define PG8_LDA(dst, b, h) do { _Pragma("unroll") for (int m = 0; m < 4; ++m) _Pragma("unroll") for (int k = 0; k < 2; ++k) dst[m][k] = *(const PG8_LAS bf16x8*)(lds + PG8_SA(b, h) + aoff + m * 2048 + k * 1024); } while (0)
#define PG8_LDB(dst, b, h) do { _Pragma("unroll") for (int n = 0; n < 2; ++n) _Pragma("unroll") for (int k = 0; k < 2; ++k) dst[n][k] = *(const PG8_LAS bf16x8*)(lds + PG8_SB(b, h) + boff + n * 2048 + k * 1024); } while (0)
#define PG8_MMA(ai, bj, At, Bt) do { __builtin_amdgcn_s_setprio(1); _Pragma("unroll") for (int m = 0; m < 4; ++m) _Pragma("unroll") for (int n = 0; n < 2; ++n) _Pragma("unroll") for (int k = 0; k < 2; ++k) \
        acc[ai][bj][m][n] = __builtin_amdgcn_mfma_f32_16x16x32_bf16(Bt[n][k], At[m][k], acc[ai][bj][m][n], 0, 0, 0); __builtin_amdgcn_s_setprio(0); } while (0)
#define PG8_WAIT_V(n) asm volatile("s_waitcnt vmcnt(" #n ")" ::: "memory")
#define PG8_WAIT_L(n) asm volatile("s_waitcnt lgkmcnt(" #n ")" ::: "memory")
#define PG8_BAR __builtin_amdgcn_s_barrier()
#define PG8_SCHED __builtin_amdgcn_sched_barrier(0)
    Unit cur, nxt; int ui = 0;
    if (!S.next(0, cur)) return;
    f32x4 acc[2][2][4][2];
#pragma unroll
    for (int a = 0; a < 2; ++a)
#pragma unroll
        for (int b = 0; b < 2; ++b)
#pragma unroll
            for (int m = 0; m < 4; ++m)
#pragma unroll
                for (int n = 0; n < 2; ++n) acc[a][b][m][n] = (f32x4){0.f, 0.f, 0.f, 0.f};
    bf16x8 At[4][2], B0[2][2], B1[2][2];
    const char* cA = S.pa(g, cur); const char* cB = S.pb(g, cur);
    S.a_ready(cur);
    PG8_STAGE(PG8_SB(0, 0), cB, voffB); PG8_STAGE(PG8_SA(0, 0), cA, voffA); PG8_STAGE(PG8_SB(0, 1), cB + hstep, voffB); PG8_STAGE(PG8_SA(0, 1), cA + hstep, voffA);
    if (wr == 1) PG8_BAR;
    PG8_WAIT_V(4); PG8_BAR;
    PG8_STAGE(PG8_SB(1, 0), cB + kstep, voffB); PG8_STAGE(PG8_SA(1, 0), cA + kstep, voffA); PG8_STAGE(PG8_SB(1, 1), cB + hstep + kstep, voffB);
    PG8_WAIT_V(6); PG8_BAR;
    PG8_STAMP();
    for (;;) {
        const bool has_next = S.next(ui + 1, nxt);
        const char* nA = has_next ? S.pa(g, nxt) : cA; const char* nB = has_next ? S.pb(g, nxt) : cB;
        for (int t = 0; t < nt; t += 2) {
            const bool last = (t == nt - 2);
            const char* a1 = cA + (size_t)(t + 1) * kstep;
            const char* a2 = last ? nA : cA + (size_t)(t + 2) * kstep; const char* b2 = last ? nB : cB + (size_t)(t + 2) * kstep;
            const char* a3 = a2 + kstep; const char* b3 = b2 + kstep;
            if (last && has_next) S.a_ready(nxt);
            PG8_LDB(B0, 0, 0); PG8_SCHED; PG8_LDA(At, 0, 0); PG8_STAGE(PG8_SA(1, 1), a1 + hstep, voffA);
            PG8_WAIT_L(8); PG8_BAR; PG8_WAIT_L(0); PG8_MMA(0, 0, At, B0); PG8_BAR; PG8_SCHED;
            PG8_LDB(B1, 0, 1); PG8_STAGE(PG8_SB(0, 0), b2, voffB);
            PG8_BAR; PG8_WAIT_L(0); PG8_MMA(0, 1, At, B1); PG8_BAR;
            PG8_LDA(At, 0, 1); PG8_STAGE(PG8_SA(0, 0), a2, voffA);
            PG8_BAR; PG8_WAIT_L(0); PG8_MMA(1, 0, At, B0); PG8_BAR; PG8_SCHED;
            PG8_STAGE(PG8_SB(0, 1), b2 + hstep, voffB);
            PG8_WAIT_V(6); PG8_BAR; PG8_MMA(1, 1, At, B1); PG8_BAR;
            PG8_LDB(B0, 1, 0); PG8_SCHED; PG8_LDA(At, 1, 0); PG8_STAGE(PG8_SA(0, 1), a2 + hstep, voffA);
            PG8_WAIT_L(8); PG8_BAR; PG8_WAIT_L(0); PG8_MMA(0, 0, At, B0); PG8_BAR; PG8_SCHED;
            PG8_LDB(B1, 1, 1); PG8_STAGE(PG8_SB(1, 0), b3, voffB);
            PG8_BAR; PG8_WAIT_L(0); PG8_MMA(0, 1, At, B1); PG8_BAR;
            PG8_LDA(At, 1, 1); PG8_STAGE(PG8_SA(1, 0), a3, voffA);
            PG8_BAR; PG8_WAIT_L(0); PG8_MMA(1, 0, At, B0); PG8_BAR; PG8_SCHED;
            PG8_STAGE(PG8_SB(1, 1), b3 + hstep, voffB);
            PG8_WAIT_V(6); PG8_BAR; PG8_MMA(1, 1, At, B1); PG8_BAR;
        }
        PG8_STAMP();
        if constexpr (!Epi::AFTER_DRAIN) { E(acc, cur, wr, wc, fr, fq); S.done(cur); }
        PG8_STAMP();
        if (!has_next) break;
#pragma unroll
        for (int a = 0; a < 2; ++a)
#pragma unroll
            for (int b = 0; b < 2; ++b)
#pragma unroll
                for (int m = 0; m < 4; ++m)
#pragma unroll
                    for (int n = 0; n < 2; ++n) acc[a][b][m][n] = (f32x4){0.f, 0.f, 0.f, 0.f};
        cur = nxt; cA = nA; cB = nB; ++ui;
    }
    PG8_WAIT_V(0);
    if (wr == 0) PG8_BAR;
    PG8_BAR;
    if constexpr (Epi::AFTER_DRAIN) { E.fused(acc, cur, wr, wc, fr, fq, lds, wid, lane); S.done(cur); }
    PG8_STAMP();
    if (STAMP && wid == 0) { stamps[lane] = lane < nts ? (((unsigned long long)(unsigned)ts_hi << 32) | (unsigned)ts_lo) : 0ull;
        if (lane == 62) stamps[62] = rt_entry; if (lane == 63) stamps[63] = (unsigned long long)wall_clock64(); }
#undef PG8_STAMP
#undef PG8_SA
#undef PG8_SB
#undef PG8_STAGE
#undef PG8_LDA
#undef PG8_LDB
#undef PG8_MMA
#undef PG8_WAIT_V
#undef PG8_WAIT_L
#undef PG8_BAR
#undef PG8_SCHED
}
}

typedef unsigned short bf16_t;
__device__ __forceinline__ float wave_sum(float v) {
#pragma unroll
    for (int o = 32; o; o >>= 1) v += __shfl_xor(v, o);
    return v;
}
__device__ __forceinline__ float block_sum(float v, float* red) {
    v = wave_sum(v);
    __syncthreads();
    if ((threadIdx.x & 63) == 0) red[threadIdx.x >> 6] = v;
    __syncthreads();
    float s = 0.f;
#pragma unroll
    for (int i = 0; i < NWAVES; ++i) s += red[i];
    return s;
}
__device__ __forceinline__ int opaque_tid() { int t = threadIdx.x; asm volatile("" : "+v"(t)); return t; }
typedef float nt_f32x4 __attribute__((ext_vector_type(4)));
__device__ __forceinline__ float4 nt_load4(const float* p) { const nt_f32x4 v = __builtin_nontemporal_load((const nt_f32x4*)p); return make_float4(v[0], v[1], v[2], v[3]); }
typedef unsigned nt_u32x4 __attribute__((ext_vector_type(4)));
typedef unsigned nt_u32x2 __attribute__((ext_vector_type(2)));
__device__ __forceinline__ uint4 nt_load4u(const void* p) { const nt_u32x4 v = __builtin_nontemporal_load((const nt_u32x4*)p); return make_uint4(v[0], v[1], v[2], v[3]); }
__device__ __forceinline__ uint2 nt_load2u(const void* p) { const nt_u32x2 v = __builtin_nontemporal_load((const nt_u32x2*)p); return make_uint2(v[0], v[1]); }
__device__ __forceinline__ void nt_store4(float* p, float a, float b, float c, float d) { nt_f32x4 v = {a, b, c, d}; __builtin_nontemporal_store(v, (nt_f32x4*)p); }
__device__ __forceinline__ void nt_store4u(void* p, uint4 v) { nt_u32x4 w = {v.x, v.y, v.z, v.w}; __builtin_nontemporal_store(w, (nt_u32x4*)p); }
__device__ __forceinline__ void nt_store2u(void* p, uint2 v) { nt_u32x2 w = {v.x, v.y}; __builtin_nontemporal_store(w, (nt_u32x2*)p); }
__device__ __forceinline__ float silu(float x) { return x / (1.0f + expf(-x)); }


__device__ __forceinline__ unsigned pk_bf16(float lo, float hi) { unsigned r; asm volatile("v_cvt_pk_bf16_f32 %0, %1, %2" : "=v"(r) : "v"(lo), "v"(hi)); return r; }
__device__ __forceinline__ void transpose_convert(const float* __restrict__ W, bf16_t* __restrict__ Wt, int K, int N, float* lds, int wb0, int nwb) {
    const int tid = opaque_tid();
    const int tk = K / 64, tn = N / 256;
    for (int tile = (int)blockIdx.x - wb0; tile < tk * tn; tile += nwb) {
        const int k0 = (tile / tn) * 64, n0 = (tile % tn) * 256;
        __syncthreads();
        float4 v[8];
#pragma unroll
        for (int i = 0; i < 8; ++i) v[i] = nt_load4(W + (size_t)(k0 + (tid >> 6) + 8 * i) * N + n0 + (tid & 63) * 4);
#pragma unroll
        for (int i = 0; i < 8; ++i) { float* d = lds + ((tid >> 6) + 8 * i) * 257 + (tid & 63) * 4; d[0] = v[i].x; d[1] = v[i].y; d[2] = v[i].z; d[3] = v[i].w; }
        __syncthreads();
#pragma unroll
        for (int q = 0; q < 4; ++q) {
            const int c = q * NTHREADS + tid, n = c >> 3, k8 = (c & 7) * 8;
            uint4 o;
            o.x = pk_bf16(lds[(k8 + 0) * 257 + n], lds[(k8 + 1) * 257 + n]); o.y = pk_bf16(lds[(k8 + 2) * 257 + n], lds[(k8 + 3) * 257 + n]);
            o.z = pk_bf16(lds[(k8 + 4) * 257 + n], lds[(k8 + 5) * 257 + n]); o.w = pk_bf16(lds[(k8 + 6) * 257 + n], lds[(k8 + 7) * 257 + n]);
            *(uint4*)(Wt + (size_t)(n0 + n) * K + k0 + k8) = o;
        }
    }
}
__device__ __forceinline__ float wave_max(float v) {
#pragma unroll
    for (int o = 32; o; o >>= 1) v = fmaxf(v, __shfl_xor(v, o));
    return v;
}
__device__ __forceinline__ float block_max(float v, float* red) {
    v = wave_max(v);
    __syncthreads();
    if ((threadIdx.x & 63) == 0) red[threadIdx.x >> 6] = v;
    __syncthreads();
    float s = red[0];
#pragma unroll
    for (int i = 1; i < NWAVES; ++i) s = fmaxf(s, red[i]);
    return s;
}
__device__ __forceinline__ unsigned q4(float a, float b, float c, float d, float inv, int off) {
    const int x = __float2int_rn(a * inv) + off, y = __float2int_rn(b * inv) + off, z = __float2int_rn(c * inv) + off, w = __float2int_rn(d * inv) + off;
    return (unsigned)(x & 255) | ((unsigned)(y & 255) << 8) | ((unsigned)(z & 255) << 16) | ((unsigned)(w & 255) << 24);
}
constexpr int UROW = 1024;
template <int O> __device__ __forceinline__ unsigned nibh8(const float (&x)[16], float inv) {
    unsigned r = 0;
#pragma unroll
    for (int i = 0; i < 8; ++i) r |= (unsigned)min(max((int)floorf(x[O + i] * inv) + 8, 0), 15) << (4 * i);
    return r;
}
__device__ __forceinline__ void quant_tables(const Params& p, int wb0, int nwb) {
    const int tid = opaque_tid(), lane = tid & 63, wv = tid >> 6;
    unsigned char* tq = (unsigned char*)p.ws + B_TQ; float* rsc = p.ws + W_SU;
    const int nw = nwb * NWAVES;
    for (int row0 = ((int)blockIdx.x - wb0) * NWAVES + wv; row0 < 2 * 16384; row0 += 2 * nw) {
        float x[2][2][16]; float mx[2][2];
#pragma unroll
        for (int u = 0; u < 2; ++u) {
            const int row = min(row0 + u * nw, 2 * 16384 - 1);
            const float* src = (row < 16384 ? p.in[I_PU] : p.in[I_PV]) + (size_t)(row & 16383) * D + lane * 4;
#pragma unroll
            for (int h = 0; h < 2; ++h) {
                mx[u][h] = 0.f;
#pragma unroll
                for (int q = 0; q < 4; ++q) { const float4 v = nt_load4(src + (h * 4 + q) * 256); x[u][h][q * 4] = v.x; x[u][h][q * 4 + 1] = v.y; x[u][h][q * 4 + 2] = v.z; x[u][h][q * 4 + 3] = v.w;
                    mx[u][h] = fmaxf(mx[u][h], fmaxf(fmaxf(fabsf(v.x), fabsf(v.y)), fmaxf(fabsf(v.z), fabsf(v.w)))); }
            }
        }
#pragma unroll
        for (int u = 0; u < 2; ++u) {
            const int row = row0 + u * nw;
            if (row < 2 * 16384) {
                const float rmx = wave_max(fmaxf(mx[u][0], mx[u][1]));
                {
                    float ss = 0.f;
#pragma unroll
                    for (int h = 0; h < 2; ++h)
#pragma unroll
                        for (int i = 0; i < 16; ++i) ss += x[u][h][i] * x[u][h][i];
                    const float rms = sqrtf(wave_sum(ss) * (1.0f / 2048.0f));
                    if (row >= 16384) {
                        const float cl = fminf(rmx, 2.94f * rms);
                        const float Rv = cl > 0.f ? cl * (1.0f / 6.0f) : 1.0f, iv = 1.0f / Rv;
                        unsigned w4[4];
#pragma unroll
                        for (int q = 0; q < 4; ++q) {
                            const float* xs = &x[u][q >> 1][(q & 1) * 8];
                            unsigned r = 0u;
                            r = __builtin_amdgcn_cvt_scalef32_pk_fp4_f32(r, xs[0] * iv, xs[1] * iv, 1.0f, 0);
                            r = __builtin_amdgcn_cvt_scalef32_pk_fp4_f32(r, xs[2] * iv, xs[3] * iv, 1.0f, 1);
                            r = __builtin_amdgcn_cvt_scalef32_pk_fp4_f32(r, xs[4] * iv, xs[5] * iv, 1.0f, 2);
                            r = __builtin_amdgcn_cvt_scalef32_pk_fp4_f32(r, xs[6] * iv, xs[7] * iv, 1.0f, 3);
                            w4[q] = r;
                        }
                        nt_store4u(tq + (size_t)row * UROW + lane * 16, make_uint4(w4[0], w4[1], w4[2], w4[3]));
                        if (lane == 0) rsc[row] = Rv;
                        continue;
                    }
                    const float clipv = fminf(rmx, 2.5125f * rms);
                    const float Ru = clipv > 0.f ? clipv * (1.0f / 7.5f) : 1.0f, iu = 1.0f / Ru;
                    nt_store4u(tq + (size_t)row * UROW + lane * 16, make_uint4(nibh8<0>(x[u][0], iu), nibh8<8>(x[u][0], iu), nibh8<0>(x[u][1], iu), nibh8<8>(x[u][1], iu)));
                    if (lane == 0) rsc[row] = Ru;
                }
            }
        }
    }
}

__device__ __forceinline__ void naive_gemm(const float* __restrict__ A, int lda, const float* __restrict__ Bm, int ldb,
                                           float* __restrict__ C, int ldc, int M, int N, int K, float* lds) {
    float* As = lds;
    float* Bs = lds + 16 * 132;
    const int tid = opaque_tid(), tx = tid & 31, ty = tid >> 5;
    const int tilesN = N / 128, ntiles = (M / 128) * tilesN;
    for (int tile = blockIdx.x; tile < ntiles; tile += gridDim.x) {
        const int m0 = (tile / tilesN) * 128, n0 = (tile % tilesN) * 128;
        float acc[8][4];
#pragma unroll
        for (int i = 0; i < 8; ++i)
#pragma unroll
            for (int j = 0; j < 4; ++j) acc[i][j] = 0.f;
        for (int k0 = 0; k0 < K; k0 += 16) {
            {
                const int row = tid >> 2, kq = (tid & 3) * 4;
                const float4 a = *(const float4*)(A + (size_t)(m0 + row) * lda + k0 + kq);
                As[(kq + 0) * 132 + row] = a.x; As[(kq + 1) * 132 + row] = a.y; As[(kq + 2) * 132 + row] = a.z; As[(kq + 3) * 132 + row] = a.w;
                const int kk = tid >> 5, n4 = (tid & 31) * 4;
                *(float4*)(Bs + kk * 128 + n4) = *(const float4*)(Bm + (size_t)(k0 + kk) * ldb + n0 + n4);
            }
            __syncthreads();
#pragma unroll 4
            for (int k = 0; k < 16; ++k) {
                const float4 a0 = *(const float4*)(As + k * 132 + ty * 8), a1 = *(const float4*)(As + k * 132 + ty * 8 + 4);
                const float4 b = *(const float4*)(Bs + k * 128 + tx * 4);
                const float av[8] = {a0.x, a0.y, a0.z, a0.w, a1.x, a1.y, a1.z, a1.w};
                const float bv[4] = {b.x, b.y, b.z, b.w};
#pragma unroll
                for (int i = 0; i < 8; ++i)
#pragma unroll
                    for (int j = 0; j < 4; ++j) acc[i][j] += av[i] * bv[j];
            }
            __syncthreads();
        }
#pragma unroll
        for (int i = 0; i < 8; ++i)
            *(float4*)(C + (size_t)(m0 + ty * 8 + i) * ldc + n0 + tx * 4) = make_float4(acc[i][0], acc[i][1], acc[i][2], acc[i][3]);
    }
}

__device__ __forceinline__ void phase_a(const Params& p, float* lds) {
    const int tid = opaque_tid();
    const float* c = p.in[I_C]; const float* cctx = p.in[I_CCTX]; const float* wada = p.in[I_WADA];
    float* part = p.ws + W_ADAP;
    for (int item = blockIdx.x; item < 32 * 24; item += gridDim.x) {
        const int ks = item / 24, j = (item % 24) * 512 + tid;
        __syncthreads();
        if (tid < 5 * 64) { const int n = tid >> 6, k = ks * 64 + (tid & 63); lds[tid] = silu(n < 4 ? c[n * 2048 + k] : cctx[k]); }
        __syncthreads();
        float a0 = 0.f, a1 = 0.f, a2 = 0.f, a3 = 0.f, a4 = 0.f;
#pragma unroll 32
        for (int kk = 0; kk < 64; ++kk) {
            const float w = __builtin_nontemporal_load(wada + (size_t)(ks * 64 + kk) * 12288 + j);
            a0 += lds[kk] * w; a1 += lds[64 + kk] * w; a2 += lds[128 + kk] * w; a3 += lds[192 + kk] * w; a4 += lds[256 + kk] * w;
        }
        part[(size_t)(ks * 5 + 0) * 12288 + j] = a0; part[(size_t)(ks * 5 + 1) * 12288 + j] = a1; part[(size_t)(ks * 5 + 2) * 12288 + j] = a2;
        part[(size_t)(ks * 5 + 3) * 12288 + j] = a3; part[(size_t)(ks * 5 + 4) * 12288 + j] = a4;
    }
}
typedef short bf16x8v __attribute__((ext_vector_type(8)));
typedef float f32x4v __attribute__((ext_vector_type(4)));
typedef float f32x16v __attribute__((ext_vector_type(16)));
__device__ __forceinline__ void phase_filters(const Params& p, float* lds) {
    const int tid = opaque_tid();
    const float* w1 = p.in[I_FW1]; const float* b1 = p.in[I_FB1]; const float* w2 = p.in[I_FW2]; const float* b2 = p.in[I_FB2];
    const float* w3 = p.in[I_FW3]; const float* b3 = p.in[I_FB3]; const float* w4 = p.in[I_FW4]; const float* freq = p.in[I_FREQ];
    float* hT = (float*)((char*)p.ws + B_KF); float* sp = p.ws + W_SP;
    float* zf = lds; float* ha = lds + 64 * 36; float* hb = ha + 64 * 68; float* red2 = hb + 64 * 68;
    float* W1 = red2 + 256; float* W2 = W1 + 33 * 64; float* W3 = W2 + 64 * 64;
    __syncthreads();
    for (int e = tid; e < 33 * 64; e += NTHREADS) W1[e] = w1[e];
    for (int e = tid; e < 64 * 64; e += NTHREADS) { W2[e] = w2[e]; W3[e] = w3[e]; }
    for (int item = blockIdx.x; item < 256; item += gridDim.x) {
        const int pt = item >> 3;
        __syncthreads();
        for (int e = tid; e < 64 * 33; e += NTHREADS) {
            const int pos = e / 33, m = e % 33, i = pt * 64 + pos;
            const float t = (float)i / 2047.0f, w = 6.283185307179586f * (float)i / 2048.0f;
            float v;
            if (m == 0) v = t;
            else if (m <= 16) { const float f = 1e-4f + (float)(m - 1) * ((15.0f - 1e-4f) / 15.0f); v = __cosf(f * w); }
            else { const float f = 1e-4f + (float)(m - 17) * ((15.0f - 1e-4f) / 15.0f); v = -__sinf(f * w); }
            zf[pos * 36 + m] = v;
        }
        __syncthreads();
        const int pos = tid >> 3, u0 = (tid & 7) * 8;
        {
            float a[8];
#pragma unroll
            for (int u = 0; u < 8; ++u) a[u] = b1[u0 + u];
#pragma unroll 11
            for (int m = 0; m < 33; ++m) { const float zv = zf[pos * 36 + m]; const float4 wa = *(const float4*)(W1 + m * 64 + u0), wb = *(const float4*)(W1 + m * 64 + u0 + 4);
                a[0] += zv * wa.x; a[1] += zv * wa.y; a[2] += zv * wa.z; a[3] += zv * wa.w; a[4] += zv * wb.x; a[5] += zv * wb.y; a[6] += zv * wb.z; a[7] += zv * wb.w; }
#pragma unroll
            for (int u = 0; u < 8; ++u) ha[pos * 68 + u0 + u] = __sinf(freq[u0 + u] * a[u]);
        }
        __syncthreads();
        {
            float a[8];
#pragma unroll
            for (int u = 0; u < 8; ++u) a[u] = b2[u0 + u];
#pragma unroll 16
            for (int m = 0; m < 64; ++m) { const float zv = ha[pos * 68 + m]; const float4 wa = *(const float4*)(W2 + m * 64 + u0), wb = *(const float4*)(W2 + m * 64 + u0 + 4);
                a[0] += zv * wa.x; a[1] += zv * wa.y; a[2] += zv * wa.z; a[3] += zv * wa.w; a[4] += zv * wb.x; a[5] += zv * wb.y; a[6] += zv * wb.z; a[7] += zv * wb.w; }
#pragma unroll
            for (int u = 0; u < 8; ++u) hb[pos * 68 + u0 + u] = __sinf(freq[64 + u0 + u] * a[u]);
        }
        __syncthreads();
        {
            float a[8];
#pragma unroll
            for (int u = 0; u < 8; ++u) a[u] = b3[u0 + u];
#pragma unroll 16
            for (int m = 0; m < 64; ++m) { const float zv = hb[pos * 68 + m]; const float4 wa = *(const float4*)(W3 + m * 64 + u0), wb = *(const float4*)(W3 + m * 64 + u0 + 4);
                a[0] += zv * wa.x; a[1] += zv * wa.y; a[2] += zv * wa.z; a[3] += zv * wa.w; a[4] += zv * wb.x; a[5] += zv * wb.y; a[6] += zv * wb.z; a[7] += zv * wb.w; }
#pragma unroll
            for (int u = 0; u < 8; ++u) ha[pos * 68 + u0 + u] = __sinf(freq[128 + u0 + u] * a[u]);
        }
        __syncthreads();
#pragma unroll 1
        for (int jt = (item & 7) * 2; jt < (item & 7) * 2 + 2; ++jt) {
            const int lane = tid & 63, wv = tid >> 6, cl = lane & 15, g = lane >> 4;
            union frag { unsigned u[4]; bf16x8v v; };
            frag af[2][2];
#pragma unroll
            for (int mt = 0; mt < 2; ++mt)
#pragma unroll
                for (int ks = 0; ks < 2; ++ks) {
                    const float* wp = w4 + (size_t)(ks * 32 + 8 * g) * 4096 + jt * 256 + wv * 32 + mt * 16 + cl;
                    float x[8];
#pragma unroll
                    for (int i = 0; i < 8; ++i) x[i] = wp[(size_t)i * 4096];
                    af[mt][ks].u[0] = pk_bf16(x[0], x[1]); af[mt][ks].u[1] = pk_bf16(x[2], x[3]); af[mt][ks].u[2] = pk_bf16(x[4], x[5]); af[mt][ks].u[3] = pk_bf16(x[6], x[7]);
                }
            f32x4v acc[2][4];
#pragma unroll
            for (int mt = 0; mt < 2; ++mt)
#pragma unroll
                for (int nt = 0; nt < 4; ++nt) acc[mt][nt] = (f32x4v){0.f, 0.f, 0.f, 0.f};
#pragma unroll
            for (int nt = 0; nt < 4; ++nt)
#pragma unroll
                for (int ks = 0; ks < 2; ++ks) {
                    const float4 h0 = *(const float4*)(ha + (nt * 16 + cl) * 68 + ks * 32 + 8 * g), h1 = *(const float4*)(ha + (nt * 16 + cl) * 68 + ks * 32 + 8 * g + 4);
                    frag bf; bf.u[0] = pk_bf16(h0.x, h0.y); bf.u[1] = pk_bf16(h0.z, h0.w); bf.u[2] = pk_bf16(h1.x, h1.y); bf.u[3] = pk_bf16(h1.z, h1.w);
#pragma unroll
                    for (int mt = 0; mt < 2; ++mt) acc[mt][nt] = __builtin_amdgcn_mfma_f32_16x16x32_bf16(af[mt][ks].v, bf.v, acc[mt][nt], 0, 0, 0);
                }
#pragma unroll
            for (int mt = 0; mt < 2; ++mt)
#pragma unroll
                for (int r = 0; r < 4; ++r) {
                    const int j = jt * 256 + wv * 32 + mt * 16 + 4 * g + r;
                    const float delta = 3.070113457f + (float)(j & 1023) * ((15.35056729f - 3.070113457f) / 1023.0f);
                    float asum = 0.f;
#pragma unroll
                    for (int nt = 0; nt < 4; ++nt) {
                        const int ps = pt * 64 + nt * 16 + cl;
                        const float val = acc[mt][nt][r] * __expf(-((float)ps / 2047.0f) * delta);
                        asum += fabsf(val);
                        __builtin_nontemporal_store(val, hT + (size_t)j * SL + ps);
                    }
                    asum += __shfl_xor(asum, 1); asum += __shfl_xor(asum, 2); asum += __shfl_xor(asum, 4); asum += __shfl_xor(asum, 8);
                    if (cl == 0) sp[(size_t)pt * 4096 + j] = asum;
                }
        }
    }
}

__device__ __forceinline__ void phase_b(const Params& p) {
    const int tid = opaque_tid();
    const float* part = p.ws + W_ADAP; float* ada = p.ws + W_ADA; const float* bada = p.in[I_BADA];
    for (int e = blockIdx.x * NTHREADS + tid; e < 5 * 12288; e += gridDim.x * NTHREADS) {
        float s = bada[e % 12288];
#pragma unroll 8
        for (int ks = 0; ks < 32; ++ks) s += part[(size_t)ks * 5 * 12288 + e];
        ada[e] = s;
    }
    const float* sp = p.ws + W_SP; float* fs = p.ws + W_FS;
    for (int j = blockIdx.x * NTHREADS + tid; j < 4096; j += gridDim.x * NTHREADS) {
        float s = 0.f;
#pragma unroll 8
        for (int pt = 0; pt < 32; ++pt) s += sp[(size_t)pt * 4096 + j];
        fs[j] = s;
    }
}

__device__ __forceinline__ void phase_c(const Params& p) {
    const int tid = opaque_tid();
    const float* ada = p.ws + W_ADA;
    const float* x = p.in[I_X]; bf16_t* ub = (bf16_t*)((char*)p.ws + B_UB);
    for (size_t e = (size_t)blockIdx.x * NTHREADS + tid; e < (size_t)NT * D / 4; e += (size_t)gridDim.x * NTHREADS) {
        const size_t row = e / (D / 4); const int col = (int)(e % (D / 4)) * 4; const int b = (int)(row / SL);
        const float4 xv = nt_load4(x + row * D + col);
        const float4 sh = *(const float4*)(ada + b * 12288 + col), sc = *(const float4*)(ada + b * 12288 + 2048 + col);
        uint2 o; o.x = pk_bf16(xv.x * (1.f + sc.x) + sh.x, xv.y * (1.f + sc.y) + sh.y); o.y = pk_bf16(xv.z * (1.f + sc.z) + sh.z, xv.w * (1.f + sc.w) + sh.w);
        *(uint2*)(ub + row * D + col) = o;
    }
    const float* ctx = p.in[I_CTX]; bf16_t* ucb = ub + (size_t)NT * D;
    for (size_t e = (size_t)blockIdx.x * NTHREADS + tid; e < (size_t)NTC * D / 4; e += (size_t)gridDim.x * NTHREADS) {
        const size_t row = e / (D / 4); const int col = (int)(e % (D / 4)) * 4;
        const float4 xv = nt_load4(ctx + row * D + col);
        const float4 sh = *(const float4*)(ada + 4 * 12288 + col), sc = *(const float4*)(ada + 4 * 12288 + 2048 + col);
        uint2 o; o.x = pk_bf16(xv.x * (1.f + sc.x) + sh.x, xv.y * (1.f + sc.y) + sh.y); o.y = pk_bf16(xv.z * (1.f + sc.z) + sh.z, xv.w * (1.f + sc.w) + sh.w);
        *(uint2*)(ucb + row * D + col) = o;
    }
}

__device__ __forceinline__ float bf2f(bf16_t v) { return __uint_as_float(((unsigned)v) << 16); }
constexpr int HY_PB = 4416, HY_PJ = 272, HY_R0 = 4 * HY_PB, HY_R1 = HY_R0 + 8192 + 64, HY_SLOT = HY_R1 + 8192 + 64;
static_assert(HY_SLOT % 16 == 0 && 4 * HY_SLOT + 64 <= 155 * 1024, "hyena LDS");
__device__ __forceinline__ bf16x8v hy_lda(const unsigned char* base, int off) {
    const unsigned* q = (const unsigned*)(base + off);
    union { unsigned u[4]; bf16x8v v; } r; r.u[0] = q[0]; r.u[1] = q[1]; r.u[2] = q[2]; r.u[3] = q[3];
    return r.v;
}
__device__ __forceinline__ void hy_stage_rows(const bf16_t* zT, const float* cw, const float* cb, int ch, int half, int lane, unsigned char* sl) {
    const float w0 = cw[ch], w1 = cw[3072 + ch], w2 = cw[6144 + ch], bs = cb[ch];
#pragma unroll 4
    for (int q = 0; q < 8; ++q) {
        const int bsel = 2 * half + (q >> 2), t0 = ((q & 3) * 64 + lane) * 8;
        const bf16_t* zrow = zT + (size_t)ch * NT + bsel * SL;
        const uint4 raw = nt_load4u(zrow + t0);
        float z[10];
        z[0] = t0 > 0 ? bf2f(zrow[t0 - 1]) : 0.f; z[9] = t0 + 8 < SL ? bf2f(zrow[t0 + 8]) : 0.f;
        z[1] = __uint_as_float(raw.x << 16); z[2] = __uint_as_float(raw.x & 0xffff0000u); z[3] = __uint_as_float(raw.y << 16); z[4] = __uint_as_float(raw.y & 0xffff0000u);
        z[5] = __uint_as_float(raw.z << 16); z[6] = __uint_as_float(raw.z & 0xffff0000u); z[7] = __uint_as_float(raw.w << 16); z[8] = __uint_as_float(raw.w & 0xffff0000u);
        float sv[8];
#pragma unroll
        for (int i = 0; i < 8; ++i) sv[i] = w0 * z[i] + w1 * z[i + 1] + w2 * z[i + 2] + bs;
        uint4 o; o.x = pk_bf16(sv[0], sv[1]); o.y = pk_bf16(sv[2], sv[3]); o.z = pk_bf16(sv[4], sv[5]); o.w = pk_bf16(sv[6], sv[7]);
        *(uint4*)(sl + bsel * HY_PB + (t0 >> 7) * HY_PJ + (t0 & 127) * 2) = o;
    }
}
__device__ __forceinline__ void hy_pair_sync(volatile __attribute__((address_space(3))) unsigned* fl, int wv, unsigned n) {
    asm volatile("s_waitcnt lgkmcnt(0)" ::: "memory");
    fl[wv] = n;
    while (fl[wv ^ 1] < n) __builtin_amdgcn_s_sleep(0);
    asm volatile("" ::: "memory");
}
__device__ __forceinline__ void phase_hyena(const Params& p, unsigned char* smem) {
    const int tid = opaque_tid(), lane = tid & 63, wv = tid >> 6, slot = wv >> 1, half = wv & 1, pt = tid & 127;
    const bf16_t* zT = (const bf16_t*)((const char*)p.ws + B_ZT); const float* hT = (const float*)((const char*)p.ws + B_KF); const float* fs = p.ws + W_FS; bf16_t* hyT = (bf16_t*)((char*)p.ws + B_HYT);
    const float* cw = p.in[I_CONVW]; const float* cb = p.in[I_CONVB]; const float* skip = p.in[I_SKIP];
    unsigned char* sl = smem + slot * HY_SLOT;
    const int a_ = lane & 31, hh = lane >> 5, i_local = a_ >> 2, batch = a_ & 3, I0 = 8 * half;
    const int laneA = ((a_ & 1) ? HY_R0 : HY_R1) + 2 * (2047 - a_ - (1 - (a_ & 1)) + 8 * hh);
    volatile __attribute__((address_space(3))) unsigned* fl = (volatile __attribute__((address_space(3))) unsigned*)(smem + 4 * HY_SLOT);
    unsigned seq = 0u;
    __syncthreads();
    if (tid < 8) fl[tid] = 0u;
    if (wv < 4) __builtin_amdgcn_s_setprio(2);
    for (int item = blockIdx.x; item < DHY / 4; item += gridDim.x) {
        const int c = item * 4 + slot;
        __syncthreads();
        hy_stage_rows(zT, cw, cb, c, half, lane, sl);
#pragma unroll 1
        for (int ord = 0; ord < 2; ++ord) {
            {
                const float* hf = hT + (size_t)((ord * 2 + 0) * 1024 + c) * SL; const float* hbk = hT + (size_t)((ord * 2 + 1) * 1024 + c) * SL;
                const float sk = skip[ord * 1024 + c]; const float invs = 1.0f / (fs[(ord * 2 + 0) * 1024 + c] + fs[(ord * 2 + 1) * 1024 + c]);
#pragma unroll
                for (int q = 0; q < 4; ++q) {
                    const int X0 = (q * 128 + pt) * 8;
                    float rv[9];
#pragma unroll
                    for (int i = 0; i < 9; ++i) { const int dp = 2047 - X0 - i; rv[i] = (dp >= 0 ? __builtin_nontemporal_load(hf + dp) : (dp >= -2047 ? __builtin_nontemporal_load(hbk - dp) : 0.f)) * invs; if (dp == 0) rv[i] += sk; }
                    uint4 o0, o1;
                    o0.x = pk_bf16(rv[0], rv[1]); o0.y = pk_bf16(rv[2], rv[3]); o0.z = pk_bf16(rv[4], rv[5]); o0.w = pk_bf16(rv[6], rv[7]);
                    o1.x = pk_bf16(rv[1], rv[2]); o1.y = pk_bf16(rv[3], rv[4]); o1.z = pk_bf16(rv[5], rv[6]); o1.w = pk_bf16(rv[7], rv[8]);
                    *(uint4*)(sl + HY_R0 + X0 * 2) = o0; *(uint4*)(sl + HY_R1 + X0 * 2) = o1;
                }
            }
            hy_pair_sync(fl, wv, ++seq);
            f32x16v acc[4];
#pragma unroll
            for (int mb = 0; mb < 4; ++mb)
#pragma unroll
                for (int e = 0; e < 16; ++e) acc[mb][e] = 0.f;
            {
                const int dlo = I0 - 15, dhi = I0 + 7;
                bf16x8v As[7][2];
#pragma unroll
                for (int s2 = 0; s2 < 3; ++s2)
#pragma unroll
                    for (int k2 = 0; k2 < 2; ++k2) As[4 + s2][k2] = hy_lda(sl, laneA - 64 * (4 * dlo - 3 + s2) + 32 * k2);
#pragma unroll 1
                for (int d = dlo; d <= dhi; ++d) {
#pragma unroll
                    for (int k2 = 0; k2 < 2; ++k2) { As[0][k2] = As[4][k2]; As[1][k2] = As[5][k2]; As[2][k2] = As[6][k2]; }
#pragma unroll
                    for (int s2 = 3; s2 < 7; ++s2)
#pragma unroll
                        for (int k2 = 0; k2 < 2; ++k2) As[s2][k2] = hy_lda(sl, laneA - 64 * (4 * d - 3 + s2) + 32 * k2);
                    const int jl = I0 + i_local - d; const bool valid = (unsigned)jl < 16u;
                    const unsigned char* bp = sl + batch * HY_PB + (valid ? jl : 0) * HY_PJ + hh * 16;
                    bf16x8v Bq[8];
#pragma unroll
                    for (int q = 0; q < 8; ++q) { const bf16x8v v = *(const bf16x8v*)(bp + q * 32); const bf16x8v zero = {0, 0, 0, 0, 0, 0, 0, 0}; Bq[q] = valid ? v : zero; }
#pragma unroll
                    for (int kb = 0; kb < 4; ++kb)
#pragma unroll
                        for (int k2 = 0; k2 < 2; ++k2)
#pragma unroll
                            for (int mb = 0; mb < 4; ++mb) acc[mb] = __builtin_amdgcn_mfma_f32_32x32x16_bf16(As[mb - kb + 3][k2], Bq[2 * kb + k2], acc[mb], 0, 0, 0);
                }
            }
            hy_pair_sync(fl, wv, ++seq);
            hy_stage_rows(zT, cw, cb, (ord == 0 ? 1024 : 2048) + c, half, lane, sl);
            hy_pair_sync(fl, wv, ++seq);
            {
#pragma unroll
                for (int mb = 0; mb < 4; ++mb)
#pragma unroll
                    for (int q4 = 0; q4 < 4; ++q4) {
                        const int t4 = 128 * (I0 + i_local) + 32 * mb + 8 * q4 + 4 * hh;
                        uint2* gp = (uint2*)(sl + batch * HY_PB + (t4 >> 7) * HY_PJ + (t4 & 127) * 2);
                        const uint2 gv = *gp;
                        uint2 o; o.x = pk_bf16(__uint_as_float(gv.x << 16) * acc[mb][q4 * 4 + 0], __uint_as_float(gv.x & 0xffff0000u) * acc[mb][q4 * 4 + 1]);
                        o.y = pk_bf16(__uint_as_float(gv.y << 16) * acc[mb][q4 * 4 + 2], __uint_as_float(gv.y & 0xffff0000u) * acc[mb][q4 * 4 + 3]);
                        *gp = o;
                    }
            }
            if (ord == 1) {
                hy_pair_sync(fl, wv, ++seq);
#pragma unroll
                for (int q = 0; q < 8; ++q) {
                    const int bsel = 2 * half + (q >> 2), t0 = ((q & 3) * 64 + lane) * 8;
                    nt_store4u(hyT + (size_t)c * NT + bsel * SL + t0, *(const uint4*)(sl + bsel * HY_PB + (t0 >> 7) * HY_PJ + (t0 & 127) * 2));
                }
            }
        }
    }
    __builtin_amdgcn_s_setprio(0);
}

__device__ __forceinline__ bf16x8v pack_p(const f32x4v& lo, const f32x4v& hi) {
    union { unsigned u[4]; bf16x8v v; } r;
    r.u[0] = pk_bf16(lo[0], lo[1]); r.u[1] = pk_bf16(lo[2], lo[3]); r.u[2] = pk_bf16(hi[0], hi[1]); r.u[3] = pk_bf16(hi[2], hi[3]);
    return r.v;
}
__device__ __forceinline__ bf16x8v ld_pair8(const bf16_t* lo, const bf16_t* hi) {
    union { uint2 d[2]; bf16x8v v; } r;
    r.d[0] = *(const uint2*)lo; r.d[1] = *(const uint2*)hi;
    return r.v;
}
typedef __attribute__((address_space(3))) const bf16_t* lds_bf16p;
#define LDS_FRAG(pe) (*(const __attribute__((address_space(3))) bf16x8v*)(pe))
constexpr int NA_KC = 0, NA_VC = 32768, NA_KL = 65536, NA_RPB = 155648;
__device__ __forceinline__ void phase_na(const Params& p, unsigned char* smem) {
    const int tid = opaque_tid(), lane = tid & 63, wv = tid >> 6, ql = lane & 15, g = lane >> 4;
    const bf16_t* qh = (const bf16_t*)((const char*)p.ws + B_QH); const bf16_t* kh = (const bf16_t*)((const char*)p.ws + B_KH);
    const bf16_t* kch = (const bf16_t*)((const char*)p.ws + B_KCH); const bf16_t* vT = (const bf16_t*)((const char*)p.ws + B_VT);
    const bf16_t* vcT = (const bf16_t*)((const char*)p.ws + B_VCT); bf16_t* na = (bf16_t*)((char*)p.ws + B_NA);
    const float* rpb = p.in[I_RPB];
    const lds_bf16p kcl = (lds_bf16p)((__attribute__((address_space(3))) unsigned char*)smem + NA_KC);
    const lds_bf16p vcl = (lds_bf16p)((__attribute__((address_space(3))) unsigned char*)smem + NA_VC);
    const lds_bf16p kll = (lds_bf16p)((__attribute__((address_space(3))) unsigned char*)smem + NA_KL);
    for (int sitem = blockIdx.x; sitem < 256; sitem += gridDim.x) {
      const int b = sitem >> 6, h = (sitem >> 2) & 15, rqp = sitem & 3;
      __syncthreads();
      {
          const uint4* s0 = (const uint4*)(kch + (size_t)((b * 16 + h) * 32) * 512); const uint4* s1 = (const uint4*)(vcT + (size_t)((b * 16 + h) * 32) * 512);
          uint4* d0 = (uint4*)(smem + NA_KC); uint4* d1 = (uint4*)(smem + NA_VC);
#pragma unroll
          for (int i = 0; i < 4; ++i) { d0[tid + i * NTHREADS] = s0[tid + i * NTHREADS]; d1[tid + i * NTHREADS] = s1[tid + i * NTHREADS]; }
          if (tid < 465) ((float*)(smem + NA_RPB))[tid] = rpb[h * 465 + tid];
      }
#pragma unroll 1
      for (int half = 0; half < 2; ++half) {
        const int r0 = rqp * 8 + half * 4;
        const int rs_min = min(max(r0 - 4, 0), 24), rs_max = min(max(r0 - 1, 0), 24), nrows = rs_max - rs_min + 8;
        if (half) __syncthreads();
        {
            const uint4* s0 = (const uint4*)(kh + (size_t)((b * 16 + h) * 256 + rs_min * 8) * 512); uint4* d0 = (uint4*)(smem + NA_KL);
            for (int e = tid; e < nrows * 512; e += NTHREADS) d0[e] = s0[e];
        }
        __syncthreads();
#pragma unroll 1
        for (int ti = 0; ti < 2; ++ti) {
        const int r = r0 + (wv >> 2) + 2 * ti, j = wv & 3;
        const int rs = min(max(r - 4, 0), 24), cs = min(max(16 * j - 8, 0), 32);
        const int x = 16 * j + ql, wsx = min(max(x - 8, 0), 48);
        const bf16_t* qrow = qh + ((size_t)((b * 16 + h) * SL + r * 64 + x)) * 64;
        const bf16x8v qf0 = __builtin_nontemporal_load((const bf16x8v*)(qrow + 8 * g)), qf1 = __builtin_nontemporal_load((const bf16x8v*)(qrow + 32 + 8 * g));
        const __attribute__((address_space(3))) float* rp_h = (const __attribute__((address_space(3))) float*)((__attribute__((address_space(3))) unsigned char*)smem + NA_RPB);
        f32x4v o1[4], o2[4]; float m1 = -1e30f, l1 = 0.f, m2 = -1e30f, l2 = 0.f;
#pragma unroll
        for (int d = 0; d < 4; ++d) { o1[d] = (f32x4v){0.f, 0.f, 0.f, 0.f}; o2[d] = (f32x4v){0.f, 0.f, 0.f, 0.f}; }
        const int koff = (ql >> 2) * 512 + g * 32 + (ql & 3) * 8;
        const bf16_t* vb = vT + (size_t)((b * 16 + h) * 256 + g) * 512 + ql * 8;
        {
            f32x4v st[16];
#pragma unroll
            for (int kb = 0; kb < 16; ++kb) {
                const lds_bf16p kp = kcl + koff + (kb >> 1) * 2048 + (kb & 1) * 128;
                const bf16x8v a0 = LDS_FRAG(kp), a1 = LDS_FRAG(kp + 256);
                f32x4v acc = {0.f, 0.f, 0.f, 0.f};
                acc = __builtin_amdgcn_mfma_f32_16x16x32_bf16(a0, qf0, acc, 0, 0, 0);
                acc = __builtin_amdgcn_mfma_f32_16x16x32_bf16(a1, qf1, acc, 0, 0, 0);
#pragma unroll
                for (int rr = 0; rr < 4; ++rr) { acc[rr] *= 0.125f; m1 = fmaxf(m1, acc[rr]); }
                st[kb] = acc;
            }
            m1 = fmaxf(m1, __shfl_xor(m1, 16)); m1 = fmaxf(m1, __shfl_xor(m1, 32));
#pragma unroll
            for (int kb = 0; kb < 16; ++kb)
#pragma unroll
                for (int rr = 0; rr < 4; ++rr) { const float e = __expf(st[kb][rr] - m1); st[kb][rr] = e; l1 += e; }
            l1 += __shfl_xor(l1, 16); l1 += __shfl_xor(l1, 32);
#pragma unroll
            for (int kp = 0; kp < 8; ++kp) {
                const bf16x8v pb = pack_p(st[2 * kp], st[2 * kp + 1]);
#pragma unroll
                for (int d = 0; d < 4; ++d) o1[d] = __builtin_amdgcn_mfma_f32_16x16x32_bf16(LDS_FRAG(vcl + g * 512 + ql * 8 + kp * 2048 + d * 128), pb, o1[d], 0, 0, 0);
            }
        }
        {
            f32x4v st[16];
#pragma unroll
            for (int kb = 0; kb < 16; ++kb) {
                const lds_bf16p kp = kll + koff + ((((rs + (kb >> 1) - rs_min) * 64 + cs) >> 3) * 512) + (kb & 1) * 128;
                const bf16x8v a0 = LDS_FRAG(kp), a1 = LDS_FRAG(kp + 256);
                f32x4v acc = {0.f, 0.f, 0.f, 0.f};
                acc = __builtin_amdgcn_mfma_f32_16x16x32_bf16(a0, qf0, acc, 0, 0, 0);
                acc = __builtin_amdgcn_mfma_f32_16x16x32_bf16(a1, qf1, acc, 0, 0, 0);
                const int dr = rs + (kb >> 1) - r + 7;
#pragma unroll
                for (int rr = 0; rr < 4; ++rr) {
                    const int kc = cs + 8 * g + 4 * (kb & 1) + rr, rel = kc - wsx;
                    const bool ok = rel >= 0 && rel < 16;
                    const int dc = min(max(kc - x + 15, 0), 30);
                    const float sv = ok ? acc[rr] * 0.125f + rp_h[dr * 31 + dc] : -1e30f;
                    acc[rr] = sv; m2 = fmaxf(m2, sv);
                }
                st[kb] = acc;
                if ((kb & 7) == 7) asm volatile("" ::: "memory");
            }
            m2 = fmaxf(m2, __shfl_xor(m2, 16)); m2 = fmaxf(m2, __shfl_xor(m2, 32));
#pragma unroll
            for (int kb = 0; kb < 16; ++kb)
#pragma unroll
                for (int rr = 0; rr < 4; ++rr) { const float e = __expf(st[kb][rr] - m2); st[kb][rr] = e; l2 += e; }
            l2 += __shfl_xor(l2, 16); l2 += __shfl_xor(l2, 32);
#pragma unroll
            for (int kp = 0; kp < 8; ++kp) {
                const bf16x8v pb = pack_p(st[2 * kp], st[2 * kp + 1]);
                const bf16_t* vp = vb + (size_t)(((rs + kp) * 64 + cs) >> 3) * 512;
#pragma unroll
                for (int d = 0; d < 4; ++d) o2[d] = __builtin_amdgcn_mfma_f32_16x16x32_bf16(*(const bf16x8v*)(vp + d * 128), pb, o2[d], 0, 0, 0);
                if ((kp & 3) == 3) asm volatile("" ::: "memory");
            }
        }
        const float mm = fmaxf(m1, m2), c1 = __expf(m1 - mm), c2 = __expf(m2 - mm);
        const float inv = 1.0f / (c1 * l1 + c2 * l2);
        const float w1 = c1 * inv, w2 = c2 * inv;
        f32x4v o[4];
#pragma unroll
        for (int d = 0; d < 4; ++d) o[d] = o1[d] * w1 + o2[d] * w2;
        bf16_t* op = na + (size_t)(b * SL + r * 64 + x) * DNA + h * 64 + 4 * g;
#pragma unroll
        for (int d = 0; d < 4; ++d) { uint2 w; w.x = pk_bf16(o[d][0], o[d][1]); w.y = pk_bf16(o[d][2], o[d][3]); nt_store2u(op + 16 * d, w); }
        }
      }
    }
}

__device__ __forceinline__ void phase_f(const Params& p, float* ldsf) {
    const int tid = opaque_tid();
    const bf16_t* hyT = (const bf16_t*)((const char*)p.ws + B_HYT); const bf16_t* na = (const bf16_t*)((const char*)p.ws + B_NA);
    bf16_t* ob = (bf16_t*)((char*)p.ws + B_UB);
    const float* ghy = p.in[I_GHY]; const float* gna = p.in[I_GNA];
    bf16_t* tile = (bf16_t*)ldsf;
    for (int item = blockIdx.x; item < NT / 32; item += gridDim.x) {
        const int t0 = item * 32;
        __syncthreads();
        uint4 hvv[8];
#pragma unroll
        for (int q = 0; q < 8; ++q) { const int e = q * NTHREADS + tid; hvv[q] = nt_load4u(hyT + (size_t)(e >> 2) * NT + t0 + (e & 3) * 8); }
#pragma unroll
        for (int q = 0; q < 8; ++q) {
            const int e = q * NTHREADS + tid, ch = e >> 2, part = e & 3;
            const unsigned wd[4] = {hvv[q].x, hvv[q].y, hvv[q].z, hvv[q].w};
#pragma unroll
            for (int i = 0; i < 4; ++i) { tile[(part * 8 + 2 * i) * 1032 + ch] = (bf16_t)(wd[i] & 0xffffu); tile[(part * 8 + 2 * i + 1) * 1032 + ch] = (bf16_t)(wd[i] >> 16); }
        }
        __syncthreads();
        const int tk = tid >> 4, sub = tid & 15;
        float hv[64]; float sh = 0.f, sn = 0.f;
#pragma unroll
        for (int i = 0; i < 8; ++i) {
            const uint4 v = *(const uint4*)(tile + tk * 1032 + (i * 16 + sub) * 8);
            const unsigned wd[4] = {v.x, v.y, v.z, v.w};
#pragma unroll
            for (int k = 0; k < 4; ++k) { const float a = __uint_as_float(wd[k] << 16), c = __uint_as_float(wd[k] & 0xffff0000u); hv[i * 8 + 2 * k] = a; hv[i * 8 + 2 * k + 1] = c; sh += a * a + c * c; }
        }
        const bf16_t* nrow = na + (size_t)(t0 + tk) * DNA;
        uint4 nv[8];
#pragma unroll
        for (int i = 0; i < 8; ++i) { nv[i] = nt_load4u(nrow + (i * 16 + sub) * 8);
            const unsigned wd[4] = {nv[i].x, nv[i].y, nv[i].z, nv[i].w};
#pragma unroll
            for (int k = 0; k < 4; ++k) { const float a = __uint_as_float(wd[k] << 16), c = __uint_as_float(wd[k] & 0xffff0000u); sn += a * a + c * c; } }
        sh += __shfl_xor(sh, 1); sh += __shfl_xor(sh, 2); sh += __shfl_xor(sh, 4); sh += __shfl_xor(sh, 8);
        sn += __shfl_xor(sn, 1); sn += __shfl_xor(sn, 2); sn += __shfl_xor(sn, 4); sn += __shfl_xor(sn, 8);
        const float rh = rsqrtf(sh * (1.0f / 1024.0f) + LN_EPS), rn = rsqrtf(sn * (1.0f / 1024.0f) + LN_EPS);
        bf16_t* orow = ob + (size_t)(t0 + tk) * D;
#pragma unroll
        for (int i = 0; i < 8; ++i) {
            const float4 g0 = *(const float4*)(ghy + (i * 16 + sub) * 8), g1 = *(const float4*)(ghy + (i * 16 + sub) * 8 + 4);
            uint4 w; w.x = pk_bf16(hv[i * 8] * rh * g0.x, hv[i * 8 + 1] * rh * g0.y); w.y = pk_bf16(hv[i * 8 + 2] * rh * g0.z, hv[i * 8 + 3] * rh * g0.w);
            w.z = pk_bf16(hv[i * 8 + 4] * rh * g1.x, hv[i * 8 + 5] * rh * g1.y); w.w = pk_bf16(hv[i * 8 + 6] * rh * g1.z, hv[i * 8 + 7] * rh * g1.w);
            *(uint4*)(orow + (i * 16 + sub) * 8) = w;
        }
#pragma unroll
        for (int i = 0; i < 8; ++i) {
            const float4 g0 = *(const float4*)(gna + (i * 16 + sub) * 8), g1 = *(const float4*)(gna + (i * 16 + sub) * 8 + 4);
            const unsigned wd[4] = {nv[i].x, nv[i].y, nv[i].z, nv[i].w};
            float a[8];
#pragma unroll
            for (int k = 0; k < 4; ++k) { a[2 * k] = __uint_as_float(wd[k] << 16); a[2 * k + 1] = __uint_as_float(wd[k] & 0xffff0000u); }
            uint4 w; w.x = pk_bf16(a[0] * rn * g0.x, a[1] * rn * g0.y); w.y = pk_bf16(a[2] * rn * g0.z, a[3] * rn * g0.w);
            w.z = pk_bf16(a[4] * rn * g1.x, a[5] * rn * g1.y); w.w = pk_bf16(a[6] * rn * g1.z, a[7] * rn * g1.w);
            *(uint4*)(orow + DHY + (i * 16 + sub) * 8) = w;
        }
    }
}

__device__ __forceinline__ void phase_h(const Params& p) {
    const int tid = opaque_tid(), lane = tid & 63, wv = tid >> 6;
    const float* x = p.in[I_X]; const bf16_t* y = (const bf16_t*)((const char*)p.ws + B_Y); const float* ada = p.ws + W_ADA;
    const float* g = p.in[I_LN1G]; const float* be = p.in[I_LN1B];
    bf16_t* x1 = (bf16_t*)((char*)p.ws + B_X1); bf16_t* u2b = (bf16_t*)((char*)p.ws + B_UB); unsigned* u2q = (unsigned*)((char*)p.ws + B_U2Q); float* su2 = p.ws + W_SU2;
#pragma unroll 1
    for (int tp = blockIdx.x * NWAVES + wv; tp < NT / 2; tp += gridDim.x * NWAVES) {
        const int b = (2 * tp) / SL;
        float v[2][32]; float s[2] = {0.f, 0.f};
#pragma unroll
        for (int u = 0; u < 2; ++u)
#pragma unroll
            for (int j = 0; j < 8; ++j) {
                const int col = j * 256 + lane * 4; const size_t t = (size_t)(2 * tp + u);
                const float4 xv = nt_load4(x + t * D + col); const uint2 yb = nt_load2u(y + t * D + col);
                const float4 yv = make_float4(__uint_as_float(yb.x << 16), __uint_as_float(yb.x & 0xffff0000u), __uint_as_float(yb.y << 16), __uint_as_float(yb.y & 0xffff0000u));
                const float4 gt = *(const float4*)(ada + b * 12288 + 2 * 2048 + col);
                v[u][j * 4] = ALPHA * xv.x + gt.x * yv.x; v[u][j * 4 + 1] = ALPHA * xv.y + gt.y * yv.y; v[u][j * 4 + 2] = ALPHA * xv.z + gt.z * yv.z; v[u][j * 4 + 3] = ALPHA * xv.w + gt.w * yv.w;
                s[u] += (v[u][j * 4] + v[u][j * 4 + 1]) + (v[u][j * 4 + 2] + v[u][j * 4 + 3]);
            }
        float rstd[2];
#pragma unroll
        for (int u = 0; u < 2; ++u) {
            const float mean = wave_sum(s[u]) * (1.0f / 2048.0f);
            float q2 = 0.f;
#pragma unroll
            for (int i = 0; i < 32; ++i) { v[u][i] -= mean; q2 += v[u][i] * v[u][i]; }
            rstd[u] = rsqrtf(wave_sum(q2) * (1.0f / 2048.0f) + LN_EPS);
        }
        asm volatile("" ::: "memory");
        float umx[2] = {0.f, 0.f};
#pragma unroll
        for (int j = 0; j < 8; ++j) {
            const int col = j * 256 + lane * 4;
            const float4 gv = *(const float4*)(g + col), bv = *(const float4*)(be + col);
            const float4 sh = *(const float4*)(ada + b * 12288 + 3 * 2048 + col), sc = *(const float4*)(ada + b * 12288 + 4 * 2048 + col);
#pragma unroll
            for (int u = 0; u < 2; ++u) {
                const size_t t = (size_t)(2 * tp + u);
                const float4 o = make_float4(v[u][j * 4] * rstd[u] * gv.x + bv.x, v[u][j * 4 + 1] * rstd[u] * gv.y + bv.y, v[u][j * 4 + 2] * rstd[u] * gv.z + bv.z, v[u][j * 4 + 3] * rstd[u] * gv.w + bv.w);
                { uint2 xb; xb.x = pk_bf16(o.x, o.y); xb.y = pk_bf16(o.z, o.w); nt_store2u(x1 + t * D + col, xb); }
                const float4 uv = make_float4(o.x * (1.f + sc.x) + sh.x, o.y * (1.f + sc.y) + sh.y, o.z * (1.f + sc.z) + sh.z, o.w * (1.f + sc.w) + sh.w);
                v[u][j * 4] = uv.x; v[u][j * 4 + 1] = uv.y; v[u][j * 4 + 2] = uv.z; v[u][j * 4 + 3] = uv.w;
                uint2 ub2; ub2.x = pk_bf16(uv.x, uv.y); ub2.y = pk_bf16(uv.z, uv.w);
                *(uint2*)(u2b + t * D + col) = ub2;
                umx[u] = fmaxf(umx[u], fmaxf(fmaxf(fabsf(uv.x), fabsf(uv.y)), fmaxf(fabsf(uv.z), fabsf(uv.w))));
            }
        }
#pragma unroll
        for (int u = 0; u < 2; ++u) {
            const size_t t = (size_t)(2 * tp + u);
            const float um = wave_max(umx[u]);
            const float inv = um > 0.f ? 127.0f / um : 0.f;
            uint4 qa, qb;
            qa.x = q4(v[u][0], v[u][1], v[u][2], v[u][3], inv, 0); qa.y = q4(v[u][4], v[u][5], v[u][6], v[u][7], inv, 0); qa.z = q4(v[u][8], v[u][9], v[u][10], v[u][11], inv, 0); qa.w = q4(v[u][12], v[u][13], v[u][14], v[u][15], inv, 0);
            qb.x = q4(v[u][16], v[u][17], v[u][18], v[u][19], inv, 0); qb.y = q4(v[u][20], v[u][21], v[u][22], v[u][23], inv, 0); qb.z = q4(v[u][24], v[u][25], v[u][26], v[u][27], inv, 0); qb.w = q4(v[u][28], v[u][29], v[u][30], v[u][31], inv, 0);
            nt_store4u(u2q + t * 512 + lane * 8, qa); nt_store4u(u2q + t * 512 + lane * 8 + 4, qb);
            if (lane == 0) su2[t] = um * (1.0f / 127.0f);
        }
    }
}

template <int N> __device__ __forceinline__ void bitonic_desc(float (&v)[N]) {
#pragma unroll
    for (int k = 2; k <= N; k <<= 1)
#pragma unroll
        for (int j = k >> 1; j > 0; j >>= 1)
#pragma unroll
            for (int i = 0; i < N; ++i) { const int l = i ^ j; if (l > i) { const float x = v[i], y = v[l]; const float mx = fmaxf(x, y), mn = fminf(x, y); if ((i & k) == 0) { v[i] = mx; v[l] = mn; } else { v[i] = mn; v[l] = mx; } } }
}
__device__ __forceinline__ void bitonic_merge16_desc(float (&v)[16]) {
#pragma unroll
    for (int j = 8; j > 0; j >>= 1)
#pragma unroll
        for (int i = 0; i < 16; ++i) { const int l = i ^ j; if (l > i) { const float x = v[i], y = v[l]; v[i] = fmaxf(x, y); v[l] = fminf(x, y); } }
}
__device__ __forceinline__ void top16_of_128(float (&sc)[32], float (&top)[16]) {
    float lo[16], hi[16];
#pragma unroll
    for (int i = 0; i < 16; ++i) { lo[i] = sc[i]; hi[i] = sc[16 + i]; }
    bitonic_desc<16>(lo); bitonic_desc<16>(hi);
#pragma unroll
    for (int i = 0; i < 16; ++i) top[i] = fmaxf(lo[i], hi[15 - i]);
    bitonic_merge16_desc(top);
#pragma unroll
    for (int off = 16; off <= 32; off <<= 1) {
        float o[16];
#pragma unroll
        for (int i = 0; i < 16; ++i) o[i] = __shfl_xor(top[15 - i], off);
#pragma unroll
        for (int i = 0; i < 16; ++i) top[i] = fmaxf(top[i], o[i]);
        bitonic_merge16_desc(top);
    }
}
__device__ __forceinline__ void ce_carry(float& va, int& xa, float& vb, int& xb, bool desc) {
    const bool sw = desc ? (vb > va) : (vb < va);
    const float tv = sw ? vb : va, uv = sw ? va : vb; const int tx = sw ? xb : xa, ux = sw ? xa : xb;
    va = tv; vb = uv; xa = tx; xb = ux;
}
__device__ __forceinline__ void bitonic_merge16_desc_carry(float (&v)[16], int (&x)[16]) {
#pragma unroll
    for (int j = 8; j > 0; j >>= 1)
#pragma unroll
        for (int i = 0; i < 16; ++i) { const int l = i ^ j; if (l > i) ce_carry(v[i], x[i], v[l], x[l], true); }
}
constexpr int CAND_I[52] = {0,0,0,0,0,0,0,0,0,0,0,0,0,0,0,0,1,1,1,1,1,1,1,1,2,2,2,2,2,3,3,3,3,4,4,4,5,5,6,6,7,7,8,9,10,11,12,13,14,15,-1,-1};
constexpr int CAND_J[52] = {0,1,2,3,4,5,6,7,8,9,10,11,12,13,14,15,0,1,2,3,4,5,6,7,0,1,2,3,4,0,1,2,3,0,1,2,0,1,0,1,0,1,0,0,0,0,0,0,0,0,-1,-1};

__device__ __forceinline__ int rl_i(int v, int l) { return __builtin_amdgcn_readlane(v, l); }
__device__ __forceinline__ float rl_f(float v, int l) { return __int_as_float(__builtin_amdgcn_readlane(__float_as_int(v), l)); }
#define LANE_OF(k) ((((k) >> 3) & 1) * 32 + (((k) >> 2) & 1) * 16 + (((k) >> 1) & 1) * 8 + ((k) & 1) * 4)
constexpr size_t B_KEYSB = 15 * MiB;
constexpr size_t B_QB = B_Y;

typedef float f32x2v __attribute__((ext_vector_type(2)));
#define PKFMA_LO(fv, xv, wsv) do { f32x2v _t; asm("v_cvt_pk_f32_fp8 %1, %2\n\tv_pk_fma_f32 %0, %3, %1, %0" : "+v"(fv), "=&v"(_t) : "v"(xv), "v"(wsv)); } while (0)
#define PKFMA_HI(fv, xv, wsv) do { f32x2v _t; asm("v_cvt_pk_f32_fp8_sdwa %1, %2 src0_sel:WORD_1\n\tv_pk_fma_f32 %0, %3, %1, %0" : "+v"(fv), "=&v"(_t) : "v"(xv), "v"(wsv)); } while (0)
#define PKFMA_F4(fv, xv, wsv, OPSEL) do { f32x2v _t; asm("v_cvt_scalef32_pk_f32_fp4 %1, %2, 1.0 " OPSEL "\n\tv_pk_fma_f32 %0, %3, %1, %0" : "+v"(fv), "=&v"(_t) : "v"(xv), "v"(wsv)); } while (0)
#define FACC(i) (f2[(i) >> 1][(i) & 1])
__device__ __forceinline__ void gather_token(const Params& p, int t, const int* sel_idx, const float* sel_g, int lane) {
    const bf16_t* x1 = (const bf16_t*)((const char*)p.ws + B_X1); const float* ada = p.ws + W_ADA;
    const char* uq = (const char*)p.ws + B_TQ; const char* vq = uq + (size_t)16384 * UROW; const char* u2q = (const char*)p.ws + B_U2Q;
    const __amdgpu_buffer_rsrc_t ursrc = __builtin_amdgcn_make_buffer_rsrc((void*)uq, 0, 16384 * UROW, 0x00020000);
    const __amdgpu_buffer_rsrc_t vrsrc = __builtin_amdgcn_make_buffer_rsrc((void*)vq, 0, 16384 * UROW, 0x00020000);
    const float* su2 = p.ws + W_SU2; const float* rsu = p.ws + W_SU; const float* rsv = p.ws + W_SV;
    const float* g2 = p.in[I_LN2G]; const float* b2 = p.in[I_LN2B];
    const int b = t / SL;
    unsigned ue[4], uo[4]; int us0, us1;
    {
        const uint4 ua_ = nt_load4u(u2q + (size_t)t * D + lane * 32), ub_ = nt_load4u(u2q + (size_t)t * D + lane * 32 + 16);
        const int4 ua = make_int4((int)ua_.x, (int)ua_.y, (int)ua_.z, (int)ua_.w), ub = make_int4((int)ub_.x, (int)ub_.y, (int)ub_.z, (int)ub_.w);
        ue[0] = __builtin_amdgcn_perm((unsigned)ua.y, (unsigned)ua.x, 0x06040200u); uo[0] = __builtin_amdgcn_perm((unsigned)ua.y, (unsigned)ua.x, 0x07050301u);
        ue[1] = __builtin_amdgcn_perm((unsigned)ua.w, (unsigned)ua.z, 0x06040200u); uo[1] = __builtin_amdgcn_perm((unsigned)ua.w, (unsigned)ua.z, 0x07050301u);
        ue[2] = __builtin_amdgcn_perm((unsigned)ub.y, (unsigned)ub.x, 0x06040200u); uo[2] = __builtin_amdgcn_perm((unsigned)ub.y, (unsigned)ub.x, 0x07050301u);
        ue[3] = __builtin_amdgcn_perm((unsigned)ub.w, (unsigned)ub.z, 0x06040200u); uo[3] = __builtin_amdgcn_perm((unsigned)ub.w, (unsigned)ub.z, 0x07050301u);
        us0 = __builtin_amdgcn_sdot4(ua.x, 0x01010101, 0, false); us0 = __builtin_amdgcn_sdot4(ua.y, 0x01010101, us0, false); us0 = __builtin_amdgcn_sdot4(ua.z, 0x01010101, us0, false); us0 = __builtin_amdgcn_sdot4(ua.w, 0x01010101, us0, false);
        us1 = __builtin_amdgcn_sdot4(ub.x, 0x01010101, 0, false); us1 = __builtin_amdgcn_sdot4(ub.y, 0x01010101, us1, false); us1 = __builtin_amdgcn_sdot4(ub.z, 0x01010101, us1, false); us1 = __builtin_amdgcn_sdot4(ub.w, 0x01010101, us1, false);
    }
    const float s2 = su2[t];
    const float uoff = 7.5f * wave_sum((float)(us0 + us1));
    f32x2v f2[16];
#pragma unroll
    for (int i = 0; i < 16; ++i) f2[i] = (f32x2v){0.f, 0.f};
    const int kk8 = ((lane >> 5) & 1) * 4 + ((lane >> 4) & 1) * 2 + ((lane >> 3) & 1);
#define LANE_OF8(k) ((((k) >> 2) & 1) * 32 + (((k) >> 1) & 1) * 16 + ((k) & 1) * 8)
    int e_cur = sel_idx[kk8]; float g_cur = sel_g[kk8];
    uint4 un[8];
#pragma unroll
    for (int k = 0; k < 8; ++k) { const int ro = rl_i(e_cur, LANE_OF8(k)) * UROW; un[k] = __builtin_bit_cast(uint4, __builtin_amdgcn_raw_buffer_load_b128(ursrc, lane * 16, ro, 0)); }
#pragma unroll 1
    for (int bt = 0; bt < 16; ++bt) {
        uint4 vn[8];
#pragma unroll
        for (int k = 0; k < 8; ++k) { const int ro = rl_i(e_cur, LANE_OF8(k)) * UROW; vn[k] = __builtin_bit_cast(uint4, __builtin_amdgcn_raw_buffer_load_b128(vrsrc, lane * 16, ro, 0)); }
        __builtin_amdgcn_sched_barrier(0);
        float part[8];
#pragma unroll
        for (int k = 0; k < 8; ++k) {
            const uint4 nq = un[k];
            int d0 = __builtin_amdgcn_sdot4((int)ue[0], (int)(nq.x & 0x0F0F0F0Fu), 0, false); d0 = __builtin_amdgcn_sdot4((int)uo[0], (int)((nq.x >> 4) & 0x0F0F0F0Fu), d0, false);
            d0 = __builtin_amdgcn_sdot4((int)ue[1], (int)(nq.y & 0x0F0F0F0Fu), d0, false); d0 = __builtin_amdgcn_sdot4((int)uo[1], (int)((nq.y >> 4) & 0x0F0F0F0Fu), d0, false);
            d0 = __builtin_amdgcn_sdot4((int)ue[2], (int)(nq.z & 0x0F0F0F0Fu), d0, false); d0 = __builtin_amdgcn_sdot4((int)uo[2], (int)((nq.z >> 4) & 0x0F0F0F0Fu), d0, false);
            d0 = __builtin_amdgcn_sdot4((int)ue[3], (int)(nq.w & 0x0F0F0F0Fu), d0, false); d0 = __builtin_amdgcn_sdot4((int)uo[3], (int)((nq.w >> 4) & 0x0F0F0F0Fu), d0, false);
            part[k] = (float)d0;
            __builtin_amdgcn_sched_barrier(0);
        }
        const int bn = (bt + 1) & 15;
        const int e_nxt = sel_idx[bn * 8 + kk8]; const float g_nxt = sel_g[bn * 8 + kk8];
#pragma unroll
        for (int k = 0; k < 8; ++k) { const int ro = rl_i(e_nxt, LANE_OF8(k)) * UROW; un[k] = __builtin_bit_cast(uint4, __builtin_amdgcn_raw_buffer_load_b128(ursrc, lane * 16, ro, 0)); }
        __builtin_amdgcn_sched_barrier(0);
        { const bool up = (lane & 32) != 0;
#pragma unroll
          for (int i = 0; i < 4; ++i) { const float keep = up ? part[i + 4] : part[i], send = up ? part[i] : part[i + 4]; part[i] = keep + __shfl_xor(send, 32); } }
        { const bool up = (lane & 16) != 0;
#pragma unroll
          for (int i = 0; i < 2; ++i) { const float keep = up ? part[i + 2] : part[i], send = up ? part[i] : part[i + 2]; part[i] = keep + __shfl_xor(send, 16); } }
        { const bool up = (lane & 8) != 0;
          const float keep = up ? part[1] : part[0], send = up ? part[0] : part[1]; part[0] = keep + __shfl_xor(send, 8); }
        float tot = part[0]; tot += __shfl_xor(tot, 1); tot += __shfl_xor(tot, 2); tot += __shfl_xor(tot, 4);
        const float dt = (tot - uoff) * s2 * rsu[e_cur];
        const float act = 0.5f * dt * (1.0f + erff(dt * 0.7071067811865476f));
        const float w_l = g_cur * act * rsv[e_cur];
#pragma unroll
        for (int k = 0; k < 8; ++k) {
            const float w = rl_f(w_l, LANE_OF8(k));
            const f32x2v wp0 = {w, w};
            const unsigned wd[4] = {vn[k].x, vn[k].y, vn[k].z, vn[k].w};
#pragma unroll
            for (int q = 0; q < 4; ++q) {
                PKFMA_F4(f2[q * 4 + 0], wd[q], wp0, ""); PKFMA_F4(f2[q * 4 + 1], wd[q], wp0, "op_sel:[1,0,0]"); PKFMA_F4(f2[q * 4 + 2], wd[q], wp0, "op_sel:[0,1,0]"); PKFMA_F4(f2[q * 4 + 3], wd[q], wp0, "op_sel:[1,1,0]");
            }
        }
        e_cur = e_nxt; g_cur = g_nxt;
    }
#undef LANE_OF8
    asm volatile("" ::: "memory");
    float v[32]; float s = 0.f;
#pragma unroll
    for (int q = 0; q < 8; ++q) {
        const int col = q * 256 + lane * 4, o = q * 4;
        const uint2 xb = nt_load2u(x1 + (size_t)t * D + col); const float4 gt = *(const float4*)(ada + b * 12288 + 5 * 2048 + col);
        const float4 xv = make_float4(__uint_as_float(xb.x << 16), __uint_as_float(xb.x & 0xffff0000u), __uint_as_float(xb.y << 16), __uint_as_float(xb.y & 0xffff0000u));
        v[o] = ALPHA * xv.x + gt.x * FACC(o); v[o + 1] = ALPHA * xv.y + gt.y * FACC(o + 1);
        v[o + 2] = ALPHA * xv.z + gt.z * FACC(o + 2); v[o + 3] = ALPHA * xv.w + gt.w * FACC(o + 3);
        s += (v[o] + v[o + 1]) + (v[o + 2] + v[o + 3]);
    }
    const float mean = wave_sum(s) * (1.0f / 2048.0f);
    float q2 = 0.f;
#pragma unroll
    for (int i = 0; i < 32; ++i) { v[i] -= mean; q2 += v[i] * v[i]; }
    const float rstd = rsqrtf(wave_sum(q2) * (1.0f / 2048.0f) + LN_EPS);
    asm volatile("" ::: "memory");
#pragma unroll
    for (int q = 0; q < 8; ++q) {
        const int col = q * 256 + lane * 4, o = q * 4;
        const float4 gv = *(const float4*)(g2 + col), bv = *(const float4*)(b2 + col);
        nt_store4(p.out + (size_t)t * D + col, v[o] * rstd * gv.x + bv.x, v[o + 1] * rstd * gv.y + bv.y, v[o + 2] * rstd * gv.z + bv.z, v[o + 3] * rstd * gv.w + bv.w);
    }
}

__device__ __forceinline__ void phase_jk(const Params& p, unsigned char* smem) {
    const int tid0 = opaque_tid();
    const bf16_t* qb = (const bf16_t*)((const char*)p.ws + B_QB); const bf16_t* keysb = (const bf16_t*)((const char*)p.ws + B_KEYSB);
    int* sel_idx = (int*)smem; float* sel_g = (float*)(smem + 8192);
#pragma unroll 1
    for (int item = blockIdx.x; item < NT / 16; item += gridDim.x) {
        int tid = tid0; asm volatile("" : "+v"(tid));
        const int lane = tid & 63, wv = tid >> 6, ql = lane & 15, g = lane >> 4;
        const int t0 = item * 16, h = wv;
        __syncthreads();
        float ta[16], tb[16];
#pragma unroll
        for (int i = 0; i < 16; ++i) { ta[i] = 0.f; tb[i] = 0.f; }
#pragma unroll 1
        for (int pp = 0; pp < 2; ++pp) {
            const bf16_t* qrow = qb + ((size_t)((((t0 >> 4) * 8 + h) * 2 + pp) * 4) * 64 + lane) * 8;
            bf16x8v qf[4];
#pragma unroll
            for (int kc = 0; kc < 4; ++kc) qf[kc] = __builtin_nontemporal_load((const bf16x8v*)(qrow + kc * 512));
            const bf16_t* kbase = keysb + (size_t)((h * 2 + pp) * 8) * 2048 + lane * 8;
            float sc[32];
#pragma unroll
            for (int nb = 0; nb < 8; ++nb) {
                f32x4v acc = {0.f, 0.f, 0.f, 0.f};
#pragma unroll
                for (int kc = 0; kc < 4; ++kc) acc = __builtin_amdgcn_mfma_f32_16x16x32_bf16(*(const bf16x8v*)(kbase + (nb * 4 + kc) * 512), qf[kc], acc, 0, 0, 0);
#pragma unroll
                for (int rr = 0; rr < 4; ++rr) sc[nb * 4 + rr] = __int_as_float((__float_as_int(acc[rr]) & ~127) | (16 * nb + 4 * g + rr));
                if (nb == 3) asm volatile("" ::: "memory");
            }
            float top[16];
            top16_of_128(sc, top);
#pragma unroll
            for (int i = 0; i < 16; ++i) { if (pp == 0) ta[i] = top[i]; else tb[i] = top[i]; }
        }
        float cv[16]; int cx[16];
#pragma unroll
        for (int sidx = 0; sidx < 13; ++sidx) {
            float vv[4]; int xx[4];
#pragma unroll
            for (int q = 0; q < 4; ++q) {
                const int ci = CAND_I[4 * sidx + q], cj = CAND_J[4 * sidx + q];
                if (ci >= 0) { vv[q] = ta[ci] + tb[cj]; xx[q] = ((__float_as_int(ta[ci]) & 127) << 7) | (__float_as_int(tb[cj]) & 127); } else { vv[q] = -3.0e38f; xx[q] = 0; }
            }
            cv[sidx] = g == 0 ? vv[0] : (g == 1 ? vv[1] : (g == 2 ? vv[2] : vv[3]));
            cx[sidx] = g == 0 ? xx[0] : (g == 1 ? xx[1] : (g == 2 ? xx[2] : xx[3]));
        }
#pragma unroll
        for (int sidx = 13; sidx < 16; ++sidx) { cv[sidx] = -3.0e38f; cx[sidx] = 0; }
#pragma unroll
        for (int k = 2; k <= 16; k <<= 1)
#pragma unroll
            for (int j = k >> 1; j > 0; j >>= 1)
#pragma unroll
                for (int i = 0; i < 16; ++i) { const int l = i ^ j; if (l > i) ce_carry(cv[i], cx[i], cv[l], cx[l], (i & k) == 0); }
#pragma unroll
        for (int off = 16; off <= 32; off <<= 1) {
            float ov[16]; int ox[16];
#pragma unroll
            for (int i = 0; i < 16; ++i) { ov[i] = __shfl_xor(cv[15 - i], off); ox[i] = __shfl_xor(cx[15 - i], off); }
#pragma unroll
            for (int i = 0; i < 16; ++i) { const bool tk = ov[i] > cv[i]; cv[i] = tk ? ov[i] : cv[i]; cx[i] = tk ? ox[i] : cx[i]; }
            bitonic_merge16_desc_carry(cv, cx);
        }
        {
            float ex[16]; float sum = 0.f;
#pragma unroll
            for (int i = 0; i < 16; ++i) { ex[i] = __expf(cv[i] - cv[0]); sum += ex[i]; }
            const float inv = 1.0f / sum;
            if (g == 0) {
#pragma unroll
                for (int q = 0; q < 4; ++q) {
                    *(int4*)(sel_idx + ql * 128 + h * 16 + q * 4) = make_int4(cx[q * 4], cx[q * 4 + 1], cx[q * 4 + 2], cx[q * 4 + 3]);
                    *(float4*)(sel_g + ql * 128 + h * 16 + q * 4) = make_float4(ex[q * 4] * inv, ex[q * 4 + 1] * inv, ex[q * 4 + 2] * inv, ex[q * 4 + 3] * inv);
                }
            }
        }
        __syncthreads();
#pragma unroll 1
        for (int k = 0; k < 2; ++k) { int lane2 = lane; asm volatile("" : "+v"(lane2)); gather_token(p, t0 + 2 * wv + k, sel_idx + (2 * wv + k) * 128, sel_g + (2 * wv + k) * 128, lane2); }
    }
}

__device__ __forceinline__ void map_tile(int L, int nM, int nN, int& pm, int& pn) {
    const int nwg = nM * nN; int wgid = L;
    { const int q = nwg / 8, r = nwg % 8, xcd = wgid % 8, off = wgid / 8; wgid = (xcd < r ? xcd * (q + 1) : r * (q + 1) + (xcd - r) * q) + off; }
    const int nig = 8 * nN, gid = wgid / nig, fm = gid * 8, gsz = (nM - fm) < 8 ? (nM - fm) : 8;
    pm = fm + ((wgid % nig) % gsz); pn = (wgid % nig) / gsz;
}
struct ProjOrder {
    int G, c; const bf16_t* ub; const bf16_t* wint;
    __device__ bool next(int i, pg8::Unit& u) const {
        const int L = i * G + c; if (L >= 800) return false;
        if (L < 384) { u.kind = 0; map_tile(L, 12, 32, u.pm, u.pn); }
        else if (L < 512) { u.kind = 1; map_tile(L - 384, 4, 32, u.pm, u.pn); }
        else if (L < 768) { u.kind = 2; map_tile(L - 512, 32, 8, u.pm, u.pn); }
        else if (L < 784) { u.kind = 3; u.pm = (L - 768) >> 2; u.pn = (L - 768) & 3; }
        else { u.kind = 4; u.pm = (L - 784) >> 2; u.pn = (L - 784) & 3; }
        return true;
    }
    __device__ __forceinline__ void a_ready(const pg8::Unit&) const {}
    __device__ __forceinline__ void done(const pg8::Unit&) const {}
    template <class G_> __device__ __forceinline__ const char* pa(const G_&, const pg8::Unit& u) const {
        const size_t ts = (size_t)256 * D * 2;
        switch (u.kind) { case 0: return (const char*)wint + (size_t)u.pm * ts; case 1: return (const char*)wint + (size_t)(20 + u.pm) * ts; case 2: return (const char*)ub + (size_t)u.pm * ts;
                          case 3: return (const char*)ub + (size_t)(32 + u.pm) * ts; default: return (const char*)wint + (size_t)(20 + u.pm) * ts; }
    }
    template <class G_> __device__ __forceinline__ const char* pb(const G_&, const pg8::Unit& u) const {
        const size_t ts = (size_t)256 * D * 2;
        switch (u.kind) { case 0: case 1: return (const char*)ub + (size_t)u.pn * ts; case 2: return (const char*)wint + (size_t)(12 + u.pn) * ts;
                          case 3: return (const char*)wint + (size_t)(16 + u.pn) * ts; default: return (const char*)ub + (size_t)(32 + u.pn) * ts; }
    }
};
struct EpiProj {
    static constexpr bool PERM = true, AFTER_DRAIN = false;
    unsigned char* ws;
    __device__ __forceinline__ void operator()(const pg8::f32x4 (&acc)[2][2][4][2], const pg8::Unit& u, int wr, int wc, int fr, int fq) const {
        bf16_t* const zT = (bf16_t*)(ws + B_ZT); bf16_t* const vT = (bf16_t*)(ws + B_VT); bf16_t* const qh = (bf16_t*)(ws + B_QH); bf16_t* const kh = (bf16_t*)(ws + B_KH);
        bf16_t* const kch = (bf16_t*)(ws + B_KCH); bf16_t* const vcT = (bf16_t*)(ws + B_VCT);
#pragma unroll
        for (int ai = 0; ai < 2; ++ai)
#pragma unroll
            for (int m = 0; m < 4; ++m) {
                const int r = u.pm * 256 + ai * 128 + wr * 64 + m * 16 + fr;
#pragma unroll
                for (int bj = 0; bj < 2; ++bj) {
                    const int cc = u.pn * 256 + bj * 128 + wc * 32 + 8 * fq;
                    bf16_t* dst;
                    if (u.kind == 0) dst = zT + (size_t)r * NT + cc;
                    else if (u.kind == 1) {
                        const int bb = cc >> 11, t = cc & 2047, hh = r >> 6, dd = r & 63;
                        dst = vT + (size_t)((bb * 16 + hh) * 256 + (t >> 3)) * 512 + (dd >> 4) * 128 + (dd & 15) * 8;
                    } else if (u.kind == 2) {
                        const int bb = r >> 11, t = r & 2047, hc = cc & 1023, hh = hc >> 6, dd = hc & 63;
                        if (cc < 1024) dst = qh + ((size_t)((bb * 16 + hh) * SL + t)) * 64 + dd;
                        else dst = kh + (size_t)((bb * 16 + hh) * 256 + (t >> 3)) * 512 + (dd >> 5) * 256 + ((t & 7) >> 2) * 128 + ((dd & 31) >> 3) * 32 + (t & 3) * 8;
                    } else if (u.kind == 3) {
                        const int bb = r >> 8, jj = r & 255, hh = cc >> 6, dd = cc & 63;
                        dst = kch + (size_t)((bb * 16 + hh) * 32 + (jj >> 3)) * 512 + (dd >> 5) * 256 + ((jj & 7) >> 2) * 128 + ((dd & 31) >> 3) * 32 + (jj & 3) * 8;
                    } else {
                        const int bb = cc >> 8, jj = cc & 255, hh = r >> 6, dd = r & 63;
                        dst = vcT + (size_t)((bb * 16 + hh) * 32 + (jj >> 3)) * 512 + (dd >> 4) * 128 + (dd & 15) * 8;
                    }
                    const pg8::f32x4 v0 = acc[ai][bj][m][0], v1 = acc[ai][bj][m][1];
                    pg8::u32x4 w; w.x = pg8::cvt_pk_bf16(v0[0], v0[1]); w.y = pg8::cvt_pk_bf16(v0[2], v0[3]); w.z = pg8::cvt_pk_bf16(v1[0], v1[1]); w.w = pg8::cvt_pk_bf16(v1[2], v1[3]);
                    *(pg8::u32x4*)dst = w;
                }
            }
    }
};

struct EpiQFrag {
    static constexpr bool PERM = true, AFTER_DRAIN = false;
    bf16_t* O;
    __device__ __forceinline__ void operator()(const pg8::f32x4 (&acc)[2][2][4][2], const pg8::Unit& u, int wr, int wc, int fr, int fq) const {
#pragma unroll
        for (int ai = 0; ai < 2; ++ai)
#pragma unroll
            for (int m = 0; m < 4; ++m) {
                const int t = u.pm * 256 + ai * 128 + wr * 64 + m * 16 + fr;
#pragma unroll
                for (int bj = 0; bj < 2; ++bj) {
                    const int c = u.pn * 256 + bj * 128 + wc * 32 + 8 * fq;
                    const int hh = c >> 8, pp = (c >> 7) & 1, d = c & 127;
                    bf16_t* dst = O + ((size_t)(((((t >> 4) * 8 + hh) * 2 + pp) * 4 + (d >> 5)) * 64 + ((d & 31) >> 3) * 16 + (t & 15))) * 8;
                    const pg8::f32x4 v0 = acc[ai][bj][m][0], v1 = acc[ai][bj][m][1];
                    pg8::u32x4 w; w.x = pg8::cvt_pk_bf16(v0[0], v0[1]); w.y = pg8::cvt_pk_bf16(v0[2], v0[3]); w.z = pg8::cvt_pk_bf16(v1[0], v1[1]); w.w = pg8::cvt_pk_bf16(v1[2], v1[3]);
                    __builtin_nontemporal_store(w, (pg8::u32x4*)dst);
                }
            }
    }
};

#define XB_TMO      128
#define XB_XCNT(j)  (256  + 64 * (j))
#define XB_XSUB(j)  (1280 + 64 * (j))
#define XB_XGEN(j)  (2304 + 64 * (j))
#define XB_TOP      3328
#define XB_TOPGEN   3392
#define XCD_BAR_WORDS 3456
#define XB_SPIN_CAP (1u << 18)
#define LAS __attribute__((address_space(3)))

__device__ __forceinline__ unsigned xb_ld(unsigned* p)              { return __hip_atomic_load(p, __ATOMIC_RELAXED, __HIP_MEMORY_SCOPE_AGENT); }
__device__ __forceinline__ unsigned xb_add(unsigned* p, unsigned v) { return __hip_atomic_fetch_add(p, v, __ATOMIC_RELAXED, __HIP_MEMORY_SCOPE_AGENT); }
__device__ __forceinline__ unsigned xb_xcc_id() { return (unsigned)__builtin_amdgcn_s_getreg((3 << 11) | 20) & 0xFu; }
#define XB_SPIN(cond, bar) do { unsigned _sp = 0; while (cond) { __builtin_amdgcn_s_sleep(1); \
    if ((++_sp & 255u) == 0u) { if (xb_ld(&(bar)[XB_TMO])) break; if (_sp > XB_SPIN_CAP) { atomicAdd(&(bar)[XB_TMO], 1u); break; } } } } while (0)

struct XcdBarrier {
    unsigned* bar; unsigned x;
    volatile LAS unsigned* st;
};

__device__ __forceinline__ XcdBarrier xcd_barrier_post(unsigned* bar, volatile LAS unsigned* st) {
    XcdBarrier b; b.bar = bar; b.x = xb_xcc_id(); b.st = st;
    if (threadIdx.x == 0) (void)xb_add(&bar[XB_XCNT(b.x)], 1u);
    return b;
}
__device__ __forceinline__ void xcd_barrier_complete(unsigned* bar, unsigned x, unsigned& nloc, unsigned& nx) {
    const unsigned G = gridDim.x * gridDim.y * gridDim.z;
    unsigned sum, cnt, mine, sp = 0u;
    for (;;) {
        sum = 0u; cnt = 0u; mine = 0u;
#pragma unroll
        for (unsigned j = 0; j < 16; ++j) { const unsigned c = xb_ld(&bar[XB_XCNT(j)]); sum += c; cnt += (c > 0u) ? 1u : 0u; mine = (j == x) ? c : mine; }
        if (sum == G) break;
        __builtin_amdgcn_s_sleep(1);
        if ((++sp & 255u) == 0u) { if (xb_ld(&bar[XB_TMO])) break; if (sp > XB_SPIN_CAP) { atomicAdd(&bar[XB_TMO], 1u); break; } }
    }
    nloc = mine > 0u ? mine : 1u; nx = cnt > 0u ? cnt : 1u;
}

__device__ __forceinline__ void xcd_barrier(const XcdBarrier& b) {
    asm volatile("s_waitcnt vmcnt(0)" ::: "memory");
    __syncthreads();
    if (threadIdx.x == 0) {
        unsigned* bar = b.bar;
        __builtin_amdgcn_s_waitcnt(0);
        unsigned nloc = b.st[0], nx = b.st[1]; const unsigned k = b.st[2];
        if (nloc == 0u) { xcd_barrier_complete(bar, b.x, nloc, nx); b.st[0] = nloc; b.st[1] = nx; }
        b.st[2] = k + 1u;
        const unsigned old = xb_add(&bar[XB_XSUB(b.x)], 1u);
        if (old + 1u == (k + 1u) * nloc) {
            __builtin_amdgcn_fence(__ATOMIC_RELEASE, "agent");
            asm volatile("s_waitcnt vmcnt(0)" ::: "memory");
            (void)xb_add(&bar[XB_TOP], 1u);
        }
        asm volatile("buffer_inv sc1" ::: "memory");
        XB_SPIN(xb_ld(&bar[XB_TOP]) < (k + 1u) * nx, bar);
        asm volatile("s_waitcnt vmcnt(0)" ::: "memory");
    }
    __syncthreads();
}
constexpr size_t B_BAR = 14 * MiB;

__global__ void __launch_bounds__(NTHREADS) fwd_megakernel(Params p) {
    extern __shared__ __attribute__((aligned(16))) unsigned char smem[];
    float* lds = (float*)smem; float* red = (float*)(smem + RED_OFF);
    PG8_LAS unsigned char* glds = (PG8_LAS unsigned char*)smem;
    volatile LAS unsigned* xst = (volatile LAS unsigned*)(smem + LDS_BYTES - 16);
    if (threadIdx.x < 4) xst[threadIdx.x] = 0u;
    __syncthreads();
    XcdBarrier xb = xcd_barrier_post((unsigned*)((char*)p.ws + B_BAR), xst);
    bf16_t* wint = (bf16_t*)((char*)p.ws + B_WINT); bf16_t* woutt = (bf16_t*)((char*)p.ws + B_WOUTT); bf16_t* wqt = (bf16_t*)((char*)p.ws + B_WQT);
    bf16_t* ub = (bf16_t*)((char*)p.ws + B_UB);
    phase_a(p, lds);
    transpose_convert(p.in[I_WIN], wint, D, DPROJ, lds, 0, (int)gridDim.x);
    phase_filters(p, lds);
    {
        const float* ks = p.in[I_KEYS]; bf16_t* kd = (bf16_t*)((char*)p.ws + B_KEYSB);
        for (int e = blockIdx.x * NTHREADS + threadIdx.x; e < 16 * 128 * 128 / 4; e += gridDim.x * NTHREADS) {
            const float4 v = *(const float4*)(ks + e * 4); uint2 o; o.x = pk_bf16(v.x, v.y); o.y = pk_bf16(v.z, v.w);
            const int d = (e * 4) & 127, n = ((e * 4) >> 7) & 127, hp = (e * 4) >> 14;
            *(uint2*)(kd + ((size_t)(((hp * 8 + (n >> 4)) * 4 + (d >> 5)) * 64 + ((d & 31) >> 3) * 16 + (n & 15))) * 8 + (d & 7)) = o;
        }
    }
    xcd_barrier(xb);
    phase_b(p);
    xcd_barrier(xb);
    phase_c(p);
    xcd_barrier(xb);
    {
        pg8::Gemm g{ub, wint, NT + NTC, DPROJ, D}; ProjOrder S{(int)gridDim.x, (int)blockIdx.x, ub, wint};
        EpiProj E{(unsigned char*)p.ws};
        pg8::gemm_phase<EpiProj, ProjOrder>(glds, g, S, E, nullptr);
    }
    if (gridDim.x == 256 && blockIdx.x >= 32) {
        quant_tables(p, 32, 224);
        transpose_convert(p.in[I_WOUT], woutt, D, D, lds, 32, 224);
        transpose_convert(p.in[I_WQ], wqt, D, D, lds, 32, 224);
    } else if (gridDim.x != 256) {
        quant_tables(p, 0, (int)gridDim.x);
        transpose_convert(p.in[I_WOUT], woutt, D, D, lds, 0, (int)gridDim.x);
        transpose_convert(p.in[I_WQ], wqt, D, D, lds, 0, (int)gridDim.x);
    }
    xcd_barrier(xb);
    phase_hyena(p, smem);
    phase_na(p, smem);
    xcd_barrier(xb);
    phase_f(p, lds);
    xcd_barrier(xb);
    {
        pg8::Gemm g{ub, woutt, NT, D, D}; pg8::StaticOrder S; S.init(NT, D, (int)gridDim.x, (int)blockIdx.x);
        pg8::EpiBf16<0> E{(bf16_t*)((char*)p.ws + B_Y), D, nullptr, 0, 0};
        pg8::gemm_phase<pg8::EpiBf16<0>, pg8::StaticOrder>(glds, g, S, E, nullptr);
    }
    xcd_barrier(xb);
    phase_h(p);
    xcd_barrier(xb);
    {
        pg8::Gemm g{ub, wqt, NT, D, D}; pg8::StaticOrder S; S.init(NT, D, (int)gridDim.x, (int)blockIdx.x);
        EpiQFrag E{(bf16_t*)((char*)p.ws + B_QB)};
        pg8::gemm_phase<EpiQFrag, pg8::StaticOrder>(glds, g, S, E, nullptr);
    }
    xcd_barrier(xb);
    phase_jk(p, smem);
}

extern "C" void kernel_launch(void* const* d_in, const int* in_sizes, int n_in, void* d_out, int out_size, void* d_ws, size_t ws_size, hipStream_t stream) {
    static int grid_blocks = 0;
    if (grid_blocks == 0) {
        if (n_in != N_IN || out_size != NT * D || ws_size < W_END * sizeof(float)) {
            fprintf(stderr, "kernel_launch: unexpected shapes: n_in %d out %d ws %zu (need %zu)\n", n_in, out_size, ws_size, (size_t)W_END * 4); grid_blocks = -1; return; }
        int dev = 0, cus = 0, per_cu = 0;
        hipGetDevice(&dev);
        hipDeviceGetAttribute(&cus, hipDeviceAttributeMultiprocessorCount, dev);
        if (hipFuncSetAttribute((const void*)fwd_megakernel, hipFuncAttributeMaxDynamicSharedMemorySize, LDS_BYTES) != hipSuccess) { fprintf(stderr, "kernel_launch: hipFuncSetAttribute failed\n"); grid_blocks = -1; return; }
        if (hipOccupancyMaxActiveBlocksPerMultiprocessor(&per_cu, (const void*)fwd_megakernel, NTHREADS, LDS_BYTES) != hipSuccess || per_cu < 1) { fprintf(stderr, "kernel_launch: occupancy query failed (%d)\n", per_cu); (void)hipGetLastError(); grid_blocks = -1; return; }
        grid_blocks = cus * (per_cu > 1 ? 1 : per_cu);
        fprintf(stderr, "kernel_launch: cus %d per_cu %d grid %d\n", cus, per_cu, grid_blocks);
    }
    if (grid_blocks < 0) return;
    Params p{};
    for (int i = 0; i < N_IN; ++i) p.in[i] = (const float*)d_in[i];
    p.out = (float*)d_out; p.ws = (float*)d_ws;
    if (hipMemsetAsync((char*)d_ws + B_BAR, 0, XCD_BAR_WORDS * sizeof(unsigned), stream) != hipSuccess) { fprintf(stderr, "kernel_launch: memset failed\n"); return; }
    void* args[] = {&p};
    hipLaunchKernelGGL(fwd_megakernel, dim3(grid_blocks), dim3(NTHREADS), LDS_BYTES, stream, p);
    const hipError_t e = hipPeekAtLastError();
    if (e != hipSuccess) fprintf(stderr, "launch failed: %s (grid %d)\n", hipGetErrorString(e), grid_blocks);
}
```

```cpp
#include <hip/hip_runtime.h>
#include <hip/hip_cooperative_groups.h>
#include <cstdio>
namespace cg = cooperative_groups;

constexpr int D = 2048, NB = 4, SL = 2048, NT = NB * SL, CL = 256, NTC = NB * CL;
constexpr int DHY = 1024, DNA = 1024, DPROJ = 6144, OFFQ = 3072, OFFK = 4096, OFFV = 5120;
constexpr int NTHREADS = 512, NWAVES = 8;
constexpr float LN_EPS = 1e-5f;
constexpr float ALPHA = 1.189207115002721f;

enum { I_X = 0, I_C, I_CTX, I_CCTX, I_WADA, I_BADA, I_WIN, I_CONVW, I_CONVB, I_FW1, I_FB1, I_FW2, I_FB2, I_FW3, I_FB3, I_FW4,
       I_FREQ, I_SKIP, I_RPB, I_GHY, I_GNA, I_WOUT, I_LN1G, I_LN1B, I_WQ, I_KEYS, I_PU, I_PV, I_LN2G, I_LN2B, N_IN };

constexpr size_t W_ADAP = 0;
constexpr size_t W_ADA  = W_ADAP + 32 * 5 * 12288;
constexpr size_t W_FS   = W_ADA + 5 * 12288;
constexpr size_t W_SP   = W_FS + 4096;
constexpr size_t W_SU   = W_SP + 32 * 4096;
constexpr size_t W_SV   = W_SU + 16384;
constexpr size_t W_SU2  = W_SV + 16384;
constexpr size_t W_SC   = W_SU2 + 8192;
static_assert((W_SC + 16384) * 4 <= 14 * 1048576, "small region overflow");
constexpr size_t MiB = 1048576;
constexpr size_t B_WINT  = 16 * MiB;
constexpr size_t B_WOUTT = B_WINT + 24 * MiB;
constexpr size_t B_WQT   = B_WOUTT + 8 * MiB;
constexpr size_t B_UB    = B_WQT + 8 * MiB;
constexpr size_t B_ZT    = B_UB + 36 * MiB;
constexpr size_t B_VT    = B_ZT + 48 * MiB;
constexpr size_t B_QH    = B_VT + 16 * MiB;
constexpr size_t B_KH    = B_QH + 16 * MiB;
constexpr size_t B_KCH   = B_KH + 16 * MiB;
constexpr size_t B_VCT   = B_KCH + 2 * MiB;
constexpr size_t B_KF    = B_VCT + 2 * MiB;
constexpr size_t B_HRAW  = B_KF + 32 * MiB;
constexpr size_t B_HYT   = B_HRAW;
constexpr size_t B_NA    = B_HRAW + 16 * MiB;
constexpr size_t B_Y     = B_HRAW + 32 * MiB;
constexpr size_t B_X1    = B_Y + 64 * MiB;
constexpr size_t B_U2Q   = B_X1 + 64 * MiB;
constexpr size_t B_TQ    = B_U2Q + 16 * MiB;
constexpr size_t B_END   = B_TQ + 64 * MiB;
constexpr size_t W_KF = B_KF / 4, W_X1 = B_X1 / 4, W_HRAW = B_HRAW / 4, W_Y = B_Y / 4, W_END = B_END / 4;
static_assert(B_END <= 512 * MiB, "workspace");

constexpr int LDS_BYTES = 156 * 1024;
constexpr int RED_OFF = 155 * 1024;

struct Params { const float* in[N_IN]; float* out; float* ws; };

namespace pg8 {
#define PG8_LAS __attribute__((address_space(3)))
typedef unsigned short bf16_t;
typedef short bf16x8 __attribute__((ext_vector_type(8)));
typedef float f32x4 __attribute__((ext_vector_type(4)));
typedef unsigned u32x4 __attribute__((ext_vector_type(4)));
constexpr int BM = 256, BK = 64, HALF = 128, HTB = HALF * BK * 2  , STAGE_BYTES = 8 * HTB, NXCD = 8, WGM = 8;

__host__ __device__ __forceinline__ int lds_byte(int r, int c) { const int st = (r >> 4) * 2 + (c >> 5), rr = r & 15, cc = c & 31, ob = rr * 64 + cc * 2; return st * 1024 + (ob ^ (((ob >> 9) & 1) << 5)); }
__host__ __device__ __forceinline__ void stage_rc(int b, int& R, int& C) { const int st = b / 1024, sb = b % 1024, swz = sb ^ (((sb >> 9) & 1) << 5); R = (st >> 1) * 16 + swz / 64; C = (st & 1) * 32 + (swz % 64) / 2; }
__host__ __device__ __forceinline__ int perm32(int rho) { const int n = rho >> 4, i = rho & 15; return 8 * (i >> 2) + 4 * n + (i & 3); }

struct Unit { int pm, pn, kind; };
struct Gemm { const bf16_t* A; const bf16_t* Bt; int M, N, K; };

struct StaticOrder {
    int nM, nN, nwg, G, c;
    __host__ __device__ void init(int M, int N, int G_, int c_) { nM = M / BM; nN = N / BM; nwg = nM * nN; G = G_; c = c_; }
    __host__ __device__ bool next(int i, Unit& u) const {
        const long L = (long)i * G + c; if (L >= nwg) return false;
        int wgid = (int)L; { const int q = nwg / NXCD, r = nwg % NXCD, xcd = wgid % NXCD, off = wgid / NXCD; wgid = (xcd < r ? xcd * (q + 1) : r * (q + 1) + (xcd - r) * q) + off; }
        const int nig = WGM * nN, gid = wgid / nig, fm = gid * WGM, gsz = (nM - fm) < WGM ? (nM - fm) : WGM;
        u.pm = fm + ((wgid % nig) % gsz); u.pn = (wgid % nig) / gsz; return true;
    }
    __device__ __forceinline__ void a_ready(const Unit&) const {}
    __device__ __forceinline__ void done(const Unit&) const {}
    template <class G_> __device__ __forceinline__ const char* pa(const G_& g, const Unit& u) const { return (const char*)g.A + (size_t)u.pm * (size_t)(BM * 2) * g.K; }
    template <class G_> __device__ __forceinline__ const char* pb(const G_& g, const Unit& u) const { return (const char*)g.Bt + (size_t)u.pn * (size_t)(BM * 2) * g.K; }
};
__device__ __forceinline__ unsigned cvt_pk_bf16(float lo, float hi) { unsigned r; asm volatile("v_cvt_pk_bf16_f32 %0, %1, %2" : "=v"(r) : "v"(lo), "v"(hi)); return r; }
typedef float f32x2 __attribute__((ext_vector_type(2)));
__device__ __forceinline__ f32x2 gelu_pk(f32x2 v) {
    const f32x2 av = __builtin_elementwise_abs(v), d = av * 0.2316418882f + 1.0f;
    f32x2 t; t.x = __builtin_amdgcn_rcpf(d.x); t.y = __builtin_amdgcn_rcpf(d.y);
    f32x2 q = t * 0.5307027145f + (-0.7265760135f); q = q * t + 0.7107068705f; q = q * t + (-0.142248368f); q = q * t + 0.127414796f; q = q * t;
    const f32x2 s = (v * v) * (-0.72134752044f);
    f32x2 e; e.x = __builtin_amdgcn_exp2f(s.x); e.y = __builtin_amdgcn_exp2f(s.y);
    const f32x2 m = v * (q * e), r = v - m;
    f32x2 o; o.x = v.x < 0.f ? m.x : r.x; o.y = v.y < 0.f ? m.y : r.y; return o;
}

struct EpiF32 {
    static constexpr bool PERM = false, AFTER_DRAIN = false;
    float* C; int ldc; const float* bias;
    __device__ __forceinline__ void operator()(const f32x4 (&acc)[2][2][4][2], const Unit& u, int wr, int wc, int fr, int fq) const {
        const int row0 = u.pm * BM + wr * 64 + fr, col0 = u.pn * BM + wc * 32 + 4 * fq;
        f32x4 bv[2][2];
#pragma unroll
        for (int bj = 0; bj < 2; ++bj)
#pragma unroll
            for (int n = 0; n < 2; ++n) bv[bj][n] = bias ? *(const f32x4*)(bias + col0 + bj * HALF + n * 16) : (f32x4){0.f, 0.f, 0.f, 0.f};
#pragma unroll
        for (int ai = 0; ai < 2; ++ai)
#pragma unroll
            for (int m = 0; m < 4; ++m) { float* rowp = C + (size_t)(row0 + ai * HALF + m * 16) * ldc + col0;
#pragma unroll
                for (int bj = 0; bj < 2; ++bj)
#pragma unroll
                    for (int n = 0; n < 2; ++n) *(f32x4*)(rowp + bj * HALF + n * 16) = acc[ai][bj][m][n] + bv[bj][n]; }
    }
};
template <int ACT  > struct EpiBf16 {
    static constexpr bool PERM = true, AFTER_DRAIN = false;
    bf16_t* O; int ldc; const float* bias; int split_cols; size_t split_stride;
    __device__ __forceinline__ void operator()(const f32x4 (&acc)[2][2][4][2], const Unit& u, int wr, int wc, int fr, int fq) const {
        const int row0 = u.pm * BM + wr * 64 + fr; int colt = u.pn * BM; bf16_t* base = O;
        if (split_cols) { const int t = colt / split_cols; base += (size_t)t * split_stride; colt -= t * split_cols; }
        const int col0 = colt + wc * 32 + 8 * fq, bcol0 = u.pn * BM + wc * 32 + 8 * fq;
        f32x4 bv[2][2];
#pragma unroll
        for (int bj = 0; bj < 2; ++bj)
#pragma unroll
            for (int n = 0; n < 2; ++n) bv[bj][n] = bias ? *(const f32x4*)(bias + bcol0 + bj * HALF + 4 * n) : (f32x4){0.f, 0.f, 0.f, 0.f};
#pragma unroll
        for (int ai = 0; ai < 2; ++ai)
#pragma unroll
            for (int m = 0; m < 4; ++m) { bf16_t* rowp = base + (size_t)(row0 + ai * HALF + m * 16) * ldc + col0;
#pragma unroll
                for (int bj = 0; bj < 2; ++bj) { f32x4 v0 = acc[ai][bj][m][0] + bv[bj][0], v1 = acc[ai][bj][m][1] + bv[bj][1];
                    if (ACT == 1) { f32x2 a = gelu_pk((f32x2){v0[0], v0[1]}), b = gelu_pk((f32x2){v0[2], v0[3]}), c = gelu_pk((f32x2){v1[0], v1[1]}), d = gelu_pk((f32x2){v1[2], v1[3]});
                        v0 = (f32x4){a.x, a.y, b.x, b.y}; v1 = (f32x4){c.x, c.y, d.x, d.y}; }
                    if (ACT == 2) {
#pragma unroll
                        for (int j = 0; j < 4; ++j) { v0[j] = 0.5f * v0[j] * (1.0f + erff(v0[j] * 0.70710678f)); v1[j] = 0.5f * v1[j] * (1.0f + erff(v1[j] * 0.70710678f)); } }
                    u32x4 w; w.x = cvt_pk_bf16(v0[0], v0[1]); w.y = cvt_pk_bf16(v0[2], v0[3]); w.z = cvt_pk_bf16(v1[0], v1[1]); w.w = cvt_pk_bf16(v1[2], v1[3]);
                    *(u32x4*)(rowp + bj * HALF) = w; } }
    }
};
template <class Epi, class Sched, bool STAMP = false>
__device__ __forceinline__ void gemm_phase(PG8_LAS unsigned char* lds, const Gemm g, const Sched& S, const Epi& E, unsigned long long* stamps) {
    const int tid = threadIdx.x, wid = __builtin_amdgcn_readfirstlane(tid >> 6), lane = tid & 63, wr = wid >> 2, wc = wid & 3, fr = lane & 15, fq = lane >> 4;
    const int K = g.K, nt = K / BK;
    int ts_lo = 0, ts_hi = 0, nts = 0; const unsigned long long rt_entry = STAMP ? (unsigned long long)wall_clock64() : 0ull;
#define PG8_STAMP() do { if (STAMP && wid == 0 && nts < 64) { const unsigned long long _c = (unsigned long long)clock64(); \
        ts_lo = (lane == nts) ? (int)(unsigned)_c : ts_lo; ts_hi = (lane == nts) ? (int)(unsigned)(_c >> 32) : ts_hi; ++nts; } } while (0)
    PG8_STAMP();
    unsigned voffA[2], voffB[2];
#pragma unroll
    for (int i = 0; i < 2; ++i) { int R, C; stage_rc(tid * 16 + i * 8192, R, C); const int Rb = Epi::PERM ? ((R & ~31) + perm32(R & 31)) : R;
        voffA[i] = (unsigned)(R * K + C) * 2u; voffB[i] = (unsigned)(Rb * K + C) * 2u; }
    const size_t kstep = (size_t)(BK * 2);
    const size_t hstep = (size_t)HALF * K * 2;
    const size_t tstep = 2 * hstep;
    const unsigned ldsw = (unsigned)wid * 1024u;
    const int aoff = lds_byte(wr * 64 + fr, fq * 8), boff = lds_byte(wc * 32 + fr, fq * 8);
#define PG8_SA(b, h) (((b) * 2 + (h)) * HTB)
#define PG8_SB(b, h) ((4 + (b) * 2 + (h)) * HTB)
#define PG8_STAGE(bufoff, gbase, voff) do { _Pragma("unroll") for (int _i = 0; _i < 2; ++_i) \
        __builtin_amdgcn_global_load_lds((const unsigned*)((const char*)(gbase) + (voff)[_i]), (PG8_LAS unsigned*)(lds + (bufoff) + ldsw + _i * 8192), 16, 0, 0); } while (0)
#define PG8_LDA(dst, b, h) do { _Pragma("unroll") for (int m = 0; m < 4; ++m) _Pragma("unroll") for (int k = 0; k < 2; ++k) dst[m][k] = *(const PG8_LAS bf16x8*)(lds + PG8_SA(b, h) + aoff + m * 2048 + k * 1024); } while (0)
#define PG8_LDB(dst, b, h) do { _Pragma("unroll") for (int n = 0; n < 2; ++n) _Pragma("unroll") for (int k = 0; k < 2; ++k) dst[n][k] = *(const PG8_LAS bf16x8*)(lds + PG8_SB(b, h) + boff + n * 2048 + k * 1024); } while (0)
#define PG8_MMA(ai, bj, At, Bt) do { __builtin_amdgcn_s_setprio(1); _Pragma("unroll") for (int m = 0; m < 4; ++m) _Pragma("unroll") for (int n = 0; n < 2; ++n) _Pragma("unroll") for (int k = 0; k < 2; ++k) \
        acc[ai][bj][m][n] = __builtin_amdgcn_mfma_f32_16x16x32_bf16(Bt[n][k], At[m][k], acc[ai][bj][m][n], 0, 0, 0); __builtin_amdgcn_s_setprio(0); } while (0)
#define PG8_WAIT_V(n) asm volatile("s_waitcnt vmcnt(" #n ")" ::: "memory")
#define PG8_WAIT_L(n) asm volatile("s_waitcnt lgkmcnt(" #n ")" ::: "memory")
#define PG8_BAR __builtin_amdgcn_s_barrier()
#define PG8_SCHED __builtin_amdgcn_sched_barrier(0)
    Unit cur, nxt; int ui = 0;
    if (!S.next(0, cur)) return;
    f32x4 acc[2][2][4][2];
#pragma unroll
    for (int a = 0; a < 2; ++a)
#pragma unroll
        for (int b = 0; b < 2; ++b)
#pragma unroll
            for (int m = 0; m < 4; ++m)
#pragma unroll
                for (int n = 0; n < 2; ++n) acc[a][b][m][n] = (f32x4){0.f, 0.f, 0.f, 0.f};
    bf16x8 At[4][2], B0[2][2], B1[2][2];
    const char* cA = S.pa(g, cur); const char* cB = S.pb(g, cur);
    S.a_ready(cur);
    PG8_STAGE(PG8_SB(0, 0), cB, voffB); PG8_STAGE(PG8_SA(0, 0), cA, voffA); PG8_STAGE(PG8_SB(0, 1), cB + hstep, voffB); PG8_STAGE(PG8_SA(0, 1), cA + hstep, voffA);
    if (wr == 1) PG8_BAR;
    PG8_WAIT_V(4); PG8_BAR;
    PG8_STAGE(PG8_SB(1, 0), cB + kstep, voffB); PG8_STAGE(PG8_SA(1, 0), cA + kstep, voffA); PG8_STAGE(PG8_SB(1, 1), cB + hstep + kstep, voffB);
    PG8_WAIT_V(6); PG8_BAR;
    PG8_STAMP();
    for (;;) {
        const bool has_next = S.next(ui + 1, nxt);
        const char* nA = has_next ? S.pa(g, nxt) : cA; const char* nB = has_next ? S.pb(g, nxt) : cB;
        for (int t = 0; t < nt; t += 2) {
            const bool last = (t == nt - 2);
            const char* a1 = cA + (size_t)(t + 1) * kstep;
            const char* a2 = last ? nA : cA + (size_t)(t + 2) * kstep; const char* b2 = last ? nB : cB + (size_t)(t + 2) * kstep;
            const char* a3 = a2 + kstep; const char* b3 = b2 + kstep;
            if (last && has_next) S.a_ready(nxt);
            PG8_LDB(B0, 0, 0); PG8_SCHED; PG8_LDA(At, 0, 0); PG8_STAGE(PG8_SA(1, 1), a1 + hstep, voffA);
            PG8_WAIT_L(8); PG8_BAR; PG8_WAIT_L(0); PG8_MMA(0, 0, At, B0); PG8_BAR; PG8_SCHED;
            PG8_LDB(B1, 0, 1); PG8_STAGE(PG8_SB(0, 0), b2, voffB);
            PG8_BAR; PG8_WAIT_L(0); PG8_MMA(0, 1, At, B1); PG8_BAR;
            PG8_LDA(At, 0, 1); PG8_STAGE(PG8_SA(0, 0), a2, voffA);
            PG8_BAR; PG8_WAIT_L(0); PG8_MMA(1, 0, At, B0); PG8_BAR; PG8_SCHED;
            PG8_STAGE(PG8_SB(0, 1), b2 + hstep, voffB);
            PG8_WAIT_V(6); PG8_BAR; PG8_MMA(1, 1, At, B1); PG8_BAR;
            PG8_LDB(B0, 1, 0); PG8_SCHED; PG8_LDA(At, 1, 0); PG8_STAGE(PG8_SA(0, 1), a2 + hstep, voffA);
            PG8_WAIT_L(8); PG8_BAR; PG8_WAIT_L(0); PG8_MMA(0, 0, At, B0); PG8_BAR; PG8_SCHED;
            PG8_LDB(B1, 1, 1); PG8_STAGE(PG8_SB(1, 0), b3, voffB);
            PG8_BAR; PG8_WAIT_L(0); PG8_MMA(0, 1, At, B1); PG8_BAR;
            PG8_LDA(At, 1, 1); PG8_STAGE(PG8_SA(1, 0), a3, voffA);
            PG8_BAR; PG8_WAIT_L(0); PG8_MMA(1, 0, At, B0); PG8_BAR; PG8_SCHED;
            PG8_STAGE(PG8_SB(1, 1), b3 + hstep, voffB);
            PG8_WAIT_V(6); PG8_BAR; PG8_MMA(1, 1, At, B1); PG8_BAR;
        }
        PG8_STAMP();
        if constexpr (!Epi::AFTER_DRAIN) { E(acc, cur, wr, wc, fr, fq); S.done(cur); }
        PG8_STAMP();
        if (!has_next) break;
#pragma unroll
        for (int a = 0; a < 2; ++a)
#pragma unroll
            for (int b = 0; b < 2; ++b)
#pragma unroll
                for (int m = 0; m < 4; ++m)
#pragma unroll
                    for (int n = 0; n < 2; ++n) acc[a][b][m][n] = (f32x4){0.f, 0.f, 0.f, 0.f};
        cur = nxt; cA = nA; cB = nB; ++ui;
    }
    PG8_WAIT_V(0);
    if (wr == 0) PG8_BAR;
    PG8_BAR;
    if constexpr (Epi::AFTER_DRAIN) { E.fused(acc, cur, wr, wc, fr, fq, lds, wid, lane); S.done(cur); }
    PG8_STAMP();
    if (STAMP && wid == 0) { stamps[lane] = lane < nts ? (((unsigned long long)(unsigned)ts_hi << 32) | (unsigned)ts_lo) : 0ull;
        if (lane == 62) stamps[62] = rt_entry; if (lane == 63) stamps[63] = (unsigned long long)wall_clock64(); }
#undef PG8_STAMP
#undef PG8_SA
#undef PG8_SB
#undef PG8_STAGE
#undef PG8_LDA
#undef PG8_LDB
#undef PG8_MMA
#undef PG8_WAIT_V
#undef PG8_WAIT_L
#undef PG8_BAR
#undef PG8_SCHED
}
}

typedef unsigned short bf16_t;
__device__ __forceinline__ float wave_sum(float v) {
#pragma unroll
    for (int o = 32; o; o >>= 1) v += __shfl_xor(v, o);
    return v;
}
__device__ __forceinline__ float block_sum(float v, float* red) {
    v = wave_sum(v);
    __syncthreads();
    if ((threadIdx.x & 63) == 0) red[threadIdx.x >> 6] = v;
    __syncthreads();
    float s = 0.f;
#pragma unroll
    for (int i = 0; i < NWAVES; ++i) s += red[i];
    return s;
}
__device__ __forceinline__ int opaque_tid() { int t = threadIdx.x; asm volatile("" : "+v"(t)); return t; }
typedef float nt_f32x4 __attribute__((ext_vector_type(4)));
__device__ __forceinline__ float4 nt_load4(const float* p) { const nt_f32x4 v = __builtin_nontemporal_load((const nt_f32x4*)p); return make_float4(v[0], v[1], v[2], v[3]); }
typedef unsigned nt_u32x4 __attribute__((ext_vector_type(4)));
typedef unsigned nt_u32x2 __attribute__((ext_vector_type(2)));
__device__ __forceinline__ uint4 nt_load4u(const void* p) { const nt_u32x4 v = __builtin_nontemporal_load((const nt_u32x4*)p); return make_uint4(v[0], v[1], v[2], v[3]); }
__device__ __forceinline__ uint2 nt_load2u(const void* p) { const nt_u32x2 v = __builtin_nontemporal_load((const nt_u32x2*)p); return make_uint2(v[0], v[1]); }
__device__ __forceinline__ void nt_store4(float* p, float a, float b, float c, float d) { nt_f32x4 v = {a, b, c, d}; __builtin_nontemporal_store(v, (nt_f32x4*)p); }
__device__ __forceinline__ void nt_store4u(void* p, uint4 v) { nt_u32x4 w = {v.x, v.y, v.z, v.w}; __builtin_nontemporal_store(w, (nt_u32x4*)p); }
__device__ __forceinline__ void nt_store2u(void* p, uint2 v) { nt_u32x2 w = {v.x, v.y}; __builtin_nontemporal_store(w, (nt_u32x2*)p); }
__device__ __forceinline__ float silu(float x) { return x / (1.0f + expf(-x)); }


__device__ __forceinline__ unsigned pk_bf16(float lo, float hi) { unsigned r; asm volatile("v_cvt_pk_bf16_f32 %0, %1, %2" : "=v"(r) : "v"(lo), "v"(hi)); return r; }
__device__ __forceinline__ void transpose_convert(const float* __restrict__ W, bf16_t* __restrict__ Wt, int K, int N, float* lds, int wb0, int nwb) {
    const int tid = opaque_tid();
    const int tk = K / 64, tn = N / 256;
    for (int tile = (int)blockIdx.x - wb0; tile < tk * tn; tile += nwb) {
        const int k0 = (tile / tn) * 64, n0 = (tile % tn) * 256;
        __syncthreads();
        float4 v[8];
#pragma unroll
        for (int i = 0; i < 8; ++i) v[i] = nt_load4(W + (size_t)(k0 + (tid >> 6) + 8 * i) * N + n0 + (tid & 63) * 4);
#pragma unroll
        for (int i = 0; i < 8; ++i) { float* d = lds + ((tid >> 6) + 8 * i) * 257 + (tid & 63) * 4; d[0] = v[i].x; d[1] = v[i].y; d[2] = v[i].z; d[3] = v[i].w; }
        __syncthreads();
#pragma unroll
        for (int q = 0; q < 4; ++q) {
            const int c = q * NTHREADS + tid, n = c >> 3, k8 = (c & 7) * 8;
            uint4 o;
            o.x = pk_bf16(lds[(k8 + 0) * 257 + n], lds[(k8 + 1) * 257 + n]); o.y = pk_bf16(lds[(k8 + 2) * 257 + n], lds[(k8 + 3) * 257 + n]);
            o.z = pk_bf16(lds[(k8 + 4) * 257 + n], lds[(k8 + 5) * 257 + n]); o.w = pk_bf16(lds[(k8 + 6) * 257 + n], lds[(k8 + 7) * 257 + n]);
            *(uint4*)(Wt + (size_t)(n0 + n) * K + k0 + k8) = o;
        }
    }
}
__device__ __forceinline__ float wave_max(float v) {
#pragma unroll
    for (int o = 32; o; o >>= 1) v = fmaxf(v, __shfl_xor(v, o));
    return v;
}
__device__ __forceinline__ float block_max(float v, float* red) {
    v = wave_max(v);
    __syncthreads();
    if ((threadIdx.x & 63) == 0) red[threadIdx.x >> 6] = v;
    __syncthreads();
    float s = red[0];
#pragma unroll
    for (int i = 1; i < NWAVES; ++i) s = fmaxf(s, red[i]);
    return s;
}
__device__ __forceinline__ unsigned q4(float a, float b, float c, float d, float inv, int off) {
    const int x = __float2int_rn(a * inv) + off, y = __float2int_rn(b * inv) + off, z = __float2int_rn(c * inv) + off, w = __float2int_rn(d * inv) + off;
    return (unsigned)(x & 255) | ((unsigned)(y & 255) << 8) | ((unsigned)(z & 255) << 16) | ((unsigned)(w & 255) << 24);
}
constexpr int UROW = 1024;
template <int O> __device__ __forceinline__ unsigned nibh8(const float (&x)[16], float inv) {
    unsigned r = 0;
#pragma unroll
    for (int i = 0; i < 8; ++i) r |= (unsigned)min(max((int)floorf(x[O + i] * inv) + 8, 0), 15) << (4 * i);
    return r;
}
__device__ __forceinline__ void quant_tables(const Params& p, int wb0, int nwb) {
    const int tid = opaque_tid(), lane = tid & 63, wv = tid >> 6;
    unsigned char* tq = (unsigned char*)p.ws + B_TQ; float* rsc = p.ws + W_SU;
    const int nw = nwb * NWAVES;
    for (int row0 = ((int)blockIdx.x - wb0) * NWAVES + wv; row0 < 2 * 16384; row0 += 2 * nw) {
        float x[2][2][16]; float mx[2][2];
#pragma unroll
        for (int u = 0; u < 2; ++u) {
            const int row = min(row0 + u * nw, 2 * 16384 - 1);
            const float* src = (row < 16384 ? p.in[I_PU] : p.in[I_PV]) + (size_t)(row & 16383) * D + lane * 4;
#pragma unroll
            for (int h = 0; h < 2; ++h) {
                mx[u][h] = 0.f;
#pragma unroll
                for (int q = 0; q < 4; ++q) { const float4 v = nt_load4(src + (h * 4 + q) * 256); x[u][h][q * 4] = v.x; x[u][h][q * 4 + 1] = v.y; x[u][h][q * 4 + 2] = v.z; x[u][h][q * 4 + 3] = v.w;
                    mx[u][h] = fmaxf(mx[u][h], fmaxf(fmaxf(fabsf(v.x), fabsf(v.y)), fmaxf(fabsf(v.z), fabsf(v.w)))); }
            }
        }
#pragma unroll
        for (int u = 0; u < 2; ++u) {
            const int row = row0 + u * nw;
            if (row < 2 * 16384) {
                const float rmx = wave_max(fmaxf(mx[u][0], mx[u][1]));
                {
                    float ss = 0.f;
#pragma unroll
                    for (int h = 0; h < 2; ++h)
#pragma unroll
                        for (int i = 0; i < 16; ++i) ss += x[u][h][i] * x[u][h][i];
                    const float rms = sqrtf(wave_sum(ss) * (1.0f / 2048.0f));
                    if (row >= 16384) {
                        const float cl = fminf(rmx, 2.94f * rms);
                        const float Rv = cl > 0.f ? cl * (1.0f / 6.0f) : 1.0f, iv = 1.0f / Rv;
                        unsigned w4[4];
#pragma unroll
                        for (int q = 0; q < 4; ++q) {
                            const float* xs = &x[u][q >> 1][(q & 1) * 8];
                            unsigned r = 0u;
                            r = __builtin_amdgcn_cvt_scalef32_pk_fp4_f32(r, xs[0] * iv, xs[1] * iv, 1.0f, 0);
                            r = __builtin_amdgcn_cvt_scalef32_pk_fp4_f32(r, xs[2] * iv, xs[3] * iv, 1.0f, 1);
                            r = __builtin_amdgcn_cvt_scalef32_pk_fp4_f32(r, xs[4] * iv, xs[5] * iv, 1.0f, 2);
                            r = __builtin_amdgcn_cvt_scalef32_pk_fp4_f32(r, xs[6] * iv, xs[7] * iv, 1.0f, 3);
                            w4[q] = r;
                        }
                        nt_store4u(tq + (size_t)row * UROW + lane * 16, make_uint4(w4[0], w4[1], w4[2], w4[3]));
                        if (lane == 0) rsc[row] = Rv;
                        continue;
                    }
                    const float clipv = fminf(rmx, 2.5125f * rms);
                    const float Ru = clipv > 0.f ? clipv * (1.0f / 7.5f) : 1.0f, iu = 1.0f / Ru;
                    const unsigned c0 = nibh8<0>(x[u][0], iu), c1 = nibh8<8>(x[u][0], iu), c2 = nibh8<0>(x[u][1], iu), c3 = nibh8<8>(x[u][1], iu);
                    nt_store4u(tq + (size_t)row * UROW + lane * 16, make_uint4(c0, c1, c2, c3));
                    unsigned cs = __builtin_amdgcn_udot8(c0, 0x11111111u, 0u, false); cs = __builtin_amdgcn_udot8(c1, 0x11111111u, cs, false);
                    cs = __builtin_amdgcn_udot8(c2, 0x11111111u, cs, false); cs = __builtin_amdgcn_udot8(c3, 0x11111111u, cs, false);
                    const float csum = wave_sum((float)cs);
                    if (lane == 0) { rsc[row] = Ru; (p.ws + W_SC)[row] = csum; }
                }
            }
        }
    }
}

__device__ __forceinline__ void naive_gemm(const float* __restrict__ A, int lda, const float* __restrict__ Bm, int ldb,
                                           float* __restrict__ C, int ldc, int M, int N, int K, float* lds) {
    float* As = lds;
    float* Bs = lds + 16 * 132;
    const int tid = opaque_tid(), tx = tid & 31, ty = tid >> 5;
    const int tilesN = N / 128, ntiles = (M / 128) * tilesN;
    for (int tile = blockIdx.x; tile < ntiles; tile += gridDim.x) {
        const int m0 = (tile / tilesN) * 128, n0 = (tile % tilesN) * 128;
        float acc[8][4];
#pragma unroll
        for (int i = 0; i < 8; ++i)
#pragma unroll
            for (int j = 0; j < 4; ++j) acc[i][j] = 0.f;
        for (int k0 = 0; k0 < K; k0 += 16) {
            {
                const int row = tid >> 2, kq = (tid & 3) * 4;
                const float4 a = *(const float4*)(A + (size_t)(m0 + row) * lda + k0 + kq);
                As[(kq + 0) * 132 + row] = a.x; As[(kq + 1) * 132 + row] = a.y; As[(kq + 2) * 132 + row] = a.z; As[(kq + 3) * 132 + row] = a.w;
                const int kk = tid >> 5, n4 = (tid & 31) * 4;
                *(float4*)(Bs + kk * 128 + n4) = *(const float4*)(Bm + (size_t)(k0 + kk) * ldb + n0 + n4);
            }
            __syncthreads();
#pragma unroll 4
            for (int k = 0; k < 16; ++k) {
                const float4 a0 = *(const float4*)(As + k * 132 + ty * 8), a1 = *(const float4*)(As + k * 132 + ty * 8 + 4);
                const float4 b = *(const float4*)(Bs + k * 128 + tx * 4);
                const float av[8] = {a0.x, a0.y, a0.z, a0.w, a1.x, a1.y, a1.z, a1.w};
                const float bv[4] = {b.x, b.y, b.z, b.w};
#pragma unroll
                for (int i = 0; i < 8; ++i)
#pragma unroll
                    for (int j = 0; j < 4; ++j) acc[i][j] += av[i] * bv[j];
            }
            __syncthreads();
        }
#pragma unroll
        for (int i = 0; i < 8; ++i)
            *(float4*)(C + (size_t)(m0 + ty * 8 + i) * ldc + n0 + tx * 4) = make_float4(acc[i][0], acc[i][1], acc[i][2], acc[i][3]);
    }
}

__device__ __forceinline__ void phase_a(const Params& p, float* lds) {
    const int tid = opaque_tid();
    const float* c = p.in[I_C]; const float* cctx = p.in[I_CCTX]; const float* wada = p.in[I_WADA];
    float* part = p.ws + W_ADAP;
    for (int item = blockIdx.x; item < 32 * 24; item += gridDim.x) {
        const int ks = item / 24, j = (item % 24) * 512 + tid;
        __syncthreads();
        if (tid < 5 * 64) { const int n = tid >> 6, k = ks * 64 + (tid & 63); lds[tid] = silu(n < 4 ? c[n * 2048 + k] : cctx[k]); }
        __syncthreads();
        float a0 = 0.f, a1 = 0.f, a2 = 0.f, a3 = 0.f, a4 = 0.f;
#pragma unroll 32
        for (int kk = 0; kk < 64; ++kk) {
            const float w = __builtin_nontemporal_load(wada + (size_t)(ks * 64 + kk) * 12288 + j);
            a0 += lds[kk] * w; a1 += lds[64 + kk] * w; a2 += lds[128 + kk] * w; a3 += lds[192 + kk] * w; a4 += lds[256 + kk] * w;
        }
        part[(size_t)(ks * 5 + 0) * 12288 + j] = a0; part[(size_t)(ks * 5 + 1) * 12288 + j] = a1; part[(size_t)(ks * 5 + 2) * 12288 + j] = a2;
        part[(size_t)(ks * 5 + 3) * 12288 + j] = a3; part[(size_t)(ks * 5 + 4) * 12288 + j] = a4;
    }
}
typedef short bf16x8v __attribute__((ext_vector_type(8)));
typedef float f32x4v __attribute__((ext_vector_type(4)));
typedef float f32x16v __attribute__((ext_vector_type(16)));
__device__ __forceinline__ void phase_filters(const Params& p, float* lds) {
    const int tid = opaque_tid();
    const float* w1 = p.in[I_FW1]; const float* b1 = p.in[I_FB1]; const float* w2 = p.in[I_FW2]; const float* b2 = p.in[I_FB2];
    const float* w3 = p.in[I_FW3]; const float* b3 = p.in[I_FB3]; const float* w4 = p.in[I_FW4]; const float* freq = p.in[I_FREQ];
    float* hT = (float*)((char*)p.ws + B_KF); float* sp = p.ws + W_SP;
    float* zf = lds; float* ha = lds + 64 * 36; float* hb = ha + 64 * 68; float* red2 = hb + 64 * 68;
    float* W1 = red2 + 256; float* W2 = W1 + 33 * 64; float* W3 = W2 + 64 * 64;
    __syncthreads();
    for (int e = tid; e < 33 * 64; e += NTHREADS) W1[e] = w1[e];
    for (int e = tid; e < 64 * 64; e += NTHREADS) { W2[e] = w2[e]; W3[e] = w3[e]; }
    for (int item = blockIdx.x; item < 256; item += gridDim.x) {
        const int pt = item >> 3;
        __syncthreads();
        for (int e = tid; e < 64 * 33; e += NTHREADS) {
            const int pos = e / 33, m = e % 33, i = pt * 64 + pos;
            const float t = (float)i / 2047.0f, w = 6.283185307179586f * (float)i / 2048.0f;
            float v;
            if (m == 0) v = t;
            else if (m <= 16) { const float f = 1e-4f + (float)(m - 1) * ((15.0f - 1e-4f) / 15.0f); v = __cosf(f * w); }
            else { const float f = 1e-4f + (float)(m - 17) * ((15.0f - 1e-4f) / 15.0f); v = -__sinf(f * w); }
            zf[pos * 36 + m] = v;
        }
        __syncthreads();
        const int pos = tid >> 3, u0 = (tid & 7) * 8;
        {
            float a[8];
#pragma unroll
            for (int u = 0; u < 8; ++u) a[u] = b1[u0 + u];
#pragma unroll 11
            for (int m = 0; m < 33; ++m) { const float zv = zf[pos * 36 + m]; const float4 wa = *(const float4*)(W1 + m * 64 + u0), wb = *(const float4*)(W1 + m * 64 + u0 + 4);
                a[0] += zv * wa.x; a[1] += zv * wa.y; a[2] += zv * wa.z; a[3] += zv * wa.w; a[4] += zv * wb.x; a[5] += zv * wb.y; a[6] += zv * wb.z; a[7] += zv * wb.w; }
#pragma unroll
            for (int u = 0; u < 8; ++u) ha[pos * 68 + u0 + u] = __sinf(freq[u0 + u] * a[u]);
        }
        __syncthreads();
        {
            float a[8];
#pragma unroll
            for (int u = 0; u < 8; ++u) a[u] = b2[u0 + u];
#pragma unroll 16
            for (int m = 0; m < 64; ++m) { const float zv = ha[pos * 68 + m]; const float4 wa = *(const float4*)(W2 + m * 64 + u0), wb = *(const float4*)(W2 + m * 64 + u0 + 4);
                a[0] += zv * wa.x; a[1] += zv * wa.y; a[2] += zv * wa.z; a[3] += zv * wa.w; a[4] += zv * wb.x; a[5] += zv * wb.y; a[6] += zv * wb.z; a[7] += zv * wb.w; }
#pragma unroll
            for (int u = 0; u < 8; ++u) hb[pos * 68 + u0 + u] = __sinf(freq[64 + u0 + u] * a[u]);
        }
        __syncthreads();
        {
            float a[8];
#pragma unroll
            for (int u = 0; u < 8; ++u) a[u] = b3[u0 + u];
#pragma unroll 16
            for (int m = 0; m < 64; ++m) { const float zv = hb[pos * 68 + m]; const float4 wa = *(const float4*)(W3 + m * 64 + u0), wb = *(const float4*)(W3 + m * 64 + u0 + 4);
                a[0] += zv * wa.x; a[1] += zv * wa.y; a[2] += zv * wa.z; a[3] += zv * wa.w; a[4] += zv * wb.x; a[5] += zv * wb.y; a[6] += zv * wb.z; a[7] += zv * wb.w; }
#pragma unroll
            for (int u = 0; u < 8; ++u) ha[pos * 68 + u0 + u] = __sinf(freq[128 + u0 + u] * a[u]);
        }
        __syncthreads();
#pragma unroll 1
        for (int jt = (item & 7) * 2; jt < (item & 7) * 2 + 2; ++jt) {
            const int lane = tid & 63, wv = tid >> 6, cl = lane & 15, g = lane >> 4;
            union frag { unsigned u[4]; bf16x8v v; };
            frag af[2][2];
#pragma unroll
            for (int mt = 0; mt < 2; ++mt)
#pragma unroll
                for (int ks = 0; ks < 2; ++ks) {
                    const float* wp = w4 + (size_t)(ks * 32 + 8 * g) * 4096 + jt * 256 + wv * 32 + mt * 16 + cl;
                    float x[8];
#pragma unroll
                    for (int i = 0; i < 8; ++i) x[i] = wp[(size_t)i * 4096];
                    af[mt][ks].u[0] = pk_bf16(x[0], x[1]); af[mt][ks].u[1] = pk_bf16(x[2], x[3]); af[mt][ks].u[2] = pk_bf16(x[4], x[5]); af[mt][ks].u[3] = pk_bf16(x[6], x[7]);
                }
            f32x4v acc[2][4];
#pragma unroll
            for (int mt = 0; mt < 2; ++mt)
#pragma unroll
                for (int nt = 0; nt < 4; ++nt) acc[mt][nt] = (f32x4v){0.f, 0.f, 0.f, 0.f};
#pragma unroll
            for (int nt = 0; nt < 4; ++nt)
#pragma unroll
                for (int ks = 0; ks < 2; ++ks) {
                    const float4 h0 = *(const float4*)(ha + (nt * 16 + cl) * 68 + ks * 32 + 8 * g), h1 = *(const float4*)(ha + (nt * 16 + cl) * 68 + ks * 32 + 8 * g + 4);
                    frag bf; bf.u[0] = pk_bf16(h0.x, h0.y); bf.u[1] = pk_bf16(h0.z, h0.w); bf.u[2] = pk_bf16(h1.x, h1.y); bf.u[3] = pk_bf16(h1.z, h1.w);
#pragma unroll
                    for (int mt = 0; mt < 2; ++mt) acc[mt][nt] = __builtin_amdgcn_mfma_f32_16x16x32_bf16(af[mt][ks].v, bf.v, acc[mt][nt], 0, 0, 0);
                }
#pragma unroll
            for (int mt = 0; mt < 2; ++mt)
#pragma unroll
                for (int r = 0; r < 4; ++r) {
                    const int j = jt * 256 + wv * 32 + mt * 16 + 4 * g + r;
                    const float delta = 3.070113457f + (float)(j & 1023) * ((15.35056729f - 3.070113457f) / 1023.0f);
                    float asum = 0.f;
#pragma unroll
                    for (int nt = 0; nt < 4; ++nt) {
                        const int ps = pt * 64 + nt * 16 + cl;
                        const float val = acc[mt][nt][r] * __expf(-((float)ps / 2047.0f) * delta);
                        asum += fabsf(val);
                        __builtin_nontemporal_store(val, hT + (size_t)j * SL + ps);
                    }
                    asum += __shfl_xor(asum, 1); asum += __shfl_xor(asum, 2); asum += __shfl_xor(asum, 4); asum += __shfl_xor(asum, 8);
                    if (cl == 0) sp[(size_t)pt * 4096 + j] = asum;
                }
        }
    }
}

__device__ __forceinline__ void phase_b(const Params& p) {
    const int tid = opaque_tid();
    const float* part = p.ws + W_ADAP; float* ada = p.ws + W_ADA; const float* bada = p.in[I_BADA];
    for (int e = blockIdx.x * NTHREADS + tid; e < 5 * 12288; e += gridDim.x * NTHREADS) {
        float s = bada[e % 12288];
#pragma unroll 8
        for (int ks = 0; ks < 32; ++ks) s += part[(size_t)ks * 5 * 12288 + e];
        ada[e] = s;
    }
    const float* sp = p.ws + W_SP; float* fs = p.ws + W_FS;
    for (int j = blockIdx.x * NTHREADS + tid; j < 4096; j += gridDim.x * NTHREADS) {
        float s = 0.f;
#pragma unroll 8
        for (int pt = 0; pt < 32; ++pt) s += sp[(size_t)pt * 4096 + j];
        fs[j] = s;
    }
}

__device__ __forceinline__ void phase_c(const Params& p) {
    const int tid = opaque_tid();
    const float* ada = p.ws + W_ADA;
    const float* x = p.in[I_X]; bf16_t* ub = (bf16_t*)((char*)p.ws + B_UB);
    for (size_t e = (size_t)blockIdx.x * NTHREADS + tid; e < (size_t)NT * D / 4; e += (size_t)gridDim.x * NTHREADS) {
        const size_t row = e / (D / 4); const int col = (int)(e % (D / 4)) * 4; const int b = (int)(row / SL);
        const float4 xv = nt_load4(x + row * D + col);
        const float4 sh = *(const float4*)(ada + b * 12288 + col), sc = *(const float4*)(ada + b * 12288 + 2048 + col);
        uint2 o; o.x = pk_bf16(xv.x * (1.f + sc.x) + sh.x, xv.y * (1.f + sc.y) + sh.y); o.y = pk_bf16(xv.z * (1.f + sc.z) + sh.z, xv.w * (1.f + sc.w) + sh.w);
        *(uint2*)(ub + row * D + col) = o;
    }
    const float* ctx = p.in[I_CTX]; bf16_t* ucb = ub + (size_t)NT * D;
    for (size_t e = (size_t)blockIdx.x * NTHREADS + tid; e < (size_t)NTC * D / 4; e += (size_t)gridDim.x * NTHREADS) {
        const size_t row = e / (D / 4); const int col = (int)(e % (D / 4)) * 4;
        const float4 xv = nt_load4(ctx + row * D + col);
        const float4 sh = *(const float4*)(ada + 4 * 12288 + col), sc = *(const float4*)(ada + 4 * 12288 + 2048 + col);
        uint2 o; o.x = pk_bf16(xv.x * (1.f + sc.x) + sh.x, xv.y * (1.f + sc.y) + sh.y); o.y = pk_bf16(xv.z * (1.f + sc.z) + sh.z, xv.w * (1.f + sc.w) + sh.w);
        *(uint2*)(ucb + row * D + col) = o;
    }
}

__device__ __forceinline__ float bf2f(bf16_t v) { return __uint_as_float(((unsigned)v) << 16); }
constexpr int HY_PB = 4416, HY_PJ = 272, HY_R0 = 4 * HY_PB, HY_R1 = HY_R0 + 8192 + 64, HY_SLOT = HY_R1 + 8192 + 64;
static_assert(HY_SLOT % 16 == 0 && 4 * HY_SLOT + 64 <= 155 * 1024, "hyena LDS");
__device__ __forceinline__ bf16x8v hy_lda(const unsigned char* base, int off) {
    const unsigned* q = (const unsigned*)(base + off);
    union { unsigned u[4]; bf16x8v v; } r; r.u[0] = q[0]; r.u[1] = q[1]; r.u[2] = q[2]; r.u[3] = q[3];
    return r.v;
}
__device__ __forceinline__ void hy_stage_rows(const bf16_t* zT, const float* cw, const float* cb, int ch, int half, int lane, unsigned char* sl) {
    const float w0 = cw[ch], w1 = cw[3072 + ch], w2 = cw[6144 + ch], bs = cb[ch];
#pragma unroll 4
    for (int q = 0; q < 8; ++q) {
        const int bsel = 2 * half + (q >> 2), t0 = ((q & 3) * 64 + lane) * 8;
        const bf16_t* zrow = zT + (size_t)ch * NT + bsel * SL;
        const uint4 raw = nt_load4u(zrow + t0);
        float z[10];
        z[0] = t0 > 0 ? bf2f(zrow[t0 - 1]) : 0.f; z[9] = t0 + 8 < SL ? bf2f(zrow[t0 + 8]) : 0.f;
        z[1] = __uint_as_float(raw.x << 16); z[2] = __uint_as_float(raw.x & 0xffff0000u); z[3] = __uint_as_float(raw.y << 16); z[4] = __uint_as_float(raw.y & 0xffff0000u);
        z[5] = __uint_as_float(raw.z << 16); z[6] = __uint_as_float(raw.z & 0xffff0000u); z[7] = __uint_as_float(raw.w << 16); z[8] = __uint_as_float(raw.w & 0xffff0000u);
        float sv[8];
#pragma unroll
        for (int i = 0; i < 8; ++i) sv[i] = w0 * z[i] + w1 * z[i + 1] + w2 * z[i + 2] + bs;
        uint4 o; o.x = pk_bf16(sv[0], sv[1]); o.y = pk_bf16(sv[2], sv[3]); o.z = pk_bf16(sv[4], sv[5]); o.w = pk_bf16(sv[6], sv[7]);
        *(uint4*)(sl + bsel * HY_PB + (t0 >> 7) * HY_PJ + (t0 & 127) * 2) = o;
    }
}
__device__ __forceinline__ void hy_pair_sync(volatile __attribute__((address_space(3))) unsigned* fl, int wv, unsigned n) {
    asm volatile("s_waitcnt lgkmcnt(0)" ::: "memory");
    fl[wv] = n;
    while (fl[wv ^ 1] < n) __builtin_amdgcn_s_sleep(0);
    asm volatile("" ::: "memory");
}
__device__ __forceinline__ void phase_hyena(const Params& p, unsigned char* smem) {
    const int tid = opaque_tid(), lane = tid & 63, wv = tid >> 6, slot = wv >> 1, half = wv & 1, pt = tid & 127;
    const bf16_t* zT = (const bf16_t*)((const char*)p.ws + B_ZT); const float* hT = (const float*)((const char*)p.ws + B_KF); const float* fs = p.ws + W_FS; bf16_t* hyT = (bf16_t*)((char*)p.ws + B_HYT);
    const float* cw = p.in[I_CONVW]; const float* cb = p.in[I_CONVB]; const float* skip = p.in[I_SKIP];
    unsigned char* sl = smem + slot * HY_SLOT;
    const int a_ = lane & 31, hh = lane >> 5, i_local = a_ >> 2, batch = a_ & 3, I0 = 8 * half;
    const int laneA = ((a_ & 1) ? HY_R0 : HY_R1) + 2 * (2047 - a_ - (1 - (a_ & 1)) + 8 * hh);
    volatile __attribute__((address_space(3))) unsigned* fl = (volatile __attribute__((address_space(3))) unsigned*)(smem + 4 * HY_SLOT);
    unsigned seq = 0u;
    __syncthreads();
    if (tid < 8) fl[tid] = 0u;
    if (wv < 4) __builtin_amdgcn_s_setprio(2);
    for (int item = blockIdx.x; item < DHY / 4; item += gridDim.x) {
        const int c = item * 4 + slot;
        __syncthreads();
        hy_stage_rows(zT, cw, cb, c, half, lane, sl);
#pragma unroll 1
        for (int ord = 0; ord < 2; ++ord) {
            {
                const float* hf = hT + (size_t)((ord * 2 + 0) * 1024 + c) * SL; const float* hbk = hT + (size_t)((ord * 2 + 1) * 1024 + c) * SL;
                const float sk = skip[ord * 1024 + c]; const float invs = 1.0f / (fs[(ord * 2 + 0) * 1024 + c] + fs[(ord * 2 + 1) * 1024 + c]);
#pragma unroll
                for (int q = 0; q < 4; ++q) {
                    const int X0 = (q * 128 + pt) * 8;
                    float rv[9];
#pragma unroll
                    for (int i = 0; i < 9; ++i) { const int dp = 2047 - X0 - i; rv[i] = (dp >= 0 ? __builtin_nontemporal_load(hf + dp) : (dp >= -2047 ? __builtin_nontemporal_load(hbk - dp) : 0.f)) * invs; if (dp == 0) rv[i] += sk; }
                    uint4 o0, o1;
                    o0.x = pk_bf16(rv[0], rv[1]); o0.y = pk_bf16(rv[2], rv[3]); o0.z = pk_bf16(rv[4], rv[5]); o0.w = pk_bf16(rv[6], rv[7]);
                    o1.x = pk_bf16(rv[1], rv[2]); o1.y = pk_bf16(rv[3], rv[4]); o1.z = pk_bf16(rv[5], rv[6]); o1.w = pk_bf16(rv[7], rv[8]);
                    *(uint4*)(sl + HY_R0 + X0 * 2) = o0; *(uint4*)(sl + HY_R1 + X0 * 2) = o1;
                }
            }
            hy_pair_sync(fl, wv, ++seq);
            f32x16v acc[4];
#pragma unroll
            for (int mb = 0; mb < 4; ++mb)
#pragma unroll
                for (int e = 0; e < 16; ++e) acc[mb][e] = 0.f;
            {
                const int dlo = I0 - 15, dhi = I0 + 7;
                bf16x8v As[7][2];
#pragma unroll
                for (int s2 = 0; s2 < 3; ++s2)
#pragma unroll
                    for (int k2 = 0; k2 < 2; ++k2) As[4 + s2][k2] = hy_lda(sl, laneA - 64 * (4 * dlo - 3 + s2) + 32 * k2);
#pragma unroll 1
                for (int d = dlo; d <= dhi; ++d) {
#pragma unroll
                    for (int k2 = 0; k2 < 2; ++k2) { As[0][k2] = As[4][k2]; As[1][k2] = As[5][k2]; As[2][k2] = As[6][k2]; }
#pragma unroll
                    for (int s2 = 3; s2 < 7; ++s2)
#pragma unroll
                        for (int k2 = 0; k2 < 2; ++k2) As[s2][k2] = hy_lda(sl, laneA - 64 * (4 * d - 3 + s2) + 32 * k2);
                    const int jl = I0 + i_local - d; const bool valid = (unsigned)jl < 16u;
                    const unsigned char* bp = sl + batch * HY_PB + (valid ? jl : 0) * HY_PJ + hh * 16;
                    bf16x8v Bq[8];
#pragma unroll
                    for (int q = 0; q < 8; ++q) { const bf16x8v v = *(const bf16x8v*)(bp + q * 32); const bf16x8v zero = {0, 0, 0, 0, 0, 0, 0, 0}; Bq[q] = valid ? v : zero; }
#pragma unroll
                    for (int kb = 0; kb < 4; ++kb)
#pragma unroll
                        for (int k2 = 0; k2 < 2; ++k2)
#pragma unroll
                            for (int mb = 0; mb < 4; ++mb) acc[mb] = __builtin_amdgcn_mfma_f32_32x32x16_bf16(As[mb - kb + 3][k2], Bq[2 * kb + k2], acc[mb], 0, 0, 0);
                }
            }
            hy_pair_sync(fl, wv, ++seq);
            hy_stage_rows(zT, cw, cb, (ord == 0 ? 1024 : 2048) + c, half, lane, sl);
            hy_pair_sync(fl, wv, ++seq);
            {
#pragma unroll
                for (int mb = 0; mb < 4; ++mb)
#pragma unroll
                    for (int q4 = 0; q4 < 4; ++q4) {
                        const int t4 = 128 * (I0 + i_local) + 32 * mb + 8 * q4 + 4 * hh;
                        uint2* gp = (uint2*)(sl + batch * HY_PB + (t4 >> 7) * HY_PJ + (t4 & 127) * 2);
                        const uint2 gv = *gp;
                        uint2 o; o.x = pk_bf16(__uint_as_float(gv.x << 16) * acc[mb][q4 * 4 + 0], __uint_as_float(gv.x & 0xffff0000u) * acc[mb][q4 * 4 + 1]);
                        o.y = pk_bf16(__uint_as_float(gv.y << 16) * acc[mb][q4 * 4 + 2], __uint_as_float(gv.y & 0xffff0000u) * acc[mb][q4 * 4 + 3]);
                        *gp = o;
                    }
            }
            if (ord == 1) {
                hy_pair_sync(fl, wv, ++seq);
#pragma unroll
                for (int q = 0; q < 8; ++q) {
                    const int bsel = 2 * half + (q >> 2), t0 = ((q & 3) * 64 + lane) * 8;
                    nt_store4u(hyT + (size_t)c * NT + bsel * SL + t0, *(const uint4*)(sl + bsel * HY_PB + (t0 >> 7) * HY_PJ + (t0 & 127) * 2));
                }
            }
        }
    }
    __builtin_amdgcn_s_setprio(0);
}

__device__ __forceinline__ bf16x8v pack_p(const f32x4v& lo, const f32x4v& hi) {
    union { unsigned u[4]; bf16x8v v; } r;
    r.u[0] = pk_bf16(lo[0], lo[1]); r.u[1] = pk_bf16(lo[2], lo[3]); r.u[2] = pk_bf16(hi[0], hi[1]); r.u[3] = pk_bf16(hi[2], hi[3]);
    return r.v;
}
__device__ __forceinline__ bf16x8v ld_pair8(const bf16_t* lo, const bf16_t* hi) {
    union { uint2 d[2]; bf16x8v v; } r;
    r.d[0] = *(const uint2*)lo; r.d[1] = *(const uint2*)hi;
    return r.v;
}
typedef __attribute__((address_space(3))) const bf16_t* lds_bf16p;
#define LDS_FRAG(pe) (*(const __attribute__((address_space(3))) bf16x8v*)(pe))
constexpr int NA_KC = 0, NA_VC = 32768, NA_KL = 65536, NA_RPB = 155648;
__device__ __forceinline__ void phase_na(const Params& p, unsigned char* smem) {
    const int tid = opaque_tid(), lane = tid & 63, wv = tid >> 6, ql = lane & 15, g = lane >> 4;
    const bf16_t* qh = (const bf16_t*)((const char*)p.ws + B_QH); const bf16_t* kh = (const bf16_t*)((const char*)p.ws + B_KH);
    const bf16_t* kch = (const bf16_t*)((const char*)p.ws + B_KCH); const bf16_t* vT = (const bf16_t*)((const char*)p.ws + B_VT);
    const bf16_t* vcT = (const bf16_t*)((const char*)p.ws + B_VCT); bf16_t* na = (bf16_t*)((char*)p.ws + B_NA);
    const float* rpb = p.in[I_RPB];
    const lds_bf16p kcl = (lds_bf16p)((__attribute__((address_space(3))) unsigned char*)smem + NA_KC);
    const lds_bf16p vcl = (lds_bf16p)((__attribute__((address_space(3))) unsigned char*)smem + NA_VC);
    const lds_bf16p kll = (lds_bf16p)((__attribute__((address_space(3))) unsigned char*)smem + NA_KL);
    for (int sitem = blockIdx.x; sitem < 256; sitem += gridDim.x) {
      const int b = sitem >> 6, h = (sitem >> 2) & 15, rqp = sitem & 3;
      __syncthreads();
      {
          const uint4* s0 = (const uint4*)(kch + (size_t)((b * 16 + h) * 32) * 512); const uint4* s1 = (const uint4*)(vcT + (size_t)((b * 16 + h) * 32) * 512);
          uint4* d0 = (uint4*)(smem + NA_KC); uint4* d1 = (uint4*)(smem + NA_VC);
#pragma unroll
          for (int i = 0; i < 4; ++i) { d0[tid + i * NTHREADS] = s0[tid + i * NTHREADS]; d1[tid + i * NTHREADS] = s1[tid + i * NTHREADS]; }
          if (tid < 465) ((float*)(smem + NA_RPB))[tid] = rpb[h * 465 + tid];
      }
#pragma unroll 1
      for (int half = 0; half < 2; ++half) {
        const int r0 = rqp * 8 + half * 4;
        const int rs_min = min(max(r0 - 4, 0), 24), rs_max = min(max(r0 - 1, 0), 24), nrows = rs_max - rs_min + 8;
        if (half) __syncthreads();
        {
            const uint4* s0 = (const uint4*)(kh + (size_t)((b * 16 + h) * 256 + rs_min * 8) * 512); uint4* d0 = (uint4*)(smem + NA_KL);
            for (int e = tid; e < nrows * 512; e += NTHREADS) d0[e] = s0[e];
        }
        __syncthreads();
#pragma unroll 1
        for (int ti = 0; ti < 2; ++ti) {
        const int r = r0 + (wv >> 2) + 2 * ti, j = wv & 3;
        const int rs = min(max(r - 4, 0), 24), cs = min(max(16 * j - 8, 0), 32);
        const int x = 16 * j + ql, wsx = min(max(x - 8, 0), 48);
        const bf16_t* qrow = qh + ((size_t)((b * 16 + h) * SL + r * 64 + x)) * 64;
        const bf16x8v qf0 = __builtin_nontemporal_load((const bf16x8v*)(qrow + 8 * g)), qf1 = __builtin_nontemporal_load((const bf16x8v*)(qrow + 32 + 8 * g));
        const __attribute__((address_space(3))) float* rp_h = (const __attribute__((address_space(3))) float*)((__attribute__((address_space(3))) unsigned char*)smem + NA_RPB);
        f32x4v o1[4], o2[4]; float m1 = -1e30f, l1 = 0.f, m2 = -1e30f, l2 = 0.f;
#pragma unroll
        for (int d = 0; d < 4; ++d) { o1[d] = (f32x4v){0.f, 0.f, 0.f, 0.f}; o2[d] = (f32x4v){0.f, 0.f, 0.f, 0.f}; }
        const int koff = (ql >> 2) * 512 + g * 32 + (ql & 3) * 8;
        const bf16_t* vb = vT + (size_t)((b * 16 + h) * 256 + g) * 512 + ql * 8;
        {
            f32x4v st[16];
#pragma unroll
            for (int kb = 0; kb < 16; ++kb) {
                const lds_bf16p kp = kcl + koff + (kb >> 1) * 2048 + (kb & 1) * 128;
                const bf16x8v a0 = LDS_FRAG(kp), a1 = LDS_FRAG(kp + 256);
                f32x4v acc = {0.f, 0.f, 0.f, 0.f};
                acc = __builtin_amdgcn_mfma_f32_16x16x32_bf16(a0, qf0, acc, 0, 0, 0);
                acc = __builtin_amdgcn_mfma_f32_16x16x32_bf16(a1, qf1, acc, 0, 0, 0);
#pragma unroll
                for (int rr = 0; rr < 4; ++rr) { acc[rr] *= 0.125f; m1 = fmaxf(m1, acc[rr]); }
                st[kb] = acc;
            }
            m1 = fmaxf(m1, __shfl_xor(m1, 16)); m1 = fmaxf(m1, __shfl_xor(m1, 32));
#pragma unroll
            for (int kb = 0; kb < 16; ++kb)
#pragma unroll
                for (int rr = 0; rr < 4; ++rr) { const float e = __expf(st[kb][rr] - m1); st[kb][rr] = e; l1 += e; }
            l1 += __shfl_xor(l1, 16); l1 += __shfl_xor(l1, 32);
#pragma unroll
            for (int kp = 0; kp < 8; ++kp) {
                const bf16x8v pb = pack_p(st[2 * kp], st[2 * kp + 1]);
#pragma unroll
                for (int d = 0; d < 4; ++d) o1[d] = __builtin_amdgcn_mfma_f32_16x16x32_bf16(LDS_FRAG(vcl + g * 512 + ql * 8 + kp * 2048 + d * 128), pb, o1[d], 0, 0, 0);
            }
        }
        {
            f32x4v st[16];
#pragma unroll
            for (int kb = 0; kb < 16; ++kb) {
                const lds_bf16p kp = kll + koff + ((((rs + (kb >> 1) - rs_min) * 64 + cs) >> 3) * 512) + (kb & 1) * 128;
                const bf16x8v a0 = LDS_FRAG(kp), a1 = LDS_FRAG(kp + 256);
                f32x4v acc = {0.f, 0.f, 0.f, 0.f};
                acc = __builtin_amdgcn_mfma_f32_16x16x32_bf16(a0, qf0, acc, 0, 0, 0);
                acc = __builtin_amdgcn_mfma_f32_16x16x32_bf16(a1, qf1, acc, 0, 0, 0);
                const int dr = rs + (kb >> 1) - r + 7;
#pragma unroll
                for (int rr = 0; rr < 4; ++rr) {
                    const int kc = cs + 8 * g + 4 * (kb & 1) + rr, rel = kc - wsx;
                    const bool ok = rel >= 0 && rel < 16;
                    const int dc = min(max(kc - x + 15, 0), 30);
                    const float sv = ok ? acc[rr] * 0.125f + rp_h[dr * 31 + dc] : -1e30f;
                    acc[rr] = sv; m2 = fmaxf(m2, sv);
                }
                st[kb] = acc;
                if ((kb & 7) == 7) asm volatile("" ::: "memory");
            }
            m2 = fmaxf(m2, __shfl_xor(m2, 16)); m2 = fmaxf(m2, __shfl_xor(m2, 32));
#pragma unroll
            for (int kb = 0; kb < 16; ++kb)
#pragma unroll
                for (int rr = 0; rr < 4; ++rr) { const float e = __expf(st[kb][rr] - m2); st[kb][rr] = e; l2 += e; }
            l2 += __shfl_xor(l2, 16); l2 += __shfl_xor(l2, 32);
#pragma unroll
            for (int kp = 0; kp < 8; ++kp) {
                const bf16x8v pb = pack_p(st[2 * kp], st[2 * kp + 1]);
                const bf16_t* vp = vb + (size_t)(((rs + kp) * 64 + cs) >> 3) * 512;
#pragma unroll
                for (int d = 0; d < 4; ++d) o2[d] = __builtin_amdgcn_mfma_f32_16x16x32_bf16(*(const bf16x8v*)(vp + d * 128), pb, o2[d], 0, 0, 0);
                if ((kp & 3) == 3) asm volatile("" ::: "memory");
            }
        }
        const float mm = fmaxf(m1, m2), c1 = __expf(m1 - mm), c2 = __expf(m2 - mm);
        const float inv = 1.0f / (c1 * l1 + c2 * l2);
        const float w1 = c1 * inv, w2 = c2 * inv;
        f32x4v o[4];
#pragma unroll
        for (int d = 0; d < 4; ++d) o[d] = o1[d] * w1 + o2[d] * w2;
        bf16_t* op = na + (size_t)(b * SL + r * 64 + x) * DNA + h * 64 + 4 * g;
#pragma unroll
        for (int d = 0; d < 4; ++d) { uint2 w; w.x = pk_bf16(o[d][0], o[d][1]); w.y = pk_bf16(o[d][2], o[d][3]); nt_store2u(op + 16 * d, w); }
        }
      }
    }
}

__device__ __forceinline__ void phase_f(const Params& p, float* ldsf) {
    const int tid = opaque_tid();
    const bf16_t* hyT = (const bf16_t*)((const char*)p.ws + B_HYT); const bf16_t* na = (const bf16_t*)((const char*)p.ws + B_NA);
    bf16_t* ob = (bf16_t*)((char*)p.ws + B_UB);
    const float* ghy = p.in[I_GHY]; const float* gna = p.in[I_GNA];
    bf16_t* tile = (bf16_t*)ldsf;
    for (int item = blockIdx.x; item < NT / 32; item += gridDim.x) {
        const int t0 = item * 32;
        __syncthreads();
        uint4 hvv[8];
#pragma unroll
        for (int q = 0; q < 8; ++q) { const int e = q * NTHREADS + tid; hvv[q] = nt_load4u(hyT + (size_t)(e >> 2) * NT + t0 + (e & 3) * 8); }
#pragma unroll
        for (int q = 0; q < 8; ++q) {
            const int e = q * NTHREADS + tid, ch = e >> 2, part = e & 3;
            const unsigned wd[4] = {hvv[q].x, hvv[q].y, hvv[q].z, hvv[q].w};
#pragma unroll
            for (int i = 0; i < 4; ++i) { tile[(part * 8 + 2 * i) * 1032 + ch] = (bf16_t)(wd[i] & 0xffffu); tile[(part * 8 + 2 * i + 1) * 1032 + ch] = (bf16_t)(wd[i] >> 16); }
        }
        __syncthreads();
        const int tk = tid >> 4, sub = tid & 15;
        float hv[64]; float sh = 0.f, sn = 0.f;
#pragma unroll
        for (int i = 0; i < 8; ++i) {
            const uint4 v = *(const uint4*)(tile + tk * 1032 + (i * 16 + sub) * 8);
            const unsigned wd[4] = {v.x, v.y, v.z, v.w};
#pragma unroll
            for (int k = 0; k < 4; ++k) { const float a = __uint_as_float(wd[k] << 16), c = __uint_as_float(wd[k] & 0xffff0000u); hv[i * 8 + 2 * k] = a; hv[i * 8 + 2 * k + 1] = c; sh += a * a + c * c; }
        }
        const bf16_t* nrow = na + (size_t)(t0 + tk) * DNA;
        uint4 nv[8];
#pragma unroll
        for (int i = 0; i < 8; ++i) { nv[i] = nt_load4u(nrow + (i * 16 + sub) * 8);
            const unsigned wd[4] = {nv[i].x, nv[i].y, nv[i].z, nv[i].w};
#pragma unroll
            for (int k = 0; k < 4; ++k) { const float a = __uint_as_float(wd[k] << 16), c = __uint_as_float(wd[k] & 0xffff0000u); sn += a * a + c * c; } }
        sh += __shfl_xor(sh, 1); sh += __shfl_xor(sh, 2); sh += __shfl_xor(sh, 4); sh += __shfl_xor(sh, 8);
        sn += __shfl_xor(sn, 1); sn += __shfl_xor(sn, 2); sn += __shfl_xor(sn, 4); sn += __shfl_xor(sn, 8);
        const float rh = rsqrtf(sh * (1.0f / 1024.0f) + LN_EPS), rn = rsqrtf(sn * (1.0f / 1024.0f) + LN_EPS);
        bf16_t* orow = ob + (size_t)(t0 + tk) * D;
#pragma unroll
        for (int i = 0; i < 8; ++i) {
            const float4 g0 = *(const float4*)(ghy + (i * 16 + sub) * 8), g1 = *(const float4*)(ghy + (i * 16 + sub) * 8 + 4);
            uint4 w; w.x = pk_bf16(hv[i * 8] * rh * g0.x, hv[i * 8 + 1] * rh * g0.y); w.y = pk_bf16(hv[i * 8 + 2] * rh * g0.z, hv[i * 8 + 3] * rh * g0.w);
            w.z = pk_bf16(hv[i * 8 + 4] * rh * g1.x, hv[i * 8 + 5] * rh * g1.y); w.w = pk_bf16(hv[i * 8 + 6] * rh * g1.z, hv[i * 8 + 7] * rh * g1.w);
            *(uint4*)(orow + (i * 16 + sub) * 8) = w;
        }
#pragma unroll
        for (int i = 0; i < 8; ++i) {
            const float4 g0 = *(const float4*)(gna + (i * 16 + sub) * 8), g1 = *(const float4*)(gna + (i * 16 + sub) * 8 + 4);
            const unsigned wd[4] = {nv[i].x, nv[i].y, nv[i].z, nv[i].w};
            float a[8];
#pragma unroll
            for (int k = 0; k < 4; ++k) { a[2 * k] = __uint_as_float(wd[k] << 16); a[2 * k + 1] = __uint_as_float(wd[k] & 0xffff0000u); }
            uint4 w; w.x = pk_bf16(a[0] * rn * g0.x, a[1] * rn * g0.y); w.y = pk_bf16(a[2] * rn * g0.z, a[3] * rn * g0.w);
            w.z = pk_bf16(a[4] * rn * g1.x, a[5] * rn * g1.y); w.w = pk_bf16(a[6] * rn * g1.z, a[7] * rn * g1.w);
            *(uint4*)(orow + DHY + (i * 16 + sub) * 8) = w;
        }
    }
}

__device__ __forceinline__ void phase_h(const Params& p) {
    const int tid = opaque_tid(), lane = tid & 63, wv = tid >> 6;
    const float* x = p.in[I_X]; const bf16_t* y = (const bf16_t*)((const char*)p.ws + B_Y); const float* ada = p.ws + W_ADA;
    const float* g = p.in[I_LN1G]; const float* be = p.in[I_LN1B];
    bf16_t* x1 = (bf16_t*)((char*)p.ws + B_X1); bf16_t* u2b = (bf16_t*)((char*)p.ws + B_UB); unsigned* u2q = (unsigned*)((char*)p.ws + B_U2Q); float* su2 = p.ws + W_SU2;
#pragma unroll 1
    for (int tp = blockIdx.x * NWAVES + wv; tp < NT / 2; tp += gridDim.x * NWAVES) {
        const int b = (2 * tp) / SL;
        float v[2][32]; float s[2] = {0.f, 0.f};
#pragma unroll
        for (int u = 0; u < 2; ++u)
#pragma unroll
            for (int j = 0; j < 8; ++j) {
                const int col = j * 256 + lane * 4; const size_t t = (size_t)(2 * tp + u);
                const float4 xv = nt_load4(x + t * D + col); const uint2 yb = nt_load2u(y + t * D + col);
                const float4 yv = make_float4(__uint_as_float(yb.x << 16), __uint_as_float(yb.x & 0xffff0000u), __uint_as_float(yb.y << 16), __uint_as_float(yb.y & 0xffff0000u));
                const float4 gt = *(const float4*)(ada + b * 12288 + 2 * 2048 + col);
                v[u][j * 4] = ALPHA * xv.x + gt.x * yv.x; v[u][j * 4 + 1] = ALPHA * xv.y + gt.y * yv.y; v[u][j * 4 + 2] = ALPHA * xv.z + gt.z * yv.z; v[u][j * 4 + 3] = ALPHA * xv.w + gt.w * yv.w;
                s[u] += (v[u][j * 4] + v[u][j * 4 + 1]) + (v[u][j * 4 + 2] + v[u][j * 4 + 3]);
            }
        float rstd[2];
#pragma unroll
        for (int u = 0; u < 2; ++u) {
            const float mean = wave_sum(s[u]) * (1.0f / 2048.0f);
            float q2 = 0.f;
#pragma unroll
            for (int i = 0; i < 32; ++i) { v[u][i] -= mean; q2 += v[u][i] * v[u][i]; }
            rstd[u] = rsqrtf(wave_sum(q2) * (1.0f / 2048.0f) + LN_EPS);
        }
        asm volatile("" ::: "memory");
        float umx[2] = {0.f, 0.f};
#pragma unroll
        for (int j = 0; j < 8; ++j) {
            const int col = j * 256 + lane * 4;
            const float4 gv = *(const float4*)(g + col), bv = *(const float4*)(be + col);
            const float4 sh = *(const float4*)(ada + b * 12288 + 3 * 2048 + col), sc = *(const float4*)(ada + b * 12288 + 4 * 2048 + col);
#pragma unroll
            for (int u = 0; u < 2; ++u) {
                const size_t t = (size_t)(2 * tp + u);
                const float4 o = make_float4(v[u][j * 4] * rstd[u] * gv.x + bv.x, v[u][j * 4 + 1] * rstd[u] * gv.y + bv.y, v[u][j * 4 + 2] * rstd[u] * gv.z + bv.z, v[u][j * 4 + 3] * rstd[u] * gv.w + bv.w);
                { uint2 xb; xb.x = pk_bf16(o.x, o.y); xb.y = pk_bf16(o.z, o.w); nt_store2u(x1 + t * D + col, xb); }
                const float4 uv = make_float4(o.x * (1.f + sc.x) + sh.x, o.y * (1.f + sc.y) + sh.y, o.z * (1.f + sc.z) + sh.z, o.w * (1.f + sc.w) + sh.w);
                v[u][j * 4] = uv.x; v[u][j * 4 + 1] = uv.y; v[u][j * 4 + 2] = uv.z; v[u][j * 4 + 3] = uv.w;
                uint2 ub2; ub2.x = pk_bf16(uv.x, uv.y); ub2.y = pk_bf16(uv.z, uv.w);
                *(uint2*)(u2b + t * D + col) = ub2;
                umx[u] = fmaxf(umx[u], fmaxf(fmaxf(fabsf(uv.x), fabsf(uv.y)), fmaxf(fabsf(uv.z), fabsf(uv.w))));
            }
        }
#pragma unroll
        for (int u = 0; u < 2; ++u) {
            const size_t t = (size_t)(2 * tp + u);
            const float um = wave_max(umx[u]);
            const float inv = um > 0.f ? 127.0f / um : 0.f;
            uint4 qa, qb;
            qa.x = q4(v[u][0], v[u][1], v[u][2], v[u][3], inv, 0); qa.y = q4(v[u][4], v[u][5], v[u][6], v[u][7], inv, 0); qa.z = q4(v[u][8], v[u][9], v[u][10], v[u][11], inv, 0); qa.w = q4(v[u][12], v[u][13], v[u][14], v[u][15], inv, 0);
            qb.x = q4(v[u][16], v[u][17], v[u][18], v[u][19], inv, 0); qb.y = q4(v[u][20], v[u][21], v[u][22], v[u][23], inv, 0); qb.z = q4(v[u][24], v[u][25], v[u][26], v[u][27], inv, 0); qb.w = q4(v[u][28], v[u][29], v[u][30], v[u][31], inv, 0);
            nt_store4u(u2q + t * 512 + lane * 8, qa); nt_store4u(u2q + t * 512 + lane * 8 + 4, qb);
            if (lane == 0) su2[t] = um * (1.0f / 127.0f);
        }
    }
}

template <int N> __device__ __forceinline__ void bitonic_desc(float (&v)[N]) {
#pragma unroll
    for (int k = 2; k <= N; k <<= 1)
#pragma unroll
        for (int j = k >> 1; j > 0; j >>= 1)
#pragma unroll
            for (int i = 0; i < N; ++i) { const int l = i ^ j; if (l > i) { const float x = v[i], y = v[l]; const float mx = fmaxf(x, y), mn = fminf(x, y); if ((i & k) == 0) { v[i] = mx; v[l] = mn; } else { v[i] = mn; v[l] = mx; } } }
}
__device__ __forceinline__ void bitonic_merge16_desc(float (&v)[16]) {
#pragma unroll
    for (int j = 8; j > 0; j >>= 1)
#pragma unroll
        for (int i = 0; i < 16; ++i) { const int l = i ^ j; if (l > i) { const float x = v[i], y = v[l]; v[i] = fmaxf(x, y); v[l] = fminf(x, y); } }
}
__device__ __forceinline__ void top16_of_128(float (&sc)[32], float (&top)[16]) {
    float lo[16], hi[16];
#pragma unroll
    for (int i = 0; i < 16; ++i) { lo[i] = sc[i]; hi[i] = sc[16 + i]; }
    bitonic_desc<16>(lo); bitonic_desc<16>(hi);
#pragma unroll
    for (int i = 0; i < 16; ++i) top[i] = fmaxf(lo[i], hi[15 - i]);
    bitonic_merge16_desc(top);
#pragma unroll
    for (int off = 16; off <= 32; off <<= 1) {
        float o[16];
#pragma unroll
        for (int i = 0; i < 16; ++i) o[i] = __shfl_xor(top[15 - i], off);
#pragma unroll
        for (int i = 0; i < 16; ++i) top[i] = fmaxf(top[i], o[i]);
        bitonic_merge16_desc(top);
    }
}
__device__ __forceinline__ void ce_carry(float& va, int& xa, float& vb, int& xb, bool desc) {
    const bool sw = desc ? (vb > va) : (vb < va);
    const float tv = sw ? vb : va, uv = sw ? va : vb; const int tx = sw ? xb : xa, ux = sw ? xa : xb;
    va = tv; vb = uv; xa = tx; xb = ux;
}
__device__ __forceinline__ void bitonic_merge16_desc_carry(float (&v)[16], int (&x)[16]) {
#pragma unroll
    for (int j = 8; j > 0; j >>= 1)
#pragma unroll
        for (int i = 0; i < 16; ++i) { const int l = i ^ j; if (l > i) ce_carry(v[i], x[i], v[l], x[l], true); }
}
constexpr int CAND_I[52] = {0,0,0,0,0,0,0,0,0,0,0,0,0,0,0,0,1,1,1,1,1,1,1,1,2,2,2,2,2,3,3,3,3,4,4,4,5,5,6,6,7,7,8,9,10,11,12,13,14,15,-1,-1};
constexpr int CAND_J[52] = {0,1,2,3,4,5,6,7,8,9,10,11,12,13,14,15,0,1,2,3,4,5,6,7,0,1,2,3,4,0,1,2,3,0,1,2,0,1,0,1,0,1,0,0,0,0,0,0,0,0,-1,-1};

__device__ __forceinline__ int rl_i(int v, int l) { return __builtin_amdgcn_readlane(v, l); }
__device__ __forceinline__ float rl_f(float v, int l) { return __int_as_float(__builtin_amdgcn_readlane(__float_as_int(v), l)); }
#define LANE_OF(k) ((((k) >> 3) & 1) * 32 + (((k) >> 2) & 1) * 16 + (((k) >> 1) & 1) * 8 + ((k) & 1) * 4)
constexpr size_t B_KEYSB = 15 * MiB;
constexpr size_t B_QB = B_Y;

typedef float f32x2v __attribute__((ext_vector_type(2)));
#define PKFMA_LO(fv, xv, wsv) do { f32x2v _t; asm("v_cvt_pk_f32_fp8 %1, %2\n\tv_pk_fma_f32 %0, %3, %1, %0" : "+v"(fv), "=&v"(_t) : "v"(xv), "v"(wsv)); } while (0)
#define PKFMA_HI(fv, xv, wsv) do { f32x2v _t; asm("v_cvt_pk_f32_fp8_sdwa %1, %2 src0_sel:WORD_1\n\tv_pk_fma_f32 %0, %3, %1, %0" : "+v"(fv), "=&v"(_t) : "v"(xv), "v"(wsv)); } while (0)
#define PKFMA_F4(fv, xv, wsv, OPSEL) do { f32x2v _t; asm("v_cvt_scalef32_pk_f32_fp4 %1, %2, 1.0 " OPSEL "\n\tv_pk_fma_f32 %0, %3, %1, %0" : "+v"(fv), "=&v"(_t) : "v"(xv), "v"(wsv)); } while (0)
#define FACC(i) (f2[(i) >> 1][(i) & 1])
__device__ __forceinline__ void gather_token(const Params& p, int t, const int* sel_idx, const float* sel_g, int lane) {
    const bf16_t* x1 = (const bf16_t*)((const char*)p.ws + B_X1); const float* ada = p.ws + W_ADA;
    const char* uq = (const char*)p.ws + B_TQ; const char* vq = uq + (size_t)16384 * UROW; const char* u2q = (const char*)p.ws + B_U2Q;
    const __amdgpu_buffer_rsrc_t ursrc = __builtin_amdgcn_make_buffer_rsrc((void*)uq, 0, 16384 * UROW, 0x00020000);
    const __amdgpu_buffer_rsrc_t vrsrc = __builtin_amdgcn_make_buffer_rsrc((void*)vq, 0, 16384 * UROW, 0x00020000);
    const float* su2 = p.ws + W_SU2; const float* rsu = p.ws + W_SU; const float* rsv = p.ws + W_SV;
    const float* g2 = p.in[I_LN2G]; const float* b2 = p.in[I_LN2B];
    const int b = t / SL;
    unsigned uh[4], ul[4]; int us0;
    {
        const uint4 ua_ = nt_load4u(u2q + (size_t)t * D + lane * 32), ub_ = nt_load4u(u2q + (size_t)t * D + lane * 32 + 16);
        const unsigned xw[8] = {ua_.x, ua_.y, ua_.z, ua_.w, ub_.x, ub_.y, ub_.z, ub_.w};
        us0 = 0;
#pragma unroll
        for (int i = 0; i < 8; ++i) us0 = __builtin_amdgcn_sdot4((int)xw[i], 0x01010101, us0, false);
#pragma unroll
        for (int q = 0; q < 4; ++q) {
            const unsigned a = xw[2 * q] ^ 0x80808080u, bq = xw[2 * q + 1] ^ 0x80808080u;
            const unsigned la = a & 0x0F0F0F0Fu, lb = bq & 0x0F0F0F0Fu, ha = (a >> 4) & 0x0F0F0F0Fu, hb = (bq >> 4) & 0x0F0F0F0Fu;
            ul[q] = __builtin_amdgcn_perm(lb | (lb >> 4), la | (la >> 4), 0x06040200u);
            uh[q] = __builtin_amdgcn_perm(hb | (hb >> 4), ha | (ha >> 4), 0x06040200u);
        }
    }
    const float s2 = su2[t];
    const float uoff = 7.5f * wave_sum((float)us0);
    const float* scu = p.ws + W_SC;
    f32x2v f2[16];
#pragma unroll
    for (int i = 0; i < 16; ++i) f2[i] = (f32x2v){0.f, 0.f};
    const int kk8 = ((lane >> 5) & 1) * 4 + ((lane >> 4) & 1) * 2 + ((lane >> 3) & 1);
#define LANE_OF8(k) ((((k) >> 2) & 1) * 32 + (((k) >> 1) & 1) * 16 + ((k) & 1) * 8)
    int e_cur = sel_idx[kk8]; float g_cur = sel_g[kk8];
    uint4 un[8];
#pragma unroll
    for (int k = 0; k < 8; ++k) { const int ro = rl_i(e_cur, LANE_OF8(k)) * UROW; un[k] = __builtin_bit_cast(uint4, __builtin_amdgcn_raw_buffer_load_b128(ursrc, lane * 16, ro, 0)); }
#pragma unroll 1
    for (int bt = 0; bt < 16; ++bt) {
        uint4 vn[8];
#pragma unroll
        for (int k = 0; k < 8; ++k) { const int ro = rl_i(e_cur, LANE_OF8(k)) * UROW; vn[k] = __builtin_bit_cast(uint4, __builtin_amdgcn_raw_buffer_load_b128(vrsrc, lane * 16, ro, 0)); }
        __builtin_amdgcn_sched_barrier(0);
        float part[8];
#pragma unroll
        for (int k = 0; k < 8; ++k) {
            const uint4 nq = un[k];
            unsigned dh = __builtin_amdgcn_udot8(uh[0], nq.x, 0u, false), dl = __builtin_amdgcn_udot8(ul[0], nq.x, 0u, false);
            dh = __builtin_amdgcn_udot8(uh[1], nq.y, dh, false); dl = __builtin_amdgcn_udot8(ul[1], nq.y, dl, false);
            dh = __builtin_amdgcn_udot8(uh[2], nq.z, dh, false); dl = __builtin_amdgcn_udot8(ul[2], nq.z, dl, false);
            dh = __builtin_amdgcn_udot8(uh[3], nq.w, dh, false); dl = __builtin_amdgcn_udot8(ul[3], nq.w, dl, false);
            const unsigned d0 = dh * 16u + dl;
            part[k] = (float)d0;
            __builtin_amdgcn_sched_barrier(0);
        }
        const int bn = (bt + 1) & 15;
        const int e_nxt = sel_idx[bn * 8 + kk8]; const float g_nxt = sel_g[bn * 8 + kk8];
#pragma unroll
        for (int k = 0; k < 8; ++k) { const int ro = rl_i(e_nxt, LANE_OF8(k)) * UROW; un[k] = __builtin_bit_cast(uint4, __builtin_amdgcn_raw_buffer_load_b128(ursrc, lane * 16, ro, 0)); }
        __builtin_amdgcn_sched_barrier(0);
        { const bool up = (lane & 32) != 0;
#pragma unroll
          for (int i = 0; i < 4; ++i) { const float keep = up ? part[i + 4] : part[i], send = up ? part[i] : part[i + 4]; part[i] = keep + __shfl_xor(send, 32); } }
        { const bool up = (lane & 16) != 0;
#pragma unroll
          for (int i = 0; i < 2; ++i) { const float keep = up ? part[i + 2] : part[i], send = up ? part[i] : part[i + 2]; part[i] = keep + __shfl_xor(send, 16); } }
        { const bool up = (lane & 8) != 0;
          const float keep = up ? part[1] : part[0], send = up ? part[0] : part[1]; part[0] = keep + __shfl_xor(send, 8); }
        float tot = part[0]; tot += __shfl_xor(tot, 1); tot += __shfl_xor(tot, 2); tot += __shfl_xor(tot, 4);
        const float dt = (tot - 128.0f * scu[e_cur] - uoff) * s2 * rsu[e_cur];
        const float act = 0.5f * dt * (1.0f + erff(dt * 0.7071067811865476f));
        const float w_l = g_cur * act * rsv[e_cur];
#pragma unroll
        for (int k = 0; k < 8; ++k) {
            const float w = rl_f(w_l, LANE_OF8(k));
            const f32x2v wp0 = {w, w};
            const unsigned wd[4] = {vn[k].x, vn[k].y, vn[k].z, vn[k].w};
#pragma unroll
            for (int q = 0; q < 4; ++q) {
                PKFMA_F4(f2[q * 4 + 0], wd[q], wp0, ""); PKFMA_F4(f2[q * 4 + 1], wd[q], wp0, "op_sel:[1,0,0]"); PKFMA_F4(f2[q * 4 + 2], wd[q], wp0, "op_sel:[0,1,0]"); PKFMA_F4(f2[q * 4 + 3], wd[q], wp0, "op_sel:[1,1,0]");
            }
        }
        e_cur = e_nxt; g_cur = g_nxt;
    }
#undef LANE_OF8
    asm volatile("" ::: "memory");
    float v[32]; float s = 0.f;
#pragma unroll
    for (int q = 0; q < 8; ++q) {
        const int col = q * 256 + lane * 4, o = q * 4;
        const uint2 xb = nt_load2u(x1 + (size_t)t * D + col); const float4 gt = *(const float4*)(ada + b * 12288 + 5 * 2048 + col);
        const float4 xv = make_float4(__uint_as_float(xb.x << 16), __uint_as_float(xb.x & 0xffff0000u), __uint_as_float(xb.y << 16), __uint_as_float(xb.y & 0xffff0000u));
        v[o] = ALPHA * xv.x + gt.x * FACC(o); v[o + 1] = ALPHA * xv.y + gt.y * FACC(o + 1);
        v[o + 2] = ALPHA * xv.z + gt.z * FACC(o + 2); v[o + 3] = ALPHA * xv.w + gt.w * FACC(o + 3);
        s += (v[o] + v[o + 1]) + (v[o + 2] + v[o + 3]);
    }
    const float mean = wave_sum(s) * (1.0f / 2048.0f);
    float q2 = 0.f;
#pragma unroll
    for (int i = 0; i < 32; ++i) { v[i] -= mean; q2 += v[i] * v[i]; }
    const float rstd = rsqrtf(wave_sum(q2) * (1.0f / 2048.0f) + LN_EPS);
    asm volatile("" ::: "memory");
#pragma unroll
    for (int q = 0; q < 8; ++q) {
        const int col = q * 256 + lane * 4, o = q * 4;
        const float4 gv = *(const float4*)(g2 + col), bv = *(const float4*)(b2 + col);
        nt_store4(p.out + (size_t)t * D + col, v[o] * rstd * gv.x + bv.x, v[o + 1] * rstd * gv.y + bv.y, v[o + 2] * rstd * gv.z + bv.z, v[o + 3] * rstd * gv.w + bv.w);
    }
}

__device__ __forceinline__ void phase_jk(const Params& p, unsigned char* smem) {
    const int tid0 = opaque_tid();
    const bf16_t* qb = (const bf16_t*)((const char*)p.ws + B_QB); const bf16_t* keysb = (const bf16_t*)((const char*)p.ws + B_KEYSB);
    int* sel_idx = (int*)smem; float* sel_g = (float*)(smem + 8192);
#pragma unroll 1
    for (int item = blockIdx.x; item < NT / 16; item += gridDim.x) {
        int tid = tid0; asm volatile("" : "+v"(tid));
        const int lane = tid & 63, wv = tid >> 6, ql = lane & 15, g = lane >> 4;
        const int t0 = item * 16, h = wv;
        __syncthreads();
        float ta[16], tb[16];
#pragma unroll
        for (int i = 0; i < 16; ++i) { ta[i] = 0.f; tb[i] = 0.f; }
#pragma unroll 1
        for (int pp = 0; pp < 2; ++pp) {
            const bf16_t* qrow = qb + ((size_t)((((t0 >> 4) * 8 + h) * 2 + pp) * 4) * 64 + lane) * 8;
            bf16x8v qf[4];
#pragma unroll
            for (int kc = 0; kc < 4; ++kc) qf[kc] = __builtin_nontemporal_load((const bf16x8v*)(qrow + kc * 512));
            const bf16_t* kbase = keysb + (size_t)((h * 2 + pp) * 8) * 2048 + lane * 8;
            float sc[32];
#pragma unroll
            for (int nb = 0; nb < 8; ++nb) {
                f32x4v acc = {0.f, 0.f, 0.f, 0.f};
#pragma unroll
                for (int kc = 0; kc < 4; ++kc) acc = __builtin_amdgcn_mfma_f32_16x16x32_bf16(*(const bf16x8v*)(kbase + (nb * 4 + kc) * 512), qf[kc], acc, 0, 0, 0);
#pragma unroll
                for (int rr = 0; rr < 4; ++rr) sc[nb * 4 + rr] = __int_as_float((__float_as_int(acc[rr]) & ~127) | (16 * nb + 4 * g + rr));
                if (nb == 3) asm volatile("" ::: "memory");
            }
            float top[16];
            top16_of_128(sc, top);
#pragma unroll
            for (int i = 0; i < 16; ++i) { if (pp == 0) ta[i] = top[i]; else tb[i] = top[i]; }
        }
        float cv[16]; int cx[16];
#pragma unroll
        for (int sidx = 0; sidx < 13; ++sidx) {
            float vv[4]; int xx[4];
#pragma unroll
            for (int q = 0; q < 4; ++q) {
                const int ci = CAND_I[4 * sidx + q], cj = CAND_J[4 * sidx + q];
                if (ci >= 0) { vv[q] = ta[ci] + tb[cj]; xx[q] = ((__float_as_int(ta[ci]) & 127) << 7) | (__float_as_int(tb[cj]) & 127); } else { vv[q] = -3.0e38f; xx[q] = 0; }
            }
            cv[sidx] = g == 0 ? vv[0] : (g == 1 ? vv[1] : (g == 2 ? vv[2] : vv[3]));
            cx[sidx] = g == 0 ? xx[0] : (g == 1 ? xx[1] : (g == 2 ? xx[2] : xx[3]));
        }
#pragma unroll
        for (int sidx = 13; sidx < 16; ++sidx) { cv[sidx] = -3.0e38f; cx[sidx] = 0; }
#pragma unroll
        for (int k = 2; k <= 16; k <<= 1)
#pragma unroll
            for (int j = k >> 1; j > 0; j >>= 1)
#pragma unroll
                for (int i = 0; i < 16; ++i) { const int l = i ^ j; if (l > i) ce_carry(cv[i], cx[i], cv[l], cx[l], (i & k) == 0); }
#pragma unroll
        for (int off = 16; off <= 32; off <<= 1) {
            float ov[16]; int ox[16];
#pragma unroll
            for (int i = 0; i < 16; ++i) { ov[i] = __shfl_xor(cv[15 - i], off); ox[i] = __shfl_xor(cx[15 - i], off); }
#pragma unroll
            for (int i = 0; i < 16; ++i) { const bool tk = ov[i] > cv[i]; cv[i] = tk ? ov[i] : cv[i]; cx[i] = tk ? ox[i] : cx[i]; }
            bitonic_merge16_desc_carry(cv, cx);
        }
        {
            float ex[16]; float sum = 0.f;
#pragma unroll
            for (int i = 0; i < 16; ++i) { ex[i] = __expf(cv[i] - cv[0]); sum += ex[i]; }
            const float inv = 1.0f / sum;
            if (g == 0) {
#pragma unroll
                for (int q = 0; q < 4; ++q) {
                    *(int4*)(sel_idx + ql * 128 + h * 16 + q * 4) = make_int4(cx[q * 4], cx[q * 4 + 1], cx[q * 4 + 2], cx[q * 4 + 3]);
                    *(float4*)(sel_g + ql * 128 + h * 16 + q * 4) = make_float4(ex[q * 4] * inv, ex[q * 4 + 1] * inv, ex[q * 4 + 2] * inv, ex[q * 4 + 3] * inv);
                }
            }
        }
        __syncthreads();
#pragma unroll 1
        for (int k = 0; k < 2; ++k) { int lane2 = lane; asm volatile("" : "+v"(lane2)); gather_token(p, t0 + 2 * wv + k, sel_idx + (2 * wv + k) * 128, sel_g + (2 * wv + k) * 128, lane2); }
    }
}

__device__ __forceinline__ void map_tile(int L, int nM, int nN, int& pm, int& pn) {
    const int nwg = nM * nN; int wgid = L;
    { const int q = nwg / 8, r = nwg % 8, xcd = wgid % 8, off = wgid / 8; wgid = (xcd < r ? xcd * (q + 1) : r * (q + 1) + (xcd - r) * q) + off; }
    const int nig = 8 * nN, gid = wgid / nig, fm = gid * 8, gsz = (nM - fm) < 8 ? (nM - fm) : 8;
    pm = fm + ((wgid % nig) % gsz); pn = (wgid % nig) / gsz;
}
struct ProjOrder {
    int G, c; const bf16_t* ub; const bf16_t* wint;
    __device__ bool next(int i, pg8::Unit& u) const {
        const int L = i * G + c; if (L >= 800) return false;
        if (L < 384) { u.kind = 0; map_tile(L, 12, 32, u.pm, u.pn); }
        else if (L < 512) { u.kind = 1; map_tile(L - 384, 4, 32, u.pm, u.pn); }
        else if (L < 768) { u.kind = 2; map_tile(L - 512, 32, 8, u.pm, u.pn); }
        else if (L < 784) { u.kind = 3; u.pm = (L - 768) >> 2; u.pn = (L - 768) & 3; }
        else { u.kind = 4; u.pm = (L - 784) >> 2; u.pn = (L - 784) & 3; }
        return true;
    }
    __device__ __forceinline__ void a_ready(const pg8::Unit&) const {}
    __device__ __forceinline__ void done(const pg8::Unit&) const {}
    template <class G_> __device__ __forceinline__ const char* pa(const G_&, const pg8::Unit& u) const {
        const size_t ts = (size_t)256 * D * 2;
        switch (u.kind) { case 0: return (const char*)wint + (size_t)u.pm * ts; case 1: return (const char*)wint + (size_t)(20 + u.pm) * ts; case 2: return (const char*)ub + (size_t)u.pm * ts;
                          case 3: return (const char*)ub + (size_t)(32 + u.pm) * ts; default: return (const char*)wint + (size_t)(20 + u.pm) * ts; }
    }
    template <class G_> __device__ __forceinline__ const char* pb(const G_&, const pg8::Unit& u) const {
        const size_t ts = (size_t)256 * D * 2;
        switch (u.kind) { case 0: case 1: return (const char*)ub + (size_t)u.pn * ts; case 2: return (const char*)wint + (size_t)(12 + u.pn) * ts;
                          case 3: return (const char*)wint + (size_t)(16 + u.pn) * ts; default: return (const char*)ub + (size_t)(32 + u.pn) * ts; }
    }
};
struct EpiProj {
    static constexpr bool PERM = true, AFTER_DRAIN = false;
    unsigned char* ws;
    __device__ __forceinline__ void operator()(const pg8::f32x4 (&acc)[2][2][4][2], const pg8::Unit& u, int wr, int wc, int fr, int fq) const {
        bf16_t* const zT = (bf16_t*)(ws + B_ZT); bf16_t* const vT = (bf16_t*)(ws + B_VT); bf16_t* const qh = (bf16_t*)(ws + B_QH); bf16_t* const kh = (bf16_t*)(ws + B_KH);
        bf16_t* const kch = (bf16_t*)(ws + B_KCH); bf16_t* const vcT = (bf16_t*)(ws + B_VCT);
#pragma unroll
        for (int ai = 0; ai < 2; ++ai)
#pragma unroll
            for (int m = 0; m < 4; ++m) {
                const int r = u.pm * 256 + ai * 128 + wr * 64 + m * 16 + fr;
#pragma unroll
                for (int bj = 0; bj < 2; ++bj) {
                    const int cc = u.pn * 256 + bj * 128 + wc * 32 + 8 * fq;
                    bf16_t* dst;
                    if (u.kind == 0) dst = zT + (size_t)r * NT + cc;
                    else if (u.kind == 1) {
                        const int bb = cc >> 11, t = cc & 2047, hh = r >> 6, dd = r & 63;
                        dst = vT + (size_t)((bb * 16 + hh) * 256 + (t >> 3)) * 512 + (dd >> 4) * 128 + (dd & 15) * 8;
                    } else if (u.kind == 2) {
                        const int bb = r >> 11, t = r & 2047, hc = cc & 1023, hh = hc >> 6, dd = hc & 63;
                        if (cc < 1024) dst = qh + ((size_t)((bb * 16 + hh) * SL + t)) * 64 + dd;
                        else dst = kh + (size_t)((bb * 16 + hh) * 256 + (t >> 3)) * 512 + (dd >> 5) * 256 + ((t & 7) >> 2) * 128 + ((dd & 31) >> 3) * 32 + (t & 3) * 8;
                    } else if (u.kind == 3) {
                        const int bb = r >> 8, jj = r & 255, hh = cc >> 6, dd = cc & 63;
                        dst = kch + (size_t)((bb * 16 + hh) * 32 + (jj >> 3)) * 512 + (dd >> 5) * 256 + ((jj & 7) >> 2) * 128 + ((dd & 31) >> 3) * 32 + (jj & 3) * 8;
                    } else {
                        const int bb = cc >> 8, jj = cc & 255, hh = r >> 6, dd = r & 63;
                        dst = vcT + (size_t)((bb * 16 + hh) * 32 + (jj >> 3)) * 512 + (dd >> 4) * 128 + (dd & 15) * 8;
                    }
                    const pg8::f32x4 v0 = acc[ai][bj][m][0], v1 = acc[ai][bj][m][1];
                    pg8::u32x4 w; w.x = pg8::cvt_pk_bf16(v0[0], v0[1]); w.y = pg8::cvt_pk_bf16(v0[2], v0[3]); w.z = pg8::cvt_pk_bf16(v1[0], v1[1]); w.w = pg8::cvt_pk_bf16(v1[2], v1[3]);
                    *(pg8::u32x4*)dst = w;
                }
            }
    }
};

struct EpiQFrag {
    static constexpr bool PERM = true, AFTER_DRAIN = false;
    bf16_t* O;
    __device__ __forceinline__ void operator()(const pg8::f32x4 (&acc)[2][2][4][2], const pg8::Unit& u, int wr, int wc, int fr, int fq) const {
#pragma unroll
        for (int ai = 0; ai < 2; ++ai)
#pragma unroll
            for (int m = 0; m < 4; ++m) {
                const int t = u.pm * 256 + ai * 128 + wr * 64 + m * 16 + fr;
#pragma unroll
                for (int bj = 0; bj < 2; ++bj) {
                    const int c = u.pn * 256 + bj * 128 + wc * 32 + 8 * fq;
                    const int hh = c >> 8, pp = (c >> 7) & 1, d = c & 127;
                    bf16_t* dst = O + ((size_t)(((((t >> 4) * 8 + hh) * 2 + pp) * 4 + (d >> 5)) * 64 + ((d & 31) >> 3) * 16 + (t & 15))) * 8;
                    const pg8::f32x4 v0 = acc[ai][bj][m][0], v1 = acc[ai][bj][m][1];
                    pg8::u32x4 w; w.x = pg8::cvt_pk_bf16(v0[0], v0[1]); w.y = pg8::cvt_pk_bf16(v0[2], v0[3]); w.z = pg8::cvt_pk_bf16(v1[0], v1[1]); w.w = pg8::cvt_pk_bf16(v1[2], v1[3]);
                    __builtin_nontemporal_store(w, (pg8::u32x4*)dst);
                }
            }
    }
};

#define XB_TMO      128
#define XB_XCNT(j)  (256  + 64 * (j))
#define XB_XSUB(j)  (1280 + 64 * (j))
#define XB_XGEN(j)  (2304 + 64 * (j))
#define XB_TOP      3328
#define XB_TOPGEN   3392
#define XCD_BAR_WORDS 3456
#define XB_SPIN_CAP (1u << 18)
#define LAS __attribute__((address_space(3)))

__device__ __forceinline__ unsigned xb_ld(unsigned* p)              { return __hip_atomic_load(p, __ATOMIC_RELAXED, __HIP_MEMORY_SCOPE_AGENT); }
__device__ __forceinline__ unsigned xb_add(unsigned* p, unsigned v) { return __hip_atomic_fetch_add(p, v, __ATOMIC_RELAXED, __HIP_MEMORY_SCOPE_AGENT); }
__device__ __forceinline__ unsigned xb_xcc_id() { return (unsigned)__builtin_amdgcn_s_getreg((3 << 11) | 20) & 0xFu; }
#define XB_SPIN(cond, bar) do { unsigned _sp = 0; while (cond) { __builtin_amdgcn_s_sleep(1); \
    if ((++_sp & 255u) == 0u) { if (xb_ld(&(bar)[XB_TMO])) break; if (_sp > XB_SPIN_CAP) { atomicAdd(&(bar)[XB_TMO], 1u); break; } } } } while (0)

struct XcdBarrier {
    unsigned* bar; unsigned x;
    volatile LAS unsigned* st;
};

__device__ __forceinline__ XcdBarrier xcd_barrier_post(unsigned* bar, volatile LAS unsigned* st) {
    XcdBarrier b; b.bar = bar; b.x = xb_xcc_id(); b.st = st;
    if (threadIdx.x == 0) (void)xb_add(&bar[XB_XCNT(b.x)], 1u);
    return b;
}
__device__ __forceinline__ void xcd_barrier_complete(unsigned* bar, unsigned x, unsigned& nloc, unsigned& nx) {
    const unsigned G = gridDim.x * gridDim.y * gridDim.z;
    unsigned sum, cnt, mine, sp = 0u;
    for (;;) {
        sum = 0u; cnt = 0u; mine = 0u;
#pragma unroll
        for (unsigned j = 0; j < 16; ++j) { const unsigned c = xb_ld(&bar[XB_XCNT(j)]); sum += c; cnt += (c > 0u) ? 1u : 0u; mine = (j == x) ? c : mine; }
        if (sum == G) break;
        __builtin_amdgcn_s_sleep(1);
        if ((++sp & 255u) == 0u) { if (xb_ld(&bar[XB_TMO])) break; if (sp > XB_SPIN_CAP) { atomicAdd(&bar[XB_TMO], 1u); break; } }
    }
    nloc = mine > 0u ? mine : 1u; nx = cnt > 0u ? cnt : 1u;
}

__device__ __forceinline__ void xcd_barrier(const XcdBarrier& b) {
    asm volatile("s_waitcnt vmcnt(0)" ::: "memory");
    __syncthreads();
    if (threadIdx.x == 0) {
        unsigned* bar = b.bar;
        __builtin_amdgcn_s_waitcnt(0);
        unsigned nloc = b.st[0], nx = b.st[1]; const unsigned k = b.st[2];
        if (nloc == 0u) { xcd_barrier_complete(bar, b.x, nloc, nx); b.st[0] = nloc; b.st[1] = nx; }
        b.st[2] = k + 1u;
        const unsigned old = xb_add(&bar[XB_XSUB(b.x)], 1u);
        if (old + 1u == (k + 1u) * nloc) {
            __builtin_amdgcn_fence(__ATOMIC_RELEASE, "agent");
            asm volatile("s_waitcnt vmcnt(0)" ::: "memory");
            (void)xb_add(&bar[XB_TOP], 1u);
        }
        asm volatile("buffer_inv sc1" ::: "memory");
        XB_SPIN(xb_ld(&bar[XB_TOP]) < (k + 1u) * nx, bar);
        asm volatile("s_waitcnt vmcnt(0)" ::: "memory");
    }
    __syncthreads();
}
constexpr size_t B_BAR = 14 * MiB;

__global__ void __launch_bounds__(NTHREADS) fwd_megakernel(Params p) {
    extern __shared__ __attribute__((aligned(16))) unsigned char smem[];
    float* lds = (float*)smem; float* red = (float*)(smem + RED_OFF);
    PG8_LAS unsigned char* glds = (PG8_LAS unsigned char*)smem;
    volatile LAS unsigned* xst = (volatile LAS unsigned*)(smem + LDS_BYTES - 16);
    if (threadIdx.x < 4) xst[threadIdx.x] = 0u;
    __syncthreads();
    XcdBarrier xb = xcd_barrier_post((unsigned*)((char*)p.ws + B_BAR), xst);
    bf16_t* wint = (bf16_t*)((char*)p.ws + B_WINT); bf16_t* woutt = (bf16_t*)((char*)p.ws + B_WOUTT); bf16_t* wqt = (bf16_t*)((char*)p.ws + B_WQT);
    bf16_t* ub = (bf16_t*)((char*)p.ws + B_UB);
    phase_a(p, lds);
    transpose_convert(p.in[I_WIN], wint, D, DPROJ, lds, 0, (int)gridDim.x);
    phase_filters(p, lds);
    {
        const float* ks = p.in[I_KEYS]; bf16_t* kd = (bf16_t*)((char*)p.ws + B_KEYSB);
        for (int e = blockIdx.x * NTHREADS + threadIdx.x; e < 16 * 128 * 128 / 4; e += gridDim.x * NTHREADS) {
            const float4 v = *(const float4*)(ks + e * 4); uint2 o; o.x = pk_bf16(v.x, v.y); o.y = pk_bf16(v.z, v.w);
            const int d = (e * 4) & 127, n = ((e * 4) >> 7) & 127, hp = (e * 4) >> 14;
            *(uint2*)(kd + ((size_t)(((hp * 8 + (n >> 4)) * 4 + (d >> 5)) * 64 + ((d & 31) >> 3) * 16 + (n & 15))) * 8 + (d & 7)) = o;
        }
    }
    xcd_barrier(xb);
    phase_b(p);
    xcd_barrier(xb);
    phase_c(p);
    xcd_barrier(xb);
    {
        pg8::Gemm g{ub, wint, NT + NTC, DPROJ, D}; ProjOrder S{(int)gridDim.x, (int)blockIdx.x, ub, wint};
        EpiProj E{(unsigned char*)p.ws};
        pg8::gemm_phase<EpiProj, ProjOrder>(glds, g, S, E, nullptr);
    }
    if (gridDim.x == 256 && blockIdx.x >= 32) {
        quant_tables(p, 32, 224);
        transpose_convert(p.in[I_WOUT], woutt, D, D, lds, 32, 224);
        transpose_convert(p.in[I_WQ], wqt, D, D, lds, 32, 224);
    } else if (gridDim.x != 256) {
        quant_tables(p, 0, (int)gridDim.x);
        transpose_convert(p.in[I_WOUT], woutt, D, D, lds, 0, (int)gridDim.x);
        transpose_convert(p.in[I_WQ], wqt, D, D, lds, 0, (int)gridDim.x);
    }
    xcd_barrier(xb);
    phase_hyena(p, smem);
    phase_na(p, smem);
    xcd_barrier(xb);
    phase_f(p, lds);
    xcd_barrier(xb);
    {
        pg8::Gemm g{ub, woutt, NT, D, D}; pg8::StaticOrder S; S.init(NT, D, (int)gridDim.x, (int)blockIdx.x);
        pg8::EpiBf16<0> E{(bf16_t*)((char*)p.ws + B_Y), D, nullptr, 0, 0};
        pg8::gemm_phase<pg8::EpiBf16<0>, pg8::StaticOrder>(glds, g, S, E, nullptr);
    }
    xcd_barrier(xb);
    phase_h(p);
    xcd_barrier(xb);
    {
        pg8::Gemm g{ub, wqt, NT, D, D}; pg8::StaticOrder S; S.init(NT, D, (int)gridDim.x, (int)blockIdx.x);
        EpiQFrag E{(bf16_t*)((char*)p.ws + B_QB)};
        pg8::gemm_phase<EpiQFrag, pg8::StaticOrder>(glds, g, S, E, nullptr);
    }
    xcd_barrier(xb);
    phase_jk(p, smem);
}

extern "C" void kernel_launch(void* const* d_in, const int* in_sizes, int n_in, void* d_out, int out_size, void* d_ws, size_t ws_size, hipStream_t stream) {
    static int grid_blocks = 0;
    if (grid_blocks == 0) {
        if (n_in != N_IN || out_size != NT * D || ws_size < W_END * sizeof(float)) {
            fprintf(stderr, "kernel_launch: unexpected shapes: n_in %d out %d ws %zu (need %zu)\n", n_in, out_size, ws_size, (size_t)W_END * 4); grid_blocks = -1; return; }
        int dev = 0, cus = 0, per_cu = 0;
        hipGetDevice(&dev);
        hipDeviceGetAttribute(&cus, hipDeviceAttributeMultiprocessorCount, dev);
        if (hipFuncSetAttribute((const void*)fwd_megakernel, hipFuncAttributeMaxDynamicSharedMemorySize, LDS_BYTES) != hipSuccess) { fprintf(stderr, "kernel_launch: hipFuncSetAttribute failed\n"); grid_blocks = -1; return; }
        if (hipOccupancyMaxActiveBlocksPerMultiprocessor(&per_cu, (const void*)fwd_megakernel, NTHREADS, LDS_BYTES) != hipSuccess || per_cu < 1) { fprintf(stderr, "kernel_launch: occupancy query failed (%d)\n", per_cu); (void)hipGetLastError(); grid_blocks = -1; return; }
        grid_blocks = cus * (per_cu > 1 ? 1 : per_cu);
        fprintf(stderr, "kernel_launch: cus %d per_cu %d grid %d\n", cus, per_cu, grid_blocks);
    }
    if (grid_blocks < 0) return;
    Params p{};
    for (int i = 0; i < N_IN; ++i) p.in[i] = (const float*)d_in[i];
    p.out = (float*)d_out; p.ws = (float*)d_ws;
    if (hipMemsetAsync((char*)d_ws + B_BAR, 0, XCD_BAR_WORDS * sizeof(unsigned), stream) != hipSuccess) { fprintf(stderr, "kernel_launch: memset failed\n"); return; }
    void* args[] = {&p};
    hipLaunchKernelGGL(fwd_megakernel, dim3(grid_blocks), dim3(NTHREADS), LDS_BYTES, stream, p);
    const hipError_t e = hipPeekAtLastError();
    if (e != hipSuccess) fprintf(stderr, "launch failed: %s (grid %d)\n", hipGetErrorString(e), grid_blocks);
}
```

```cpp
#include <hip/hip_runtime.h>
#include <hip/hip_cooperative_groups.h>
#include <cstdio>
namespace cg = cooperative_groups;

constexpr int D = 2048, NB = 4, SL = 2048, NT = NB * SL, CL = 256, NTC = NB * CL;
constexpr int DHY = 1024, DNA = 1024, DPROJ = 6144, OFFQ = 3072, OFFK = 4096, OFFV = 5120;
constexpr int NTHREADS = 512, NWAVES = 8;
constexpr float LN_EPS = 1e-5f;
constexpr float ALPHA = 1.189207115002721f;

enum { I_X = 0, I_C, I_CTX, I_CCTX, I_WADA, I_BADA, I_WIN, I_CONVW, I_CONVB, I_FW1, I_FB1, I_FW2, I_FB2, I_FW3, I_FB3, I_FW4,
       I_FREQ, I_SKIP, I_RPB, I_GHY, I_GNA, I_WOUT, I_LN1G, I_LN1B, I_WQ, I_KEYS, I_PU, I_PV, I_LN2G, I_LN2B, N_IN };

constexpr size_t W_ADAP = 0;
constexpr size_t W_ADA  = W_ADAP + 32 * 5 * 12288;
constexpr size_t W_FS   = W_ADA + 5 * 12288;
constexpr size_t W_SP   = W_FS + 4096;
constexpr size_t W_SU   = W_SP + 32 * 4096;
constexpr size_t W_SV   = W_SU + 16384;
constexpr size_t W_SU2  = W_SV + 16384;
constexpr size_t W_SC   = W_SU2 + 8192;
static_assert((W_SC + 16384) * 4 <= 14 * 1048576, "small region overflow");
constexpr size_t MiB = 1048576;
constexpr size_t B_WINT  = 16 * MiB;
constexpr size_t B_WOUTT = B_WINT + 24 * MiB;
constexpr size_t B_WQT   = B_WOUTT + 8 * MiB;
constexpr size_t B_UB    = B_WQT + 8 * MiB;
constexpr size_t B_ZT    = B_UB + 36 * MiB;
constexpr size_t B_VT    = B_ZT + 48 * MiB;
constexpr size_t B_QH    = B_VT + 16 * MiB;
constexpr size_t B_KH    = B_QH + 16 * MiB;
constexpr size_t B_KCH   = B_KH + 16 * MiB;
constexpr size_t B_VCT   = B_KCH + 2 * MiB;
constexpr size_t B_KF    = B_VCT + 2 * MiB;
constexpr size_t B_HRAW  = B_KF + 32 * MiB;
constexpr size_t B_HYT   = B_HRAW;
constexpr size_t B_NA    = B_HRAW + 16 * MiB;
constexpr size_t B_Y     = B_HRAW + 32 * MiB;
constexpr size_t B_X1    = B_Y + 64 * MiB;
constexpr size_t B_U2Q   = B_X1 + 64 * MiB;
constexpr size_t B_TQ    = B_U2Q + 16 * MiB;
constexpr size_t B_END   = B_TQ + 64 * MiB;
constexpr size_t W_KF = B_KF / 4, W_X1 = B_X1 / 4, W_HRAW = B_HRAW / 4, W_Y = B_Y / 4, W_END = B_END / 4;
static_assert(B_END <= 512 * MiB, "workspace");

constexpr int LDS_BYTES = 156 * 1024;
constexpr int RED_OFF = 155 * 1024;

struct Params { const float* in[N_IN]; float* out; float* ws; };

namespace pg8 {
#define PG8_LAS __attribute__((address_space(3)))
typedef unsigned short bf16_t;
typedef short bf16x8 __attribute__((ext_vector_type(8)));
typedef float f32x4 __attribute__((ext_vector_type(4)));
typedef unsigned u32x4 __attribute__((ext_vector_type(4)));
constexpr int BM = 256, BK = 64, HALF = 128, HTB = HALF * BK * 2  , STAGE_BYTES = 8 * HTB, NXCD = 8, WGM = 8;

__host__ __device__ __forceinline__ int lds_byte(int r, int c) { const int st = (r >> 4) * 2 + (c >> 5), rr = r & 15, cc = c & 31, ob = rr * 64 + cc * 2; return st * 1024 + (ob ^ (((ob >> 9) & 1) << 5)); }
__host__ __device__ __forceinline__ void stage_rc(int b, int& R, int& C) { const int st = b / 1024, sb = b % 1024, swz = sb ^ (((sb >> 9) & 1) << 5); R = (st >> 1) * 16 + swz / 64; C = (st & 1) * 32 + (swz % 64) / 2; }
__host__ __device__ __forceinline__ int perm32(int rho) { const int n = rho >> 4, i = rho & 15; return 8 * (i >> 2) + 4 * n + (i & 3); }

struct Unit { int pm, pn, kind; };
struct Gemm { const bf16_t* A; const bf16_t* Bt; int M, N, K; };

struct StaticOrder {
    int nM, nN, nwg, G, c;
    __host__ __device__ void init(int M, int N, int G_, int c_) { nM = M / BM; nN = N / BM; nwg = nM * nN; G = G_; c = c_; }
    __host__ __device__ bool next(int i, Unit& u) const {
        const long L = (long)i * G + c; if (L >= nwg) return false;
        int wgid = (int)L; { const int q = nwg / NXCD, r = nwg % NXCD, xcd = wgid % NXCD, off = wgid / NXCD; wgid = (xcd < r ? xcd * (q + 1) : r * (q + 1) + (xcd - r) * q) + off; }
        const int nig = WGM * nN, gid = wgid / nig, fm = gid * WGM, gsz = (nM - fm) < WGM ? (nM - fm) : WGM;
        u.pm = fm + ((wgid % nig) % gsz); u.pn = (wgid % nig) / gsz; return true;
    }
    __device__ __forceinline__ void a_ready(const Unit&) const {}
    __device__ __forceinline__ void done(const Unit&) const {}
    template <class G_> __device__ __forceinline__ const char* pa(const G_& g, const Unit& u) const { return (const char*)g.A + (size_t)u.pm * (size_t)(BM * 2) * g.K; }
    template <class G_> __device__ __forceinline__ const char* pb(const G_& g, const Unit& u) const { return (const char*)g.Bt + (size_t)u.pn * (size_t)(BM * 2) * g.K; }
};
struct XcdRowOrder : StaticOrder {
    __host__ __device__ bool next(int i, Unit& u) const {
        if (G != 256 || nM != 32 || nN != 8) return StaticOrder::next(i, u);
        if (i != 0) return false;
        u.pm = 4 * (c & 7) + ((c >> 3) & 3); u.pn = c >> 5; return true;
    }
};
__device__ __forceinline__ unsigned cvt_pk_bf16(float lo, float hi) { unsigned r; asm volatile("v_cvt_pk_bf16_f32 %0, %1, %2" : "=v"(r) : "v"(lo), "v"(hi)); return r; }
typedef float f32x2 __attribute__((ext_vector_type(2)));
__device__ __forceinline__ f32x2 gelu_pk(f32x2 v) {
    const f32x2 av = __builtin_elementwise_abs(v), d = av * 0.2316418882f + 1.0f;
    f32x2 t; t.x = __builtin_amdgcn_rcpf(d.x); t.y = __builtin_amdgcn_rcpf(d.y);
    f32x2 q = t * 0.5307027145f + (-0.7265760135f); q = q * t + 0.7107068705f; q = q * t + (-0.142248368f); q = q * t + 0.127414796f; q = q * t;
    const f32x2 s = (v * v) * (-0.72134752044f);
    f32x2 e; e.x = __builtin_amdgcn_exp2f(s.x); e.y = __builtin_amdgcn_exp2f(s.y);
    const f32x2 m = v * (q * e), r = v - m;
    f32x2 o; o.x = v.x < 0.f ? m.x : r.x; o.y = v.y < 0.f ? m.y : r.y; return o;
}

struct EpiF32 {
    static constexpr bool PERM = false, AFTER_DRAIN = false;
    float* C; int ldc; const float* bias;
    __device__ __forceinline__ void operator()(const f32x4 (&acc)[2][2][4][2], const Unit& u, int wr, int wc, int fr, int fq) const {
        const int row0 = u.pm * BM + wr * 64 + fr, col0 = u.pn * BM + wc * 32 + 4 * fq;
        f32x4 bv[2][2];
#pragma unroll
        for (int bj = 0; bj < 2; ++bj)
#pragma unroll
            for (int n = 0; n < 2; ++n) bv[bj][n] = bias ? *(const f32x4*)(bias + col0 + bj * HALF + n * 16) : (f32x4){0.f, 0.f, 0.f, 0.f};
#pragma unroll
        for (int ai = 0; ai < 2; ++ai)
#pragma unroll
            for (int m = 0; m < 4; ++m) { float* rowp = C + (size_t)(row0 + ai * HALF + m * 16) * ldc + col0;
#pragma unroll
                for (int bj = 0; bj < 2; ++bj)
#pragma unroll
                    for (int n = 0; n < 2; ++n) *(f32x4*)(rowp + bj * HALF + n * 16) = acc[ai][bj][m][n] + bv[bj][n]; }
    }
};
template <int ACT  > struct EpiBf16 {
    static constexpr bool PERM = true, AFTER_DRAIN = false;
    bf16_t* O; int ldc; const float* bias; int split_cols; size_t split_stride;
    __device__ __forceinline__ void operator()(const f32x4 (&acc)[2][2][4][2], const Unit& u, int wr, int wc, int fr, int fq) const {
        const int row0 = u.pm * BM + wr * 64 + fr; int colt = u.pn * BM; bf16_t* base = O;
        if (split_cols) { const int t = colt / split_cols; base += (size_t)t * split_stride; colt -= t * split_cols; }
        const int col0 = colt + wc * 32 + 8 * fq, bcol0 = u.pn * BM + wc * 32 + 8 * fq;
        f32x4 bv[2][2];
#pragma unroll
        for (int bj = 0; bj < 2; ++bj)
#pragma unroll
            for (int n = 0; n < 2; ++n) bv[bj][n] = bias ? *(const f32x4*)(bias + bcol0 + bj * HALF + 4 * n) : (f32x4){0.f, 0.f, 0.f, 0.f};
#pragma unroll
        for (int ai = 0; ai < 2; ++ai)
#pragma unroll
            for (int m = 0; m < 4; ++m) { bf16_t* rowp = base + (size_t)(row0 + ai * HALF + m * 16) * ldc + col0;
#pragma unroll
                for (int bj = 0; bj < 2; ++bj) { f32x4 v0 = acc[ai][bj][m][0] + bv[bj][0], v1 = acc[ai][bj][m][1] + bv[bj][1];
                    if (ACT == 1) { f32x2 a = gelu_pk((f32x2){v0[0], v0[1]}), b = gelu_pk((f32x2){v0[2], v0[3]}), c = gelu_pk((f32x2){v1[0], v1[1]}), d = gelu_pk((f32x2){v1[2], v1[3]});
                        v0 = (f32x4){a.x, a.y, b.x, b.y}; v1 = (f32x4){c.x, c.y, d.x, d.y}; }
                    if (ACT == 2) {
#pragma unroll
                        for (int j = 0; j < 4; ++j) { v0[j] = 0.5f * v0[j] * (1.0f + erff(v0[j] * 0.70710678f)); v1[j] = 0.5f * v1[j] * (1.0f + erff(v1[j] * 0.70710678f)); } }
                    u32x4 w; w.x = cvt_pk_bf16(v0[0], v0[1]); w.y = cvt_pk_bf16(v0[2], v0[3]); w.z = cvt_pk_bf16(v1[0], v1[1]); w.w = cvt_pk_bf16(v1[2], v1[3]);
                    *(u32x4*)(rowp + bj * HALF) = w; } }
    }
};
template <class Epi, class Sched, bool STAMP = false>
__device__ __forceinline__ void gemm_phase(PG8_LAS unsigned char* lds, const Gemm g, const Sched& S, const Epi& E, unsigned long long* stamps) {
    const int tid = threadIdx.x, wid = __builtin_amdgcn_readfirstlane(tid >> 6), lane = tid & 63, wr = wid >> 2, wc = wid & 3, fr = lane & 15, fq = lane >> 4;
    const int K = g.K, nt = K / BK;
    int ts_lo = 0, ts_hi = 0, nts = 0; const unsigned long long rt_entry = STAMP ? (unsigned long long)wall_clock64() : 0ull;
#define PG8_STAMP() do { if (STAMP && wid == 0 && nts < 64) { const unsigned long long _c = (unsigned long long)clock64(); \
        ts_lo = (lane == nts) ? (int)(unsigned)_c : ts_lo; ts_hi = (lane == nts) ? (int)(unsigned)(_c >> 32) : ts_hi; ++nts; } } while (0)
    PG8_STAMP();
    unsigned voffA[2], voffB[2];
#pragma unroll
    for (int i = 0; i < 2; ++i) { int R, C; stage_rc(tid * 16 + i * 8192, R, C); const int Rb = Epi::PERM ? ((R & ~31) + perm32(R & 31)) : R;
        voffA[i] = (unsigned)(R * K + C) * 2u; voffB[i] = (unsigned)(Rb * K + C) * 2u; }
    const size_t kstep = (size_t)(BK * 2);
    const size_t hstep = (size_t)HALF * K * 2;
    const size_t tstep = 2 * hstep;
    const unsigned ldsw = (unsigned)wid * 1024u;
    const int aoff = lds_byte(wr * 64 + fr, fq * 8), boff = lds_byte(wc * 32 + fr, fq * 8);
#define PG8_SA(b, h) (((b) * 2 + (h)) * HTB)
#define PG8_SB(b, h) ((4 + (b) * 2 + (h)) * HTB)
#define PG8_STAGE(bufoff, gbase, voff) do { _Pragma("unroll") for (int _i = 0; _i < 2; ++_i) \
        __builtin_amdgcn_global_load_lds((const unsigned*)((const char*)(gbase) + (voff)[_i]), (PG8_LAS unsigned*)(lds + (bufoff) + ldsw + _i * 8192), 16, 0, 0); } while (0)
#define PG8_LDA(dst, b, h) do { _Pragma("unroll") for (int m = 0; m < 4; ++m) _Pragma("unroll") for (int k = 0; k < 2; ++k) dst[m][k] = *(const PG8_LAS bf16x8*)(lds + PG8_SA(b, h) + aoff + m * 2048 + k * 1024); } while (0)
#define PG8_LDB(dst, b, h) do { _Pragma("unroll") for (int n = 0; n < 2; ++n) _Pragma("unroll") for (int k = 0; k < 2; ++k) dst[n][k] = *(const PG8_LAS bf16x8*)(lds + PG8_SB(b, h) + boff + n * 2048 + k * 1024); } while (0)
#define PG8_MMA(ai, bj, At, Bt) do { __builtin_amdgcn_s_setprio(1); _Pragma("unroll") for (int m = 0; m < 4; ++m) _Pragma("unroll") for (int n = 0; n < 2; ++n) _Pragma("unroll") for (int k = 0; k < 2; ++k) \
        acc[ai][bj][m][n] = __builtin_amdgcn_mfma_f32_16x16x32_bf16(Bt[n][k], At[m][k], acc[ai][bj][m][n], 0, 0, 0); __builtin_amdgcn_s_setprio(0); } while (0)
#define PG8_WAIT_V(n) asm volatile("s_waitcnt vmcnt(" #n ")" ::: "memory")
#define PG8_WAIT_L(n) asm volatile("s_waitcnt lgkmcnt(" #n ")" ::: "memory")
#define PG8_BAR __builtin_amdgcn_s_barrier()
#define PG8_SCHED __builtin_amdgcn_sched_barrier(0)
    Unit cur, nxt; int ui = 0;
    if (!S.next(0, cur)) return;
    f32x4 acc[2][2][4][2];
#pragma unroll
    for (int a = 0; a < 2; ++a)
#pragma unroll
        for (int b = 0; b < 2; ++b)
#pragma unroll
            for (int m = 0; m < 4; ++m)
#pragma unroll
                for (int n = 0; n < 2; ++n) acc[a][b][m][n] = (f32x4){0.f, 0.f, 0.f, 0.f};
    bf16x8 At[4][2], B0[2][2], B1[2][2];
    const char* cA = S.pa(g, cur); const char* cB = S.pb(g, cur);
    S.a_ready(cur);
    PG8_STAGE(PG8_SB(0, 0), cB, voffB); PG8_STAGE(PG8_SA(0, 0), cA, voffA); PG8_STAGE(PG8_SB(0, 1), cB + hstep, voffB); PG8_STAGE(PG8_SA(0, 1), cA + hstep, voffA);
    if (wr == 1) PG8_BAR;
    PG8_WAIT_V(4); PG8_BAR;
    PG8_STAGE(PG8_SB(1, 0), cB + kstep, voffB); PG8_STAGE(PG8_SA(1, 0), cA + kstep, voffA); PG8_STAGE(PG8_SB(1, 1), cB + hstep + kstep, voffB);
    PG8_WAIT_V(6); PG8_BAR;
    PG8_STAMP();
    for (;;) {
        const bool has_next = S.next(ui + 1, nxt);
        const char* nA = has_next ? S.pa(g, nxt) : cA; const char* nB = has_next ? S.pb(g, nxt) : cB;
        for (int t = 0; t < nt; t += 2) {
            const bool last = (t == nt - 2);
            const char* a1 = cA + (size_t)(t + 1) * kstep;
            const char* a2 = last ? nA : cA + (size_t)(t + 2) * kstep; const char* b2 = last ? nB : cB + (size_t)(t + 2) * kstep;
            const char* a3 = a2 + kstep; const char* b3 = b2 + kstep;
            if (last && has_next) S.a_ready(nxt);
            PG8_LDB(B0, 0, 0); PG8_SCHED; PG8_LDA(At, 0, 0); PG8_STAGE(PG8_SA(1, 1), a1 + hstep, voffA);
            PG8_WAIT_L(8); PG8_BAR; PG8_WAIT_L(0); PG8_MMA(0, 0, At, B0); PG8_BAR; PG8_SCHED;
            PG8_LDB(B1, 0, 1); PG8_STAGE(PG8_SB(0, 0), b2, voffB);
            PG8_BAR; PG8_WAIT_L(0); PG8_MMA(0, 1, At, B1); PG8_BAR;
            PG8_LDA(At, 0, 1); PG8_STAGE(PG8_SA(0, 0), a2, voffA);
            PG8_BAR; PG8_WAIT_L(0); PG8_MMA(1, 0, At, B0); PG8_BAR; PG8_SCHED;
            PG8_STAGE(PG8_SB(0, 1), b2 + hstep, voffB);
            PG8_WAIT_V(6); PG8_BAR; PG8_MMA(1, 1, At, B1); PG8_BAR;
            PG8_LDB(B0, 1, 0); PG8_SCHED; PG8_LDA(At, 1, 0); PG8_STAGE(PG8_SA(0, 1), a2 + hstep, voffA);
            PG8_WAIT_L(8); PG8_BAR; PG8_WAIT_L(0); PG8_MMA(0, 0, At, B0); PG8_BAR; PG8_SCHED;
            PG8_LDB(B1, 1, 1); PG8_STAGE(PG8_SB(1, 0), b3, voffB);
            PG8_BAR; PG8_WAIT_L(0); PG8_MMA(0, 1, At, B1); PG8_BAR;
            PG8_LDA(At, 1, 1); PG8_STAGE(PG8_SA(1, 0), a3, voffA);
            PG8_BAR; PG8_WAIT_L(0); PG8_MMA(1, 0, At, B0); PG8_BAR; PG8_SCHED;
            PG8_STAGE(PG8_SB(1, 1), b3 + hstep, voffB);
            PG8_WAIT_V(6); PG8_BAR; PG8_MMA(1, 1, At, B1); PG8_BAR;
        }
        PG8_STAMP();
        if constexpr (!Epi::AFTER_DRAIN) { E(acc, cur, wr, wc, fr, fq); S.done(cur); }
        PG8_STAMP();
        if (!has_next) break;
#pragma unroll
        for (int a = 0; a < 2; ++a)
#pragma unroll
            for (int b = 0; b < 2; ++b)
#pragma unroll
                for (int m = 0; m < 4; ++m)
#pragma unroll
                    for (int n = 0; n < 2; ++n) acc[a][b][m][n] = (f32x4){0.f, 0.f, 0.f, 0.f};
        cur = nxt; cA = nA; cB = nB; ++ui;
    }
    PG8_WAIT_V(0);
    if (wr == 0) PG8_BAR;
    PG8_BAR;
    if constexpr (Epi::AFTER_DRAIN) { E.fused(acc, cur, wr, wc, fr, fq, lds, wid, lane); S.done(cur); }
    PG8_STAMP();
    if (STAMP && wid == 0) { stamps[lane] = lane < nts ? (((unsigned long long)(unsigned)ts_hi << 32) | (unsigned)ts_lo) : 0ull;
        if (lane == 62) stamps[62] = rt_entry; if (lane == 63) stamps[63] = (unsigned long long)wall_clock64(); }
#undef PG8_STAMP
#undef PG8_SA
#undef PG8_SB
#undef PG8_STAGE
#undef PG8_LDA
#undef PG8_LDB
#undef PG8_MMA
#undef PG8_WAIT_V
#undef PG8_WAIT_L
#undef PG8_BAR
#undef PG8_SCHED
}
}

typedef unsigned short bf16_t;
__device__ __forceinline__ float wave_sum(float v) {
#pragma unroll
    for (int o = 32; o; o >>= 1) v += __shfl_xor(v, o);
    return v;
}
__device__ __forceinline__ float block_sum(float v, float* red) {
    v = wave_sum(v);
    __syncthreads();
    if ((threadIdx.x & 63) == 0) red[threadIdx.x >> 6] = v;
    __syncthreads();
    float s = 0.f;
#pragma unroll
    for (int i = 0; i < NWAVES; ++i) s += red[i];
    return s;
}
__device__ __forceinline__ int opaque_tid() { int t = threadIdx.x; asm volatile("" : "+v"(t)); return t; }
typedef float nt_f32x4 __attribute__((ext_vector_type(4)));
__device__ __forceinline__ float4 nt_load4(const float* p) { const nt_f32x4 v = __builtin_nontemporal_load((const nt_f32x4*)p); return make_float4(v[0], v[1], v[2], v[3]); }
typedef unsigned nt_u32x4 __attribute__((ext_vector_type(4)));
typedef unsigned nt_u32x2 __attribute__((ext_vector_type(2)));
__device__ __forceinline__ uint4 nt_load4u(const void* p) { const nt_u32x4 v = __builtin_nontemporal_load((const nt_u32x4*)p); return make_uint4(v[0], v[1], v[2], v[3]); }
__device__ __forceinline__ uint2 nt_load2u(const void* p) { const nt_u32x2 v = __builtin_nontemporal_load((const nt_u32x2*)p); return make_uint2(v[0], v[1]); }
__device__ __forceinline__ void nt_store4(float* p, float a, float b, float c, float d) { nt_f32x4 v = {a, b, c, d}; __builtin_nontemporal_store(v, (nt_f32x4*)p); }
__device__ __forceinline__ void nt_store4u(void* p, uint4 v) { nt_u32x4 w = {v.x, v.y, v.z, v.w}; __builtin_nontemporal_store(w, (nt_u32x4*)p); }
__device__ __forceinline__ void nt_store2u(void* p, uint2 v) { nt_u32x2 w = {v.x, v.y}; __builtin_nontemporal_store(w, (nt_u32x2*)p); }
__device__ __forceinline__ float silu(float x) { return x / (1.0f + expf(-x)); }


__device__ __forceinline__ unsigned pk_bf16(float lo, float hi) { unsigned r; asm volatile("v_cvt_pk_bf16_f32 %0, %1, %2" : "=v"(r) : "v"(lo), "v"(hi)); return r; }
__device__ __forceinline__ void transpose_convert(const float* __restrict__ W, bf16_t* __restrict__ Wt, int K, int N, float* lds, int wb0, int nwb) {
    const int tid = opaque_tid();
    const int tk = K / 64, tn = N / 256;
    for (int tile = (int)blockIdx.x - wb0; tile < tk * tn; tile += nwb) {
        const int k0 = (tile / tn) * 64, n0 = (tile % tn) * 256;
        __syncthreads();
        float4 v[8];
#pragma unroll
        for (int i = 0; i < 8; ++i) v[i] = nt_load4(W + (size_t)(k0 + (tid >> 6) + 8 * i) * N + n0 + (tid & 63) * 4);
#pragma unroll
        for (int i = 0; i < 8; ++i) { float* d = lds + ((tid >> 6) + 8 * i) * 257 + (tid & 63) * 4; d[0] = v[i].x; d[1] = v[i].y; d[2] = v[i].z; d[3] = v[i].w; }
        __syncthreads();
#pragma unroll
        for (int q = 0; q < 4; ++q) {
            const int c = q * NTHREADS + tid, n = c >> 3, k8 = (c & 7) * 8;
            uint4 o;
            o.x = pk_bf16(lds[(k8 + 0) * 257 + n], lds[(k8 + 1) * 257 + n]); o.y = pk_bf16(lds[(k8 + 2) * 257 + n], lds[(k8 + 3) * 257 + n]);
            o.z = pk_bf16(lds[(k8 + 4) * 257 + n], lds[(k8 + 5) * 257 + n]); o.w = pk_bf16(lds[(k8 + 6) * 257 + n], lds[(k8 + 7) * 257 + n]);
            *(uint4*)(Wt + (size_t)(n0 + n) * K + k0 + k8) = o;
        }
    }
}
__device__ __forceinline__ float wave_max(float v) {
#pragma unroll
    for (int o = 32; o; o >>= 1) v = fmaxf(v, __shfl_xor(v, o));
    return v;
}
__device__ __forceinline__ float block_max(float v, float* red) {
    v = wave_max(v);
    __syncthreads();
    if ((threadIdx.x & 63) == 0) red[threadIdx.x >> 6] = v;
    __syncthreads();
    float s = red[0];
#pragma unroll
    for (int i = 1; i < NWAVES; ++i) s = fmaxf(s, red[i]);
    return s;
}
__device__ __forceinline__ unsigned q4(float a, float b, float c, float d, float inv, int off) {
    const int x = __float2int_rn(a * inv) + off, y = __float2int_rn(b * inv) + off, z = __float2int_rn(c * inv) + off, w = __float2int_rn(d * inv) + off;
    return (unsigned)(x & 255) | ((unsigned)(y & 255) << 8) | ((unsigned)(z & 255) << 16) | ((unsigned)(w & 255) << 24);
}
constexpr int UROW = 1024;
template <int O> __device__ __forceinline__ unsigned nibh8(const float (&x)[16], float inv) {
    unsigned r = 0;
#pragma unroll
    for (int i = 0; i < 8; ++i) r |= (unsigned)min(max((int)floorf(x[O + i] * inv) + 8, 0), 15) << (4 * i);
    return r;
}
__device__ __forceinline__ void quant_tables(const Params& p, int wb0, int nwb) {
    const int tid = opaque_tid(), lane = tid & 63, wv = tid >> 6;
    unsigned char* tq = (unsigned char*)p.ws + B_TQ; float* rsc = p.ws + W_SU;
    const int nw = nwb * NWAVES;
    for (int row0 = ((int)blockIdx.x - wb0) * NWAVES + wv; row0 < 2 * 16384; row0 += 2 * nw) {
        float x[2][2][16]; float mx[2][2];
#pragma unroll
        for (int u = 0; u < 2; ++u) {
            const int row = min(row0 + u * nw, 2 * 16384 - 1);
            const float* src = (row < 16384 ? p.in[I_PU] : p.in[I_PV]) + (size_t)(row & 16383) * D + lane * 4;
#pragma unroll
            for (int h = 0; h < 2; ++h) {
                mx[u][h] = 0.f;
#pragma unroll
                for (int q = 0; q < 4; ++q) { const float4 v = nt_load4(src + (h * 4 + q) * 256); x[u][h][q * 4] = v.x; x[u][h][q * 4 + 1] = v.y; x[u][h][q * 4 + 2] = v.z; x[u][h][q * 4 + 3] = v.w;
                    mx[u][h] = fmaxf(mx[u][h], fmaxf(fmaxf(fabsf(v.x), fabsf(v.y)), fmaxf(fabsf(v.z), fabsf(v.w)))); }
            }
        }
#pragma unroll
        for (int u = 0; u < 2; ++u) {
            const int row = row0 + u * nw;
            if (row < 2 * 16384) {
                const float rmx = wave_max(fmaxf(mx[u][0], mx[u][1]));
                {
                    float ss = 0.f;
#pragma unroll
                    for (int h = 0; h < 2; ++h)
#pragma unroll
                        for (int i = 0; i < 16; ++i) ss += x[u][h][i] * x[u][h][i];
                    const float rms = sqrtf(wave_sum(ss) * (1.0f / 2048.0f));
                    if (row >= 16384) {
                        const float cl = fminf(rmx, 2.94f * rms);
                        const float Rv = cl > 0.f ? cl * (1.0f / 6.0f) : 1.0f, iv = 1.0f / Rv;
                        unsigned w4[4];
#pragma unroll
                        for (int q = 0; q < 4; ++q) {
                            const float* xs = &x[u][q >> 1][(q & 1) * 8];
                            unsigned r = 0u;
                            r = __builtin_amdgcn_cvt_scalef32_pk_fp4_f32(r, xs[0] * iv, xs[1] * iv, 1.0f, 0);
                            r = __builtin_amdgcn_cvt_scalef32_pk_fp4_f32(r, xs[2] * iv, xs[3] * iv, 1.0f, 1);
                            r = __builtin_amdgcn_cvt_scalef32_pk_fp4_f32(r, xs[4] * iv, xs[5] * iv, 1.0f, 2);
                            r = __builtin_amdgcn_cvt_scalef32_pk_fp4_f32(r, xs[6] * iv, xs[7] * iv, 1.0f, 3);
                            w4[q] = r;
                        }
                        nt_store4u(tq + (size_t)row * UROW + lane * 16, make_uint4(w4[0], w4[1], w4[2], w4[3]));
                        if (lane == 0) rsc[row] = Rv;
                        continue;
                    }
                    const float clipv = fminf(rmx, 2.5125f * rms);
                    const float Ru = clipv > 0.f ? clipv * (1.0f / 7.5f) : 1.0f, iu = 1.0f / Ru;
                    const unsigned c0 = nibh8<0>(x[u][0], iu), c1 = nibh8<8>(x[u][0], iu), c2 = nibh8<0>(x[u][1], iu), c3 = nibh8<8>(x[u][1], iu);
                    nt_store4u(tq + (size_t)row * UROW + lane * 16, make_uint4(c0, c1, c2, c3));
                    unsigned cs = __builtin_amdgcn_udot8(c0, 0x11111111u, 0u, false); cs = __builtin_amdgcn_udot8(c1, 0x11111111u, cs, false);
                    cs = __builtin_amdgcn_udot8(c2, 0x11111111u, cs, false); cs = __builtin_amdgcn_udot8(c3, 0x11111111u, cs, false);
                    const float csum = wave_sum((float)cs);
                    if (lane == 0) { rsc[row] = Ru; (p.ws + W_SC)[row] = csum; }
                }
            }
        }
    }
}

__device__ __forceinline__ void naive_gemm(const float* __restrict__ A, int lda, const float* __restrict__ Bm, int ldb,
                                           float* __restrict__ C, int ldc, int M, int N, int K, float* lds) {
    float* As = lds;
    float* Bs = lds + 16 * 132;
    const int tid = opaque_tid(), tx = tid & 31, ty = tid >> 5;
    const int tilesN = N / 128, ntiles = (M / 128) * tilesN;
    for (int tile = blockIdx.x; tile < ntiles; tile += gridDim.x) {
        const int m0 = (tile / tilesN) * 128, n0 = (tile % tilesN) * 128;
        float acc[8][4];
#pragma unroll
        for (int i = 0; i < 8; ++i)
#pragma unroll
            for (int j = 0; j < 4; ++j) acc[i][j] = 0.f;
        for (int k0 = 0; k0 < K; k0 += 16) {
            {
                const int row = tid >> 2, kq = (tid & 3) * 4;
                const float4 a = *(const float4*)(A + (size_t)(m0 + row) * lda + k0 + kq);
                As[(kq + 0) * 132 + row] = a.x; As[(kq + 1) * 132 + row] = a.y; As[(kq + 2) * 132 + row] = a.z; As[(kq + 3) * 132 + row] = a.w;
                const int kk = tid >> 5, n4 = (tid & 31) * 4;
                *(float4*)(Bs + kk * 128 + n4) = *(const float4*)(Bm + (size_t)(k0 + kk) * ldb + n0 + n4);
            }
            __syncthreads();
#pragma unroll 4
            for (int k = 0; k < 16; ++k) {
                const float4 a0 = *(const float4*)(As + k * 132 + ty * 8), a1 = *(const float4*)(As + k * 132 + ty * 8 + 4);
                const float4 b = *(const float4*)(Bs + k * 128 + tx * 4);
                const float av[8] = {a0.x, a0.y, a0.z, a0.w, a1.x, a1.y, a1.z, a1.w};
                const float bv[4] = {b.x, b.y, b.z, b.w};
#pragma unroll
                for (int i = 0; i < 8; ++i)
#pragma unroll
                    for (int j = 0; j < 4; ++j) acc[i][j] += av[i] * bv[j];
            }
            __syncthreads();
        }
#pragma unroll
        for (int i = 0; i < 8; ++i)
            *(float4*)(C + (size_t)(m0 + ty * 8 + i) * ldc + n0 + tx * 4) = make_float4(acc[i][0], acc[i][1], acc[i][2], acc[i][3]);
    }
}

__device__ __forceinline__ void phase_a(const Params& p, float* lds) {
    const int tid = opaque_tid();
    const float* c = p.in[I_C]; const float* cctx = p.in[I_CCTX]; const float* wada = p.in[I_WADA];
    float* part = p.ws + W_ADAP;
    for (int item = blockIdx.x; item < 32 * 24; item += gridDim.x) {
        const int ks = item / 24, j = (item % 24) * 512 + tid;
        __syncthreads();
        if (tid < 5 * 64) { const int n = tid >> 6, k = ks * 64 + (tid & 63); lds[tid] = silu(n < 4 ? c[n * 2048 + k] : cctx[k]); }
        __syncthreads();
        float a0 = 0.f, a1 = 0.f, a2 = 0.f, a3 = 0.f, a4 = 0.f;
#pragma unroll 32
        for (int kk = 0; kk < 64; ++kk) {
            const float w = __builtin_nontemporal_load(wada + (size_t)(ks * 64 + kk) * 12288 + j);
            a0 += lds[kk] * w; a1 += lds[64 + kk] * w; a2 += lds[128 + kk] * w; a3 += lds[192 + kk] * w; a4 += lds[256 + kk] * w;
        }
        part[(size_t)(ks * 5 + 0) * 12288 + j] = a0; part[(size_t)(ks * 5 + 1) * 12288 + j] = a1; part[(size_t)(ks * 5 + 2) * 12288 + j] = a2;
        part[(size_t)(ks * 5 + 3) * 12288 + j] = a3; part[(size_t)(ks * 5 + 4) * 12288 + j] = a4;
    }
}
typedef short bf16x8v __attribute__((ext_vector_type(8)));
typedef float f32x4v __attribute__((ext_vector_type(4)));
typedef float f32x16v __attribute__((ext_vector_type(16)));
__device__ __forceinline__ void phase_filters(const Params& p, float* lds) {
    const int tid = opaque_tid();
    const float* w1 = p.in[I_FW1]; const float* b1 = p.in[I_FB1]; const float* w2 = p.in[I_FW2]; const float* b2 = p.in[I_FB2];
    const float* w3 = p.in[I_FW3]; const float* b3 = p.in[I_FB3]; const float* w4 = p.in[I_FW4]; const float* freq = p.in[I_FREQ];
    float* hT = (float*)((char*)p.ws + B_KF); float* sp = p.ws + W_SP;
    float* zf = lds; float* ha = lds + 64 * 36; float* hb = ha + 64 * 68; float* red2 = hb + 64 * 68;
    float* W1 = red2 + 256; float* W2 = W1 + 33 * 64; float* W3 = W2 + 64 * 64;
    __syncthreads();
    for (int e = tid; e < 33 * 64; e += NTHREADS) W1[e] = w1[e];
    for (int e = tid; e < 64 * 64; e += NTHREADS) { W2[e] = w2[e]; W3[e] = w3[e]; }
    for (int item = blockIdx.x; item < 256; item += gridDim.x) {
        const int pt = item >> 3;
        __syncthreads();
        for (int e = tid; e < 64 * 33; e += NTHREADS) {
            const int pos = e / 33, m = e % 33, i = pt * 64 + pos;
            const float t = (float)i / 2047.0f, w = 6.283185307179586f * (float)i / 2048.0f;
            float v;
            if (m == 0) v = t;
            else if (m <= 16) { const float f = 1e-4f + (float)(m - 1) * ((15.0f - 1e-4f) / 15.0f); v = __cosf(f * w); }
            else { const float f = 1e-4f + (float)(m - 17) * ((15.0f - 1e-4f) / 15.0f); v = -__sinf(f * w); }
            zf[pos * 36 + m] = v;
        }
        __syncthreads();
        const int pos = tid >> 3, u0 = (tid & 7) * 8;
        {
            float a[8];
#pragma unroll
            for (int u = 0; u < 8; ++u) a[u] = b1[u0 + u];
#pragma unroll 11
            for (int m = 0; m < 33; ++m) { const float zv = zf[pos * 36 + m]; const float4 wa = *(const float4*)(W1 + m * 64 + u0), wb = *(const float4*)(W1 + m * 64 + u0 + 4);
                a[0] += zv * wa.x; a[1] += zv * wa.y; a[2] += zv * wa.z; a[3] += zv * wa.w; a[4] += zv * wb.x; a[5] += zv * wb.y; a[6] += zv * wb.z; a[7] += zv * wb.w; }
#pragma unroll
            for (int u = 0; u < 8; ++u) ha[pos * 68 + u0 + u] = __sinf(freq[u0 + u] * a[u]);
        }
        __syncthreads();
        {
            float a[8];
#pragma unroll
            for (int u = 0; u < 8; ++u) a[u] = b2[u0 + u];
#pragma unroll 16
            for (int m = 0; m < 64; ++m) { const float zv = ha[pos * 68 + m]; const float4 wa = *(const float4*)(W2 + m * 64 + u0), wb = *(const float4*)(W2 + m * 64 + u0 + 4);
                a[0] += zv * wa.x; a[1] += zv * wa.y; a[2] += zv * wa.z; a[3] += zv * wa.w; a[4] += zv * wb.x; a[5] += zv * wb.y; a[6] += zv * wb.z; a[7] += zv * wb.w; }
#pragma unroll
            for (int u = 0; u < 8; ++u) hb[pos * 68 + u0 + u] = __sinf(freq[64 + u0 + u] * a[u]);
        }
        __syncthreads();
        {
            float a[8];
#pragma unroll
            for (int u = 0; u < 8; ++u) a[u] = b3[u0 + u];
#pragma unroll 16
            for (int m = 0; m < 64; ++m) { const float zv = hb[pos * 68 + m]; const float4 wa = *(const float4*)(W3 + m * 64 + u0), wb = *(const float4*)(W3 + m * 64 + u0 + 4);
                a[0] += zv * wa.x; a[1] += zv * wa.y; a[2] += zv * wa.z; a[3] += zv * wa.w; a[4] += zv * wb.x; a[5] += zv * wb.y; a[6] += zv * wb.z; a[7] += zv * wb.w; }
#pragma unroll
            for (int u = 0; u < 8; ++u) ha[pos * 68 + u0 + u] = __sinf(freq[128 + u0 + u] * a[u]);
        }
        __syncthreads();
#pragma unroll 1
        for (int jt = (item & 7) * 2; jt < (item & 7) * 2 + 2; ++jt) {
            const int lane = tid & 63, wv = tid >> 6, cl = lane & 15, g = lane >> 4;
            union frag { unsigned u[4]; bf16x8v v; };
            frag af[2][2];
#pragma unroll
            for (int mt = 0; mt < 2; ++mt)
#pragma unroll
                for (int ks = 0; ks < 2; ++ks) {
                    const float* wp = w4 + (size_t)(ks * 32 + 8 * g) * 4096 + jt * 256 + wv * 32 + mt * 16 + cl;
                    float x[8];
#pragma unroll
                    for (int i = 0; i < 8; ++i) x[i] = wp[(size_t)i * 4096];
                    af[mt][ks].u[0] = pk_bf16(x[0], x[1]); af[mt][ks].u[1] = pk_bf16(x[2], x[3]); af[mt][ks].u[2] = pk_bf16(x[4], x[5]); af[mt][ks].u[3] = pk_bf16(x[6], x[7]);
                }
            f32x4v acc[2][4];
#pragma unroll
            for (int mt = 0; mt < 2; ++mt)
#pragma unroll
                for (int nt = 0; nt < 4; ++nt) acc[mt][nt] = (f32x4v){0.f, 0.f, 0.f, 0.f};
#pragma unroll
            for (int nt = 0; nt < 4; ++nt)
#pragma unroll
                for (int ks = 0; ks < 2; ++ks) {
                    const float4 h0 = *(const float4*)(ha + (nt * 16 + cl) * 68 + ks * 32 + 8 * g), h1 = *(const float4*)(ha + (nt * 16 + cl) * 68 + ks * 32 + 8 * g + 4);
                    frag bf; bf.u[0] = pk_bf16(h0.x, h0.y); bf.u[1] = pk_bf16(h0.z, h0.w); bf.u[2] = pk_bf16(h1.x, h1.y); bf.u[3] = pk_bf16(h1.z, h1.w);
#pragma unroll
                    for (int mt = 0; mt < 2; ++mt) acc[mt][nt] = __builtin_amdgcn_mfma_f32_16x16x32_bf16(af[mt][ks].v, bf.v, acc[mt][nt], 0, 0, 0);
                }
#pragma unroll
            for (int mt = 0; mt < 2; ++mt)
#pragma unroll
                for (int r = 0; r < 4; ++r) {
                    const int j = jt * 256 + wv * 32 + mt * 16 + 4 * g + r;
                    const float delta = 3.070113457f + (float)(j & 1023) * ((15.35056729f - 3.070113457f) / 1023.0f);
                    float asum = 0.f;
#pragma unroll
                    for (int nt = 0; nt < 4; ++nt) {
                        const int ps = pt * 64 + nt * 16 + cl;
                        const float val = acc[mt][nt][r] * __expf(-((float)ps / 2047.0f) * delta);
                        asum += fabsf(val);
                        __builtin_nontemporal_store(val, hT + (size_t)j * SL + ps);
                    }
                    asum += __shfl_xor(asum, 1); asum += __shfl_xor(asum, 2); asum += __shfl_xor(asum, 4); asum += __shfl_xor(asum, 8);
                    if (cl == 0) sp[(size_t)pt * 4096 + j] = asum;
                }
        }
    }
}

__device__ __forceinline__ void phase_b(const Params& p) {
    const int tid = opaque_tid();
    const float* part = p.ws + W_ADAP; float* ada = p.ws + W_ADA; const float* bada = p.in[I_BADA];
    for (int e = blockIdx.x * NTHREADS + tid; e < 5 * 12288; e += gridDim.x * NTHREADS) {
        float s = bada[e % 12288];
#pragma unroll 8
        for (int ks = 0; ks < 32; ++ks) s += part[(size_t)ks * 5 * 12288 + e];
        ada[e] = s;
    }
    const float* sp = p.ws + W_SP; float* fs = p.ws + W_FS;
    for (int j = blockIdx.x * NTHREADS + tid; j < 4096; j += gridDim.x * NTHREADS) {
        float s = 0.f;
#pragma unroll 8
        for (int pt = 0; pt < 32; ++pt) s += sp[(size_t)pt * 4096 + j];
        fs[j] = s;
    }
}

__device__ __forceinline__ void phase_c(const Params& p) {
    const int tid = opaque_tid();
    const float* ada = p.ws + W_ADA;
    const float* x = p.in[I_X]; bf16_t* ub = (bf16_t*)((char*)p.ws + B_UB);
    for (size_t e = (size_t)blockIdx.x * NTHREADS + tid; e < (size_t)NT * D / 4; e += (size_t)gridDim.x * NTHREADS) {
        const size_t row = e / (D / 4); const int col = (int)(e % (D / 4)) * 4; const int b = (int)(row / SL);
        const float4 xv = nt_load4(x + row * D + col);
        const float4 sh = *(const float4*)(ada + b * 12288 + col), sc = *(const float4*)(ada + b * 12288 + 2048 + col);
        uint2 o; o.x = pk_bf16(xv.x * (1.f + sc.x) + sh.x, xv.y * (1.f + sc.y) + sh.y); o.y = pk_bf16(xv.z * (1.f + sc.z) + sh.z, xv.w * (1.f + sc.w) + sh.w);
        *(uint2*)(ub + row * D + col) = o;
    }
    const float* ctx = p.in[I_CTX]; bf16_t* ucb = ub + (size_t)NT * D;
    for (size_t e = (size_t)blockIdx.x * NTHREADS + tid; e < (size_t)NTC * D / 4; e += (size_t)gridDim.x * NTHREADS) {
        const size_t row = e / (D / 4); const int col = (int)(e % (D / 4)) * 4;
        const float4 xv = nt_load4(ctx + row * D + col);
        const float4 sh = *(const float4*)(ada + 4 * 12288 + col), sc = *(const float4*)(ada + 4 * 12288 + 2048 + col);
        uint2 o; o.x = pk_bf16(xv.x * (1.f + sc.x) + sh.x, xv.y * (1.f + sc.y) + sh.y); o.y = pk_bf16(xv.z * (1.f + sc.z) + sh.z, xv.w * (1.f + sc.w) + sh.w);
        *(uint2*)(ucb + row * D + col) = o;
    }
}

__device__ __forceinline__ float bf2f(bf16_t v) { return __uint_as_float(((unsigned)v) << 16); }
constexpr int HY_PB = 4416, HY_PJ = 272, HY_R0 = 4 * HY_PB, HY_R1 = HY_R0 + 8192 + 64, HY_SLOT = HY_R1 + 8192 + 64;
static_assert(HY_SLOT % 16 == 0 && 4 * HY_SLOT + 64 <= 155 * 1024, "hyena LDS");
__device__ __forceinline__ bf16x8v hy_lda(const unsigned char* base, int off) {
    const unsigned* q = (const unsigned*)(base + off);
    union { unsigned u[4]; bf16x8v v; } r; r.u[0] = q[0]; r.u[1] = q[1]; r.u[2] = q[2]; r.u[3] = q[3];
    return r.v;
}
__device__ __forceinline__ void hy_stage_rows(const bf16_t* zT, const float* cw, const float* cb, int ch, int half, int lane, unsigned char* sl) {
    const float w0 = cw[ch], w1 = cw[3072 + ch], w2 = cw[6144 + ch], bs = cb[ch];
#pragma unroll 4
    for (int q = 0; q < 8; ++q) {
        const int bsel = 2 * half + (q >> 2), t0 = ((q & 3) * 64 + lane) * 8;
        const bf16_t* zrow = zT + (size_t)ch * NT + bsel * SL;
        const uint4 raw = nt_load4u(zrow + t0);
        float z[10];
        z[0] = t0 > 0 ? bf2f(zrow[t0 - 1]) : 0.f; z[9] = t0 + 8 < SL ? bf2f(zrow[t0 + 8]) : 0.f;
        z[1] = __uint_as_float(raw.x << 16); z[2] = __uint_as_float(raw.x & 0xffff0000u); z[3] = __uint_as_float(raw.y << 16); z[4] = __uint_as_float(raw.y & 0xffff0000u);
        z[5] = __uint_as_float(raw.z << 16); z[6] = __uint_as_float(raw.z & 0xffff0000u); z[7] = __uint_as_float(raw.w << 16); z[8] = __uint_as_float(raw.w & 0xffff0000u);
        float sv[8];
#pragma unroll
        for (int i = 0; i < 8; ++i) sv[i] = w0 * z[i] + w1 * z[i + 1] + w2 * z[i + 2] + bs;
        uint4 o; o.x = pk_bf16(sv[0], sv[1]); o.y = pk_bf16(sv[2], sv[3]); o.z = pk_bf16(sv[4], sv[5]); o.w = pk_bf16(sv[6], sv[7]);
        *(uint4*)(sl + bsel * HY_PB + (t0 >> 7) * HY_PJ + (t0 & 127) * 2) = o;
    }
}
__device__ __forceinline__ void hy_pair_sync(volatile __attribute__((address_space(3))) unsigned* fl, int wv, unsigned n) {
    asm volatile("s_waitcnt lgkmcnt(0)" ::: "memory");
    fl[wv] = n;
    while (fl[wv ^ 1] < n) __builtin_amdgcn_s_sleep(0);
    asm volatile("" ::: "memory");
}
__device__ __forceinline__ void phase_hyena(const Params& p, unsigned char* smem) {
    const int tid = opaque_tid(), lane = tid & 63, wv = tid >> 6, slot = wv >> 1, half = wv & 1, pt = tid & 127;
    const bf16_t* zT = (const bf16_t*)((const char*)p.ws + B_ZT); const float* hT = (const float*)((const char*)p.ws + B_KF); const float* fs = p.ws + W_FS; bf16_t* hyT = (bf16_t*)((char*)p.ws + B_HYT);
    const float* cw = p.in[I_CONVW]; const float* cb = p.in[I_CONVB]; const float* skip = p.in[I_SKIP];
    unsigned char* sl = smem + slot * HY_SLOT;
    const int a_ = lane & 31, hh = lane >> 5, i_local = a_ >> 2, batch = a_ & 3, I0 = 8 * half;
    const int laneA = ((a_ & 1) ? HY_R0 : HY_R1) + 2 * (2047 - a_ - (1 - (a_ & 1)) + 8 * hh);
    volatile __attribute__((address_space(3))) unsigned* fl = (volatile __attribute__((address_space(3))) unsigned*)(smem + 4 * HY_SLOT);
    unsigned seq = 0u;
    __syncthreads();
    if (tid < 8) fl[tid] = 0u;
    if (wv < 4) __builtin_amdgcn_s_setprio(2);
    for (int item = blockIdx.x; item < DHY / 4; item += gridDim.x) {
        const int c = item * 4 + slot;
        __syncthreads();
        hy_stage_rows(zT, cw, cb, c, half, lane, sl);
#pragma unroll 1
        for (int ord = 0; ord < 2; ++ord) {
            {
                const float* hf = hT + (size_t)((ord * 2 + 0) * 1024 + c) * SL; const float* hbk = hT + (size_t)((ord * 2 + 1) * 1024 + c) * SL;
                const float sk = skip[ord * 1024 + c]; const float invs = 1.0f / (fs[(ord * 2 + 0) * 1024 + c] + fs[(ord * 2 + 1) * 1024 + c]);
#pragma unroll
                for (int q = 0; q < 4; ++q) {
                    const int X0 = (q * 128 + pt) * 8;
                    float rv[9];
#pragma unroll
                    for (int i = 0; i < 9; ++i) { const int dp = 2047 - X0 - i; rv[i] = (dp >= 0 ? __builtin_nontemporal_load(hf + dp) : (dp >= -2047 ? __builtin_nontemporal_load(hbk - dp) : 0.f)) * invs; if (dp == 0) rv[i] += sk; }
                    uint4 o0, o1;
                    o0.x = pk_bf16(rv[0], rv[1]); o0.y = pk_bf16(rv[2], rv[3]); o0.z = pk_bf16(rv[4], rv[5]); o0.w = pk_bf16(rv[6], rv[7]);
                    o1.x = pk_bf16(rv[1], rv[2]); o1.y = pk_bf16(rv[3], rv[4]); o1.z = pk_bf16(rv[5], rv[6]); o1.w = pk_bf16(rv[7], rv[8]);
                    *(uint4*)(sl + HY_R0 + X0 * 2) = o0; *(uint4*)(sl + HY_R1 + X0 * 2) = o1;
                }
            }
            hy_pair_sync(fl, wv, ++seq);
            f32x16v acc[4];
#pragma unroll
            for (int mb = 0; mb < 4; ++mb)
#pragma unroll
                for (int e = 0; e < 16; ++e) acc[mb][e] = 0.f;
            {
                const int dlo = I0 - 15, dhi = I0 + 7;
                bf16x8v As[7][2];
#pragma unroll
                for (int s2 = 0; s2 < 3; ++s2)
#pragma unroll
                    for (int k2 = 0; k2 < 2; ++k2) As[4 + s2][k2] = hy_lda(sl, laneA - 64 * (4 * dlo - 3 + s2) + 32 * k2);
#pragma unroll 1
                for (int d = dlo; d <= dhi; ++d) {
#pragma unroll
                    for (int k2 = 0; k2 < 2; ++k2) { As[0][k2] = As[4][k2]; As[1][k2] = As[5][k2]; As[2][k2] = As[6][k2]; }
#pragma unroll
                    for (int s2 = 3; s2 < 7; ++s2)
#pragma unroll
                        for (int k2 = 0; k2 < 2; ++k2) As[s2][k2] = hy_lda(sl, laneA - 64 * (4 * d - 3 + s2) + 32 * k2);
                    const int jl = I0 + i_local - d; const bool valid = (unsigned)jl < 16u;
                    const unsigned char* bp = sl + batch * HY_PB + (valid ? jl : 0) * HY_PJ + hh * 16;
                    bf16x8v Bq[8];
#pragma unroll
                    for (int q = 0; q < 8; ++q) { const bf16x8v v = *(const bf16x8v*)(bp + q * 32); const bf16x8v zero = {0, 0, 0, 0, 0, 0, 0, 0}; Bq[q] = valid ? v : zero; }
#pragma unroll
                    for (int kb = 0; kb < 4; ++kb)
#pragma unroll
                        for (int k2 = 0; k2 < 2; ++k2)
#pragma unroll
                            for (int mb = 0; mb < 4; ++mb) acc[mb] = __builtin_amdgcn_mfma_f32_32x32x16_bf16(As[mb - kb + 3][k2], Bq[2 * kb + k2], acc[mb], 0, 0, 0);
                }
            }
            hy_pair_sync(fl, wv, ++seq);
            hy_stage_rows(zT, cw, cb, (ord == 0 ? 1024 : 2048) + c, half, lane, sl);
            hy_pair_sync(fl, wv, ++seq);
            {
#pragma unroll
                for (int mb = 0; mb < 4; ++mb)
#pragma unroll
                    for (int q4 = 0; q4 < 4; ++q4) {
                        const int t4 = 128 * (I0 + i_local) + 32 * mb + 8 * q4 + 4 * hh;
                        uint2* gp = (uint2*)(sl + batch * HY_PB + (t4 >> 7) * HY_PJ + (t4 & 127) * 2);
                        const uint2 gv = *gp;
                        uint2 o; o.x = pk_bf16(__uint_as_float(gv.x << 16) * acc[mb][q4 * 4 + 0], __uint_as_float(gv.x & 0xffff0000u) * acc[mb][q4 * 4 + 1]);
                        o.y = pk_bf16(__uint_as_float(gv.y << 16) * acc[mb][q4 * 4 + 2], __uint_as_float(gv.y & 0xffff0000u) * acc[mb][q4 * 4 + 3]);
                        *gp = o;
                    }
            }
            if (ord == 1) {
                hy_pair_sync(fl, wv, ++seq);
#pragma unroll
                for (int q = 0; q < 8; ++q) {
                    const int bsel = 2 * half + (q >> 2), t0 = ((q & 3) * 64 + lane) * 8;
                    nt_store4u(hyT + (size_t)c * NT + bsel * SL + t0, *(const uint4*)(sl + bsel * HY_PB + (t0 >> 7) * HY_PJ + (t0 & 127) * 2));
                }
            }
        }
    }
    __builtin_amdgcn_s_setprio(0);
}

__device__ __forceinline__ bf16x8v pack_p(const f32x4v& lo, const f32x4v& hi) {
    union { unsigned u[4]; bf16x8v v; } r;
    r.u[0] = pk_bf16(lo[0], lo[1]); r.u[1] = pk_bf16(lo[2], lo[3]); r.u[2] = pk_bf16(hi[0], hi[1]); r.u[3] = pk_bf16(hi[2], hi[3]);
    return r.v;
}
__device__ __forceinline__ bf16x8v ld_pair8(const bf16_t* lo, const bf16_t* hi) {
    union { uint2 d[2]; bf16x8v v; } r;
    r.d[0] = *(const uint2*)lo; r.d[1] = *(const uint2*)hi;
    return r.v;
}
typedef __attribute__((address_space(3))) const bf16_t* lds_bf16p;
#define LDS_FRAG(pe) (*(const __attribute__((address_space(3))) bf16x8v*)(pe))
constexpr int NA_KC = 0, NA_VC = 32768, NA_KL = 65536, NA_RPB = 155648;
__device__ __forceinline__ void phase_na(const Params& p, unsigned char* smem) {
    const int tid = opaque_tid(), lane = tid & 63, wv = tid >> 6, ql = lane & 15, g = lane >> 4;
    const bf16_t* qh = (const bf16_t*)((const char*)p.ws + B_QH); const bf16_t* kh = (const bf16_t*)((const char*)p.ws + B_KH);
    const bf16_t* kch = (const bf16_t*)((const char*)p.ws + B_KCH); const bf16_t* vT = (const bf16_t*)((const char*)p.ws + B_VT);
    const bf16_t* vcT = (const bf16_t*)((const char*)p.ws + B_VCT); bf16_t* na = (bf16_t*)((char*)p.ws + B_NA);
    const float* rpb = p.in[I_RPB];
    const lds_bf16p kcl = (lds_bf16p)((__attribute__((address_space(3))) unsigned char*)smem + NA_KC);
    const lds_bf16p vcl = (lds_bf16p)((__attribute__((address_space(3))) unsigned char*)smem + NA_VC);
    const lds_bf16p kll = (lds_bf16p)((__attribute__((address_space(3))) unsigned char*)smem + NA_KL);
    for (int sitem = blockIdx.x; sitem < 256; sitem += gridDim.x) {
      const int b = sitem >> 6, h = (sitem >> 2) & 15, rqp = sitem & 3;
      __syncthreads();
      {
          const uint4* s0 = (const uint4*)(kch + (size_t)((b * 16 + h) * 32) * 512); const uint4* s1 = (const uint4*)(vcT + (size_t)((b * 16 + h) * 32) * 512);
          uint4* d0 = (uint4*)(smem + NA_KC); uint4* d1 = (uint4*)(smem + NA_VC);
#pragma unroll
          for (int i = 0; i < 4; ++i) { d0[tid + i * NTHREADS] = s0[tid + i * NTHREADS]; d1[tid + i * NTHREADS] = s1[tid + i * NTHREADS]; }
          if (tid < 465) ((float*)(smem + NA_RPB))[tid] = rpb[h * 465 + tid];
      }
#pragma unroll 1
      for (int half = 0; half < 2; ++half) {
        const int r0 = rqp * 8 + half * 4;
        const int rs_min = min(max(r0 - 4, 0), 24), rs_max = min(max(r0 - 1, 0), 24), nrows = rs_max - rs_min + 8;
        if (half) __syncthreads();
        {
            const uint4* s0 = (const uint4*)(kh + (size_t)((b * 16 + h) * 256 + rs_min * 8) * 512); uint4* d0 = (uint4*)(smem + NA_KL);
            for (int e = tid; e < nrows * 512; e += NTHREADS) d0[e] = s0[e];
        }
        __syncthreads();
#pragma unroll 1
        for (int ti = 0; ti < 2; ++ti) {
        const int r = r0 + (wv >> 2) + 2 * ti, j = wv & 3;
        const int rs = min(max(r - 4, 0), 24), cs = min(max(16 * j - 8, 0), 32);
        const int x = 16 * j + ql, wsx = min(max(x - 8, 0), 48);
        const bf16_t* qrow = qh + ((size_t)((b * 16 + h) * SL + r * 64 + x)) * 64;
        const bf16x8v qf0 = __builtin_nontemporal_load((const bf16x8v*)(qrow + 8 * g)), qf1 = __builtin_nontemporal_load((const bf16x8v*)(qrow + 32 + 8 * g));
        const __attribute__((address_space(3))) float* rp_h = (const __attribute__((address_space(3))) float*)((__attribute__((address_space(3))) unsigned char*)smem + NA_RPB);
        f32x4v o1[4], o2[4]; float m1 = -1e30f, l1 = 0.f, m2 = -1e30f, l2 = 0.f;
#pragma unroll
        for (int d = 0; d < 4; ++d) { o1[d] = (f32x4v){0.f, 0.f, 0.f, 0.f}; o2[d] = (f32x4v){0.f, 0.f, 0.f, 0.f}; }
        const int koff = (ql >> 2) * 512 + g * 32 + (ql & 3) * 8;
        const bf16_t* vb = vT + (size_t)((b * 16 + h) * 256 + g) * 512 + ql * 8;
        {
            f32x4v st[16];
#pragma unroll
            for (int kb = 0; kb < 16; ++kb) {
                const lds_bf16p kp = kcl + koff + (kb >> 1) * 2048 + (kb & 1) * 128;
                const bf16x8v a0 = LDS_FRAG(kp), a1 = LDS_FRAG(kp + 256);
                f32x4v acc = {0.f, 0.f, 0.f, 0.f};
                acc = __builtin_amdgcn_mfma_f32_16x16x32_bf16(a0, qf0, acc, 0, 0, 0);
                acc = __builtin_amdgcn_mfma_f32_16x16x32_bf16(a1, qf1, acc, 0, 0, 0);
#pragma unroll
                for (int rr = 0; rr < 4; ++rr) { acc[rr] *= 0.125f; m1 = fmaxf(m1, acc[rr]); }
                st[kb] = acc;
            }
            m1 = fmaxf(m1, __shfl_xor(m1, 16)); m1 = fmaxf(m1, __shfl_xor(m1, 32));
#pragma unroll
            for (int kb = 0; kb < 16; ++kb)
#pragma unroll
                for (int rr = 0; rr < 4; ++rr) { const float e = __expf(st[kb][rr] - m1); st[kb][rr] = e; l1 += e; }
            l1 += __shfl_xor(l1, 16); l1 += __shfl_xor(l1, 32);
#pragma unroll
            for (int kp = 0; kp < 8; ++kp) {
                const bf16x8v pb = pack_p(st[2 * kp], st[2 * kp + 1]);
#pragma unroll
                for (int d = 0; d < 4; ++d) o1[d] = __builtin_amdgcn_mfma_f32_16x16x32_bf16(LDS_FRAG(vcl + g * 512 + ql * 8 + kp * 2048 + d * 128), pb, o1[d], 0, 0, 0);
            }
        }
        {
            f32x4v st[16];
#pragma unroll
            for (int kb = 0; kb < 16; ++kb) {
                const lds_bf16p kp = kll + koff + ((((rs + (kb >> 1) - rs_min) * 64 + cs) >> 3) * 512) + (kb & 1) * 128;
                const bf16x8v a0 = LDS_FRAG(kp), a1 = LDS_FRAG(kp + 256);
                f32x4v acc = {0.f, 0.f, 0.f, 0.f};
                acc = __builtin_amdgcn_mfma_f32_16x16x32_bf16(a0, qf0, acc, 0, 0, 0);
                acc = __builtin_amdgcn_mfma_f32_16x16x32_bf16(a1, qf1, acc, 0, 0, 0);
                const int dr = rs + (kb >> 1) - r + 7;
#pragma unroll
                for (int rr = 0; rr < 4; ++rr) {
                    const int kc = cs + 8 * g + 4 * (kb & 1) + rr, rel = kc - wsx;
                    const bool ok = rel >= 0 && rel < 16;
                    const int dc = min(max(kc - x + 15, 0), 30);
                    const float sv = ok ? acc[rr] * 0.125f + rp_h[dr * 31 + dc] : -1e30f;
                    acc[rr] = sv; m2 = fmaxf(m2, sv);
                }
                st[kb] = acc;
                if ((kb & 7) == 7) asm volatile("" ::: "memory");
            }
            m2 = fmaxf(m2, __shfl_xor(m2, 16)); m2 = fmaxf(m2, __shfl_xor(m2, 32));
#pragma unroll
            for (int kb = 0; kb < 16; ++kb)
#pragma unroll
                for (int rr = 0; rr < 4; ++rr) { const float e = __expf(st[kb][rr] - m2); st[kb][rr] = e; l2 += e; }
            l2 += __shfl_xor(l2, 16); l2 += __shfl_xor(l2, 32);
#pragma unroll
            for (int kp = 0; kp < 8; ++kp) {
                const bf16x8v pb = pack_p(st[2 * kp], st[2 * kp + 1]);
                const bf16_t* vp = vb + (size_t)(((rs + kp) * 64 + cs) >> 3) * 512;
#pragma unroll
                for (int d = 0; d < 4; ++d) o2[d] = __builtin_amdgcn_mfma_f32_16x16x32_bf16(*(const bf16x8v*)(vp + d * 128), pb, o2[d], 0, 0, 0);
                if ((kp & 3) == 3) asm volatile("" ::: "memory");
            }
        }
        const float mm = fmaxf(m1, m2), c1 = __expf(m1 - mm), c2 = __expf(m2 - mm);
        const float inv = 1.0f / (c1 * l1 + c2 * l2);
        const float w1 = c1 * inv, w2 = c2 * inv;
        f32x4v o[4];
#pragma unroll
        for (int d = 0; d < 4; ++d) o[d] = o1[d] * w1 + o2[d] * w2;
        bf16_t* op = na + (size_t)(b * SL + r * 64 + x) * DNA + h * 64 + 4 * g;
#pragma unroll
        for (int d = 0; d < 4; ++d) { uint2 w; w.x = pk_bf16(o[d][0], o[d][1]); w.y = pk_bf16(o[d][2], o[d][3]); nt_store2u(op + 16 * d, w); }
        }
      }
    }
}

__device__ __forceinline__ void phase_f(const Params& p, float* ldsf) {
    const int tid = opaque_tid();
    const bf16_t* hyT = (const bf16_t*)((const char*)p.ws + B_HYT); const bf16_t* na = (const bf16_t*)((const char*)p.ws + B_NA);
    bf16_t* ob = (bf16_t*)((char*)p.ws + B_UB);
    const float* ghy = p.in[I_GHY]; const float* gna = p.in[I_GNA];
    bf16_t* tile = (bf16_t*)ldsf;
    for (int item0 = blockIdx.x; item0 < NT / 32; item0 += gridDim.x) {
        const int item = gridDim.x == 256 ? 32 * (item0 & 7) + (item0 >> 3) : item0;
        const int t0 = item * 32;
        __syncthreads();
        uint4 hvv[8];
#pragma unroll
        for (int q = 0; q < 8; ++q) { const int e = q * NTHREADS + tid; hvv[q] = nt_load4u(hyT + (size_t)(e >> 2) * NT + t0 + (e & 3) * 8); }
#pragma unroll
        for (int q = 0; q < 8; ++q) {
            const int e = q * NTHREADS + tid, ch = e >> 2, part = e & 3;
            const unsigned wd[4] = {hvv[q].x, hvv[q].y, hvv[q].z, hvv[q].w};
#pragma unroll
            for (int i = 0; i < 4; ++i) { tile[(part * 8 + 2 * i) * 1032 + ch] = (bf16_t)(wd[i] & 0xffffu); tile[(part * 8 + 2 * i + 1) * 1032 + ch] = (bf16_t)(wd[i] >> 16); }
        }
        __syncthreads();
        const int tk = tid >> 4, sub = tid & 15;
        float hv[64]; float sh = 0.f, sn = 0.f;
#pragma unroll
        for (int i = 0; i < 8; ++i) {
            const uint4 v = *(const uint4*)(tile + tk * 1032 + (i * 16 + sub) * 8);
            const unsigned wd[4] = {v.x, v.y, v.z, v.w};
#pragma unroll
            for (int k = 0; k < 4; ++k) { const float a = __uint_as_float(wd[k] << 16), c = __uint_as_float(wd[k] & 0xffff0000u); hv[i * 8 + 2 * k] = a; hv[i * 8 + 2 * k + 1] = c; sh += a * a + c * c; }
        }
        const bf16_t* nrow = na + (size_t)(t0 + tk) * DNA;
        uint4 nv[8];
#pragma unroll
        for (int i = 0; i < 8; ++i) { nv[i] = nt_load4u(nrow + (i * 16 + sub) * 8);
            const unsigned wd[4] = {nv[i].x, nv[i].y, nv[i].z, nv[i].w};
#pragma unroll
            for (int k = 0; k < 4; ++k) { const float a = __uint_as_float(wd[k] << 16), c = __uint_as_float(wd[k] & 0xffff0000u); sn += a * a + c * c; } }
        sh += __shfl_xor(sh, 1); sh += __shfl_xor(sh, 2); sh += __shfl_xor(sh, 4); sh += __shfl_xor(sh, 8);
        sn += __shfl_xor(sn, 1); sn += __shfl_xor(sn, 2); sn += __shfl_xor(sn, 4); sn += __shfl_xor(sn, 8);
        const float rh = rsqrtf(sh * (1.0f / 1024.0f) + LN_EPS), rn = rsqrtf(sn * (1.0f / 1024.0f) + LN_EPS);
        bf16_t* orow = ob + (size_t)(t0 + tk) * D;
#pragma unroll
        for (int i = 0; i < 8; ++i) {
            const float4 g0 = *(const float4*)(ghy + (i * 16 + sub) * 8), g1 = *(const float4*)(ghy + (i * 16 + sub) * 8 + 4);
            uint4 w; w.x = pk_bf16(hv[i * 8] * rh * g0.x, hv[i * 8 + 1] * rh * g0.y); w.y = pk_bf16(hv[i * 8 + 2] * rh * g0.z, hv[i * 8 + 3] * rh * g0.w);
            w.z = pk_bf16(hv[i * 8 + 4] * rh * g1.x, hv[i * 8 + 5] * rh * g1.y); w.w = pk_bf16(hv[i * 8 + 6] * rh * g1.z, hv[i * 8 + 7] * rh * g1.w);
            *(uint4*)(orow + (i * 16 + sub) * 8) = w;
        }
#pragma unroll
        for (int i = 0; i < 8; ++i) {
            const float4 g0 = *(const float4*)(gna + (i * 16 + sub) * 8), g1 = *(const float4*)(gna + (i * 16 + sub) * 8 + 4);
            const unsigned wd[4] = {nv[i].x, nv[i].y, nv[i].z, nv[i].w};
            float a[8];
#pragma unroll
            for (int k = 0; k < 4; ++k) { a[2 * k] = __uint_as_float(wd[k] << 16); a[2 * k + 1] = __uint_as_float(wd[k] & 0xffff0000u); }
            uint4 w; w.x = pk_bf16(a[0] * rn * g0.x, a[1] * rn * g0.y); w.y = pk_bf16(a[2] * rn * g0.z, a[3] * rn * g0.w);
            w.z = pk_bf16(a[4] * rn * g1.x, a[5] * rn * g1.y); w.w = pk_bf16(a[6] * rn * g1.z, a[7] * rn * g1.w);
            *(uint4*)(orow + DHY + (i * 16 + sub) * 8) = w;
        }
    }
}

__device__ __forceinline__ void phase_h(const Params& p) {
    const int tid = opaque_tid(), lane = tid & 63, wv = tid >> 6;
    const float* x = p.in[I_X]; const bf16_t* y = (const bf16_t*)((const char*)p.ws + B_Y); const float* ada = p.ws + W_ADA;
    const float* g = p.in[I_LN1G]; const float* be = p.in[I_LN1B];
    bf16_t* x1 = (bf16_t*)((char*)p.ws + B_X1); bf16_t* u2b = (bf16_t*)((char*)p.ws + B_UB); unsigned* u2q = (unsigned*)((char*)p.ws + B_U2Q); float* su2 = p.ws + W_SU2;
#pragma unroll 1
    for (int tpl = blockIdx.x * NWAVES + wv, it = 0; tpl < NT / 2; tpl += gridDim.x * NWAVES, ++it) {
        const int tp = gridDim.x == 256 ? 512 * ((int)blockIdx.x & 7) + ((int)blockIdx.x >> 3) * 16 + wv * 2 + it : tpl;
        const int b = (2 * tp) / SL;
        float v[2][32]; float s[2] = {0.f, 0.f};
#pragma unroll
        for (int u = 0; u < 2; ++u)
#pragma unroll
            for (int j = 0; j < 8; ++j) {
                const int col = j * 256 + lane * 4; const size_t t = (size_t)(2 * tp + u);
                const float4 xv = nt_load4(x + t * D + col); const uint2 yb = nt_load2u(y + t * D + col);
                const float4 yv = make_float4(__uint_as_float(yb.x << 16), __uint_as_float(yb.x & 0xffff0000u), __uint_as_float(yb.y << 16), __uint_as_float(yb.y & 0xffff0000u));
                const float4 gt = *(const float4*)(ada + b * 12288 + 2 * 2048 + col);
                v[u][j * 4] = ALPHA * xv.x + gt.x * yv.x; v[u][j * 4 + 1] = ALPHA * xv.y + gt.y * yv.y; v[u][j * 4 + 2] = ALPHA * xv.z + gt.z * yv.z; v[u][j * 4 + 3] = ALPHA * xv.w + gt.w * yv.w;
                s[u] += (v[u][j * 4] + v[u][j * 4 + 1]) + (v[u][j * 4 + 2] + v[u][j * 4 + 3]);
            }
        float rstd[2];
#pragma unroll
        for (int u = 0; u < 2; ++u) {
            const float mean = wave_sum(s[u]) * (1.0f / 2048.0f);
            float q2 = 0.f;
#pragma unroll
            for (int i = 0; i < 32; ++i) { v[u][i] -= mean; q2 += v[u][i] * v[u][i]; }
            rstd[u] = rsqrtf(wave_sum(q2) * (1.0f / 2048.0f) + LN_EPS);
        }
        asm volatile("" ::: "memory");
        float umx[2] = {0.f, 0.f};
#pragma unroll
        for (int j = 0; j < 8; ++j) {
            const int col = j * 256 + lane * 4;
            const float4 gv = *(const float4*)(g + col), bv = *(const float4*)(be + col);
            const float4 sh = *(const float4*)(ada + b * 12288 + 3 * 2048 + col), sc = *(const float4*)(ada + b * 12288 + 4 * 2048 + col);
#pragma unroll
            for (int u = 0; u < 2; ++u) {
                const size_t t = (size_t)(2 * tp + u);
                const float4 o = make_float4(v[u][j * 4] * rstd[u] * gv.x + bv.x, v[u][j * 4 + 1] * rstd[u] * gv.y + bv.y, v[u][j * 4 + 2] * rstd[u] * gv.z + bv.z, v[u][j * 4 + 3] * rstd[u] * gv.w + bv.w);
                { uint2 xb; xb.x = pk_bf16(o.x, o.y); xb.y = pk_bf16(o.z, o.w); nt_store2u(x1 + t * D + col, xb); }
                const float4 uv = make_float4(o.x * (1.f + sc.x) + sh.x, o.y * (1.f + sc.y) + sh.y, o.z * (1.f + sc.z) + sh.z, o.w * (1.f + sc.w) + sh.w);
                v[u][j * 4] = uv.x; v[u][j * 4 + 1] = uv.y; v[u][j * 4 + 2] = uv.z; v[u][j * 4 + 3] = uv.w;
                uint2 ub2; ub2.x = pk_bf16(uv.x, uv.y); ub2.y = pk_bf16(uv.z, uv.w);
                *(uint2*)(u2b + t * D + col) = ub2;
                umx[u] = fmaxf(umx[u], fmaxf(fmaxf(fabsf(uv.x), fabsf(uv.y)), fmaxf(fabsf(uv.z), fabsf(uv.w))));
            }
        }
#pragma unroll
        for (int u = 0; u < 2; ++u) {
            const size_t t = (size_t)(2 * tp + u);
            const float um = wave_max(umx[u]);
            const float inv = um > 0.f ? 127.0f / um : 0.f;
            uint4 qa, qb;
            qa.x = q4(v[u][0], v[u][1], v[u][2], v[u][3], inv, 0); qa.y = q4(v[u][4], v[u][5], v[u][6], v[u][7], inv, 0); qa.z = q4(v[u][8], v[u][9], v[u][10], v[u][11], inv, 0); qa.w = q4(v[u][12], v[u][13], v[u][14], v[u][15], inv, 0);
            qb.x = q4(v[u][16], v[u][17], v[u][18], v[u][19], inv, 0); qb.y = q4(v[u][20], v[u][21], v[u][22], v[u][23], inv, 0); qb.z = q4(v[u][24], v[u][25], v[u][26], v[u][27], inv, 0); qb.w = q4(v[u][28], v[u][29], v[u][30], v[u][31], inv, 0);
            nt_store4u(u2q + t * 512 + lane * 8, qa); nt_store4u(u2q + t * 512 + lane * 8 + 4, qb);
            if (lane == 0) su2[t] = um * (1.0f / 127.0f);
        }
    }
}

template <int N> __device__ __forceinline__ void bitonic_desc(float (&v)[N]) {
#pragma unroll
    for (int k = 2; k <= N; k <<= 1)
#pragma unroll
        for (int j = k >> 1; j > 0; j >>= 1)
#pragma unroll
            for (int i = 0; i < N; ++i) { const int l = i ^ j; if (l > i) { const float x = v[i], y = v[l]; const float mx = fmaxf(x, y), mn = fminf(x, y); if ((i & k) == 0) { v[i] = mx; v[l] = mn; } else { v[i] = mn; v[l] = mx; } } }
}
__device__ __forceinline__ void bitonic_merge16_desc(float (&v)[16]) {
#pragma unroll
    for (int j = 8; j > 0; j >>= 1)
#pragma unroll
        for (int i = 0; i < 16; ++i) { const int l = i ^ j; if (l > i) { const float x = v[i], y = v[l]; v[i] = fmaxf(x, y); v[l] = fminf(x, y); } }
}
__device__ __forceinline__ void top16_of_128(float (&sc)[32], float (&top)[16]) {
    float lo[16], hi[16];
#pragma unroll
    for (int i = 0; i < 16; ++i) { lo[i] = sc[i]; hi[i] = sc[16 + i]; }
    bitonic_desc<16>(lo); bitonic_desc<16>(hi);
#pragma unroll
    for (int i = 0; i < 16; ++i) top[i] = fmaxf(lo[i], hi[15 - i]);
    bitonic_merge16_desc(top);
#pragma unroll
    for (int off = 16; off <= 32; off <<= 1) {
        float o[16];
#pragma unroll
        for (int i = 0; i < 16; ++i) o[i] = __shfl_xor(top[15 - i], off);
#pragma unroll
        for (int i = 0; i < 16; ++i) top[i] = fmaxf(top[i], o[i]);
        bitonic_merge16_desc(top);
    }
}
__device__ __forceinline__ void ce_carry(float& va, int& xa, float& vb, int& xb, bool desc) {
    const bool sw = desc ? (vb > va) : (vb < va);
    const float tv = sw ? vb : va, uv = sw ? va : vb; const int tx = sw ? xb : xa, ux = sw ? xa : xb;
    va = tv; vb = uv; xa = tx; xb = ux;
}
__device__ __forceinline__ void bitonic_merge16_desc_carry(float (&v)[16], int (&x)[16]) {
#pragma unroll
    for (int j = 8; j > 0; j >>= 1)
#pragma unroll
        for (int i = 0; i < 16; ++i) { const int l = i ^ j; if (l > i) ce_carry(v[i], x[i], v[l], x[l], true); }
}
constexpr int CAND_I[52] = {0,0,0,0,0,0,0,0,0,0,0,0,0,0,0,0,1,1,1,1,1,1,1,1,2,2,2,2,2,3,3,3,3,4,4,4,5,5,6,6,7,7,8,9,10,11,12,13,14,15,-1,-1};
constexpr int CAND_J[52] = {0,1,2,3,4,5,6,7,8,9,10,11,12,13,14,15,0,1,2,3,4,5,6,7,0,1,2,3,4,0,1,2,3,0,1,2,0,1,0,1,0,1,0,0,0,0,0,0,0,0,-1,-1};

__device__ __forceinline__ int rl_i(int v, int l) { return __builtin_amdgcn_readlane(v, l); }
__device__ __forceinline__ float rl_f(float v, int l) { return __int_as_float(__builtin_amdgcn_readlane(__float_as_int(v), l)); }
#define LANE_OF(k) ((((k) >> 3) & 1) * 32 + (((k) >> 2) & 1) * 16 + (((k) >> 1) & 1) * 8 + ((k) & 1) * 4)
constexpr size_t B_KEYSB = 15 * MiB;
constexpr size_t B_QB = B_Y;

typedef float f32x2v __attribute__((ext_vector_type(2)));
#define PKFMA_LO(fv, xv, wsv) do { f32x2v _t; asm("v_cvt_pk_f32_fp8 %1, %2\n\tv_pk_fma_f32 %0, %3, %1, %0" : "+v"(fv), "=&v"(_t) : "v"(xv), "v"(wsv)); } while (0)
#define PKFMA_HI(fv, xv, wsv) do { f32x2v _t; asm("v_cvt_pk_f32_fp8_sdwa %1, %2 src0_sel:WORD_1\n\tv_pk_fma_f32 %0, %3, %1, %0" : "+v"(fv), "=&v"(_t) : "v"(xv), "v"(wsv)); } while (0)
#define PKFMA_F4(fv, xv, wsv, OPSEL) do { f32x2v _t; asm("v_cvt_scalef32_pk_f32_fp4 %1, %2, 1.0 " OPSEL "\n\tv_pk_fma_f32 %0, %3, %1, %0" : "+v"(fv), "=&v"(_t) : "v"(xv), "v"(wsv)); } while (0)
#define FACC(i) (f2[(i) >> 1][(i) & 1])
__device__ __forceinline__ void gather_token(const Params& p, int t, const int* sel_idx, const float* sel_g, int lane) {
    const bf16_t* x1 = (const bf16_t*)((const char*)p.ws + B_X1); const float* ada = p.ws + W_ADA;
    const char* uq = (const char*)p.ws + B_TQ; const char* vq = uq + (size_t)16384 * UROW; const char* u2q = (const char*)p.ws + B_U2Q;
    const __amdgpu_buffer_rsrc_t ursrc = __builtin_amdgcn_make_buffer_rsrc((void*)uq, 0, 16384 * UROW, 0x00020000);
    const __amdgpu_buffer_rsrc_t vrsrc = __builtin_amdgcn_make_buffer_rsrc((void*)vq, 0, 16384 * UROW, 0x00020000);
    const float* su2 = p.ws + W_SU2; const float* rsu = p.ws + W_SU; const float* rsv = p.ws + W_SV;
    const float* g2 = p.in[I_LN2G]; const float* b2 = p.in[I_LN2B];
    const int b = t / SL;
    unsigned uh[4], ul[4]; int us0;
    {
        const uint4 ua_ = nt_load4u(u2q + (size_t)t * D + lane * 32), ub_ = nt_load4u(u2q + (size_t)t * D + lane * 32 + 16);
        const unsigned xw[8] = {ua_.x, ua_.y, ua_.z, ua_.w, ub_.x, ub_.y, ub_.z, ub_.w};
        us0 = 0;
#pragma unroll
        for (int i = 0; i < 8; ++i) us0 = __builtin_amdgcn_sdot4((int)xw[i], 0x01010101, us0, false);
#pragma unroll
        for (int q = 0; q < 4; ++q) {
            const unsigned a = xw[2 * q] ^ 0x80808080u, bq = xw[2 * q + 1] ^ 0x80808080u;
            const unsigned la = a & 0x0F0F0F0Fu, lb = bq & 0x0F0F0F0Fu, ha = (a >> 4) & 0x0F0F0F0Fu, hb = (bq >> 4) & 0x0F0F0F0Fu;
            ul[q] = __builtin_amdgcn_perm(lb | (lb >> 4), la | (la >> 4), 0x06040200u);
            uh[q] = __builtin_amdgcn_perm(hb | (hb >> 4), ha | (ha >> 4), 0x06040200u);
        }
    }
    const float s2 = su2[t];
    const float uoff = 7.5f * wave_sum((float)us0);
    const float* scu = p.ws + W_SC;
    f32x2v f2[16];
#pragma unroll
    for (int i = 0; i < 16; ++i) f2[i] = (f32x2v){0.f, 0.f};
    const int kk8 = ((lane >> 5) & 1) * 4 + ((lane >> 4) & 1) * 2 + ((lane >> 3) & 1);
#define LANE_OF8(k) ((((k) >> 2) & 1) * 32 + (((k) >> 1) & 1) * 16 + ((k) & 1) * 8)
    int e_cur = sel_idx[kk8]; float g_cur = sel_g[kk8];
    uint4 un[8];
#pragma unroll
    for (int k = 0; k < 8; ++k) { const int ro = rl_i(e_cur, LANE_OF8(k)) * UROW; un[k] = __builtin_bit_cast(uint4, __builtin_amdgcn_raw_buffer_load_b128(ursrc, lane * 16, ro, 0)); }
#pragma unroll 1
    for (int bt = 0; bt < 16; ++bt) {
        uint4 vn[8];
#pragma unroll
        for (int k = 0; k < 8; ++k) { const int ro = rl_i(e_cur, LANE_OF8(k)) * UROW; vn[k] = __builtin_bit_cast(uint4, __builtin_amdgcn_raw_buffer_load_b128(vrsrc, lane * 16, ro, 0)); }
        __builtin_amdgcn_sched_barrier(0);
        float part[8];
#pragma unroll
        for (int k = 0; k < 8; ++k) {
            const uint4 nq = un[k];
            unsigned dh = __builtin_amdgcn_udot8(uh[0], nq.x, 0u, false), dl = __builtin_amdgcn_udot8(ul[0], nq.x, 0u, false);
            dh = __builtin_amdgcn_udot8(uh[1], nq.y, dh, false); dl = __builtin_amdgcn_udot8(ul[1], nq.y, dl, false);
            dh = __builtin_amdgcn_udot8(uh[2], nq.z, dh, false); dl = __builtin_amdgcn_udot8(ul[2], nq.z, dl, false);
            dh = __builtin_amdgcn_udot8(uh[3], nq.w, dh, false); dl = __builtin_amdgcn_udot8(ul[3], nq.w, dl, false);
            const unsigned d0 = dh * 16u + dl;
            part[k] = (float)d0;
            __builtin_amdgcn_sched_barrier(0);
        }
        const int bn = (bt + 1) & 15;
        const int e_nxt = sel_idx[bn * 8 + kk8]; const float g_nxt = sel_g[bn * 8 + kk8];
#pragma unroll
        for (int k = 0; k < 8; ++k) { const int ro = rl_i(e_nxt, LANE_OF8(k)) * UROW; un[k] = __builtin_bit_cast(uint4, __builtin_amdgcn_raw_buffer_load_b128(ursrc, lane * 16, ro, 0)); }
        __builtin_amdgcn_sched_barrier(0);
        { const bool up = (lane & 32) != 0;
#pragma unroll
          for (int i = 0; i < 4; ++i) { const float keep = up ? part[i + 4] : part[i], send = up ? part[i] : part[i + 4]; part[i] = keep + __shfl_xor(send, 32); } }
        { const bool up = (lane & 16) != 0;
#pragma unroll
          for (int i = 0; i < 2; ++i) { const float keep = up ? part[i + 2] : part[i], send = up ? part[i] : part[i + 2]; part[i] = keep + __shfl_xor(send, 16); } }
        { const bool up = (lane & 8) != 0;
          const float keep = up ? part[1] : part[0], send = up ? part[0] : part[1]; part[0] = keep + __shfl_xor(send, 8); }
        float tot = part[0]; tot += __shfl_xor(tot, 1); tot += __shfl_xor(tot, 2); tot += __shfl_xor(tot, 4);
        const float dt = (tot - 128.0f * scu[e_cur] - uoff) * s2 * rsu[e_cur];
        const float act = 0.5f * dt * (1.0f + erff(dt * 0.7071067811865476f));
        const float w_l = g_cur * act * rsv[e_cur];
#pragma unroll
        for (int k = 0; k < 8; ++k) {
            const float w = rl_f(w_l, LANE_OF8(k));
            const f32x2v wp0 = {w, w};
            const unsigned wd[4] = {vn[k].x, vn[k].y, vn[k].z, vn[k].w};
#pragma unroll
            for (int q = 0; q < 4; ++q) {
                PKFMA_F4(f2[q * 4 + 0], wd[q], wp0, ""); PKFMA_F4(f2[q * 4 + 1], wd[q], wp0, "op_sel:[1,0,0]"); PKFMA_F4(f2[q * 4 + 2], wd[q], wp0, "op_sel:[0,1,0]"); PKFMA_F4(f2[q * 4 + 3], wd[q], wp0, "op_sel:[1,1,0]");
            }
        }
        e_cur = e_nxt; g_cur = g_nxt;
    }
#undef LANE_OF8
    asm volatile("" ::: "memory");
    float v[32]; float s = 0.f;
#pragma unroll
    for (int q = 0; q < 8; ++q) {
        const int col = q * 256 + lane * 4, o = q * 4;
        const uint2 xb = nt_load2u(x1 + (size_t)t * D + col); const float4 gt = *(const float4*)(ada + b * 12288 + 5 * 2048 + col);
        const float4 xv = make_float4(__uint_as_float(xb.x << 16), __uint_as_float(xb.x & 0xffff0000u), __uint_as_float(xb.y << 16), __uint_as_float(xb.y & 0xffff0000u));
        v[o] = ALPHA * xv.x + gt.x * FACC(o); v[o + 1] = ALPHA * xv.y + gt.y * FACC(o + 1);
        v[o + 2] = ALPHA * xv.z + gt.z * FACC(o + 2); v[o + 3] = ALPHA * xv.w + gt.w * FACC(o + 3);
        s += (v[o] + v[o + 1]) + (v[o + 2] + v[o + 3]);
    }
    const float mean = wave_sum(s) * (1.0f / 2048.0f);
    float q2 = 0.f;
#pragma unroll
    for (int i = 0; i < 32; ++i) { v[i] -= mean; q2 += v[i] * v[i]; }
    const float rstd = rsqrtf(wave_sum(q2) * (1.0f / 2048.0f) + LN_EPS);
    asm volatile("" ::: "memory");
#pragma unroll
    for (int q = 0; q < 8; ++q) {
        const int col = q * 256 + lane * 4, o = q * 4;
        const float4 gv = *(const float4*)(g2 + col), bv = *(const float4*)(b2 + col);
        nt_store4(p.out + (size_t)t * D + col, v[o] * rstd * gv.x + bv.x, v[o + 1] * rstd * gv.y + bv.y, v[o + 2] * rstd * gv.z + bv.z, v[o + 3] * rstd * gv.w + bv.w);
    }
}

__device__ __forceinline__ void phase_jk(const Params& p, unsigned char* smem) {
    const int tid0 = opaque_tid();
    const bf16_t* qb = (const bf16_t*)((const char*)p.ws + B_QB); const bf16_t* keysb = (const bf16_t*)((const char*)p.ws + B_KEYSB);
    int* sel_idx = (int*)smem; float* sel_g = (float*)(smem + 8192);
#pragma unroll 1
    for (int iteml = blockIdx.x, itn = 0; iteml < NT / 16; iteml += gridDim.x, ++itn) {
        const int item = gridDim.x == 256 ? 64 * ((int)blockIdx.x & 7) + ((int)blockIdx.x >> 3) + 32 * itn : iteml;
        int tid = tid0; asm volatile("" : "+v"(tid));
        const int lane = tid & 63, wv = tid >> 6, ql = lane & 15, g = lane >> 4;
        const int t0 = item * 16, h = wv;
        __syncthreads();
        float ta[16], tb[16];
#pragma unroll
        for (int i = 0; i < 16; ++i) { ta[i] = 0.f; tb[i] = 0.f; }
#pragma unroll 1
        for (int pp = 0; pp < 2; ++pp) {
            const bf16_t* qrow = qb + ((size_t)((((t0 >> 4) * 8 + h) * 2 + pp) * 4) * 64 + lane) * 8;
            bf16x8v qf[4];
#pragma unroll
            for (int kc = 0; kc < 4; ++kc) qf[kc] = __builtin_nontemporal_load((const bf16x8v*)(qrow + kc * 512));
            const bf16_t* kbase = keysb + (size_t)((h * 2 + pp) * 8) * 2048 + lane * 8;
            float sc[32];
#pragma unroll
            for (int nb = 0; nb < 8; ++nb) {
                f32x4v acc = {0.f, 0.f, 0.f, 0.f};
#pragma unroll
                for (int kc = 0; kc < 4; ++kc) acc = __builtin_amdgcn_mfma_f32_16x16x32_bf16(*(const bf16x8v*)(kbase + (nb * 4 + kc) * 512), qf[kc], acc, 0, 0, 0);
#pragma unroll
                for (int rr = 0; rr < 4; ++rr) sc[nb * 4 + rr] = __int_as_float((__float_as_int(acc[rr]) & ~127) | (16 * nb + 4 * g + rr));
                if (nb == 3) asm volatile("" ::: "memory");
            }
            float top[16];
            top16_of_128(sc, top);
#pragma unroll
            for (int i = 0; i < 16; ++i) { if (pp == 0) ta[i] = top[i]; else tb[i] = top[i]; }
        }
        float cv[16]; int cx[16];
#pragma unroll
        for (int sidx = 0; sidx < 13; ++sidx) {
            float vv[4]; int xx[4];
#pragma unroll
            for (int q = 0; q < 4; ++q) {
                const int ci = CAND_I[4 * sidx + q], cj = CAND_J[4 * sidx + q];
                if (ci >= 0) { vv[q] = ta[ci] + tb[cj]; xx[q] = ((__float_as_int(ta[ci]) & 127) << 7) | (__float_as_int(tb[cj]) & 127); } else { vv[q] = -3.0e38f; xx[q] = 0; }
            }
            cv[sidx] = g == 0 ? vv[0] : (g == 1 ? vv[1] : (g == 2 ? vv[2] : vv[3]));
            cx[sidx] = g == 0 ? xx[0] : (g == 1 ? xx[1] : (g == 2 ? xx[2] : xx[3]));
        }
#pragma unroll
        for (int sidx = 13; sidx < 16; ++sidx) { cv[sidx] = -3.0e38f; cx[sidx] = 0; }
#pragma unroll
        for (int k = 2; k <= 16; k <<= 1)
#pragma unroll
            for (int j = k >> 1; j > 0; j >>= 1)
#pragma unroll
                for (int i = 0; i < 16; ++i) { const int l = i ^ j; if (l > i) ce_carry(cv[i], cx[i], cv[l], cx[l], (i & k) == 0); }
#pragma unroll
        for (int off = 16; off <= 32; off <<= 1) {
            float ov[16]; int ox[16];
#pragma unroll
            for (int i = 0; i < 16; ++i) { ov[i] = __shfl_xor(cv[15 - i], off); ox[i] = __shfl_xor(cx[15 - i], off); }
#pragma unroll
            for (int i = 0; i < 16; ++i) { const bool tk = ov[i] > cv[i]; cv[i] = tk ? ov[i] : cv[i]; cx[i] = tk ? ox[i] : cx[i]; }
            bitonic_merge16_desc_carry(cv, cx);
        }
        {
            float ex[16]; float sum = 0.f;
#pragma unroll
            for (int i = 0; i < 16; ++i) { ex[i] = __expf(cv[i] - cv[0]); sum += ex[i]; }
            const float inv = 1.0f / sum;
            if (g == 0) {
#pragma unroll
                for (int q = 0; q < 4; ++q) {
                    *(int4*)(sel_idx + ql * 128 + h * 16 + q * 4) = make_int4(cx[q * 4], cx[q * 4 + 1], cx[q * 4 + 2], cx[q * 4 + 3]);
                    *(float4*)(sel_g + ql * 128 + h * 16 + q * 4) = make_float4(ex[q * 4] * inv, ex[q * 4 + 1] * inv, ex[q * 4 + 2] * inv, ex[q * 4 + 3] * inv);
                }
            }
        }
        __syncthreads();
#pragma unroll 1
        for (int k = 0; k < 2; ++k) { int lane2 = lane; asm volatile("" : "+v"(lane2)); gather_token(p, t0 + 2 * wv + k, sel_idx + (2 * wv + k) * 128, sel_g + (2 * wv + k) * 128, lane2); }
    }
}

__device__ __forceinline__ void map_tile(int L, int nM, int nN, int& pm, int& pn) {
    const int nwg = nM * nN; int wgid = L;
    { const int q = nwg / 8, r = nwg % 8, xcd = wgid % 8, off = wgid / 8; wgid = (xcd < r ? xcd * (q + 1) : r * (q + 1) + (xcd - r) * q) + off; }
    const int nig = 8 * nN, gid = wgid / nig, fm = gid * 8, gsz = (nM - fm) < 8 ? (nM - fm) : 8;
    pm = fm + ((wgid % nig) % gsz); pn = (wgid % nig) / gsz;
}
struct ProjOrder {
    int G, c; const bf16_t* ub; const bf16_t* wint;
    __device__ bool next(int i, pg8::Unit& u) const {
        const int L = i * G + c; if (L >= 800) return false;
        if (L < 384) { u.kind = 0; map_tile(L, 12, 32, u.pm, u.pn); }
        else if (L < 512) { u.kind = 1; map_tile(L - 384, 4, 32, u.pm, u.pn); }
        else if (L < 768) { u.kind = 2; map_tile(L - 512, 32, 8, u.pm, u.pn); }
        else if (L < 784) { u.kind = 3; u.pm = (L - 768) >> 2; u.pn = (L - 768) & 3; }
        else { u.kind = 4; u.pm = (L - 784) >> 2; u.pn = (L - 784) & 3; }
        return true;
    }
    __device__ __forceinline__ void a_ready(const pg8::Unit&) const {}
    __device__ __forceinline__ void done(const pg8::Unit&) const {}
    template <class G_> __device__ __forceinline__ const char* pa(const G_&, const pg8::Unit& u) const {
        const size_t ts = (size_t)256 * D * 2;
        switch (u.kind) { case 0: return (const char*)wint + (size_t)u.pm * ts; case 1: return (const char*)wint + (size_t)(20 + u.pm) * ts; case 2: return (const char*)ub + (size_t)u.pm * ts;
                          case 3: return (const char*)ub + (size_t)(32 + u.pm) * ts; default: return (const char*)wint + (size_t)(20 + u.pm) * ts; }
    }
    template <class G_> __device__ __forceinline__ const char* pb(const G_&, const pg8::Unit& u) const {
        const size_t ts = (size_t)256 * D * 2;
        switch (u.kind) { case 0: case 1: return (const char*)ub + (size_t)u.pn * ts; case 2: return (const char*)wint + (size_t)(12 + u.pn) * ts;
                          case 3: return (const char*)wint + (size_t)(16 + u.pn) * ts; default: return (const char*)ub + (size_t)(32 + u.pn) * ts; }
    }
};
struct EpiProj {
    static constexpr bool PERM = true, AFTER_DRAIN = false;
    unsigned char* ws;
    __device__ __forceinline__ void operator()(const pg8::f32x4 (&acc)[2][2][4][2], const pg8::Unit& u, int wr, int wc, int fr, int fq) const {
        bf16_t* const zT = (bf16_t*)(ws + B_ZT); bf16_t* const vT = (bf16_t*)(ws + B_VT); bf16_t* const qh = (bf16_t*)(ws + B_QH); bf16_t* const kh = (bf16_t*)(ws + B_KH);
        bf16_t* const kch = (bf16_t*)(ws + B_KCH); bf16_t* const vcT = (bf16_t*)(ws + B_VCT);
#pragma unroll
        for (int ai = 0; ai < 2; ++ai)
#pragma unroll
            for (int m = 0; m < 4; ++m) {
                const int r = u.pm * 256 + ai * 128 + wr * 64 + m * 16 + fr;
#pragma unroll
                for (int bj = 0; bj < 2; ++bj) {
                    const int cc = u.pn * 256 + bj * 128 + wc * 32 + 8 * fq;
                    bf16_t* dst;
                    if (u.kind == 0) dst = zT + (size_t)r * NT + cc;
                    else if (u.kind == 1) {
                        const int bb = cc >> 11, t = cc & 2047, hh = r >> 6, dd = r & 63;
                        dst = vT + (size_t)((bb * 16 + hh) * 256 + (t >> 3)) * 512 + (dd >> 4) * 128 + (dd & 15) * 8;
                    } else if (u.kind == 2) {
                        const int bb = r >> 11, t = r & 2047, hc = cc & 1023, hh = hc >> 6, dd = hc & 63;
                        if (cc < 1024) dst = qh + ((size_t)((bb * 16 + hh) * SL + t)) * 64 + dd;
                        else dst = kh + (size_t)((bb * 16 + hh) * 256 + (t >> 3)) * 512 + (dd >> 5) * 256 + ((t & 7) >> 2) * 128 + ((dd & 31) >> 3) * 32 + (t & 3) * 8;
                    } else if (u.kind == 3) {
                        const int bb = r >> 8, jj = r & 255, hh = cc >> 6, dd = cc & 63;
                        dst = kch + (size_t)((bb * 16 + hh) * 32 + (jj >> 3)) * 512 + (dd >> 5) * 256 + ((jj & 7) >> 2) * 128 + ((dd & 31) >> 3) * 32 + (jj & 3) * 8;
                    } else {
                        const int bb = cc >> 8, jj = cc & 255, hh = r >> 6, dd = r & 63;
                        dst = vcT + (size_t)((bb * 16 + hh) * 32 + (jj >> 3)) * 512 + (dd >> 4) * 128 + (dd & 15) * 8;
                    }
                    const pg8::f32x4 v0 = acc[ai][bj][m][0], v1 = acc[ai][bj][m][1];
                    pg8::u32x4 w; w.x = pg8::cvt_pk_bf16(v0[0], v0[1]); w.y = pg8::cvt_pk_bf16(v0[2], v0[3]); w.z = pg8::cvt_pk_bf16(v1[0], v1[1]); w.w = pg8::cvt_pk_bf16(v1[2], v1[3]);
                    *(pg8::u32x4*)dst = w;
                }
            }
    }
};

struct EpiQFrag {
    static constexpr bool PERM = true, AFTER_DRAIN = false;
    bf16_t* O;
    __device__ __forceinline__ void operator()(const pg8::f32x4 (&acc)[2][2][4][2], const pg8::Unit& u, int wr, int wc, int fr, int fq) const {
#pragma unroll
        for (int ai = 0; ai < 2; ++ai)
#pragma unroll
            for (int m = 0; m < 4; ++m) {
                const int t = u.pm * 256 + ai * 128 + wr * 64 + m * 16 + fr;
#pragma unroll
                for (int bj = 0; bj < 2; ++bj) {
                    const int c = u.pn * 256 + bj * 128 + wc * 32 + 8 * fq;
                    const int hh = c >> 8, pp = (c >> 7) & 1, d = c & 127;
                    bf16_t* dst = O + ((size_t)(((((t >> 4) * 8 + hh) * 2 + pp) * 4 + (d >> 5)) * 64 + ((d & 31) >> 3) * 16 + (t & 15))) * 8;
                    const pg8::f32x4 v0 = acc[ai][bj][m][0], v1 = acc[ai][bj][m][1];
                    pg8::u32x4 w; w.x = pg8::cvt_pk_bf16(v0[0], v0[1]); w.y = pg8::cvt_pk_bf16(v0[2], v0[3]); w.z = pg8::cvt_pk_bf16(v1[0], v1[1]); w.w = pg8::cvt_pk_bf16(v1[2], v1[3]);
                    __builtin_nontemporal_store(w, (pg8::u32x4*)dst);
                }
            }
    }
};

#define XB_TMO      128
#define XB_XCNT(j)  (256  + 64 * (j))
#define XB_XSUB(j)  (1280 + 64 * (j))
#define XB_XGEN(j)  (2304 + 64 * (j))
#define XB_TOP      3328
#define XB_TOPGEN   3392
#define XCD_BAR_WORDS 3456
#define XB_SPIN_CAP (1u << 18)
#define LAS __attribute__((address_space(3)))

__device__ __forceinline__ unsigned xb_ld(unsigned* p)              { return __hip_atomic_load(p, __ATOMIC_RELAXED, __HIP_MEMORY_SCOPE_AGENT); }
__device__ __forceinline__ unsigned xb_add(unsigned* p, unsigned v) { return __hip_atomic_fetch_add(p, v, __ATOMIC_RELAXED, __HIP_MEMORY_SCOPE_AGENT); }
__device__ __forceinline__ unsigned xb_xcc_id() { return (unsigned)__builtin_amdgcn_s_getreg((3 << 11) | 20) & 0xFu; }
#define XB_SPIN(cond, bar) do { unsigned _sp = 0; while (cond) { __builtin_amdgcn_s_sleep(1); \
    if ((++_sp & 255u) == 0u) { if (xb_ld(&(bar)[XB_TMO])) break; if (_sp > XB_SPIN_CAP) { atomicAdd(&(bar)[XB_TMO], 1u); break; } } } } while (0)

struct XcdBarrier {
    unsigned* bar; unsigned x;
    volatile LAS unsigned* st;
};

__device__ __forceinline__ XcdBarrier xcd_barrier_post(unsigned* bar, volatile LAS unsigned* st) {
    XcdBarrier b; b.bar = bar; b.x = xb_xcc_id(); b.st = st;
    if (threadIdx.x == 0) (void)xb_add(&bar[XB_XCNT(b.x)], 1u);
    return b;
}
__device__ __forceinline__ void xcd_barrier_complete(unsigned* bar, unsigned x, unsigned& nloc, unsigned& nx) {
    const unsigned G = gridDim.x * gridDim.y * gridDim.z;
    unsigned sum, cnt, mine, sp = 0u;
    for (;;) {
        sum = 0u; cnt = 0u; mine = 0u;
#pragma unroll
        for (unsigned j = 0; j < 16; ++j) { const unsigned c = xb_ld(&bar[XB_XCNT(j)]); sum += c; cnt += (c > 0u) ? 1u : 0u; mine = (j == x) ? c : mine; }
        if (sum == G) break;
        __builtin_amdgcn_s_sleep(1);
        if ((++sp & 255u) == 0u) { if (xb_ld(&bar[XB_TMO])) break; if (sp > XB_SPIN_CAP) { atomicAdd(&bar[XB_TMO], 1u); break; } }
    }
    nloc = mine > 0u ? mine : 1u; nx = cnt > 0u ? cnt : 1u;
}

__device__ __forceinline__ void xcd_barrier(const XcdBarrier& b) {
    asm volatile("s_waitcnt vmcnt(0)" ::: "memory");
    __syncthreads();
    if (threadIdx.x == 0) {
        unsigned* bar = b.bar;
        __builtin_amdgcn_s_waitcnt(0);
        unsigned nloc = b.st[0], nx = b.st[1]; const unsigned k = b.st[2];
        if (nloc == 0u) { xcd_barrier_complete(bar, b.x, nloc, nx); b.st[0] = nloc; b.st[1] = nx; }
        b.st[2] = k + 1u;
        const unsigned old = xb_add(&bar[XB_XSUB(b.x)], 1u);
        if (old + 1u == (k + 1u) * nloc) {
            __builtin_amdgcn_fence(__ATOMIC_RELEASE, "agent");
            asm volatile("s_waitcnt vmcnt(0)" ::: "memory");
            (void)xb_add(&bar[XB_TOP], 1u);
        }
        asm volatile("buffer_inv sc1" ::: "memory");
        XB_SPIN(xb_ld(&bar[XB_TOP]) < (k + 1u) * nx, bar);
        asm volatile("s_waitcnt vmcnt(0)" ::: "memory");
    }
    __syncthreads();
}
constexpr size_t B_BAR = 14 * MiB;

__global__ void __launch_bounds__(NTHREADS) fwd_megakernel(Params p) {
    extern __shared__ __attribute__((aligned(16))) unsigned char smem[];
    float* lds = (float*)smem; float* red = (float*)(smem + RED_OFF);
    PG8_LAS unsigned char* glds = (PG8_LAS unsigned char*)smem;
    volatile LAS unsigned* xst = (volatile LAS unsigned*)(smem + LDS_BYTES - 16);
    if (threadIdx.x < 4) xst[threadIdx.x] = 0u;
    __syncthreads();
    XcdBarrier xb = xcd_barrier_post((unsigned*)((char*)p.ws + B_BAR), xst);
    bf16_t* wint = (bf16_t*)((char*)p.ws + B_WINT); bf16_t* woutt = (bf16_t*)((char*)p.ws + B_WOUTT); bf16_t* wqt = (bf16_t*)((char*)p.ws + B_WQT);
    bf16_t* ub = (bf16_t*)((char*)p.ws + B_UB);
    phase_a(p, lds);
    transpose_convert(p.in[I_WIN], wint, D, DPROJ, lds, 0, (int)gridDim.x);
    phase_filters(p, lds);
    {
        const float* ks = p.in[I_KEYS]; bf16_t* kd = (bf16_t*)((char*)p.ws + B_KEYSB);
        for (int e = blockIdx.x * NTHREADS + threadIdx.x; e < 16 * 128 * 128 / 4; e += gridDim.x * NTHREADS) {
            const float4 v = *(const float4*)(ks + e * 4); uint2 o; o.x = pk_bf16(v.x, v.y); o.y = pk_bf16(v.z, v.w);
            const int d = (e * 4) & 127, n = ((e * 4) >> 7) & 127, hp = (e * 4) >> 14;
            *(uint2*)(kd + ((size_t)(((hp * 8 + (n >> 4)) * 4 + (d >> 5)) * 64 + ((d & 31) >> 3) * 16 + (n & 15))) * 8 + (d & 7)) = o;
        }
    }
    xcd_barrier(xb);
    phase_b(p);
    xcd_barrier(xb);
    phase_c(p);
    xcd_barrier(xb);
    {
        pg8::Gemm g{ub, wint, NT + NTC, DPROJ, D}; ProjOrder S{(int)gridDim.x, (int)blockIdx.x, ub, wint};
        EpiProj E{(unsigned char*)p.ws};
        pg8::gemm_phase<EpiProj, ProjOrder>(glds, g, S, E, nullptr);
    }
    if (gridDim.x == 256 && blockIdx.x >= 32) {
        quant_tables(p, 32, 224);
        transpose_convert(p.in[I_WOUT], woutt, D, D, lds, 32, 224);
        transpose_convert(p.in[I_WQ], wqt, D, D, lds, 32, 224);
    } else if (gridDim.x != 256) {
        quant_tables(p, 0, (int)gridDim.x);
        transpose_convert(p.in[I_WOUT], woutt, D, D, lds, 0, (int)gridDim.x);
        transpose_convert(p.in[I_WQ], wqt, D, D, lds, 0, (int)gridDim.x);
    }
    xcd_barrier(xb);
    phase_hyena(p, smem);
    phase_na(p, smem);
    xcd_barrier(xb);
    phase_f(p, lds);
    xcd_barrier(xb);
    {
        pg8::Gemm g{ub, woutt, NT, D, D}; pg8::XcdRowOrder S; S.init(NT, D, (int)gridDim.x, (int)blockIdx.x);
        pg8::EpiBf16<0> E{(bf16_t*)((char*)p.ws + B_Y), D, nullptr, 0, 0};
        pg8::gemm_phase<pg8::EpiBf16<0>, pg8::XcdRowOrder>(glds, g, S, E, nullptr);
    }
    xcd_barrier(xb);
    phase_h(p);
    xcd_barrier(xb);
    {
        pg8::Gemm g{ub, wqt, NT, D, D}; pg8::XcdRowOrder S; S.init(NT, D, (int)gridDim.x, (int)blockIdx.x);
        EpiQFrag E{(bf16_t*)((char*)p.ws + B_QB)};
        pg8::gemm_phase<EpiQFrag, pg8::XcdRowOrder>(glds, g, S, E, nullptr);
    }
    xcd_barrier(xb);
    phase_jk(p, smem);
}

extern "C" void kernel_launch(void* const* d_in, const int* in_sizes, int n_in, void* d_out, int out_size, void* d_ws, size_t ws_size, hipStream_t stream) {
    static int grid_blocks = 0;
    if (grid_blocks == 0) {
        if (n_in != N_IN || out_size != NT * D || ws_size < W_END * sizeof(float)) {
            fprintf(stderr, "kernel_launch: unexpected shapes: n_in %d out %d ws %zu (need %zu)\n", n_in, out_size, ws_size, (size_t)W_END * 4); grid_blocks = -1; return; }
        int dev = 0, cus = 0, per_cu = 0;
        hipGetDevice(&dev);
        hipDeviceGetAttribute(&cus, hipDeviceAttributeMultiprocessorCount, dev);
        if (hipFuncSetAttribute((const void*)fwd_megakernel, hipFuncAttributeMaxDynamicSharedMemorySize, LDS_BYTES) != hipSuccess) { fprintf(stderr, "kernel_launch: hipFuncSetAttribute failed\n"); grid_blocks = -1; return; }
        if (hipOccupancyMaxActiveBlocksPerMultiprocessor(&per_cu, (const void*)fwd_megakernel, NTHREADS, LDS_BYTES) != hipSuccess || per_cu < 1) { fprintf(stderr, "kernel_launch: occupancy query failed (%d)\n", per_cu); (void)hipGetLastError(); grid_blocks = -1; return; }
        grid_blocks = cus * (per_cu > 1 ? 1 : per_cu);
        fprintf(stderr, "kernel_launch: cus %d per_cu %d grid %d\n", cus, per_cu, grid_blocks);
    }
    if (grid_blocks < 0) return;
    Params p{};
    for (int i = 0; i < N_IN; ++i) p.in[i] = (const float*)d_in[i];
    p.out = (float*)d_out; p.ws = (float*)d_ws;
    if (hipMemsetAsync((char*)d_ws + B_BAR, 0, XCD_BAR_WORDS * sizeof(unsigned), stream) != hipSuccess) { fprintf(stderr, "kernel_launch: memset failed\n"); return; }
    void* args[] = {&p};
    hipLaunchKernelGGL(fwd_megakernel, dim3(grid_blocks), dim3(NTHREADS), LDS_BYTES, stream, p);
    const hipError_t e = hipPeekAtLastError();
    if (e != hipSuccess) fprintf(stderr, "launch failed: %s (grid %d)\n", hipGetErrorString(e), grid_blocks);
}
```

```cpp
#include <hip/hip_runtime.h>
#include <hip/hip_cooperative_groups.h>
#include <cstdio>
namespace cg = cooperative_groups;

constexpr int D = 2048, NB = 4, SL = 2048, NT = NB * SL, CL = 256, NTC = NB * CL;
constexpr int DHY = 1024, DNA = 1024, DPROJ = 6144, OFFQ = 3072, OFFK = 4096, OFFV = 5120;
constexpr int NTHREADS = 512, NWAVES = 8;
constexpr float LN_EPS = 1e-5f;
constexpr float ALPHA = 1.189207115002721f;

enum { I_X = 0, I_C, I_CTX, I_CCTX, I_WADA, I_BADA, I_WIN, I_CONVW, I_CONVB, I_FW1, I_FB1, I_FW2, I_FB2, I_FW3, I_FB3, I_FW4,
       I_FREQ, I_SKIP, I_RPB, I_GHY, I_GNA, I_WOUT, I_LN1G, I_LN1B, I_WQ, I_KEYS, I_PU, I_PV, I_LN2G, I_LN2B, N_IN };

constexpr size_t W_ADAP = 0;
constexpr size_t W_ADA  = W_ADAP + 32 * 5 * 12288;
constexpr size_t W_FS   = W_ADA + 5 * 12288;
constexpr size_t W_SP   = W_FS + 4096;
constexpr size_t W_SU   = W_SP + 32 * 4096;
constexpr size_t W_SV   = W_SU + 16384;
constexpr size_t W_SU2  = W_SV + 16384;
constexpr size_t W_SC   = W_SU2 + 8192;
static_assert((W_SC + 16384) * 4 <= 14 * 1048576, "small region overflow");
constexpr size_t MiB = 1048576;
constexpr size_t B_WINT  = 16 * MiB;
constexpr size_t B_WOUTT = B_WINT + 24 * MiB;
constexpr size_t B_WQT   = B_WOUTT + 8 * MiB;
constexpr size_t B_UB    = B_WQT + 8 * MiB;
constexpr size_t B_ZT    = B_UB + 36 * MiB;
constexpr size_t B_VT    = B_ZT + 48 * MiB;
constexpr size_t B_QH    = B_VT + 16 * MiB;
constexpr size_t B_KH    = B_QH + 16 * MiB;
constexpr size_t B_KCH   = B_KH + 16 * MiB;
constexpr size_t B_VCT   = B_KCH + 2 * MiB;
constexpr size_t B_KF    = B_VCT + 2 * MiB;
constexpr size_t B_HRAW  = B_KF + 32 * MiB;
constexpr size_t B_HYT   = B_HRAW;
constexpr size_t B_NA    = B_HRAW + 16 * MiB;
constexpr size_t B_Y     = B_HRAW + 32 * MiB;
constexpr size_t B_X1    = B_Y + 64 * MiB;
constexpr size_t B_U2Q   = B_X1 + 64 * MiB;
constexpr size_t B_TQ    = B_U2Q + 16 * MiB;
constexpr size_t B_END   = B_TQ + 64 * MiB;
constexpr size_t W_KF = B_KF / 4, W_X1 = B_X1 / 4, W_HRAW = B_HRAW / 4, W_Y = B_Y / 4, W_END = B_END / 4;
static_assert(B_END <= 512 * MiB, "workspace");

constexpr int LDS_BYTES = 156 * 1024;
constexpr int RED_OFF = 155 * 1024;

struct Params { const float* in[N_IN]; float* out; float* ws; };

namespace pg8 {
#define PG8_LAS __attribute__((address_space(3)))
typedef unsigned short bf16_t;
typedef short bf16x8 __attribute__((ext_vector_type(8)));
typedef float f32x4 __attribute__((ext_vector_type(4)));
typedef unsigned u32x4 __attribute__((ext_vector_type(4)));
constexpr int BM = 256, BK = 64, HALF = 128, HTB = HALF * BK * 2  , STAGE_BYTES = 8 * HTB, NXCD = 8, WGM = 8;

__host__ __device__ __forceinline__ int lds_byte(int r, int c) { const int st = (r >> 4) * 2 + (c >> 5), rr = r & 15, cc = c & 31, ob = rr * 64 + cc * 2; return st * 1024 + (ob ^ (((ob >> 9) & 1) << 5)); }
__host__ __device__ __forceinline__ void stage_rc(int b, int& R, int& C) { const int st = b / 1024, sb = b % 1024, swz = sb ^ (((sb >> 9) & 1) << 5); R = (st >> 1) * 16 + swz / 64; C = (st & 1) * 32 + (swz % 64) / 2; }
__host__ __device__ __forceinline__ int perm32(int rho) { const int n = rho >> 4, i = rho & 15; return 8 * (i >> 2) + 4 * n + (i & 3); }

struct Unit { int pm, pn, kind; };
struct Gemm { const bf16_t* A; const bf16_t* Bt; int M, N, K; };

struct StaticOrder {
    int nM, nN, nwg, G, c;
    __host__ __device__ void init(int M, int N, int G_, int c_) { nM = M / BM; nN = N / BM; nwg = nM * nN; G = G_; c = c_; }
    __host__ __device__ bool next(int i, Unit& u) const {
        const long L = (long)i * G + c; if (L >= nwg) return false;
        int wgid = (int)L; { const int q = nwg / NXCD, r = nwg % NXCD, xcd = wgid % NXCD, off = wgid / NXCD; wgid = (xcd < r ? xcd * (q + 1) : r * (q + 1) + (xcd - r) * q) + off; }
        const int nig = WGM * nN, gid = wgid / nig, fm = gid * WGM, gsz = (nM - fm) < WGM ? (nM - fm) : WGM;
        u.pm = fm + ((wgid % nig) % gsz); u.pn = (wgid % nig) / gsz; return true;
    }
    __device__ __forceinline__ void a_ready(const Unit&) const {}
    __device__ __forceinline__ void done(const Unit&) const {}
    template <class G_> __device__ __forceinline__ const char* pa(const G_& g, const Unit& u) const { return (const char*)g.A + (size_t)u.pm * (size_t)(BM * 2) * g.K; }
    template <class G_> __device__ __forceinline__ const char* pb(const G_& g, const Unit& u) const { return (const char*)g.Bt + (size_t)u.pn * (size_t)(BM * 2) * g.K; }
};
struct XcdRowOrder : StaticOrder {
    __host__ __device__ bool next(int i, Unit& u) const {
        if (G != 256 || nM != 32 || nN != 8) return StaticOrder::next(i, u);
        if (i != 0) return false;
        u.pm = 4 * (c & 7) + ((c >> 3) & 3); u.pn = c >> 5; return true;
    }
};
__device__ __forceinline__ unsigned cvt_pk_bf16(float lo, float hi) { unsigned r; asm volatile("v_cvt_pk_bf16_f32 %0, %1, %2" : "=v"(r) : "v"(lo), "v"(hi)); return r; }
typedef float f32x2 __attribute__((ext_vector_type(2)));
__device__ __forceinline__ f32x2 gelu_pk(f32x2 v) {
    const f32x2 av = __builtin_elementwise_abs(v), d = av * 0.2316418882f + 1.0f;
    f32x2 t; t.x = __builtin_amdgcn_rcpf(d.x); t.y = __builtin_amdgcn_rcpf(d.y);
    f32x2 q = t * 0.5307027145f + (-0.7265760135f); q = q * t + 0.7107068705f; q = q * t + (-0.142248368f); q = q * t + 0.127414796f; q = q * t;
    const f32x2 s = (v * v) * (-0.72134752044f);
    f32x2 e; e.x = __builtin_amdgcn_exp2f(s.x); e.y = __builtin_amdgcn_exp2f(s.y);
    const f32x2 m = v * (q * e), r = v - m;
    f32x2 o; o.x = v.x < 0.f ? m.x : r.x; o.y = v.y < 0.f ? m.y : r.y; return o;
}

struct EpiF32 {
    static constexpr bool PERM = false, AFTER_DRAIN = false;
    float* C; int ldc; const float* bias;
    __device__ __forceinline__ void operator()(const f32x4 (&acc)[2][2][4][2], const Unit& u, int wr, int wc, int fr, int fq) const {
        const int row0 = u.pm * BM + wr * 64 + fr, col0 = u.pn * BM + wc * 32 + 4 * fq;
        f32x4 bv[2][2];
#pragma unroll
        for (int bj = 0; bj < 2; ++bj)
#pragma unroll
            for (int n = 0; n < 2; ++n) bv[bj][n] = bias ? *(const f32x4*)(bias + col0 + bj * HALF + n * 16) : (f32x4){0.f, 0.f, 0.f, 0.f};
#pragma unroll
        for (int ai = 0; ai < 2; ++ai)
#pragma unroll
            for (int m = 0; m < 4; ++m) { float* rowp = C + (size_t)(row0 + ai * HALF + m * 16) * ldc + col0;
#pragma unroll
                for (int bj = 0; bj < 2; ++bj)
#pragma unroll
                    for (int n = 0; n < 2; ++n) *(f32x4*)(rowp + bj * HALF + n * 16) = acc[ai][bj][m][n] + bv[bj][n]; }
    }
};
template <int ACT  > struct EpiBf16 {
    static constexpr bool PERM = true, AFTER_DRAIN = false;
    bf16_t* O; int ldc; const float* bias; int split_cols; size_t split_stride;
    __device__ __forceinline__ void operator()(const f32x4 (&acc)[2][2][4][2], const Unit& u, int wr, int wc, int fr, int fq) const {
        const int row0 = u.pm * BM + wr * 64 + fr; int colt = u.pn * BM; bf16_t* base = O;
        if (split_cols) { const int t = colt / split_cols; base += (size_t)t * split_stride; colt -= t * split_cols; }
        const int col0 = colt + wc * 32 + 8 * fq, bcol0 = u.pn * BM + wc * 32 + 8 * fq;
        f32x4 bv[2][2];
#pragma unroll
        for (int bj = 0; bj < 2; ++bj)
#pragma unroll
            for (int n = 0; n < 2; ++n) bv[bj][n] = bias ? *(const f32x4*)(bias + bcol0 + bj * HALF + 4 * n) : (f32x4){0.f, 0.f, 0.f, 0.f};
#pragma unroll
        for (int ai = 0; ai < 2; ++ai)
#pragma unroll
            for (int m = 0; m < 4; ++m) { bf16_t* rowp = base + (size_t)(row0 + ai * HALF + m * 16) * ldc + col0;
#pragma unroll
                for (int bj = 0; bj < 2; ++bj) { f32x4 v0 = acc[ai][bj][m][0] + bv[bj][0], v1 = acc[ai][bj][m][1] + bv[bj][1];
                    if (ACT == 1) { f32x2 a = gelu_pk((f32x2){v0[0], v0[1]}), b = gelu_pk((f32x2){v0[2], v0[3]}), c = gelu_pk((f32x2){v1[0], v1[1]}), d = gelu_pk((f32x2){v1[2], v1[3]});
                        v0 = (f32x4){a.x, a.y, b.x, b.y}; v1 = (f32x4){c.x, c.y, d.x, d.y}; }
                    if (ACT == 2) {
#pragma unroll
                        for (int j = 0; j < 4; ++j) { v0[j] = 0.5f * v0[j] * (1.0f + erff(v0[j] * 0.70710678f)); v1[j] = 0.5f * v1[j] * (1.0f + erff(v1[j] * 0.70710678f)); } }
                    u32x4 w; w.x = cvt_pk_bf16(v0[0], v0[1]); w.y = cvt_pk_bf16(v0[2], v0[3]); w.z = cvt_pk_bf16(v1[0], v1[1]); w.w = cvt_pk_bf16(v1[2], v1[3]);
                    *(u32x4*)(rowp + bj * HALF) = w; } }
    }
};
template <class Epi, class Sched, bool STAMP = false>
__device__ __forceinline__ void gemm_phase(PG8_LAS unsigned char* lds, const Gemm g, const Sched& S, const Epi& E, unsigned long long* stamps) {
    const int tid = threadIdx.x, wid = __builtin_amdgcn_readfirstlane(tid >> 6), lane = tid & 63, wr = wid >> 2, wc = wid & 3, fr = lane & 15, fq = lane >> 4;
    const int K = g.K, nt = K / BK;
    int ts_lo = 0, ts_hi = 0, nts = 0; const unsigned long long rt_entry = STAMP ? (unsigned long long)wall_clock64() : 0ull;
#define PG8_STAMP() do { if (STAMP && wid == 0 && nts < 64) { const unsigned long long _c = (unsigned long long)clock64(); \
        ts_lo = (lane == nts) ? (int)(unsigned)_c : ts_lo; ts_hi = (lane == nts) ? (int)(unsigned)(_c >> 32) : ts_hi; ++nts; } } while (0)
    PG8_STAMP();
    unsigned voffA[2], voffB[2];
#pragma unroll
    for (int i = 0; i < 2; ++i) { int R, C; stage_rc(tid * 16 + i * 8192, R, C); const int Rb = Epi::PERM ? ((R & ~31) + perm32(R & 31)) : R;
        voffA[i] = (unsigned)(R * K + C) * 2u; voffB[i] = (unsigned)(Rb * K + C) * 2u; }
    const size_t kstep = (size_t)(BK * 2);
    const size_t hstep = (size_t)HALF * K * 2;
    const size_t tstep = 2 * hstep;
    const unsigned ldsw = (unsigned)wid * 1024u;
    const int aoff = lds_byte(wr * 64 + fr, fq * 8), boff = lds_byte(wc * 32 + fr, fq * 8);
#define PG8_SA(b, h) (((b) * 2 + (h)) * HTB)
#define PG8_SB(b, h) ((4 + (b) * 2 + (h)) * HTB)
#define PG8_STAGE(bufoff, gbase, voff) do { _Pragma("unroll") for (int _i = 0; _i < 2; ++_i) \
        __builtin_amdgcn_global_load_lds((const unsigned*)((const char*)(gbase) + (voff)[_i]), (PG8_LAS unsigned*)(lds + (bufoff) + ldsw + _i * 8192), 16, 0, 0); } while (0)
#define PG8_LDA(dst, b, h) do { _Pragma("unroll") for (int m = 0; m < 4; ++m) _Pragma("unroll") for (int k = 0; k < 2; ++k) dst[m][k] = *(const PG8_LAS bf16x8*)(lds + PG8_SA(b, h) + aoff + m * 2048 + k * 1024); } while (0)
#define PG8_LDB(dst, b, h) do { _Pragma("unroll") for (int n = 0; n < 2; ++n) _Pragma("unroll") for (int k = 0; k < 2; ++k) dst[n][k] = *(const PG8_LAS bf16x8*)(lds + PG8_SB(b, h) + boff + n * 2048 + k * 1024); } while (0)
#define PG8_MMA(ai, bj, At, Bt) do { __builtin_amdgcn_s_setprio(1); _Pragma("unroll") for (int m = 0; m < 4; ++m) _Pragma("unroll") for (int n = 0; n < 2; ++n) _Pragma("unroll") for (int k = 0; k < 2; ++k) \
        acc[ai][bj][m][n] = __builtin_amdgcn_mfma_f32_16x16x32_bf16(Bt[n][k], At[m][k], acc[ai][bj][m][n], 0, 0, 0); __builtin_amdgcn_s_setprio(0); } while (0)
#define PG8_WAIT_V(n) asm volatile("s_waitcnt vmcnt(" #n ")" ::: "memory")
#define PG8_WAIT_L(n) asm volatile("s_waitcnt lgkmcnt(" #n ")" ::: "memory")
#define PG8_BAR __builtin_amdgcn_s_barrier()
#define PG8_SCHED __builtin_amdgcn_sched_barrier(0)
    Unit cur, nxt; int ui = 0;
    if (!S.next(0, cur)) return;
    f32x4 acc[2][2][4][2];
#pragma unroll
    for (int a = 0; a < 2; ++a)
#pragma unroll
        for (int b = 0; b < 2; ++b)
#pragma unroll
            for (int m = 0; m < 4; ++m)
#pragma unroll
                for (int n = 0; n < 2; ++n) acc[a][b][m][n] = (f32x4){0.f, 0.f, 0.f, 0.f};
    bf16x8 At[4][2], B0[2][2], B1[2][2];
    const char* cA = S.pa(g, cur); const char* cB = S.pb(g, cur);
    S.a_ready(cur);
    PG8_STAGE(PG8_SB(0, 0), cB, voffB); PG8_STAGE(PG8_SA(0, 0), cA, voffA); PG8_STAGE(PG8_SB(0, 1), cB + hstep, voffB); PG8_STAGE(PG8_SA(0, 1), cA + hstep, voffA);
    if (wr == 1) PG8_BAR;
    PG8_WAIT_V(4); PG8_BAR;
    PG8_STAGE(PG8_SB(1, 0), cB + kstep, voffB); PG8_STAGE(PG8_SA(1, 0), cA + kstep, voffA); PG8_STAGE(PG8_SB(1, 1), cB + hstep + kstep, voffB);
    PG8_WAIT_V(6); PG8_BAR;
    PG8_STAMP();
    for (;;) {
        const bool has_next = S.next(ui + 1, nxt);
        const char* nA = has_next ? S.pa(g, nxt) : cA; const char* nB = has_next ? S.pb(g, nxt) : cB;
        for (int t = 0; t < nt; t += 2) {
            const bool last = (t == nt - 2);
            const char* a1 = cA + (size_t)(t + 1) * kstep;
            const char* a2 = last ? nA : cA + (size_t)(t + 2) * kstep; const char* b2 = last ? nB : cB + (size_t)(t + 2) * kstep;
            const char* a3 = a2 + kstep; const char* b3 = b2 + kstep;
            if (last && has_next) S.a_ready(nxt);
            PG8_LDB(B0, 0, 0); PG8_SCHED; PG8_LDA(At, 0, 0); PG8_STAGE(PG8_SA(1, 1), a1 + hstep, voffA);
            PG8_WAIT_L(8); PG8_BAR; PG8_WAIT_L(0); PG8_MMA(0, 0, At, B0); PG8_BAR; PG8_SCHED;
            PG8_LDB(B1, 0, 1); PG8_STAGE(PG8_SB(0, 0), b2, voffB);
            PG8_BAR; PG8_WAIT_L(0); PG8_MMA(0, 1, At, B1); PG8_BAR;
            PG8_LDA(At, 0, 1); PG8_STAGE(PG8_SA(0, 0), a2, voffA);
            PG8_BAR; PG8_WAIT_L(0); PG8_MMA(1, 0, At, B0); PG8_BAR; PG8_SCHED;
            PG8_STAGE(PG8_SB(0, 1), b2 + hstep, voffB);
            PG8_WAIT_V(6); PG8_BAR; PG8_MMA(1, 1, At, B1); PG8_BAR;
            PG8_LDB(B0, 1, 0); PG8_SCHED; PG8_LDA(At, 1, 0); PG8_STAGE(PG8_SA(0, 1), a2 + hstep, voffA);
            PG8_WAIT_L(8); PG8_BAR; PG8_WAIT_L(0); PG8_MMA(0, 0, At, B0); PG8_BAR; PG8_SCHED;
            PG8_LDB(B1, 1, 1); PG8_STAGE(PG8_SB(1, 0), b3, voffB);
            PG8_BAR; PG8_WAIT_L(0); PG8_MMA(0, 1, At, B1); PG8_BAR;
            PG8_LDA(At, 1, 1); PG8_STAGE(PG8_SA(1, 0), a3, voffA);
            PG8_BAR; PG8_WAIT_L(0); PG8_MMA(1, 0, At, B0); PG8_BAR; PG8_SCHED;
            PG8_STAGE(PG8_SB(1, 1), b3 + hstep, voffB);
            PG8_WAIT_V(6); PG8_BAR; PG8_MMA(1, 1, At, B1); PG8_BAR;
        }
        PG8_STAMP();
        if constexpr (!Epi::AFTER_DRAIN) { E(acc, cur, wr, wc, fr, fq); S.done(cur); }
        PG8_STAMP();
        if (!has_next) break;
#pragma unroll
        for (int a = 0; a < 2; ++a)
#pragma unroll
            for (int b = 0; b < 2; ++b)
#pragma unroll
                for (int m = 0; m < 4; ++m)
#pragma unroll
                    for (int n = 0; n < 2; ++n) acc[a][b][m][n] = (f32x4){0.f, 0.f, 0.f, 0.f};
        cur = nxt; cA = nA; cB = nB; ++ui;
    }
    PG8_WAIT_V(0);
    if (wr == 0) PG8_BAR;
    PG8_BAR;
    if constexpr (Epi::AFTER_DRAIN) { E.fused(acc, cur, wr, wc, fr, fq, lds, wid, lane); S.done(cur); }
    PG8_STAMP();
    if (STAMP && wid == 0) { stamps[lane] = lane < nts ? (((unsigned long long)(unsigned)ts_hi << 32) | (unsigned)ts_lo) : 0ull;
        if (lane == 62) stamps[62] = rt_entry; if (lane == 63) stamps[63] = (unsigned long long)wall_clock64(); }
#undef PG8_STAMP
#undef PG8_SA
#undef PG8_SB
#undef PG8_STAGE
#undef PG8_LDA
#undef PG8_LDB
#undef PG8_MMA
#undef PG8_WAIT_V
#undef PG8_WAIT_L
#undef PG8_BAR
#undef PG8_SCHED
}
}

typedef unsigned short bf16_t;
__device__ __forceinline__ float wave_sum(float v) {
#pragma unroll
    for (int o = 32; o; o >>= 1) v += __shfl_xor(v, o);
    return v;
}
__device__ __forceinline__ float block_sum(float v, float* red) {
    v = wave_sum(v);
    __syncthreads();
    if ((threadIdx.x & 63) == 0) red[threadIdx.x >> 6] = v;
    __syncthreads();
    float s = 0.f;
#pragma unroll
    for (int i = 0; i < NWAVES; ++i) s += red[i];
    return s;
}
__device__ __forceinline__ int opaque_tid() { int t = threadIdx.x; asm volatile("" : "+v"(t)); return t; }
typedef float nt_f32x4 __attribute__((ext_vector_type(4)));
__device__ __forceinline__ float4 nt_load4(const float* p) { const nt_f32x4 v = __builtin_nontemporal_load((const nt_f32x4*)p); return make_float4(v[0], v[1], v[2], v[3]); }
typedef unsigned nt_u32x4 __attribute__((ext_vector_type(4)));
typedef unsigned nt_u32x2 __attribute__((ext_vector_type(2)));
__device__ __forceinline__ uint4 nt_load4u(const void* p) { const nt_u32x4 v = __builtin_nontemporal_load((const nt_u32x4*)p); return make_uint4(v[0], v[1], v[2], v[3]); }
__device__ __forceinline__ uint2 nt_load2u(const void* p) { const nt_u32x2 v = __builtin_nontemporal_load((const nt_u32x2*)p); return make_uint2(v[0], v[1]); }
__device__ __forceinline__ void nt_store4(float* p, float a, float b, float c, float d) { nt_f32x4 v = {a, b, c, d}; __builtin_nontemporal_store(v, (nt_f32x4*)p); }
__device__ __forceinline__ void nt_store4u(void* p, uint4 v) { nt_u32x4 w = {v.x, v.y, v.z, v.w}; __builtin_nontemporal_store(w, (nt_u32x4*)p); }
__device__ __forceinline__ void nt_store2u(void* p, uint2 v) { nt_u32x2 w = {v.x, v.y}; __builtin_nontemporal_store(w, (nt_u32x2*)p); }
__device__ __forceinline__ float silu(float x) { return x / (1.0f + expf(-x)); }


__device__ __forceinline__ unsigned pk_bf16(float lo, float hi) { unsigned r; asm volatile("v_cvt_pk_bf16_f32 %0, %1, %2" : "=v"(r) : "v"(lo), "v"(hi)); return r; }
__device__ __forceinline__ void transpose_convert(const float* __restrict__ W, bf16_t* __restrict__ Wt, int K, int N, float* lds, int wb0, int nwb) {
    const int tid = opaque_tid();
    const int tk = K / 64, tn = N / 256;
    for (int tile = (int)blockIdx.x - wb0; tile < tk * tn; tile += nwb) {
        const int k0 = (tile / tn) * 64, n0 = (tile % tn) * 256;
        __syncthreads();
        float4 v[8];
#pragma unroll
        for (int i = 0; i < 8; ++i) v[i] = nt_load4(W + (size_t)(k0 + (tid >> 6) + 8 * i) * N + n0 + (tid & 63) * 4);
#pragma unroll
        for (int i = 0; i < 8; ++i) { float* d = lds + ((tid >> 6) + 8 * i) * 257 + (tid & 63) * 4; d[0] = v[i].x; d[1] = v[i].y; d[2] = v[i].z; d[3] = v[i].w; }
        __syncthreads();
#pragma unroll
        for (int q = 0; q < 4; ++q) {
            const int c = q * NTHREADS + tid, n = c >> 3, k8 = (c & 7) * 8;
            uint4 o;
            o.x = pk_bf16(lds[(k8 + 0) * 257 + n], lds[(k8 + 1) * 257 + n]); o.y = pk_bf16(lds[(k8 + 2) * 257 + n], lds[(k8 + 3) * 257 + n]);
            o.z = pk_bf16(lds[(k8 + 4) * 257 + n], lds[(k8 + 5) * 257 + n]); o.w = pk_bf16(lds[(k8 + 6) * 257 + n], lds[(k8 + 7) * 257 + n]);
            *(uint4*)(Wt + (size_t)(n0 + n) * K + k0 + k8) = o;
        }
    }
}
__device__ __forceinline__ float wave_max(float v) {
#pragma unroll
    for (int o = 32; o; o >>= 1) v = fmaxf(v, __shfl_xor(v, o));
    return v;
}
__device__ __forceinline__ float block_max(float v, float* red) {
    v = wave_max(v);
    __syncthreads();
    if ((threadIdx.x & 63) == 0) red[threadIdx.x >> 6] = v;
    __syncthreads();
    float s = red[0];
#pragma unroll
    for (int i = 1; i < NWAVES; ++i) s = fmaxf(s, red[i]);
    return s;
}
__device__ __forceinline__ unsigned q4(float a, float b, float c, float d, float inv, int off) {
    const int x = __float2int_rn(a * inv) + off, y = __float2int_rn(b * inv) + off, z = __float2int_rn(c * inv) + off, w = __float2int_rn(d * inv) + off;
    return (unsigned)(x & 255) | ((unsigned)(y & 255) << 8) | ((unsigned)(z & 255) << 16) | ((unsigned)(w & 255) << 24);
}
constexpr int UROW = 1024;
template <int O> __device__ __forceinline__ unsigned nibh8(const float (&x)[16], float inv) {
    unsigned r = 0;
#pragma unroll
    for (int i = 0; i < 8; ++i) r |= (unsigned)min(max((int)floorf(x[O + i] * inv) + 8, 0), 15) << (4 * i);
    return r;
}
template <int U = 2> __device__ __forceinline__ void quant_tables(const Params& p, int wb0, int nwb, int rb = 0, int re = 2 * 16384) {
    const int tid = opaque_tid(), lane = tid & 63, wv = tid >> 6;
    unsigned char* tq = (unsigned char*)p.ws + B_TQ; float* rsc = p.ws + W_SU;
    const int nw = nwb * NWAVES;
    for (int row0 = rb + ((int)blockIdx.x - wb0) * NWAVES + wv; row0 < re; row0 += U * nw) {
        float x[2][2][16]; float mx[2][2];
#pragma unroll
        for (int u = 0; u < U; ++u) {
            const int row = min(row0 + u * nw, re - 1);
            const float* src = (row < 16384 ? p.in[I_PU] : p.in[I_PV]) + (size_t)(row & 16383) * D + lane * 4;
#pragma unroll
            for (int h = 0; h < 2; ++h) {
                mx[u][h] = 0.f;
#pragma unroll
                for (int q = 0; q < 4; ++q) { const float4 v = nt_load4(src + (h * 4 + q) * 256); x[u][h][q * 4] = v.x; x[u][h][q * 4 + 1] = v.y; x[u][h][q * 4 + 2] = v.z; x[u][h][q * 4 + 3] = v.w;
                    mx[u][h] = fmaxf(mx[u][h], fmaxf(fmaxf(fabsf(v.x), fabsf(v.y)), fmaxf(fabsf(v.z), fabsf(v.w)))); }
            }
        }
#pragma unroll
        for (int u = 0; u < U; ++u) {
            const int row = row0 + u * nw;
            if (row < re) {
                const float rmx = wave_max(fmaxf(mx[u][0], mx[u][1]));
                {
                    float ss = 0.f;
#pragma unroll
                    for (int h = 0; h < 2; ++h)
#pragma unroll
                        for (int i = 0; i < 16; ++i) ss += x[u][h][i] * x[u][h][i];
                    const float rms = sqrtf(wave_sum(ss) * (1.0f / 2048.0f));
                    if (row >= 16384) {
                        const float cl = fminf(rmx, 2.94f * rms);
                        const float Rv = cl > 0.f ? cl * (1.0f / 6.0f) : 1.0f, iv = 1.0f / Rv;
                        unsigned w4[4];
#pragma unroll
                        for (int q = 0; q < 4; ++q) {
                            const float* xs = &x[u][q >> 1][(q & 1) * 8];
                            unsigned r = 0u;
                            r = __builtin_amdgcn_cvt_scalef32_pk_fp4_f32(r, xs[0] * iv, xs[1] * iv, 1.0f, 0);
                            r = __builtin_amdgcn_cvt_scalef32_pk_fp4_f32(r, xs[2] * iv, xs[3] * iv, 1.0f, 1);
                            r = __builtin_amdgcn_cvt_scalef32_pk_fp4_f32(r, xs[4] * iv, xs[5] * iv, 1.0f, 2);
                            r = __builtin_amdgcn_cvt_scalef32_pk_fp4_f32(r, xs[6] * iv, xs[7] * iv, 1.0f, 3);
                            w4[q] = r;
                        }
                        nt_store4u(tq + (size_t)row * UROW + lane * 16, make_uint4(w4[0], w4[1], w4[2], w4[3]));
                        if (lane == 0) rsc[row] = Rv;
                        continue;
                    }
                    const float clipv = fminf(rmx, 2.5125f * rms);
                    const float Ru = clipv > 0.f ? clipv * (1.0f / 7.5f) : 1.0f, iu = 1.0f / Ru;
                    const unsigned c0 = nibh8<0>(x[u][0], iu), c1 = nibh8<8>(x[u][0], iu), c2 = nibh8<0>(x[u][1], iu), c3 = nibh8<8>(x[u][1], iu);
                    nt_store4u(tq + (size_t)row * UROW + lane * 16, make_uint4(c0, c1, c2, c3));
                    unsigned cs = __builtin_amdgcn_udot8(c0, 0x11111111u, 0u, false); cs = __builtin_amdgcn_udot8(c1, 0x11111111u, cs, false);
                    cs = __builtin_amdgcn_udot8(c2, 0x11111111u, cs, false); cs = __builtin_amdgcn_udot8(c3, 0x11111111u, cs, false);
                    const float csum = wave_sum((float)cs);
                    if (lane == 0) { rsc[row] = Ru; (p.ws + W_SC)[row] = csum; }
                }
            }
        }
    }
}

__device__ __forceinline__ void naive_gemm(const float* __restrict__ A, int lda, const float* __restrict__ Bm, int ldb,
                                           float* __restrict__ C, int ldc, int M, int N, int K, float* lds) {
    float* As = lds;
    float* Bs = lds + 16 * 132;
    const int tid = opaque_tid(), tx = tid & 31, ty = tid >> 5;
    const int tilesN = N / 128, ntiles = (M / 128) * tilesN;
    for (int tile = blockIdx.x; tile < ntiles; tile += gridDim.x) {
        const int m0 = (tile / tilesN) * 128, n0 = (tile % tilesN) * 128;
        float acc[8][4];
#pragma unroll
        for (int i = 0; i < 8; ++i)
#pragma unroll
            for (int j = 0; j < 4; ++j) acc[i][j] = 0.f;
        for (int k0 = 0; k0 < K; k0 += 16) {
            {
                const int row = tid >> 2, kq = (tid & 3) * 4;
                const float4 a = *(const float4*)(A + (size_t)(m0 + row) * lda + k0 + kq);
                As[(kq + 0) * 132 + row] = a.x; As[(kq + 1) * 132 + row] = a.y; As[(kq + 2) * 132 + row] = a.z; As[(kq + 3) * 132 + row] = a.w;
                const int kk = tid >> 5, n4 = (tid & 31) * 4;
                *(float4*)(Bs + kk * 128 + n4) = *(const float4*)(Bm + (size_t)(k0 + kk) * ldb + n0 + n4);
            }
            __syncthreads();
#pragma unroll 4
            for (int k = 0; k < 16; ++k) {
                const float4 a0 = *(const float4*)(As + k * 132 + ty * 8), a1 = *(const float4*)(As + k * 132 + ty * 8 + 4);
                const float4 b = *(const float4*)(Bs + k * 128 + tx * 4);
                const float av[8] = {a0.x, a0.y, a0.z, a0.w, a1.x, a1.y, a1.z, a1.w};
                const float bv[4] = {b.x, b.y, b.z, b.w};
#pragma unroll
                for (int i = 0; i < 8; ++i)
#pragma unroll
                    for (int j = 0; j < 4; ++j) acc[i][j] += av[i] * bv[j];
            }
            __syncthreads();
        }
#pragma unroll
        for (int i = 0; i < 8; ++i)
            *(float4*)(C + (size_t)(m0 + ty * 8 + i) * ldc + n0 + tx * 4) = make_float4(acc[i][0], acc[i][1], acc[i][2], acc[i][3]);
    }
}

__device__ __forceinline__ void phase_a(const Params& p, float* lds) {
    const int tid = opaque_tid();
    const float* c = p.in[I_C]; const float* cctx = p.in[I_CCTX]; const float* wada = p.in[I_WADA];
    float* part = p.ws + W_ADAP;
    for (int item = blockIdx.x; item < 32 * 24; item += gridDim.x) {
        const int ks = item / 24, j = (item % 24) * 512 + tid;
        __syncthreads();
        if (tid < 5 * 64) { const int n = tid >> 6, k = ks * 64 + (tid & 63); lds[tid] = silu(n < 4 ? c[n * 2048 + k] : cctx[k]); }
        __syncthreads();
        float a0 = 0.f, a1 = 0.f, a2 = 0.f, a3 = 0.f, a4 = 0.f;
#pragma unroll 32
        for (int kk = 0; kk < 64; ++kk) {
            const float w = __builtin_nontemporal_load(wada + (size_t)(ks * 64 + kk) * 12288 + j);
            a0 += lds[kk] * w; a1 += lds[64 + kk] * w; a2 += lds[128 + kk] * w; a3 += lds[192 + kk] * w; a4 += lds[256 + kk] * w;
        }
        part[(size_t)(ks * 5 + 0) * 12288 + j] = a0; part[(size_t)(ks * 5 + 1) * 12288 + j] = a1; part[(size_t)(ks * 5 + 2) * 12288 + j] = a2;
        part[(size_t)(ks * 5 + 3) * 12288 + j] = a3; part[(size_t)(ks * 5 + 4) * 12288 + j] = a4;
    }
}
typedef short bf16x8v __attribute__((ext_vector_type(8)));
typedef float f32x4v __attribute__((ext_vector_type(4)));
typedef float f32x16v __attribute__((ext_vector_type(16)));
__device__ __forceinline__ void phase_filters(const Params& p, float* lds) {
    const int tid = opaque_tid();
    const float* w1 = p.in[I_FW1]; const float* b1 = p.in[I_FB1]; const float* w2 = p.in[I_FW2]; const float* b2 = p.in[I_FB2];
    const float* w3 = p.in[I_FW3]; const float* b3 = p.in[I_FB3]; const float* w4 = p.in[I_FW4]; const float* freq = p.in[I_FREQ];
    float* hT = (float*)((char*)p.ws + B_KF); float* sp = p.ws + W_SP;
    float* zf = lds; float* ha = lds + 64 * 36; float* hb = ha + 64 * 68; float* red2 = hb + 64 * 68;
    float* W1 = red2 + 256; float* W2 = W1 + 33 * 64; float* W3 = W2 + 64 * 64;
    __syncthreads();
    for (int e = tid; e < 33 * 64; e += NTHREADS) W1[e] = w1[e];
    for (int e = tid; e < 64 * 64; e += NTHREADS) { W2[e] = w2[e]; W3[e] = w3[e]; }
    for (int item = blockIdx.x; item < 256; item += gridDim.x) {
        const int pt = item >> 3;
        __syncthreads();
        for (int e = tid; e < 64 * 33; e += NTHREADS) {
            const int pos = e / 33, m = e % 33, i = pt * 64 + pos;
            const float t = (float)i / 2047.0f, w = 6.283185307179586f * (float)i / 2048.0f;
            float v;
            if (m == 0) v = t;
            else if (m <= 16) { const float f = 1e-4f + (float)(m - 1) * ((15.0f - 1e-4f) / 15.0f); v = __cosf(f * w); }
            else { const float f = 1e-4f + (float)(m - 17) * ((15.0f - 1e-4f) / 15.0f); v = -__sinf(f * w); }
            zf[pos * 36 + m] = v;
        }
        __syncthreads();
        const int pos = tid >> 3, u0 = (tid & 7) * 8;
        {
            float a[8];
#pragma unroll
            for (int u = 0; u < 8; ++u) a[u] = b1[u0 + u];
#pragma unroll 11
            for (int m = 0; m < 33; ++m) { const float zv = zf[pos * 36 + m]; const float4 wa = *(const float4*)(W1 + m * 64 + u0), wb = *(const float4*)(W1 + m * 64 + u0 + 4);
                a[0] += zv * wa.x; a[1] += zv * wa.y; a[2] += zv * wa.z; a[3] += zv * wa.w; a[4] += zv * wb.x; a[5] += zv * wb.y; a[6] += zv * wb.z; a[7] += zv * wb.w; }
#pragma unroll
            for (int u = 0; u < 8; ++u) ha[pos * 68 + u0 + u] = __sinf(freq[u0 + u] * a[u]);
        }
        __syncthreads();
        {
            float a[8];
#pragma unroll
            for (int u = 0; u < 8; ++u) a[u] = b2[u0 + u];
#pragma unroll 16
            for (int m = 0; m < 64; ++m) { const float zv = ha[pos * 68 + m]; const float4 wa = *(const float4*)(W2 + m * 64 + u0), wb = *(const float4*)(W2 + m * 64 + u0 + 4);
                a[0] += zv * wa.x; a[1] += zv * wa.y; a[2] += zv * wa.z; a[3] += zv * wa.w; a[4] += zv * wb.x; a[5] += zv * wb.y; a[6] += zv * wb.z; a[7] += zv * wb.w; }
#pragma unroll
            for (int u = 0; u < 8; ++u) hb[pos * 68 + u0 + u] = __sinf(freq[64 + u0 + u] * a[u]);
        }
        __syncthreads();
        {
            float a[8];
#pragma unroll
            for (int u = 0; u < 8; ++u) a[u] = b3[u0 + u];
#pragma unroll 16
            for (int m = 0; m < 64; ++m) { const float zv = hb[pos * 68 + m]; const float4 wa = *(const float4*)(W3 + m * 64 + u0), wb = *(const float4*)(W3 + m * 64 + u0 + 4);
                a[0] += zv * wa.x; a[1] += zv * wa.y; a[2] += zv * wa.z; a[3] += zv * wa.w; a[4] += zv * wb.x; a[5] += zv * wb.y; a[6] += zv * wb.z; a[7] += zv * wb.w; }
#pragma unroll
            for (int u = 0; u < 8; ++u) ha[pos * 68 + u0 + u] = __sinf(freq[128 + u0 + u] * a[u]);
        }
        __syncthreads();
#pragma unroll 1
        for (int jt = (item & 7) * 2; jt < (item & 7) * 2 + 2; ++jt) {
            const int lane = tid & 63, wv = tid >> 6, cl = lane & 15, g = lane >> 4;
            union frag { unsigned u[4]; bf16x8v v; };
            frag af[2][2];
#pragma unroll
            for (int mt = 0; mt < 2; ++mt)
#pragma unroll
                for (int ks = 0; ks < 2; ++ks) {
                    const float* wp = w4 + (size_t)(ks * 32 + 8 * g) * 4096 + jt * 256 + wv * 32 + mt * 16 + cl;
                    float x[8];
#pragma unroll
                    for (int i = 0; i < 8; ++i) x[i] = wp[(size_t)i * 4096];
                    af[mt][ks].u[0] = pk_bf16(x[0], x[1]); af[mt][ks].u[1] = pk_bf16(x[2], x[3]); af[mt][ks].u[2] = pk_bf16(x[4], x[5]); af[mt][ks].u[3] = pk_bf16(x[6], x[7]);
                }
            f32x4v acc[2][4];
#pragma unroll
            for (int mt = 0; mt < 2; ++mt)
#pragma unroll
                for (int nt = 0; nt < 4; ++nt) acc[mt][nt] = (f32x4v){0.f, 0.f, 0.f, 0.f};
#pragma unroll
            for (int nt = 0; nt < 4; ++nt)
#pragma unroll
                for (int ks = 0; ks < 2; ++ks) {
                    const float4 h0 = *(const float4*)(ha + (nt * 16 + cl) * 68 + ks * 32 + 8 * g), h1 = *(const float4*)(ha + (nt * 16 + cl) * 68 + ks * 32 + 8 * g + 4);
                    frag bf; bf.u[0] = pk_bf16(h0.x, h0.y); bf.u[1] = pk_bf16(h0.z, h0.w); bf.u[2] = pk_bf16(h1.x, h1.y); bf.u[3] = pk_bf16(h1.z, h1.w);
#pragma unroll
                    for (int mt = 0; mt < 2; ++mt) acc[mt][nt] = __builtin_amdgcn_mfma_f32_16x16x32_bf16(af[mt][ks].v, bf.v, acc[mt][nt], 0, 0, 0);
                }
#pragma unroll
            for (int mt = 0; mt < 2; ++mt)
#pragma unroll
                for (int r = 0; r < 4; ++r) {
                    const int j = jt * 256 + wv * 32 + mt * 16 + 4 * g + r;
                    const float delta = 3.070113457f + (float)(j & 1023) * ((15.35056729f - 3.070113457f) / 1023.0f);
                    float asum = 0.f;
#pragma unroll
                    for (int nt = 0; nt < 4; ++nt) {
                        const int ps = pt * 64 + nt * 16 + cl;
                        const float val = acc[mt][nt][r] * __expf(-((float)ps / 2047.0f) * delta);
                        asum += fabsf(val);
                        __builtin_nontemporal_store(val, hT + (size_t)j * SL + ps);
                    }
                    asum += __shfl_xor(asum, 1); asum += __shfl_xor(asum, 2); asum += __shfl_xor(asum, 4); asum += __shfl_xor(asum, 8);
                    if (cl == 0) sp[(size_t)pt * 4096 + j] = asum;
                }
        }
    }
}

__device__ __forceinline__ void phase_b(const Params& p) {
    const int tid = opaque_tid();
    const float* part = p.ws + W_ADAP; float* ada = p.ws + W_ADA; const float* bada = p.in[I_BADA];
    for (int e = blockIdx.x * NTHREADS + tid; e < 5 * 12288; e += gridDim.x * NTHREADS) {
        float s = bada[e % 12288];
#pragma unroll 8
        for (int ks = 0; ks < 32; ++ks) s += part[(size_t)ks * 5 * 12288 + e];
        ada[e] = s;
    }
    const float* sp = p.ws + W_SP; float* fs = p.ws + W_FS;
    for (int j = blockIdx.x * NTHREADS + tid; j < 4096; j += gridDim.x * NTHREADS) {
        float s = 0.f;
#pragma unroll 8
        for (int pt = 0; pt < 32; ++pt) s += sp[(size_t)pt * 4096 + j];
        fs[j] = s;
    }
}

__device__ __forceinline__ void phase_c(const Params& p) {
    const int tid = opaque_tid();
    const float* ada = p.ws + W_ADA;
    const float* x = p.in[I_X]; bf16_t* ub = (bf16_t*)((char*)p.ws + B_UB);
    for (size_t e = (size_t)blockIdx.x * NTHREADS + tid; e < (size_t)NT * D / 4; e += (size_t)gridDim.x * NTHREADS) {
        const size_t row = e / (D / 4); const int col = (int)(e % (D / 4)) * 4; const int b = (int)(row / SL);
        const float4 xv = nt_load4(x + row * D + col);
        const float4 sh = *(const float4*)(ada + b * 12288 + col), sc = *(const float4*)(ada + b * 12288 + 2048 + col);
        uint2 o; o.x = pk_bf16(xv.x * (1.f + sc.x) + sh.x, xv.y * (1.f + sc.y) + sh.y); o.y = pk_bf16(xv.z * (1.f + sc.z) + sh.z, xv.w * (1.f + sc.w) + sh.w);
        *(uint2*)(ub + row * D + col) = o;
    }
    const float* ctx = p.in[I_CTX]; bf16_t* ucb = ub + (size_t)NT * D;
    for (size_t e = (size_t)blockIdx.x * NTHREADS + tid; e < (size_t)NTC * D / 4; e += (size_t)gridDim.x * NTHREADS) {
        const size_t row = e / (D / 4); const int col = (int)(e % (D / 4)) * 4;
        const float4 xv = nt_load4(ctx + row * D + col);
        const float4 sh = *(const float4*)(ada + 4 * 12288 + col), sc = *(const float4*)(ada + 4 * 12288 + 2048 + col);
        uint2 o; o.x = pk_bf16(xv.x * (1.f + sc.x) + sh.x, xv.y * (1.f + sc.y) + sh.y); o.y = pk_bf16(xv.z * (1.f + sc.z) + sh.z, xv.w * (1.f + sc.w) + sh.w);
        *(uint2*)(ucb + row * D + col) = o;
    }
}

__device__ __forceinline__ float bf2f(bf16_t v) { return __uint_as_float(((unsigned)v) << 16); }
constexpr int HY_PB = 4416, HY_PJ = 272, HY_R0 = 4 * HY_PB, HY_R1 = HY_R0 + 8192 + 64, HY_SLOT = HY_R1 + 8192 + 64;
static_assert(HY_SLOT % 16 == 0 && 4 * HY_SLOT + 64 <= 155 * 1024, "hyena LDS");
__device__ __forceinline__ bf16x8v hy_lda(const unsigned char* base, int off) {
    const unsigned* q = (const unsigned*)(base + off);
    union { unsigned u[4]; bf16x8v v; } r; r.u[0] = q[0]; r.u[1] = q[1]; r.u[2] = q[2]; r.u[3] = q[3];
    return r.v;
}
__device__ __forceinline__ void hy_stage_rows(const bf16_t* zT, const float* cw, const float* cb, int ch, int half, int lane, unsigned char* sl) {
    const float w0 = cw[ch], w1 = cw[3072 + ch], w2 = cw[6144 + ch], bs = cb[ch];
#pragma unroll 4
    for (int q = 0; q < 8; ++q) {
        const int bsel = 2 * half + (q >> 2), t0 = ((q & 3) * 64 + lane) * 8;
        const bf16_t* zrow = zT + (size_t)ch * NT + bsel * SL;
        const uint4 raw = nt_load4u(zrow + t0);
        float z[10];
        z[0] = t0 > 0 ? bf2f(zrow[t0 - 1]) : 0.f; z[9] = t0 + 8 < SL ? bf2f(zrow[t0 + 8]) : 0.f;
        z[1] = __uint_as_float(raw.x << 16); z[2] = __uint_as_float(raw.x & 0xffff0000u); z[3] = __uint_as_float(raw.y << 16); z[4] = __uint_as_float(raw.y & 0xffff0000u);
        z[5] = __uint_as_float(raw.z << 16); z[6] = __uint_as_float(raw.z & 0xffff0000u); z[7] = __uint_as_float(raw.w << 16); z[8] = __uint_as_float(raw.w & 0xffff0000u);
        float sv[8];
#pragma unroll
        for (int i = 0; i < 8; ++i) sv[i] = w0 * z[i] + w1 * z[i + 1] + w2 * z[i + 2] + bs;
        uint4 o; o.x = pk_bf16(sv[0], sv[1]); o.y = pk_bf16(sv[2], sv[3]); o.z = pk_bf16(sv[4], sv[5]); o.w = pk_bf16(sv[6], sv[7]);
        *(uint4*)(sl + bsel * HY_PB + (t0 >> 7) * HY_PJ + (t0 & 127) * 2) = o;
    }
}
__device__ __forceinline__ void hy_pair_sync(volatile __attribute__((address_space(3))) unsigned* fl, int wv, unsigned n) {
    asm volatile("s_waitcnt lgkmcnt(0)" ::: "memory");
    fl[wv] = n;
    while (fl[wv ^ 1] < n) __builtin_amdgcn_s_sleep(0);
    asm volatile("" ::: "memory");
}
__device__ __forceinline__ void phase_hyena(const Params& p, unsigned char* smem) {
    const int tid = opaque_tid(), lane = tid & 63, wv = tid >> 6, slot = wv >> 1, half = wv & 1, pt = tid & 127;
    const bf16_t* zT = (const bf16_t*)((const char*)p.ws + B_ZT); const float* hT = (const float*)((const char*)p.ws + B_KF); const float* fs = p.ws + W_FS; bf16_t* hyT = (bf16_t*)((char*)p.ws + B_HYT);
    const float* cw = p.in[I_CONVW]; const float* cb = p.in[I_CONVB]; const float* skip = p.in[I_SKIP];
    unsigned char* sl = smem + slot * HY_SLOT;
    const int a_ = lane & 31, hh = lane >> 5, i_local = a_ >> 2, batch = a_ & 3, I0 = 8 * half;
    const int laneA = ((a_ & 1) ? HY_R0 : HY_R1) + 2 * (2047 - a_ - (1 - (a_ & 1)) + 8 * hh);
    volatile __attribute__((address_space(3))) unsigned* fl = (volatile __attribute__((address_space(3))) unsigned*)(smem + 4 * HY_SLOT);
    unsigned seq = 0u;
    __syncthreads();
    if (tid < 8) fl[tid] = 0u;
    if (wv < 4) __builtin_amdgcn_s_setprio(2);
    for (int item = blockIdx.x; item < DHY / 4; item += gridDim.x) {
        const int c = item * 4 + slot;
        __syncthreads();
        hy_stage_rows(zT, cw, cb, c, half, lane, sl);
#pragma unroll 1
        for (int ord = 0; ord < 2; ++ord) {
            {
                const float* hf = hT + (size_t)((ord * 2 + 0) * 1024 + c) * SL; const float* hbk = hT + (size_t)((ord * 2 + 1) * 1024 + c) * SL;
                const float sk = skip[ord * 1024 + c]; const float invs = 1.0f / (fs[(ord * 2 + 0) * 1024 + c] + fs[(ord * 2 + 1) * 1024 + c]);
#pragma unroll
                for (int q = 0; q < 4; ++q) {
                    const int X0 = (q * 128 + pt) * 8;
                    float rv[9];
#pragma unroll
                    for (int i = 0; i < 9; ++i) { const int dp = 2047 - X0 - i; rv[i] = (dp >= 0 ? __builtin_nontemporal_load(hf + dp) : (dp >= -2047 ? __builtin_nontemporal_load(hbk - dp) : 0.f)) * invs; if (dp == 0) rv[i] += sk; }
                    uint4 o0, o1;
                    o0.x = pk_bf16(rv[0], rv[1]); o0.y = pk_bf16(rv[2], rv[3]); o0.z = pk_bf16(rv[4], rv[5]); o0.w = pk_bf16(rv[6], rv[7]);
                    o1.x = pk_bf16(rv[1], rv[2]); o1.y = pk_bf16(rv[3], rv[4]); o1.z = pk_bf16(rv[5], rv[6]); o1.w = pk_bf16(rv[7], rv[8]);
                    *(uint4*)(sl + HY_R0 + X0 * 2) = o0; *(uint4*)(sl + HY_R1 + X0 * 2) = o1;
                }
            }
            hy_pair_sync(fl, wv, ++seq);
            f32x16v acc[4];
#pragma unroll
            for (int mb = 0; mb < 4; ++mb)
#pragma unroll
                for (int e = 0; e < 16; ++e) acc[mb][e] = 0.f;
            {
                const int dlo = I0 - 15, dhi = I0 + 7;
                bf16x8v As[7][2];
#pragma unroll
                for (int s2 = 0; s2 < 3; ++s2)
#pragma unroll
                    for (int k2 = 0; k2 < 2; ++k2) As[4 + s2][k2] = hy_lda(sl, laneA - 64 * (4 * dlo - 3 + s2) + 32 * k2);
#pragma unroll 1
                for (int d = dlo; d <= dhi; ++d) {
#pragma unroll
                    for (int k2 = 0; k2 < 2; ++k2) { As[0][k2] = As[4][k2]; As[1][k2] = As[5][k2]; As[2][k2] = As[6][k2]; }
#pragma unroll
                    for (int s2 = 3; s2 < 7; ++s2)
#pragma unroll
                        for (int k2 = 0; k2 < 2; ++k2) As[s2][k2] = hy_lda(sl, laneA - 64 * (4 * d - 3 + s2) + 32 * k2);
                    const int jl = I0 + i_local - d; const bool valid = (unsigned)jl < 16u;
                    const unsigned char* bp = sl + batch * HY_PB + (valid ? jl : 0) * HY_PJ + hh * 16;
                    bf16x8v Bq[8];
#pragma unroll
                    for (int q = 0; q < 8; ++q) { const bf16x8v v = *(const bf16x8v*)(bp + q * 32); const bf16x8v zero = {0, 0, 0, 0, 0, 0, 0, 0}; Bq[q] = valid ? v : zero; }
#pragma unroll
                    for (int kb = 0; kb < 4; ++kb)
#pragma unroll
                        for (int k2 = 0; k2 < 2; ++k2)
#pragma unroll
                            for (int mb = 0; mb < 4; ++mb) acc[mb] = __builtin_amdgcn_mfma_f32_32x32x16_bf16(As[mb - kb + 3][k2], Bq[2 * kb + k2], acc[mb], 0, 0, 0);
                }
            }
            hy_pair_sync(fl, wv, ++seq);
            hy_stage_rows(zT, cw, cb, (ord == 0 ? 1024 : 2048) + c, half, lane, sl);
            hy_pair_sync(fl, wv, ++seq);
            {
#pragma unroll
                for (int mb = 0; mb < 4; ++mb)
#pragma unroll
                    for (int q4 = 0; q4 < 4; ++q4) {
                        const int t4 = 128 * (I0 + i_local) + 32 * mb + 8 * q4 + 4 * hh;
                        uint2* gp = (uint2*)(sl + batch * HY_PB + (t4 >> 7) * HY_PJ + (t4 & 127) * 2);
                        const uint2 gv = *gp;
                        uint2 o; o.x = pk_bf16(__uint_as_float(gv.x << 16) * acc[mb][q4 * 4 + 0], __uint_as_float(gv.x & 0xffff0000u) * acc[mb][q4 * 4 + 1]);
                        o.y = pk_bf16(__uint_as_float(gv.y << 16) * acc[mb][q4 * 4 + 2], __uint_as_float(gv.y & 0xffff0000u) * acc[mb][q4 * 4 + 3]);
                        *gp = o;
                    }
            }
            if (ord == 1) {
                hy_pair_sync(fl, wv, ++seq);
#pragma unroll
                for (int q = 0; q < 8; ++q) {
                    const int bsel = 2 * half + (q >> 2), t0 = ((q & 3) * 64 + lane) * 8;
                    nt_store4u(hyT + (size_t)c * NT + bsel * SL + t0, *(const uint4*)(sl + bsel * HY_PB + (t0 >> 7) * HY_PJ + (t0 & 127) * 2));
                }
            }
        }
    }
    __builtin_amdgcn_s_setprio(0);
}

__device__ __forceinline__ bf16x8v pack_p(const f32x4v& lo, const f32x4v& hi) {
    union { unsigned u[4]; bf16x8v v; } r;
    r.u[0] = pk_bf16(lo[0], lo[1]); r.u[1] = pk_bf16(lo[2], lo[3]); r.u[2] = pk_bf16(hi[0], hi[1]); r.u[3] = pk_bf16(hi[2], hi[3]);
    return r.v;
}
__device__ __forceinline__ bf16x8v ld_pair8(const bf16_t* lo, const bf16_t* hi) {
    union { uint2 d[2]; bf16x8v v; } r;
    r.d[0] = *(const uint2*)lo; r.d[1] = *(const uint2*)hi;
    return r.v;
}
typedef __attribute__((address_space(3))) const bf16_t* lds_bf16p;
#define LDS_FRAG(pe) (*(const __attribute__((address_space(3))) bf16x8v*)(pe))
constexpr int NA_KC = 0, NA_VC = 32768, NA_KL = 65536, NA_RPB = 155648;
__device__ __forceinline__ void phase_na(const Params& p, unsigned char* smem) {
    const int tid = opaque_tid(), lane = tid & 63, wv = tid >> 6, ql = lane & 15, g = lane >> 4;
    const bf16_t* qh = (const bf16_t*)((const char*)p.ws + B_QH); const bf16_t* kh = (const bf16_t*)((const char*)p.ws + B_KH);
    const bf16_t* kch = (const bf16_t*)((const char*)p.ws + B_KCH); const bf16_t* vT = (const bf16_t*)((const char*)p.ws + B_VT);
    const bf16_t* vcT = (const bf16_t*)((const char*)p.ws + B_VCT); bf16_t* na = (bf16_t*)((char*)p.ws + B_NA);
    const float* rpb = p.in[I_RPB];
    const lds_bf16p kcl = (lds_bf16p)((__attribute__((address_space(3))) unsigned char*)smem + NA_KC);
    const lds_bf16p vcl = (lds_bf16p)((__attribute__((address_space(3))) unsigned char*)smem + NA_VC);
    const lds_bf16p kll = (lds_bf16p)((__attribute__((address_space(3))) unsigned char*)smem + NA_KL);
    for (int sitem = blockIdx.x; sitem < 256; sitem += gridDim.x) {
      const int b = sitem >> 6, h = (sitem >> 2) & 15, rqp = sitem & 3;
      __syncthreads();
      {
          const uint4* s0 = (const uint4*)(kch + (size_t)((b * 16 + h) * 32) * 512); const uint4* s1 = (const uint4*)(vcT + (size_t)((b * 16 + h) * 32) * 512);
          uint4* d0 = (uint4*)(smem + NA_KC); uint4* d1 = (uint4*)(smem + NA_VC);
#pragma unroll
          for (int i = 0; i < 4; ++i) { d0[tid + i * NTHREADS] = s0[tid + i * NTHREADS]; d1[tid + i * NTHREADS] = s1[tid + i * NTHREADS]; }
          if (tid < 465) ((float*)(smem + NA_RPB))[tid] = rpb[h * 465 + tid];
      }
#pragma unroll 1
      for (int half = 0; half < 2; ++half) {
        const int r0 = rqp * 8 + half * 4;
        const int rs_min = min(max(r0 - 4, 0), 24), rs_max = min(max(r0 - 1, 0), 24), nrows = rs_max - rs_min + 8;
        if (half) __syncthreads();
        {
            const uint4* s0 = (const uint4*)(kh + (size_t)((b * 16 + h) * 256 + rs_min * 8) * 512); uint4* d0 = (uint4*)(smem + NA_KL);
            for (int e = tid; e < nrows * 512; e += NTHREADS) d0[e] = s0[e];
        }
        __syncthreads();
#pragma unroll 1
        for (int ti = 0; ti < 2; ++ti) {
        const int r = r0 + (wv >> 2) + 2 * ti, j = wv & 3;
        const int rs = min(max(r - 4, 0), 24), cs = min(max(16 * j - 8, 0), 32);
        const int x = 16 * j + ql, wsx = min(max(x - 8, 0), 48);
        const bf16_t* qrow = qh + ((size_t)((b * 16 + h) * SL + r * 64 + x)) * 64;
        const bf16x8v qf0 = __builtin_nontemporal_load((const bf16x8v*)(qrow + 8 * g)), qf1 = __builtin_nontemporal_load((const bf16x8v*)(qrow + 32 + 8 * g));
        const __attribute__((address_space(3))) float* rp_h = (const __attribute__((address_space(3))) float*)((__attribute__((address_space(3))) unsigned char*)smem + NA_RPB);
        f32x4v o1[4], o2[4]; float m1 = -1e30f, l1 = 0.f, m2 = -1e30f, l2 = 0.f;
#pragma unroll
        for (int d = 0; d < 4; ++d) { o1[d] = (f32x4v){0.f, 0.f, 0.f, 0.f}; o2[d] = (f32x4v){0.f, 0.f, 0.f, 0.f}; }
        const int koff = (ql >> 2) * 512 + g * 32 + (ql & 3) * 8;
        const bf16_t* vb = vT + (size_t)((b * 16 + h) * 256 + g) * 512 + ql * 8;
        {
            f32x4v st[16];
#pragma unroll
            for (int kb = 0; kb < 16; ++kb) {
                const lds_bf16p kp = kcl + koff + (kb >> 1) * 2048 + (kb & 1) * 128;
                const bf16x8v a0 = LDS_FRAG(kp), a1 = LDS_FRAG(kp + 256);
                f32x4v acc = {0.f, 0.f, 0.f, 0.f};
                acc = __builtin_amdgcn_mfma_f32_16x16x32_bf16(a0, qf0, acc, 0, 0, 0);
                acc = __builtin_amdgcn_mfma_f32_16x16x32_bf16(a1, qf1, acc, 0, 0, 0);
#pragma unroll
                for (int rr = 0; rr < 4; ++rr) { acc[rr] *= 0.125f; m1 = fmaxf(m1, acc[rr]); }
                st[kb] = acc;
            }
            m1 = fmaxf(m1, __shfl_xor(m1, 16)); m1 = fmaxf(m1, __shfl_xor(m1, 32));
#pragma unroll
            for (int kb = 0; kb < 16; ++kb)
#pragma unroll
                for (int rr = 0; rr < 4; ++rr) { const float e = __expf(st[kb][rr] - m1); st[kb][rr] = e; l1 += e; }
            l1 += __shfl_xor(l1, 16); l1 += __shfl_xor(l1, 32);
#pragma unroll
            for (int kp = 0; kp < 8; ++kp) {
                const bf16x8v pb = pack_p(st[2 * kp], st[2 * kp + 1]);
#pragma unroll
                for (int d = 0; d < 4; ++d) o1[d] = __builtin_amdgcn_mfma_f32_16x16x32_bf16(LDS_FRAG(vcl + g * 512 + ql * 8 + kp * 2048 + d * 128), pb, o1[d], 0, 0, 0);
            }
        }
        {
            f32x4v st[16];
#pragma unroll
            for (int kb = 0; kb < 16; ++kb) {
                const lds_bf16p kp = kll + koff + ((((rs + (kb >> 1) - rs_min) * 64 + cs) >> 3) * 512) + (kb & 1) * 128;
                const bf16x8v a0 = LDS_FRAG(kp), a1 = LDS_FRAG(kp + 256);
                f32x4v acc = {0.f, 0.f, 0.f, 0.f};
                acc = __builtin_amdgcn_mfma_f32_16x16x32_bf16(a0, qf0, acc, 0, 0, 0);
                acc = __builtin_amdgcn_mfma_f32_16x16x32_bf16(a1, qf1, acc, 0, 0, 0);
                const int dr = rs + (kb >> 1) - r + 7;
#pragma unroll
                for (int rr = 0; rr < 4; ++rr) {
                    const int kc = cs + 8 * g + 4 * (kb & 1) + rr, rel = kc - wsx;
                    const bool ok = rel >= 0 && rel < 16;
                    const int dc = min(max(kc - x + 15, 0), 30);
                    const float sv = ok ? acc[rr] * 0.125f + rp_h[dr * 31 + dc] : -1e30f;
                    acc[rr] = sv; m2 = fmaxf(m2, sv);
                }
                st[kb] = acc;
                if ((kb & 7) == 7) asm volatile("" ::: "memory");
            }
            m2 = fmaxf(m2, __shfl_xor(m2, 16)); m2 = fmaxf(m2, __shfl_xor(m2, 32));
#pragma unroll
            for (int kb = 0; kb < 16; ++kb)
#pragma unroll
                for (int rr = 0; rr < 4; ++rr) { const float e = __expf(st[kb][rr] - m2); st[kb][rr] = e; l2 += e; }
            l2 += __shfl_xor(l2, 16); l2 += __shfl_xor(l2, 32);
#pragma unroll
            for (int kp = 0; kp < 8; ++kp) {
                const bf16x8v pb = pack_p(st[2 * kp], st[2 * kp + 1]);
                const bf16_t* vp = vb + (size_t)(((rs + kp) * 64 + cs) >> 3) * 512;
#pragma unroll
                for (int d = 0; d < 4; ++d) o2[d] = __builtin_amdgcn_mfma_f32_16x16x32_bf16(*(const bf16x8v*)(vp + d * 128), pb, o2[d], 0, 0, 0);
                if ((kp & 3) == 3) asm volatile("" ::: "memory");
            }
        }
        const float mm = fmaxf(m1, m2), c1 = __expf(m1 - mm), c2 = __expf(m2 - mm);
        const float inv = 1.0f / (c1 * l1 + c2 * l2);
        const float w1 = c1 * inv, w2 = c2 * inv;
        f32x4v o[4];
#pragma unroll
        for (int d = 0; d < 4; ++d) o[d] = o1[d] * w1 + o2[d] * w2;
        bf16_t* op = na + (size_t)(b * SL + r * 64 + x) * DNA + h * 64 + 4 * g;
#pragma unroll
        for (int d = 0; d < 4; ++d) { uint2 w; w.x = pk_bf16(o[d][0], o[d][1]); w.y = pk_bf16(o[d][2], o[d][3]); nt_store2u(op + 16 * d, w); }
        }
      }
    }
}

__device__ __forceinline__ void phase_f(const Params& p, float* ldsf) {
    const int tid = opaque_tid();
    const bf16_t* hyT = (const bf16_t*)((const char*)p.ws + B_HYT); const bf16_t* na = (const bf16_t*)((const char*)p.ws + B_NA);
    bf16_t* ob = (bf16_t*)((char*)p.ws + B_UB);
    const float* ghy = p.in[I_GHY]; const float* gna = p.in[I_GNA];
    bf16_t* tile = (bf16_t*)ldsf;
    for (int item0 = blockIdx.x; item0 < NT / 32; item0 += gridDim.x) {
        const int item = gridDim.x == 256 ? 32 * (item0 & 7) + (item0 >> 3) : item0;
        const int t0 = item * 32;
        __syncthreads();
        uint4 hvv[8];
#pragma unroll
        for (int q = 0; q < 8; ++q) { const int e = q * NTHREADS + tid; hvv[q] = nt_load4u(hyT + (size_t)(e >> 2) * NT + t0 + (e & 3) * 8); }
#pragma unroll
        for (int q = 0; q < 8; ++q) {
            const int e = q * NTHREADS + tid, ch = e >> 2, part = e & 3;
            const unsigned wd[4] = {hvv[q].x, hvv[q].y, hvv[q].z, hvv[q].w};
#pragma unroll
            for (int i = 0; i < 4; ++i) { tile[(part * 8 + 2 * i) * 1032 + ch] = (bf16_t)(wd[i] & 0xffffu); tile[(part * 8 + 2 * i + 1) * 1032 + ch] = (bf16_t)(wd[i] >> 16); }
        }
        __syncthreads();
        const int tk = tid >> 4, sub = tid & 15;
        float hv[64]; float sh = 0.f, sn = 0.f;
#pragma unroll
        for (int i = 0; i < 8; ++i) {
            const uint4 v = *(const uint4*)(tile + tk * 1032 + (i * 16 + sub) * 8);
            const unsigned wd[4] = {v.x, v.y, v.z, v.w};
#pragma unroll
            for (int k = 0; k < 4; ++k) { const float a = __uint_as_float(wd[k] << 16), c = __uint_as_float(wd[k] & 0xffff0000u); hv[i * 8 + 2 * k] = a; hv[i * 8 + 2 * k + 1] = c; sh += a * a + c * c; }
        }
        const bf16_t* nrow = na + (size_t)(t0 + tk) * DNA;
        uint4 nv[8];
#pragma unroll
        for (int i = 0; i < 8; ++i) { nv[i] = nt_load4u(nrow + (i * 16 + sub) * 8);
            const unsigned wd[4] = {nv[i].x, nv[i].y, nv[i].z, nv[i].w};
#pragma unroll
            for (int k = 0; k < 4; ++k) { const float a = __uint_as_float(wd[k] << 16), c = __uint_as_float(wd[k] & 0xffff0000u); sn += a * a + c * c; } }
        sh += __shfl_xor(sh, 1); sh += __shfl_xor(sh, 2); sh += __shfl_xor(sh, 4); sh += __shfl_xor(sh, 8);
        sn += __shfl_xor(sn, 1); sn += __shfl_xor(sn, 2); sn += __shfl_xor(sn, 4); sn += __shfl_xor(sn, 8);
        const float rh = rsqrtf(sh * (1.0f / 1024.0f) + LN_EPS), rn = rsqrtf(sn * (1.0f / 1024.0f) + LN_EPS);
        bf16_t* orow = ob + (size_t)(t0 + tk) * D;
#pragma unroll
        for (int i = 0; i < 8; ++i) {
            const float4 g0 = *(const float4*)(ghy + (i * 16 + sub) * 8), g1 = *(const float4*)(ghy + (i * 16 + sub) * 8 + 4);
            uint4 w; w.x = pk_bf16(hv[i * 8] * rh * g0.x, hv[i * 8 + 1] * rh * g0.y); w.y = pk_bf16(hv[i * 8 + 2] * rh * g0.z, hv[i * 8 + 3] * rh * g0.w);
            w.z = pk_bf16(hv[i * 8 + 4] * rh * g1.x, hv[i * 8 + 5] * rh * g1.y); w.w = pk_bf16(hv[i * 8 + 6] * rh * g1.z, hv[i * 8 + 7] * rh * g1.w);
            *(uint4*)(orow + (i * 16 + sub) * 8) = w;
        }
#pragma unroll
        for (int i = 0; i < 8; ++i) {
            const float4 g0 = *(const float4*)(gna + (i * 16 + sub) * 8), g1 = *(const float4*)(gna + (i * 16 + sub) * 8 + 4);
            const unsigned wd[4] = {nv[i].x, nv[i].y, nv[i].z, nv[i].w};
            float a[8];
#pragma unroll
            for (int k = 0; k < 4; ++k) { a[2 * k] = __uint_as_float(wd[k] << 16); a[2 * k + 1] = __uint_as_float(wd[k] & 0xffff0000u); }
            uint4 w; w.x = pk_bf16(a[0] * rn * g0.x, a[1] * rn * g0.y); w.y = pk_bf16(a[2] * rn * g0.z, a[3] * rn * g0.w);
            w.z = pk_bf16(a[4] * rn * g1.x, a[5] * rn * g1.y); w.w = pk_bf16(a[6] * rn * g1.z, a[7] * rn * g1.w);
            *(uint4*)(orow + DHY + (i * 16 + sub) * 8) = w;
        }
    }
}

__device__ __forceinline__ void phase_h(const Params& p) {
    const int tid = opaque_tid(), lane = tid & 63, wv = tid >> 6;
    const float* x = p.in[I_X]; const bf16_t* y = (const bf16_t*)((const char*)p.ws + B_Y); const float* ada = p.ws + W_ADA;
    const float* g = p.in[I_LN1G]; const float* be = p.in[I_LN1B];
    bf16_t* x1 = (bf16_t*)((char*)p.ws + B_X1); bf16_t* u2b = (bf16_t*)((char*)p.ws + B_UB); unsigned* u2q = (unsigned*)((char*)p.ws + B_U2Q); float* su2 = p.ws + W_SU2;
#pragma unroll 1
    for (int tpl = blockIdx.x * NWAVES + wv, it = 0; tpl < NT / 2; tpl += gridDim.x * NWAVES, ++it) {
        const int tp = gridDim.x == 256 ? 512 * ((int)blockIdx.x & 7) + ((int)blockIdx.x >> 3) * 16 + wv * 2 + it : tpl;
        const int b = (2 * tp) / SL;
        float v[2][32]; float s[2] = {0.f, 0.f};
#pragma unroll
        for (int u = 0; u < 2; ++u)
#pragma unroll
            for (int j = 0; j < 8; ++j) {
                const int col = j * 256 + lane * 4; const size_t t = (size_t)(2 * tp + u);
                const float4 xv = nt_load4(x + t * D + col); const uint2 yb = nt_load2u(y + t * D + col);
                const float4 yv = make_float4(__uint_as_float(yb.x << 16), __uint_as_float(yb.x & 0xffff0000u), __uint_as_float(yb.y << 16), __uint_as_float(yb.y & 0xffff0000u));
                const float4 gt = *(const float4*)(ada + b * 12288 + 2 * 2048 + col);
                v[u][j * 4] = ALPHA * xv.x + gt.x * yv.x; v[u][j * 4 + 1] = ALPHA * xv.y + gt.y * yv.y; v[u][j * 4 + 2] = ALPHA * xv.z + gt.z * yv.z; v[u][j * 4 + 3] = ALPHA * xv.w + gt.w * yv.w;
                s[u] += (v[u][j * 4] + v[u][j * 4 + 1]) + (v[u][j * 4 + 2] + v[u][j * 4 + 3]);
            }
        float rstd[2];
#pragma unroll
        for (int u = 0; u < 2; ++u) {
            const float mean = wave_sum(s[u]) * (1.0f / 2048.0f);
            float q2 = 0.f;
#pragma unroll
            for (int i = 0; i < 32; ++i) { v[u][i] -= mean; q2 += v[u][i] * v[u][i]; }
            rstd[u] = rsqrtf(wave_sum(q2) * (1.0f / 2048.0f) + LN_EPS);
        }
        asm volatile("" ::: "memory");
        float umx[2] = {0.f, 0.f};
#pragma unroll
        for (int j = 0; j < 8; ++j) {
            const int col = j * 256 + lane * 4;
            const float4 gv = *(const float4*)(g + col), bv = *(const float4*)(be + col);
            const float4 sh = *(const float4*)(ada + b * 12288 + 3 * 2048 + col), sc = *(const float4*)(ada + b * 12288 + 4 * 2048 + col);
#pragma unroll
            for (int u = 0; u < 2; ++u) {
                const size_t t = (size_t)(2 * tp + u);
                const float4 o = make_float4(v[u][j * 4] * rstd[u] * gv.x + bv.x, v[u][j * 4 + 1] * rstd[u] * gv.y + bv.y, v[u][j * 4 + 2] * rstd[u] * gv.z + bv.z, v[u][j * 4 + 3] * rstd[u] * gv.w + bv.w);
                { uint2 xb; xb.x = pk_bf16(o.x, o.y); xb.y = pk_bf16(o.z, o.w); nt_store2u(x1 + t * D + col, xb); }
                const float4 uv = make_float4(o.x * (1.f + sc.x) + sh.x, o.y * (1.f + sc.y) + sh.y, o.z * (1.f + sc.z) + sh.z, o.w * (1.f + sc.w) + sh.w);
                v[u][j * 4] = uv.x; v[u][j * 4 + 1] = uv.y; v[u][j * 4 + 2] = uv.z; v[u][j * 4 + 3] = uv.w;
                uint2 ub2; ub2.x = pk_bf16(uv.x, uv.y); ub2.y = pk_bf16(uv.z, uv.w);
                *(uint2*)(u2b + t * D + col) = ub2;
                umx[u] = fmaxf(umx[u], fmaxf(fmaxf(fabsf(uv.x), fabsf(uv.y)), fmaxf(fabsf(uv.z), fabsf(uv.w))));
            }
        }
#pragma unroll
        for (int u = 0; u < 2; ++u) {
            const size_t t = (size_t)(2 * tp + u);
            const float um = wave_max(umx[u]);
            const float inv = um > 0.f ? 127.0f / um : 0.f;
            uint4 qa, qb;
            qa.x = q4(v[u][0], v[u][1], v[u][2], v[u][3], inv, 0); qa.y = q4(v[u][4], v[u][5], v[u][6], v[u][7], inv, 0); qa.z = q4(v[u][8], v[u][9], v[u][10], v[u][11], inv, 0); qa.w = q4(v[u][12], v[u][13], v[u][14], v[u][15], inv, 0);
            qb.x = q4(v[u][16], v[u][17], v[u][18], v[u][19], inv, 0); qb.y = q4(v[u][20], v[u][21], v[u][22], v[u][23], inv, 0); qb.z = q4(v[u][24], v[u][25], v[u][26], v[u][27], inv, 0); qb.w = q4(v[u][28], v[u][29], v[u][30], v[u][31], inv, 0);
            nt_store4u(u2q + t * 512 + lane * 8, qa); nt_store4u(u2q + t * 512 + lane * 8 + 4, qb);
            if (lane == 0) su2[t] = um * (1.0f / 127.0f);
        }
    }
}

template <int N> __device__ __forceinline__ void bitonic_desc(float (&v)[N]) {
#pragma unroll
    for (int k = 2; k <= N; k <<= 1)
#pragma unroll
        for (int j = k >> 1; j > 0; j >>= 1)
#pragma unroll
            for (int i = 0; i < N; ++i) { const int l = i ^ j; if (l > i) { const float x = v[i], y = v[l]; const float mx = fmaxf(x, y), mn = fminf(x, y); if ((i & k) == 0) { v[i] = mx; v[l] = mn; } else { v[i] = mn; v[l] = mx; } } }
}
__device__ __forceinline__ void bitonic_merge16_desc(float (&v)[16]) {
#pragma unroll
    for (int j = 8; j > 0; j >>= 1)
#pragma unroll
        for (int i = 0; i < 16; ++i) { const int l = i ^ j; if (l > i) { const float x = v[i], y = v[l]; v[i] = fmaxf(x, y); v[l] = fminf(x, y); } }
}
__device__ __forceinline__ void top16_of_128(float (&sc)[32], float (&top)[16]) {
    float lo[16], hi[16];
#pragma unroll
    for (int i = 0; i < 16; ++i) { lo[i] = sc[i]; hi[i] = sc[16 + i]; }
    bitonic_desc<16>(lo); bitonic_desc<16>(hi);
#pragma unroll
    for (int i = 0; i < 16; ++i) top[i] = fmaxf(lo[i], hi[15 - i]);
    bitonic_merge16_desc(top);
#pragma unroll
    for (int off = 16; off <= 32; off <<= 1) {
        float o[16];
#pragma unroll
        for (int i = 0; i < 16; ++i) o[i] = __shfl_xor(top[15 - i], off);
#pragma unroll
        for (int i = 0; i < 16; ++i) top[i] = fmaxf(top[i], o[i]);
        bitonic_merge16_desc(top);
    }
}
__device__ __forceinline__ void ce_carry(float& va, int& xa, float& vb, int& xb, bool desc) {
    const bool sw = desc ? (vb > va) : (vb < va);
    const float tv = sw ? vb : va, uv = sw ? va : vb; const int tx = sw ? xb : xa, ux = sw ? xa : xb;
    va = tv; vb = uv; xa = tx; xb = ux;
}
__device__ __forceinline__ void bitonic_merge16_desc_carry(float (&v)[16], int (&x)[16]) {
#pragma unroll
    for (int j = 8; j > 0; j >>= 1)
#pragma unroll
        for (int i = 0; i < 16; ++i) { const int l = i ^ j; if (l > i) ce_carry(v[i], x[i], v[l], x[l], true); }
}
constexpr int CAND_I[52] = {0,0,0,0,0,0,0,0,0,0,0,0,0,0,0,0,1,1,1,1,1,1,1,1,2,2,2,2,2,3,3,3,3,4,4,4,5,5,6,6,7,7,8,9,10,11,12,13,14,15,-1,-1};
constexpr int CAND_J[52] = {0,1,2,3,4,5,6,7,8,9,10,11,12,13,14,15,0,1,2,3,4,5,6,7,0,1,2,3,4,0,1,2,3,0,1,2,0,1,0,1,0,1,0,0,0,0,0,0,0,0,-1,-1};

__device__ __forceinline__ int rl_i(int v, int l) { return __builtin_amdgcn_readlane(v, l); }
__device__ __forceinline__ float rl_f(float v, int l) { return __int_as_float(__builtin_amdgcn_readlane(__float_as_int(v), l)); }
#define LANE_OF(k) ((((k) >> 3) & 1) * 32 + (((k) >> 2) & 1) * 16 + (((k) >> 1) & 1) * 8 + ((k) & 1) * 4)
constexpr size_t B_KEYSB = 15 * MiB;
constexpr size_t B_QB = B_Y;

typedef float f32x2v __attribute__((ext_vector_type(2)));
#define PKFMA_LO(fv, xv, wsv) do { f32x2v _t; asm("v_cvt_pk_f32_fp8 %1, %2\n\tv_pk_fma_f32 %0, %3, %1, %0" : "+v"(fv), "=&v"(_t) : "v"(xv), "v"(wsv)); } while (0)
#define PKFMA_HI(fv, xv, wsv) do { f32x2v _t; asm("v_cvt_pk_f32_fp8_sdwa %1, %2 src0_sel:WORD_1\n\tv_pk_fma_f32 %0, %3, %1, %0" : "+v"(fv), "=&v"(_t) : "v"(xv), "v"(wsv)); } while (0)
#define PKFMA_F4(fv, xv, wsv, OPSEL) do { f32x2v _t; asm("v_cvt_scalef32_pk_f32_fp4 %1, %2, 1.0 " OPSEL "\n\tv_pk_fma_f32 %0, %3, %1, %0" : "+v"(fv), "=&v"(_t) : "v"(xv), "v"(wsv)); } while (0)
#define FACC(i) (f2[(i) >> 1][(i) & 1])
__device__ __forceinline__ void gather_token(const Params& p, int t, const int* sel_idx, const float* sel_g, int lane) {
    const bf16_t* x1 = (const bf16_t*)((const char*)p.ws + B_X1); const float* ada = p.ws + W_ADA;
    const char* uq = (const char*)p.ws + B_TQ; const char* vq = uq + (size_t)16384 * UROW; const char* u2q = (const char*)p.ws + B_U2Q;
    const __amdgpu_buffer_rsrc_t ursrc = __builtin_amdgcn_make_buffer_rsrc((void*)uq, 0, 16384 * UROW, 0x00020000);
    const __amdgpu_buffer_rsrc_t vrsrc = __builtin_amdgcn_make_buffer_rsrc((void*)vq, 0, 16384 * UROW, 0x00020000);
    const float* su2 = p.ws + W_SU2; const float* rsu = p.ws + W_SU; const float* rsv = p.ws + W_SV;
    const float* g2 = p.in[I_LN2G]; const float* b2 = p.in[I_LN2B];
    const int b = t / SL;
    unsigned uh[4], ul[4]; int us0;
    {
        const uint4 ua_ = nt_load4u(u2q + (size_t)t * D + lane * 32), ub_ = nt_load4u(u2q + (size_t)t * D + lane * 32 + 16);
        const unsigned xw[8] = {ua_.x, ua_.y, ua_.z, ua_.w, ub_.x, ub_.y, ub_.z, ub_.w};
        us0 = 0;
#pragma unroll
        for (int i = 0; i < 8; ++i) us0 = __builtin_amdgcn_sdot4((int)xw[i], 0x01010101, us0, false);
#pragma unroll
        for (int q = 0; q < 4; ++q) {
            const unsigned a = xw[2 * q] ^ 0x80808080u, bq = xw[2 * q + 1] ^ 0x80808080u;
            const unsigned la = a & 0x0F0F0F0Fu, lb = bq & 0x0F0F0F0Fu, ha = (a >> 4) & 0x0F0F0F0Fu, hb = (bq >> 4) & 0x0F0F0F0Fu;
            ul[q] = __builtin_amdgcn_perm(lb | (lb >> 4), la | (la >> 4), 0x06040200u);
            uh[q] = __builtin_amdgcn_perm(hb | (hb >> 4), ha | (ha >> 4), 0x06040200u);
        }
    }
    const float s2 = su2[t];
    const float uoff = 7.5f * wave_sum((float)us0);
    const float* scu = p.ws + W_SC;
    f32x2v f2[16];
#pragma unroll
    for (int i = 0; i < 16; ++i) f2[i] = (f32x2v){0.f, 0.f};
    const int kk8 = ((lane >> 5) & 1) * 4 + ((lane >> 4) & 1) * 2 + ((lane >> 3) & 1);
#define LANE_OF8(k) ((((k) >> 2) & 1) * 32 + (((k) >> 1) & 1) * 16 + ((k) & 1) * 8)
    int e_cur = sel_idx[kk8]; float g_cur = sel_g[kk8];
    uint4 un[8];
#pragma unroll
    for (int k = 0; k < 8; ++k) { const int ro = rl_i(e_cur, LANE_OF8(k)) * UROW; un[k] = __builtin_bit_cast(uint4, __builtin_amdgcn_raw_buffer_load_b128(ursrc, lane * 16, ro, 0)); }
#pragma unroll 1
    for (int bt = 0; bt < 16; ++bt) {
        uint4 vn[8];
#pragma unroll
        for (int k = 0; k < 8; ++k) { const int ro = rl_i(e_cur, LANE_OF8(k)) * UROW; vn[k] = __builtin_bit_cast(uint4, __builtin_amdgcn_raw_buffer_load_b128(vrsrc, lane * 16, ro, 0)); }
        __builtin_amdgcn_sched_barrier(0);
        float part[8];
#pragma unroll
        for (int k = 0; k < 8; ++k) {
            const uint4 nq = un[k];
            unsigned dh = __builtin_amdgcn_udot8(uh[0], nq.x, 0u, false), dl = __builtin_amdgcn_udot8(ul[0], nq.x, 0u, false);
            dh = __builtin_amdgcn_udot8(uh[1], nq.y, dh, false); dl = __builtin_amdgcn_udot8(ul[1], nq.y, dl, false);
            dh = __builtin_amdgcn_udot8(uh[2], nq.z, dh, false); dl = __builtin_amdgcn_udot8(ul[2], nq.z, dl, false);
            dh = __builtin_amdgcn_udot8(uh[3], nq.w, dh, false); dl = __builtin_amdgcn_udot8(ul[3], nq.w, dl, false);
            const unsigned d0 = dh * 16u + dl;
            part[k] = (float)d0;
            __builtin_amdgcn_sched_barrier(0);
        }
        const int bn = (bt + 1) & 15;
        const int e_nxt = sel_idx[bn * 8 + kk8]; const float g_nxt = sel_g[bn * 8 + kk8];
#pragma unroll
        for (int k = 0; k < 8; ++k) { const int ro = rl_i(e_nxt, LANE_OF8(k)) * UROW; un[k] = __builtin_bit_cast(uint4, __builtin_amdgcn_raw_buffer_load_b128(ursrc, lane * 16, ro, 0)); }
        __builtin_amdgcn_sched_barrier(0);
        { const bool up = (lane & 32) != 0;
#pragma unroll
          for (int i = 0; i < 4; ++i) { const float keep = up ? part[i + 4] : part[i], send = up ? part[i] : part[i + 4]; part[i] = keep + __shfl_xor(send, 32); } }
        { const bool up = (lane & 16) != 0;
#pragma unroll
          for (int i = 0; i < 2; ++i) { const float keep = up ? part[i + 2] : part[i], send = up ? part[i] : part[i + 2]; part[i] = keep + __shfl_xor(send, 16); } }
        { const bool up = (lane & 8) != 0;
          const float keep = up ? part[1] : part[0], send = up ? part[0] : part[1]; part[0] = keep + __shfl_xor(send, 8); }
        float tot = part[0]; tot += __shfl_xor(tot, 1); tot += __shfl_xor(tot, 2); tot += __shfl_xor(tot, 4);
        const float dt = (tot - 128.0f * scu[e_cur] - uoff) * s2 * rsu[e_cur];
        const float act = 0.5f * dt * (1.0f + erff(dt * 0.7071067811865476f));
        const float w_l = g_cur * act * rsv[e_cur];
#pragma unroll
        for (int k = 0; k < 8; ++k) {
            const float w = rl_f(w_l, LANE_OF8(k));
            const f32x2v wp0 = {w, w};
            const unsigned wd[4] = {vn[k].x, vn[k].y, vn[k].z, vn[k].w};
#pragma unroll
            for (int q = 0; q < 4; ++q) {
                PKFMA_F4(f2[q * 4 + 0], wd[q], wp0, ""); PKFMA_F4(f2[q * 4 + 1], wd[q], wp0, "op_sel:[1,0,0]"); PKFMA_F4(f2[q * 4 + 2], wd[q], wp0, "op_sel:[0,1,0]"); PKFMA_F4(f2[q * 4 + 3], wd[q], wp0, "op_sel:[1,1,0]");
            }
        }
        e_cur = e_nxt; g_cur = g_nxt;
    }
#undef LANE_OF8
    asm volatile("" ::: "memory");
    float v[32]; float s = 0.f;
#pragma unroll
    for (int q = 0; q < 8; ++q) {
        const int col = q * 256 + lane * 4, o = q * 4;
        const uint2 xb = nt_load2u(x1 + (size_t)t * D + col); const float4 gt = *(const float4*)(ada + b * 12288 + 5 * 2048 + col);
        const float4 xv = make_float4(__uint_as_float(xb.x << 16), __uint_as_float(xb.x & 0xffff0000u), __uint_as_float(xb.y << 16), __uint_as_float(xb.y & 0xffff0000u));
        v[o] = ALPHA * xv.x + gt.x * FACC(o); v[o + 1] = ALPHA * xv.y + gt.y * FACC(o + 1);
        v[o + 2] = ALPHA * xv.z + gt.z * FACC(o + 2); v[o + 3] = ALPHA * xv.w + gt.w * FACC(o + 3);
        s += (v[o] + v[o + 1]) + (v[o + 2] + v[o + 3]);
    }
    const float mean = wave_sum(s) * (1.0f / 2048.0f);
    float q2 = 0.f;
#pragma unroll
    for (int i = 0; i < 32; ++i) { v[i] -= mean; q2 += v[i] * v[i]; }
    const float rstd = rsqrtf(wave_sum(q2) * (1.0f / 2048.0f) + LN_EPS);
    asm volatile("" ::: "memory");
#pragma unroll
    for (int q = 0; q < 8; ++q) {
        const int col = q * 256 + lane * 4, o = q * 4;
        const float4 gv = *(const float4*)(g2 + col), bv = *(const float4*)(b2 + col);
        nt_store4(p.out + (size_t)t * D + col, v[o] * rstd * gv.x + bv.x, v[o + 1] * rstd * gv.y + bv.y, v[o + 2] * rstd * gv.z + bv.z, v[o + 3] * rstd * gv.w + bv.w);
    }
}

__device__ __forceinline__ void phase_jk(const Params& p, unsigned char* smem) {
    const int tid0 = opaque_tid();
    const bf16_t* qb = (const bf16_t*)((const char*)p.ws + B_QB); const bf16_t* keysb = (const bf16_t*)((const char*)p.ws + B_KEYSB);
    int* sel_idx = (int*)smem; float* sel_g = (float*)(smem + 8192);
#pragma unroll 1
    for (int iteml = blockIdx.x, itn = 0; iteml < NT / 16; iteml += gridDim.x, ++itn) {
        const int item = gridDim.x == 256 ? 64 * ((int)blockIdx.x & 7) + ((int)blockIdx.x >> 3) + 32 * itn : iteml;
        int tid = tid0; asm volatile("" : "+v"(tid));
        const int lane = tid & 63, wv = tid >> 6, ql = lane & 15, g = lane >> 4;
        const int t0 = item * 16, h = wv;
        __syncthreads();
        float ta[16], tb[16];
#pragma unroll
        for (int i = 0; i < 16; ++i) { ta[i] = 0.f; tb[i] = 0.f; }
#pragma unroll 1
        for (int pp = 0; pp < 2; ++pp) {
            const bf16_t* qrow = qb + ((size_t)((((t0 >> 4) * 8 + h) * 2 + pp) * 4) * 64 + lane) * 8;
            bf16x8v qf[4];
#pragma unroll
            for (int kc = 0; kc < 4; ++kc) qf[kc] = __builtin_nontemporal_load((const bf16x8v*)(qrow + kc * 512));
            const bf16_t* kbase = keysb + (size_t)((h * 2 + pp) * 8) * 2048 + lane * 8;
            float sc[32];
#pragma unroll
            for (int nb = 0; nb < 8; ++nb) {
                f32x4v acc = {0.f, 0.f, 0.f, 0.f};
#pragma unroll
                for (int kc = 0; kc < 4; ++kc) acc = __builtin_amdgcn_mfma_f32_16x16x32_bf16(*(const bf16x8v*)(kbase + (nb * 4 + kc) * 512), qf[kc], acc, 0, 0, 0);
#pragma unroll
                for (int rr = 0; rr < 4; ++rr) sc[nb * 4 + rr] = __int_as_float((__float_as_int(acc[rr]) & ~127) | (16 * nb + 4 * g + rr));
                if (nb == 3) asm volatile("" ::: "memory");
            }
            float top[16];
            top16_of_128(sc, top);
#pragma unroll
            for (int i = 0; i < 16; ++i) { if (pp == 0) ta[i] = top[i]; else tb[i] = top[i]; }
        }
        float cv[16]; int cx[16];
#pragma unroll
        for (int sidx = 0; sidx < 13; ++sidx) {
            float vv[4]; int xx[4];
#pragma unroll
            for (int q = 0; q < 4; ++q) {
                const int ci = CAND_I[4 * sidx + q], cj = CAND_J[4 * sidx + q];
                if (ci >= 0) { vv[q] = ta[ci] + tb[cj]; xx[q] = ((__float_as_int(ta[ci]) & 127) << 7) | (__float_as_int(tb[cj]) & 127); } else { vv[q] = -3.0e38f; xx[q] = 0; }
            }
            cv[sidx] = g == 0 ? vv[0] : (g == 1 ? vv[1] : (g == 2 ? vv[2] : vv[3]));
            cx[sidx] = g == 0 ? xx[0] : (g == 1 ? xx[1] : (g == 2 ? xx[2] : xx[3]));
        }
#pragma unroll
        for (int sidx = 13; sidx < 16; ++sidx) { cv[sidx] = -3.0e38f; cx[sidx] = 0; }
#pragma unroll
        for (int k = 2; k <= 16; k <<= 1)
#pragma unroll
            for (int j = k >> 1; j > 0; j >>= 1)
#pragma unroll
                for (int i = 0; i < 16; ++i) { const int l = i ^ j; if (l > i) ce_carry(cv[i], cx[i], cv[l], cx[l], (i & k) == 0); }
#pragma unroll
        for (int off = 16; off <= 32; off <<= 1) {
            float ov[16]; int ox[16];
#pragma unroll
            for (int i = 0; i < 16; ++i) { ov[i] = __shfl_xor(cv[15 - i], off); ox[i] = __shfl_xor(cx[15 - i], off); }
#pragma unroll
            for (int i = 0; i < 16; ++i) { const bool tk = ov[i] > cv[i]; cv[i] = tk ? ov[i] : cv[i]; cx[i] = tk ? ox[i] : cx[i]; }
            bitonic_merge16_desc_carry(cv, cx);
        }
        {
            float ex[16]; float sum = 0.f;
#pragma unroll
            for (int i = 0; i < 16; ++i) { ex[i] = __expf(cv[i] - cv[0]); sum += ex[i]; }
            const float inv = 1.0f / sum;
            if (g == 0) {
#pragma unroll
                for (int q = 0; q < 4; ++q) {
                    *(int4*)(sel_idx + ql * 128 + h * 16 + q * 4) = make_int4(cx[q * 4], cx[q * 4 + 1], cx[q * 4 + 2], cx[q * 4 + 3]);
                    *(float4*)(sel_g + ql * 128 + h * 16 + q * 4) = make_float4(ex[q * 4] * inv, ex[q * 4 + 1] * inv, ex[q * 4 + 2] * inv, ex[q * 4 + 3] * inv);
                }
            }
        }
        __syncthreads();
#pragma unroll 1
        for (int k = 0; k < 2; ++k) { int lane2 = lane; asm volatile("" : "+v"(lane2)); gather_token(p, t0 + 2 * wv + k, sel_idx + (2 * wv + k) * 128, sel_g + (2 * wv + k) * 128, lane2); }
    }
}

__device__ __forceinline__ void map_tile(int L, int nM, int nN, int& pm, int& pn) {
    const int nwg = nM * nN; int wgid = L;
    { const int q = nwg / 8, r = nwg % 8, xcd = wgid % 8, off = wgid / 8; wgid = (xcd < r ? xcd * (q + 1) : r * (q + 1) + (xcd - r) * q) + off; }
    const int nig = 8 * nN, gid = wgid / nig, fm = gid * 8, gsz = (nM - fm) < 8 ? (nM - fm) : 8;
    pm = fm + ((wgid % nig) % gsz); pn = (wgid % nig) / gsz;
}
struct ProjOrder {
    int G, c; const bf16_t* ub; const bf16_t* wint;
    __device__ bool next(int i, pg8::Unit& u) const {
        const int L = i * G + c; if (L >= 800) return false;
        if (L < 384) { u.kind = 0; map_tile(L, 12, 32, u.pm, u.pn); }
        else if (L < 512) { u.kind = 1; map_tile(L - 384, 4, 32, u.pm, u.pn); }
        else if (L < 768) { u.kind = 2; map_tile(L - 512, 32, 8, u.pm, u.pn); }
        else if (L < 784) { u.kind = 3; u.pm = (L - 768) >> 2; u.pn = (L - 768) & 3; }
        else { u.kind = 4; u.pm = (L - 784) >> 2; u.pn = (L - 784) & 3; }
        return true;
    }
    __device__ __forceinline__ void a_ready(const pg8::Unit&) const {}
    __device__ __forceinline__ void done(const pg8::Unit&) const {}
    template <class G_> __device__ __forceinline__ const char* pa(const G_&, const pg8::Unit& u) const {
        const size_t ts = (size_t)256 * D * 2;
        switch (u.kind) { case 0: return (const char*)wint + (size_t)u.pm * ts; case 1: return (const char*)wint + (size_t)(20 + u.pm) * ts; case 2: return (const char*)ub + (size_t)u.pm * ts;
                          case 3: return (const char*)ub + (size_t)(32 + u.pm) * ts; default: return (const char*)wint + (size_t)(20 + u.pm) * ts; }
    }
    template <class G_> __device__ __forceinline__ const char* pb(const G_&, const pg8::Unit& u) const {
        const size_t ts = (size_t)256 * D * 2;
        switch (u.kind) { case 0: case 1: return (const char*)ub + (size_t)u.pn * ts; case 2: return (const char*)wint + (size_t)(12 + u.pn) * ts;
                          case 3: return (const char*)wint + (size_t)(16 + u.pn) * ts; default: return (const char*)ub + (size_t)(32 + u.pn) * ts; }
    }
};
struct EpiProj {
    static constexpr bool PERM = true, AFTER_DRAIN = false;
    unsigned char* ws;
    __device__ __forceinline__ void operator()(const pg8::f32x4 (&acc)[2][2][4][2], const pg8::Unit& u, int wr, int wc, int fr, int fq) const {
        bf16_t* const zT = (bf16_t*)(ws + B_ZT); bf16_t* const vT = (bf16_t*)(ws + B_VT); bf16_t* const qh = (bf16_t*)(ws + B_QH); bf16_t* const kh = (bf16_t*)(ws + B_KH);
        bf16_t* const kch = (bf16_t*)(ws + B_KCH); bf16_t* const vcT = (bf16_t*)(ws + B_VCT);
#pragma unroll
        for (int ai = 0; ai < 2; ++ai)
#pragma unroll
            for (int m = 0; m < 4; ++m) {
                const int r = u.pm * 256 + ai * 128 + wr * 64 + m * 16 + fr;
#pragma unroll
                for (int bj = 0; bj < 2; ++bj) {
                    const int cc = u.pn * 256 + bj * 128 + wc * 32 + 8 * fq;
                    bf16_t* dst;
                    if (u.kind == 0) dst = zT + (size_t)r * NT + cc;
                    else if (u.kind == 1) {
                        const int bb = cc >> 11, t = cc & 2047, hh = r >> 6, dd = r & 63;
                        dst = vT + (size_t)((bb * 16 + hh) * 256 + (t >> 3)) * 512 + (dd >> 4) * 128 + (dd & 15) * 8;
                    } else if (u.kind == 2) {
                        const int bb = r >> 11, t = r & 2047, hc = cc & 1023, hh = hc >> 6, dd = hc & 63;
                        if (cc < 1024) dst = qh + ((size_t)((bb * 16 + hh) * SL + t)) * 64 + dd;
                        else dst = kh + (size_t)((bb * 16 + hh) * 256 + (t >> 3)) * 512 + (dd >> 5) * 256 + ((t & 7) >> 2) * 128 + ((dd & 31) >> 3) * 32 + (t & 3) * 8;
                    } else if (u.kind == 3) {
                        const int bb = r >> 8, jj = r & 255, hh = cc >> 6, dd = cc & 63;
                        dst = kch + (size_t)((bb * 16 + hh) * 32 + (jj >> 3)) * 512 + (dd >> 5) * 256 + ((jj & 7) >> 2) * 128 + ((dd & 31) >> 3) * 32 + (jj & 3) * 8;
                    } else {
                        const int bb = cc >> 8, jj = cc & 255, hh = r >> 6, dd = r & 63;
                        dst = vcT + (size_t)((bb * 16 + hh) * 32 + (jj >> 3)) * 512 + (dd >> 4) * 128 + (dd & 15) * 8;
                    }
                    const pg8::f32x4 v0 = acc[ai][bj][m][0], v1 = acc[ai][bj][m][1];
                    pg8::u32x4 w; w.x = pg8::cvt_pk_bf16(v0[0], v0[1]); w.y = pg8::cvt_pk_bf16(v0[2], v0[3]); w.z = pg8::cvt_pk_bf16(v1[0], v1[1]); w.w = pg8::cvt_pk_bf16(v1[2], v1[3]);
                    *(pg8::u32x4*)dst = w;
                }
            }
    }
};

struct EpiQFrag {
    static constexpr bool PERM = true, AFTER_DRAIN = false;
    bf16_t* O;
    __device__ __forceinline__ void operator()(const pg8::f32x4 (&acc)[2][2][4][2], const pg8::Unit& u, int wr, int wc, int fr, int fq) const {
#pragma unroll
        for (int ai = 0; ai < 2; ++ai)
#pragma unroll
            for (int m = 0; m < 4; ++m) {
                const int t = u.pm * 256 + ai * 128 + wr * 64 + m * 16 + fr;
#pragma unroll
                for (int bj = 0; bj < 2; ++bj) {
                    const int c = u.pn * 256 + bj * 128 + wc * 32 + 8 * fq;
                    const int hh = c >> 8, pp = (c >> 7) & 1, d = c & 127;
                    bf16_t* dst = O + ((size_t)(((((t >> 4) * 8 + hh) * 2 + pp) * 4 + (d >> 5)) * 64 + ((d & 31) >> 3) * 16 + (t & 15))) * 8;
                    const pg8::f32x4 v0 = acc[ai][bj][m][0], v1 = acc[ai][bj][m][1];
                    pg8::u32x4 w; w.x = pg8::cvt_pk_bf16(v0[0], v0[1]); w.y = pg8::cvt_pk_bf16(v0[2], v0[3]); w.z = pg8::cvt_pk_bf16(v1[0], v1[1]); w.w = pg8::cvt_pk_bf16(v1[2], v1[3]);
                    __builtin_nontemporal_store(w, (pg8::u32x4*)dst);
                }
            }
    }
};

#define XB_TMO      128
#define XB_XCNT(j)  (256  + 64 * (j))
#define XB_XSUB(j)  (1280 + 64 * (j))
#define XB_XGEN(j)  (2304 + 64 * (j))
#define XB_TOP      3328
#define XB_TOPGEN   3392
#define XCD_BAR_WORDS 3456
#define XB_SPIN_CAP (1u << 18)
#define LAS __attribute__((address_space(3)))

__device__ __forceinline__ unsigned xb_ld(unsigned* p)              { return __hip_atomic_load(p, __ATOMIC_RELAXED, __HIP_MEMORY_SCOPE_AGENT); }
__device__ __forceinline__ unsigned xb_add(unsigned* p, unsigned v) { return __hip_atomic_fetch_add(p, v, __ATOMIC_RELAXED, __HIP_MEMORY_SCOPE_AGENT); }
__device__ __forceinline__ unsigned xb_xcc_id() { return (unsigned)__builtin_amdgcn_s_getreg((3 << 11) | 20) & 0xFu; }
#define XB_SPIN(cond, bar) do { unsigned _sp = 0; while (cond) { __builtin_amdgcn_s_sleep(1); \
    if ((++_sp & 255u) == 0u) { if (xb_ld(&(bar)[XB_TMO])) break; if (_sp > XB_SPIN_CAP) { atomicAdd(&(bar)[XB_TMO], 1u); break; } } } } while (0)

struct XcdBarrier {
    unsigned* bar; unsigned x;
    volatile LAS unsigned* st;
};

__device__ __forceinline__ XcdBarrier xcd_barrier_post(unsigned* bar, volatile LAS unsigned* st) {
    XcdBarrier b; b.bar = bar; b.x = xb_xcc_id(); b.st = st;
    if (threadIdx.x == 0) (void)xb_add(&bar[XB_XCNT(b.x)], 1u);
    return b;
}
__device__ __forceinline__ void xcd_barrier_complete(unsigned* bar, unsigned x, unsigned& nloc, unsigned& nx) {
    const unsigned G = gridDim.x * gridDim.y * gridDim.z;
    unsigned sum, cnt, mine, sp = 0u;
    for (;;) {
        sum = 0u; cnt = 0u; mine = 0u;
#pragma unroll
        for (unsigned j = 0; j < 16; ++j) { const unsigned c = xb_ld(&bar[XB_XCNT(j)]); sum += c; cnt += (c > 0u) ? 1u : 0u; mine = (j == x) ? c : mine; }
        if (sum == G) break;
        __builtin_amdgcn_s_sleep(1);
        if ((++sp & 255u) == 0u) { if (xb_ld(&bar[XB_TMO])) break; if (sp > XB_SPIN_CAP) { atomicAdd(&bar[XB_TMO], 1u); break; } }
    }
    nloc = mine > 0u ? mine : 1u; nx = cnt > 0u ? cnt : 1u;
}

__device__ __forceinline__ void xcd_barrier_arrive(const XcdBarrier& b) {
    asm volatile("s_waitcnt vmcnt(0)" ::: "memory");
    __syncthreads();
    if (threadIdx.x == 0) {
        unsigned* bar = b.bar;
        __builtin_amdgcn_s_waitcnt(0);
        unsigned nloc = b.st[0], nx = b.st[1]; const unsigned k = b.st[2];
        if (nloc == 0u) { xcd_barrier_complete(bar, b.x, nloc, nx); b.st[0] = nloc; b.st[1] = nx; }
        b.st[2] = k + 1u;
        const unsigned old = xb_add(&bar[XB_XSUB(b.x)], 1u);
        if (old + 1u == (k + 1u) * nloc) {
            __builtin_amdgcn_fence(__ATOMIC_RELEASE, "agent");
            asm volatile("s_waitcnt vmcnt(0)" ::: "memory");
            (void)xb_add(&bar[XB_TOP], 1u);
        }
        asm volatile("buffer_inv sc1" ::: "memory");
    }
}
__device__ __forceinline__ void xcd_barrier_wait(const XcdBarrier& b) {
    if (threadIdx.x == 0) {
        unsigned* bar = b.bar;
        const unsigned nx = b.st[1], k1 = b.st[2];
        XB_SPIN(xb_ld(&bar[XB_TOP]) < k1 * nx, bar);
        asm volatile("s_waitcnt vmcnt(0)" ::: "memory");
    }
    __syncthreads();
}
__device__ __forceinline__ void xcd_barrier(const XcdBarrier& b) { xcd_barrier_arrive(b); xcd_barrier_wait(b); }
__device__ __forceinline__ void xcd_barrier_hosting(const XcdBarrier& b, const Params& p, int slice) {
    xcd_barrier_arrive(b);
    if (gridDim.x == 256) quant_tables<1>(p, 0, 256, 2048 * slice, 2048 * (slice + 1));
    xcd_barrier_wait(b);
}
constexpr size_t B_BAR = 14 * MiB;

__global__ void __launch_bounds__(NTHREADS) fwd_megakernel(Params p) {
    extern __shared__ __attribute__((aligned(16))) unsigned char smem[];
    float* lds = (float*)smem; float* red = (float*)(smem + RED_OFF);
    PG8_LAS unsigned char* glds = (PG8_LAS unsigned char*)smem;
    volatile LAS unsigned* xst = (volatile LAS unsigned*)(smem + LDS_BYTES - 16);
    if (threadIdx.x < 4) xst[threadIdx.x] = 0u;
    __syncthreads();
    XcdBarrier xb = xcd_barrier_post((unsigned*)((char*)p.ws + B_BAR), xst);
    bf16_t* wint = (bf16_t*)((char*)p.ws + B_WINT); bf16_t* woutt = (bf16_t*)((char*)p.ws + B_WOUTT); bf16_t* wqt = (bf16_t*)((char*)p.ws + B_WQT);
    bf16_t* ub = (bf16_t*)((char*)p.ws + B_UB);
    phase_a(p, lds);
    transpose_convert(p.in[I_WIN], wint, D, DPROJ, lds, 0, (int)gridDim.x);
    phase_filters(p, lds);
    {
        const float* ks = p.in[I_KEYS]; bf16_t* kd = (bf16_t*)((char*)p.ws + B_KEYSB);
        for (int e = blockIdx.x * NTHREADS + threadIdx.x; e < 16 * 128 * 128 / 4; e += gridDim.x * NTHREADS) {
            const float4 v = *(const float4*)(ks + e * 4); uint2 o; o.x = pk_bf16(v.x, v.y); o.y = pk_bf16(v.z, v.w);
            const int d = (e * 4) & 127, n = ((e * 4) >> 7) & 127, hp = (e * 4) >> 14;
            *(uint2*)(kd + ((size_t)(((hp * 8 + (n >> 4)) * 4 + (d >> 5)) * 64 + ((d & 31) >> 3) * 16 + (n & 15))) * 8 + (d & 7)) = o;
        }
    }
    xcd_barrier_hosting(xb, p, 0);
    phase_b(p);
    xcd_barrier_hosting(xb, p, 1);
    phase_c(p);
    xcd_barrier_hosting(xb, p, 2);
    {
        pg8::Gemm g{ub, wint, NT + NTC, DPROJ, D}; ProjOrder S{(int)gridDim.x, (int)blockIdx.x, ub, wint};
        EpiProj E{(unsigned char*)p.ws};
        pg8::gemm_phase<EpiProj, ProjOrder>(glds, g, S, E, nullptr);
    }
    if (gridDim.x == 256 && blockIdx.x >= 32) {
        quant_tables(p, 32, 224, 3 * 2048, 4 * 2048);
        quant_tables(p, 32, 224, 7 * 2048, 2 * 16384);
        transpose_convert(p.in[I_WOUT], woutt, D, D, lds, 32, 224);
        transpose_convert(p.in[I_WQ], wqt, D, D, lds, 32, 224);
    } else if (gridDim.x != 256) {
        quant_tables(p, 0, (int)gridDim.x);
        transpose_convert(p.in[I_WOUT], woutt, D, D, lds, 0, (int)gridDim.x);
        transpose_convert(p.in[I_WQ], wqt, D, D, lds, 0, (int)gridDim.x);
    }
    xcd_barrier(xb);
    phase_hyena(p, smem);
    phase_na(p, smem);
    xcd_barrier_hosting(xb, p, 4);
    phase_f(p, lds);
    xcd_barrier_hosting(xb, p, 5);
    {
        pg8::Gemm g{ub, woutt, NT, D, D}; pg8::XcdRowOrder S; S.init(NT, D, (int)gridDim.x, (int)blockIdx.x);
        pg8::EpiBf16<0> E{(bf16_t*)((char*)p.ws + B_Y), D, nullptr, 0, 0};
        pg8::gemm_phase<pg8::EpiBf16<0>, pg8::XcdRowOrder>(glds, g, S, E, nullptr);
    }
    xcd_barrier_hosting(xb, p, 6);
    phase_h(p);
    xcd_barrier(xb);
    {
        pg8::Gemm g{ub, wqt, NT, D, D}; pg8::XcdRowOrder S; S.init(NT, D, (int)gridDim.x, (int)blockIdx.x);
        EpiQFrag E{(bf16_t*)((char*)p.ws + B_QB)};
        pg8::gemm_phase<EpiQFrag, pg8::XcdRowOrder>(glds, g, S, E, nullptr);
    }
    xcd_barrier(xb);
    phase_jk(p, smem);
}

extern "C" void kernel_launch(void* const* d_in, const int* in_sizes, int n_in, void* d_out, int out_size, void* d_ws, size_t ws_size, hipStream_t stream) {
    static int grid_blocks = 0;
    if (grid_blocks == 0) {
        if (n_in != N_IN || out_size != NT * D || ws_size < W_END * sizeof(float)) {
            fprintf(stderr, "kernel_launch: unexpected shapes: n_in %d out %d ws %zu (need %zu)\n", n_in, out_size, ws_size, (size_t)W_END * 4); grid_blocks = -1; return; }
        int dev = 0, cus = 0, per_cu = 0;
        hipGetDevice(&dev);
        hipDeviceGetAttribute(&cus, hipDeviceAttributeMultiprocessorCount, dev);
        if (hipFuncSetAttribute((const void*)fwd_megakernel, hipFuncAttributeMaxDynamicSharedMemorySize, LDS_BYTES) != hipSuccess) { fprintf(stderr, "kernel_launch: hipFuncSetAttribute failed\n"); grid_blocks = -1; return; }
        if (hipOccupancyMaxActiveBlocksPerMultiprocessor(&per_cu, (const void*)fwd_megakernel, NTHREADS, LDS_BYTES) != hipSuccess || per_cu < 1) { fprintf(stderr, "kernel_launch: occupancy query failed (%d)\n", per_cu); (void)hipGetLastError(); grid_blocks = -1; return; }
        grid_blocks = cus * (per_cu > 1 ? 1 : per_cu);
        fprintf(stderr, "kernel_launch: cus %d per_cu %d grid %d\n", cus, per_cu, grid_blocks);
    }
    if (grid_blocks < 0) return;
    Params p{};
    for (int i = 0; i < N_IN; ++i) p.in[i] = (const float*)d_in[i];
    p.out = (float*)d_out; p.ws = (float*)d_ws;
    if (hipMemsetAsync((char*)d_ws + B_BAR, 0, XCD_BAR_WORDS * sizeof(unsigned), stream) != hipSuccess) { fprintf(stderr, "kernel_launch: memset failed\n"); return; }
    void* args[] = {&p};
    hipLaunchKernelGGL(fwd_megakernel, dim3(grid_blocks), dim3(NTHREADS), LDS_BYTES, stream, p);
    const hipError_t e = hipPeekAtLastError();
    if (e != hipSuccess) fprintf(stderr, "launch failed: %s (grid %d)\n", hipGetErrorString(e), grid_blocks);
}
```

```cpp
#include <hip/hip_runtime.h>
#include <hip/hip_cooperative_groups.h>
#include <cstdio>
namespace cg = cooperative_groups;

constexpr int D = 2048, NB = 4, SL = 2048, NT = NB * SL, CL = 256, NTC = NB * CL;
constexpr int DHY = 1024, DNA = 1024, DPROJ = 6144, OFFQ = 3072, OFFK = 4096, OFFV = 5120;
constexpr int NTHREADS = 512, NWAVES = 8;
constexpr float LN_EPS = 1e-5f;
constexpr float ALPHA = 1.189207115002721f;

enum { I_X = 0, I_C, I_CTX, I_CCTX, I_WADA, I_BADA, I_WIN, I_CONVW, I_CONVB, I_FW1, I_FB1, I_FW2, I_FB2, I_FW3, I_FB3, I_FW4,
       I_FREQ, I_SKIP, I_RPB, I_GHY, I_GNA, I_WOUT, I_LN1G, I_LN1B, I_WQ, I_KEYS, I_PU, I_PV, I_LN2G, I_LN2B, N_IN };

constexpr size_t W_ADAP = 0;
constexpr size_t W_ADA  = W_ADAP + 32 * 5 * 12288;
constexpr size_t W_FS   = W_ADA + 5 * 12288;
constexpr size_t W_SP   = W_FS + 4096;
constexpr size_t W_SU   = W_SP + 32 * 4096;
constexpr size_t W_SV   = W_SU + 16384;
constexpr size_t W_SU2  = W_SV + 16384;
constexpr size_t W_SC   = W_SU2 + 8192;
static_assert((W_SC + 16384) * 4 <= 14 * 1048576, "small region overflow");
constexpr size_t MiB = 1048576;
constexpr size_t B_WINT  = 16 * MiB;
constexpr size_t B_WOUTT = B_WINT + 24 * MiB;
constexpr size_t B_WQT   = B_WOUTT + 8 * MiB;
constexpr size_t B_UB    = B_WQT + 8 * MiB;
constexpr size_t B_ZT    = B_UB + 36 * MiB;
constexpr size_t B_VT    = B_ZT + 48 * MiB;
constexpr size_t B_QH    = B_VT + 16 * MiB;
constexpr size_t B_KH    = B_QH + 16 * MiB;
constexpr size_t B_KCH   = B_KH + 16 * MiB;
constexpr size_t B_VCT   = B_KCH + 2 * MiB;
constexpr size_t B_KF    = B_VCT + 2 * MiB;
constexpr size_t B_HRAW  = B_KF + 32 * MiB;
constexpr size_t B_HYT   = B_HRAW;
constexpr size_t B_NA    = B_HRAW + 16 * MiB;
constexpr size_t B_Y     = B_HRAW + 32 * MiB;
constexpr size_t B_X1    = B_Y + 64 * MiB;
constexpr size_t B_U2Q   = B_X1 + 64 * MiB;
constexpr size_t B_TQ    = B_U2Q + 16 * MiB;
constexpr size_t B_END   = B_TQ + 64 * MiB;
constexpr size_t W_KF = B_KF / 4, W_X1 = B_X1 / 4, W_HRAW = B_HRAW / 4, W_Y = B_Y / 4, W_END = B_END / 4;
static_assert(B_END <= 512 * MiB, "workspace");

constexpr int LDS_BYTES = 156 * 1024;
constexpr int RED_OFF = 155 * 1024;

struct Params { const float* in[N_IN]; float* out; float* ws; };

namespace pg8 {
#define PG8_LAS __attribute__((address_space(3)))
typedef unsigned short bf16_t;
typedef short bf16x8 __attribute__((ext_vector_type(8)));
typedef float f32x4 __attribute__((ext_vector_type(4)));
typedef unsigned u32x4 __attribute__((ext_vector_type(4)));
constexpr int BM = 256, BK = 64, HALF = 128, HTB = HALF * BK * 2  , STAGE_BYTES = 8 * HTB, NXCD = 8, WGM = 8;

__host__ __device__ __forceinline__ int lds_byte(int r, int c) { const int st = (r >> 4) * 2 + (c >> 5), rr = r & 15, cc = c & 31, ob = rr * 64 + cc * 2; return st * 1024 + (ob ^ (((ob >> 9) & 1) << 5)); }
__host__ __device__ __forceinline__ void stage_rc(int b, int& R, int& C) { const int st = b / 1024, sb = b % 1024, swz = sb ^ (((sb >> 9) & 1) << 5); R = (st >> 1) * 16 + swz / 64; C = (st & 1) * 32 + (swz % 64) / 2; }
__host__ __device__ __forceinline__ int perm32(int rho) { const int n = rho >> 4, i = rho & 15; return 8 * (i >> 2) + 4 * n + (i & 3); }

struct Unit { int pm, pn, kind; };
struct Gemm { const bf16_t* A; const bf16_t* Bt; int M, N, K; };

struct StaticOrder {
    int nM, nN, nwg, G, c;
    __host__ __device__ void init(int M, int N, int G_, int c_) { nM = M / BM; nN = N / BM; nwg = nM * nN; G = G_; c = c_; }
    __host__ __device__ bool next(int i, Unit& u) const {
        const long L = (long)i * G + c; if (L >= nwg) return false;
        int wgid = (int)L; { const int q = nwg / NXCD, r = nwg % NXCD, xcd = wgid % NXCD, off = wgid / NXCD; wgid = (xcd < r ? xcd * (q + 1) : r * (q + 1) + (xcd - r) * q) + off; }
        const int nig = WGM * nN, gid = wgid / nig, fm = gid * WGM, gsz = (nM - fm) < WGM ? (nM - fm) : WGM;
        u.pm = fm + ((wgid % nig) % gsz); u.pn = (wgid % nig) / gsz; return true;
    }
    __device__ __forceinline__ void a_ready(const Unit&) const {}
    __device__ __forceinline__ void done(const Unit&) const {}
    template <class G_> __device__ __forceinline__ const char* pa(const G_& g, const Unit& u) const { return (const char*)g.A + (size_t)u.pm * (size_t)(BM * 2) * g.K; }
    template <class G_> __device__ __forceinline__ const char* pb(const G_& g, const Unit& u) const { return (const char*)g.Bt + (size_t)u.pn * (size_t)(BM * 2) * g.K; }
};
struct XcdRowOrder : StaticOrder {
    __host__ __device__ bool next(int i, Unit& u) const {
        if (G != 256 || nM != 32 || nN != 8) return StaticOrder::next(i, u);
        if (i != 0) return false;
        u.pm = 4 * (c & 7) + ((c >> 3) & 3); u.pn = c >> 5; return true;
    }
};
__device__ __forceinline__ unsigned cvt_pk_bf16(float lo, float hi) { unsigned r; asm volatile("v_cvt_pk_bf16_f32 %0, %1, %2" : "=v"(r) : "v"(lo), "v"(hi)); return r; }
typedef float f32x2 __attribute__((ext_vector_type(2)));
__device__ __forceinline__ f32x2 gelu_pk(f32x2 v) {
    const f32x2 av = __builtin_elementwise_abs(v), d = av * 0.2316418882f + 1.0f;
    f32x2 t; t.x = __builtin_amdgcn_rcpf(d.x); t.y = __builtin_amdgcn_rcpf(d.y);
    f32x2 q = t * 0.5307027145f + (-0.7265760135f); q = q * t + 0.7107068705f; q = q * t + (-0.142248368f); q = q * t + 0.127414796f; q = q * t;
    const f32x2 s = (v * v) * (-0.72134752044f);
    f32x2 e; e.x = __builtin_amdgcn_exp2f(s.x); e.y = __builtin_amdgcn_exp2f(s.y);
    const f32x2 m = v * (q * e), r = v - m;
    f32x2 o; o.x = v.x < 0.f ? m.x : r.x; o.y = v.y < 0.f ? m.y : r.y; return o;
}

struct EpiF32 {
    static constexpr bool PERM = false, AFTER_DRAIN = false;
    float* C; int ldc; const float* bias;
    __device__ __forceinline__ void operator()(const f32x4 (&acc)[2][2][4][2], const Unit& u, int wr, int wc, int fr, int fq) const {
        const int row0 = u.pm * BM + wr * 64 + fr, col0 = u.pn * BM + wc * 32 + 4 * fq;
        f32x4 bv[2][2];
#pragma unroll
        for (int bj = 0; bj < 2; ++bj)
#pragma unroll
            for (int n = 0; n < 2; ++n) bv[bj][n] = bias ? *(const f32x4*)(bias + col0 + bj * HALF + n * 16) : (f32x4){0.f, 0.f, 0.f, 0.f};
#pragma unroll
        for (int ai = 0; ai < 2; ++ai)
#pragma unroll
            for (int m = 0; m < 4; ++m) { float* rowp = C + (size_t)(row0 + ai * HALF + m * 16) * ldc + col0;
#pragma unroll
                for (int bj = 0; bj < 2; ++bj)
#pragma unroll
                    for (int n = 0; n < 2; ++n) *(f32x4*)(rowp + bj * HALF + n * 16) = acc[ai][bj][m][n] + bv[bj][n]; }
    }
};
template <int ACT  > struct EpiBf16 {
    static constexpr bool PERM = true, AFTER_DRAIN = false;
    bf16_t* O; int ldc; const float* bias; int split_cols; size_t split_stride;
    __device__ __forceinline__ void operator()(const f32x4 (&acc)[2][2][4][2], const Unit& u, int wr, int wc, int fr, int fq) const {
        const int row0 = u.pm * BM + wr * 64 + fr; int colt = u.pn * BM; bf16_t* base = O;
        if (split_cols) { const int t = colt / split_cols; base += (size_t)t * split_stride; colt -= t * split_cols; }
        const int col0 = colt + wc * 32 + 8 * fq, bcol0 = u.pn * BM + wc * 32 + 8 * fq;
        f32x4 bv[2][2];
#pragma unroll
        for (int bj = 0; bj < 2; ++bj)
#pragma unroll
            for (int n = 0; n < 2; ++n) bv[bj][n] = bias ? *(const f32x4*)(bias + bcol0 + bj * HALF + 4 * n) : (f32x4){0.f, 0.f, 0.f, 0.f};
#pragma unroll
        for (int ai = 0; ai < 2; ++ai)
#pragma unroll
            for (int m = 0; m < 4; ++m) { bf16_t* rowp = base + (size_t)(row0 + ai * HALF + m * 16) * ldc + col0;
#pragma unroll
                for (int bj = 0; bj < 2; ++bj) { f32x4 v0 = acc[ai][bj][m][0] + bv[bj][0], v1 = acc[ai][bj][m][1] + bv[bj][1];
                    if (ACT == 1) { f32x2 a = gelu_pk((f32x2){v0[0], v0[1]}), b = gelu_pk((f32x2){v0[2], v0[3]}), c = gelu_pk((f32x2){v1[0], v1[1]}), d = gelu_pk((f32x2){v1[2], v1[3]});
                        v0 = (f32x4){a.x, a.y, b.x, b.y}; v1 = (f32x4){c.x, c.y, d.x, d.y}; }
                    if (ACT == 2) {
#pragma unroll
                        for (int j = 0; j < 4; ++j) { v0[j] = 0.5f * v0[j] * (1.0f + erff(v0[j] * 0.70710678f)); v1[j] = 0.5f * v1[j] * (1.0f + erff(v1[j] * 0.70710678f)); } }
                    u32x4 w; w.x = cvt_pk_bf16(v0[0], v0[1]); w.y = cvt_pk_bf16(v0[2], v0[3]); w.z = cvt_pk_bf16(v1[0], v1[1]); w.w = cvt_pk_bf16(v1[2], v1[3]);
                    *(u32x4*)(rowp + bj * HALF) = w; } }
    }
};
template <class Epi, class Sched, bool STAMP = false>
__device__ __forceinline__ void gemm_phase(PG8_LAS unsigned char* lds, const Gemm g, const Sched& S, const Epi& E, unsigned long long* stamps) {
    const int tid = threadIdx.x, wid = __builtin_amdgcn_readfirstlane(tid >> 6), lane = tid & 63, wr = wid >> 2, wc = wid & 3, fr = lane & 15, fq = lane >> 4;
    const int K = g.K, nt = K / BK;
    int ts_lo = 0, ts_hi = 0, nts = 0; const unsigned long long rt_entry = STAMP ? (unsigned long long)wall_clock64() : 0ull;
#define PG8_STAMP() do { if (STAMP && wid == 0 && nts < 64) { const unsigned long long _c = (unsigned long long)clock64(); \
        ts_lo = (lane == nts) ? (int)(unsigned)_c : ts_lo; ts_hi = (lane == nts) ? (int)(unsigned)(_c >> 32) : ts_hi; ++nts; } } while (0)
    PG8_STAMP();
    unsigned voffA[2], voffB[2];
#pragma unroll
    for (int i = 0; i < 2; ++i) { int R, C; stage_rc(tid * 16 + i * 8192, R, C); const int Rb = Epi::PERM ? ((R & ~31) + perm32(R & 31)) : R;
        voffA[i] = (unsigned)(R * K + C) * 2u; voffB[i] = (unsigned)(Rb * K + C) * 2u; }
    const size_t kstep = (size_t)(BK * 2);
    const size_t hstep = (size_t)HALF * K * 2;
    const size_t tstep = 2 * hstep;
    const unsigned ldsw = (unsigned)wid * 1024u;
    const int aoff = lds_byte(wr * 64 + fr, fq * 8), boff = lds_byte(wc * 32 + fr, fq * 8);
#define PG8_SA(b, h) (((b) * 2 + (h)) * HTB)
#define PG8_SB(b, h) ((4 + (b) * 2 + (h)) * HTB)
#define PG8_STAGE(bufoff, gbase, voff) do { _Pragma("unroll") for (int _i = 0; _i < 2; ++_i) \
        __builtin_amdgcn_global_load_lds((const unsigned*)((const char*)(gbase) + (voff)[_i]), (PG8_LAS unsigned*)(lds + (bufoff) + ldsw + _i * 8192), 16, 0, 0); } while (0)
#define PG8_LDA(dst, b, h) do { _Pragma("unroll") for (int m = 0; m < 4; ++m) _Pragma("unroll") for (int k = 0; k < 2; ++k) dst[m][k] = *(const PG8_LAS bf16x8*)(lds + PG8_SA(b, h) + aoff + m * 2048 + k * 1024); } while (0)
#define PG8_LDB(dst, b, h) do { _Pragma("unroll") for (int n = 0; n < 2; ++n) _Pragma("unroll") for (int k = 0; k < 2; ++k) dst[n][k] = *(const PG8_LAS bf16x8*)(lds + PG8_SB(b, h) + boff + n * 2048 + k * 1024); } while (0)
#define PG8_MMA(ai, bj, At, Bt) do { __builtin_amdgcn_s_setprio(1); _Pragma("unroll") for (int m = 0; m < 4; ++m) _Pragma("unroll") for (int n = 0; n < 2; ++n) _Pragma("unroll") for (int k = 0; k < 2; ++k) \
        acc[ai][bj][m][n] = __builtin_amdgcn_mfma_f32_16x16x32_bf16(Bt[n][k], At[m][k], acc[ai][bj][m][n], 0, 0, 0); __builtin_amdgcn_s_setprio(0); } while (0)
#define PG8_WAIT_V(n) asm volatile("s_waitcnt vmcnt(" #n ")" ::: "memory")
#define PG8_WAIT_L(n) asm volatile("s_waitcnt lgkmcnt(" #n ")" ::: "memory")
#define PG8_BAR __builtin_amdgcn_s_barrier()
#define PG8_SCHED __builtin_amdgcn_sched_barrier(0)
    Unit cur, nxt; int ui = 0;
    if (!S.next(0, cur)) return;
    f32x4 acc[2][2][4][2];
#pragma unroll
    for (int a = 0; a < 2; ++a)
#pragma unroll
        for (int b = 0; b < 2; ++b)
#pragma unroll
            for (int m = 0; m < 4; ++m)
#pragma unroll
                for (int n = 0; n < 2; ++n) acc[a][b][m][n] = (f32x4){0.f, 0.f, 0.f, 0.f};
    bf16x8 At[4][2], B0[2][2], B1[2][2];
    const char* cA = S.pa(g, cur); const char* cB = S.pb(g, cur);
    S.a_ready(cur);
    PG8_STAGE(PG8_SB(0, 0), cB, voffB); PG8_STAGE(PG8_SA(0, 0), cA, voffA); PG8_STAGE(PG8_SB(0, 1), cB + hstep, voffB); PG8_STAGE(PG8_SA(0, 1), cA + hstep, voffA);
    if (wr == 1) PG8_BAR;
    PG8_WAIT_V(4); PG8_BAR;
    PG8_STAGE(PG8_SB(1, 0), cB + kstep, voffB); PG8_STAGE(PG8_SA(1, 0), cA + kstep, voffA); PG8_STAGE(PG8_SB(1, 1), cB + hstep + kstep, voffB);
    PG8_WAIT_V(6); PG8_BAR;
    PG8_STAMP();
    for (;;) {
        const bool has_next = S.next(ui + 1, nxt);
        const char* nA = has_next ? S.pa(g, nxt) : cA; const char* nB = has_next ? S.pb(g, nxt) : cB;
        for (int t = 0; t < nt; t += 2) {
            const bool last = (t == nt - 2);
            const char* a1 = cA + (size_t)(t + 1) * kstep;
            const char* a2 = last ? nA : cA + (size_t)(t + 2) * kstep; const char* b2 = last ? nB : cB + (size_t)(t + 2) * kstep;
            const char* a3 = a2 + kstep; const char* b3 = b2 + kstep;
            if (last && has_next) S.a_ready(nxt);
            PG8_LDB(B0, 0, 0); PG8_SCHED; PG8_LDA(At, 0, 0); PG8_STAGE(PG8_SA(1, 1), a1 + hstep, voffA);
            PG8_WAIT_L(8); PG8_BAR; PG8_WAIT_L(0); PG8_MMA(0, 0, At, B0); PG8_BAR; PG8_SCHED;
            PG8_LDB(B1, 0, 1); PG8_STAGE(PG8_SB(0, 0), b2, voffB);
            PG8_BAR; PG8_WAIT_L(0); PG8_MMA(0, 1, At, B1); PG8_BAR;
            PG8_LDA(At, 0, 1); PG8_STAGE(PG8_SA(0, 0), a2, voffA);
            PG8_BAR; PG8_WAIT_L(0); PG8_MMA(1, 0, At, B0); PG8_BAR; PG8_SCHED;
            PG8_STAGE(PG8_SB(0, 1), b2 + hstep, voffB);
            PG8_WAIT_V(6); PG8_BAR; PG8_MMA(1, 1, At, B1); PG8_BAR;
            PG8_LDB(B0, 1, 0); PG8_SCHED; PG8_LDA(At, 1, 0); PG8_STAGE(PG8_SA(0, 1), a2 + hstep, voffA);
            PG8_WAIT_L(8); PG8_BAR; PG8_WAIT_L(0); PG8_MMA(0, 0, At, B0); PG8_BAR; PG8_SCHED;
            PG8_LDB(B1, 1, 1); PG8_STAGE(PG8_SB(1, 0), b3, voffB);
            PG8_BAR; PG8_WAIT_L(0); PG8_MMA(0, 1, At, B1); PG8_BAR;
            PG8_LDA(At, 1, 1); PG8_STAGE(PG8_SA(1, 0), a3, voffA);
            PG8_BAR; PG8_WAIT_L(0); PG8_MMA(1, 0, At, B0); PG8_BAR; PG8_SCHED;
            PG8_STAGE(PG8_SB(1, 1), b3 + hstep, voffB);
            PG8_WAIT_V(6); PG8_BAR; PG8_MMA(1, 1, At, B1); PG8_BAR;
        }
        PG8_STAMP();
        if constexpr (!Epi::AFTER_DRAIN) { E(acc, cur, wr, wc, fr, fq); S.done(cur); }
        PG8_STAMP();
        if (!has_next) break;
#pragma unroll
        for (int a = 0; a < 2; ++a)
#pragma unroll
            for (int b = 0; b < 2; ++b)
#pragma unroll
                for (int m = 0; m < 4; ++m)
#pragma unroll
                    for (int n = 0; n < 2; ++n) acc[a][b][m][n] = (f32x4){0.f, 0.f, 0.f, 0.f};
        cur = nxt; cA = nA; cB = nB; ++ui;
    }
    PG8_WAIT_V(0);
    if (wr == 0) PG8_BAR;
    PG8_BAR;
    if constexpr (Epi::AFTER_DRAIN) { E.fused(acc, cur, wr, wc, fr, fq, lds, wid, lane); S.done(cur); }
    PG8_STAMP();
    if (STAMP && wid == 0) { stamps[lane] = lane < nts ? (((unsigned long long)(unsigned)ts_hi << 32) | (unsigned)ts_lo) : 0ull;
        if (lane == 62) stamps[62] = rt_entry; if (lane == 63) stamps[63] = (unsigned long long)wall_clock64(); }
#undef PG8_STAMP
#undef PG8_SA
#undef PG8_SB
#undef PG8_STAGE
#undef PG8_LDA
#undef PG8_LDB
#undef PG8_MMA
#undef PG8_WAIT_V
#undef PG8_WAIT_L
#undef PG8_BAR
#undef PG8_SCHED
}
}

typedef unsigned short bf16_t;
__device__ __forceinline__ float wave_sum(float v) {
#pragma unroll
    for (int o = 32; o; o >>= 1) v += __shfl_xor(v, o);
    return v;
}
__device__ __forceinline__ float block_sum(float v, float* red) {
    v = wave_sum(v);
    __syncthreads();
    if ((threadIdx.x & 63) == 0) red[threadIdx.x >> 6] = v;
    __syncthreads();
    float s = 0.f;
#pragma unroll
    for (int i = 0; i < NWAVES; ++i) s += red[i];
    return s;
}
__device__ __forceinline__ int opaque_tid() { int t = threadIdx.x; asm volatile("" : "+v"(t)); return t; }
typedef float nt_f32x4 __attribute__((ext_vector_type(4)));
__device__ __forceinline__ float4 nt_load4(const float* p) { const nt_f32x4 v = __builtin_nontemporal_load((const nt_f32x4*)p); return make_float4(v[0], v[1], v[2], v[3]); }
typedef unsigned nt_u32x4 __attribute__((ext_vector_type(4)));
typedef unsigned nt_u32x2 __attribute__((ext_vector_type(2)));
__device__ __forceinline__ uint4 nt_load4u(const void* p) { const nt_u32x4 v = __builtin_nontemporal_load((const nt_u32x4*)p); return make_uint4(v[0], v[1], v[2], v[3]); }
__device__ __forceinline__ uint2 nt_load2u(const void* p) { const nt_u32x2 v = __builtin_nontemporal_load((const nt_u32x2*)p); return make_uint2(v[0], v[1]); }
__device__ __forceinline__ void nt_store4(float* p, float a, float b, float c, float d) { nt_f32x4 v = {a, b, c, d}; __builtin_nontemporal_store(v, (nt_f32x4*)p); }
__device__ __forceinline__ void nt_store4u(void* p, uint4 v) { nt_u32x4 w = {v.x, v.y, v.z, v.w}; __builtin_nontemporal_store(w, (nt_u32x4*)p); }
__device__ __forceinline__ void nt_store2u(void* p, uint2 v) { nt_u32x2 w = {v.x, v.y}; __builtin_nontemporal_store(w, (nt_u32x2*)p); }
__device__ __forceinline__ float silu(float x) { return x / (1.0f + expf(-x)); }


__device__ __forceinline__ unsigned pk_bf16(float lo, float hi) { unsigned r; asm volatile("v_cvt_pk_bf16_f32 %0, %1, %2" : "=v"(r) : "v"(lo), "v"(hi)); return r; }
__device__ __forceinline__ void transpose_convert(const float* __restrict__ W, bf16_t* __restrict__ Wt, int K, int N, float* lds, int wb0, int nwb, int t_begin = 0, int t_end = 1 << 30) {
    const int tid = opaque_tid();
    const int tk = K / 64, tn = N / 256;
    for (int tile = t_begin + (int)blockIdx.x - wb0; tile < min(tk * tn, t_end); tile += nwb) {
        const int k0 = (tile / tn) * 64, n0 = (tile % tn) * 256;
        __syncthreads();
        float4 v[8];
#pragma unroll
        for (int i = 0; i < 8; ++i) v[i] = nt_load4(W + (size_t)(k0 + (tid >> 6) + 8 * i) * N + n0 + (tid & 63) * 4);
#pragma unroll
        for (int i = 0; i < 8; ++i) { float* d = lds + ((tid >> 6) + 8 * i) * 257 + (tid & 63) * 4; d[0] = v[i].x; d[1] = v[i].y; d[2] = v[i].z; d[3] = v[i].w; }
        __syncthreads();
#pragma unroll
        for (int q = 0; q < 4; ++q) {
            const int c = q * NTHREADS + tid, n = c >> 3, k8 = (c & 7) * 8;
            uint4 o;
            o.x = pk_bf16(lds[(k8 + 0) * 257 + n], lds[(k8 + 1) * 257 + n]); o.y = pk_bf16(lds[(k8 + 2) * 257 + n], lds[(k8 + 3) * 257 + n]);
            o.z = pk_bf16(lds[(k8 + 4) * 257 + n], lds[(k8 + 5) * 257 + n]); o.w = pk_bf16(lds[(k8 + 6) * 257 + n], lds[(k8 + 7) * 257 + n]);
            *(uint4*)(Wt + (size_t)(n0 + n) * K + k0 + k8) = o;
        }
    }
}
__device__ __forceinline__ float wave_max(float v) {
#pragma unroll
    for (int o = 32; o; o >>= 1) v = fmaxf(v, __shfl_xor(v, o));
    return v;
}
__device__ __forceinline__ float block_max(float v, float* red) {
    v = wave_max(v);
    __syncthreads();
    if ((threadIdx.x & 63) == 0) red[threadIdx.x >> 6] = v;
    __syncthreads();
    float s = red[0];
#pragma unroll
    for (int i = 1; i < NWAVES; ++i) s = fmaxf(s, red[i]);
    return s;
}
__device__ __forceinline__ unsigned q4(float a, float b, float c, float d, float inv, int off) {
    const int x = __float2int_rn(a * inv) + off, y = __float2int_rn(b * inv) + off, z = __float2int_rn(c * inv) + off, w = __float2int_rn(d * inv) + off;
    return (unsigned)(x & 255) | ((unsigned)(y & 255) << 8) | ((unsigned)(z & 255) << 16) | ((unsigned)(w & 255) << 24);
}
constexpr int UROW = 1024;
template <int O> __device__ __forceinline__ unsigned nibh8(const float (&x)[16], float inv) {
    unsigned r = 0;
#pragma unroll
    for (int i = 0; i < 8; ++i) r |= (unsigned)min(max((int)floorf(x[O + i] * inv) + 8, 0), 15) << (4 * i);
    return r;
}
template <int U = 2> __device__ __forceinline__ void quant_tables(const Params& p, int wb0, int nwb, int rb = 0, int re = 2 * 16384) {
    const int tid = opaque_tid(), lane = tid & 63, wv = tid >> 6;
    unsigned char* tq = (unsigned char*)p.ws + B_TQ; float* rsc = p.ws + W_SU;
    const int nw = nwb * NWAVES;
    for (int row0 = rb + ((int)blockIdx.x - wb0) * NWAVES + wv; row0 < re; row0 += U * nw) {
        float x[2][2][16]; float mx[2][2];
#pragma unroll
        for (int u = 0; u < U; ++u) {
            const int row = min(row0 + u * nw, re - 1);
            const float* src = (row < 16384 ? p.in[I_PU] : p.in[I_PV]) + (size_t)(row & 16383) * D + lane * 4;
#pragma unroll
            for (int h = 0; h < 2; ++h) {
                mx[u][h] = 0.f;
#pragma unroll
                for (int q = 0; q < 4; ++q) { const float4 v = nt_load4(src + (h * 4 + q) * 256); x[u][h][q * 4] = v.x; x[u][h][q * 4 + 1] = v.y; x[u][h][q * 4 + 2] = v.z; x[u][h][q * 4 + 3] = v.w;
                    mx[u][h] = fmaxf(mx[u][h], fmaxf(fmaxf(fabsf(v.x), fabsf(v.y)), fmaxf(fabsf(v.z), fabsf(v.w)))); }
            }
        }
#pragma unroll
        for (int u = 0; u < U; ++u) {
            const int row = row0 + u * nw;
            if (row < re) {
                const float rmx = wave_max(fmaxf(mx[u][0], mx[u][1]));
                {
                    float ss = 0.f;
#pragma unroll
                    for (int h = 0; h < 2; ++h)
#pragma unroll
                        for (int i = 0; i < 16; ++i) ss += x[u][h][i] * x[u][h][i];
                    const float rms = sqrtf(wave_sum(ss) * (1.0f / 2048.0f));
                    if (row >= 16384) {
                        const float cl = fminf(rmx, 2.94f * rms);
                        const float Rv = cl > 0.f ? cl * (1.0f / 6.0f) : 1.0f, iv = 1.0f / Rv;
                        unsigned w4[4];
#pragma unroll
                        for (int q = 0; q < 4; ++q) {
                            const float* xs = &x[u][q >> 1][(q & 1) * 8];
                            unsigned r = 0u;
                            r = __builtin_amdgcn_cvt_scalef32_pk_fp4_f32(r, xs[0] * iv, xs[1] * iv, 1.0f, 0);
                            r = __builtin_amdgcn_cvt_scalef32_pk_fp4_f32(r, xs[2] * iv, xs[3] * iv, 1.0f, 1);
                            r = __builtin_amdgcn_cvt_scalef32_pk_fp4_f32(r, xs[4] * iv, xs[5] * iv, 1.0f, 2);
                            r = __builtin_amdgcn_cvt_scalef32_pk_fp4_f32(r, xs[6] * iv, xs[7] * iv, 1.0f, 3);
                            w4[q] = r;
                        }
                        nt_store4u(tq + (size_t)row * UROW + lane * 16, make_uint4(w4[0], w4[1], w4[2], w4[3]));
                        if (lane == 0) rsc[row] = Rv;
                        continue;
                    }
                    const float clipv = fminf(rmx, 2.5125f * rms);
                    const float Ru = clipv > 0.f ? clipv * (1.0f / 7.5f) : 1.0f, iu = 1.0f / Ru;
                    const unsigned c0 = nibh8<0>(x[u][0], iu), c1 = nibh8<8>(x[u][0], iu), c2 = nibh8<0>(x[u][1], iu), c3 = nibh8<8>(x[u][1], iu);
                    nt_store4u(tq + (size_t)row * UROW + lane * 16, make_uint4(c0, c1, c2, c3));
                    unsigned cs = __builtin_amdgcn_udot8(c0, 0x11111111u, 0u, false); cs = __builtin_amdgcn_udot8(c1, 0x11111111u, cs, false);
                    cs = __builtin_amdgcn_udot8(c2, 0x11111111u, cs, false); cs = __builtin_amdgcn_udot8(c3, 0x11111111u, cs, false);
                    const float csum = wave_sum((float)cs);
                    if (lane == 0) { rsc[row] = Ru; (p.ws + W_SC)[row] = csum; }
                }
            }
        }
    }
}

__device__ __forceinline__ void naive_gemm(const float* __restrict__ A, int lda, const float* __restrict__ Bm, int ldb,
                                           float* __restrict__ C, int ldc, int M, int N, int K, float* lds) {
    float* As = lds;
    float* Bs = lds + 16 * 132;
    const int tid = opaque_tid(), tx = tid & 31, ty = tid >> 5;
    const int tilesN = N / 128, ntiles = (M / 128) * tilesN;
    for (int tile = blockIdx.x; tile < ntiles; tile += gridDim.x) {
        const int m0 = (tile / tilesN) * 128, n0 = (tile % tilesN) * 128;
        float acc[8][4];
#pragma unroll
        for (int i = 0; i < 8; ++i)
#pragma unroll
            for (int j = 0; j < 4; ++j) acc[i][j] = 0.f;
        for (int k0 = 0; k0 < K; k0 += 16) {
            {
                const int row = tid >> 2, kq = (tid & 3) * 4;
                const float4 a = *(const float4*)(A + (size_t)(m0 + row) * lda + k0 + kq);
                As[(kq + 0) * 132 + row] = a.x; As[(kq + 1) * 132 + row] = a.y; As[(kq + 2) * 132 + row] = a.z; As[(kq + 3) * 132 + row] = a.w;
                const int kk = tid >> 5, n4 = (tid & 31) * 4;
                *(float4*)(Bs + kk * 128 + n4) = *(const float4*)(Bm + (size_t)(k0 + kk) * ldb + n0 + n4);
            }
            __syncthreads();
#pragma unroll 4
            for (int k = 0; k < 16; ++k) {
                const float4 a0 = *(const float4*)(As + k * 132 + ty * 8), a1 = *(const float4*)(As + k * 132 + ty * 8 + 4);
                const float4 b = *(const float4*)(Bs + k * 128 + tx * 4);
                const float av[8] = {a0.x, a0.y, a0.z, a0.w, a1.x, a1.y, a1.z, a1.w};
                const float bv[4] = {b.x, b.y, b.z, b.w};
#pragma unroll
                for (int i = 0; i < 8; ++i)
#pragma unroll
                    for (int j = 0; j < 4; ++j) acc[i][j] += av[i] * bv[j];
            }
            __syncthreads();
        }
#pragma unroll
        for (int i = 0; i < 8; ++i)
            *(float4*)(C + (size_t)(m0 + ty * 8 + i) * ldc + n0 + tx * 4) = make_float4(acc[i][0], acc[i][1], acc[i][2], acc[i][3]);
    }
}

__device__ __forceinline__ void phase_a(const Params& p, float* lds) {
    const int tid = opaque_tid();
    const float* c = p.in[I_C]; const float* cctx = p.in[I_CCTX]; const float* wada = p.in[I_WADA];
    float* part = p.ws + W_ADAP;
    for (int item = blockIdx.x; item < 32 * 24; item += gridDim.x) {
        const int ks = item / 24, j = (item % 24) * 512 + tid;
        __syncthreads();
        if (tid < 5 * 64) { const int n = tid >> 6, k = ks * 64 + (tid & 63); lds[tid] = silu(n < 4 ? c[n * 2048 + k] : cctx[k]); }
        __syncthreads();
        float a0 = 0.f, a1 = 0.f, a2 = 0.f, a3 = 0.f, a4 = 0.f;
#pragma unroll 32
        for (int kk = 0; kk < 64; ++kk) {
            const float w = __builtin_nontemporal_load(wada + (size_t)(ks * 64 + kk) * 12288 + j);
            a0 += lds[kk] * w; a1 += lds[64 + kk] * w; a2 += lds[128 + kk] * w; a3 += lds[192 + kk] * w; a4 += lds[256 + kk] * w;
        }
        part[(size_t)(ks * 5 + 0) * 12288 + j] = a0; part[(size_t)(ks * 5 + 1) * 12288 + j] = a1; part[(size_t)(ks * 5 + 2) * 12288 + j] = a2;
        part[(size_t)(ks * 5 + 3) * 12288 + j] = a3; part[(size_t)(ks * 5 + 4) * 12288 + j] = a4;
    }
}
typedef short bf16x8v __attribute__((ext_vector_type(8)));
typedef float f32x4v __attribute__((ext_vector_type(4)));
typedef float f32x16v __attribute__((ext_vector_type(16)));
__device__ __forceinline__ void phase_filters(const Params& p, float* lds) {
    const int tid = opaque_tid();
    const float* w1 = p.in[I_FW1]; const float* b1 = p.in[I_FB1]; const float* w2 = p.in[I_FW2]; const float* b2 = p.in[I_FB2];
    const float* w3 = p.in[I_FW3]; const float* b3 = p.in[I_FB3]; const float* w4 = p.in[I_FW4]; const float* freq = p.in[I_FREQ];
    float* hT = (float*)((char*)p.ws + B_KF); float* sp = p.ws + W_SP;
    float* zf = lds; float* ha = lds + 64 * 36; float* hb = ha + 64 * 68; float* red2 = hb + 64 * 68;
    float* W1 = red2 + 256; float* W2 = W1 + 33 * 64; float* W3 = W2 + 64 * 64;
    __syncthreads();
    for (int e = tid; e < 33 * 64; e += NTHREADS) W1[e] = w1[e];
    for (int e = tid; e < 64 * 64; e += NTHREADS) { W2[e] = w2[e]; W3[e] = w3[e]; }
    for (int item = blockIdx.x; item < 256; item += gridDim.x) {
        const int pt = item >> 3;
        __syncthreads();
        for (int e = tid; e < 64 * 33; e += NTHREADS) {
            const int pos = e / 33, m = e % 33, i = pt * 64 + pos;
            const float t = (float)i / 2047.0f, w = 6.283185307179586f * (float)i / 2048.0f;
            float v;
            if (m == 0) v = t;
            else if (m <= 16) { const float f = 1e-4f + (float)(m - 1) * ((15.0f - 1e-4f) / 15.0f); v = __cosf(f * w); }
            else { const float f = 1e-4f + (float)(m - 17) * ((15.0f - 1e-4f) / 15.0f); v = -__sinf(f * w); }
            zf[pos * 36 + m] = v;
        }
        __syncthreads();
        const int pos = tid >> 3, u0 = (tid & 7) * 8;
        {
            float a[8];
#pragma unroll
            for (int u = 0; u < 8; ++u) a[u] = b1[u0 + u];
#pragma unroll 11
            for (int m = 0; m < 33; ++m) { const float zv = zf[pos * 36 + m]; const float4 wa = *(const float4*)(W1 + m * 64 + u0), wb = *(const float4*)(W1 + m * 64 + u0 + 4);
                a[0] += zv * wa.x; a[1] += zv * wa.y; a[2] += zv * wa.z; a[3] += zv * wa.w; a[4] += zv * wb.x; a[5] += zv * wb.y; a[6] += zv * wb.z; a[7] += zv * wb.w; }
#pragma unroll
            for (int u = 0; u < 8; ++u) ha[pos * 68 + u0 + u] = __sinf(freq[u0 + u] * a[u]);
        }
        __syncthreads();
        {
            float a[8];
#pragma unroll
            for (int u = 0; u < 8; ++u) a[u] = b2[u0 + u];
#pragma unroll 16
            for (int m = 0; m < 64; ++m) { const float zv = ha[pos * 68 + m]; const float4 wa = *(const float4*)(W2 + m * 64 + u0), wb = *(const float4*)(W2 + m * 64 + u0 + 4);
                a[0] += zv * wa.x; a[1] += zv * wa.y; a[2] += zv * wa.z; a[3] += zv * wa.w; a[4] += zv * wb.x; a[5] += zv * wb.y; a[6] += zv * wb.z; a[7] += zv * wb.w; }
#pragma unroll
            for (int u = 0; u < 8; ++u) hb[pos * 68 + u0 + u] = __sinf(freq[64 + u0 + u] * a[u]);
        }
        __syncthreads();
        {
            float a[8];
#pragma unroll
            for (int u = 0; u < 8; ++u) a[u] = b3[u0 + u];
#pragma unroll 16
            for (int m = 0; m < 64; ++m) { const float zv = hb[pos * 68 + m]; const float4 wa = *(const float4*)(W3 + m * 64 + u0), wb = *(const float4*)(W3 + m * 64 + u0 + 4);
                a[0] += zv * wa.x; a[1] += zv * wa.y; a[2] += zv * wa.z; a[3] += zv * wa.w; a[4] += zv * wb.x; a[5] += zv * wb.y; a[6] += zv * wb.z; a[7] += zv * wb.w; }
#pragma unroll
            for (int u = 0; u < 8; ++u) ha[pos * 68 + u0 + u] = __sinf(freq[128 + u0 + u] * a[u]);
        }
        __syncthreads();
#pragma unroll 1
        for (int jt = (item & 7) * 2; jt < (item & 7) * 2 + 2; ++jt) {
            const int lane = tid & 63, wv = tid >> 6, cl = lane & 15, g = lane >> 4;
            union frag { unsigned u[4]; bf16x8v v; };
            frag af[2][2];
#pragma unroll
            for (int mt = 0; mt < 2; ++mt)
#pragma unroll
                for (int ks = 0; ks < 2; ++ks) {
                    const float* wp = w4 + (size_t)(ks * 32 + 8 * g) * 4096 + jt * 256 + wv * 32 + mt * 16 + cl;
                    float x[8];
#pragma unroll
                    for (int i = 0; i < 8; ++i) x[i] = wp[(size_t)i * 4096];
                    af[mt][ks].u[0] = pk_bf16(x[0], x[1]); af[mt][ks].u[1] = pk_bf16(x[2], x[3]); af[mt][ks].u[2] = pk_bf16(x[4], x[5]); af[mt][ks].u[3] = pk_bf16(x[6], x[7]);
                }
            f32x4v acc[2][4];
#pragma unroll
            for (int mt = 0; mt < 2; ++mt)
#pragma unroll
                for (int nt = 0; nt < 4; ++nt) acc[mt][nt] = (f32x4v){0.f, 0.f, 0.f, 0.f};
#pragma unroll
            for (int nt = 0; nt < 4; ++nt)
#pragma unroll
                for (int ks = 0; ks < 2; ++ks) {
                    const float4 h0 = *(const float4*)(ha + (nt * 16 + cl) * 68 + ks * 32 + 8 * g), h1 = *(const float4*)(ha + (nt * 16 + cl) * 68 + ks * 32 + 8 * g + 4);
                    frag bf; bf.u[0] = pk_bf16(h0.x, h0.y); bf.u[1] = pk_bf16(h0.z, h0.w); bf.u[2] = pk_bf16(h1.x, h1.y); bf.u[3] = pk_bf16(h1.z, h1.w);
#pragma unroll
                    for (int mt = 0; mt < 2; ++mt) acc[mt][nt] = __builtin_amdgcn_mfma_f32_16x16x32_bf16(af[mt][ks].v, bf.v, acc[mt][nt], 0, 0, 0);
                }
#pragma unroll
            for (int mt = 0; mt < 2; ++mt)
#pragma unroll
                for (int r = 0; r < 4; ++r) {
                    const int j = jt * 256 + wv * 32 + mt * 16 + 4 * g + r;
                    const float delta = 3.070113457f + (float)(j & 1023) * ((15.35056729f - 3.070113457f) / 1023.0f);
                    float asum = 0.f;
#pragma unroll
                    for (int nt = 0; nt < 4; ++nt) {
                        const int ps = pt * 64 + nt * 16 + cl;
                        const float val = acc[mt][nt][r] * __expf(-((float)ps / 2047.0f) * delta);
                        asum += fabsf(val);
                        __builtin_nontemporal_store(val, hT + (size_t)j * SL + ps);
                    }
                    asum += __shfl_xor(asum, 1); asum += __shfl_xor(asum, 2); asum += __shfl_xor(asum, 4); asum += __shfl_xor(asum, 8);
                    if (cl == 0) sp[(size_t)pt * 4096 + j] = asum;
                }
        }
    }
}

__device__ __forceinline__ void phase_b(const Params& p) {
    const int tid = opaque_tid();
    const float* part = p.ws + W_ADAP; float* ada = p.ws + W_ADA; const float* bada = p.in[I_BADA];
    for (int e = blockIdx.x * NTHREADS + tid; e < 5 * 12288; e += gridDim.x * NTHREADS) {
        float s = bada[e % 12288];
#pragma unroll 8
        for (int ks = 0; ks < 32; ++ks) s += part[(size_t)ks * 5 * 12288 + e];
        ada[e] = s;
    }
    const float* sp = p.ws + W_SP; float* fs = p.ws + W_FS;
    for (int j = blockIdx.x * NTHREADS + tid; j < 4096; j += gridDim.x * NTHREADS) {
        float s = 0.f;
#pragma unroll 8
        for (int pt = 0; pt < 32; ++pt) s += sp[(size_t)pt * 4096 + j];
        fs[j] = s;
    }
}

__device__ __forceinline__ void phase_c(const Params& p) {
    const int tid = opaque_tid();
    const float* ada = p.ws + W_ADA;
    const float* x = p.in[I_X]; bf16_t* ub = (bf16_t*)((char*)p.ws + B_UB);
    for (size_t e = (size_t)blockIdx.x * NTHREADS + tid; e < (size_t)NT * D / 4; e += (size_t)gridDim.x * NTHREADS) {
        const size_t row = e / (D / 4); const int col = (int)(e % (D / 4)) * 4; const int b = (int)(row / SL);
        const float4 xv = nt_load4(x + row * D + col);
        const float4 sh = *(const float4*)(ada + b * 12288 + col), sc = *(const float4*)(ada + b * 12288 + 2048 + col);
        uint2 o; o.x = pk_bf16(xv.x * (1.f + sc.x) + sh.x, xv.y * (1.f + sc.y) + sh.y); o.y = pk_bf16(xv.z * (1.f + sc.z) + sh.z, xv.w * (1.f + sc.w) + sh.w);
        *(uint2*)(ub + row * D + col) = o;
    }
    const float* ctx = p.in[I_CTX]; bf16_t* ucb = ub + (size_t)NT * D;
    for (size_t e = (size_t)blockIdx.x * NTHREADS + tid; e < (size_t)NTC * D / 4; e += (size_t)gridDim.x * NTHREADS) {
        const size_t row = e / (D / 4); const int col = (int)(e % (D / 4)) * 4;
        const float4 xv = nt_load4(ctx + row * D + col);
        const float4 sh = *(const float4*)(ada + 4 * 12288 + col), sc = *(const float4*)(ada + 4 * 12288 + 2048 + col);
        uint2 o; o.x = pk_bf16(xv.x * (1.f + sc.x) + sh.x, xv.y * (1.f + sc.y) + sh.y); o.y = pk_bf16(xv.z * (1.f + sc.z) + sh.z, xv.w * (1.f + sc.w) + sh.w);
        *(uint2*)(ucb + row * D + col) = o;
    }
}

__device__ __forceinline__ float bf2f(bf16_t v) { return __uint_as_float(((unsigned)v) << 16); }
constexpr int HY_PB = 4416, HY_PJ = 272, HY_R0 = 4 * HY_PB, HY_R1 = HY_R0 + 8192 + 64, HY_SLOT = HY_R1 + 8192 + 64;
static_assert(HY_SLOT % 16 == 0 && 4 * HY_SLOT + 64 <= 155 * 1024, "hyena LDS");
__device__ __forceinline__ bf16x8v hy_lda(const unsigned char* base, int off) {
    const unsigned* q = (const unsigned*)(base + off);
    union { unsigned u[4]; bf16x8v v; } r; r.u[0] = q[0]; r.u[1] = q[1]; r.u[2] = q[2]; r.u[3] = q[3];
    return r.v;
}
__device__ __forceinline__ void hy_stage_rows(const bf16_t* zT, const float* cw, const float* cb, int ch, int half, int lane, unsigned char* sl) {
    const float w0 = cw[ch], w1 = cw[3072 + ch], w2 = cw[6144 + ch], bs = cb[ch];
#pragma unroll 4
    for (int q = 0; q < 8; ++q) {
        const int bsel = 2 * half + (q >> 2), t0 = ((q & 3) * 64 + lane) * 8;
        const bf16_t* zrow = zT + (size_t)ch * NT + bsel * SL;
        const uint4 raw = nt_load4u(zrow + t0);
        float z[10];
        z[0] = t0 > 0 ? bf2f(zrow[t0 - 1]) : 0.f; z[9] = t0 + 8 < SL ? bf2f(zrow[t0 + 8]) : 0.f;
        z[1] = __uint_as_float(raw.x << 16); z[2] = __uint_as_float(raw.x & 0xffff0000u); z[3] = __uint_as_float(raw.y << 16); z[4] = __uint_as_float(raw.y & 0xffff0000u);
        z[5] = __uint_as_float(raw.z << 16); z[6] = __uint_as_float(raw.z & 0xffff0000u); z[7] = __uint_as_float(raw.w << 16); z[8] = __uint_as_float(raw.w & 0xffff0000u);
        float sv[8];
#pragma unroll
        for (int i = 0; i < 8; ++i) sv[i] = w0 * z[i] + w1 * z[i + 1] + w2 * z[i + 2] + bs;
        uint4 o; o.x = pk_bf16(sv[0], sv[1]); o.y = pk_bf16(sv[2], sv[3]); o.z = pk_bf16(sv[4], sv[5]); o.w = pk_bf16(sv[6], sv[7]);
        *(uint4*)(sl + bsel * HY_PB + (t0 >> 7) * HY_PJ + (t0 & 127) * 2) = o;
    }
}
__device__ __forceinline__ void hy_pair_sync(volatile __attribute__((address_space(3))) unsigned* fl, int wv, unsigned n) {
    asm volatile("s_waitcnt lgkmcnt(0)" ::: "memory");
    fl[wv] = n;
    while (fl[wv ^ 1] < n) __builtin_amdgcn_s_sleep(0);
    asm volatile("" ::: "memory");
}
__device__ __forceinline__ void phase_hyena(const Params& p, unsigned char* smem) {
    const int tid = opaque_tid(), lane = tid & 63, wv = tid >> 6, slot = wv >> 1, half = wv & 1, pt = tid & 127;
    const bf16_t* zT = (const bf16_t*)((const char*)p.ws + B_ZT); const float* hT = (const float*)((const char*)p.ws + B_KF); const float* fs = p.ws + W_FS; bf16_t* hyT = (bf16_t*)((char*)p.ws + B_HYT);
    const float* cw = p.in[I_CONVW]; const float* cb = p.in[I_CONVB]; const float* skip = p.in[I_SKIP];
    unsigned char* sl = smem + slot * HY_SLOT;
    const int a_ = lane & 31, hh = lane >> 5, i_local = a_ >> 2, batch = a_ & 3, I0 = 8 * half;
    const int laneA = ((a_ & 1) ? HY_R0 : HY_R1) + 2 * (2047 - a_ - (1 - (a_ & 1)) + 8 * hh);
    volatile __attribute__((address_space(3))) unsigned* fl = (volatile __attribute__((address_space(3))) unsigned*)(smem + 4 * HY_SLOT);
    unsigned seq = 0u;
    __syncthreads();
    if (tid < 8) fl[tid] = 0u;
    if (wv < 4) __builtin_amdgcn_s_setprio(2);
    for (int item = blockIdx.x; item < DHY / 4; item += gridDim.x) {
        const int c = item * 4 + slot;
        __syncthreads();
        hy_stage_rows(zT, cw, cb, c, half, lane, sl);
#pragma unroll 1
        for (int ord = 0; ord < 2; ++ord) {
            {
                const float* hf = hT + (size_t)((ord * 2 + 0) * 1024 + c) * SL; const float* hbk = hT + (size_t)((ord * 2 + 1) * 1024 + c) * SL;
                const float sk = skip[ord * 1024 + c]; const float invs = 1.0f / (fs[(ord * 2 + 0) * 1024 + c] + fs[(ord * 2 + 1) * 1024 + c]);
#pragma unroll
                for (int q = 0; q < 4; ++q) {
                    const int X0 = (q * 128 + pt) * 8;
                    float rv[9];
#pragma unroll
                    for (int i = 0; i < 9; ++i) { const int dp = 2047 - X0 - i; rv[i] = (dp >= 0 ? __builtin_nontemporal_load(hf + dp) : (dp >= -2047 ? __builtin_nontemporal_load(hbk - dp) : 0.f)) * invs; if (dp == 0) rv[i] += sk; }
                    uint4 o0, o1;
                    o0.x = pk_bf16(rv[0], rv[1]); o0.y = pk_bf16(rv[2], rv[3]); o0.z = pk_bf16(rv[4], rv[5]); o0.w = pk_bf16(rv[6], rv[7]);
                    o1.x = pk_bf16(rv[1], rv[2]); o1.y = pk_bf16(rv[3], rv[4]); o1.z = pk_bf16(rv[5], rv[6]); o1.w = pk_bf16(rv[7], rv[8]);
                    *(uint4*)(sl + HY_R0 + X0 * 2) = o0; *(uint4*)(sl + HY_R1 + X0 * 2) = o1;
                }
            }
            hy_pair_sync(fl, wv, ++seq);
            f32x16v acc[4];
#pragma unroll
            for (int mb = 0; mb < 4; ++mb)
#pragma unroll
                for (int e = 0; e < 16; ++e) acc[mb][e] = 0.f;
            {
                const int dlo = I0 - 15, dhi = I0 + 7;
                bf16x8v As[7][2];
#pragma unroll
                for (int s2 = 0; s2 < 3; ++s2)
#pragma unroll
                    for (int k2 = 0; k2 < 2; ++k2) As[4 + s2][k2] = hy_lda(sl, laneA - 64 * (4 * dlo - 3 + s2) + 32 * k2);
#pragma unroll 1
                for (int d = dlo; d <= dhi; ++d) {
#pragma unroll
                    for (int k2 = 0; k2 < 2; ++k2) { As[0][k2] = As[4][k2]; As[1][k2] = As[5][k2]; As[2][k2] = As[6][k2]; }
#pragma unroll
                    for (int s2 = 3; s2 < 7; ++s2)
#pragma unroll
                        for (int k2 = 0; k2 < 2; ++k2) As[s2][k2] = hy_lda(sl, laneA - 64 * (4 * d - 3 + s2) + 32 * k2);
                    const int jl = I0 + i_local - d; const bool valid = (unsigned)jl < 16u;
                    const unsigned char* bp = sl + batch * HY_PB + (valid ? jl : 0) * HY_PJ + hh * 16;
                    bf16x8v Bq[8];
#pragma unroll
                    for (int q = 0; q < 8; ++q) { const bf16x8v v = *(const bf16x8v*)(bp + q * 32); const bf16x8v zero = {0, 0, 0, 0, 0, 0, 0, 0}; Bq[q] = valid ? v : zero; }
#pragma unroll
                    for (int kb = 0; kb < 4; ++kb)
#pragma unroll
                        for (int k2 = 0; k2 < 2; ++k2)
#pragma unroll
                            for (int mb = 0; mb < 4; ++mb) acc[mb] = __builtin_amdgcn_mfma_f32_32x32x16_bf16(As[mb - kb + 3][k2], Bq[2 * kb + k2], acc[mb], 0, 0, 0);
                }
            }
            hy_pair_sync(fl, wv, ++seq);
            hy_stage_rows(zT, cw, cb, (ord == 0 ? 1024 : 2048) + c, half, lane, sl);
            hy_pair_sync(fl, wv, ++seq);
            {
#pragma unroll
                for (int mb = 0; mb < 4; ++mb)
#pragma unroll
                    for (int q4 = 0; q4 < 4; ++q4) {
                        const int t4 = 128 * (I0 + i_local) + 32 * mb + 8 * q4 + 4 * hh;
                        uint2* gp = (uint2*)(sl + batch * HY_PB + (t4 >> 7) * HY_PJ + (t4 & 127) * 2);
                        const uint2 gv = *gp;
                        uint2 o; o.x = pk_bf16(__uint_as_float(gv.x << 16) * acc[mb][q4 * 4 + 0], __uint_as_float(gv.x & 0xffff0000u) * acc[mb][q4 * 4 + 1]);
                        o.y = pk_bf16(__uint_as_float(gv.y << 16) * acc[mb][q4 * 4 + 2], __uint_as_float(gv.y & 0xffff0000u) * acc[mb][q4 * 4 + 3]);
                        *gp = o;
                    }
            }
            if (ord == 1) {
                hy_pair_sync(fl, wv, ++seq);
#pragma unroll
                for (int q = 0; q < 8; ++q) {
                    const int bsel = 2 * half + (q >> 2), t0 = ((q & 3) * 64 + lane) * 8;
                    nt_store4u(hyT + (size_t)c * NT + bsel * SL + t0, *(const uint4*)(sl + bsel * HY_PB + (t0 >> 7) * HY_PJ + (t0 & 127) * 2));
                }
            }
        }
    }
    __builtin_amdgcn_s_setprio(0);
}

__device__ __forceinline__ bf16x8v pack_p(const f32x4v& lo, const f32x4v& hi) {
    union { unsigned u[4]; bf16x8v v; } r;
    r.u[0] = pk_bf16(lo[0], lo[1]); r.u[1] = pk_bf16(lo[2], lo[3]); r.u[2] = pk_bf16(hi[0], hi[1]); r.u[3] = pk_bf16(hi[2], hi[3]);
    return r.v;
}
__device__ __forceinline__ bf16x8v ld_pair8(const bf16_t* lo, const bf16_t* hi) {
    union { uint2 d[2]; bf16x8v v; } r;
    r.d[0] = *(const uint2*)lo; r.d[1] = *(const uint2*)hi;
    return r.v;
}
typedef __attribute__((address_space(3))) const bf16_t* lds_bf16p;
#define LDS_FRAG(pe) (*(const __attribute__((address_space(3))) bf16x8v*)(pe))
constexpr int NA_KC = 0, NA_VC = 32768, NA_KL = 65536, NA_RPB = 155648;
__device__ __forceinline__ void phase_na(const Params& p, unsigned char* smem) {
    const int tid = opaque_tid(), lane = tid & 63, wv = tid >> 6, ql = lane & 15, g = lane >> 4;
    const bf16_t* qh = (const bf16_t*)((const char*)p.ws + B_QH); const bf16_t* kh = (const bf16_t*)((const char*)p.ws + B_KH);
    const bf16_t* kch = (const bf16_t*)((const char*)p.ws + B_KCH); const bf16_t* vT = (const bf16_t*)((const char*)p.ws + B_VT);
    const bf16_t* vcT = (const bf16_t*)((const char*)p.ws + B_VCT); bf16_t* na = (bf16_t*)((char*)p.ws + B_NA);
    const float* rpb = p.in[I_RPB];
    const lds_bf16p kcl = (lds_bf16p)((__attribute__((address_space(3))) unsigned char*)smem + NA_KC);
    const lds_bf16p vcl = (lds_bf16p)((__attribute__((address_space(3))) unsigned char*)smem + NA_VC);
    const lds_bf16p kll = (lds_bf16p)((__attribute__((address_space(3))) unsigned char*)smem + NA_KL);
    for (int sitem = blockIdx.x; sitem < 256; sitem += gridDim.x) {
      const int b = sitem >> 6, h = (sitem >> 2) & 15, rqp = sitem & 3;
      __syncthreads();
      {
          const uint4* s0 = (const uint4*)(kch + (size_t)((b * 16 + h) * 32) * 512); const uint4* s1 = (const uint4*)(vcT + (size_t)((b * 16 + h) * 32) * 512);
          uint4* d0 = (uint4*)(smem + NA_KC); uint4* d1 = (uint4*)(smem + NA_VC);
#pragma unroll
          for (int i = 0; i < 4; ++i) { d0[tid + i * NTHREADS] = s0[tid + i * NTHREADS]; d1[tid + i * NTHREADS] = s1[tid + i * NTHREADS]; }
          if (tid < 465) ((float*)(smem + NA_RPB))[tid] = rpb[h * 465 + tid];
      }
#pragma unroll 1
      for (int half = 0; half < 2; ++half) {
        const int r0 = rqp * 8 + half * 4;
        const int rs_min = min(max(r0 - 4, 0), 24), rs_max = min(max(r0 - 1, 0), 24), nrows = rs_max - rs_min + 8;
        if (half) __syncthreads();
        {
            const uint4* s0 = (const uint4*)(kh + (size_t)((b * 16 + h) * 256 + rs_min * 8) * 512); uint4* d0 = (uint4*)(smem + NA_KL);
            for (int e = tid; e < nrows * 512; e += NTHREADS) d0[e] = s0[e];
        }
        __syncthreads();
#pragma unroll 1
        for (int ti = 0; ti < 2; ++ti) {
        const int r = r0 + (wv >> 2) + 2 * ti, j = wv & 3;
        const int rs = min(max(r - 4, 0), 24), cs = min(max(16 * j - 8, 0), 32);
        const int x = 16 * j + ql, wsx = min(max(x - 8, 0), 48);
        const bf16_t* qrow = qh + ((size_t)((b * 16 + h) * SL + r * 64 + x)) * 64;
        const bf16x8v qf0 = __builtin_nontemporal_load((const bf16x8v*)(qrow + 8 * g)), qf1 = __builtin_nontemporal_load((const bf16x8v*)(qrow + 32 + 8 * g));
        const __attribute__((address_space(3))) float* rp_h = (const __attribute__((address_space(3))) float*)((__attribute__((address_space(3))) unsigned char*)smem + NA_RPB);
        f32x4v o1[4], o2[4]; float m1 = -1e30f, l1 = 0.f, m2 = -1e30f, l2 = 0.f;
#pragma unroll
        for (int d = 0; d < 4; ++d) { o1[d] = (f32x4v){0.f, 0.f, 0.f, 0.f}; o2[d] = (f32x4v){0.f, 0.f, 0.f, 0.f}; }
        const int koff = (ql >> 2) * 512 + g * 32 + (ql & 3) * 8;
        const bf16_t* vb = vT + (size_t)((b * 16 + h) * 256 + g) * 512 + ql * 8;
        {
            f32x4v st[16];
#pragma unroll
            for (int kb = 0; kb < 16; ++kb) {
                const lds_bf16p kp = kcl + koff + (kb >> 1) * 2048 + (kb & 1) * 128;
                const bf16x8v a0 = LDS_FRAG(kp), a1 = LDS_FRAG(kp + 256);
                f32x4v acc = {0.f, 0.f, 0.f, 0.f};
                acc = __builtin_amdgcn_mfma_f32_16x16x32_bf16(a0, qf0, acc, 0, 0, 0);
                acc = __builtin_amdgcn_mfma_f32_16x16x32_bf16(a1, qf1, acc, 0, 0, 0);
#pragma unroll
                for (int rr = 0; rr < 4; ++rr) { acc[rr] *= 0.125f; m1 = fmaxf(m1, acc[rr]); }
                st[kb] = acc;
            }
            m1 = fmaxf(m1, __shfl_xor(m1, 16)); m1 = fmaxf(m1, __shfl_xor(m1, 32));
#pragma unroll
            for (int kb = 0; kb < 16; ++kb)
#pragma unroll
                for (int rr = 0; rr < 4; ++rr) { const float e = __expf(st[kb][rr] - m1); st[kb][rr] = e; l1 += e; }
            l1 += __shfl_xor(l1, 16); l1 += __shfl_xor(l1, 32);
#pragma unroll
            for (int kp = 0; kp < 8; ++kp) {
                const bf16x8v pb = pack_p(st[2 * kp], st[2 * kp + 1]);
#pragma unroll
                for (int d = 0; d < 4; ++d) o1[d] = __builtin_amdgcn_mfma_f32_16x16x32_bf16(LDS_FRAG(vcl + g * 512 + ql * 8 + kp * 2048 + d * 128), pb, o1[d], 0, 0, 0);
            }
        }
        {
            f32x4v st[16];
#pragma unroll
            for (int kb = 0; kb < 16; ++kb) {
                const lds_bf16p kp = kll + koff + ((((rs + (kb >> 1) - rs_min) * 64 + cs) >> 3) * 512) + (kb & 1) * 128;
                const bf16x8v a0 = LDS_FRAG(kp), a1 = LDS_FRAG(kp + 256);
                f32x4v acc = {0.f, 0.f, 0.f, 0.f};
                acc = __builtin_amdgcn_mfma_f32_16x16x32_bf16(a0, qf0, acc, 0, 0, 0);
                acc = __builtin_amdgcn_mfma_f32_16x16x32_bf16(a1, qf1, acc, 0, 0, 0);
                const int dr = rs + (kb >> 1) - r + 7;
#pragma unroll
                for (int rr = 0; rr < 4; ++rr) {
                    const int kc = cs + 8 * g + 4 * (kb & 1) + rr, rel = kc - wsx;
                    const bool ok = rel >= 0 && rel < 16;
                    const int dc = min(max(kc - x + 15, 0), 30);
                    const float sv = ok ? acc[rr] * 0.125f + rp_h[dr * 31 + dc] : -1e30f;
                    acc[rr] = sv; m2 = fmaxf(m2, sv);
                }
                st[kb] = acc;
                if ((kb & 7) == 7) asm volatile("" ::: "memory");
            }
            m2 = fmaxf(m2, __shfl_xor(m2, 16)); m2 = fmaxf(m2, __shfl_xor(m2, 32));
#pragma unroll
            for (int kb = 0; kb < 16; ++kb)
#pragma unroll
                for (int rr = 0; rr < 4; ++rr) { const float e = __expf(st[kb][rr] - m2); st[kb][rr] = e; l2 += e; }
            l2 += __shfl_xor(l2, 16); l2 += __shfl_xor(l2, 32);
#pragma unroll
            for (int kp = 0; kp < 8; ++kp) {
                const bf16x8v pb = pack_p(st[2 * kp], st[2 * kp + 1]);
                const bf16_t* vp = vb + (size_t)(((rs + kp) * 64 + cs) >> 3) * 512;
#pragma unroll
                for (int d = 0; d < 4; ++d) o2[d] = __builtin_amdgcn_mfma_f32_16x16x32_bf16(*(const bf16x8v*)(vp + d * 128), pb, o2[d], 0, 0, 0);
                if ((kp & 3) == 3) asm volatile("" ::: "memory");
            }
        }
        const float mm = fmaxf(m1, m2), c1 = __expf(m1 - mm), c2 = __expf(m2 - mm);
        const float inv = 1.0f / (c1 * l1 + c2 * l2);
        const float w1 = c1 * inv, w2 = c2 * inv;
        f32x4v o[4];
#pragma unroll
        for (int d = 0; d < 4; ++d) o[d] = o1[d] * w1 + o2[d] * w2;
        bf16_t* op = na + (size_t)(b * SL + r * 64 + x) * DNA + h * 64 + 4 * g;
#pragma unroll
        for (int d = 0; d < 4; ++d) { uint2 w; w.x = pk_bf16(o[d][0], o[d][1]); w.y = pk_bf16(o[d][2], o[d][3]); nt_store2u(op + 16 * d, w); }
        }
      }
    }
}

__device__ __forceinline__ void phase_f(const Params& p, float* ldsf) {
    const int tid = opaque_tid();
    const bf16_t* hyT = (const bf16_t*)((const char*)p.ws + B_HYT); const bf16_t* na = (const bf16_t*)((const char*)p.ws + B_NA);
    bf16_t* ob = (bf16_t*)((char*)p.ws + B_UB);
    const float* ghy = p.in[I_GHY]; const float* gna = p.in[I_GNA];
    bf16_t* tile = (bf16_t*)ldsf;
    for (int item0 = blockIdx.x; item0 < NT / 32; item0 += gridDim.x) {
        const int item = gridDim.x == 256 ? 32 * (item0 & 7) + (item0 >> 3) : item0;
        const int t0 = item * 32;
        __syncthreads();
        uint4 hvv[8];
#pragma unroll
        for (int q = 0; q < 8; ++q) { const int e = q * NTHREADS + tid; hvv[q] = nt_load4u(hyT + (size_t)(e >> 2) * NT + t0 + (e & 3) * 8); }
#pragma unroll
        for (int q = 0; q < 8; ++q) {
            const int e = q * NTHREADS + tid, ch = e >> 2, part = e & 3;
            const unsigned wd[4] = {hvv[q].x, hvv[q].y, hvv[q].z, hvv[q].w};
#pragma unroll
            for (int i = 0; i < 4; ++i) { tile[(part * 8 + 2 * i) * 1032 + ch] = (bf16_t)(wd[i] & 0xffffu); tile[(part * 8 + 2 * i + 1) * 1032 + ch] = (bf16_t)(wd[i] >> 16); }
        }
        __syncthreads();
        const int tk = tid >> 4, sub = tid & 15;
        float hv[64]; float sh = 0.f, sn = 0.f;
#pragma unroll
        for (int i = 0; i < 8; ++i) {
            const uint4 v = *(const uint4*)(tile + tk * 1032 + (i * 16 + sub) * 8);
            const unsigned wd[4] = {v.x, v.y, v.z, v.w};
#pragma unroll
            for (int k = 0; k < 4; ++k) { const float a = __uint_as_float(wd[k] << 16), c = __uint_as_float(wd[k] & 0xffff0000u); hv[i * 8 + 2 * k] = a; hv[i * 8 + 2 * k + 1] = c; sh += a * a + c * c; }
        }
        const bf16_t* nrow = na + (size_t)(t0 + tk) * DNA;
        uint4 nv[8];
#pragma unroll
        for (int i = 0; i < 8; ++i) { nv[i] = nt_load4u(nrow + (i * 16 + sub) * 8);
            const unsigned wd[4] = {nv[i].x, nv[i].y, nv[i].z, nv[i].w};
#pragma unroll
            for (int k = 0; k < 4; ++k) { const float a = __uint_as_float(wd[k] << 16), c = __uint_as_float(wd[k] & 0xffff0000u); sn += a * a + c * c; } }
        sh += __shfl_xor(sh, 1); sh += __shfl_xor(sh, 2); sh += __shfl_xor(sh, 4); sh += __shfl_xor(sh, 8);
        sn += __shfl_xor(sn, 1); sn += __shfl_xor(sn, 2); sn += __shfl_xor(sn, 4); sn += __shfl_xor(sn, 8);
        const float rh = rsqrtf(sh * (1.0f / 1024.0f) + LN_EPS), rn = rsqrtf(sn * (1.0f / 1024.0f) + LN_EPS);
        bf16_t* orow = ob + (size_t)(t0 + tk) * D;
#pragma unroll
        for (int i = 0; i < 8; ++i) {
            const float4 g0 = *(const float4*)(ghy + (i * 16 + sub) * 8), g1 = *(const float4*)(ghy + (i * 16 + sub) * 8 + 4);
            uint4 w; w.x = pk_bf16(hv[i * 8] * rh * g0.x, hv[i * 8 + 1] * rh * g0.y); w.y = pk_bf16(hv[i * 8 + 2] * rh * g0.z, hv[i * 8 + 3] * rh * g0.w);
            w.z = pk_bf16(hv[i * 8 + 4] * rh * g1.x, hv[i * 8 + 5] * rh * g1.y); w.w = pk_bf16(hv[i * 8 + 6] * rh * g1.z, hv[i * 8 + 7] * rh * g1.w);
            *(uint4*)(orow + (i * 16 + sub) * 8) = w;
        }
#pragma unroll
        for (int i = 0; i < 8; ++i) {
            const float4 g0 = *(const float4*)(gna + (i * 16 + sub) * 8), g1 = *(const float4*)(gna + (i * 16 + sub) * 8 + 4);
            const unsigned wd[4] = {nv[i].x, nv[i].y, nv[i].z, nv[i].w};
            float a[8];
#pragma unroll
            for (int k = 0; k < 4; ++k) { a[2 * k] = __uint_as_float(wd[k] << 16); a[2 * k + 1] = __uint_as_float(wd[k] & 0xffff0000u); }
            uint4 w; w.x = pk_bf16(a[0] * rn * g0.x, a[1] * rn * g0.y); w.y = pk_bf16(a[2] * rn * g0.z, a[3] * rn * g0.w);
            w.z = pk_bf16(a[4] * rn * g1.x, a[5] * rn * g1.y); w.w = pk_bf16(a[6] * rn * g1.z, a[7] * rn * g1.w);
            *(uint4*)(orow + DHY + (i * 16 + sub) * 8) = w;
        }
    }
}

__device__ __forceinline__ void phase_h(const Params& p) {
    const int tid = opaque_tid(), lane = tid & 63, wv = tid >> 6;
    const float* x = p.in[I_X]; const bf16_t* y = (const bf16_t*)((const char*)p.ws + B_Y); const float* ada = p.ws + W_ADA;
    const float* g = p.in[I_LN1G]; const float* be = p.in[I_LN1B];
    bf16_t* x1 = (bf16_t*)((char*)p.ws + B_X1); bf16_t* u2b = (bf16_t*)((char*)p.ws + B_UB); unsigned* u2q = (unsigned*)((char*)p.ws + B_U2Q); float* su2 = p.ws + W_SU2;
#pragma unroll 1
    for (int tpl = blockIdx.x * NWAVES + wv, it = 0; tpl < NT / 2; tpl += gridDim.x * NWAVES, ++it) {
        const int tp = gridDim.x == 256 ? 512 * ((int)blockIdx.x & 7) + ((int)blockIdx.x >> 3) * 16 + wv * 2 + it : tpl;
        const int b = (2 * tp) / SL;
        float v[2][32]; float s[2] = {0.f, 0.f};
#pragma unroll
        for (int u = 0; u < 2; ++u)
#pragma unroll
            for (int j = 0; j < 8; ++j) {
                const int col = j * 256 + lane * 4; const size_t t = (size_t)(2 * tp + u);
                const float4 xv = nt_load4(x + t * D + col); const uint2 yb = nt_load2u(y + t * D + col);
                const float4 yv = make_float4(__uint_as_float(yb.x << 16), __uint_as_float(yb.x & 0xffff0000u), __uint_as_float(yb.y << 16), __uint_as_float(yb.y & 0xffff0000u));
                const float4 gt = *(const float4*)(ada + b * 12288 + 2 * 2048 + col);
                v[u][j * 4] = ALPHA * xv.x + gt.x * yv.x; v[u][j * 4 + 1] = ALPHA * xv.y + gt.y * yv.y; v[u][j * 4 + 2] = ALPHA * xv.z + gt.z * yv.z; v[u][j * 4 + 3] = ALPHA * xv.w + gt.w * yv.w;
                s[u] += (v[u][j * 4] + v[u][j * 4 + 1]) + (v[u][j * 4 + 2] + v[u][j * 4 + 3]);
            }
        float rstd[2];
#pragma unroll
        for (int u = 0; u < 2; ++u) {
            const float mean = wave_sum(s[u]) * (1.0f / 2048.0f);
            float q2 = 0.f;
#pragma unroll
            for (int i = 0; i < 32; ++i) { v[u][i] -= mean; q2 += v[u][i] * v[u][i]; }
            rstd[u] = rsqrtf(wave_sum(q2) * (1.0f / 2048.0f) + LN_EPS);
        }
        asm volatile("" ::: "memory");
        float umx[2] = {0.f, 0.f};
#pragma unroll
        for (int j = 0; j < 8; ++j) {
            const int col = j * 256 + lane * 4;
            const float4 gv = *(const float4*)(g + col), bv = *(const float4*)(be + col);
            const float4 sh = *(const float4*)(ada + b * 12288 + 3 * 2048 + col), sc = *(const float4*)(ada + b * 12288 + 4 * 2048 + col);
#pragma unroll
            for (int u = 0; u < 2; ++u) {
                const size_t t = (size_t)(2 * tp + u);
                const float4 o = make_float4(v[u][j * 4] * rstd[u] * gv.x + bv.x, v[u][j * 4 + 1] * rstd[u] * gv.y + bv.y, v[u][j * 4 + 2] * rstd[u] * gv.z + bv.z, v[u][j * 4 + 3] * rstd[u] * gv.w + bv.w);
                { uint2 xb; xb.x = pk_bf16(o.x, o.y); xb.y = pk_bf16(o.z, o.w); nt_store2u(x1 + t * D + col, xb); }
                const float4 uv = make_float4(o.x * (1.f + sc.x) + sh.x, o.y * (1.f + sc.y) + sh.y, o.z * (1.f + sc.z) + sh.z, o.w * (1.f + sc.w) + sh.w);
                v[u][j * 4] = uv.x; v[u][j * 4 + 1] = uv.y; v[u][j * 4 + 2] = uv.z; v[u][j * 4 + 3] = uv.w;
                uint2 ub2; ub2.x = pk_bf16(uv.x, uv.y); ub2.y = pk_bf16(uv.z, uv.w);
                *(uint2*)(u2b + t * D + col) = ub2;
                umx[u] = fmaxf(umx[u], fmaxf(fmaxf(fabsf(uv.x), fabsf(uv.y)), fmaxf(fabsf(uv.z), fabsf(uv.w))));
            }
        }
#pragma unroll
        for (int u = 0; u < 2; ++u) {
            const size_t t = (size_t)(2 * tp + u);
            const float um = wave_max(umx[u]);
            const float inv = um > 0.f ? 127.0f / um : 0.f;
            uint4 qa, qb;
            qa.x = q4(v[u][0], v[u][1], v[u][2], v[u][3], inv, 0); qa.y = q4(v[u][4], v[u][5], v[u][6], v[u][7], inv, 0); qa.z = q4(v[u][8], v[u][9], v[u][10], v[u][11], inv, 0); qa.w = q4(v[u][12], v[u][13], v[u][14], v[u][15], inv, 0);
            qb.x = q4(v[u][16], v[u][17], v[u][18], v[u][19], inv, 0); qb.y = q4(v[u][20], v[u][21], v[u][22], v[u][23], inv, 0); qb.z = q4(v[u][24], v[u][25], v[u][26], v[u][27], inv, 0); qb.w = q4(v[u][28], v[u][29], v[u][30], v[u][31], inv, 0);
            nt_store4u(u2q + t * 512 + lane * 8, qa); nt_store4u(u2q + t * 512 + lane * 8 + 4, qb);
            if (lane == 0) su2[t] = um * (1.0f / 127.0f);
        }
    }
}

template <int N> __device__ __forceinline__ void bitonic_desc(float (&v)[N]) {
#pragma unroll
    for (int k = 2; k <= N; k <<= 1)
#pragma unroll
        for (int j = k >> 1; j > 0; j >>= 1)
#pragma unroll
            for (int i = 0; i < N; ++i) { const int l = i ^ j; if (l > i) { const float x = v[i], y = v[l]; const float mx = fmaxf(x, y), mn = fminf(x, y); if ((i & k) == 0) { v[i] = mx; v[l] = mn; } else { v[i] = mn; v[l] = mx; } } }
}
__device__ __forceinline__ void bitonic_merge16_desc(float (&v)[16]) {
#pragma unroll
    for (int j = 8; j > 0; j >>= 1)
#pragma unroll
        for (int i = 0; i < 16; ++i) { const int l = i ^ j; if (l > i) { const float x = v[i], y = v[l]; v[i] = fmaxf(x, y); v[l] = fminf(x, y); } }
}
__device__ __forceinline__ void top16_of_128(float (&sc)[32], float (&top)[16]) {
    float lo[16], hi[16];
#pragma unroll
    for (int i = 0; i < 16; ++i) { lo[i] = sc[i]; hi[i] = sc[16 + i]; }
    bitonic_desc<16>(lo); bitonic_desc<16>(hi);
#pragma unroll
    for (int i = 0; i < 16; ++i) top[i] = fmaxf(lo[i], hi[15 - i]);
    bitonic_merge16_desc(top);
#pragma unroll
    for (int off = 16; off <= 32; off <<= 1) {
        float o[16];
#pragma unroll
        for (int i = 0; i < 16; ++i) o[i] = __shfl_xor(top[15 - i], off);
#pragma unroll
        for (int i = 0; i < 16; ++i) top[i] = fmaxf(top[i], o[i]);
        bitonic_merge16_desc(top);
    }
}
__device__ __forceinline__ void ce_carry(float& va, int& xa, float& vb, int& xb, bool desc) {
    const bool sw = desc ? (vb > va) : (vb < va);
    const float tv = sw ? vb : va, uv = sw ? va : vb; const int tx = sw ? xb : xa, ux = sw ? xa : xb;
    va = tv; vb = uv; xa = tx; xb = ux;
}
__device__ __forceinline__ void bitonic_merge16_desc_carry(float (&v)[16], int (&x)[16]) {
#pragma unroll
    for (int j = 8; j > 0; j >>= 1)
#pragma unroll
        for (int i = 0; i < 16; ++i) { const int l = i ^ j; if (l > i) ce_carry(v[i], x[i], v[l], x[l], true); }
}
constexpr int CAND_I[52] = {0,0,0,0,0,0,0,0,0,0,0,0,0,0,0,0,1,1,1,1,1,1,1,1,2,2,2,2,2,3,3,3,3,4,4,4,5,5,6,6,7,7,8,9,10,11,12,13,14,15,-1,-1};
constexpr int CAND_J[52] = {0,1,2,3,4,5,6,7,8,9,10,11,12,13,14,15,0,1,2,3,4,5,6,7,0,1,2,3,4,0,1,2,3,0,1,2,0,1,0,1,0,1,0,0,0,0,0,0,0,0,-1,-1};

__device__ __forceinline__ int rl_i(int v, int l) { return __builtin_amdgcn_readlane(v, l); }
__device__ __forceinline__ float rl_f(float v, int l) { return __int_as_float(__builtin_amdgcn_readlane(__float_as_int(v), l)); }
#define LANE_OF(k) ((((k) >> 3) & 1) * 32 + (((k) >> 2) & 1) * 16 + (((k) >> 1) & 1) * 8 + ((k) & 1) * 4)
constexpr size_t B_KEYSB = 15 * MiB;
constexpr size_t B_QB = B_Y;

typedef float f32x2v __attribute__((ext_vector_type(2)));
#define PKFMA_LO(fv, xv, wsv) do { f32x2v _t; asm("v_cvt_pk_f32_fp8 %1, %2\n\tv_pk_fma_f32 %0, %3, %1, %0" : "+v"(fv), "=&v"(_t) : "v"(xv), "v"(wsv)); } while (0)
#define PKFMA_HI(fv, xv, wsv) do { f32x2v _t; asm("v_cvt_pk_f32_fp8_sdwa %1, %2 src0_sel:WORD_1\n\tv_pk_fma_f32 %0, %3, %1, %0" : "+v"(fv), "=&v"(_t) : "v"(xv), "v"(wsv)); } while (0)
#define PKFMA_F4(fv, xv, wsv, OPSEL) do { f32x2v _t; asm("v_cvt_scalef32_pk_f32_fp4 %1, %2, 1.0 " OPSEL "\n\tv_pk_fma_f32 %0, %3, %1, %0" : "+v"(fv), "=&v"(_t) : "v"(xv), "v"(wsv)); } while (0)
#define FACC(i) (f2[(i) >> 1][(i) & 1])
__device__ __forceinline__ void gather_token(const Params& p, int t, const int* sel_idx, const float* sel_g, int lane) {
    const bf16_t* x1 = (const bf16_t*)((const char*)p.ws + B_X1); const float* ada = p.ws + W_ADA;
    const char* uq = (const char*)p.ws + B_TQ; const char* vq = uq + (size_t)16384 * UROW; const char* u2q = (const char*)p.ws + B_U2Q;
    const __amdgpu_buffer_rsrc_t ursrc = __builtin_amdgcn_make_buffer_rsrc((void*)uq, 0, 16384 * UROW, 0x00020000);
    const __amdgpu_buffer_rsrc_t vrsrc = __builtin_amdgcn_make_buffer_rsrc((void*)vq, 0, 16384 * UROW, 0x00020000);
    const float* su2 = p.ws + W_SU2; const float* rsu = p.ws + W_SU; const float* rsv = p.ws + W_SV;
    const float* g2 = p.in[I_LN2G]; const float* b2 = p.in[I_LN2B];
    const int b = t / SL;
    unsigned uh[4], ul[4]; int us0;
    {
        const uint4 ua_ = nt_load4u(u2q + (size_t)t * D + lane * 32), ub_ = nt_load4u(u2q + (size_t)t * D + lane * 32 + 16);
        const unsigned xw[8] = {ua_.x, ua_.y, ua_.z, ua_.w, ub_.x, ub_.y, ub_.z, ub_.w};
        us0 = 0;
#pragma unroll
        for (int i = 0; i < 8; ++i) us0 = __builtin_amdgcn_sdot4((int)xw[i], 0x01010101, us0, false);
#pragma unroll
        for (int q = 0; q < 4; ++q) {
            const unsigned a = xw[2 * q] ^ 0x80808080u, bq = xw[2 * q + 1] ^ 0x80808080u;
            const unsigned la = a & 0x0F0F0F0Fu, lb = bq & 0x0F0F0F0Fu, ha = (a >> 4) & 0x0F0F0F0Fu, hb = (bq >> 4) & 0x0F0F0F0Fu;
            ul[q] = __builtin_amdgcn_perm(lb | (lb >> 4), la | (la >> 4), 0x06040200u);
            uh[q] = __builtin_amdgcn_perm(hb | (hb >> 4), ha | (ha >> 4), 0x06040200u);
        }
    }
    const float s2 = su2[t];
    const float uoff = 7.5f * wave_sum((float)us0);
    const float* scu = p.ws + W_SC;
    f32x2v f2[16];
#pragma unroll
    for (int i = 0; i < 16; ++i) f2[i] = (f32x2v){0.f, 0.f};
    const int kk8 = ((lane >> 5) & 1) * 4 + ((lane >> 4) & 1) * 2 + ((lane >> 3) & 1);
#define LANE_OF8(k) ((((k) >> 2) & 1) * 32 + (((k) >> 1) & 1) * 16 + ((k) & 1) * 8)
    int e_cur = sel_idx[kk8]; float g_cur = sel_g[kk8];
    uint4 un[8];
#pragma unroll
    for (int k = 0; k < 8; ++k) { const int ro = rl_i(e_cur, LANE_OF8(k)) * UROW; un[k] = __builtin_bit_cast(uint4, __builtin_amdgcn_raw_buffer_load_b128(ursrc, lane * 16, ro, 0)); }
#pragma unroll 1
    for (int bt = 0; bt < 16; ++bt) {
        uint4 vn[8];
#pragma unroll
        for (int k = 0; k < 8; ++k) { const int ro = rl_i(e_cur, LANE_OF8(k)) * UROW; vn[k] = __builtin_bit_cast(uint4, __builtin_amdgcn_raw_buffer_load_b128(vrsrc, lane * 16, ro, 0)); }
        __builtin_amdgcn_sched_barrier(0);
        float part[8];
#pragma unroll
        for (int k = 0; k < 8; ++k) {
            const uint4 nq = un[k];
            unsigned dh = __builtin_amdgcn_udot8(uh[0], nq.x, 0u, false), dl = __builtin_amdgcn_udot8(ul[0], nq.x, 0u, false);
            dh = __builtin_amdgcn_udot8(uh[1], nq.y, dh, false); dl = __builtin_amdgcn_udot8(ul[1], nq.y, dl, false);
            dh = __builtin_amdgcn_udot8(uh[2], nq.z, dh, false); dl = __builtin_amdgcn_udot8(ul[2], nq.z, dl, false);
            dh = __builtin_amdgcn_udot8(uh[3], nq.w, dh, false); dl = __builtin_amdgcn_udot8(ul[3], nq.w, dl, false);
            const unsigned d0 = dh * 16u + dl;
            part[k] = (float)d0;
            __builtin_amdgcn_sched_barrier(0);
        }
        const int bn = (bt + 1) & 15;
        const int e_nxt = sel_idx[bn * 8 + kk8]; const float g_nxt = sel_g[bn * 8 + kk8];
#pragma unroll
        for (int k = 0; k < 8; ++k) { const int ro = rl_i(e_nxt, LANE_OF8(k)) * UROW; un[k] = __builtin_bit_cast(uint4, __builtin_amdgcn_raw_buffer_load_b128(ursrc, lane * 16, ro, 0)); }
        __builtin_amdgcn_sched_barrier(0);
        { const bool up = (lane & 32) != 0;
#pragma unroll
          for (int i = 0; i < 4; ++i) { const float keep = up ? part[i + 4] : part[i], send = up ? part[i] : part[i + 4]; part[i] = keep + __shfl_xor(send, 32); } }
        { const bool up = (lane & 16) != 0;
#pragma unroll
          for (int i = 0; i < 2; ++i) { const float keep = up ? part[i + 2] : part[i], send = up ? part[i] : part[i + 2]; part[i] = keep + __shfl_xor(send, 16); } }
        { const bool up = (lane & 8) != 0;
          const float keep = up ? part[1] : part[0], send = up ? part[0] : part[1]; part[0] = keep + __shfl_xor(send, 8); }
        float tot = part[0]; tot += __shfl_xor(tot, 1); tot += __shfl_xor(tot, 2); tot += __shfl_xor(tot, 4);
        const float dt = (tot - 128.0f * scu[e_cur] - uoff) * s2 * rsu[e_cur];
        const float act = 0.5f * dt * (1.0f + erff(dt * 0.7071067811865476f));
        const float w_l = g_cur * act * rsv[e_cur];
#pragma unroll
        for (int k = 0; k < 8; ++k) {
            const float w = rl_f(w_l, LANE_OF8(k));
            const f32x2v wp0 = {w, w};
            const unsigned wd[4] = {vn[k].x, vn[k].y, vn[k].z, vn[k].w};
#pragma unroll
            for (int q = 0; q < 4; ++q) {
                PKFMA_F4(f2[q * 4 + 0], wd[q], wp0, ""); PKFMA_F4(f2[q * 4 + 1], wd[q], wp0, "op_sel:[1,0,0]"); PKFMA_F4(f2[q * 4 + 2], wd[q], wp0, "op_sel:[0,1,0]"); PKFMA_F4(f2[q * 4 + 3], wd[q], wp0, "op_sel:[1,1,0]");
            }
        }
        e_cur = e_nxt; g_cur = g_nxt;
    }
#undef LANE_OF8
    asm volatile("" ::: "memory");
    float v[32]; float s = 0.f;
#pragma unroll
    for (int q = 0; q < 8; ++q) {
        const int col = q * 256 + lane * 4, o = q * 4;
        const uint2 xb = nt_load2u(x1 + (size_t)t * D + col); const float4 gt = *(const float4*)(ada + b * 12288 + 5 * 2048 + col);
        const float4 xv = make_float4(__uint_as_float(xb.x << 16), __uint_as_float(xb.x & 0xffff0000u), __uint_as_float(xb.y << 16), __uint_as_float(xb.y & 0xffff0000u));
        v[o] = ALPHA * xv.x + gt.x * FACC(o); v[o + 1] = ALPHA * xv.y + gt.y * FACC(o + 1);
        v[o + 2] = ALPHA * xv.z + gt.z * FACC(o + 2); v[o + 3] = ALPHA * xv.w + gt.w * FACC(o + 3);
        s += (v[o] + v[o + 1]) + (v[o + 2] + v[o + 3]);
    }
    const float mean = wave_sum(s) * (1.0f / 2048.0f);
    float q2 = 0.f;
#pragma unroll
    for (int i = 0; i < 32; ++i) { v[i] -= mean; q2 += v[i] * v[i]; }
    const float rstd = rsqrtf(wave_sum(q2) * (1.0f / 2048.0f) + LN_EPS);
    asm volatile("" ::: "memory");
#pragma unroll
    for (int q = 0; q < 8; ++q) {
        const int col = q * 256 + lane * 4, o = q * 4;
        const float4 gv = *(const float4*)(g2 + col), bv = *(const float4*)(b2 + col);
        nt_store4(p.out + (size_t)t * D + col, v[o] * rstd * gv.x + bv.x, v[o + 1] * rstd * gv.y + bv.y, v[o + 2] * rstd * gv.z + bv.z, v[o + 3] * rstd * gv.w + bv.w);
    }
}

__device__ __forceinline__ void phase_jk(const Params& p, unsigned char* smem) {
    const int tid0 = opaque_tid();
    const bf16_t* qb = (const bf16_t*)((const char*)p.ws + B_QB); const bf16_t* keysb = (const bf16_t*)((const char*)p.ws + B_KEYSB);
    int* sel_idx = (int*)smem; float* sel_g = (float*)(smem + 8192);
#pragma unroll 1
    for (int iteml = blockIdx.x, itn = 0; iteml < NT / 16; iteml += gridDim.x, ++itn) {
        const int item = gridDim.x == 256 ? 64 * ((int)blockIdx.x & 7) + ((int)blockIdx.x >> 3) + 32 * itn : iteml;
        int tid = tid0; asm volatile("" : "+v"(tid));
        const int lane = tid & 63, wv = tid >> 6, ql = lane & 15, g = lane >> 4;
        const int t0 = item * 16, h = wv;
        __syncthreads();
        float ta[16], tb[16];
#pragma unroll
        for (int i = 0; i < 16; ++i) { ta[i] = 0.f; tb[i] = 0.f; }
#pragma unroll 1
        for (int pp = 0; pp < 2; ++pp) {
            const bf16_t* qrow = qb + ((size_t)((((t0 >> 4) * 8 + h) * 2 + pp) * 4) * 64 + lane) * 8;
            bf16x8v qf[4];
#pragma unroll
            for (int kc = 0; kc < 4; ++kc) qf[kc] = __builtin_nontemporal_load((const bf16x8v*)(qrow + kc * 512));
            const bf16_t* kbase = keysb + (size_t)((h * 2 + pp) * 8) * 2048 + lane * 8;
            float sc[32];
#pragma unroll
            for (int nb = 0; nb < 8; ++nb) {
                f32x4v acc = {0.f, 0.f, 0.f, 0.f};
#pragma unroll
                for (int kc = 0; kc < 4; ++kc) acc = __builtin_amdgcn_mfma_f32_16x16x32_bf16(*(const bf16x8v*)(kbase + (nb * 4 + kc) * 512), qf[kc], acc, 0, 0, 0);
#pragma unroll
                for (int rr = 0; rr < 4; ++rr) sc[nb * 4 + rr] = __int_as_float((__float_as_int(acc[rr]) & ~127) | (16 * nb + 4 * g + rr));
                if (nb == 3) asm volatile("" ::: "memory");
            }
            float top[16];
            top16_of_128(sc, top);
#pragma unroll
            for (int i = 0; i < 16; ++i) { if (pp == 0) ta[i] = top[i]; else tb[i] = top[i]; }
        }
        float cv[16]; int cx[16];
#pragma unroll
        for (int sidx = 0; sidx < 13; ++sidx) {
            float vv[4]; int xx[4];
#pragma unroll
            for (int q = 0; q < 4; ++q) {
                const int ci = CAND_I[4 * sidx + q], cj = CAND_J[4 * sidx + q];
                if (ci >= 0) { vv[q] = ta[ci] + tb[cj]; xx[q] = ((__float_as_int(ta[ci]) & 127) << 7) | (__float_as_int(tb[cj]) & 127); } else { vv[q] = -3.0e38f; xx[q] = 0; }
            }
            cv[sidx] = g == 0 ? vv[0] : (g == 1 ? vv[1] : (g == 2 ? vv[2] : vv[3]));
            cx[sidx] = g == 0 ? xx[0] : (g == 1 ? xx[1] : (g == 2 ? xx[2] : xx[3]));
        }
#pragma unroll
        for (int sidx = 13; sidx < 16; ++sidx) { cv[sidx] = -3.0e38f; cx[sidx] = 0; }
#pragma unroll
        for (int k = 2; k <= 16; k <<= 1)
#pragma unroll
            for (int j = k >> 1; j > 0; j >>= 1)
#pragma unroll
                for (int i = 0; i < 16; ++i) { const int l = i ^ j; if (l > i) ce_carry(cv[i], cx[i], cv[l], cx[l], (i & k) == 0); }
#pragma unroll
        for (int off = 16; off <= 32; off <<= 1) {
            float ov[16]; int ox[16];
#pragma unroll
            for (int i = 0; i < 16; ++i) { ov[i] = __shfl_xor(cv[15 - i], off); ox[i] = __shfl_xor(cx[15 - i], off); }
#pragma unroll
            for (int i = 0; i < 16; ++i) { const bool tk = ov[i] > cv[i]; cv[i] = tk ? ov[i] : cv[i]; cx[i] = tk ? ox[i] : cx[i]; }
            bitonic_merge16_desc_carry(cv, cx);
        }
        {
            float ex[16]; float sum = 0.f;
#pragma unroll
            for (int i = 0; i < 16; ++i) { ex[i] = __expf(cv[i] - cv[0]); sum += ex[i]; }
            const float inv = 1.0f / sum;
            if (g == 0) {
#pragma unroll
                for (int q = 0; q < 4; ++q) {
                    *(int4*)(sel_idx + ql * 128 + h * 16 + q * 4) = make_int4(cx[q * 4], cx[q * 4 + 1], cx[q * 4 + 2], cx[q * 4 + 3]);
                    *(float4*)(sel_g + ql * 128 + h * 16 + q * 4) = make_float4(ex[q * 4] * inv, ex[q * 4 + 1] * inv, ex[q * 4 + 2] * inv, ex[q * 4 + 3] * inv);
                }
            }
        }
        __syncthreads();
#pragma unroll 1
        for (int k = 0; k < 2; ++k) { int lane2 = lane; asm volatile("" : "+v"(lane2)); gather_token(p, t0 + 2 * wv + k, sel_idx + (2 * wv + k) * 128, sel_g + (2 * wv + k) * 128, lane2); }
    }
}

__device__ __forceinline__ void map_tile(int L, int nM, int nN, int& pm, int& pn) {
    const int nwg = nM * nN; int wgid = L;
    { const int q = nwg / 8, r = nwg % 8, xcd = wgid % 8, off = wgid / 8; wgid = (xcd < r ? xcd * (q + 1) : r * (q + 1) + (xcd - r) * q) + off; }
    const int nig = 8 * nN, gid = wgid / nig, fm = gid * 8, gsz = (nM - fm) < 8 ? (nM - fm) : 8;
    pm = fm + ((wgid % nig) % gsz); pn = (wgid % nig) / gsz;
}
struct ProjOrder {
    int G, c; const bf16_t* ub; const bf16_t* wint;
    __device__ bool next(int i, pg8::Unit& u) const {
        const int L = i * G + c; if (L >= 800) return false;
        if (L < 384) { u.kind = 0; map_tile(L, 12, 32, u.pm, u.pn); }
        else if (L < 512) { u.kind = 1; map_tile(L - 384, 4, 32, u.pm, u.pn); }
        else if (L < 768) { u.kind = 2; map_tile(L - 512, 32, 8, u.pm, u.pn); }
        else if (L < 784) { u.kind = 3; u.pm = (L - 768) >> 2; u.pn = (L - 768) & 3; }
        else { u.kind = 4; u.pm = (L - 784) >> 2; u.pn = (L - 784) & 3; }
        return true;
    }
    __device__ __forceinline__ void a_ready(const pg8::Unit&) const {}
    __device__ __forceinline__ void done(const pg8::Unit&) const {}
    template <class G_> __device__ __forceinline__ const char* pa(const G_&, const pg8::Unit& u) const {
        const size_t ts = (size_t)256 * D * 2;
        switch (u.kind) { case 0: return (const char*)wint + (size_t)u.pm * ts; case 1: return (const char*)wint + (size_t)(20 + u.pm) * ts; case 2: return (const char*)ub + (size_t)u.pm * ts;
                          case 3: return (const char*)ub + (size_t)(32 + u.pm) * ts; default: return (const char*)wint + (size_t)(20 + u.pm) * ts; }
    }
    template <class G_> __device__ __forceinline__ const char* pb(const G_&, const pg8::Unit& u) const {
        const size_t ts = (size_t)256 * D * 2;
        switch (u.kind) { case 0: case 1: return (const char*)ub + (size_t)u.pn * ts; case 2: return (const char*)wint + (size_t)(12 + u.pn) * ts;
                          case 3: return (const char*)wint + (size_t)(16 + u.pn) * ts; default: return (const char*)ub + (size_t)(32 + u.pn) * ts; }
    }
};
struct EpiProj {
    static constexpr bool PERM = true, AFTER_DRAIN = false;
    unsigned char* ws;
    __device__ __forceinline__ void operator()(const pg8::f32x4 (&acc)[2][2][4][2], const pg8::Unit& u, int wr, int wc, int fr, int fq) const {
        bf16_t* const zT = (bf16_t*)(ws + B_ZT); bf16_t* const vT = (bf16_t*)(ws + B_VT); bf16_t* const qh = (bf16_t*)(ws + B_QH); bf16_t* const kh = (bf16_t*)(ws + B_KH);
        bf16_t* const kch = (bf16_t*)(ws + B_KCH); bf16_t* const vcT = (bf16_t*)(ws + B_VCT);
#pragma unroll
        for (int ai = 0; ai < 2; ++ai)
#pragma unroll
            for (int m = 0; m < 4; ++m) {
                const int r = u.pm * 256 + ai * 128 + wr * 64 + m * 16 + fr;
#pragma unroll
                for (int bj = 0; bj < 2; ++bj) {
                    const int cc = u.pn * 256 + bj * 128 + wc * 32 + 8 * fq;
                    bf16_t* dst;
                    if (u.kind == 0) dst = zT + (size_t)r * NT + cc;
                    else if (u.kind == 1) {
                        const int bb = cc >> 11, t = cc & 2047, hh = r >> 6, dd = r & 63;
                        dst = vT + (size_t)((bb * 16 + hh) * 256 + (t >> 3)) * 512 + (dd >> 4) * 128 + (dd & 15) * 8;
                    } else if (u.kind == 2) {
                        const int bb = r >> 11, t = r & 2047, hc = cc & 1023, hh = hc >> 6, dd = hc & 63;
                        if (cc < 1024) dst = qh + ((size_t)((bb * 16 + hh) * SL + t)) * 64 + dd;
                        else dst = kh + (size_t)((bb * 16 + hh) * 256 + (t >> 3)) * 512 + (dd >> 5) * 256 + ((t & 7) >> 2) * 128 + ((dd & 31) >> 3) * 32 + (t & 3) * 8;
                    } else if (u.kind == 3) {
                        const int bb = r >> 8, jj = r & 255, hh = cc >> 6, dd = cc & 63;
                        dst = kch + (size_t)((bb * 16 + hh) * 32 + (jj >> 3)) * 512 + (dd >> 5) * 256 + ((jj & 7) >> 2) * 128 + ((dd & 31) >> 3) * 32 + (jj & 3) * 8;
                    } else {
                        const int bb = cc >> 8, jj = cc & 255, hh = r >> 6, dd = r & 63;
                        dst = vcT + (size_t)((bb * 16 + hh) * 32 + (jj >> 3)) * 512 + (dd >> 4) * 128 + (dd & 15) * 8;
                    }
                    const pg8::f32x4 v0 = acc[ai][bj][m][0], v1 = acc[ai][bj][m][1];
                    pg8::u32x4 w; w.x = pg8::cvt_pk_bf16(v0[0], v0[1]); w.y = pg8::cvt_pk_bf16(v0[2], v0[3]); w.z = pg8::cvt_pk_bf16(v1[0], v1[1]); w.w = pg8::cvt_pk_bf16(v1[2], v1[3]);
                    *(pg8::u32x4*)dst = w;
                }
            }
    }
};

struct EpiQFrag {
    static constexpr bool PERM = true, AFTER_DRAIN = false;
    bf16_t* O;
    __device__ __forceinline__ void operator()(const pg8::f32x4 (&acc)[2][2][4][2], const pg8::Unit& u, int wr, int wc, int fr, int fq) const {
#pragma unroll
        for (int ai = 0; ai < 2; ++ai)
#pragma unroll
            for (int m = 0; m < 4; ++m) {
                const int t = u.pm * 256 + ai * 128 + wr * 64 + m * 16 + fr;
#pragma unroll
                for (int bj = 0; bj < 2; ++bj) {
                    const int c = u.pn * 256 + bj * 128 + wc * 32 + 8 * fq;
                    const int hh = c >> 8, pp = (c >> 7) & 1, d = c & 127;
                    bf16_t* dst = O + ((size_t)(((((t >> 4) * 8 + hh) * 2 + pp) * 4 + (d >> 5)) * 64 + ((d & 31) >> 3) * 16 + (t & 15))) * 8;
                    const pg8::f32x4 v0 = acc[ai][bj][m][0], v1 = acc[ai][bj][m][1];
                    pg8::u32x4 w; w.x = pg8::cvt_pk_bf16(v0[0], v0[1]); w.y = pg8::cvt_pk_bf16(v0[2], v0[3]); w.z = pg8::cvt_pk_bf16(v1[0], v1[1]); w.w = pg8::cvt_pk_bf16(v1[2], v1[3]);
                    __builtin_nontemporal_store(w, (pg8::u32x4*)dst);
                }
            }
    }
};

#define XB_TMO      128
#define XB_XCNT(j)  (256  + 64 * (j))
#define XB_XSUB(j)  (1280 + 64 * (j))
#define XB_XGEN(j)  (2304 + 64 * (j))
#define XB_TOP      3328
#define XB_TOPGEN   3392
#define XCD_BAR_WORDS 3456
#define XB_SPIN_CAP (1u << 18)
#define LAS __attribute__((address_space(3)))

__device__ __forceinline__ unsigned xb_ld(unsigned* p)              { return __hip_atomic_load(p, __ATOMIC_RELAXED, __HIP_MEMORY_SCOPE_AGENT); }
__device__ __forceinline__ unsigned xb_add(unsigned* p, unsigned v) { return __hip_atomic_fetch_add(p, v, __ATOMIC_RELAXED, __HIP_MEMORY_SCOPE_AGENT); }
__device__ __forceinline__ unsigned xb_xcc_id() { return (unsigned)__builtin_amdgcn_s_getreg((3 << 11) | 20) & 0xFu; }
#define XB_SPIN(cond, bar) do { unsigned _sp = 0; while (cond) { __builtin_amdgcn_s_sleep(1); \
    if ((++_sp & 255u) == 0u) { if (xb_ld(&(bar)[XB_TMO])) break; if (_sp > XB_SPIN_CAP) { atomicAdd(&(bar)[XB_TMO], 1u); break; } } } } while (0)

struct XcdBarrier {
    unsigned* bar; unsigned x;
    volatile LAS unsigned* st;
};

__device__ __forceinline__ XcdBarrier xcd_barrier_post(unsigned* bar, volatile LAS unsigned* st) {
    XcdBarrier b; b.bar = bar; b.x = xb_xcc_id(); b.st = st;
    if (threadIdx.x == 0) (void)xb_add(&bar[XB_XCNT(b.x)], 1u);
    return b;
}
__device__ __forceinline__ void xcd_barrier_complete(unsigned* bar, unsigned x, unsigned& nloc, unsigned& nx) {
    const unsigned G = gridDim.x * gridDim.y * gridDim.z;
    unsigned sum, cnt, mine, sp = 0u;
    for (;;) {
        sum = 0u; cnt = 0u; mine = 0u;
#pragma unroll
        for (unsigned j = 0; j < 16; ++j) { const unsigned c = xb_ld(&bar[XB_XCNT(j)]); sum += c; cnt += (c > 0u) ? 1u : 0u; mine = (j == x) ? c : mine; }
        if (sum == G) break;
        __builtin_amdgcn_s_sleep(1);
        if ((++sp & 255u) == 0u) { if (xb_ld(&bar[XB_TMO])) break; if (sp > XB_SPIN_CAP) { atomicAdd(&bar[XB_TMO], 1u); break; } }
    }
    nloc = mine > 0u ? mine : 1u; nx = cnt > 0u ? cnt : 1u;
}

__device__ __forceinline__ void xcd_barrier_arrive(const XcdBarrier& b) {
    asm volatile("s_waitcnt vmcnt(0)" ::: "memory");
    __syncthreads();
    if (threadIdx.x == 0) {
        unsigned* bar = b.bar;
        __builtin_amdgcn_s_waitcnt(0);
        unsigned nloc = b.st[0], nx = b.st[1]; const unsigned k = b.st[2];
        if (nloc == 0u) { xcd_barrier_complete(bar, b.x, nloc, nx); b.st[0] = nloc; b.st[1] = nx; }
        b.st[2] = k + 1u;
        const unsigned old = xb_add(&bar[XB_XSUB(b.x)], 1u);
        if (old + 1u == (k + 1u) * nloc) {
            __builtin_amdgcn_fence(__ATOMIC_RELEASE, "agent");
            asm volatile("s_waitcnt vmcnt(0)" ::: "memory");
            (void)xb_add(&bar[XB_TOP], 1u);
        }
        asm volatile("buffer_inv sc1" ::: "memory");
    }
}
__device__ __forceinline__ void xcd_barrier_wait(const XcdBarrier& b) {
    if (threadIdx.x == 0) {
        unsigned* bar = b.bar;
        const unsigned nx = b.st[1], k1 = b.st[2];
        XB_SPIN(xb_ld(&bar[XB_TOP]) < k1 * nx, bar);
        asm volatile("s_waitcnt vmcnt(0)" ::: "memory");
    }
    __syncthreads();
}
__device__ __forceinline__ void xcd_barrier(const XcdBarrier& b) { xcd_barrier_arrive(b); xcd_barrier_wait(b); }
__device__ __forceinline__ void xcd_barrier_hosting(const XcdBarrier& b, const Params& p, int slice, float* lds = nullptr) {
    xcd_barrier_arrive(b);
    if (gridDim.x == 256) {
        if (slice >= 0) quant_tables<1>(p, 0, 256, 2048 * slice, 2048 * (slice + 1));
        else transpose_convert(p.in[I_WIN], (bf16_t*)((char*)p.ws + B_WINT), D, DPROJ, lds, 0, 256, 256 * (-slice), 256 * (-slice + 1));
    }
    xcd_barrier_wait(b);
}
constexpr size_t B_BAR = 14 * MiB;

__global__ void __launch_bounds__(NTHREADS) fwd_megakernel(Params p) {
    extern __shared__ __attribute__((aligned(16))) unsigned char smem[];
    float* lds = (float*)smem; float* red = (float*)(smem + RED_OFF);
    PG8_LAS unsigned char* glds = (PG8_LAS unsigned char*)smem;
    volatile LAS unsigned* xst = (volatile LAS unsigned*)(smem + LDS_BYTES - 16);
    if (threadIdx.x < 4) xst[threadIdx.x] = 0u;
    __syncthreads();
    XcdBarrier xb = xcd_barrier_post((unsigned*)((char*)p.ws + B_BAR), xst);
    bf16_t* wint = (bf16_t*)((char*)p.ws + B_WINT); bf16_t* woutt = (bf16_t*)((char*)p.ws + B_WOUTT); bf16_t* wqt = (bf16_t*)((char*)p.ws + B_WQT);
    bf16_t* ub = (bf16_t*)((char*)p.ws + B_UB);
    phase_a(p, lds);
    transpose_convert(p.in[I_WIN], wint, D, DPROJ, lds, 0, (int)gridDim.x, 0, gridDim.x == 256 ? 256 : (1 << 30));
    phase_filters(p, lds);
    {
        const float* ks = p.in[I_KEYS]; bf16_t* kd = (bf16_t*)((char*)p.ws + B_KEYSB);
        for (int e = blockIdx.x * NTHREADS + threadIdx.x; e < 16 * 128 * 128 / 4; e += gridDim.x * NTHREADS) {
            const float4 v = *(const float4*)(ks + e * 4); uint2 o; o.x = pk_bf16(v.x, v.y); o.y = pk_bf16(v.z, v.w);
            const int d = (e * 4) & 127, n = ((e * 4) >> 7) & 127, hp = (e * 4) >> 14;
            *(uint2*)(kd + ((size_t)(((hp * 8 + (n >> 4)) * 4 + (d >> 5)) * 64 + ((d & 31) >> 3) * 16 + (n & 15))) * 8 + (d & 7)) = o;
        }
    }
    xcd_barrier_hosting(xb, p, -1, lds);
    phase_b(p);
    xcd_barrier_hosting(xb, p, -2, lds);
    phase_c(p);
    xcd_barrier_hosting(xb, p, 0);
    {
        pg8::Gemm g{ub, wint, NT + NTC, DPROJ, D}; ProjOrder S{(int)gridDim.x, (int)blockIdx.x, ub, wint};
        EpiProj E{(unsigned char*)p.ws};
        pg8::gemm_phase<EpiProj, ProjOrder>(glds, g, S, E, nullptr);
    }
    if (gridDim.x == 256 && blockIdx.x >= 32) {
        quant_tables(p, 32, 224, 3 * 2048, 4 * 2048);
        quant_tables(p, 32, 224, 7 * 2048, 2 * 16384);
        transpose_convert(p.in[I_WOUT], woutt, D, D, lds, 32, 224);
        transpose_convert(p.in[I_WQ], wqt, D, D, lds, 32, 224);
    } else if (gridDim.x != 256) {
        quant_tables(p, 0, (int)gridDim.x);
        transpose_convert(p.in[I_WOUT], woutt, D, D, lds, 0, (int)gridDim.x);
        transpose_convert(p.in[I_WQ], wqt, D, D, lds, 0, (int)gridDim.x);
    }
    xcd_barrier_hosting(xb, p, 1);
    phase_hyena(p, smem);
    phase_na(p, smem);
    xcd_barrier_hosting(xb, p, 4);
    phase_f(p, lds);
    xcd_barrier_hosting(xb, p, 5);
    {
        pg8::Gemm g{ub, woutt, NT, D, D}; pg8::XcdRowOrder S; S.init(NT, D, (int)gridDim.x, (int)blockIdx.x);
        pg8::EpiBf16<0> E{(bf16_t*)((char*)p.ws + B_Y), D, nullptr, 0, 0};
        pg8::gemm_phase<pg8::EpiBf16<0>, pg8::XcdRowOrder>(glds, g, S, E, nullptr);
    }
    xcd_barrier_hosting(xb, p, 6);
    phase_h(p);
    xcd_barrier_hosting(xb, p, 2);
    {
        pg8::Gemm g{ub, wqt, NT, D, D}; pg8::XcdRowOrder S; S.init(NT, D, (int)gridDim.x, (int)blockIdx.x);
        EpiQFrag E{(bf16_t*)((char*)p.ws + B_QB)};
        pg8::gemm_phase<EpiQFrag, pg8::XcdRowOrder>(glds, g, S, E, nullptr);
    }
    xcd_barrier(xb);
    phase_jk(p, smem);
}

extern "C" void kernel_launch(void* const* d_in, const int* in_sizes, int n_in, void* d_out, int out_size, void* d_ws, size_t ws_size, hipStream_t stream) {
    static int grid_blocks = 0;
    if (grid_blocks == 0) {
        if (n_in != N_IN || out_size != NT * D || ws_size < W_END * sizeof(float)) {
            fprintf(stderr, "kernel_launch: unexpected shapes: n_in %d out %d ws %zu (need %zu)\n", n_in, out_size, ws_size, (size_t)W_END * 4); grid_blocks = -1; return; }
        int dev = 0, cus = 0, per_cu = 0;
        hipGetDevice(&dev);
        hipDeviceGetAttribute(&cus, hipDeviceAttributeMultiprocessorCount, dev);
        if (hipFuncSetAttribute((const void*)fwd_megakernel, hipFuncAttributeMaxDynamicSharedMemorySize, LDS_BYTES) != hipSuccess) { fprintf(stderr, "kernel_launch: hipFuncSetAttribute failed\n"); grid_blocks = -1; return; }
        if (hipOccupancyMaxActiveBlocksPerMultiprocessor(&per_cu, (const void*)fwd_megakernel, NTHREADS, LDS_BYTES) != hipSuccess || per_cu < 1) { fprintf(stderr, "kernel_launch: occupancy query failed (%d)\n", per_cu); (void)hipGetLastError(); grid_blocks = -1; return; }
        grid_blocks = cus * (per_cu > 1 ? 1 : per_cu);
        fprintf(stderr, "kernel_launch: cus %d per_cu %d grid %d\n", cus, per_cu, grid_blocks);
    }
    if (grid_blocks < 0) return;
    Params p{};
    for (int i = 0; i < N_IN; ++i) p.in[i] = (const float*)d_in[i];
    p.out = (float*)d_out; p.ws = (float*)d_ws;
    if (hipMemsetAsync((char*)d_ws + B_BAR, 0, XCD_BAR_WORDS * sizeof(unsigned), stream) != hipSuccess) { fprintf(stderr, "kernel_launch: memset failed\n"); return; }
    void* args[] = {&p};
    hipLaunchKernelGGL(fwd_megakernel, dim3(grid_blocks), dim3(NTHREADS), LDS_BYTES, stream, p);
    const hipError_t e = hipPeekAtLastError();
    if (e != hipSuccess) fprintf(stderr, "launch failed: %s (grid %d)\n", hipGetErrorString(e), grid_blocks);
}
```
